# Optimizing an MI355X kernel written in HIP

```python
import math
import jax, jax.numpy as jnp
from jax import lax
import numpy as np

D_MODEL = 1024
BATCH = 8
SEQ = 4096
DEPTH = 2

GRID_W = 64
CTX_LEN = 256

RET_HEADS = 4
RET_DK = 128
RET_DV = 256
RET_CHUNK = 128
RET_QK = RET_HEADS * RET_DK
RET_V = RET_HEADS * RET_DV

GLA_HEADS = 4
GLA_DK = 128
GLA_DV = 256
GLA_RANK = 16
GLA_CHUNK = 64
GLA_LOGIT_NORM = 16.0
GLA_QK = GLA_HEADS * GLA_DK
GLA_V = GLA_HEADS * GLA_DV

ROPE_BASE = 10000.0
EPS = 1e-6

IN_SPLITS = (RET_QK, RET_QK, RET_V, RET_V, GLA_QK, GLA_QK, GLA_V, GLA_V, GLA_RANK, D_MODEL, D_MODEL)
IN_WIDTH = 2 * RET_QK + 2 * RET_V + 2 * GLA_QK + 2 * GLA_V + GLA_RANK + 2 * D_MODEL

kernel_name = "hybrid_retention_gla_prefix_dit"


def rms_norm(x, gain):
    xf = x.astype(jnp.float32)
    y = xf * lax.rsqrt(jnp.mean(xf * xf, axis=-1, keepdims=True) + EPS)
    return (y * gain.astype(jnp.float32)).astype(x.dtype)


def modulation(cvec, w_ada, b_ada):
    m = jax.nn.silu(cvec) @ w_ada + b_ada
    return jnp.split(m, 3, axis=-1)


def split_columns(p):
    idx, acc = [], 0
    for w in IN_SPLITS[:-1]:
        acc += w
        idx.append(acc)
    return jnp.split(p, idx, axis=-1)


def to_heads(t, n_heads):
    b, l, w = t.shape
    return t.reshape(b, l, n_heads, w // n_heads).transpose(0, 2, 1, 3)


def from_heads(t):
    b, h, l, d = t.shape
    return t.transpose(0, 2, 1, 3).reshape(b, l, h * d)


def flip(t):
    return jnp.flip(t, axis=2)


def axial_rotary(rows):
    r_idx, c_idx = jnp.meshgrid(jnp.arange(rows), jnp.arange(GRID_W), indexing="ij")
    r_idx = r_idx.reshape(-1).astype(jnp.float32)
    c_idx = c_idx.reshape(-1).astype(jnp.float32)
    n_freq = RET_DK // 4
    inv_freq = ROPE_BASE ** (-jnp.arange(n_freq, dtype=jnp.float32) / n_freq)
    ang_r = r_idx[:, None] * inv_freq
    ang_c = c_idx[:, None] * inv_freq
    ang = jnp.stack([ang_r, ang_r, ang_c, ang_c], axis=1).reshape(-1, RET_DK)
    return jnp.cos(ang), jnp.sin(ang)


def apply_rotary(t, cos, sin):
    tr = t.reshape(*t.shape[:-1], 2, 2, RET_DK // 4)
    rot = jnp.concatenate([-tr[..., 1:, :], tr[..., :1, :]], axis=-2).reshape(t.shape)
    return t * cos + rot * sin


def retention_chunked(q, k, v, log_gamma, state0, strict):
    b, nh, seq, dk = q.shape
    dv = v.shape[-1]
    n = seq // RET_CHUNK
    qc = q.reshape(b, nh, n, RET_CHUNK, dk)
    kc = k.reshape(b, nh, n, RET_CHUNK, dk)
    vc = v.reshape(b, nh, n, RET_CHUNK, dv)
    pos = jnp.arange(RET_CHUNK, dtype=jnp.float32)
    diff = pos[:, None] - pos[None, :]
    keep = (diff > 0) if strict else (diff >= 0)
    decay = jnp.where(keep, jnp.exp(log_gamma[:, None, None] * jnp.where(keep, diff, 0.0)), 0.0)
    scores = jnp.einsum("bhnid,bhnjd->bhnij", qc, kc) * decay[None, :, None]
    intra = jnp.einsum("bhnij,bhnje->bhnie", scores, vc)
    lgv = log_gamma[None, :, None, None, None]
    k_dec = kc * jnp.exp(lgv * (RET_CHUNK - 1.0 - pos)[:, None])
    kv_chunk = jnp.einsum("bhncd,bhnce->bhnde", k_dec, vc)
    gamma_chunk = jnp.exp(log_gamma * RET_CHUNK)[None, :, None, None]

    def step(s, kv):
        return gamma_chunk * s + kv, s

    s_final, s_prev = lax.scan(step, state0, jnp.moveaxis(kv_chunk, 2, 0))
    s_prev = jnp.moveaxis(s_prev, 0, 2)
    q_dec = qc * jnp.exp(lgv * (pos + 1.0)[:, None])
    inter = jnp.einsum("bhncd,bhnde->bhnce", q_dec, s_prev)
    return (intra + inter).reshape(b, nh, seq, dv), s_final


def gla_chunked(q, k, v, log_a, state0, strict):
    b, nh, seq, dk = q.shape
    dv = v.shape[-1]
    n = seq // GLA_CHUNK
    qc = q.reshape(b, nh, n, GLA_CHUNK, dk)
    kc = k.reshape(b, nh, n, GLA_CHUNK, dk)
    vc = v.reshape(b, nh, n, GLA_CHUNK, dv)
    g = jnp.cumsum(log_a.reshape(b, nh, n, GLA_CHUNK, dk), axis=3)
    g_ref = g[:, :, :, GLA_CHUNK // 2 - 1:GLA_CHUNK // 2, :]
    g_last = g[:, :, :, -1:, :]
    q_rel = qc * jnp.exp(g - g_ref)
    k_rel = kc * jnp.exp(g_ref - g)
    pos = jnp.arange(GLA_CHUNK)
    keep = (pos[:, None] > pos[None, :]) if strict else (pos[:, None] >= pos[None, :])
    scores = jnp.where(keep, jnp.einsum("bhnid,bhnjd->bhnij", q_rel, k_rel), 0.0)
    intra = jnp.einsum("bhnij,bhnje->bhnie", scores, vc)
    kv_chunk = jnp.einsum("bhncd,bhnce->bhnde", kc * jnp.exp(g_last - g), vc)
    chunk_decay = jnp.exp(g_last[:, :, :, 0, :])

    def step(s, inp):
        a, kv = inp
        return a[..., None] * s + kv, s

    s_final, s_prev = lax.scan(step, state0, (jnp.moveaxis(chunk_decay, 2, 0), jnp.moveaxis(kv_chunk, 2, 0)))
    s_prev = jnp.moveaxis(s_prev, 0, 2)
    inter = jnp.einsum("bhncd,bhnde->bhnce", qc * jnp.exp(g), s_prev)
    return (intra + inter).reshape(b, nh, seq, dv), s_final


def gla_log_decay(z, w_up, b_up):
    logit = (z @ w_up + b_up).astype(jnp.float32)
    return to_heads(jax.nn.log_sigmoid(logit) / GLA_LOGIT_NORM, GLA_HEADS)


def token_mixers(u, w_in, ret_decay, gla_w_up, gla_b_up, rotary, init_states):
    p = u @ w_in
    rq, rk, rv, rg, gq, gk, gv, gg, glr, ma, mb = split_columns(p)
    s_rf0, s_rb0, s_gf0, s_gb0 = init_states
    rq = to_heads(rq, RET_HEADS) * RET_DK ** -0.5
    rk = to_heads(rk, RET_HEADS)
    if rotary is not None:
        cos, sin = rotary
        rq = apply_rotary(rq, cos, sin)
        rk = apply_rotary(rk, cos, sin)
    rv = to_heads(rv, RET_HEADS)
    log_gamma = jnp.log1p(-jnp.exp(ret_decay.astype(jnp.float32)))
    ret_f, s_rf = retention_chunked(rq, rk, rv, log_gamma[0], s_rf0, False)
    ret_b, s_rb = retention_chunked(flip(rq), flip(rk), flip(rv), log_gamma[1], s_rb0, True)
    ret = ret_f + flip(ret_b)
    gq = to_heads(gq, GLA_HEADS) * GLA_DK ** -0.5
    gk = to_heads(gk, GLA_HEADS)
    gv = to_heads(gv, GLA_HEADS)
    log_a_f = gla_log_decay(glr, gla_w_up[0], gla_b_up[0])
    log_a_b = gla_log_decay(glr, gla_w_up[1], gla_b_up[1])
    gla_f, s_gf = gla_chunked(gq, gk, gv, log_a_f, s_gf0, False)
    gla_b, s_gb = gla_chunked(flip(gq), flip(gk), flip(gv), flip(log_a_b), s_gb0, True)
    gla = gla_f + flip(gla_b)
    return (ret, gla, rg, gg, ma, mb), (s_rf, s_rb, s_gf, s_gb)


def head_group_norm(o, gain):
    of = o.astype(jnp.float32)
    mu = jnp.mean(of, axis=-1, keepdims=True)
    var = jnp.mean(jnp.square(of - mu), axis=-1, keepdims=True)
    return from_heads((of - mu) * lax.rsqrt(var + EPS)) * gain.astype(jnp.float32)


def head_rms_norm(o, gain):
    of = o.astype(jnp.float32)
    y = of * lax.rsqrt(jnp.mean(of * of, axis=-1, keepdims=True) + EPS)
    return from_heads(y) * gain.astype(jnp.float32)


def merge_branches(parts, ret_norm_gain, gla_norm_gain, w_branch_ret, w_branch_gla, w_out):
    ret, gla, rg, gg, ma, mb = parts
    dtype = rg.dtype
    y_ret = (head_group_norm(ret, ret_norm_gain).astype(dtype) * jax.nn.silu(rg)) @ w_branch_ret
    y_gla = (head_rms_norm(gla, gla_norm_gain).astype(dtype) * jax.nn.silu(gg)) @ w_branch_gla
    merged = jax.nn.sigmoid(ma) * y_ret + jax.nn.sigmoid(mb) * y_gla
    return merged @ w_out


def setup_inputs(seed: int = 0) -> dict:
    key = jax.random.key(seed)
    ks = jax.random.split(key, 18)

    def normal(k, shape, scale):
        return scale * jax.random.normal(k, shape, jnp.float32)

    ret_decay_base = -math.log(2.0) * (5.0 + jnp.arange(RET_HEADS, dtype=jnp.float32))
    return {
        "x": normal(ks[0], (BATCH, SEQ, D_MODEL), 1.0),
        "c": normal(ks[1], (BATCH, D_MODEL), 1.0),
        "ctx": normal(ks[2], (BATCH, CTX_LEN, D_MODEL), 1.0),
        "c_ctx": normal(ks[3], (D_MODEL,), 1.0),
        "norm_gain": 1.0 + normal(ks[4], (DEPTH, D_MODEL), 0.1),
        "w_ada": normal(ks[5], (DEPTH, D_MODEL, 3 * D_MODEL), 0.5 * D_MODEL ** -0.5),
        "b_ada": normal(ks[6], (DEPTH, 3 * D_MODEL), 0.02),
        "w_in": normal(ks[7], (DEPTH, D_MODEL, IN_WIDTH), D_MODEL ** -0.5),
        "ret_decay": ret_decay_base + normal(ks[8], (DEPTH, 2, RET_HEADS), 0.05),
        "gla_w_up": normal(ks[9], (DEPTH, 2, GLA_RANK, GLA_QK), GLA_RANK ** -0.5),
        "gla_b_up": normal(ks[10], (DEPTH, 2, GLA_QK), 0.1),
        "ret_norm_gain": 1.0 + normal(ks[11], (DEPTH, RET_V), 0.1),
        "gla_norm_gain": 1.0 + normal(ks[12], (DEPTH, GLA_V), 0.1),
        "w_branch_ret": normal(ks[13], (DEPTH, RET_V, D_MODEL), RET_V ** -0.5),
        "w_branch_gla": normal(ks[14], (DEPTH, GLA_V, D_MODEL), GLA_V ** -0.5),
        "w_out": normal(ks[15], (DEPTH, D_MODEL, D_MODEL), D_MODEL ** -0.5),
        "final_norm_gain": 1.0 + normal(ks[16], (D_MODEL,), 0.1),
    }


def reference(x, c, ctx, c_ctx, norm_gain, w_ada, b_ada, w_in, ret_decay, gla_w_up, gla_b_up,
              ret_norm_gain, gla_norm_gain, w_branch_ret, w_branch_gla, w_out, final_norm_gain):
    batch, n_latent = x.shape[0], x.shape[1]
    rows = n_latent // GRID_W
    rotary = axial_rotary(rows)
    zero_states = (
        jnp.zeros((batch, RET_HEADS, RET_DK, RET_DV), jnp.float32),
        jnp.zeros((batch, RET_HEADS, RET_DK, RET_DV), jnp.float32),
        jnp.zeros((batch, GLA_HEADS, GLA_DK, GLA_DV), jnp.float32),
        jnp.zeros((batch, GLA_HEADS, GLA_DK, GLA_DV), jnp.float32),
    )
    h_lat, h_ctx = x, ctx
    for l in range(DEPTH):
        shift_x, scale_x, gate_x = modulation(c, w_ada[l], b_ada[l])
        shift_c, scale_c, gate_c = modulation(c_ctx, w_ada[l], b_ada[l])
        u_ctx = rms_norm(h_ctx, norm_gain[l]) * (1.0 + scale_c) + shift_c
        ctx_parts, ctx_states = token_mixers(u_ctx, w_in[l], ret_decay[l], gla_w_up[l], gla_b_up[l],
                                             None, zero_states)
        u_lat = rms_norm(h_lat, norm_gain[l]) * (1.0 + scale_x[:, None, :]) + shift_x[:, None, :]
        lat_parts, _ = token_mixers(u_lat, w_in[l], ret_decay[l], gla_w_up[l], gla_b_up[l],
                                    rotary, ctx_states)
        h_lat = h_lat + gate_x[:, None, :] * merge_branches(
            lat_parts, ret_norm_gain[l], gla_norm_gain[l], w_branch_ret[l], w_branch_gla[l], w_out[l])
        if l < DEPTH - 1:
            h_ctx = h_ctx + gate_c * merge_branches(
                ctx_parts, ret_norm_gain[l], gla_norm_gain[l], w_branch_ret[l], w_branch_gla[l], w_out[l])
    return rms_norm(h_lat, final_norm_gain)
```

```cpp
#include <hip/hip_runtime.h>
#include <hip/hip_cooperative_groups.h>
#include <cstdio>
namespace cg = cooperative_groups;

typedef unsigned short u16;
using bf16x8 = __attribute__((ext_vector_type(8))) short;
using bf16x4 = __attribute__((ext_vector_type(4))) short;
using f32x4  = __attribute__((ext_vector_type(4))) float;

#define NTHREADS 512
#define DM 1024
#define NB 8
#define SEQL 4096
#define CTXL 256
#define MLAT 32768
#define MCTX 2048
#define MTOT 34816
#define INW 8208

#define OFF_S    0ull
#define OFF_RG   (OFF_S   + (size_t)MTOT * 4096 * 2)
#define OFF_U    (OFF_RG  + (size_t)MTOT * 2048 * 2)
#define OFF_WT   (OFF_U   + (size_t)MTOT * 1024 * 2)
#define WT_ROWS  11392
#define OFF_GLR  (OFF_WT  + (size_t)WT_ROWS * 1024 * 2)
#define OFF_HCTX (OFF_GLR + (size_t)MTOT * 16 * 4)
#define OFF_MOD  (OFF_HCTX+ (size_t)MCTX * 1024 * 4)
#define OFF_ROT  (OFF_MOD + (size_t)2 * 9 * 3072 * 4)
#define OFF_END  (OFF_ROT + (size_t)64 * 32 * 2 * 4)

#define WT_SCAN 0
#define WT_GATE 4224
#define WT_BRR  8320
#define WT_BRG  9344
#define WT_OUT  10368

#define LDS_BYTES 161792
#define SCAN_GB   80896

struct Params {
  const float* x; const float* c; const float* ctx; const float* c_ctx;
  const float* norm_gain; const float* w_ada; const float* b_ada; const float* w_in;
  const float* ret_decay; const float* gla_w_up; const float* gla_b_up;
  const float* ret_norm_gain; const float* gla_norm_gain;
  const float* w_br_ret; const float* w_br_gla; const float* w_out; const float* final_gain;
  float* out; char* ws;
};

__device__ __forceinline__ u16 f2bf(float f) {
  unsigned u = __float_as_uint(f);
  u += 0x7fffu + ((u >> 16) & 1u);
  return (u16)(u >> 16);
}
__device__ __forceinline__ float bf2f(u16 h) { return __uint_as_float(((unsigned)h) << 16); }
__device__ __forceinline__ float sigmoidf_(float x) { return 1.f / (1.f + __expf(-x)); }
__device__ __forceinline__ float siluf_(float x) { return x / (1.f + __expf(-x)); }

__device__ __forceinline__ int opaque_tid() { int t = threadIdx.x; asm volatile("" : "+v"(t)); return t; }

__device__ __forceinline__ float wave_sum(float v) {
#pragma unroll
  for (int o = 32; o > 0; o >>= 1) v += __shfl_xor(v, o, 64);
  return v;
}

__device__ __forceinline__ const float* wt_src(const Params& p, int l, int n, int& ld) {
  if (n < WT_GATE) {
    int tile = n >> 7, cc = n & 127;
    int col;
    if (tile < 8) {
      int d = (cc & 64) | ((cc & 16) << 1) | ((cc & 32) >> 1) | (cc & 15);
      col = tile * 128 + d;
    } else if (tile < 16) col = 1024 + (tile - 8) * 128 + cc;
    else if (tile < 24) col = 3072 + (tile - 16) * 128 + cc;
    else if (tile < 32) col = 4096 + (tile - 24) * 128 + cc;
    else { if (cc >= 16) { ld = 0; return nullptr; } col = 6144 + cc; }
    ld = INW; return p.w_in + (size_t)l * DM * INW + col;
  } else if (n < WT_BRR) {
    int g = n - WT_GATE; int col;
    if (g < 1024) col = 2048 + g;
    else if (g < 2048) col = 5120 + (g - 1024);
    else if (g < 3072) col = 6160 + (g - 2048);
    else col = 7184 + (g - 3072);
    ld = INW; return p.w_in + (size_t)l * DM * INW + col;
  } else if (n < WT_BRG) { ld = DM; return p.w_br_ret + (size_t)l * DM * DM + (n - WT_BRR); }
  else if (n < WT_OUT)   { ld = DM; return p.w_br_gla + (size_t)l * DM * DM + (n - WT_BRG); }
  else                   { ld = DM; return p.w_out    + (size_t)l * DM * DM + (n - WT_OUT); }
}

#define WT_UNITS (178 * 16)
__device__ __forceinline__ void wt_unit(const Params& p, int l, int unit, char* smem) {
  float* tile = (float*)smem;
  int nb = unit >> 4, kb = unit & 15;
  int tid = opaque_tid();
  int n0 = nb * 64, k0 = kb * 64;
  {
    int nl = tid & 63, kq = tid >> 6;
    int ld; const float* src = wt_src(p, l, n0 + nl, ld);
#pragma unroll
    for (int i = 0; i < 8; ++i) {
      int kl = kq + 8 * i;
      float v = src ? src[(size_t)(k0 + kl) * ld] : 0.f;
      tile[kl * 65 + nl] = v;
    }
  }
  __syncthreads();
  {
    int nl = tid >> 3, kq = tid & 7;
    bf16x8 o;
#pragma unroll
    for (int j = 0; j < 8; ++j) o[j] = (short)f2bf(tile[(kq * 8 + j) * 65 + nl]);
    u16* wt = (u16*)(p.ws + OFF_WT);
    *(bf16x8*)(wt + (size_t)(n0 + nl) * 1024 + k0 + kq * 8) = o;
  }
  __syncthreads();
}

__device__ __forceinline__ void mod_unit(const Params& p, int unit, char* smem) {
  float* sc = (float*)smem;
  float* red = sc + 9 * 1024;
  int l = unit / 48, jb = unit % 48;
  int tid = opaque_tid();
  for (int i = tid; i < 9 * 1024; i += NTHREADS) {
    int r = i >> 10, k = i & 1023;
    float v = (r < 8) ? p.c[r * 1024 + k] : p.c_ctx[k];
    sc[i] = siluf_(v);
  }
  __syncthreads();
  int jl = tid & 63, kg = tid >> 6;
  int j = jb * 64 + jl;
  float acc[9];
#pragma unroll
  for (int r = 0; r < 9; ++r) acc[r] = 0.f;
  const float* w = p.w_ada + (size_t)l * DM * 3072 + j;
  for (int k = kg * 128; k < kg * 128 + 128; ++k) {
    float wv = w[(size_t)k * 3072];
#pragma unroll
    for (int r = 0; r < 9; ++r) acc[r] += sc[r * 1024 + k] * wv;
  }
#pragma unroll
  for (int r = 0; r < 9; ++r) red[(kg * 9 + r) * 64 + jl] = acc[r];
  __syncthreads();
  float* mod = (float*)(p.ws + OFF_MOD);
  for (int i = tid; i < 9 * 64; i += NTHREADS) {
    int r = i >> 6, jj = i & 63;
    float s = 0.f;
#pragma unroll
    for (int g = 0; g < 8; ++g) s += red[(g * 9 + r) * 64 + jj];
    mod[((size_t)l * 9 + r) * 3072 + jb * 64 + jj] = s + p.b_ada[l * 3072 + jb * 64 + jj];
  }
  __syncthreads();
}

__device__ __forceinline__ void rot_unit(const Params& p) {
  float* rot = (float*)(p.ws + OFF_ROT);
  for (int i = opaque_tid(); i < 64 * 32; i += NTHREADS) {
    int pos = i >> 5, f = i & 31;
    float inv = exp2f(-(float)f * (13.287712379549449f / 32.f));
    float ang = (float)pos * inv;
    rot[i * 2] = __cosf(ang);
    rot[i * 2 + 1] = __sinf(ang);
  }
}

__device__ __forceinline__ void phase_u(const Params& p, int l) {
  const int tid = opaque_tid(); int wave = tid >> 6, lane = tid & 63;
  const float* mod = (const float*)(p.ws + OFF_MOD) + (size_t)l * 9 * 3072;
  const float* gain = p.norm_gain + l * DM;
  u16* U = (u16*)(p.ws + OFF_U);
  for (int row = blockIdx.x * 8 + wave; row < MTOT; row += gridDim.x * 8) {
    const float* h; int r;
    if (row < MLAT) { h = (l == 0 ? p.x : p.out) + (size_t)row * DM; r = row >> 12; }
    else { int cr = row - MLAT; h = (l == 0 ? p.ctx : (const float*)(p.ws + OFF_HCTX)) + (size_t)cr * DM; r = 8; }
    float4 v[4]; float ss = 0.f;
#pragma unroll
    for (int i = 0; i < 4; ++i) {
      v[i] = *(const float4*)(h + i * 256 + lane * 4);
      ss += v[i].x * v[i].x + v[i].y * v[i].y + v[i].z * v[i].z + v[i].w * v[i].w;
    }
    ss = wave_sum(ss);
    float rstd = rsqrtf(ss * (1.f / 1024.f) + 1e-6f);
    const float* sh = mod + r * 3072;
#pragma unroll
    for (int i = 0; i < 4; ++i) {
      int cidx = i * 256 + lane * 4;
      float4 g = *(const float4*)(gain + cidx);
      float4 s = *(const float4*)(sh + cidx);
      float4 sc = *(const float4*)(sh + 1024 + cidx);
      bf16x4 o;
      o[0] = (short)f2bf(v[i].x * rstd * g.x * (1.f + sc.x) + s.x);
      o[1] = (short)f2bf(v[i].y * rstd * g.y * (1.f + sc.y) + s.y);
      o[2] = (short)f2bf(v[i].z * rstd * g.z * (1.f + sc.z) + s.z);
      o[3] = (short)f2bf(v[i].w * rstd * g.w * (1.f + sc.w) + s.w);
      *(bf16x4*)(U + (size_t)row * DM + cidx) = o;
    }
  }
}

__device__ __forceinline__ void phase_final(const Params& p) {
  const int tid = opaque_tid(); int wave = tid >> 6, lane = tid & 63;
  for (int row = blockIdx.x * 8 + wave; row < MLAT; row += gridDim.x * 8) {
    float* h = p.out + (size_t)row * DM;
    float4 v[4]; float ss = 0.f;
#pragma unroll
    for (int i = 0; i < 4; ++i) {
      v[i] = *(const float4*)(h + i * 256 + lane * 4);
      ss += v[i].x * v[i].x + v[i].y * v[i].y + v[i].z * v[i].z + v[i].w * v[i].w;
    }
    ss = wave_sum(ss);
    float rstd = rsqrtf(ss * (1.f / 1024.f) + 1e-6f);
#pragma unroll
    for (int i = 0; i < 4; ++i) {
      int cidx = i * 256 + lane * 4;
      float4 g = *(const float4*)(p.final_gain + cidx);
      float4 o;
      o.x = v[i].x * rstd * g.x; o.y = v[i].y * rstd * g.y; o.z = v[i].z * rstd * g.z; o.w = v[i].w * rstd * g.w;
      *(float4*)(h + cidx) = o;
    }
  }
}

__device__ __forceinline__ int lds_byte(int r, int c) {
  int st = (r >> 4) * 2 + (c >> 5), rr = r & 15, cc = c & 31, ob = rr * 64 + cc * 2;
  return st * 1024 + (ob ^ (((ob >> 9) & 1) << 5));
}

__device__ __forceinline__ void stage_half(int tid, const u16* __restrict__ g, size_t ld, int row0, int k0, char* lds_half) {
#pragma unroll
  for (int i = 0; i < 2; ++i) {
    int b = tid * 16 + i * 8192;
    int st = b >> 10, sb = b & 1023, swz = sb ^ (((sb >> 9) & 1) << 5);
    int R = (st >> 1) * 16 + (swz >> 6), C = (st & 1) * 32 + ((swz & 63) >> 1);
    __builtin_amdgcn_global_load_lds((const unsigned*)(g + (size_t)(row0 + R) * ld + k0 + C),
                                     (__attribute__((address_space(3))) unsigned*)(lds_half + b), 16, 0, 0);
  }
}

__device__ __forceinline__ void gemm_mainloop(const u16* __restrict__ A, size_t lda, int row0,
                                              const u16* __restrict__ Bt, size_t ldb, int col0,
                                              int K, char* smem, f32x4 (&acc)[4][4], int tid) {
  const int wid = tid >> 6, lane = tid & 63;
  const int wr = wid >> 1, wc = wid & 1, fr = lane & 15, fq = lane >> 4;
  const int nt = K / 64;
  __syncthreads();
  stage_half(tid, A, lda, row0, 0, smem);
  stage_half(tid, A, lda, row0 + 128, 0, smem + 16384);
  stage_half(tid, Bt, ldb, col0, 0, smem + 32768);
  asm volatile("s_waitcnt vmcnt(0)" ::: "memory");
  __syncthreads();
  for (int t = 0; t < nt; ++t) {
    char* cur = smem + (t & 1) * 49152;
    if (t + 1 < nt) {
      char* nxt = smem + ((t + 1) & 1) * 49152;
      int k0 = (t + 1) * 64;
      stage_half(tid, A, lda, row0, k0, nxt);
      stage_half(tid, A, lda, row0 + 128, k0, nxt + 16384);
      stage_half(tid, Bt, ldb, col0, k0, nxt + 32768);
    }
    const char* sa = cur + (wr >> 1) * 16384;
    const char* sb = cur + 32768;
#pragma unroll
    for (int ks = 0; ks < 2; ++ks) {
      bf16x8 af[4], bfr[4];
#pragma unroll
      for (int m = 0; m < 4; ++m) af[m] = *(const bf16x8*)(sa + lds_byte((wr & 1) * 64 + m * 16 + fr, ks * 32 + fq * 8));
#pragma unroll
      for (int n = 0; n < 4; ++n) bfr[n] = *(const bf16x8*)(sb + lds_byte(wc * 64 + n * 16 + fr, ks * 32 + fq * 8));
#pragma unroll
      for (int m = 0; m < 4; ++m)
#pragma unroll
        for (int n = 0; n < 4; ++n)
          acc[m][n] = __builtin_amdgcn_mfma_f32_16x16x32_bf16(af[m], bfr[n], acc[m][n], 0, 0, 0);
    }
    asm volatile("s_waitcnt vmcnt(0)" ::: "memory");
    __syncthreads();
  }
  __builtin_amdgcn_sched_barrier(0);
}

#define ZERO_ACC(a) _Pragma("unroll") for (int _m = 0; _m < 4; ++_m) _Pragma("unroll") for (int _n = 0; _n < 4; ++_n) a[_m][_n] = (f32x4){0.f, 0.f, 0.f, 0.f}

__device__ __forceinline__ void gemm_scan_in(const Params& p, int tile, char* smem) {
  const int tid = opaque_tid();
  const int mt = tile / 33, ntile = tile % 33;
  const u16* U = (const u16*)(p.ws + OFF_U);
  const u16* WT = (const u16*)(p.ws + OFF_WT) + (size_t)WT_SCAN * 1024;
  f32x4 acc[4][4]; ZERO_ACC(acc);
  gemm_mainloop(U, 1024, mt * 256, WT, 1024, ntile * 128, 1024, smem, acc, tid);
  const int wid = tid >> 6, lane = tid & 63;
  const int wr = wid >> 1, wc = wid & 1, fr = lane & 15, fq = lane >> 4;
  const unsigned rl0 = wr * 64 + fq * 4;
  if (ntile == 32) {
    float* GLRb = (float*)(p.ws + OFF_GLR) + (size_t)mt * 256 * 16;
    if (wc == 0) {
#pragma unroll
      for (int m = 0; m < 4; ++m)
#pragma unroll
        for (int j = 0; j < 4; ++j) GLRb[(rl0 + m * 16 + j) * 16u + fr] = acc[m][0][j];
    }
    return;
  }
  u16* Sb = (u16*)(p.ws + OFF_S) + (size_t)mt * 256 * 4096 + ntile * 128;
  const bool is_qk = ntile < 8;
  const bool scaled = (ntile < 4) || (ntile >= 16 && ntile < 20);
  const float scl = scaled ? 0.08838834764831845f : 1.f;
  const unsigned c0 = wc * 64 + fr;
  if (is_qk && mt < 128) {
    const float* rot = (const float*)(p.ws + OFF_ROT);
    const int tbase = (mt & 15) * 256;
#pragma unroll
    for (int m = 0; m < 4; ++m)
#pragma unroll
      for (int j = 0; j < 4; ++j) {
        unsigned rl = rl0 + m * 16 + j;
        int t = tbase + rl;
        unsigned pos = (wc == 0) ? (t >> 6) : (t & 63);
#pragma unroll
        for (int g = 0; g < 2; ++g) {
          float2 cs = *(const float2*)(rot + (pos * 32u + g * 16 + fr) * 2u);
          float x0 = acc[m][2 * g][j] * scl, x1 = acc[m][2 * g + 1][j] * scl;
          float o0 = x0 * cs.x - x1 * cs.y, o1 = x1 * cs.x + x0 * cs.y;
          unsigned o = rl * 4096u + c0;
          Sb[o + (2 * g) * 16] = f2bf(o0);
          Sb[o + (2 * g + 1) * 16] = f2bf(o1);
        }
      }
  } else {
#pragma unroll
    for (int m = 0; m < 4; ++m)
#pragma unroll
      for (int j = 0; j < 4; ++j) {
        unsigned o = (rl0 + m * 16 + j) * 4096u + c0;
#pragma unroll
        for (int n = 0; n < 4; ++n) Sb[o + n * 16] = f2bf(acc[m][n][j] * scl);
      }
  }
}

__device__ __forceinline__ void gemm_gate(const Params& p, int l, int tile, char* smem) {
  const int tid = opaque_tid();
  const int mt = tile >> 5, ntile = tile & 31;
  const u16* U = (const u16*)(p.ws + OFF_U);
  const u16* WT = (const u16*)(p.ws + OFF_WT) + (size_t)WT_GATE * 1024;
  const int wid = tid >> 6, lane = tid & 63;
  const int wr = wid >> 1, wc = wid & 1, fr = lane & 15, fq = lane >> 4;
  float* stat = (float*)(smem + 98304);
  const bool is_norm = ntile < 16;
  const int branch = ntile >> 3;
  const u16* RGb = (const u16*)(p.ws + OFF_RG) + (size_t)mt * 256 * 2048 + (branch & 1) * 1024;
  if (is_norm) {
    __syncthreads();
    int head = (ntile & 7) >> 1;
    for (int rr = 0; rr < 32; ++rr) {
      unsigned rl = wid * 32 + rr;
      bf16x4 v = *(const bf16x4*)(RGb + rl * 2048u + head * 256 + lane * 4);
      float a0 = bf2f((u16)v[0]), a1 = bf2f((u16)v[1]), a2 = bf2f((u16)v[2]), a3 = bf2f((u16)v[3]);
      float s1 = a0 + a1 + a2 + a3, s2 = a0 * a0 + a1 * a1 + a2 * a2 + a3 * a3;
      s1 = wave_sum(s1); s2 = wave_sum(s2);
      float sa, sb;
      if (branch == 0) {
        float mu = s1 * (1.f / 256.f);
        float var = fmaxf(s2 * (1.f / 256.f) - mu * mu, 0.f);
        sa = rsqrtf(var + 1e-6f); sb = -mu * sa;
      } else { sa = rsqrtf(s2 * (1.f / 256.f) + 1e-6f); sb = 0.f; }
      if (lane == 0) { stat[rl * 2] = sa; stat[rl * 2 + 1] = sb; }
    }
  }
  f32x4 acc[4][4]; ZERO_ACC(acc);
  gemm_mainloop(U, 1024, mt * 256, WT, 1024, ntile * 128, 1024, smem, acc, tid);
  u16* Sb = (u16*)(p.ws + OFF_S) + (size_t)mt * 256 * 4096;
  const unsigned rl0 = wr * 64 + fq * 4;
  if (is_norm) {
    const float* gain = (branch == 0 ? p.ret_norm_gain : p.gla_norm_gain) + l * 1024;
    const unsigned cin = (ntile & 7) * 128 + wc * 64 + fr;
    float gn[4];
#pragma unroll
    for (int n = 0; n < 4; ++n) gn[n] = gain[cin + n * 16];
#pragma unroll
    for (int m = 0; m < 4; ++m)
#pragma unroll
      for (int j = 0; j < 4; ++j) {
        unsigned rl = rl0 + m * 16 + j;
        float sa = stat[rl * 2], sb = stat[rl * 2 + 1];
#pragma unroll
        for (int n = 0; n < 4; ++n) {
          float x = bf2f(RGb[rl * 2048u + cin + n * 16]);
          float y = (x * sa + sb) * gn[n] * siluf_(acc[m][n][j]);
          Sb[rl * 4096u + 2048u + branch * 1024 + cin + n * 16] = f2bf(y);
        }
      }
  } else {
    const unsigned cout = (ntile - 16) * 128 + wc * 64 + fr;
#pragma unroll
    for (int m = 0; m < 4; ++m)
#pragma unroll
      for (int j = 0; j < 4; ++j) {
        unsigned o = (rl0 + m * 16 + j) * 4096u + cout;
#pragma unroll
        for (int n = 0; n < 4; ++n) Sb[o + n * 16] = f2bf(sigmoidf_(acc[m][n][j]));
      }
  }
}

__device__ __forceinline__ void gemm_merge(const Params& p, int tile, char* smem) {
  const int tid = opaque_tid();
  const int mt = tile >> 3, ntile = tile & 7;
  const u16* S = (const u16*)(p.ws + OFF_S);
  const u16* WT = (const u16*)(p.ws + OFF_WT);
  const int wid = tid >> 6, lane = tid & 63;
  const int wr = wid >> 1, wc = wid & 1, fr = lane & 15, fq = lane >> 4;
  const unsigned rl0 = wr * 64 + fq * 4, c0 = ntile * 128 + wc * 64 + fr;
  const u16* Sb = S + (size_t)mt * 256 * 4096;
  f32x4 acc[4][4];
  u16* MGb = (u16*)(p.ws + OFF_U) + (size_t)mt * 256 * 1024;
  ZERO_ACC(acc);
  gemm_mainloop(S + 2048, 4096, mt * 256, WT + (size_t)WT_BRR * 1024, 1024, ntile * 128, 1024, smem, acc, tid);
#pragma unroll
  for (int m = 0; m < 4; ++m)
#pragma unroll
    for (int j = 0; j < 4; ++j) {
      unsigned rl = rl0 + m * 16 + j;
#pragma unroll
      for (int n = 0; n < 4; ++n)
        MGb[rl * 1024u + c0 + n * 16] = f2bf(acc[m][n][j] * bf2f(Sb[rl * 4096u + c0 + n * 16]));
    }
  __builtin_amdgcn_sched_barrier(0);
  ZERO_ACC(acc);
  gemm_mainloop(S + 3072, 4096, mt * 256, WT + (size_t)WT_BRG * 1024, 1024, ntile * 128, 1024, smem, acc, tid);
#pragma unroll
  for (int m = 0; m < 4; ++m)
#pragma unroll
    for (int j = 0; j < 4; ++j) {
      unsigned rl = rl0 + m * 16 + j;
#pragma unroll
      for (int n = 0; n < 4; ++n) {
        float t = bf2f(MGb[rl * 1024u + c0 + n * 16]);
        float v = t + acc[m][n][j] * bf2f(Sb[rl * 4096u + 1024u + c0 + n * 16]);
        MGb[rl * 1024u + c0 + n * 16] = f2bf(v);
      }
    }
}

__device__ __forceinline__ void gemm_out(const Params& p, int l, int tile, char* smem) {
  const int tid = opaque_tid();
  const int mt = tile >> 3, ntile = tile & 7;
  const u16* MG = (const u16*)(p.ws + OFF_U);
  const u16* WT = (const u16*)(p.ws + OFF_WT) + (size_t)WT_OUT * 1024;
  const int wid = tid >> 6, lane = tid & 63;
  const int wr = wid >> 1, wc = wid & 1, fr = lane & 15, fq = lane >> 4;
  const unsigned rl0 = wr * 64 + fq * 4, c0 = ntile * 128 + wc * 64 + fr;
  f32x4 acc[4][4]; ZERO_ACC(acc);
  gemm_mainloop(MG, 1024, mt * 256, WT, 1024, ntile * 128, 1024, smem, acc, tid);
  const float* hin; float* hout; int r;
  if (mt < 128) { hin = (l == 0 ? p.x : p.out) + (size_t)mt * 256 * DM; hout = p.out + (size_t)mt * 256 * DM; r = mt >> 4; }
  else { hin = p.ctx + (size_t)(mt - 128) * 256 * DM; hout = (float*)(p.ws + OFF_HCTX) + (size_t)(mt - 128) * 256 * DM; r = 8; }
  const float* gate = (const float*)(p.ws + OFF_MOD) + (size_t)l * 9 * 3072 + r * 3072 + 2048;
  float gt4[4];
#pragma unroll
  for (int n = 0; n < 4; ++n) gt4[n] = gate[c0 + n * 16];
#pragma unroll
  for (int m = 0; m < 4; ++m)
#pragma unroll
    for (int j = 0; j < 4; ++j) {
      unsigned o = (rl0 + m * 16 + j) * 1024u + c0;
#pragma unroll
      for (int n = 0; n < 4; ++n) hout[o + n * 16] = hin[o + n * 16] + gt4[n] * acc[m][n][j];
    }
}

#define L_QR   0
#define L_KR   17408
#define L_KRT  34816
#define L_VT   53248
#define L_SGT  62464
#define L_GLRS L_SGT
#define L_VEC  79872

__device__ __forceinline__ int off128(int row, int col) { return row * 272 + col * 2; }
__device__ __forceinline__ int off64(int row, int col) { return row * 144 + col * 2; }

template <int branch, int HALF>
__device__ __forceinline__ void gate_pass(char* G, const float* GLRS, float* VEC, const float* wupp, float bup, float lg,
                                          const u16* Sq, int dir, int cd) {
  float wup[16];
#pragma unroll
  for (int r = 0; r < 16; ++r) wup[r] = (branch == 1) ? wupp[r * 512] : 0.f;
  float run = 0.f;
  bf16x8 kt8;
#pragma unroll
  for (int u = 0; u < 32; ++u) {
    const int t = HALF ? u : 31 - u;
    const int ip = HALF * 32 + t;
    float v;
    if (branch == 1) {
      const float4* gr = (const float4*)(GLRS + ip * 16);
      float4 g0 = gr[0], g1 = gr[1], g2 = gr[2], g3 = gr[3];
      float x = bup;
      x += g0.x * wup[0] + g0.y * wup[1] + g0.z * wup[2] + g0.w * wup[3];
      x += g1.x * wup[4] + g1.y * wup[5] + g1.z * wup[6] + g1.w * wup[7];
      x += g2.x * wup[8] + g2.y * wup[9] + g2.z * wup[10] + g2.w * wup[11];
      x += g3.x * wup[12] + g3.y * wup[13] + g3.z * wup[14] + g3.w * wup[15];
      v = (fminf(x, 0.f) - __logf(1.f + __expf(-fabsf(x)))) * (1.f / 16.f);
    } else v = lg;
    float rel;
    if (HALF) { run += v; rel = run; } else { rel = -run; run += v; }
    const int roff = (dir ? 63 - ip : ip) * 4096;
    float eq = __expf(rel), ek = __expf(-rel);
    float qv = bf2f(Sq[roff]) * eq;
    float kv = bf2f(Sq[roff + 512]) * ek;
    u16 kb = f2bf(kv);
    *(u16*)(G + L_QR + off128(ip, cd)) = f2bf(qv);
    *(u16*)(G + L_KR + off128(ip, cd)) = kb;
    kt8[t & 7] = (short)kb;
    if ((u & 7) == 7) { *(bf16x8*)(G + L_KRT + off64(cd, ip & ~7)) = kt8; __builtin_amdgcn_sched_barrier(0); }
  }
  if (HALF == 0) VEC[cd] = __expf(run);
  else VEC[128 + cd] = __expf(run);
}

template <int branch>
__device__ __forceinline__ void scan_item(const Params& p, int l, int item, char* smem) {
  const int b = (item >> 4) & 7, h = (item >> 2) & 3, slice = item & 3;
  const int tid = opaque_tid(), wid = __builtin_amdgcn_readfirstlane(tid >> 6), lane = tid & 63;
  const int dir = wid >> 2, gw = wid & 3, gt = tid & 255;
  const int fr = lane & 15, fq = lane >> 4;
  char* G = smem + dir * SCAN_GB;
  const u16* S = (const u16*)(p.ws + OFF_S);
  u16* RG = (u16*)(p.ws + OFF_RG);
  const float* GLR = (const float*)(p.ws + OFF_GLR);
  const int qoff = branch * 2048 + h * 128, koff = branch * 2048 + 512 + h * 128;
  const int voff = branch * 2048 + 1024 + h * 256 + slice * 64;
  const int ooff = branch * 1024 + h * 256 + slice * 64;
  const int cd = gt & 127, half = (wid >> 1) & 1;
  float lg = 0.f;
  const float* wupp = p.gla_w_up + ((size_t)(l * 2 + dir) * 16) * 512 + h * 128 + cd;
  const float bup = p.gla_b_up[(l * 2 + dir) * 512 + h * 128 + cd];
  if (branch == 0) lg = __logf(1.f - __expf(p.ret_decay[(l * 2 + dir) * 4 + h]));
  f32x4 st[2][4];
#pragma unroll
  for (int m = 0; m < 2; ++m)
#pragma unroll
    for (int n = 0; n < 4; ++n) st[m][n] = (f32x4){0.f, 0.f, 0.f, 0.f};
  float* VEC = (float*)(G + L_VEC);
  float* GLRS = (float*)(G + L_GLRS);

  for (int s = 0; s < 68; ++s) {
    int base; bool first; bool wout;
    if (s < 4) { int cc = dir ? 3 - s : s; base = MLAT + b * 256 + cc * 64; first = s < 2; wout = (l == 0); }
    else { int c = s - 4; int cc = dir ? 63 - c : c; base = b * 4096 + cc * 64; first = c < 32; wout = true; }
    if (branch == 1) {
      int ip = gt >> 2; int row = base + (dir ? 63 - ip : ip);
      float4 v = *(const float4*)(GLR + (size_t)row * 16 + (gt & 3) * 4);
      *(float4*)(GLRS + ip * 16 + (gt & 3) * 4) = v;
    }
    {
      int jp = gt >> 2; int row = base + (dir ? 63 - jp : jp);
      int e0 = (gt & 3) * 16;
      bf16x8 v0 = *(const bf16x8*)(S + (size_t)row * 4096 + voff + e0);
      bf16x8 v1 = *(const bf16x8*)(S + (size_t)row * 4096 + voff + e0 + 8);
#pragma unroll
      for (int x = 0; x < 8; ++x) {
        *(u16*)(G + L_VT + off64(e0 + x, jp)) = (u16)v0[x];
        *(u16*)(G + L_VT + off64(e0 + 8 + x, jp)) = (u16)v1[x];
      }
    }
    __syncthreads();
    {
      const u16* Sq = S + (size_t)base * 4096 + qoff + cd;
      if (half == 0) gate_pass<branch, 0>(G, GLRS, VEC, wupp, bup, lg, Sq, dir, cd);
      else           gate_pass<branch, 1>(G, GLRS, VEC, wupp, bup, lg, Sq, dir, cd);
    }
    __syncthreads();
#pragma unroll
    for (int m = 0; m < 2; ++m) {
      int d0 = gw * 32 + m * 16 + fq * 4;
      float4 eg = *(const float4*)(VEC + d0);
#pragma unroll
      for (int n = 0; n < 4; ++n) {
        int e = n * 16 + fr;
        bf16x4 o;
        o[0] = (short)f2bf(st[m][n][0] * eg.x); o[1] = (short)f2bf(st[m][n][1] * eg.y);
        o[2] = (short)f2bf(st[m][n][2] * eg.z); o[3] = (short)f2bf(st[m][n][3] * eg.w);
        *(bf16x4*)(G + L_SGT + off128(e, d0)) = o;
      }
    }
    __syncthreads();
    f32x4 pt[4], o[4];
#pragma unroll
    for (int n = 0; n < 4; ++n) { pt[n] = (f32x4){0.f, 0.f, 0.f, 0.f}; o[n] = (f32x4){0.f, 0.f, 0.f, 0.f}; }
#pragma unroll
    for (int ks = 0; ks < 4; ++ks) {
      int kc = ks * 32 + fq * 8;
      bf16x8 ka = *(const bf16x8*)(G + L_KR + off128(gw * 16 + fr, kc));
      bf16x8 qa = *(const bf16x8*)(G + L_QR + off128(gw * 16 + fr, kc));
#pragma unroll
      for (int n = 0; n < 4; ++n) {
        bf16x8 qb = *(const bf16x8*)(G + L_QR + off128(n * 16 + fr, kc));
        bf16x8 sb = *(const bf16x8*)(G + L_SGT + off128(n * 16 + fr, kc));
        pt[n] = __builtin_amdgcn_mfma_f32_16x16x32_bf16(ka, qb, pt[n], 0, 0, 0);
        o[n] = __builtin_amdgcn_mfma_f32_16x16x32_bf16(qa, sb, o[n], 0, 0, 0);
      }
    }
    __syncthreads();
#pragma unroll
    for (int n = 0; n < 4; ++n) {
      int ip = n * 16 + fr;
      int j0 = gw * 16 + fq * 4;
      bf16x4 w;
#pragma unroll
      for (int r = 0; r < 4; ++r) {
        int jp = j0 + r;
        bool keep = dir ? (ip > jp) : (ip >= jp);
        w[r] = (short)f2bf(keep ? pt[n][r] : 0.f);
      }
      *(bf16x4*)(G + L_SGT + off64(ip, j0)) = w;
    }
    __syncthreads();
    f32x4 kv[2][4];
#pragma unroll
    for (int m = 0; m < 2; ++m)
#pragma unroll
      for (int n = 0; n < 4; ++n) kv[m][n] = (f32x4){0.f, 0.f, 0.f, 0.f};
#pragma unroll
    for (int ks = 0; ks < 2; ++ks) {
      int kc = ks * 32 + fq * 8;
      bf16x8 pa = *(const bf16x8*)(G + L_SGT + off64(gw * 16 + fr, kc));
      bf16x8 k0 = *(const bf16x8*)(G + L_KRT + off64(gw * 32 + fr, kc));
      bf16x8 k1 = *(const bf16x8*)(G + L_KRT + off64(gw * 32 + 16 + fr, kc));
#pragma unroll
      for (int n = 0; n < 4; ++n) {
        bf16x8 vb = *(const bf16x8*)(G + L_VT + off64(n * 16 + fr, kc));
        o[n] = __builtin_amdgcn_mfma_f32_16x16x32_bf16(pa, vb, o[n], 0, 0, 0);
        kv[0][n] = __builtin_amdgcn_mfma_f32_16x16x32_bf16(k0, vb, kv[0][n], 0, 0, 0);
        kv[1][n] = __builtin_amdgcn_mfma_f32_16x16x32_bf16(k1, vb, kv[1][n], 0, 0, 0);
      }
    }
#pragma unroll
    for (int m = 0; m < 2; ++m) {
      int d0 = gw * 32 + m * 16 + fq * 4;
      float4 eg = *(const float4*)(VEC + d0);
      float4 el = *(const float4*)(VEC + 128 + d0);
#pragma unroll
      for (int n = 0; n < 4; ++n) {
        st[m][n][0] = eg.x * el.x * st[m][n][0] + el.x * kv[m][n][0];
        st[m][n][1] = eg.y * el.y * st[m][n][1] + el.y * kv[m][n][1];
        st[m][n][2] = eg.z * el.z * st[m][n][2] + el.z * kv[m][n][2];
        st[m][n][3] = eg.w * el.w * st[m][n][3] + el.w * kv[m][n][3];
      }
    }
    if (wout) {
#pragma unroll
      for (int r = 0; r < 4; ++r) {
        int ip = gw * 16 + fq * 4 + r;
        int row = base + (dir ? 63 - ip : ip);
        u16* dst = RG + (size_t)row * 2048 + ooff + fr;
#pragma unroll
        for (int n = 0; n < 4; ++n) {
          float v = o[n][r];
          if (!first) v += bf2f(dst[n * 16]);
          dst[n * 16] = f2bf(v);
        }
      }
    }
    __syncthreads();
  }
}

__device__ __forceinline__ void run_phase(const Params& p, int ph, char* smem) {
  const int nblk = gridDim.x, bid = blockIdx.x;
  if (ph == 0) {
    for (int u = bid; u < WT_UNITS + 96 + 1; u += nblk) {
      if (u < 96) mod_unit(p, u, smem);
      else if (u == 96) rot_unit(p);
      else wt_unit(p, 0, u - 97, smem);
    }
    return;
  }
  if (ph == 13) { phase_final(p); return; }
  const int l = (ph - 1) / 6, sp = (ph - 1) % 6;
  switch (sp) {
    case 0:
      phase_u(p, l);
      if (l == 1) for (int u = bid; u < WT_UNITS; u += nblk) wt_unit(p, 1, u, smem);
      break;
    case 1: for (int t = bid; t < 136 * 33; t += nblk) gemm_scan_in(p, t, smem); break;
    case 2: for (int t = bid; t < 256; t += nblk) { if (t < 128) scan_item<0>(p, l, t, smem); else scan_item<1>(p, l, t, smem); } break;
    case 3: { int MT = l == 0 ? 136 : 128; for (int t = bid; t < MT * 32; t += nblk) gemm_gate(p, l, t, smem); } break;
    case 4: { int MT = l == 0 ? 136 : 128; for (int t = bid; t < MT * 8; t += nblk) gemm_merge(p, t, smem); } break;
    case 5: { int MT = l == 0 ? 136 : 128; for (int t = bid; t < MT * 8; t += nblk) gemm_out(p, l, t, smem); } break;
  }
}

__global__ void __launch_bounds__(NTHREADS) mega(Params p, int ph_lo, int ph_hi, int coop) {
  extern __shared__ __attribute__((aligned(16))) char smem[];
  for (int ph = ph_lo; ph < ph_hi; ++ph) {
    run_phase(p, ph, smem);
    if (coop && ph + 1 < ph_hi) { cg::this_grid().sync(); }
  }
}

extern "C" void kernel_launch(void* const* d_in, const int* in_sizes, int n_in,
                              void* d_out, int out_size, void* d_ws, size_t ws_size,
                              hipStream_t stream) {
  Params p{};
  p.x = (const float*)d_in[0]; p.c = (const float*)d_in[1]; p.ctx = (const float*)d_in[2]; p.c_ctx = (const float*)d_in[3];
  p.norm_gain = (const float*)d_in[4]; p.w_ada = (const float*)d_in[5]; p.b_ada = (const float*)d_in[6]; p.w_in = (const float*)d_in[7];
  p.ret_decay = (const float*)d_in[8]; p.gla_w_up = (const float*)d_in[9]; p.gla_b_up = (const float*)d_in[10];
  p.ret_norm_gain = (const float*)d_in[11]; p.gla_norm_gain = (const float*)d_in[12];
  p.w_br_ret = (const float*)d_in[13]; p.w_br_gla = (const float*)d_in[14]; p.w_out = (const float*)d_in[15]; p.final_gain = (const float*)d_in[16];
  p.out = (float*)d_out; p.ws = (char*)d_ws;
  static int grid_blocks = 0;
  if (!grid_blocks) {
    hipFuncSetAttribute((const void*)mega, hipFuncAttributeMaxDynamicSharedMemorySize, LDS_BYTES);
    int dev = 0, cus = 0, per_cu = 0;
    hipGetDevice(&dev);
    hipDeviceGetAttribute(&cus, hipDeviceAttributeMultiprocessorCount, dev);
    hipOccupancyMaxActiveBlocksPerMultiprocessor(&per_cu, mega, NTHREADS, LDS_BYTES);
    if (per_cu < 1) per_cu = 1;
    grid_blocks = cus * 1;
  }
#ifdef MULTI_LAUNCH
  for (int ph = 0; ph < 14; ++ph) {
    mega<<<dim3(grid_blocks), dim3(NTHREADS), LDS_BYTES, stream>>>(p, ph, ph + 1, 0);
  }
#else
  int lo = 0, hi = 14, coop = 1;
  void* args[] = {&p, &lo, &hi, &coop};
  hipError_t e = hipLaunchCooperativeKernel((void*)mega, dim3(grid_blocks), dim3(NTHREADS), args, LDS_BYTES, stream);
  if (e != hipSuccess) fprintf(stderr, "cooperative launch failed: %s (grid %d)\n", hipGetErrorString(e), grid_blocks);
#endif
}
```

```cpp
#include <hip/hip_runtime.h>
#include <hip/hip_cooperative_groups.h>
#include <cstdio>
namespace cg = cooperative_groups;

typedef unsigned short u16;
using bf16x8 = __attribute__((ext_vector_type(8))) short;
using bf16x4 = __attribute__((ext_vector_type(4))) short;
using f32x4  = __attribute__((ext_vector_type(4))) float;

#define NTHREADS 512
#define DM 1024
#define NB 8
#define SEQL 4096
#define CTXL 256
#define MLAT 32768
#define MCTX 2048
#define MTOT 34816
#define INW 8208

#define OFF_S    0ull
#define OFF_RG   (OFF_S   + (size_t)MTOT * 4096 * 2)
#define OFF_U    (OFF_RG  + (size_t)MTOT * 2048 * 2)
#define OFF_WT   (OFF_U   + (size_t)MTOT * 1024 * 2)
#define WT_ROWS  11392
#define OFF_GLR  (OFF_WT  + (size_t)WT_ROWS * 1024 * 2)
#define OFF_HCTX (OFF_GLR + (size_t)MTOT * 16 * 4)
#define OFF_MOD  (OFF_HCTX+ (size_t)MCTX * 1024 * 4)
#define OFF_ROT  (OFF_MOD + (size_t)2 * 9 * 3072 * 4)
#define OFF_END  (OFF_ROT + (size_t)64 * 32 * 2 * 4)

#define WT_SCAN 0
#define WT_GATE 4224
#define WT_BRR  8320
#define WT_BRG  9344
#define WT_OUT  10368

#define LDS_BYTES 161792
#define SCAN_GB   80896

struct Params {
  const float* x; const float* c; const float* ctx; const float* c_ctx;
  const float* norm_gain; const float* w_ada; const float* b_ada; const float* w_in;
  const float* ret_decay; const float* gla_w_up; const float* gla_b_up;
  const float* ret_norm_gain; const float* gla_norm_gain;
  const float* w_br_ret; const float* w_br_gla; const float* w_out; const float* final_gain;
  float* out; char* ws;
};

__device__ __forceinline__ u16 f2bf(float f) {
  unsigned u = __float_as_uint(f);
  u += 0x7fffu + ((u >> 16) & 1u);
  return (u16)(u >> 16);
}
__device__ __forceinline__ float bf2f(u16 h) { return __uint_as_float(((unsigned)h) << 16); }
__device__ __forceinline__ float sigmoidf_(float x) { return 1.f / (1.f + __expf(-x)); }
__device__ __forceinline__ float siluf_(float x) { return x / (1.f + __expf(-x)); }

__device__ __forceinline__ int opaque_tid() { int t = threadIdx.x; asm volatile("" : "+v"(t)); return t; }

__device__ __forceinline__ float wave_sum(float v) {
#pragma unroll
  for (int o = 32; o > 0; o >>= 1) v += __shfl_xor(v, o, 64);
  return v;
}

__device__ __forceinline__ const float* wt_src(const Params& p, int l, int n, int& ld) {
  if (n < WT_GATE) {
    int tile = n >> 7, cc = n & 127;
    int col;
    if (tile < 8) {
      int d = (cc & 64) | ((cc & 16) << 1) | ((cc & 32) >> 1) | (cc & 15);
      col = tile * 128 + d;
    } else if (tile < 16) col = 1024 + (tile - 8) * 128 + cc;
    else if (tile < 24) col = 3072 + (tile - 16) * 128 + cc;
    else if (tile < 32) col = 4096 + (tile - 24) * 128 + cc;
    else { if (cc >= 16) { ld = 0; return nullptr; } col = 6144 + cc; }
    ld = INW; return p.w_in + (size_t)l * DM * INW + col;
  } else if (n < WT_BRR) {
    int g = n - WT_GATE; int col;
    if (g < 1024) col = 2048 + g;
    else if (g < 2048) col = 5120 + (g - 1024);
    else if (g < 3072) col = 6160 + (g - 2048);
    else col = 7184 + (g - 3072);
    ld = INW; return p.w_in + (size_t)l * DM * INW + col;
  } else if (n < WT_BRG) { ld = DM; return p.w_br_ret + (size_t)l * DM * DM + (n - WT_BRR); }
  else if (n < WT_OUT)   { ld = DM; return p.w_br_gla + (size_t)l * DM * DM + (n - WT_BRG); }
  else                   { ld = DM; return p.w_out    + (size_t)l * DM * DM + (n - WT_OUT); }
}

#define WT_UNITS (178 * 16)
__device__ __forceinline__ void wt_unit(const Params& p, int l, int unit, char* smem) {
  float* tile = (float*)smem;
  int nb = unit >> 4, kb = unit & 15;
  int tid = opaque_tid();
  int n0 = nb * 64, k0 = kb * 64;
  {
    int nl = tid & 63, kq = tid >> 6;
    int ld; const float* src = wt_src(p, l, n0 + nl, ld);
#pragma unroll
    for (int i = 0; i < 8; ++i) {
      int kl = kq + 8 * i;
      float v = src ? src[(size_t)(k0 + kl) * ld] : 0.f;
      tile[kl * 65 + nl] = v;
    }
  }
  __syncthreads();
  {
    int nl = tid >> 3, kq = tid & 7;
    bf16x8 o;
#pragma unroll
    for (int j = 0; j < 8; ++j) o[j] = (short)f2bf(tile[(kq * 8 + j) * 65 + nl]);
    u16* wt = (u16*)(p.ws + OFF_WT);
    *(bf16x8*)(wt + (size_t)(n0 + nl) * 1024 + k0 + kq * 8) = o;
  }
  __syncthreads();
}

__device__ __forceinline__ void mod_unit(const Params& p, int unit, char* smem) {
  float* sc = (float*)smem;
  float* red = sc + 9 * 1024;
  int l = unit / 48, jb = unit % 48;
  int tid = opaque_tid();
  for (int i = tid; i < 9 * 1024; i += NTHREADS) {
    int r = i >> 10, k = i & 1023;
    float v = (r < 8) ? p.c[r * 1024 + k] : p.c_ctx[k];
    sc[i] = siluf_(v);
  }
  __syncthreads();
  int jl = tid & 63, kg = tid >> 6;
  int j = jb * 64 + jl;
  float acc[9];
#pragma unroll
  for (int r = 0; r < 9; ++r) acc[r] = 0.f;
  const float* w = p.w_ada + (size_t)l * DM * 3072 + j;
  for (int k = kg * 128; k < kg * 128 + 128; ++k) {
    float wv = w[(size_t)k * 3072];
#pragma unroll
    for (int r = 0; r < 9; ++r) acc[r] += sc[r * 1024 + k] * wv;
  }
#pragma unroll
  for (int r = 0; r < 9; ++r) red[(kg * 9 + r) * 64 + jl] = acc[r];
  __syncthreads();
  float* mod = (float*)(p.ws + OFF_MOD);
  for (int i = tid; i < 9 * 64; i += NTHREADS) {
    int r = i >> 6, jj = i & 63;
    float s = 0.f;
#pragma unroll
    for (int g = 0; g < 8; ++g) s += red[(g * 9 + r) * 64 + jj];
    mod[((size_t)l * 9 + r) * 3072 + jb * 64 + jj] = s + p.b_ada[l * 3072 + jb * 64 + jj];
  }
  __syncthreads();
}

__device__ __forceinline__ void rot_unit(const Params& p) {
  float* rot = (float*)(p.ws + OFF_ROT);
  for (int i = opaque_tid(); i < 64 * 32; i += NTHREADS) {
    int pos = i >> 5, f = i & 31;
    float inv = exp2f(-(float)f * (13.287712379549449f / 32.f));
    float ang = (float)pos * inv;
    rot[i * 2] = __cosf(ang);
    rot[i * 2 + 1] = __sinf(ang);
  }
}

__device__ __forceinline__ void phase_u(const Params& p, int l) {
  const int tid = opaque_tid(); int wave = tid >> 6, lane = tid & 63;
  const float* mod = (const float*)(p.ws + OFF_MOD) + (size_t)l * 9 * 3072;
  const float* gain = p.norm_gain + l * DM;
  u16* U = (u16*)(p.ws + OFF_U);
  for (int row = blockIdx.x * 8 + wave; row < MTOT; row += gridDim.x * 8) {
    const float* h; int r;
    if (row < MLAT) { h = (l == 0 ? p.x : p.out) + (size_t)row * DM; r = row >> 12; }
    else { int cr = row - MLAT; h = (l == 0 ? p.ctx : (const float*)(p.ws + OFF_HCTX)) + (size_t)cr * DM; r = 8; }
    float4 v[4]; float ss = 0.f;
#pragma unroll
    for (int i = 0; i < 4; ++i) {
      v[i] = *(const float4*)(h + i * 256 + lane * 4);
      ss += v[i].x * v[i].x + v[i].y * v[i].y + v[i].z * v[i].z + v[i].w * v[i].w;
    }
    ss = wave_sum(ss);
    float rstd = rsqrtf(ss * (1.f / 1024.f) + 1e-6f);
    const float* sh = mod + r * 3072;
#pragma unroll
    for (int i = 0; i < 4; ++i) {
      int cidx = i * 256 + lane * 4;
      float4 g = *(const float4*)(gain + cidx);
      float4 s = *(const float4*)(sh + cidx);
      float4 sc = *(const float4*)(sh + 1024 + cidx);
      bf16x4 o;
      o[0] = (short)f2bf(v[i].x * rstd * g.x * (1.f + sc.x) + s.x);
      o[1] = (short)f2bf(v[i].y * rstd * g.y * (1.f + sc.y) + s.y);
      o[2] = (short)f2bf(v[i].z * rstd * g.z * (1.f + sc.z) + s.z);
      o[3] = (short)f2bf(v[i].w * rstd * g.w * (1.f + sc.w) + s.w);
      *(bf16x4*)(U + (size_t)row * DM + cidx) = o;
    }
  }
}

__device__ __forceinline__ void phase_final(const Params& p) {
  const int tid = opaque_tid(); int wave = tid >> 6, lane = tid & 63;
  for (int row = blockIdx.x * 8 + wave; row < MLAT; row += gridDim.x * 8) {
    float* h = p.out + (size_t)row * DM;
    float4 v[4]; float ss = 0.f;
#pragma unroll
    for (int i = 0; i < 4; ++i) {
      v[i] = *(const float4*)(h + i * 256 + lane * 4);
      ss += v[i].x * v[i].x + v[i].y * v[i].y + v[i].z * v[i].z + v[i].w * v[i].w;
    }
    ss = wave_sum(ss);
    float rstd = rsqrtf(ss * (1.f / 1024.f) + 1e-6f);
#pragma unroll
    for (int i = 0; i < 4; ++i) {
      int cidx = i * 256 + lane * 4;
      float4 g = *(const float4*)(p.final_gain + cidx);
      float4 o;
      o.x = v[i].x * rstd * g.x; o.y = v[i].y * rstd * g.y; o.z = v[i].z * rstd * g.z; o.w = v[i].w * rstd * g.w;
      *(float4*)(h + cidx) = o;
    }
  }
}

__device__ __forceinline__ int lds_byte(int r, int c) {
  int st = (r >> 4) * 2 + (c >> 5), rr = r & 15, cc = c & 31, ob = rr * 64 + cc * 2;
  return st * 1024 + (ob ^ (((ob >> 9) & 1) << 5));
}

__device__ __forceinline__ void stage_half(int tid, const u16* __restrict__ g, size_t ld, int row0, int k0, char* lds_half) {
#pragma unroll
  for (int i = 0; i < 2; ++i) {
    int b = tid * 16 + i * 8192;
    int st = b >> 10, sb = b & 1023, swz = sb ^ (((sb >> 9) & 1) << 5);
    int R = (st >> 1) * 16 + (swz >> 6), C = (st & 1) * 32 + ((swz & 63) >> 1);
    __builtin_amdgcn_global_load_lds((const unsigned*)(g + (size_t)(row0 + R) * ld + k0 + C),
                                     (__attribute__((address_space(3))) unsigned*)(lds_half + b), 16, 0, 0);
  }
}

__device__ __forceinline__ void gemm_mainloop(const u16* __restrict__ A, size_t lda, int row0,
                                              const u16* __restrict__ Bt, size_t ldb, int col0,
                                              int K, char* smem, f32x4 (&acc)[4][4], int tid) {
  const int wid = tid >> 6, lane = tid & 63;
  const int wr = wid >> 1, wc = wid & 1, fr = lane & 15, fq = lane >> 4;
  const int nt = K / 64;
  __syncthreads();
  stage_half(tid, A, lda, row0, 0, smem);
  stage_half(tid, A, lda, row0 + 128, 0, smem + 16384);
  stage_half(tid, Bt, ldb, col0, 0, smem + 32768);
  asm volatile("s_waitcnt vmcnt(0)" ::: "memory");
  __syncthreads();
  for (int t = 0; t < nt; ++t) {
    char* cur = smem + (t & 1) * 49152;
    if (t + 1 < nt) {
      char* nxt = smem + ((t + 1) & 1) * 49152;
      int k0 = (t + 1) * 64;
      stage_half(tid, A, lda, row0, k0, nxt);
      stage_half(tid, A, lda, row0 + 128, k0, nxt + 16384);
      stage_half(tid, Bt, ldb, col0, k0, nxt + 32768);
    }
    const char* sa = cur + (wr >> 1) * 16384;
    const char* sb = cur + 32768;
#pragma unroll
    for (int ks = 0; ks < 2; ++ks) {
      bf16x8 af[4], bfr[4];
#pragma unroll
      for (int m = 0; m < 4; ++m) af[m] = *(const bf16x8*)(sa + lds_byte((wr & 1) * 64 + m * 16 + fr, ks * 32 + fq * 8));
#pragma unroll
      for (int n = 0; n < 4; ++n) bfr[n] = *(const bf16x8*)(sb + lds_byte(wc * 64 + n * 16 + fr, ks * 32 + fq * 8));
#pragma unroll
      for (int m = 0; m < 4; ++m)
#pragma unroll
        for (int n = 0; n < 4; ++n)
          acc[m][n] = __builtin_amdgcn_mfma_f32_16x16x32_bf16(af[m], bfr[n], acc[m][n], 0, 0, 0);
    }
    asm volatile("s_waitcnt vmcnt(0)" ::: "memory");
    __syncthreads();
  }
  __builtin_amdgcn_sched_barrier(0);
}

#define ZERO_ACC(a) _Pragma("unroll") for (int _m = 0; _m < 4; ++_m) _Pragma("unroll") for (int _n = 0; _n < 4; ++_n) a[_m][_n] = (f32x4){0.f, 0.f, 0.f, 0.f}

__device__ __forceinline__ void gemm_scan_in(const Params& p, int tile, char* smem) {
  const int tid = opaque_tid();
  const int mt = tile / 33, ntile = tile % 33;
  const u16* U = (const u16*)(p.ws + OFF_U);
  const u16* WT = (const u16*)(p.ws + OFF_WT) + (size_t)WT_SCAN * 1024;
  f32x4 acc[4][4]; ZERO_ACC(acc);
  gemm_mainloop(U, 1024, mt * 256, WT, 1024, ntile * 128, 1024, smem, acc, tid);
  const int wid = tid >> 6, lane = tid & 63;
  const int wr = wid >> 1, wc = wid & 1, fr = lane & 15, fq = lane >> 4;
  const unsigned rl0 = wr * 64 + fq * 4;
  if (ntile == 32) {
    float* GLRb = (float*)(p.ws + OFF_GLR) + (size_t)mt * 256 * 16;
    if (wc == 0) {
#pragma unroll
      for (int m = 0; m < 4; ++m)
#pragma unroll
        for (int j = 0; j < 4; ++j) GLRb[(rl0 + m * 16 + j) * 16u + fr] = acc[m][0][j];
    }
    return;
  }
  u16* Sb = (u16*)(p.ws + OFF_S) + (size_t)mt * 256 * 4096 + ntile * 128;
  const bool is_qk = ntile < 8;
  const bool scaled = (ntile < 4) || (ntile >= 16 && ntile < 20);
  const float scl = scaled ? 0.08838834764831845f : 1.f;
  const unsigned c0 = wc * 64 + fr;
  if (is_qk && mt < 128) {
    const float* rot = (const float*)(p.ws + OFF_ROT);
    const int tbase = (mt & 15) * 256;
#pragma unroll
    for (int m = 0; m < 4; ++m)
#pragma unroll
      for (int j = 0; j < 4; ++j) {
        unsigned rl = rl0 + m * 16 + j;
        int t = tbase + rl;
        unsigned pos = (wc == 0) ? (t >> 6) : (t & 63);
#pragma unroll
        for (int g = 0; g < 2; ++g) {
          float2 cs = *(const float2*)(rot + (pos * 32u + g * 16 + fr) * 2u);
          float x0 = acc[m][2 * g][j] * scl, x1 = acc[m][2 * g + 1][j] * scl;
          float o0 = x0 * cs.x - x1 * cs.y, o1 = x1 * cs.x + x0 * cs.y;
          unsigned o = rl * 4096u + c0;
          Sb[o + (2 * g) * 16] = f2bf(o0);
          Sb[o + (2 * g + 1) * 16] = f2bf(o1);
        }
      }
  } else {
#pragma unroll
    for (int m = 0; m < 4; ++m)
#pragma unroll
      for (int j = 0; j < 4; ++j) {
        unsigned o = (rl0 + m * 16 + j) * 4096u + c0;
#pragma unroll
        for (int n = 0; n < 4; ++n) Sb[o + n * 16] = f2bf(acc[m][n][j] * scl);
      }
  }
}

__device__ __forceinline__ void gemm_gate(const Params& p, int l, int tile, char* smem) {
  const int tid = opaque_tid();
  const int mt = tile >> 5, ntile = tile & 31;
  const u16* U = (const u16*)(p.ws + OFF_U);
  const u16* WT = (const u16*)(p.ws + OFF_WT) + (size_t)WT_GATE * 1024;
  const int wid = tid >> 6, lane = tid & 63;
  const int wr = wid >> 1, wc = wid & 1, fr = lane & 15, fq = lane >> 4;
  float* stat = (float*)(smem + 98304);
  const bool is_norm = ntile < 16;
  const int branch = ntile >> 3;
  const u16* RGb = (const u16*)(p.ws + OFF_RG) + (size_t)mt * 256 * 2048 + (branch & 1) * 1024;
  if (is_norm) {
    __syncthreads();
    int head = (ntile & 7) >> 1;
    for (int rr = 0; rr < 32; ++rr) {
      unsigned rl = wid * 32 + rr;
      bf16x4 v = *(const bf16x4*)(RGb + rl * 2048u + head * 256 + lane * 4);
      float a0 = bf2f((u16)v[0]), a1 = bf2f((u16)v[1]), a2 = bf2f((u16)v[2]), a3 = bf2f((u16)v[3]);
      float s1 = a0 + a1 + a2 + a3, s2 = a0 * a0 + a1 * a1 + a2 * a2 + a3 * a3;
      s1 = wave_sum(s1); s2 = wave_sum(s2);
      float sa, sb;
      if (branch == 0) {
        float mu = s1 * (1.f / 256.f);
        float var = fmaxf(s2 * (1.f / 256.f) - mu * mu, 0.f);
        sa = rsqrtf(var + 1e-6f); sb = -mu * sa;
      } else { sa = rsqrtf(s2 * (1.f / 256.f) + 1e-6f); sb = 0.f; }
      if (lane == 0) { stat[rl * 2] = sa; stat[rl * 2 + 1] = sb; }
    }
  }
  f32x4 acc[4][4]; ZERO_ACC(acc);
  gemm_mainloop(U, 1024, mt * 256, WT, 1024, ntile * 128, 1024, smem, acc, tid);
  u16* Sb = (u16*)(p.ws + OFF_S) + (size_t)mt * 256 * 4096;
  const unsigned rl0 = wr * 64 + fq * 4;
  if (is_norm) {
    const float* gain = (branch == 0 ? p.ret_norm_gain : p.gla_norm_gain) + l * 1024;
    const unsigned cin = (ntile & 7) * 128 + wc * 64 + fr;
    float gn[4];
#pragma unroll
    for (int n = 0; n < 4; ++n) gn[n] = gain[cin + n * 16];
#pragma unroll
    for (int m = 0; m < 4; ++m)
#pragma unroll
      for (int j = 0; j < 4; ++j) {
        unsigned rl = rl0 + m * 16 + j;
        float sa = stat[rl * 2], sb = stat[rl * 2 + 1];
#pragma unroll
        for (int n = 0; n < 4; ++n) {
          float x = bf2f(RGb[rl * 2048u + cin + n * 16]);
          float y = (x * sa + sb) * gn[n] * siluf_(acc[m][n][j]);
          Sb[rl * 4096u + 2048u + branch * 1024 + cin + n * 16] = f2bf(y);
        }
      }
  } else {
    const unsigned cout = (ntile - 16) * 128 + wc * 64 + fr;
#pragma unroll
    for (int m = 0; m < 4; ++m)
#pragma unroll
      for (int j = 0; j < 4; ++j) {
        unsigned o = (rl0 + m * 16 + j) * 4096u + cout;
#pragma unroll
        for (int n = 0; n < 4; ++n) Sb[o + n * 16] = f2bf(sigmoidf_(acc[m][n][j]));
      }
  }
}

__device__ __forceinline__ void gemm_merge(const Params& p, int tile, char* smem) {
  const int tid = opaque_tid();
  const int mt = tile >> 3, ntile = tile & 7;
  const u16* S = (const u16*)(p.ws + OFF_S);
  const u16* WT = (const u16*)(p.ws + OFF_WT);
  const int wid = tid >> 6, lane = tid & 63;
  const int wr = wid >> 1, wc = wid & 1, fr = lane & 15, fq = lane >> 4;
  const unsigned rl0 = wr * 64 + fq * 4, c0 = ntile * 128 + wc * 64 + fr;
  const u16* Sb = S + (size_t)mt * 256 * 4096;
  f32x4 acc[4][4];
  u16* MGb = (u16*)(p.ws + OFF_U) + (size_t)mt * 256 * 1024;
  ZERO_ACC(acc);
  gemm_mainloop(S + 2048, 4096, mt * 256, WT + (size_t)WT_BRR * 1024, 1024, ntile * 128, 1024, smem, acc, tid);
#pragma unroll
  for (int m = 0; m < 4; ++m)
#pragma unroll
    for (int j = 0; j < 4; ++j) {
      unsigned rl = rl0 + m * 16 + j;
#pragma unroll
      for (int n = 0; n < 4; ++n)
        MGb[rl * 1024u + c0 + n * 16] = f2bf(acc[m][n][j] * bf2f(Sb[rl * 4096u + c0 + n * 16]));
    }
  __builtin_amdgcn_sched_barrier(0);
  ZERO_ACC(acc);
  gemm_mainloop(S + 3072, 4096, mt * 256, WT + (size_t)WT_BRG * 1024, 1024, ntile * 128, 1024, smem, acc, tid);
#pragma unroll
  for (int m = 0; m < 4; ++m)
#pragma unroll
    for (int j = 0; j < 4; ++j) {
      unsigned rl = rl0 + m * 16 + j;
#pragma unroll
      for (int n = 0; n < 4; ++n) {
        float t = bf2f(MGb[rl * 1024u + c0 + n * 16]);
        float v = t + acc[m][n][j] * bf2f(Sb[rl * 4096u + 1024u + c0 + n * 16]);
        MGb[rl * 1024u + c0 + n * 16] = f2bf(v);
      }
    }
}

__device__ __forceinline__ void gemm_out(const Params& p, int l, int tile, char* smem) {
  const int tid = opaque_tid();
  const int mt = tile >> 3, ntile = tile & 7;
  const u16* MG = (const u16*)(p.ws + OFF_U);
  const u16* WT = (const u16*)(p.ws + OFF_WT) + (size_t)WT_OUT * 1024;
  const int wid = tid >> 6, lane = tid & 63;
  const int wr = wid >> 1, wc = wid & 1, fr = lane & 15, fq = lane >> 4;
  const unsigned rl0 = wr * 64 + fq * 4, c0 = ntile * 128 + wc * 64 + fr;
  f32x4 acc[4][4]; ZERO_ACC(acc);
  gemm_mainloop(MG, 1024, mt * 256, WT, 1024, ntile * 128, 1024, smem, acc, tid);
  const float* hin; float* hout; int r;
  if (mt < 128) { hin = (l == 0 ? p.x : p.out) + (size_t)mt * 256 * DM; hout = p.out + (size_t)mt * 256 * DM; r = mt >> 4; }
  else { hin = p.ctx + (size_t)(mt - 128) * 256 * DM; hout = (float*)(p.ws + OFF_HCTX) + (size_t)(mt - 128) * 256 * DM; r = 8; }
  const float* gate = (const float*)(p.ws + OFF_MOD) + (size_t)l * 9 * 3072 + r * 3072 + 2048;
  float gt4[4];
#pragma unroll
  for (int n = 0; n < 4; ++n) gt4[n] = gate[c0 + n * 16];
#pragma unroll
  for (int m = 0; m < 4; ++m)
#pragma unroll
    for (int j = 0; j < 4; ++j) {
      unsigned o = (rl0 + m * 16 + j) * 1024u + c0;
#pragma unroll
      for (int n = 0; n < 4; ++n) hout[o + n * 16] = hin[o + n * 16] + gt4[n] * acc[m][n][j];
    }
}

#define OFF_VECS OFF_WT
__device__ __forceinline__ float logsig16(float x) { return (fminf(x, 0.f) - __logf(1.f + __expf(-fabsf(x)))) * (1.f / 16.f); }

__device__ __forceinline__ void gla_prepass_unit(const Params& p, int l, int unit, char* smem) {
  const int tid = opaque_tid();
  const int b = unit / 68, cid = unit % 68;
  const int base = cid < 4 ? (MLAT + b * 256 + cid * 64) : (b * 4096 + (cid - 4) * 64);
  float* GLRS = (float*)smem;
  __syncthreads();
  if (tid < 256) {
    const float* GLR = (const float*)(p.ws + OFF_GLR) + (size_t)base * 16;
    *(float4*)(GLRS + tid * 4) = *(const float4*)(GLR + tid * 4);
  }
  float wf[16], wb[16];
  {
    const float* w0 = p.gla_w_up + (size_t)(l * 2 + 0) * 16 * 512 + tid;
    const float* w1 = p.gla_w_up + (size_t)(l * 2 + 1) * 16 * 512 + tid;
#pragma unroll
    for (int r = 0; r < 16; ++r) { wf[r] = w0[r * 512]; wb[r] = w1[r * 512]; }
  }
  const float bf_ = p.gla_b_up[(l * 2 + 0) * 512 + tid], bb_ = p.gla_b_up[(l * 2 + 1) * 512 + tid];
  __syncthreads();
  u16* Sq = (u16*)(p.ws + OFF_S) + (size_t)base * 4096 + 2048 + tid;
  u16* Ub = (u16*)(p.ws + OFF_U) + (size_t)base * 1024 + tid;
  float accF = 0.f, accB = 0.f;
#pragma unroll 8
  for (int u = 0; u < 32; ++u) {
    const int i = 31 - u;
    const float4* gr = (const float4*)(GLRS + i * 16);
    float4 g0 = gr[0], g1 = gr[1], g2 = gr[2], g3 = gr[3];
    float xf = bf_, xb = bb_;
    xf += g0.x * wf[0] + g0.y * wf[1] + g0.z * wf[2] + g0.w * wf[3] + g1.x * wf[4] + g1.y * wf[5] + g1.z * wf[6] + g1.w * wf[7]
        + g2.x * wf[8] + g2.y * wf[9] + g2.z * wf[10] + g2.w * wf[11] + g3.x * wf[12] + g3.y * wf[13] + g3.z * wf[14] + g3.w * wf[15];
    xb += g0.x * wb[0] + g0.y * wb[1] + g0.z * wb[2] + g0.w * wb[3] + g1.x * wb[4] + g1.y * wb[5] + g1.z * wb[6] + g1.w * wb[7]
        + g2.x * wb[8] + g2.y * wb[9] + g2.z * wb[10] + g2.w * wb[11] + g3.x * wb[12] + g3.y * wb[13] + g3.z * wb[14] + g3.w * wb[15];
    const float laf = logsig16(xf), lab = logsig16(xb);
    const float relf = -accF; accF += laf;
    accB += lab; const float relb = accB;
    const float q = bf2f(Sq[(unsigned)i * 4096u]), k = bf2f(Sq[(unsigned)i * 4096u + 512u]);
    Sq[(unsigned)i * 4096u] = f2bf(q * __expf(relf));
    Sq[(unsigned)i * 4096u + 512u] = f2bf(k * __expf(-relf));
    Ub[(unsigned)i * 1024u] = f2bf(q * __expf(relb));
    Ub[(unsigned)i * 1024u + 512u] = f2bf(k * __expf(-relb));
  }
  float accF2 = 0.f, accB2 = 0.f;
#pragma unroll 8
  for (int u = 0; u < 32; ++u) {
    const int i = 32 + u;
    const float4* gr = (const float4*)(GLRS + i * 16);
    float4 g0 = gr[0], g1 = gr[1], g2 = gr[2], g3 = gr[3];
    float xf = bf_, xb = bb_;
    xf += g0.x * wf[0] + g0.y * wf[1] + g0.z * wf[2] + g0.w * wf[3] + g1.x * wf[4] + g1.y * wf[5] + g1.z * wf[6] + g1.w * wf[7]
        + g2.x * wf[8] + g2.y * wf[9] + g2.z * wf[10] + g2.w * wf[11] + g3.x * wf[12] + g3.y * wf[13] + g3.z * wf[14] + g3.w * wf[15];
    xb += g0.x * wb[0] + g0.y * wb[1] + g0.z * wb[2] + g0.w * wb[3] + g1.x * wb[4] + g1.y * wb[5] + g1.z * wb[6] + g1.w * wb[7]
        + g2.x * wb[8] + g2.y * wb[9] + g2.z * wb[10] + g2.w * wb[11] + g3.x * wb[12] + g3.y * wb[13] + g3.z * wb[14] + g3.w * wb[15];
    const float laf = logsig16(xf), lab = logsig16(xb);
    accF2 += laf; const float relf = accF2;
    const float relb = -accB2; accB2 += lab;
    const float q = bf2f(Sq[(unsigned)i * 4096u]), k = bf2f(Sq[(unsigned)i * 4096u + 512u]);
    Sq[(unsigned)i * 4096u] = f2bf(q * __expf(relf));
    Sq[(unsigned)i * 4096u + 512u] = f2bf(k * __expf(-relf));
    Ub[(unsigned)i * 1024u] = f2bf(q * __expf(relb));
    Ub[(unsigned)i * 1024u + 512u] = f2bf(k * __expf(-relb));
  }
  float* V0 = (float*)(p.ws + OFF_VECS) + ((size_t)(0 * 544 + b * 68 + cid) * 2) * 512 + tid;
  float* V1 = (float*)(p.ws + OFF_VECS) + ((size_t)(1 * 544 + b * 68 + cid) * 2) * 512 + tid;
  V0[0] = __expf(accF);  V0[512] = __expf(accF2);
  V1[0] = __expf(accB2); V1[512] = __expf(accB);
}

#define L_QR   0
#define L_KR   17408
#define L_V    34816
#define L_SGT  44032
#undef  SCAN_GB
#define SCAN_GB 61440

__device__ __forceinline__ int off128(int row, int col) { return row * 272 + col * 2; }
__device__ __forceinline__ int off64(int row, int col) { return row * 144 + col * 2; }

template <int RS>
__device__ __forceinline__ bf16x8 tr_frag(unsigned img_addr, int r0, int c0, int lane) {
  const int g = lane >> 4, q = (lane & 15) >> 2, pp = lane & 3;
  unsigned a = img_addr + (unsigned)((r0 + 8 * g + q) * RS + (c0 + 4 * pp) * 2);
  bf16x4 lo, hi;
  asm volatile("ds_read_b64_tr_b16 %0, %2\n\tds_read_b64_tr_b16 %1, %2 offset:%3\n\ts_waitcnt lgkmcnt(0)"
               : "=&v"(lo), "=&v"(hi) : "v"(a), "n"(4 * RS) : "memory");
  bf16x8 r;
  r[0] = lo[0]; r[1] = lo[1]; r[2] = lo[2]; r[3] = lo[3]; r[4] = hi[0]; r[5] = hi[1]; r[6] = hi[2]; r[7] = hi[3];
  return r;
}

__device__ __forceinline__ bf16x8 scale8(bf16x8 v, float f) {
  bf16x8 o;
#pragma unroll
  for (int x = 0; x < 8; ++x) o[x] = (short)f2bf(bf2f((u16)v[x]) * f);
  return o;
}

template <int branch>
__device__ __forceinline__ void scan_item(const Params& p, int l, int item, char* smem) {
  const int b = (item >> 4) & 7, h = (item >> 2) & 3, slice = item & 3;
  const int tid = opaque_tid(), wid = __builtin_amdgcn_readfirstlane(tid >> 6), lane = tid & 63;
  const int dir = wid >> 2, gw = wid & 3, gt = tid & 255;
  const int fr = lane & 15, fq = lane >> 4;
  char* G = smem + dir * SCAN_GB;
  const unsigned Ga = (unsigned)(size_t)G;
  const u16* S = (const u16*)(p.ws + OFF_S);
  u16* RG = (u16*)(p.ws + OFF_RG);
  const u16* qsrc; unsigned qstride;
  if (branch == 0) { qsrc = S + h * 128; qstride = 4096; }
  else if (dir == 0) { qsrc = S + 2048 + h * 128; qstride = 4096; }
  else { qsrc = (const u16*)(p.ws + OFF_U) + h * 128; qstride = 1024; }
  const int voff = branch * 2048 + 1024 + h * 256 + slice * 64;
  const int ooff = branch * 1024 + h * 256 + slice * 64;
  float lg = 0.f, egc = 1.f;
  if (branch == 0) { lg = __logf(1.f - __expf(p.ret_decay[(l * 2 + dir) * 4 + h])); egc = __expf(32.f * lg); }
  const float* VECS = (const float*)(p.ws + OFF_VECS) + ((size_t)(dir * 544 + b * 68) * 2) * 512 + h * 128;
  f32x4 st[2][4];
#pragma unroll
  for (int m = 0; m < 2; ++m)
#pragma unroll
    for (int n = 0; n < 4; ++n) st[m][n] = (f32x4){0.f, 0.f, 0.f, 0.f};

  const int qj = gt >> 4, qc = gt & 15;
  const int vj = gt >> 3, vc = gt & 7;
  bf16x8 pq[4], pk[4], pv[2];
  float4 peg[2], pel[2];
  auto prefetch = [&](int s) {
    int base, cid;
    if (s < 4) { int cc = dir ? 3 - s : s; base = MLAT + b * 256 + cc * 64; cid = cc; }
    else { int c = s - 4; int cc = dir ? 63 - c : c; base = b * 4096 + cc * 64; cid = 4 + cc; }
#pragma unroll
    for (int i = 0; i < 4; ++i) {
      int jp = qj + 16 * i;
      unsigned ro = (unsigned)(base + (dir ? 63 - jp : jp)) * qstride + qc * 8;
      pq[i] = *(const bf16x8*)(qsrc + ro);
      pk[i] = *(const bf16x8*)(qsrc + ro + 512);
    }
#pragma unroll
    for (int i = 0; i < 2; ++i) {
      int jp = vj + 32 * i;
      pv[i] = *(const bf16x8*)(S + (size_t)(base + (dir ? 63 - jp : jp)) * 4096 + voff + vc * 8);
    }
    if (branch == 1) {
#pragma unroll
      for (int m = 0; m < 2; ++m) {
        int d0 = gw * 32 + m * 16 + fq * 4;
        peg[m] = *(const float4*)(VECS + (size_t)cid * 1024 + d0);
        pel[m] = *(const float4*)(VECS + (size_t)cid * 1024 + 512 + d0);
      }
    }
  };
  prefetch(0);
  __syncthreads();

  for (int s = 0; s < 68; ++s) {
    int base; bool first; bool wout;
    if (s < 4) { int cc = dir ? 3 - s : s; base = MLAT + b * 256 + cc * 64; first = s < 2; wout = (l == 0); }
    else { int c = s - 4; int cc = dir ? 63 - c : c; base = b * 4096 + cc * 64; first = c < 32; wout = true; }
    float4 eg[2], el[2];
#pragma unroll
    for (int m = 0; m < 2; ++m) {
      if (branch == 1) { eg[m] = peg[m]; el[m] = pel[m]; }
      else { eg[m] = make_float4(egc, egc, egc, egc); el[m] = eg[m]; }
    }
#pragma unroll
    for (int i = 0; i < 4; ++i) {
      int jp = qj + 16 * i;
      bf16x8 qv = pq[i], kv_ = pk[i];
      if (branch == 0) {
        float fqs = __expf((float)(jp - 31) * lg), fks = __expf((float)(31 - jp) * lg);
        qv = scale8(qv, fqs); kv_ = scale8(kv_, fks);
      }
      *(bf16x8*)(G + L_QR + off128(jp, qc * 8)) = qv;
      *(bf16x8*)(G + L_KR + off128(jp, qc * 8)) = kv_;
    }
#pragma unroll
    for (int i = 0; i < 2; ++i) *(bf16x8*)(G + L_V + off64(vj + 32 * i, vc * 8)) = pv[i];
#pragma unroll
    for (int m = 0; m < 2; ++m) {
      int d0 = gw * 32 + m * 16 + fq * 4;
#pragma unroll
      for (int n = 0; n < 4; ++n) {
        int e = n * 16 + fr;
        bf16x4 o4;
        o4[0] = (short)f2bf(st[m][n][0] * eg[m].x); o4[1] = (short)f2bf(st[m][n][1] * eg[m].y);
        o4[2] = (short)f2bf(st[m][n][2] * eg[m].z); o4[3] = (short)f2bf(st[m][n][3] * eg[m].w);
        *(bf16x4*)(G + L_SGT + off128(e, d0)) = o4;
      }
    }
    u16 oldv[4][4];
    u16* dstb = RG + (size_t)base * 2048 + ooff + fr;
    if (wout && !first) {
#pragma unroll
      for (int r = 0; r < 4; ++r) {
        int ip = gw * 16 + fq * 4 + r;
        unsigned ro = (unsigned)(dir ? 63 - ip : ip) * 2048u;
#pragma unroll
        for (int n = 0; n < 4; ++n) oldv[r][n] = dstb[ro + n * 16];
      }
    }
    if (s + 1 < 68) prefetch(s + 1);
    __syncthreads();
    f32x4 pt[4], o[4];
#pragma unroll
    for (int n = 0; n < 4; ++n) { pt[n] = (f32x4){0.f, 0.f, 0.f, 0.f}; o[n] = (f32x4){0.f, 0.f, 0.f, 0.f}; }
#pragma unroll
    for (int ks = 0; ks < 4; ++ks) {
      int kc = ks * 32 + fq * 8;
      bf16x8 ka = *(const bf16x8*)(G + L_KR + off128(gw * 16 + fr, kc));
      bf16x8 qa = *(const bf16x8*)(G + L_QR + off128(gw * 16 + fr, kc));
#pragma unroll
      for (int n = 0; n < 4; ++n) {
        bf16x8 qb = *(const bf16x8*)(G + L_QR + off128(n * 16 + fr, kc));
        bf16x8 sb = *(const bf16x8*)(G + L_SGT + off128(n * 16 + fr, kc));
        pt[n] = __builtin_amdgcn_mfma_f32_16x16x32_bf16(ka, qb, pt[n], 0, 0, 0);
        o[n] = __builtin_amdgcn_mfma_f32_16x16x32_bf16(qa, sb, o[n], 0, 0, 0);
      }
    }
    __syncthreads();
#pragma unroll
    for (int n = 0; n < 4; ++n) {
      int ip = n * 16 + fr;
      int j0 = gw * 16 + fq * 4;
      bf16x4 w;
#pragma unroll
      for (int r = 0; r < 4; ++r) {
        int jp = j0 + r;
        bool keep = dir ? (ip > jp) : (ip >= jp);
        w[r] = (short)f2bf(keep ? pt[n][r] : 0.f);
      }
      *(bf16x4*)(G + L_SGT + off64(ip, j0)) = w;
    }
    __syncthreads();
#pragma unroll
    for (int m = 0; m < 2; ++m) {
      f32x4 kv[4];
#pragma unroll
      for (int n = 0; n < 4; ++n) kv[n] = (f32x4){0.f, 0.f, 0.f, 0.f};
#pragma unroll
      for (int ks = 0; ks < 2; ++ks) {
        int kc = ks * 32 + fq * 8;
        bf16x8 km = tr_frag<272>(Ga + L_KR, ks * 32, gw * 32 + m * 16, lane);
        bf16x8 pa;
        if (m == 0) pa = *(const bf16x8*)(G + L_SGT + off64(gw * 16 + fr, kc));
#pragma unroll
        for (int n = 0; n < 4; ++n) {
          bf16x8 vb = tr_frag<144>(Ga + L_V, ks * 32, n * 16, lane);
          if (m == 0) o[n] = __builtin_amdgcn_mfma_f32_16x16x32_bf16(pa, vb, o[n], 0, 0, 0);
          kv[n] = __builtin_amdgcn_mfma_f32_16x16x32_bf16(km, vb, kv[n], 0, 0, 0);
        }
      }
#pragma unroll
      for (int n = 0; n < 4; ++n) {
        st[m][n][0] = eg[m].x * el[m].x * st[m][n][0] + el[m].x * kv[n][0];
        st[m][n][1] = eg[m].y * el[m].y * st[m][n][1] + el[m].y * kv[n][1];
        st[m][n][2] = eg[m].z * el[m].z * st[m][n][2] + el[m].z * kv[n][2];
        st[m][n][3] = eg[m].w * el[m].w * st[m][n][3] + el[m].w * kv[n][3];
      }
    }
    if (wout) {
#pragma unroll
      for (int r = 0; r < 4; ++r) {
        int ip = gw * 16 + fq * 4 + r;
        unsigned ro = (unsigned)(dir ? 63 - ip : ip) * 2048u;
#pragma unroll
        for (int n = 0; n < 4; ++n) {
          float v = o[n][r];
          if (!first) v += bf2f(oldv[r][n]);
          dstb[ro + n * 16] = f2bf(v);
        }
      }
    }
    __syncthreads();
  }
}

#define NPHASE 18
__device__ __forceinline__ void run_phase(const Params& p, int ph, char* smem) {
  const int nblk = gridDim.x, bid = blockIdx.x;
  if (ph == 0) {
    for (int u = bid; u < WT_UNITS + 96 + 1; u += nblk) {
      if (u < 96) mod_unit(p, u, smem);
      else if (u == 96) rot_unit(p);
      else wt_unit(p, 0, u - 97, smem);
    }
    return;
  }
  if (ph == NPHASE - 1) { phase_final(p); return; }
  const int l = (ph - 1) / 8, sp = (ph - 1) % 8;
  switch (sp) {
    case 0:
      phase_u(p, l);
      if (l == 1) for (int u = bid; u < WT_UNITS; u += nblk) wt_unit(p, 1, u, smem);
      break;
    case 1:
#ifdef REP_G1
      for (int rep = 0; rep < REP_G1; ++rep)
#endif
      for (int t = bid; t < 136 * 33; t += nblk) gemm_scan_in(p, t, smem); break;
    case 2: for (int t = bid; t < 544; t += nblk) gla_prepass_unit(p, l, t, smem); break;
    case 3:
#ifdef REP_SCAN
      for (int rep = 0; rep < REP_SCAN; ++rep)
#endif
      for (int t = bid; t < 256; t += nblk) { if (t < 128) scan_item<0>(p, l, t, smem); else scan_item<1>(p, l, t, smem); } break;
    case 4: phase_u(p, l); break;
    case 5: { int MT = l == 0 ? 136 : 128; for (int t = bid; t < MT * 32; t += nblk) gemm_gate(p, l, t, smem); } break;
    case 6: { int MT = l == 0 ? 136 : 128; for (int t = bid; t < MT * 8; t += nblk) gemm_merge(p, t, smem); } break;
    case 7: { int MT = l == 0 ? 136 : 128; for (int t = bid; t < MT * 8; t += nblk) gemm_out(p, l, t, smem); } break;
  }
}

__global__ void __launch_bounds__(NTHREADS) mega(Params p, int ph_lo, int ph_hi, int coop) {
  extern __shared__ __attribute__((aligned(16))) char smem[];
  for (int ph = ph_lo; ph < ph_hi; ++ph) {
    run_phase(p, ph, smem);
    if (coop && ph + 1 < ph_hi) { cg::this_grid().sync(); }
  }
}

extern "C" void kernel_launch(void* const* d_in, const int* in_sizes, int n_in,
                              void* d_out, int out_size, void* d_ws, size_t ws_size,
                              hipStream_t stream) {
  Params p{};
  p.x = (const float*)d_in[0]; p.c = (const float*)d_in[1]; p.ctx = (const float*)d_in[2]; p.c_ctx = (const float*)d_in[3];
  p.norm_gain = (const float*)d_in[4]; p.w_ada = (const float*)d_in[5]; p.b_ada = (const float*)d_in[6]; p.w_in = (const float*)d_in[7];
  p.ret_decay = (const float*)d_in[8]; p.gla_w_up = (const float*)d_in[9]; p.gla_b_up = (const float*)d_in[10];
  p.ret_norm_gain = (const float*)d_in[11]; p.gla_norm_gain = (const float*)d_in[12];
  p.w_br_ret = (const float*)d_in[13]; p.w_br_gla = (const float*)d_in[14]; p.w_out = (const float*)d_in[15]; p.final_gain = (const float*)d_in[16];
  p.out = (float*)d_out; p.ws = (char*)d_ws;
  static int grid_blocks = 0;
  if (!grid_blocks) {
    hipFuncSetAttribute((const void*)mega, hipFuncAttributeMaxDynamicSharedMemorySize, LDS_BYTES);
    int dev = 0, cus = 0, per_cu = 0;
    hipGetDevice(&dev);
    hipDeviceGetAttribute(&cus, hipDeviceAttributeMultiprocessorCount, dev);
    hipOccupancyMaxActiveBlocksPerMultiprocessor(&per_cu, mega, NTHREADS, LDS_BYTES);
    if (per_cu < 1) per_cu = 1;
    grid_blocks = cus * 1;
  }
#ifdef MULTI_LAUNCH
  for (int ph = 0; ph < NPHASE; ++ph) {
    mega<<<dim3(grid_blocks), dim3(NTHREADS), LDS_BYTES, stream>>>(p, ph, ph + 1, 0);
  }
#else
  int lo = 0, hi = NPHASE, coop = 1;
  void* args[] = {&p, &lo, &hi, &coop};
  hipError_t e = hipLaunchCooperativeKernel((void*)mega, dim3(grid_blocks), dim3(NTHREADS), args, LDS_BYTES, stream);
  if (e != hipSuccess) fprintf(stderr, "cooperative launch failed: %s (grid %d)\n", hipGetErrorString(e), grid_blocks);
#endif
}
```

```cpp
#include <hip/hip_runtime.h>
#include <hip/hip_cooperative_groups.h>
#include <cstdio>
namespace cg = cooperative_groups;

typedef unsigned short u16;
using bf16x8 = __attribute__((ext_vector_type(8))) short;
using bf16x4 = __attribute__((ext_vector_type(4))) short;
using f32x4  = __attribute__((ext_vector_type(4))) float;

#define NTHREADS 512
#define DM 1024
#define NB 8
#define SEQL 4096
#define CTXL 256
#define MLAT 32768
#define MCTX 2048
#define MTOT 34816
#define INW 8208

#define OFF_S    0ull
#define OFF_RG   (OFF_S   + (size_t)MTOT * 4096 * 2)
#define OFF_U    (OFF_RG  + (size_t)MTOT * 2048 * 2)
#define OFF_WT   (OFF_U   + (size_t)MTOT * 1024 * 2)
#define WT_ROWS  11392
#define OFF_GLR  (OFF_WT  + (size_t)WT_ROWS * 1024 * 2)
#define OFF_HCTX (OFF_GLR + (size_t)MTOT * 16 * 4)
#define OFF_MOD  (OFF_HCTX+ (size_t)MCTX * 1024 * 4)
#define OFF_ROT  (OFF_MOD + (size_t)2 * 9 * 3072 * 4)
#define OFF_BAR  (OFF_ROT + (size_t)64 * 32 * 2 * 4)
#define OFF_END  (OFF_BAR + 256)

#define WT_SCAN 0
#define WT_GATE 4224
#define WT_BRR  8320
#define WT_BRG  9344
#define WT_OUT  10368

#define LDS_BYTES 161792
#define SCAN_GB   80896

struct Params {
  const float* x; const float* c; const float* ctx; const float* c_ctx;
  const float* norm_gain; const float* w_ada; const float* b_ada; const float* w_in;
  const float* ret_decay; const float* gla_w_up; const float* gla_b_up;
  const float* ret_norm_gain; const float* gla_norm_gain;
  const float* w_br_ret; const float* w_br_gla; const float* w_out; const float* final_gain;
  float* out; char* ws;
};

__device__ __forceinline__ u16 f2bf(float f) {
  unsigned u = __float_as_uint(f);
  u += 0x7fffu + ((u >> 16) & 1u);
  return (u16)(u >> 16);
}
__device__ __forceinline__ float bf2f(u16 h) { return __uint_as_float(((unsigned)h) << 16); }
__device__ __forceinline__ float sigmoidf_(float x) { return 1.f / (1.f + __expf(-x)); }
__device__ __forceinline__ float siluf_(float x) { return x / (1.f + __expf(-x)); }

__device__ __forceinline__ int opaque_tid() { int t = threadIdx.x; asm volatile("" : "+v"(t)); return t; }

__device__ __forceinline__ float wave_sum(float v) {
#pragma unroll
  for (int o = 32; o > 0; o >>= 1) v += __shfl_xor(v, o, 64);
  return v;
}

__device__ __forceinline__ const float* wt_src(const Params& p, int l, int n, int& ld) {
  if (n < WT_GATE) {
    int tile = n >> 7, cc = n & 127;
    int col;
    if (tile < 8) {
      int d = (cc & 64) | ((cc & 16) << 1) | ((cc & 32) >> 1) | (cc & 15);
      col = tile * 128 + d;
    } else if (tile < 16) col = 1024 + (tile - 8) * 128 + cc;
    else if (tile < 24) col = 3072 + (tile - 16) * 128 + cc;
    else if (tile < 32) col = 4096 + (tile - 24) * 128 + cc;
    else { if (cc >= 16) { ld = 0; return nullptr; } col = 6144 + cc; }
    ld = INW; return p.w_in + (size_t)l * DM * INW + col;
  } else if (n < WT_BRR) {
    int g = n - WT_GATE; int col;
    if (g < 1024) col = 2048 + g;
    else if (g < 2048) col = 5120 + (g - 1024);
    else if (g < 3072) col = 6160 + (g - 2048);
    else col = 7184 + (g - 3072);
    ld = INW; return p.w_in + (size_t)l * DM * INW + col;
  } else if (n < WT_BRG) { ld = DM; return p.w_br_ret + (size_t)l * DM * DM + (n - WT_BRR); }
  else if (n < WT_OUT)   { ld = DM; return p.w_br_gla + (size_t)l * DM * DM + (n - WT_BRG); }
  else                   { ld = DM; return p.w_out    + (size_t)l * DM * DM + (n - WT_OUT); }
}

#define WT_UNITS (178 * 16)
__device__ __forceinline__ void wt_unit(const Params& p, int l, int unit, char* smem) {
  float* tile = (float*)smem;
  int nb = unit >> 4, kb = unit & 15;
  int tid = opaque_tid();
  int n0 = nb * 64, k0 = kb * 64;
  {
    int nl = tid & 63, kq = tid >> 6;
    int ld; const float* src = wt_src(p, l, n0 + nl, ld);
#pragma unroll
    for (int i = 0; i < 8; ++i) {
      int kl = kq + 8 * i;
      float v = src ? src[(size_t)(k0 + kl) * ld] : 0.f;
      tile[kl * 65 + nl] = v;
    }
  }
  __syncthreads();
  {
    int nl = tid >> 3, kq = tid & 7;
    bf16x8 o;
#pragma unroll
    for (int j = 0; j < 8; ++j) o[j] = (short)f2bf(tile[(kq * 8 + j) * 65 + nl]);
    u16* wt = (u16*)(p.ws + OFF_WT);
    *(bf16x8*)(wt + (size_t)(n0 + nl) * 1024 + k0 + kq * 8) = o;
  }
  __syncthreads();
}

__device__ __forceinline__ void mod_unit(const Params& p, int unit, char* smem) {
  float* sc = (float*)smem;
  float* red = sc + 9 * 1024;
  int l = unit / 48, jb = unit % 48;
  int tid = opaque_tid();
  for (int i = tid; i < 9 * 1024; i += NTHREADS) {
    int r = i >> 10, k = i & 1023;
    float v = (r < 8) ? p.c[r * 1024 + k] : p.c_ctx[k];
    sc[i] = siluf_(v);
  }
  __syncthreads();
  int jl = tid & 63, kg = tid >> 6;
  int j = jb * 64 + jl;
  float acc[9];
#pragma unroll
  for (int r = 0; r < 9; ++r) acc[r] = 0.f;
  const float* w = p.w_ada + (size_t)l * DM * 3072 + j;
#pragma unroll 16
  for (int k = kg * 128; k < kg * 128 + 128; ++k) {
    float wv = w[(size_t)k * 3072];
#pragma unroll
    for (int r = 0; r < 9; ++r) acc[r] += sc[r * 1024 + k] * wv;
  }
#pragma unroll
  for (int r = 0; r < 9; ++r) red[(kg * 9 + r) * 64 + jl] = acc[r];
  __syncthreads();
  float* mod = (float*)(p.ws + OFF_MOD);
  for (int i = tid; i < 9 * 64; i += NTHREADS) {
    int r = i >> 6, jj = i & 63;
    float s = 0.f;
#pragma unroll
    for (int g = 0; g < 8; ++g) s += red[(g * 9 + r) * 64 + jj];
    mod[((size_t)l * 9 + r) * 3072 + jb * 64 + jj] = s + p.b_ada[l * 3072 + jb * 64 + jj];
  }
  __syncthreads();
}

__device__ __forceinline__ void rot_unit(const Params& p) {
  float* rot = (float*)(p.ws + OFF_ROT);
  for (int i = opaque_tid(); i < 64 * 32; i += NTHREADS) {
    int pos = i >> 5, f = i & 31;
    float inv = exp2f(-(float)f * (13.287712379549449f / 32.f));
    float ang = (float)pos * inv;
    rot[i * 2] = __cosf(ang);
    rot[i * 2 + 1] = __sinf(ang);
  }
}

__device__ __forceinline__ void phase_u(const Params& p, int l) {
  const int tid = opaque_tid(); int wave = tid >> 6, lane = tid & 63;
  const float* mod = (const float*)(p.ws + OFF_MOD) + (size_t)l * 9 * 3072;
  const float* gain = p.norm_gain + l * DM;
  u16* U = (u16*)(p.ws + OFF_U);
  for (int row = blockIdx.x * 8 + wave; row < MTOT; row += gridDim.x * 8) {
    const float* h; int r;
    if (row < MLAT) { h = (l == 0 ? p.x : p.out) + (size_t)row * DM; r = row >> 12; }
    else { int cr = row - MLAT; h = (l == 0 ? p.ctx : (const float*)(p.ws + OFF_HCTX)) + (size_t)cr * DM; r = 8; }
    float4 v[4]; float ss = 0.f;
#pragma unroll
    for (int i = 0; i < 4; ++i) {
      v[i] = *(const float4*)(h + i * 256 + lane * 4);
      ss += v[i].x * v[i].x + v[i].y * v[i].y + v[i].z * v[i].z + v[i].w * v[i].w;
    }
    ss = wave_sum(ss);
    float rstd = rsqrtf(ss * (1.f / 1024.f) + 1e-6f);
    const float* sh = mod + r * 3072;
#pragma unroll
    for (int i = 0; i < 4; ++i) {
      int cidx = i * 256 + lane * 4;
      float4 g = *(const float4*)(gain + cidx);
      float4 s = *(const float4*)(sh + cidx);
      float4 sc = *(const float4*)(sh + 1024 + cidx);
      bf16x4 o;
      o[0] = (short)f2bf(v[i].x * rstd * g.x * (1.f + sc.x) + s.x);
      o[1] = (short)f2bf(v[i].y * rstd * g.y * (1.f + sc.y) + s.y);
      o[2] = (short)f2bf(v[i].z * rstd * g.z * (1.f + sc.z) + s.z);
      o[3] = (short)f2bf(v[i].w * rstd * g.w * (1.f + sc.w) + s.w);
      *(bf16x4*)(U + (size_t)row * DM + cidx) = o;
    }
  }
}

__device__ __forceinline__ void phase_final(const Params& p) {
  const int tid = opaque_tid(); int wave = tid >> 6, lane = tid & 63;
  for (int row = blockIdx.x * 8 + wave; row < MLAT; row += gridDim.x * 8) {
    float* h = p.out + (size_t)row * DM;
    float4 v[4]; float ss = 0.f;
#pragma unroll
    for (int i = 0; i < 4; ++i) {
      v[i] = *(const float4*)(h + i * 256 + lane * 4);
      ss += v[i].x * v[i].x + v[i].y * v[i].y + v[i].z * v[i].z + v[i].w * v[i].w;
    }
    ss = wave_sum(ss);
    float rstd = rsqrtf(ss * (1.f / 1024.f) + 1e-6f);
#pragma unroll
    for (int i = 0; i < 4; ++i) {
      int cidx = i * 256 + lane * 4;
      float4 g = *(const float4*)(p.final_gain + cidx);
      float4 o;
      o.x = v[i].x * rstd * g.x; o.y = v[i].y * rstd * g.y; o.z = v[i].z * rstd * g.z; o.w = v[i].w * rstd * g.w;
      *(float4*)(h + cidx) = o;
    }
  }
}

__device__ __forceinline__ int lds_byte(int r, int c) {
  int st = (r >> 4) * 2 + (c >> 5), rr = r & 15, cc = c & 31, ob = rr * 64 + cc * 2;
  return st * 1024 + (ob ^ (((ob >> 9) & 1) << 5));
}

__device__ __forceinline__ void stage_half(int tid, const u16* __restrict__ g, size_t ld, int row0, int k0, char* lds_half) {
#pragma unroll
  for (int i = 0; i < 2; ++i) {
    int b = tid * 16 + i * 8192;
    int st = b >> 10, sb = b & 1023, swz = sb ^ (((sb >> 9) & 1) << 5);
    int R = (st >> 1) * 16 + (swz >> 6), C = (st & 1) * 32 + ((swz & 63) >> 1);
    __builtin_amdgcn_global_load_lds((const unsigned*)(g + (size_t)(row0 + R) * ld + k0 + C),
                                     (__attribute__((address_space(3))) unsigned*)(lds_half + b), 16, 0, 0);
  }
}

__device__ __forceinline__ void gemm_mainloop(const u16* __restrict__ A, size_t lda, int row0,
                                              const u16* __restrict__ Bt, size_t ldb, int col0,
                                              int K, char* smem, f32x4 (&acc)[4][4], int tid) {
  const int wid = tid >> 6, lane = tid & 63;
  const int wr = wid >> 1, wc = wid & 1, fr = lane & 15, fq = lane >> 4;
  const int nt = K / 64;
  __syncthreads();
  stage_half(tid, A, lda, row0, 0, smem);
  stage_half(tid, A, lda, row0 + 128, 0, smem + 16384);
  stage_half(tid, Bt, ldb, col0, 0, smem + 32768);
  asm volatile("s_waitcnt vmcnt(0)" ::: "memory");
  __syncthreads();
  for (int t = 0; t < nt; ++t) {
    char* cur = smem + (t & 1) * 49152;
    if (t + 1 < nt) {
      char* nxt = smem + ((t + 1) & 1) * 49152;
      int k0 = (t + 1) * 64;
      stage_half(tid, A, lda, row0, k0, nxt);
      stage_half(tid, A, lda, row0 + 128, k0, nxt + 16384);
      stage_half(tid, Bt, ldb, col0, k0, nxt + 32768);
    }
    const char* sa = cur + (wr >> 1) * 16384;
    const char* sb = cur + 32768;
#pragma unroll
    for (int ks = 0; ks < 2; ++ks) {
      bf16x8 af[4], bfr[4];
#pragma unroll
      for (int m = 0; m < 4; ++m) af[m] = *(const bf16x8*)(sa + lds_byte((wr & 1) * 64 + m * 16 + fr, ks * 32 + fq * 8));
#pragma unroll
      for (int n = 0; n < 4; ++n) bfr[n] = *(const bf16x8*)(sb + lds_byte(wc * 64 + n * 16 + fr, ks * 32 + fq * 8));
#pragma unroll
      for (int m = 0; m < 4; ++m)
#pragma unroll
        for (int n = 0; n < 4; ++n)
          acc[m][n] = __builtin_amdgcn_mfma_f32_16x16x32_bf16(af[m], bfr[n], acc[m][n], 0, 0, 0);
    }
    asm volatile("s_waitcnt vmcnt(0)" ::: "memory");
    __syncthreads();
  }
  __builtin_amdgcn_sched_barrier(0);
}

#define ZERO_ACC(a) _Pragma("unroll") for (int _m = 0; _m < 4; ++_m) _Pragma("unroll") for (int _n = 0; _n < 4; ++_n) a[_m][_n] = (f32x4){0.f, 0.f, 0.f, 0.f}

#define EP_STRIDE 68
#define EP_BYTES  (64 * EP_STRIDE * 4)
#define STAT_OFF  159744
__device__ __forceinline__ float* stage_acc(char* smem, int wid, int fr, int fq, const f32x4 (&acc)[4][4]) {
  float* e = (float*)(smem + wid * EP_BYTES);
#pragma unroll
  for (int m = 0; m < 4; ++m)
#pragma unroll
    for (int n = 0; n < 4; ++n)
#pragma unroll
      for (int j = 0; j < 4; ++j) e[(m * 16 + fq * 4 + j) * EP_STRIDE + n * 16 + fr] = acc[m][n][j];
  return e;
}
__device__ __forceinline__ bf16x8 pack8(const float (&v)[8]) {
  bf16x8 o;
#pragma unroll
  for (int x = 0; x < 8; ++x) o[x] = (short)f2bf(v[x]);
  return o;
}
#define LOAD8(dst, ptr) { float4 _a = *(const float4*)(ptr); float4 _b = *(const float4*)((ptr) + 4); \
  dst[0] = _a.x; dst[1] = _a.y; dst[2] = _a.z; dst[3] = _a.w; dst[4] = _b.x; dst[5] = _b.y; dst[6] = _b.z; dst[7] = _b.w; }

__device__ __forceinline__ void gemm_scan_in(const Params& p, int tile, char* smem) {
  const int tid = opaque_tid();
  const int mt = tile / 33, ntile = tile % 33;
  const u16* U = (const u16*)(p.ws + OFF_U);
  const u16* WT = (const u16*)(p.ws + OFF_WT) + (size_t)WT_SCAN * 1024;
  f32x4 acc[4][4]; ZERO_ACC(acc);
  gemm_mainloop(U, 1024, mt * 256, WT, 1024, ntile * 128, 1024, smem, acc, tid);
  const int wid = tid >> 6, lane = tid & 63;
  const int wr = wid >> 1, wc = wid & 1, fr = lane & 15, fq = lane >> 4;
  const float* e = stage_acc(smem, wid, fr, fq, acc);
  const int rr = lane >> 3, c8 = (lane & 7) * 8;
  if (ntile == 32) {
    float* GLRb = (float*)(p.ws + OFF_GLR) + (size_t)mt * 256 * 16;
    if (wc == 0 && c8 < 16) {
#pragma unroll
      for (int i = 0; i < 8; ++i) {
        int r = rr + 8 * i;
        float v[8]; LOAD8(v, e + r * EP_STRIDE + c8);
        float* d = GLRb + (unsigned)(wr * 64 + r) * 16u + c8;
        *(float4*)d = make_float4(v[0], v[1], v[2], v[3]);
        *(float4*)(d + 4) = make_float4(v[4], v[5], v[6], v[7]);
      }
    }
    return;
  }
  u16* Sb = (u16*)(p.ws + OFF_S) + (size_t)mt * 256 * 4096 + ntile * 128 + wc * 64 + c8;
  const bool scaled = (ntile < 4) || (ntile >= 16 && ntile < 20);
  const float scl = scaled ? 0.08838834764831845f : 1.f;
  if (ntile < 8 && mt < 128) {
    const float* rot = (const float*)(p.ws + OFF_ROT);
    const int tbase = (mt & 15) * 256 + wr * 64;
    const int pair = (c8 >> 4) & 1, f0 = ((c8 >> 5) & 1) * 16 + (c8 & 15);
#pragma unroll
    for (int i = 0; i < 8; ++i) {
      int r = rr + 8 * i;
      int t = tbase + r;
      unsigned pos = (wc == 0) ? (t >> 6) : (t & 63);
      float v[8], vp[8], cs[16];
      LOAD8(v, e + r * EP_STRIDE + c8);
      LOAD8(vp, e + r * EP_STRIDE + (c8 ^ 16));
      const float* rp = rot + (pos * 32u + f0) * 2u;
      LOAD8(cs, rp); { float* c2 = cs + 8; LOAD8(c2, rp + 8); }
      float o[8];
#pragma unroll
      for (int x = 0; x < 8; ++x) {
        float c = cs[2 * x], s = cs[2 * x + 1];
        o[x] = (pair == 0 ? (v[x] * c - vp[x] * s) : (v[x] * c + vp[x] * s)) * scl;
      }
      *(bf16x8*)(Sb + (unsigned)(wr * 64 + r) * 4096u) = pack8(o);
    }
  } else {
#pragma unroll
    for (int i = 0; i < 8; ++i) {
      int r = rr + 8 * i;
      float v[8]; LOAD8(v, e + r * EP_STRIDE + c8);
#pragma unroll
      for (int x = 0; x < 8; ++x) v[x] *= scl;
      *(bf16x8*)(Sb + (unsigned)(wr * 64 + r) * 4096u) = pack8(v);
    }
  }
}

__device__ __forceinline__ void gemm_gate(const Params& p, int l, int tile, char* smem) {
  const int tid = opaque_tid();
  const int mt = tile >> 5, ntile = tile & 31;
  const u16* U = (const u16*)(p.ws + OFF_U);
  const u16* WT = (const u16*)(p.ws + OFF_WT) + (size_t)WT_GATE * 1024;
  const int wid = tid >> 6, lane = tid & 63;
  const int wr = wid >> 1, wc = wid & 1, fr = lane & 15, fq = lane >> 4;
  float* stat = (float*)(smem + STAT_OFF);
  const bool is_norm = ntile < 16;
  const int branch = ntile >> 3;
  const u16* RGb = (const u16*)(p.ws + OFF_RG) + (size_t)mt * 256 * 2048 + (branch & 1) * 1024;
  if (is_norm) {
    __syncthreads();
    int head = (ntile & 7) >> 1;
    for (int r0 = 0; r0 < 32; r0 += 8) {
      bf16x4 vv[8];
#pragma unroll
      for (int i = 0; i < 8; ++i) vv[i] = *(const bf16x4*)(RGb + (unsigned)(wid * 32 + r0 + i) * 2048u + head * 256 + lane * 4);
#pragma unroll
      for (int i = 0; i < 8; ++i) {
        unsigned rl = wid * 32 + r0 + i;
        float a0 = bf2f((u16)vv[i][0]), a1 = bf2f((u16)vv[i][1]), a2 = bf2f((u16)vv[i][2]), a3 = bf2f((u16)vv[i][3]);
        float s1 = a0 + a1 + a2 + a3, s2 = a0 * a0 + a1 * a1 + a2 * a2 + a3 * a3;
        s1 = wave_sum(s1); s2 = wave_sum(s2);
        float sa, sb;
        if (branch == 0) {
          float mu = s1 * (1.f / 256.f);
          float var = fmaxf(s2 * (1.f / 256.f) - mu * mu, 0.f);
          sa = rsqrtf(var + 1e-6f); sb = -mu * sa;
        } else { sa = rsqrtf(s2 * (1.f / 256.f) + 1e-6f); sb = 0.f; }
        if (lane == 0) { stat[rl * 2] = sa; stat[rl * 2 + 1] = sb; }
      }
    }
  }
  f32x4 acc[4][4]; ZERO_ACC(acc);
  gemm_mainloop(U, 1024, mt * 256, WT, 1024, ntile * 128, 1024, smem, acc, tid);
  const float* e = stage_acc(smem, wid, fr, fq, acc);
  const int rr = lane >> 3, c8 = (lane & 7) * 8;
  u16* Sb = (u16*)(p.ws + OFF_S) + (size_t)mt * 256 * 4096;
  if (is_norm) {
    const float* gain = (branch == 0 ? p.ret_norm_gain : p.gla_norm_gain) + l * 1024;
    const unsigned cin = (ntile & 7) * 128 + wc * 64 + c8;
    float gn[8]; LOAD8(gn, gain + cin);
#pragma unroll
    for (int i = 0; i < 8; ++i) {
      int r = rr + 8 * i;
      unsigned rl = wr * 64 + r;
      float v[8]; LOAD8(v, e + r * EP_STRIDE + c8);
      bf16x8 xr = *(const bf16x8*)(RGb + rl * 2048u + cin);
      float sa = stat[rl * 2], sb = stat[rl * 2 + 1];
      float o[8];
#pragma unroll
      for (int x = 0; x < 8; ++x) o[x] = (bf2f((u16)xr[x]) * sa + sb) * gn[x] * siluf_(v[x]);
      *(bf16x8*)(Sb + rl * 4096u + 2048u + branch * 1024 + cin) = pack8(o);
    }
  } else {
    const unsigned cout = (ntile - 16) * 128 + wc * 64 + c8;
#pragma unroll
    for (int i = 0; i < 8; ++i) {
      int r = rr + 8 * i;
      float v[8]; LOAD8(v, e + r * EP_STRIDE + c8);
#pragma unroll
      for (int x = 0; x < 8; ++x) v[x] = sigmoidf_(v[x]);
      *(bf16x8*)(Sb + (unsigned)(wr * 64 + r) * 4096u + cout) = pack8(v);
    }
  }
}

__device__ __forceinline__ void gemm_merge(const Params& p, int tile, char* smem) {
  const int tid = opaque_tid();
  const int mt = tile >> 3, ntile = tile & 7;
  const u16* S = (const u16*)(p.ws + OFF_S);
  const u16* WT = (const u16*)(p.ws + OFF_WT);
  const int wid = tid >> 6, lane = tid & 63;
  const int wr = wid >> 1, wc = wid & 1, fr = lane & 15, fq = lane >> 4;
  const int rr = lane >> 3, c8 = (lane & 7) * 8;
  const unsigned c0 = ntile * 128 + wc * 64 + c8;
  const u16* Sb = S + (size_t)mt * 256 * 4096;
  u16* MGb = (u16*)(p.ws + OFF_U) + (size_t)mt * 256 * 1024;
  f32x4 acc[4][4];
  ZERO_ACC(acc);
  gemm_mainloop(S + 2048, 4096, mt * 256, WT + (size_t)WT_BRR * 1024, 1024, ntile * 128, 1024, smem, acc, tid);
  {
    const float* e = stage_acc(smem, wid, fr, fq, acc);
#pragma unroll
    for (int i = 0; i < 8; ++i) {
      int r = rr + 8 * i;
      unsigned rl = wr * 64 + r;
      float v[8]; LOAD8(v, e + r * EP_STRIDE + c8);
      bf16x8 ma = *(const bf16x8*)(Sb + rl * 4096u + c0);
#pragma unroll
      for (int x = 0; x < 8; ++x) v[x] *= bf2f((u16)ma[x]);
      *(bf16x8*)(MGb + rl * 1024u + c0) = pack8(v);
    }
  }
  __builtin_amdgcn_sched_barrier(0);
  ZERO_ACC(acc);
  gemm_mainloop(S + 3072, 4096, mt * 256, WT + (size_t)WT_BRG * 1024, 1024, ntile * 128, 1024, smem, acc, tid);
  {
    const float* e = stage_acc(smem, wid, fr, fq, acc);
#pragma unroll
    for (int i = 0; i < 8; ++i) {
      int r = rr + 8 * i;
      unsigned rl = wr * 64 + r;
      float v[8]; LOAD8(v, e + r * EP_STRIDE + c8);
      bf16x8 mb = *(const bf16x8*)(Sb + rl * 4096u + 1024u + c0);
      bf16x8 t0 = *(const bf16x8*)(MGb + rl * 1024u + c0);
#pragma unroll
      for (int x = 0; x < 8; ++x) v[x] = bf2f((u16)t0[x]) + v[x] * bf2f((u16)mb[x]);
      *(bf16x8*)(MGb + rl * 1024u + c0) = pack8(v);
    }
  }
}

__device__ __forceinline__ void gemm_out(const Params& p, int l, int tile, char* smem) {
  const int tid = opaque_tid();
  const int mt = tile >> 3, ntile = tile & 7;
  const u16* MG = (const u16*)(p.ws + OFF_U);
  const u16* WT = (const u16*)(p.ws + OFF_WT) + (size_t)WT_OUT * 1024;
  const int wid = tid >> 6, lane = tid & 63;
  const int wr = wid >> 1, wc = wid & 1, fr = lane & 15, fq = lane >> 4;
  const int rr = lane >> 3, c8 = (lane & 7) * 8;
  const unsigned c0 = ntile * 128 + wc * 64 + c8;
  f32x4 acc[4][4]; ZERO_ACC(acc);
  gemm_mainloop(MG, 1024, mt * 256, WT, 1024, ntile * 128, 1024, smem, acc, tid);
  const float* e = stage_acc(smem, wid, fr, fq, acc);
  const float* hin; float* hout; int rmod;
  if (mt < 128) { hin = (l == 0 ? p.x : p.out) + (size_t)mt * 256 * DM; hout = p.out + (size_t)mt * 256 * DM; rmod = mt >> 4; }
  else { hin = p.ctx + (size_t)(mt - 128) * 256 * DM; hout = (float*)(p.ws + OFF_HCTX) + (size_t)(mt - 128) * 256 * DM; rmod = 8; }
  const float* gate = (const float*)(p.ws + OFF_MOD) + (size_t)l * 9 * 3072 + rmod * 3072 + 2048;
  float gt8[8]; LOAD8(gt8, gate + c0);
#pragma unroll
  for (int i = 0; i < 8; ++i) {
    int r = rr + 8 * i;
    unsigned o = (unsigned)(wr * 64 + r) * 1024u + c0;
    float v[8], hv[8];
    LOAD8(v, e + r * EP_STRIDE + c8);
    LOAD8(hv, hin + o);
    *(float4*)(hout + o) = make_float4(hv[0] + gt8[0] * v[0], hv[1] + gt8[1] * v[1], hv[2] + gt8[2] * v[2], hv[3] + gt8[3] * v[3]);
    *(float4*)(hout + o + 4) = make_float4(hv[4] + gt8[4] * v[4], hv[5] + gt8[5] * v[5], hv[6] + gt8[6] * v[6], hv[7] + gt8[7] * v[7]);
  }
}

#define OFF_VECS OFF_WT
__device__ __forceinline__ float logsig16(float x) { return (fminf(x, 0.f) - __logf(1.f + __expf(-fabsf(x)))) * (1.f / 16.f); }

__device__ __forceinline__ void gla_prepass_unit(const Params& p, int l, int unit, char* smem) {
  const int tid = opaque_tid();
  const int b = unit / 68, cid = unit % 68;
  const int base = cid < 4 ? (MLAT + b * 256 + cid * 64) : (b * 4096 + (cid - 4) * 64);
  float* GLRS = (float*)smem;
  __syncthreads();
  if (tid < 256) {
    const float* GLR = (const float*)(p.ws + OFF_GLR) + (size_t)base * 16;
    *(float4*)(GLRS + tid * 4) = *(const float4*)(GLR + tid * 4);
  }
  float wf[16], wb[16];
  {
    const float* w0 = p.gla_w_up + (size_t)(l * 2 + 0) * 16 * 512 + tid;
    const float* w1 = p.gla_w_up + (size_t)(l * 2 + 1) * 16 * 512 + tid;
#pragma unroll
    for (int r = 0; r < 16; ++r) { wf[r] = w0[r * 512]; wb[r] = w1[r * 512]; }
  }
  const float bf_ = p.gla_b_up[(l * 2 + 0) * 512 + tid], bb_ = p.gla_b_up[(l * 2 + 1) * 512 + tid];
  __syncthreads();
  u16* Sq = (u16*)(p.ws + OFF_S) + (size_t)base * 4096 + 2048 + tid;
  u16* Ub = (u16*)(p.ws + OFF_U) + (size_t)base * 1024 + tid;
  float accF = 0.f, accB = 0.f;
#pragma unroll 8
  for (int u = 0; u < 32; ++u) {
    const int i = 31 - u;
    const float4* gr = (const float4*)(GLRS + i * 16);
    float4 g0 = gr[0], g1 = gr[1], g2 = gr[2], g3 = gr[3];
    float xf = bf_, xb = bb_;
    xf += g0.x * wf[0] + g0.y * wf[1] + g0.z * wf[2] + g0.w * wf[3] + g1.x * wf[4] + g1.y * wf[5] + g1.z * wf[6] + g1.w * wf[7]
        + g2.x * wf[8] + g2.y * wf[9] + g2.z * wf[10] + g2.w * wf[11] + g3.x * wf[12] + g3.y * wf[13] + g3.z * wf[14] + g3.w * wf[15];
    xb += g0.x * wb[0] + g0.y * wb[1] + g0.z * wb[2] + g0.w * wb[3] + g1.x * wb[4] + g1.y * wb[5] + g1.z * wb[6] + g1.w * wb[7]
        + g2.x * wb[8] + g2.y * wb[9] + g2.z * wb[10] + g2.w * wb[11] + g3.x * wb[12] + g3.y * wb[13] + g3.z * wb[14] + g3.w * wb[15];
    const float laf = logsig16(xf), lab = logsig16(xb);
    const float relf = -accF; accF += laf;
    accB += lab; const float relb = accB;
    const float q = bf2f(Sq[(unsigned)i * 4096u]), k = bf2f(Sq[(unsigned)i * 4096u + 512u]);
    Sq[(unsigned)i * 4096u] = f2bf(q * __expf(relf));
    Sq[(unsigned)i * 4096u + 512u] = f2bf(k * __expf(-relf));
    Ub[(unsigned)i * 1024u] = f2bf(q * __expf(relb));
    Ub[(unsigned)i * 1024u + 512u] = f2bf(k * __expf(-relb));
  }
  float accF2 = 0.f, accB2 = 0.f;
#pragma unroll 8
  for (int u = 0; u < 32; ++u) {
    const int i = 32 + u;
    const float4* gr = (const float4*)(GLRS + i * 16);
    float4 g0 = gr[0], g1 = gr[1], g2 = gr[2], g3 = gr[3];
    float xf = bf_, xb = bb_;
    xf += g0.x * wf[0] + g0.y * wf[1] + g0.z * wf[2] + g0.w * wf[3] + g1.x * wf[4] + g1.y * wf[5] + g1.z * wf[6] + g1.w * wf[7]
        + g2.x * wf[8] + g2.y * wf[9] + g2.z * wf[10] + g2.w * wf[11] + g3.x * wf[12] + g3.y * wf[13] + g3.z * wf[14] + g3.w * wf[15];
    xb += g0.x * wb[0] + g0.y * wb[1] + g0.z * wb[2] + g0.w * wb[3] + g1.x * wb[4] + g1.y * wb[5] + g1.z * wb[6] + g1.w * wb[7]
        + g2.x * wb[8] + g2.y * wb[9] + g2.z * wb[10] + g2.w * wb[11] + g3.x * wb[12] + g3.y * wb[13] + g3.z * wb[14] + g3.w * wb[15];
    const float laf = logsig16(xf), lab = logsig16(xb);
    accF2 += laf; const float relf = accF2;
    const float relb = -accB2; accB2 += lab;
    const float q = bf2f(Sq[(unsigned)i * 4096u]), k = bf2f(Sq[(unsigned)i * 4096u + 512u]);
    Sq[(unsigned)i * 4096u] = f2bf(q * __expf(relf));
    Sq[(unsigned)i * 4096u + 512u] = f2bf(k * __expf(-relf));
    Ub[(unsigned)i * 1024u] = f2bf(q * __expf(relb));
    Ub[(unsigned)i * 1024u + 512u] = f2bf(k * __expf(-relb));
  }
  float* V0 = (float*)(p.ws + OFF_VECS) + ((size_t)(0 * 544 + b * 68 + cid) * 2) * 512 + tid;
  float* V1 = (float*)(p.ws + OFF_VECS) + ((size_t)(1 * 544 + b * 68 + cid) * 2) * 512 + tid;
  V0[0] = __expf(accF);  V0[512] = __expf(accF2);
  V1[0] = __expf(accB2); V1[512] = __expf(accB);
}

#define L_QR   0
#define L_KR   17408
#define L_V    34816
#define L_SGT  44032
#undef  SCAN_GB
#define SCAN_GB 61440

__device__ __forceinline__ int off128(int row, int col) { return row * 272 + col * 2; }
__device__ __forceinline__ int off64(int row, int col) { return row * 144 + col * 2; }

template <int RS>
__device__ __forceinline__ bf16x8 tr_frag(unsigned img_addr, int r0, int c0, int lane) {
  const int g = lane >> 4, q = (lane & 15) >> 2, pp = lane & 3;
  unsigned a = img_addr + (unsigned)((r0 + 8 * g + q) * RS + (c0 + 4 * pp) * 2);
  bf16x4 lo, hi;
  asm volatile("ds_read_b64_tr_b16 %0, %2\n\tds_read_b64_tr_b16 %1, %2 offset:%3\n\ts_waitcnt lgkmcnt(0)"
               : "=&v"(lo), "=&v"(hi) : "v"(a), "n"(4 * RS) : "memory");
  bf16x8 r;
  r[0] = lo[0]; r[1] = lo[1]; r[2] = lo[2]; r[3] = lo[3]; r[4] = hi[0]; r[5] = hi[1]; r[6] = hi[2]; r[7] = hi[3];
  return r;
}

__device__ __forceinline__ bf16x8 scale8(bf16x8 v, float f) {
  bf16x8 o;
#pragma unroll
  for (int x = 0; x < 8; ++x) o[x] = (short)f2bf(bf2f((u16)v[x]) * f);
  return o;
}

template <int branch>
__device__ __forceinline__ void scan_item(const Params& p, int l, int item, char* smem) {
  const int b = (item >> 4) & 7, h = (item >> 2) & 3, slice = item & 3;
  const int tid = opaque_tid(), wid = __builtin_amdgcn_readfirstlane(tid >> 6), lane = tid & 63;
  const int dir = wid >> 2, gw = wid & 3, gt = tid & 255;
  const int fr = lane & 15, fq = lane >> 4;
  char* G = smem + dir * SCAN_GB;
  const unsigned Ga = (unsigned)(size_t)G;
  const u16* S = (const u16*)(p.ws + OFF_S);
  u16* RG = (u16*)(p.ws + OFF_RG);
  const u16* qsrc; unsigned qstride;
  if (branch == 0) { qsrc = S + h * 128; qstride = 4096; }
  else if (dir == 0) { qsrc = S + 2048 + h * 128; qstride = 4096; }
  else { qsrc = (const u16*)(p.ws + OFF_U) + h * 128; qstride = 1024; }
  const int voff = branch * 2048 + 1024 + h * 256 + slice * 64;
  const int ooff = branch * 1024 + h * 256 + slice * 64;
  float lg = 0.f, egc = 1.f;
  if (branch == 0) { lg = __logf(1.f - __expf(p.ret_decay[(l * 2 + dir) * 4 + h])); egc = __expf(32.f * lg); }
  const float* VECS = (const float*)(p.ws + OFF_VECS) + ((size_t)(dir * 544 + b * 68) * 2) * 512 + h * 128;
  f32x4 st[2][4];
#pragma unroll
  for (int m = 0; m < 2; ++m)
#pragma unroll
    for (int n = 0; n < 4; ++n) st[m][n] = (f32x4){0.f, 0.f, 0.f, 0.f};

  const int qj = gt >> 4, qc = gt & 15;
  const int vj = gt >> 3, vc = gt & 7;
  bf16x8 pq[4], pk[4], pv[2];
  float4 peg[2], pel[2];
  auto prefetch = [&](int s) {
    int base, cid;
    if (s < 4) { int cc = dir ? 3 - s : s; base = MLAT + b * 256 + cc * 64; cid = cc; }
    else { int c = s - 4; int cc = dir ? 63 - c : c; base = b * 4096 + cc * 64; cid = 4 + cc; }
#pragma unroll
    for (int i = 0; i < 4; ++i) {
      int jp = qj + 16 * i;
      unsigned ro = (unsigned)(base + (dir ? 63 - jp : jp)) * qstride + qc * 8;
      pq[i] = *(const bf16x8*)(qsrc + ro);
      pk[i] = *(const bf16x8*)(qsrc + ro + 512);
    }
#pragma unroll
    for (int i = 0; i < 2; ++i) {
      int jp = vj + 32 * i;
      pv[i] = *(const bf16x8*)(S + (size_t)(base + (dir ? 63 - jp : jp)) * 4096 + voff + vc * 8);
    }
    if (branch == 1) {
#pragma unroll
      for (int m = 0; m < 2; ++m) {
        int d0 = gw * 32 + m * 16 + fq * 4;
        peg[m] = *(const float4*)(VECS + (size_t)cid * 1024 + d0);
        pel[m] = *(const float4*)(VECS + (size_t)cid * 1024 + 512 + d0);
      }
    }
  };
  prefetch(0);
  __syncthreads();

  for (int s = 0; s < 68; ++s) {
    int base; bool first; bool wout;
    if (s < 4) { int cc = dir ? 3 - s : s; base = MLAT + b * 256 + cc * 64; first = s < 2; wout = (l == 0); }
    else { int c = s - 4; int cc = dir ? 63 - c : c; base = b * 4096 + cc * 64; first = c < 32; wout = true; }
    float4 eg[2], el[2];
#pragma unroll
    for (int m = 0; m < 2; ++m) {
      if (branch == 1) { eg[m] = peg[m]; el[m] = pel[m]; }
      else { eg[m] = make_float4(egc, egc, egc, egc); el[m] = eg[m]; }
    }
#pragma unroll
    for (int i = 0; i < 4; ++i) {
      int jp = qj + 16 * i;
      bf16x8 qv = pq[i], kv_ = pk[i];
      if (branch == 0) {
        float fqs = __expf((float)(jp - 31) * lg), fks = __expf((float)(31 - jp) * lg);
        qv = scale8(qv, fqs); kv_ = scale8(kv_, fks);
      }
      *(bf16x8*)(G + L_QR + off128(jp, qc * 8)) = qv;
      *(bf16x8*)(G + L_KR + off128(jp, qc * 8)) = kv_;
    }
#pragma unroll
    for (int i = 0; i < 2; ++i) *(bf16x8*)(G + L_V + off64(vj + 32 * i, vc * 8)) = pv[i];
#pragma unroll
    for (int m = 0; m < 2; ++m) {
      int d0 = gw * 32 + m * 16 + fq * 4;
#pragma unroll
      for (int n = 0; n < 4; ++n) {
        int e = n * 16 + fr;
        bf16x4 o4;
        o4[0] = (short)f2bf(st[m][n][0] * eg[m].x); o4[1] = (short)f2bf(st[m][n][1] * eg[m].y);
        o4[2] = (short)f2bf(st[m][n][2] * eg[m].z); o4[3] = (short)f2bf(st[m][n][3] * eg[m].w);
        *(bf16x4*)(G + L_SGT + off128(e, d0)) = o4;
      }
    }
    u16 oldv[4][4];
    u16* dstb = RG + (size_t)base * 2048 + ooff + fr;
    if (wout && !first) {
#pragma unroll
      for (int r = 0; r < 4; ++r) {
        int ip = gw * 16 + fq * 4 + r;
        unsigned ro = (unsigned)(dir ? 63 - ip : ip) * 2048u;
#pragma unroll
        for (int n = 0; n < 4; ++n) oldv[r][n] = dstb[ro + n * 16];
      }
    }
    if (s + 1 < 68) prefetch(s + 1);
    __syncthreads();
    f32x4 pt[4], o[4];
#pragma unroll
    for (int n = 0; n < 4; ++n) { pt[n] = (f32x4){0.f, 0.f, 0.f, 0.f}; o[n] = (f32x4){0.f, 0.f, 0.f, 0.f}; }
#pragma unroll
    for (int ks = 0; ks < 4; ++ks) {
      int kc = ks * 32 + fq * 8;
      bf16x8 ka = *(const bf16x8*)(G + L_KR + off128(gw * 16 + fr, kc));
      bf16x8 qa = *(const bf16x8*)(G + L_QR + off128(gw * 16 + fr, kc));
#pragma unroll
      for (int n = 0; n < 4; ++n) {
        bf16x8 qb = *(const bf16x8*)(G + L_QR + off128(n * 16 + fr, kc));
        bf16x8 sb = *(const bf16x8*)(G + L_SGT + off128(n * 16 + fr, kc));
        pt[n] = __builtin_amdgcn_mfma_f32_16x16x32_bf16(ka, qb, pt[n], 0, 0, 0);
        o[n] = __builtin_amdgcn_mfma_f32_16x16x32_bf16(qa, sb, o[n], 0, 0, 0);
      }
    }
    __syncthreads();
#pragma unroll
    for (int n = 0; n < 4; ++n) {
      int ip = n * 16 + fr;
      int j0 = gw * 16 + fq * 4;
      bf16x4 w;
#pragma unroll
      for (int r = 0; r < 4; ++r) {
        int jp = j0 + r;
        bool keep = dir ? (ip > jp) : (ip >= jp);
        w[r] = (short)f2bf(keep ? pt[n][r] : 0.f);
      }
      *(bf16x4*)(G + L_SGT + off64(ip, j0)) = w;
    }
    __syncthreads();
#pragma unroll
    for (int m = 0; m < 2; ++m) {
      f32x4 kv[4];
#pragma unroll
      for (int n = 0; n < 4; ++n) kv[n] = (f32x4){0.f, 0.f, 0.f, 0.f};
#pragma unroll
      for (int ks = 0; ks < 2; ++ks) {
        int kc = ks * 32 + fq * 8;
        bf16x8 km = tr_frag<272>(Ga + L_KR, ks * 32, gw * 32 + m * 16, lane);
        bf16x8 pa;
        if (m == 0) pa = *(const bf16x8*)(G + L_SGT + off64(gw * 16 + fr, kc));
#pragma unroll
        for (int n = 0; n < 4; ++n) {
          bf16x8 vb = tr_frag<144>(Ga + L_V, ks * 32, n * 16, lane);
          if (m == 0) o[n] = __builtin_amdgcn_mfma_f32_16x16x32_bf16(pa, vb, o[n], 0, 0, 0);
          kv[n] = __builtin_amdgcn_mfma_f32_16x16x32_bf16(km, vb, kv[n], 0, 0, 0);
        }
      }
#pragma unroll
      for (int n = 0; n < 4; ++n) {
        st[m][n][0] = eg[m].x * el[m].x * st[m][n][0] + el[m].x * kv[n][0];
        st[m][n][1] = eg[m].y * el[m].y * st[m][n][1] + el[m].y * kv[n][1];
        st[m][n][2] = eg[m].z * el[m].z * st[m][n][2] + el[m].z * kv[n][2];
        st[m][n][3] = eg[m].w * el[m].w * st[m][n][3] + el[m].w * kv[n][3];
      }
    }
    if (wout) {
#pragma unroll
      for (int r = 0; r < 4; ++r) {
        int ip = gw * 16 + fq * 4 + r;
        unsigned ro = (unsigned)(dir ? 63 - ip : ip) * 2048u;
#pragma unroll
        for (int n = 0; n < 4; ++n) {
          float v = o[n][r];
          if (!first) v += bf2f(oldv[r][n]);
          dstb[ro + n * 16] = f2bf(v);
        }
      }
    }
    __syncthreads();
  }
}

#define NPHASE 18
__device__ __forceinline__ void run_phase(const Params& p, int ph, char* smem) {
  const int nblk = gridDim.x, bid = blockIdx.x;
  if (ph == 0) {
#ifdef REP_P0
    for (int rep = 0; rep < REP_P0; ++rep)
#endif
    for (int u = bid; u < WT_UNITS + 96 + 1; u += nblk) {
      if (u < 96) mod_unit(p, u, smem);
      else if (u == 96) rot_unit(p);
      else wt_unit(p, 0, u - 97, smem);
    }
    return;
  }
  if (ph == NPHASE - 1) { phase_final(p); return; }
  const int l = (ph - 1) / 8, sp = (ph - 1) % 8;
  switch (sp) {
    case 0:
      phase_u(p, l);
      if (l == 1) for (int u = bid; u < WT_UNITS; u += nblk) wt_unit(p, 1, u, smem);
      break;
    case 1:
#ifdef REP_G1
      for (int rep = 0; rep < REP_G1; ++rep)
#endif
      for (int t = bid; t < 136 * 33; t += nblk) gemm_scan_in(p, t, smem); break;
    case 2: for (int t = bid; t < 544; t += nblk) gla_prepass_unit(p, l, t, smem); break;
    case 3:
#ifdef REP_SCAN
      for (int rep = 0; rep < REP_SCAN; ++rep)
#endif
      for (int t = bid; t < 256; t += nblk) { if (t < 128) scan_item<0>(p, l, t, smem); else scan_item<1>(p, l, t, smem); } break;
    case 4:
#ifdef REP_U
      for (int rep = 0; rep < REP_U; ++rep)
#endif
      phase_u(p, l); break;
    case 5: { int MT = l == 0 ? 136 : 128;
#ifdef REP_G2
      for (int rep = 0; rep < REP_G2; ++rep)
#endif
      for (int t = bid; t < MT * 32; t += nblk) gemm_gate(p, l, t, smem); } break;
    case 6: { int MT = l == 0 ? 136 : 128;
#ifdef REP_G3
      for (int rep = 0; rep < REP_G3; ++rep)
#endif
      for (int t = bid; t < MT * 8; t += nblk) gemm_merge(p, t, smem); } break;
    case 7: { int MT = l == 0 ? 136 : 128; for (int t = bid; t < MT * 8; t += nblk) gemm_out(p, l, t, smem); } break;
  }
}

__device__ __forceinline__ void grid_barrier(unsigned* cnt, unsigned target) {
  asm volatile("s_waitcnt vmcnt(0)" ::: "memory");
  __syncthreads();
  if (threadIdx.x == 0) {
    __threadfence();
    __hip_atomic_fetch_add(cnt, 1u, __ATOMIC_RELAXED, __HIP_MEMORY_SCOPE_AGENT);
    while (__hip_atomic_load(cnt, __ATOMIC_RELAXED, __HIP_MEMORY_SCOPE_AGENT) < target) __builtin_amdgcn_s_sleep(2);
    __threadfence();
  }
  __syncthreads();
}

__global__ void __launch_bounds__(NTHREADS) mega(Params p, int ph_lo, int ph_hi, int coop) {
  extern __shared__ __attribute__((aligned(16))) char smem[];
  for (int ph = ph_lo; ph < ph_hi; ++ph) {
    run_phase(p, ph, smem);
    if (coop && ph + 1 < ph_hi) {
      if (ph == ph_lo) cg::this_grid().sync();
      else grid_barrier((unsigned*)(p.ws + OFF_BAR), (unsigned)(ph - ph_lo) * gridDim.x);
    }
  }
}

extern "C" void kernel_launch(void* const* d_in, const int* in_sizes, int n_in,
                              void* d_out, int out_size, void* d_ws, size_t ws_size,
                              hipStream_t stream) {
  Params p{};
  p.x = (const float*)d_in[0]; p.c = (const float*)d_in[1]; p.ctx = (const float*)d_in[2]; p.c_ctx = (const float*)d_in[3];
  p.norm_gain = (const float*)d_in[4]; p.w_ada = (const float*)d_in[5]; p.b_ada = (const float*)d_in[6]; p.w_in = (const float*)d_in[7];
  p.ret_decay = (const float*)d_in[8]; p.gla_w_up = (const float*)d_in[9]; p.gla_b_up = (const float*)d_in[10];
  p.ret_norm_gain = (const float*)d_in[11]; p.gla_norm_gain = (const float*)d_in[12];
  p.w_br_ret = (const float*)d_in[13]; p.w_br_gla = (const float*)d_in[14]; p.w_out = (const float*)d_in[15]; p.final_gain = (const float*)d_in[16];
  p.out = (float*)d_out; p.ws = (char*)d_ws;
  static int grid_blocks = 0;
  if (!grid_blocks) {
    hipFuncSetAttribute((const void*)mega, hipFuncAttributeMaxDynamicSharedMemorySize, LDS_BYTES);
    int dev = 0, cus = 0, per_cu = 0;
    hipGetDevice(&dev);
    hipDeviceGetAttribute(&cus, hipDeviceAttributeMultiprocessorCount, dev);
    hipOccupancyMaxActiveBlocksPerMultiprocessor(&per_cu, mega, NTHREADS, LDS_BYTES);
    if (per_cu < 1) per_cu = 1;
    grid_blocks = cus * 1;
  }
#ifdef MULTI_LAUNCH
  for (int ph = 0; ph < NPHASE; ++ph) {
    mega<<<dim3(grid_blocks), dim3(NTHREADS), LDS_BYTES, stream>>>(p, ph, ph + 1, 0);
  }
#else
  hipMemsetAsync((char*)d_ws + OFF_BAR, 0, 256, stream);
  int lo = 0, hi = NPHASE, coop = 1;
  void* args[] = {&p, &lo, &hi, &coop};
  hipError_t e = hipLaunchCooperativeKernel((void*)mega, dim3(grid_blocks), dim3(NTHREADS), args, LDS_BYTES, stream);
  if (e != hipSuccess) fprintf(stderr, "cooperative launch failed: %s (grid %d)\n", hipGetErrorString(e), grid_blocks);
#endif
}
```

```cpp
#include <hip/hip_runtime.h>
#include <hip/hip_cooperative_groups.h>
#include <cstdio>
namespace cg = cooperative_groups;

typedef unsigned short u16;
using bf16x8 = __attribute__((ext_vector_type(8))) short;
using bf16x4 = __attribute__((ext_vector_type(4))) short;
using f32x4  = __attribute__((ext_vector_type(4))) float;

#define NTHREADS 512
#define DM 1024
#define NB 8
#define SEQL 4096
#define CTXL 256
#define MLAT 32768
#define MCTX 2048
#define MTOT 34816
#define INW 8208

#define OFF_S    0ull
#define OFF_RG   (OFF_S   + (size_t)MTOT * 4096 * 2)
#define OFF_U    (OFF_RG  + (size_t)MTOT * 2048 * 2)
#define OFF_WT   (OFF_U   + (size_t)MTOT * 1024 * 2)
#define WT_ROWS  11392
#define OFF_GLR  (OFF_WT  + (size_t)WT_ROWS * 1024 * 2)
#define OFF_HCTX (OFF_GLR + (size_t)MTOT * 16 * 4)
#define OFF_MOD  (OFF_HCTX+ (size_t)MCTX * 1024 * 4)
#define OFF_ROT  (OFF_MOD + (size_t)2 * 9 * 3072 * 4)
#define OFF_BAR  (OFF_ROT + (size_t)64 * 32 * 2 * 4)
#define OFF_END  (OFF_BAR + 256)

#define WT_SCAN 0
#define WT_GATE 4224
#define WT_BRR  8320
#define WT_BRG  9344
#define WT_OUT  10368

#define LDS_BYTES 161792
#define SCAN_GB   80896

struct Params {
  const float* x; const float* c; const float* ctx; const float* c_ctx;
  const float* norm_gain; const float* w_ada; const float* b_ada; const float* w_in;
  const float* ret_decay; const float* gla_w_up; const float* gla_b_up;
  const float* ret_norm_gain; const float* gla_norm_gain;
  const float* w_br_ret; const float* w_br_gla; const float* w_out; const float* final_gain;
  float* out; char* ws;
};

__device__ __forceinline__ u16 f2bf(float f) {
  unsigned u = __float_as_uint(f);
  u += 0x7fffu + ((u >> 16) & 1u);
  return (u16)(u >> 16);
}
__device__ __forceinline__ float bf2f(u16 h) { return __uint_as_float(((unsigned)h) << 16); }
__device__ __forceinline__ float sigmoidf_(float x) { return 1.f / (1.f + __expf(-x)); }
__device__ __forceinline__ float siluf_(float x) { return x / (1.f + __expf(-x)); }

__device__ __forceinline__ int opaque_tid() { int t = threadIdx.x; asm volatile("" : "+v"(t)); return t; }

__device__ __forceinline__ float wave_sum(float v) {
#pragma unroll
  for (int o = 32; o > 0; o >>= 1) v += __shfl_xor(v, o, 64);
  return v;
}

__device__ __forceinline__ const float* wt_src(const Params& p, int l, int n, int& ld) {
  if (n < WT_GATE) {
    int tile = n >> 7, cc = n & 127;
    int col;
    if (tile < 8) {
      int d = (cc & 64) | ((cc & 16) << 1) | ((cc & 32) >> 1) | (cc & 15);
      col = tile * 128 + d;
    } else if (tile < 16) col = 1024 + (tile - 8) * 128 + cc;
    else if (tile < 24) col = 3072 + (tile - 16) * 128 + cc;
    else if (tile < 32) col = 4096 + (tile - 24) * 128 + cc;
    else { if (cc >= 16) { ld = 0; return nullptr; } col = 6144 + cc; }
    ld = INW; return p.w_in + (size_t)l * DM * INW + col;
  } else if (n < WT_BRR) {
    int g = n - WT_GATE; int col;
    if (g < 1024) col = 2048 + g;
    else if (g < 2048) col = 5120 + (g - 1024);
    else if (g < 3072) col = 6160 + (g - 2048);
    else col = 7184 + (g - 3072);
    ld = INW; return p.w_in + (size_t)l * DM * INW + col;
  } else if (n < WT_BRG) { ld = DM; return p.w_br_ret + (size_t)l * DM * DM + (n - WT_BRR); }
  else if (n < WT_OUT)   { ld = DM; return p.w_br_gla + (size_t)l * DM * DM + (n - WT_BRG); }
  else                   { ld = DM; return p.w_out    + (size_t)l * DM * DM + (n - WT_OUT); }
}

#define WT_UNITS (178 * 16)
__device__ __forceinline__ void wt_unit(const Params& p, int l, int unit, char* smem) {
  float* tile = (float*)smem;
  int nb = unit >> 4, kb = unit & 15;
  int tid = opaque_tid();
  int n0 = nb * 64, k0 = kb * 64;
  {
    int nl = tid & 63, kq = tid >> 6;
    int ld; const float* src = wt_src(p, l, n0 + nl, ld);
#pragma unroll
    for (int i = 0; i < 8; ++i) {
      int kl = kq + 8 * i;
      float v = src ? src[(size_t)(k0 + kl) * ld] : 0.f;
      tile[kl * 65 + nl] = v;
    }
  }
  __syncthreads();
  {
    int nl = tid >> 3, kq = tid & 7;
    bf16x8 o;
#pragma unroll
    for (int j = 0; j < 8; ++j) o[j] = (short)f2bf(tile[(kq * 8 + j) * 65 + nl]);
    u16* wt = (u16*)(p.ws + OFF_WT);
    *(bf16x8*)(wt + (size_t)(n0 + nl) * 1024 + k0 + kq * 8) = o;
  }
  __syncthreads();
}

__device__ __forceinline__ void mod_unit(const Params& p, int unit, char* smem) {
  float* sc = (float*)smem;
  float* red = sc + 9 * 1024;
  int l = unit / 48, jb = unit % 48;
  int tid = opaque_tid();
  for (int i = tid; i < 9 * 1024; i += NTHREADS) {
    int r = i >> 10, k = i & 1023;
    float v = (r < 8) ? p.c[r * 1024 + k] : p.c_ctx[k];
    sc[i] = siluf_(v);
  }
  __syncthreads();
  int jl = tid & 63, kg = tid >> 6;
  int j = jb * 64 + jl;
  float acc[9];
#pragma unroll
  for (int r = 0; r < 9; ++r) acc[r] = 0.f;
  const float* w = p.w_ada + (size_t)l * DM * 3072 + j;
#pragma unroll 16
  for (int k = kg * 128; k < kg * 128 + 128; ++k) {
    float wv = w[(size_t)k * 3072];
#pragma unroll
    for (int r = 0; r < 9; ++r) acc[r] += sc[r * 1024 + k] * wv;
  }
#pragma unroll
  for (int r = 0; r < 9; ++r) red[(kg * 9 + r) * 64 + jl] = acc[r];
  __syncthreads();
  float* mod = (float*)(p.ws + OFF_MOD);
  for (int i = tid; i < 9 * 64; i += NTHREADS) {
    int r = i >> 6, jj = i & 63;
    float s = 0.f;
#pragma unroll
    for (int g = 0; g < 8; ++g) s += red[(g * 9 + r) * 64 + jj];
    mod[((size_t)l * 9 + r) * 3072 + jb * 64 + jj] = s + p.b_ada[l * 3072 + jb * 64 + jj];
  }
  __syncthreads();
}

__device__ __forceinline__ void rot_unit(const Params& p) {
  float* rot = (float*)(p.ws + OFF_ROT);
  for (int i = opaque_tid(); i < 64 * 32; i += NTHREADS) {
    int pos = i >> 5, f = i & 31;
    float inv = exp2f(-(float)f * (13.287712379549449f / 32.f));
    float ang = (float)pos * inv;
    rot[i * 2] = __cosf(ang);
    rot[i * 2 + 1] = __sinf(ang);
  }
}

__device__ __forceinline__ void phase_u(const Params& p, int l) {
  const int tid = opaque_tid(); int wave = tid >> 6, lane = tid & 63;
  const float* mod = (const float*)(p.ws + OFF_MOD) + (size_t)l * 9 * 3072;
  const float* gain = p.norm_gain + l * DM;
  u16* U = (u16*)(p.ws + OFF_U);
  for (int row = blockIdx.x * 8 + wave; row < MTOT; row += gridDim.x * 8) {
    const float* h; int r;
    if (row < MLAT) { h = (l == 0 ? p.x : p.out) + (size_t)row * DM; r = row >> 12; }
    else { int cr = row - MLAT; h = (l == 0 ? p.ctx : (const float*)(p.ws + OFF_HCTX)) + (size_t)cr * DM; r = 8; }
    float4 v[4]; float ss = 0.f;
#pragma unroll
    for (int i = 0; i < 4; ++i) {
      v[i] = *(const float4*)(h + i * 256 + lane * 4);
      ss += v[i].x * v[i].x + v[i].y * v[i].y + v[i].z * v[i].z + v[i].w * v[i].w;
    }
    ss = wave_sum(ss);
    float rstd = rsqrtf(ss * (1.f / 1024.f) + 1e-6f);
    const float* sh = mod + r * 3072;
#pragma unroll
    for (int i = 0; i < 4; ++i) {
      int cidx = i * 256 + lane * 4;
      float4 g = *(const float4*)(gain + cidx);
      float4 s = *(const float4*)(sh + cidx);
      float4 sc = *(const float4*)(sh + 1024 + cidx);
      bf16x4 o;
      o[0] = (short)f2bf(v[i].x * rstd * g.x * (1.f + sc.x) + s.x);
      o[1] = (short)f2bf(v[i].y * rstd * g.y * (1.f + sc.y) + s.y);
      o[2] = (short)f2bf(v[i].z * rstd * g.z * (1.f + sc.z) + s.z);
      o[3] = (short)f2bf(v[i].w * rstd * g.w * (1.f + sc.w) + s.w);
      *(bf16x4*)(U + (size_t)row * DM + cidx) = o;
    }
  }
}

__device__ __forceinline__ void phase_final(const Params& p) {
  const int tid = opaque_tid(); int wave = tid >> 6, lane = tid & 63;
  for (int row = blockIdx.x * 8 + wave; row < MLAT; row += gridDim.x * 8) {
    float* h = p.out + (size_t)row * DM;
    float4 v[4]; float ss = 0.f;
#pragma unroll
    for (int i = 0; i < 4; ++i) {
      v[i] = *(const float4*)(h + i * 256 + lane * 4);
      ss += v[i].x * v[i].x + v[i].y * v[i].y + v[i].z * v[i].z + v[i].w * v[i].w;
    }
    ss = wave_sum(ss);
    float rstd = rsqrtf(ss * (1.f / 1024.f) + 1e-6f);
#pragma unroll
    for (int i = 0; i < 4; ++i) {
      int cidx = i * 256 + lane * 4;
      float4 g = *(const float4*)(p.final_gain + cidx);
      float4 o;
      o.x = v[i].x * rstd * g.x; o.y = v[i].y * rstd * g.y; o.z = v[i].z * rstd * g.z; o.w = v[i].w * rstd * g.w;
      *(float4*)(h + cidx) = o;
    }
  }
}

__device__ __forceinline__ int lds_byte(int r, int c) {
  int st = (r >> 4) * 2 + (c >> 5), rr = r & 15, cc = c & 31, ob = rr * 64 + cc * 2;
  return st * 1024 + (ob ^ (((ob >> 9) & 1) << 5));
}

__device__ __forceinline__ void stage_half(int tid, const u16* __restrict__ g, size_t ld, int row0, int k0, char* lds_half) {
#pragma unroll
  for (int i = 0; i < 2; ++i) {
    int b = tid * 16 + i * 8192;
    int st = b >> 10, sb = b & 1023, swz = sb ^ (((sb >> 9) & 1) << 5);
    int R = (st >> 1) * 16 + (swz >> 6), C = (st & 1) * 32 + ((swz & 63) >> 1);
    __builtin_amdgcn_global_load_lds((const unsigned*)(g + (size_t)(row0 + R) * ld + k0 + C),
                                     (__attribute__((address_space(3))) unsigned*)(lds_half + b), 16, 0, 0);
  }
}

__device__ __forceinline__ void gemm_mainloop(const u16* __restrict__ A, size_t lda, int row0,
                                              const u16* __restrict__ Bt, size_t ldb, int col0,
                                              int K, char* smem, f32x4 (&acc)[4][4], int tid) {
  const int wid = tid >> 6, lane = tid & 63;
  const int wr = wid >> 1, wc = wid & 1, fr = lane & 15, fq = lane >> 4;
  const int nt = K / 64;
  asm volatile("s_waitcnt vmcnt(0)" ::: "memory");
  __syncthreads();
  stage_half(tid, A, lda, row0, 0, smem);
  stage_half(tid, A, lda, row0 + 128, 0, smem + 16384);
  stage_half(tid, Bt, ldb, col0, 0, smem + 32768);
  stage_half(tid, A, lda, row0, 64, smem + 49152);
  stage_half(tid, A, lda, row0 + 128, 64, smem + 49152 + 16384);
  stage_half(tid, Bt, ldb, col0, 64, smem + 49152 + 32768);
  int cb = 0;
  for (int t = 0; t < nt; ++t) {
    if (t + 1 < nt) asm volatile("s_waitcnt vmcnt(6)" ::: "memory");
    else asm volatile("s_waitcnt vmcnt(0)" ::: "memory");
    __builtin_amdgcn_s_barrier();
    asm volatile("" ::: "memory");
    char* cur = smem + cb * 49152;
    if (t + 2 < nt) {
      int nb = cb + 2; if (nb >= 3) nb -= 3;
      char* nxt = smem + nb * 49152;
      int k0 = (t + 2) * 64;
      stage_half(tid, A, lda, row0, k0, nxt);
      stage_half(tid, A, lda, row0 + 128, k0, nxt + 16384);
      stage_half(tid, Bt, ldb, col0, k0, nxt + 32768);
    }
    const char* sa = cur + (wr >> 1) * 16384;
    const char* sb = cur + 32768;
#pragma unroll
    for (int ks = 0; ks < 2; ++ks) {
      bf16x8 af[4], bfr[4];
#pragma unroll
      for (int m = 0; m < 4; ++m) af[m] = *(const bf16x8*)(sa + lds_byte((wr & 1) * 64 + m * 16 + fr, ks * 32 + fq * 8));
#pragma unroll
      for (int n = 0; n < 4; ++n) bfr[n] = *(const bf16x8*)(sb + lds_byte(wc * 64 + n * 16 + fr, ks * 32 + fq * 8));
#pragma unroll
      for (int m = 0; m < 4; ++m)
#pragma unroll
        for (int n = 0; n < 4; ++n)
          acc[m][n] = __builtin_amdgcn_mfma_f32_16x16x32_bf16(af[m], bfr[n], acc[m][n], 0, 0, 0);
    }
    cb = cb + 1; if (cb >= 3) cb -= 3;
  }
  __syncthreads();
  __builtin_amdgcn_sched_barrier(0);
}

#define ZERO_ACC(a) _Pragma("unroll") for (int _m = 0; _m < 4; ++_m) _Pragma("unroll") for (int _n = 0; _n < 4; ++_n) a[_m][_n] = (f32x4){0.f, 0.f, 0.f, 0.f}

#define EP_STRIDE 68
#define EP_BYTES  (64 * EP_STRIDE * 4)
#define STAT_OFF  159744
__device__ __forceinline__ float* stage_acc(char* smem, int wid, int fr, int fq, const f32x4 (&acc)[4][4]) {
  float* e = (float*)(smem + wid * EP_BYTES);
#pragma unroll
  for (int m = 0; m < 4; ++m)
#pragma unroll
    for (int n = 0; n < 4; ++n)
#pragma unroll
      for (int j = 0; j < 4; ++j) e[(m * 16 + fq * 4 + j) * EP_STRIDE + n * 16 + fr] = acc[m][n][j];
  return e;
}
__device__ __forceinline__ bf16x8 pack8(const float (&v)[8]) {
  bf16x8 o;
#pragma unroll
  for (int x = 0; x < 8; ++x) o[x] = (short)f2bf(v[x]);
  return o;
}
#define LOAD8(dst, ptr) { float4 _a = *(const float4*)(ptr); float4 _b = *(const float4*)((ptr) + 4); \
  dst[0] = _a.x; dst[1] = _a.y; dst[2] = _a.z; dst[3] = _a.w; dst[4] = _b.x; dst[5] = _b.y; dst[6] = _b.z; dst[7] = _b.w; }

__device__ __forceinline__ void gemm_scan_in(const Params& p, int mt, int ntile, char* smem) {
  const int tid = opaque_tid();
  const u16* U = (const u16*)(p.ws + OFF_U);
  const u16* WT = (const u16*)(p.ws + OFF_WT) + (size_t)WT_SCAN * 1024;
  f32x4 acc[4][4]; ZERO_ACC(acc);
  gemm_mainloop(U, 1024, mt * 256, WT, 1024, ntile * 128, 1024, smem, acc, tid);
  const int wid = tid >> 6, lane = tid & 63;
  const int wr = wid >> 1, wc = wid & 1, fr = lane & 15, fq = lane >> 4;
  const float* e = stage_acc(smem, wid, fr, fq, acc);
  const int rr = lane >> 3, c8 = (lane & 7) * 8;
  if (ntile == 32) {
    float* GLRb = (float*)(p.ws + OFF_GLR) + (size_t)mt * 256 * 16;
    if (wc == 0 && c8 < 16) {
#pragma unroll
      for (int i = 0; i < 8; ++i) {
        int r = rr + 8 * i;
        float v[8]; LOAD8(v, e + r * EP_STRIDE + c8);
        float* d = GLRb + (unsigned)(wr * 64 + r) * 16u + c8;
        *(float4*)d = make_float4(v[0], v[1], v[2], v[3]);
        *(float4*)(d + 4) = make_float4(v[4], v[5], v[6], v[7]);
      }
    }
    return;
  }
  u16* Sb = (u16*)(p.ws + OFF_S) + (size_t)mt * 256 * 4096 + ntile * 128 + wc * 64 + c8;
  const bool scaled = (ntile < 4) || (ntile >= 16 && ntile < 20);
  const float scl = scaled ? 0.08838834764831845f : 1.f;
  if (ntile < 8 && mt < 128) {
    const float* rot = (const float*)(p.ws + OFF_ROT);
    const int tbase = (mt & 15) * 256 + wr * 64;
    const int pair = (c8 >> 4) & 1, f0 = ((c8 >> 5) & 1) * 16 + (c8 & 15);
#pragma unroll
    for (int i = 0; i < 8; ++i) {
      int r = rr + 8 * i;
      int t = tbase + r;
      unsigned pos = (wc == 0) ? (t >> 6) : (t & 63);
      float v[8], vp[8], cs[16];
      LOAD8(v, e + r * EP_STRIDE + c8);
      LOAD8(vp, e + r * EP_STRIDE + (c8 ^ 16));
      const float* rp = rot + (pos * 32u + f0) * 2u;
      LOAD8(cs, rp); { float* c2 = cs + 8; LOAD8(c2, rp + 8); }
      float o[8];
#pragma unroll
      for (int x = 0; x < 8; ++x) {
        float c = cs[2 * x], s = cs[2 * x + 1];
        o[x] = (pair == 0 ? (v[x] * c - vp[x] * s) : (v[x] * c + vp[x] * s)) * scl;
      }
      *(bf16x8*)(Sb + (unsigned)(wr * 64 + r) * 4096u) = pack8(o);
    }
  } else {
#pragma unroll
    for (int i = 0; i < 8; ++i) {
      int r = rr + 8 * i;
      float v[8]; LOAD8(v, e + r * EP_STRIDE + c8);
#pragma unroll
      for (int x = 0; x < 8; ++x) v[x] *= scl;
      *(bf16x8*)(Sb + (unsigned)(wr * 64 + r) * 4096u) = pack8(v);
    }
  }
}

__device__ __forceinline__ void gemm_gate(const Params& p, int l, int mt, int ntile, char* smem) {
  const int tid = opaque_tid();
  const u16* U = (const u16*)(p.ws + OFF_U);
  const u16* WT = (const u16*)(p.ws + OFF_WT) + (size_t)WT_GATE * 1024;
  const int wid = tid >> 6, lane = tid & 63;
  const int wr = wid >> 1, wc = wid & 1, fr = lane & 15, fq = lane >> 4;
  float* stat = (float*)(smem + STAT_OFF);
  const bool is_norm = ntile < 16;
  const int branch = ntile >> 3;
  const u16* RGb = (const u16*)(p.ws + OFF_RG) + (size_t)mt * 256 * 2048 + (branch & 1) * 1024;
  if (is_norm) {
    __syncthreads();
    int head = (ntile & 7) >> 1;
    for (int r0 = 0; r0 < 32; r0 += 8) {
      bf16x4 vv[8];
#pragma unroll
      for (int i = 0; i < 8; ++i) vv[i] = *(const bf16x4*)(RGb + (unsigned)(wid * 32 + r0 + i) * 2048u + head * 256 + lane * 4);
#pragma unroll
      for (int i = 0; i < 8; ++i) {
        unsigned rl = wid * 32 + r0 + i;
        float a0 = bf2f((u16)vv[i][0]), a1 = bf2f((u16)vv[i][1]), a2 = bf2f((u16)vv[i][2]), a3 = bf2f((u16)vv[i][3]);
        float s1 = a0 + a1 + a2 + a3, s2 = a0 * a0 + a1 * a1 + a2 * a2 + a3 * a3;
        s1 = wave_sum(s1); s2 = wave_sum(s2);
        float sa, sb;
        if (branch == 0) {
          float mu = s1 * (1.f / 256.f);
          float var = fmaxf(s2 * (1.f / 256.f) - mu * mu, 0.f);
          sa = rsqrtf(var + 1e-6f); sb = -mu * sa;
        } else { sa = rsqrtf(s2 * (1.f / 256.f) + 1e-6f); sb = 0.f; }
        if (lane == 0) { stat[rl * 2] = sa; stat[rl * 2 + 1] = sb; }
      }
    }
  }
  f32x4 acc[4][4]; ZERO_ACC(acc);
  gemm_mainloop(U, 1024, mt * 256, WT, 1024, ntile * 128, 1024, smem, acc, tid);
  const float* e = stage_acc(smem, wid, fr, fq, acc);
  const int rr = lane >> 3, c8 = (lane & 7) * 8;
  u16* Sb = (u16*)(p.ws + OFF_S) + (size_t)mt * 256 * 4096;
  if (is_norm) {
    const float* gain = (branch == 0 ? p.ret_norm_gain : p.gla_norm_gain) + l * 1024;
    const unsigned cin = (ntile & 7) * 128 + wc * 64 + c8;
    float gn[8]; LOAD8(gn, gain + cin);
#pragma unroll
    for (int i = 0; i < 8; ++i) {
      int r = rr + 8 * i;
      unsigned rl = wr * 64 + r;
      float v[8]; LOAD8(v, e + r * EP_STRIDE + c8);
      bf16x8 xr = *(const bf16x8*)(RGb + rl * 2048u + cin);
      float sa = stat[rl * 2], sb = stat[rl * 2 + 1];
      float o[8];
#pragma unroll
      for (int x = 0; x < 8; ++x) o[x] = (bf2f((u16)xr[x]) * sa + sb) * gn[x] * siluf_(v[x]);
      *(bf16x8*)(Sb + rl * 4096u + 2048u + branch * 1024 + cin) = pack8(o);
    }
  } else {
    const unsigned cout = (ntile - 16) * 128 + wc * 64 + c8;
#pragma unroll
    for (int i = 0; i < 8; ++i) {
      int r = rr + 8 * i;
      float v[8]; LOAD8(v, e + r * EP_STRIDE + c8);
#pragma unroll
      for (int x = 0; x < 8; ++x) v[x] = sigmoidf_(v[x]);
      *(bf16x8*)(Sb + (unsigned)(wr * 64 + r) * 4096u + cout) = pack8(v);
    }
  }
}

__device__ __forceinline__ void gemm_merge(const Params& p, int mt, int ntile, char* smem) {
  const int tid = opaque_tid();
  const u16* S = (const u16*)(p.ws + OFF_S);
  const u16* WT = (const u16*)(p.ws + OFF_WT);
  const int wid = tid >> 6, lane = tid & 63;
  const int wr = wid >> 1, wc = wid & 1, fr = lane & 15, fq = lane >> 4;
  const int rr = lane >> 3, c8 = (lane & 7) * 8;
  const unsigned c0 = ntile * 128 + wc * 64 + c8;
  const u16* Sb = S + (size_t)mt * 256 * 4096;
  u16* MGb = (u16*)(p.ws + OFF_U) + (size_t)mt * 256 * 1024;
  f32x4 acc[4][4];
  ZERO_ACC(acc);
  gemm_mainloop(S + 2048, 4096, mt * 256, WT + (size_t)WT_BRR * 1024, 1024, ntile * 128, 1024, smem, acc, tid);
  {
    const float* e = stage_acc(smem, wid, fr, fq, acc);
#pragma unroll
    for (int i = 0; i < 8; ++i) {
      int r = rr + 8 * i;
      unsigned rl = wr * 64 + r;
      float v[8]; LOAD8(v, e + r * EP_STRIDE + c8);
      bf16x8 ma = *(const bf16x8*)(Sb + rl * 4096u + c0);
#pragma unroll
      for (int x = 0; x < 8; ++x) v[x] *= bf2f((u16)ma[x]);
      *(bf16x8*)(MGb + rl * 1024u + c0) = pack8(v);
    }
  }
  __builtin_amdgcn_sched_barrier(0);
  ZERO_ACC(acc);
  gemm_mainloop(S + 3072, 4096, mt * 256, WT + (size_t)WT_BRG * 1024, 1024, ntile * 128, 1024, smem, acc, tid);
  {
    const float* e = stage_acc(smem, wid, fr, fq, acc);
#pragma unroll
    for (int i = 0; i < 8; ++i) {
      int r = rr + 8 * i;
      unsigned rl = wr * 64 + r;
      float v[8]; LOAD8(v, e + r * EP_STRIDE + c8);
      bf16x8 mb = *(const bf16x8*)(Sb + rl * 4096u + 1024u + c0);
      bf16x8 t0 = *(const bf16x8*)(MGb + rl * 1024u + c0);
#pragma unroll
      for (int x = 0; x < 8; ++x) v[x] = bf2f((u16)t0[x]) + v[x] * bf2f((u16)mb[x]);
      *(bf16x8*)(MGb + rl * 1024u + c0) = pack8(v);
    }
  }
}

__device__ __forceinline__ void gemm_out(const Params& p, int l, int mt, int ntile, char* smem) {
  const int tid = opaque_tid();
  const u16* MG = (const u16*)(p.ws + OFF_U);
  const u16* WT = (const u16*)(p.ws + OFF_WT) + (size_t)WT_OUT * 1024;
  const int wid = tid >> 6, lane = tid & 63;
  const int wr = wid >> 1, wc = wid & 1, fr = lane & 15, fq = lane >> 4;
  const int rr = lane >> 3, c8 = (lane & 7) * 8;
  const unsigned c0 = ntile * 128 + wc * 64 + c8;
  f32x4 acc[4][4]; ZERO_ACC(acc);
  gemm_mainloop(MG, 1024, mt * 256, WT, 1024, ntile * 128, 1024, smem, acc, tid);
  const float* e = stage_acc(smem, wid, fr, fq, acc);
  const float* hin; float* hout; int rmod;
  if (mt < 128) { hin = (l == 0 ? p.x : p.out) + (size_t)mt * 256 * DM; hout = p.out + (size_t)mt * 256 * DM; rmod = mt >> 4; }
  else { hin = p.ctx + (size_t)(mt - 128) * 256 * DM; hout = (float*)(p.ws + OFF_HCTX) + (size_t)(mt - 128) * 256 * DM; rmod = 8; }
  const float* gate = (const float*)(p.ws + OFF_MOD) + (size_t)l * 9 * 3072 + rmod * 3072 + 2048;
  float gt8[8]; LOAD8(gt8, gate + c0);
#pragma unroll
  for (int i = 0; i < 8; ++i) {
    int r = rr + 8 * i;
    unsigned o = (unsigned)(wr * 64 + r) * 1024u + c0;
    float v[8], hv[8];
    LOAD8(v, e + r * EP_STRIDE + c8);
    LOAD8(hv, hin + o);
    *(float4*)(hout + o) = make_float4(hv[0] + gt8[0] * v[0], hv[1] + gt8[1] * v[1], hv[2] + gt8[2] * v[2], hv[3] + gt8[3] * v[3]);
    *(float4*)(hout + o + 4) = make_float4(hv[4] + gt8[4] * v[4], hv[5] + gt8[5] * v[5], hv[6] + gt8[6] * v[6], hv[7] + gt8[7] * v[7]);
  }
}

#define OFF_VECS OFF_WT
__device__ __forceinline__ float logsig16(float x) { return (fminf(x, 0.f) - __logf(1.f + __expf(-fabsf(x)))) * (1.f / 16.f); }

__device__ __forceinline__ void gla_prepass_unit(const Params& p, int l, int unit, char* smem) {
  const int tid = opaque_tid();
  const int b = unit / 68, cid = unit % 68;
  const int base = cid < 4 ? (MLAT + b * 256 + cid * 64) : (b * 4096 + (cid - 4) * 64);
  float* GLRS = (float*)smem;
  __syncthreads();
  if (tid < 256) {
    const float* GLR = (const float*)(p.ws + OFF_GLR) + (size_t)base * 16;
    *(float4*)(GLRS + tid * 4) = *(const float4*)(GLR + tid * 4);
  }
  float wf[16], wb[16];
  {
    const float* w0 = p.gla_w_up + (size_t)(l * 2 + 0) * 16 * 512 + tid;
    const float* w1 = p.gla_w_up + (size_t)(l * 2 + 1) * 16 * 512 + tid;
#pragma unroll
    for (int r = 0; r < 16; ++r) { wf[r] = w0[r * 512]; wb[r] = w1[r * 512]; }
  }
  const float bf_ = p.gla_b_up[(l * 2 + 0) * 512 + tid], bb_ = p.gla_b_up[(l * 2 + 1) * 512 + tid];
  __syncthreads();
  u16* Sq = (u16*)(p.ws + OFF_S) + (size_t)base * 4096 + 2048 + tid;
  u16* Ub = (u16*)(p.ws + OFF_U) + (size_t)base * 1024 + tid;
  float accF = 0.f, accB = 0.f;
#pragma unroll 8
  for (int u = 0; u < 32; ++u) {
    const int i = 31 - u;
    const float4* gr = (const float4*)(GLRS + i * 16);
    float4 g0 = gr[0], g1 = gr[1], g2 = gr[2], g3 = gr[3];
    float xf = bf_, xb = bb_;
    xf += g0.x * wf[0] + g0.y * wf[1] + g0.z * wf[2] + g0.w * wf[3] + g1.x * wf[4] + g1.y * wf[5] + g1.z * wf[6] + g1.w * wf[7]
        + g2.x * wf[8] + g2.y * wf[9] + g2.z * wf[10] + g2.w * wf[11] + g3.x * wf[12] + g3.y * wf[13] + g3.z * wf[14] + g3.w * wf[15];
    xb += g0.x * wb[0] + g0.y * wb[1] + g0.z * wb[2] + g0.w * wb[3] + g1.x * wb[4] + g1.y * wb[5] + g1.z * wb[6] + g1.w * wb[7]
        + g2.x * wb[8] + g2.y * wb[9] + g2.z * wb[10] + g2.w * wb[11] + g3.x * wb[12] + g3.y * wb[13] + g3.z * wb[14] + g3.w * wb[15];
    const float laf = logsig16(xf), lab = logsig16(xb);
    const float relf = -accF; accF += laf;
    accB += lab; const float relb = accB;
    const float q = bf2f(Sq[(unsigned)i * 4096u]), k = bf2f(Sq[(unsigned)i * 4096u + 512u]);
    Sq[(unsigned)i * 4096u] = f2bf(q * __expf(relf));
    Sq[(unsigned)i * 4096u + 512u] = f2bf(k * __expf(-relf));
    Ub[(unsigned)i * 1024u] = f2bf(q * __expf(relb));
    Ub[(unsigned)i * 1024u + 512u] = f2bf(k * __expf(-relb));
  }
  float accF2 = 0.f, accB2 = 0.f;
#pragma unroll 8
  for (int u = 0; u < 32; ++u) {
    const int i = 32 + u;
    const float4* gr = (const float4*)(GLRS + i * 16);
    float4 g0 = gr[0], g1 = gr[1], g2 = gr[2], g3 = gr[3];
    float xf = bf_, xb = bb_;
    xf += g0.x * wf[0] + g0.y * wf[1] + g0.z * wf[2] + g0.w * wf[3] + g1.x * wf[4] + g1.y * wf[5] + g1.z * wf[6] + g1.w * wf[7]
        + g2.x * wf[8] + g2.y * wf[9] + g2.z * wf[10] + g2.w * wf[11] + g3.x * wf[12] + g3.y * wf[13] + g3.z * wf[14] + g3.w * wf[15];
    xb += g0.x * wb[0] + g0.y * wb[1] + g0.z * wb[2] + g0.w * wb[3] + g1.x * wb[4] + g1.y * wb[5] + g1.z * wb[6] + g1.w * wb[7]
        + g2.x * wb[8] + g2.y * wb[9] + g2.z * wb[10] + g2.w * wb[11] + g3.x * wb[12] + g3.y * wb[13] + g3.z * wb[14] + g3.w * wb[15];
    const float laf = logsig16(xf), lab = logsig16(xb);
    accF2 += laf; const float relf = accF2;
    const float relb = -accB2; accB2 += lab;
    const float q = bf2f(Sq[(unsigned)i * 4096u]), k = bf2f(Sq[(unsigned)i * 4096u + 512u]);
    Sq[(unsigned)i * 4096u] = f2bf(q * __expf(relf));
    Sq[(unsigned)i * 4096u + 512u] = f2bf(k * __expf(-relf));
    Ub[(unsigned)i * 1024u] = f2bf(q * __expf(relb));
    Ub[(unsigned)i * 1024u + 512u] = f2bf(k * __expf(-relb));
  }
  float* V0 = (float*)(p.ws + OFF_VECS) + ((size_t)(0 * 544 + b * 68 + cid) * 2) * 512 + tid;
  float* V1 = (float*)(p.ws + OFF_VECS) + ((size_t)(1 * 544 + b * 68 + cid) * 2) * 512 + tid;
  V0[0] = __expf(accF);  V0[512] = __expf(accF2);
  V1[0] = __expf(accB2); V1[512] = __expf(accB);
}

#define L_QR   0
#define L_KR   17408
#define L_V    34816
#define L_SGT  44032
#undef  SCAN_GB
#define SCAN_GB 61440

__device__ __forceinline__ int off128(int row, int col) { return row * 272 + col * 2; }
__device__ __forceinline__ int off64(int row, int col) { return row * 144 + col * 2; }

template <int RS>
__device__ __forceinline__ bf16x8 tr_frag(unsigned img_addr, int r0, int c0, int lane) {
  const int g = lane >> 4, q = (lane & 15) >> 2, pp = lane & 3;
  unsigned a = img_addr + (unsigned)((r0 + 8 * g + q) * RS + (c0 + 4 * pp) * 2);
  bf16x4 lo, hi;
  asm volatile("ds_read_b64_tr_b16 %0, %2\n\tds_read_b64_tr_b16 %1, %2 offset:%3\n\ts_waitcnt lgkmcnt(0)"
               : "=&v"(lo), "=&v"(hi) : "v"(a), "n"(4 * RS) : "memory");
  bf16x8 r;
  r[0] = lo[0]; r[1] = lo[1]; r[2] = lo[2]; r[3] = lo[3]; r[4] = hi[0]; r[5] = hi[1]; r[6] = hi[2]; r[7] = hi[3];
  return r;
}

__device__ __forceinline__ bf16x8 scale8(bf16x8 v, float f) {
  bf16x8 o;
#pragma unroll
  for (int x = 0; x < 8; ++x) o[x] = (short)f2bf(bf2f((u16)v[x]) * f);
  return o;
}

template <int branch>
__device__ __forceinline__ void scan_item(const Params& p, int l, int item, char* smem) {
  const int b = (item >> 4) & 7, h = (item >> 2) & 3, slice = item & 3;
  const int tid = opaque_tid(), wid = __builtin_amdgcn_readfirstlane(tid >> 6), lane = tid & 63;
  const int dir = wid >> 2, gw = wid & 3, gt = tid & 255;
  const int fr = lane & 15, fq = lane >> 4;
  char* G = smem + dir * SCAN_GB;
  const unsigned Ga = (unsigned)(size_t)G;
  const u16* S = (const u16*)(p.ws + OFF_S);
  u16* RG = (u16*)(p.ws + OFF_RG);
  const u16* qsrc; unsigned qstride;
  if (branch == 0) { qsrc = S + h * 128; qstride = 4096; }
  else if (dir == 0) { qsrc = S + 2048 + h * 128; qstride = 4096; }
  else { qsrc = (const u16*)(p.ws + OFF_U) + h * 128; qstride = 1024; }
  const int voff = branch * 2048 + 1024 + h * 256 + slice * 64;
  const int ooff = branch * 1024 + h * 256 + slice * 64;
  float lg = 0.f, egc = 1.f;
  if (branch == 0) { lg = __logf(1.f - __expf(p.ret_decay[(l * 2 + dir) * 4 + h])); egc = __expf(32.f * lg); }
  const float* VECS = (const float*)(p.ws + OFF_VECS) + ((size_t)(dir * 544 + b * 68) * 2) * 512 + h * 128;
  f32x4 st[2][4];
#pragma unroll
  for (int m = 0; m < 2; ++m)
#pragma unroll
    for (int n = 0; n < 4; ++n) st[m][n] = (f32x4){0.f, 0.f, 0.f, 0.f};

  const int qj = gt >> 4, qc = gt & 15;
  const int vj = gt >> 3, vc = gt & 7;
  bf16x8 pq[4], pk[4], pv[2];
  float4 peg[2], pel[2];
  auto prefetch = [&](int s) {
    int base, cid;
    if (s < 4) { int cc = dir ? 3 - s : s; base = MLAT + b * 256 + cc * 64; cid = cc; }
    else { int c = s - 4; int cc = dir ? 63 - c : c; base = b * 4096 + cc * 64; cid = 4 + cc; }
#pragma unroll
    for (int i = 0; i < 4; ++i) {
      int jp = qj + 16 * i;
      unsigned ro = (unsigned)(base + (dir ? 63 - jp : jp)) * qstride + qc * 8;
      pq[i] = *(const bf16x8*)(qsrc + ro);
      pk[i] = *(const bf16x8*)(qsrc + ro + 512);
    }
#pragma unroll
    for (int i = 0; i < 2; ++i) {
      int jp = vj + 32 * i;
      pv[i] = *(const bf16x8*)(S + (size_t)(base + (dir ? 63 - jp : jp)) * 4096 + voff + vc * 8);
    }
    if (branch == 1) {
#pragma unroll
      for (int m = 0; m < 2; ++m) {
        int d0 = gw * 32 + m * 16 + fq * 4;
        peg[m] = *(const float4*)(VECS + (size_t)cid * 1024 + d0);
        pel[m] = *(const float4*)(VECS + (size_t)cid * 1024 + 512 + d0);
      }
    }
  };
  prefetch(0);
  __syncthreads();

  for (int s = 0; s < 68; ++s) {
    int base; bool first; bool wout;
    if (s < 4) { int cc = dir ? 3 - s : s; base = MLAT + b * 256 + cc * 64; first = s < 2; wout = (l == 0); }
    else { int c = s - 4; int cc = dir ? 63 - c : c; base = b * 4096 + cc * 64; first = c < 32; wout = true; }
    float4 eg[2], el[2];
#pragma unroll
    for (int m = 0; m < 2; ++m) {
      if (branch == 1) { eg[m] = peg[m]; el[m] = pel[m]; }
      else { eg[m] = make_float4(egc, egc, egc, egc); el[m] = eg[m]; }
    }
#pragma unroll
    for (int i = 0; i < 4; ++i) {
      int jp = qj + 16 * i;
      bf16x8 qv = pq[i], kv_ = pk[i];
      if (branch == 0) {
        float fqs = __expf((float)(jp - 31) * lg), fks = __expf((float)(31 - jp) * lg);
        qv = scale8(qv, fqs); kv_ = scale8(kv_, fks);
      }
      *(bf16x8*)(G + L_QR + off128(jp, qc * 8)) = qv;
      *(bf16x8*)(G + L_KR + off128(jp, qc * 8)) = kv_;
    }
#pragma unroll
    for (int i = 0; i < 2; ++i) *(bf16x8*)(G + L_V + off64(vj + 32 * i, vc * 8)) = pv[i];
#pragma unroll
    for (int m = 0; m < 2; ++m) {
      int d0 = gw * 32 + m * 16 + fq * 4;
#pragma unroll
      for (int n = 0; n < 4; ++n) {
        int e = n * 16 + fr;
        bf16x4 o4;
        o4[0] = (short)f2bf(st[m][n][0] * eg[m].x); o4[1] = (short)f2bf(st[m][n][1] * eg[m].y);
        o4[2] = (short)f2bf(st[m][n][2] * eg[m].z); o4[3] = (short)f2bf(st[m][n][3] * eg[m].w);
        *(bf16x4*)(G + L_SGT + off128(e, d0)) = o4;
      }
    }
    u16 oldv[4][4];
    u16* dstb = RG + (size_t)base * 2048 + ooff + fr;
    if (wout && !first) {
#pragma unroll
      for (int r = 0; r < 4; ++r) {
        int ip = gw * 16 + fq * 4 + r;
        unsigned ro = (unsigned)(dir ? 63 - ip : ip) * 2048u;
#pragma unroll
        for (int n = 0; n < 4; ++n) oldv[r][n] = dstb[ro + n * 16];
      }
    }
    if (s + 1 < 68) prefetch(s + 1);
    __syncthreads();
    f32x4 pt[4], o[4];
#pragma unroll
    for (int n = 0; n < 4; ++n) { pt[n] = (f32x4){0.f, 0.f, 0.f, 0.f}; o[n] = (f32x4){0.f, 0.f, 0.f, 0.f}; }
#pragma unroll
    for (int ks = 0; ks < 4; ++ks) {
      int kc = ks * 32 + fq * 8;
      bf16x8 ka = *(const bf16x8*)(G + L_KR + off128(gw * 16 + fr, kc));
      bf16x8 qa = *(const bf16x8*)(G + L_QR + off128(gw * 16 + fr, kc));
#pragma unroll
      for (int n = 0; n < 4; ++n) {
        bf16x8 qb = *(const bf16x8*)(G + L_QR + off128(n * 16 + fr, kc));
        bf16x8 sb = *(const bf16x8*)(G + L_SGT + off128(n * 16 + fr, kc));
        pt[n] = __builtin_amdgcn_mfma_f32_16x16x32_bf16(ka, qb, pt[n], 0, 0, 0);
        o[n] = __builtin_amdgcn_mfma_f32_16x16x32_bf16(qa, sb, o[n], 0, 0, 0);
      }
    }
    __syncthreads();
#pragma unroll
    for (int n = 0; n < 4; ++n) {
      int ip = n * 16 + fr;
      int j0 = gw * 16 + fq * 4;
      bf16x4 w;
#pragma unroll
      for (int r = 0; r < 4; ++r) {
        int jp = j0 + r;
        bool keep = dir ? (ip > jp) : (ip >= jp);
        w[r] = (short)f2bf(keep ? pt[n][r] : 0.f);
      }
      *(bf16x4*)(G + L_SGT + off64(ip, j0)) = w;
    }
    __syncthreads();
#pragma unroll
    for (int m = 0; m < 2; ++m) {
      f32x4 kv[4];
#pragma unroll
      for (int n = 0; n < 4; ++n) kv[n] = (f32x4){0.f, 0.f, 0.f, 0.f};
#pragma unroll
      for (int ks = 0; ks < 2; ++ks) {
        int kc = ks * 32 + fq * 8;
        bf16x8 km = tr_frag<272>(Ga + L_KR, ks * 32, gw * 32 + m * 16, lane);
        bf16x8 pa;
        if (m == 0) pa = *(const bf16x8*)(G + L_SGT + off64(gw * 16 + fr, kc));
#pragma unroll
        for (int n = 0; n < 4; ++n) {
          bf16x8 vb = tr_frag<144>(Ga + L_V, ks * 32, n * 16, lane);
          if (m == 0) o[n] = __builtin_amdgcn_mfma_f32_16x16x32_bf16(pa, vb, o[n], 0, 0, 0);
          kv[n] = __builtin_amdgcn_mfma_f32_16x16x32_bf16(km, vb, kv[n], 0, 0, 0);
        }
      }
#pragma unroll
      for (int n = 0; n < 4; ++n) {
        st[m][n][0] = eg[m].x * el[m].x * st[m][n][0] + el[m].x * kv[n][0];
        st[m][n][1] = eg[m].y * el[m].y * st[m][n][1] + el[m].y * kv[n][1];
        st[m][n][2] = eg[m].z * el[m].z * st[m][n][2] + el[m].z * kv[n][2];
        st[m][n][3] = eg[m].w * el[m].w * st[m][n][3] + el[m].w * kv[n][3];
      }
    }
    if (wout) {
#pragma unroll
      for (int r = 0; r < 4; ++r) {
        int ip = gw * 16 + fq * 4 + r;
        unsigned ro = (unsigned)(dir ? 63 - ip : ip) * 2048u;
#pragma unroll
        for (int n = 0; n < 4; ++n) {
          float v = o[n][r];
          if (!first) v += bf2f(oldv[r][n]);
          dstb[ro + n * 16] = f2bf(v);
        }
      }
    }
    __syncthreads();
  }
}

#define NPHASE 18
__device__ __forceinline__ void run_phase(const Params& p, int ph, char* smem) {
  const int nblk = gridDim.x, bid = blockIdx.x;
  if (ph == 0) {
#ifdef REP_P0
    for (int rep = 0; rep < REP_P0; ++rep)
#endif
    for (int u = bid; u < WT_UNITS + 96 + 1; u += nblk) {
      if (u < 96) mod_unit(p, u, smem);
      else if (u == 96) rot_unit(p);
      else wt_unit(p, 0, u - 97, smem);
    }
    return;
  }
  if (ph == NPHASE - 1) { phase_final(p); return; }
  const int l = (ph - 1) / 8, sp = (ph - 1) % 8;
  switch (sp) {
    case 0:
      phase_u(p, l);
      if (l == 1) for (int u = bid; u < WT_UNITS; u += nblk) wt_unit(p, 1, u, smem);
      break;
    case 1:
#ifdef REP_G1
      for (int rep = 0; rep < REP_G1; ++rep)
#endif
      {
        const int x = bid & 7, per = (nblk - x + 7) >> 3;
        for (int q = bid >> 3; q < 561; q += per) {
          int k = q / 33, r = q - k * 33;
          int mt = (r == 32) ? 8 * k + x : 8 * k + (r >> 2);
          int nt = (r == 32) ? 32 : x + 8 * (r & 3);
          gemm_scan_in(p, mt, nt, smem);
        }
      }
      break;
    case 2: for (int t = bid; t < 544; t += nblk) gla_prepass_unit(p, l, t, smem); break;
    case 3:
#ifdef REP_SCAN
      for (int rep = 0; rep < REP_SCAN; ++rep)
#endif
      for (int t = bid; t < 256; t += nblk) { if (t < 128) scan_item<0>(p, l, t, smem); else scan_item<1>(p, l, t, smem); } break;
    case 4:
#ifdef REP_U
      for (int rep = 0; rep < REP_U; ++rep)
#endif
      phase_u(p, l); break;
    case 5: { int MT = l == 0 ? 136 : 128;
#ifdef REP_G2
      for (int rep = 0; rep < REP_G2; ++rep)
#endif
      {
        const int x = bid & 7, per = (nblk - x + 7) >> 3;
        for (int q = bid >> 3; q < MT * 4; q += per) gemm_gate(p, l, q >> 2, x + 8 * (q & 3), smem);
      } } break;
    case 6: { int MT = l == 0 ? 136 : 128;
#ifdef REP_G3
      for (int rep = 0; rep < REP_G3; ++rep)
#endif
      {
        const int x = bid & 7, per = (nblk - x + 7) >> 3;
        for (int q = bid >> 3; q < MT; q += per) gemm_merge(p, x + 8 * (q >> 3), q & 7, smem);
      } } break;
    case 7: { int MT = l == 0 ? 136 : 128;
      {
        const int x = bid & 7, per = (nblk - x + 7) >> 3;
        for (int q = bid >> 3; q < MT; q += per) gemm_out(p, l, x + 8 * (q >> 3), q & 7, smem);
      } } break;
  }
}

__device__ __forceinline__ void grid_barrier(unsigned* cnt, unsigned target) {
  asm volatile("s_waitcnt vmcnt(0)" ::: "memory");
  __syncthreads();
  if (threadIdx.x == 0) {
    __threadfence();
    __hip_atomic_fetch_add(cnt, 1u, __ATOMIC_RELAXED, __HIP_MEMORY_SCOPE_AGENT);
    while (__hip_atomic_load(cnt, __ATOMIC_RELAXED, __HIP_MEMORY_SCOPE_AGENT) < target) __builtin_amdgcn_s_sleep(2);
    __threadfence();
  }
  __syncthreads();
}

__global__ void __launch_bounds__(NTHREADS) mega(Params p, int ph_lo, int ph_hi, int coop) {
  extern __shared__ __attribute__((aligned(16))) char smem[];
  for (int ph = ph_lo; ph < ph_hi; ++ph) {
    run_phase(p, ph, smem);
    if (coop && ph + 1 < ph_hi) {
      if (ph == ph_lo) cg::this_grid().sync();
      else grid_barrier((unsigned*)(p.ws + OFF_BAR), (unsigned)(ph - ph_lo) * gridDim.x);
    }
  }
}

extern "C" void kernel_launch(void* const* d_in, const int* in_sizes, int n_in,
                              void* d_out, int out_size, void* d_ws, size_t ws_size,
                              hipStream_t stream) {
  Params p{};
  p.x = (const float*)d_in[0]; p.c = (const float*)d_in[1]; p.ctx = (const float*)d_in[2]; p.c_ctx = (const float*)d_in[3];
  p.norm_gain = (const float*)d_in[4]; p.w_ada = (const float*)d_in[5]; p.b_ada = (const float*)d_in[6]; p.w_in = (const float*)d_in[7];
  p.ret_decay = (const float*)d_in[8]; p.gla_w_up = (const float*)d_in[9]; p.gla_b_up = (const float*)d_in[10];
  p.ret_norm_gain = (const float*)d_in[11]; p.gla_norm_gain = (const float*)d_in[12];
  p.w_br_ret = (const float*)d_in[13]; p.w_br_gla = (const float*)d_in[14]; p.w_out = (const float*)d_in[15]; p.final_gain = (const float*)d_in[16];
  p.out = (float*)d_out; p.ws = (char*)d_ws;
  static int grid_blocks = 0;
  if (!grid_blocks) {
    hipFuncSetAttribute((const void*)mega, hipFuncAttributeMaxDynamicSharedMemorySize, LDS_BYTES);
    int dev = 0, cus = 0, per_cu = 0;
    hipGetDevice(&dev);
    hipDeviceGetAttribute(&cus, hipDeviceAttributeMultiprocessorCount, dev);
    hipOccupancyMaxActiveBlocksPerMultiprocessor(&per_cu, mega, NTHREADS, LDS_BYTES);
    if (per_cu < 1) per_cu = 1;
    grid_blocks = cus * 1;
  }
#ifdef MULTI_LAUNCH
  for (int ph = 0; ph < NPHASE; ++ph) {
    mega<<<dim3(grid_blocks), dim3(NTHREADS), LDS_BYTES, stream>>>(p, ph, ph + 1, 0);
  }
#else
  hipMemsetAsync((char*)d_ws + OFF_BAR, 0, 256, stream);
  int lo = 0, hi = NPHASE, coop = 1;
  void* args[] = {&p, &lo, &hi, &coop};
  hipError_t e = hipLaunchCooperativeKernel((void*)mega, dim3(grid_blocks), dim3(NTHREADS), args, LDS_BYTES, stream);
  if (e != hipSuccess) fprintf(stderr, "cooperative launch failed: %s (grid %d)\n", hipGetErrorString(e), grid_blocks);
#endif
}
```

```cpp
#include <hip/hip_runtime.h>
#include <hip/hip_cooperative_groups.h>
#include <cstdio>
namespace cg = cooperative_groups;

typedef unsigned short u16;
using bf16x8 = __attribute__((ext_vector_type(8))) short;
using bf16x4 = __attribute__((ext_vector_type(4))) short;
using f32x4  = __attribute__((ext_vector_type(4))) float;

#define NTHREADS 512
#define DM 1024
#define NB 8
#define SEQL 4096
#define CTXL 256
#define MLAT 32768
#define MCTX 2048
#define MTOT 34816
#define INW 8208

#define OFF_S    0ull
#define OFF_RG   (OFF_S   + (size_t)MTOT * 4096 * 2)
#define OFF_U    (OFF_RG  + (size_t)MTOT * 2048 * 2)
#define OFF_WT   (OFF_U   + (size_t)MTOT * 1024 * 2)
#define WT_ROWS  11392
#define OFF_GLR  (OFF_WT  + (size_t)WT_ROWS * 1024 * 2)
#define OFF_HCTX (OFF_GLR + (size_t)MTOT * 16 * 4)
#define OFF_MOD  (OFF_HCTX+ (size_t)MCTX * 1024 * 4)
#define OFF_ROT  (OFF_MOD + (size_t)2 * 9 * 3072 * 4)
#define OFF_BAR  (OFF_ROT + (size_t)64 * 32 * 2 * 4)
#define OFF_END  (OFF_BAR + 256)

#define WT_SCAN 0
#define WT_GATE 4224
#define WT_BRR  8320
#define WT_BRG  9344
#define WT_OUT  10368

#define LDS_BYTES 161792
#define SCAN_GB   80896

struct Params {
  const float* x; const float* c; const float* ctx; const float* c_ctx;
  const float* norm_gain; const float* w_ada; const float* b_ada; const float* w_in;
  const float* ret_decay; const float* gla_w_up; const float* gla_b_up;
  const float* ret_norm_gain; const float* gla_norm_gain;
  const float* w_br_ret; const float* w_br_gla; const float* w_out; const float* final_gain;
  float* out; char* ws;
};

__device__ __forceinline__ u16 f2bf(float f) {
  unsigned u = __float_as_uint(f);
  u += 0x7fffu + ((u >> 16) & 1u);
  return (u16)(u >> 16);
}
__device__ __forceinline__ float bf2f(u16 h) { return __uint_as_float(((unsigned)h) << 16); }
__device__ __forceinline__ float sigmoidf_(float x) { return 1.f / (1.f + __expf(-x)); }
__device__ __forceinline__ float siluf_(float x) { return x / (1.f + __expf(-x)); }

__device__ __forceinline__ int opaque_tid() { int t = threadIdx.x; asm volatile("" : "+v"(t)); return t; }

__device__ __forceinline__ float wave_sum(float v) {
#pragma unroll
  for (int o = 32; o > 0; o >>= 1) v += __shfl_xor(v, o, 64);
  return v;
}

__device__ __forceinline__ const float* wt_src(const Params& p, int l, int n, int& ld) {
  if (n < WT_GATE) {
    int tile = n >> 7, cc = n & 127;
    int col;
    if (tile < 8) {
      int d = (cc & 64) | ((cc & 16) << 1) | ((cc & 32) >> 1) | (cc & 15);
      col = tile * 128 + d;
    } else if (tile < 16) col = 1024 + (tile - 8) * 128 + cc;
    else if (tile < 24) col = 3072 + (tile - 16) * 128 + cc;
    else if (tile < 32) col = 4096 + (tile - 24) * 128 + cc;
    else { if (cc >= 16) { ld = 0; return nullptr; } col = 6144 + cc; }
    ld = INW; return p.w_in + (size_t)l * DM * INW + col;
  } else if (n < WT_BRR) {
    int g = n - WT_GATE; int col;
    if (g < 1024) col = 2048 + g;
    else if (g < 2048) col = 5120 + (g - 1024);
    else if (g < 3072) col = 6160 + (g - 2048);
    else col = 7184 + (g - 3072);
    ld = INW; return p.w_in + (size_t)l * DM * INW + col;
  } else if (n < WT_BRG) { ld = DM; return p.w_br_ret + (size_t)l * DM * DM + (n - WT_BRR); }
  else if (n < WT_OUT)   { ld = DM; return p.w_br_gla + (size_t)l * DM * DM + (n - WT_BRG); }
  else                   { ld = DM; return p.w_out    + (size_t)l * DM * DM + (n - WT_OUT); }
}

#define WT_UNITS (178 * 16)
__device__ __forceinline__ void wt_unit(const Params& p, int l, int unit, char* smem) {
  float* tile = (float*)smem;
  int nb = unit >> 4, kb = unit & 15;
  int tid = opaque_tid();
  int n0 = nb * 64, k0 = kb * 64;
  {
    int nl = tid & 63, kq = tid >> 6;
    int ld; const float* src = wt_src(p, l, n0 + nl, ld);
#pragma unroll
    for (int i = 0; i < 8; ++i) {
      int kl = kq + 8 * i;
      float v = src ? src[(size_t)(k0 + kl) * ld] : 0.f;
      tile[kl * 65 + nl] = v;
    }
  }
  __syncthreads();
  {
    int nl = tid >> 3, kq = tid & 7;
    bf16x8 o;
#pragma unroll
    for (int j = 0; j < 8; ++j) o[j] = (short)f2bf(tile[(kq * 8 + j) * 65 + nl]);
    u16* wt = (u16*)(p.ws + OFF_WT);
    *(bf16x8*)(wt + (size_t)(n0 + nl) * 1024 + k0 + kq * 8) = o;
  }
  __syncthreads();
}

__device__ __forceinline__ void mod_unit(const Params& p, int unit, char* smem) {
  float* sc = (float*)smem;
  float* red = sc + 9 * 1024;
  int l = unit / 48, jb = unit % 48;
  int tid = opaque_tid();
  for (int i = tid; i < 9 * 1024; i += NTHREADS) {
    int r = i >> 10, k = i & 1023;
    float v = (r < 8) ? p.c[r * 1024 + k] : p.c_ctx[k];
    sc[i] = siluf_(v);
  }
  __syncthreads();
  int jl = tid & 63, kg = tid >> 6;
  int j = jb * 64 + jl;
  float acc[9];
#pragma unroll
  for (int r = 0; r < 9; ++r) acc[r] = 0.f;
  const float* w = p.w_ada + (size_t)l * DM * 3072 + j;
#pragma unroll 16
  for (int k = kg * 128; k < kg * 128 + 128; ++k) {
    float wv = w[(size_t)k * 3072];
#pragma unroll
    for (int r = 0; r < 9; ++r) acc[r] += sc[r * 1024 + k] * wv;
  }
#pragma unroll
  for (int r = 0; r < 9; ++r) red[(kg * 9 + r) * 64 + jl] = acc[r];
  __syncthreads();
  float* mod = (float*)(p.ws + OFF_MOD);
  for (int i = tid; i < 9 * 64; i += NTHREADS) {
    int r = i >> 6, jj = i & 63;
    float s = 0.f;
#pragma unroll
    for (int g = 0; g < 8; ++g) s += red[(g * 9 + r) * 64 + jj];
    mod[((size_t)l * 9 + r) * 3072 + jb * 64 + jj] = s + p.b_ada[l * 3072 + jb * 64 + jj];
  }
  __syncthreads();
}

__device__ __forceinline__ void rot_unit(const Params& p) {
  float* rot = (float*)(p.ws + OFF_ROT);
  for (int i = opaque_tid(); i < 64 * 32; i += NTHREADS) {
    int pos = i >> 5, f = i & 31;
    float inv = exp2f(-(float)f * (13.287712379549449f / 32.f));
    float ang = (float)pos * inv;
    rot[i * 2] = __cosf(ang);
    rot[i * 2 + 1] = __sinf(ang);
  }
}

__device__ __forceinline__ void phase_u(const Params& p, int l) {
  const int tid = opaque_tid(); int wave = tid >> 6, lane = tid & 63;
  const float* mod = (const float*)(p.ws + OFF_MOD) + (size_t)l * 9 * 3072;
  const float* gain = p.norm_gain + l * DM;
  u16* U = (u16*)(p.ws + OFF_U);
  for (int row = blockIdx.x * 8 + wave; row < MTOT; row += gridDim.x * 8) {
    const float* h; int r;
    if (row < MLAT) { h = (l == 0 ? p.x : p.out) + (size_t)row * DM; r = row >> 12; }
    else { int cr = row - MLAT; h = (l == 0 ? p.ctx : (const float*)(p.ws + OFF_HCTX)) + (size_t)cr * DM; r = 8; }
    float4 v[4]; float ss = 0.f;
#pragma unroll
    for (int i = 0; i < 4; ++i) {
      v[i] = *(const float4*)(h + i * 256 + lane * 4);
      ss += v[i].x * v[i].x + v[i].y * v[i].y + v[i].z * v[i].z + v[i].w * v[i].w;
    }
    ss = wave_sum(ss);
    float rstd = rsqrtf(ss * (1.f / 1024.f) + 1e-6f);
    const float* sh = mod + r * 3072;
#pragma unroll
    for (int i = 0; i < 4; ++i) {
      int cidx = i * 256 + lane * 4;
      float4 g = *(const float4*)(gain + cidx);
      float4 s = *(const float4*)(sh + cidx);
      float4 sc = *(const float4*)(sh + 1024 + cidx);
      bf16x4 o;
      o[0] = (short)f2bf(v[i].x * rstd * g.x * (1.f + sc.x) + s.x);
      o[1] = (short)f2bf(v[i].y * rstd * g.y * (1.f + sc.y) + s.y);
      o[2] = (short)f2bf(v[i].z * rstd * g.z * (1.f + sc.z) + s.z);
      o[3] = (short)f2bf(v[i].w * rstd * g.w * (1.f + sc.w) + s.w);
      *(bf16x4*)(U + (size_t)row * DM + cidx) = o;
    }
  }
}

__device__ __forceinline__ void phase_final(const Params& p) {
  const int tid = opaque_tid(); int wave = tid >> 6, lane = tid & 63;
  for (int row = blockIdx.x * 8 + wave; row < MLAT; row += gridDim.x * 8) {
    float* h = p.out + (size_t)row * DM;
    float4 v[4]; float ss = 0.f;
#pragma unroll
    for (int i = 0; i < 4; ++i) {
      v[i] = *(const float4*)(h + i * 256 + lane * 4);
      ss += v[i].x * v[i].x + v[i].y * v[i].y + v[i].z * v[i].z + v[i].w * v[i].w;
    }
    ss = wave_sum(ss);
    float rstd = rsqrtf(ss * (1.f / 1024.f) + 1e-6f);
#pragma unroll
    for (int i = 0; i < 4; ++i) {
      int cidx = i * 256 + lane * 4;
      float4 g = *(const float4*)(p.final_gain + cidx);
      float4 o;
      o.x = v[i].x * rstd * g.x; o.y = v[i].y * rstd * g.y; o.z = v[i].z * rstd * g.z; o.w = v[i].w * rstd * g.w;
      *(float4*)(h + cidx) = o;
    }
  }
}

__device__ __forceinline__ int lds_byte(int r, int c) {
  int st = (r >> 4) * 2 + (c >> 5), rr = r & 15, cc = c & 31, ob = rr * 64 + cc * 2;
  return st * 1024 + (ob ^ (((ob >> 9) & 1) << 5));
}

__device__ __forceinline__ void stage_half(int tid, const u16* __restrict__ g, size_t ld, int row0, int k0, char* lds_half) {
#pragma unroll
  for (int i = 0; i < 2; ++i) {
    int b = tid * 16 + i * 8192;
    int st = b >> 10, sb = b & 1023, swz = sb ^ (((sb >> 9) & 1) << 5);
    int R = (st >> 1) * 16 + (swz >> 6), C = (st & 1) * 32 + ((swz & 63) >> 1);
    __builtin_amdgcn_global_load_lds((const unsigned*)(g + (size_t)(row0 + R) * ld + k0 + C),
                                     (__attribute__((address_space(3))) unsigned*)(lds_half + b), 16, 0, 0);
  }
}

__device__ __forceinline__ void gemm_mainloop(const u16* __restrict__ A, size_t lda, int row0,
                                              const u16* __restrict__ Bt, size_t ldb, int col0,
                                              int K, char* smem, f32x4 (&acc)[4][4], int tid) {
  const int wid = tid >> 6, lane = tid & 63;
  const int wr = wid >> 1, wc = wid & 1, fr = lane & 15, fq = lane >> 4;
  const int nt = K / 64;
  asm volatile("s_waitcnt vmcnt(0)" ::: "memory");
  __syncthreads();
  stage_half(tid, A, lda, row0, 0, smem);
  stage_half(tid, A, lda, row0 + 128, 0, smem + 16384);
  stage_half(tid, Bt, ldb, col0, 0, smem + 32768);
  stage_half(tid, A, lda, row0, 64, smem + 49152);
  stage_half(tid, A, lda, row0 + 128, 64, smem + 49152 + 16384);
  stage_half(tid, Bt, ldb, col0, 64, smem + 49152 + 32768);
  int cb = 0;
  for (int t = 0; t < nt; ++t) {
    if (t + 1 < nt) asm volatile("s_waitcnt vmcnt(6)" ::: "memory");
    else asm volatile("s_waitcnt vmcnt(0)" ::: "memory");
    __builtin_amdgcn_s_barrier();
    asm volatile("" ::: "memory");
    char* cur = smem + cb * 49152;
    if (t + 2 < nt) {
      int nb = cb + 2; if (nb >= 3) nb -= 3;
      char* nxt = smem + nb * 49152;
      int k0 = (t + 2) * 64;
      stage_half(tid, A, lda, row0, k0, nxt);
      stage_half(tid, A, lda, row0 + 128, k0, nxt + 16384);
      stage_half(tid, Bt, ldb, col0, k0, nxt + 32768);
    }
    const char* sa = cur + (wr >> 1) * 16384;
    const char* sb = cur + 32768;
#pragma unroll
    for (int ks = 0; ks < 2; ++ks) {
      bf16x8 af[4], bfr[4];
#pragma unroll
      for (int m = 0; m < 4; ++m) af[m] = *(const bf16x8*)(sa + lds_byte((wr & 1) * 64 + m * 16 + fr, ks * 32 + fq * 8));
#pragma unroll
      for (int n = 0; n < 4; ++n) bfr[n] = *(const bf16x8*)(sb + lds_byte(wc * 64 + n * 16 + fr, ks * 32 + fq * 8));
#pragma unroll
      for (int m = 0; m < 4; ++m)
#pragma unroll
        for (int n = 0; n < 4; ++n)
          acc[m][n] = __builtin_amdgcn_mfma_f32_16x16x32_bf16(af[m], bfr[n], acc[m][n], 0, 0, 0);
    }
    cb = cb + 1; if (cb >= 3) cb -= 3;
  }
  __syncthreads();
  __builtin_amdgcn_sched_barrier(0);
}

#define ZERO_ACC(a) _Pragma("unroll") for (int _m = 0; _m < 4; ++_m) _Pragma("unroll") for (int _n = 0; _n < 4; ++_n) a[_m][_n] = (f32x4){0.f, 0.f, 0.f, 0.f}

#define EP_STRIDE 68
#define EP_BYTES  (64 * EP_STRIDE * 4)
#define STAT_OFF  159744
__device__ __forceinline__ float* stage_acc(char* smem, int wid, int fr, int fq, const f32x4 (&acc)[4][4]) {
  float* e = (float*)(smem + wid * EP_BYTES);
#pragma unroll
  for (int m = 0; m < 4; ++m)
#pragma unroll
    for (int n = 0; n < 4; ++n)
#pragma unroll
      for (int j = 0; j < 4; ++j) e[(m * 16 + fq * 4 + j) * EP_STRIDE + n * 16 + fr] = acc[m][n][j];
  return e;
}
__device__ __forceinline__ bf16x8 pack8(const float (&v)[8]) {
  bf16x8 o;
#pragma unroll
  for (int x = 0; x < 8; ++x) o[x] = (short)f2bf(v[x]);
  return o;
}
#define LOAD8(dst, ptr) { float4 _a = *(const float4*)(ptr); float4 _b = *(const float4*)((ptr) + 4); \
  dst[0] = _a.x; dst[1] = _a.y; dst[2] = _a.z; dst[3] = _a.w; dst[4] = _b.x; dst[5] = _b.y; dst[6] = _b.z; dst[7] = _b.w; }

__device__ __forceinline__ void gemm_scan_in(const Params& p, int mt, int ntile, char* smem) {
  const int tid = opaque_tid();
  const u16* U = (const u16*)(p.ws + OFF_U);
  const u16* WT = (const u16*)(p.ws + OFF_WT) + (size_t)WT_SCAN * 1024;
  f32x4 acc[4][4]; ZERO_ACC(acc);
  gemm_mainloop(U, 1024, mt * 256, WT, 1024, ntile * 128, 1024, smem, acc, tid);
  const int wid = tid >> 6, lane = tid & 63;
  const int wr = wid >> 1, wc = wid & 1, fr = lane & 15, fq = lane >> 4;
  const float* e = stage_acc(smem, wid, fr, fq, acc);
  const int rr = lane >> 3, c8 = (lane & 7) * 8;
  if (ntile == 32) {
    float* GLRb = (float*)(p.ws + OFF_GLR) + (size_t)mt * 256 * 16;
    if (wc == 0 && c8 < 16) {
#pragma unroll
      for (int i = 0; i < 8; ++i) {
        int r = rr + 8 * i;
        float v[8]; LOAD8(v, e + r * EP_STRIDE + c8);
        float* d = GLRb + (unsigned)(wr * 64 + r) * 16u + c8;
        *(float4*)d = make_float4(v[0], v[1], v[2], v[3]);
        *(float4*)(d + 4) = make_float4(v[4], v[5], v[6], v[7]);
      }
    }
    return;
  }
  u16* Sb = (u16*)(p.ws + OFF_S) + (size_t)mt * 256 * 4096 + ntile * 128 + wc * 64 + c8;
  const bool scaled = (ntile < 4) || (ntile >= 16 && ntile < 20);
  const float scl = scaled ? 0.08838834764831845f : 1.f;
  if (ntile < 8 && mt < 128) {
    const float* rot = (const float*)(p.ws + OFF_ROT);
    const int tbase = (mt & 15) * 256 + wr * 64;
    const int pair = (c8 >> 4) & 1, f0 = ((c8 >> 5) & 1) * 16 + (c8 & 15);
#pragma unroll
    for (int i = 0; i < 8; ++i) {
      int r = rr + 8 * i;
      int t = tbase + r;
      unsigned pos = (wc == 0) ? (t >> 6) : (t & 63);
      float v[8], vp[8], cs[16];
      LOAD8(v, e + r * EP_STRIDE + c8);
      LOAD8(vp, e + r * EP_STRIDE + (c8 ^ 16));
      const float* rp = rot + (pos * 32u + f0) * 2u;
      LOAD8(cs, rp); { float* c2 = cs + 8; LOAD8(c2, rp + 8); }
      float o[8];
#pragma unroll
      for (int x = 0; x < 8; ++x) {
        float c = cs[2 * x], s = cs[2 * x + 1];
        o[x] = (pair == 0 ? (v[x] * c - vp[x] * s) : (v[x] * c + vp[x] * s)) * scl;
      }
      *(bf16x8*)(Sb + (unsigned)(wr * 64 + r) * 4096u) = pack8(o);
    }
  } else {
#pragma unroll
    for (int i = 0; i < 8; ++i) {
      int r = rr + 8 * i;
      float v[8]; LOAD8(v, e + r * EP_STRIDE + c8);
#pragma unroll
      for (int x = 0; x < 8; ++x) v[x] *= scl;
      *(bf16x8*)(Sb + (unsigned)(wr * 64 + r) * 4096u) = pack8(v);
    }
  }
}

__device__ __forceinline__ void gemm_gate(const Params& p, int l, int mt, int ntile, char* smem) {
  const int tid = opaque_tid();
  const u16* U = (const u16*)(p.ws + OFF_U);
  const u16* WT = (const u16*)(p.ws + OFF_WT) + (size_t)WT_GATE * 1024;
  const int wid = tid >> 6, lane = tid & 63;
  const int wr = wid >> 1, wc = wid & 1, fr = lane & 15, fq = lane >> 4;
  float* stat = (float*)(smem + STAT_OFF);
  const bool is_norm = ntile < 16;
  const int branch = ntile >> 3;
  const u16* RGb = (const u16*)(p.ws + OFF_RG) + (size_t)mt * 256 * 2048 + (branch & 1) * 1024;
  if (is_norm) {
    __syncthreads();
    int head = (ntile & 7) >> 1;
    for (int r0 = 0; r0 < 32; r0 += 8) {
      bf16x4 vv[8];
#pragma unroll
      for (int i = 0; i < 8; ++i) vv[i] = *(const bf16x4*)(RGb + (unsigned)(wid * 32 + r0 + i) * 2048u + head * 256 + lane * 4);
#pragma unroll
      for (int i = 0; i < 8; ++i) {
        unsigned rl = wid * 32 + r0 + i;
        float a0 = bf2f((u16)vv[i][0]), a1 = bf2f((u16)vv[i][1]), a2 = bf2f((u16)vv[i][2]), a3 = bf2f((u16)vv[i][3]);
        float s1 = a0 + a1 + a2 + a3, s2 = a0 * a0 + a1 * a1 + a2 * a2 + a3 * a3;
        s1 = wave_sum(s1); s2 = wave_sum(s2);
        float sa, sb;
        if (branch == 0) {
          float mu = s1 * (1.f / 256.f);
          float var = fmaxf(s2 * (1.f / 256.f) - mu * mu, 0.f);
          sa = rsqrtf(var + 1e-6f); sb = -mu * sa;
        } else { sa = rsqrtf(s2 * (1.f / 256.f) + 1e-6f); sb = 0.f; }
        if (lane == 0) { stat[rl * 2] = sa; stat[rl * 2 + 1] = sb; }
      }
    }
  }
  f32x4 acc[4][4]; ZERO_ACC(acc);
  gemm_mainloop(U, 1024, mt * 256, WT, 1024, ntile * 128, 1024, smem, acc, tid);
  const float* e = stage_acc(smem, wid, fr, fq, acc);
  const int rr = lane >> 3, c8 = (lane & 7) * 8;
  u16* Sb = (u16*)(p.ws + OFF_S) + (size_t)mt * 256 * 4096;
  if (is_norm) {
    const float* gain = (branch == 0 ? p.ret_norm_gain : p.gla_norm_gain) + l * 1024;
    const unsigned cin = (ntile & 7) * 128 + wc * 64 + c8;
    float gn[8]; LOAD8(gn, gain + cin);
#pragma unroll
    for (int i = 0; i < 8; ++i) {
      int r = rr + 8 * i;
      unsigned rl = wr * 64 + r;
      float v[8]; LOAD8(v, e + r * EP_STRIDE + c8);
      bf16x8 xr = *(const bf16x8*)(RGb + rl * 2048u + cin);
      float sa = stat[rl * 2], sb = stat[rl * 2 + 1];
      float o[8];
#pragma unroll
      for (int x = 0; x < 8; ++x) o[x] = (bf2f((u16)xr[x]) * sa + sb) * gn[x] * siluf_(v[x]);
      *(bf16x8*)(Sb + rl * 4096u + 2048u + branch * 1024 + cin) = pack8(o);
    }
  } else {
    const unsigned cout = (ntile - 16) * 128 + wc * 64 + c8;
#pragma unroll
    for (int i = 0; i < 8; ++i) {
      int r = rr + 8 * i;
      float v[8]; LOAD8(v, e + r * EP_STRIDE + c8);
#pragma unroll
      for (int x = 0; x < 8; ++x) v[x] = sigmoidf_(v[x]);
      *(bf16x8*)(Sb + (unsigned)(wr * 64 + r) * 4096u + cout) = pack8(v);
    }
  }
}

__device__ __forceinline__ void gemm_merge(const Params& p, int mt, int ntile, char* smem) {
  const int tid = opaque_tid();
  const u16* S = (const u16*)(p.ws + OFF_S);
  const u16* WT = (const u16*)(p.ws + OFF_WT);
  const int wid = tid >> 6, lane = tid & 63;
  const int wr = wid >> 1, wc = wid & 1, fr = lane & 15, fq = lane >> 4;
  const int rr = lane >> 3, c8 = (lane & 7) * 8;
  const unsigned c0 = ntile * 128 + wc * 64 + c8;
  const u16* Sb = S + (size_t)mt * 256 * 4096;
  u16* MGb = (u16*)(p.ws + OFF_U) + (size_t)mt * 256 * 1024;
  f32x4 acc[4][4];
  ZERO_ACC(acc);
  gemm_mainloop(S + 2048, 4096, mt * 256, WT + (size_t)WT_BRR * 1024, 1024, ntile * 128, 1024, smem, acc, tid);
  {
    const float* e = stage_acc(smem, wid, fr, fq, acc);
#pragma unroll
    for (int i = 0; i < 8; ++i) {
      int r = rr + 8 * i;
      unsigned rl = wr * 64 + r;
      float v[8]; LOAD8(v, e + r * EP_STRIDE + c8);
      bf16x8 ma = *(const bf16x8*)(Sb + rl * 4096u + c0);
#pragma unroll
      for (int x = 0; x < 8; ++x) v[x] *= bf2f((u16)ma[x]);
      *(bf16x8*)(MGb + rl * 1024u + c0) = pack8(v);
    }
  }
  __builtin_amdgcn_sched_barrier(0);
  ZERO_ACC(acc);
  gemm_mainloop(S + 3072, 4096, mt * 256, WT + (size_t)WT_BRG * 1024, 1024, ntile * 128, 1024, smem, acc, tid);
  {
    const float* e = stage_acc(smem, wid, fr, fq, acc);
#pragma unroll
    for (int i = 0; i < 8; ++i) {
      int r = rr + 8 * i;
      unsigned rl = wr * 64 + r;
      float v[8]; LOAD8(v, e + r * EP_STRIDE + c8);
      bf16x8 mb = *(const bf16x8*)(Sb + rl * 4096u + 1024u + c0);
      bf16x8 t0 = *(const bf16x8*)(MGb + rl * 1024u + c0);
#pragma unroll
      for (int x = 0; x < 8; ++x) v[x] = bf2f((u16)t0[x]) + v[x] * bf2f((u16)mb[x]);
      *(bf16x8*)(MGb + rl * 1024u + c0) = pack8(v);
    }
  }
}

__device__ __forceinline__ void gemm_out(const Params& p, int l, int mt, int ntile, char* smem) {
  const int tid = opaque_tid();
  const u16* MG = (const u16*)(p.ws + OFF_U);
  const u16* WT = (const u16*)(p.ws + OFF_WT) + (size_t)WT_OUT * 1024;
  const int wid = tid >> 6, lane = tid & 63;
  const int wr = wid >> 1, wc = wid & 1, fr = lane & 15, fq = lane >> 4;
  const int rr = lane >> 3, c8 = (lane & 7) * 8;
  const unsigned c0 = ntile * 128 + wc * 64 + c8;
  f32x4 acc[4][4]; ZERO_ACC(acc);
  gemm_mainloop(MG, 1024, mt * 256, WT, 1024, ntile * 128, 1024, smem, acc, tid);
  const float* e = stage_acc(smem, wid, fr, fq, acc);
  const float* hin; float* hout; int rmod;
  if (mt < 128) { hin = (l == 0 ? p.x : p.out) + (size_t)mt * 256 * DM; hout = p.out + (size_t)mt * 256 * DM; rmod = mt >> 4; }
  else { hin = p.ctx + (size_t)(mt - 128) * 256 * DM; hout = (float*)(p.ws + OFF_HCTX) + (size_t)(mt - 128) * 256 * DM; rmod = 8; }
  const float* gate = (const float*)(p.ws + OFF_MOD) + (size_t)l * 9 * 3072 + rmod * 3072 + 2048;
  float gt8[8]; LOAD8(gt8, gate + c0);
#pragma unroll
  for (int i = 0; i < 8; ++i) {
    int r = rr + 8 * i;
    unsigned o = (unsigned)(wr * 64 + r) * 1024u + c0;
    float v[8], hv[8];
    LOAD8(v, e + r * EP_STRIDE + c8);
    LOAD8(hv, hin + o);
    *(float4*)(hout + o) = make_float4(hv[0] + gt8[0] * v[0], hv[1] + gt8[1] * v[1], hv[2] + gt8[2] * v[2], hv[3] + gt8[3] * v[3]);
    *(float4*)(hout + o + 4) = make_float4(hv[4] + gt8[4] * v[4], hv[5] + gt8[5] * v[5], hv[6] + gt8[6] * v[6], hv[7] + gt8[7] * v[7]);
  }
}

#define OFF_VECS OFF_WT
__device__ __forceinline__ float logsig16(float x) { return (fminf(x, 0.f) - __logf(1.f + __expf(-fabsf(x)))) * (1.f / 16.f); }

__device__ __forceinline__ void gla_prepass_unit(const Params& p, int l, int unit, char* smem) {
  const int tid = opaque_tid();
  const int b = unit / 68, cid = unit % 68;
  const int base = cid < 4 ? (MLAT + b * 256 + cid * 64) : (b * 4096 + (cid - 4) * 64);
  float* GLRS = (float*)smem;
  __syncthreads();
  if (tid < 256) {
    const float* GLR = (const float*)(p.ws + OFF_GLR) + (size_t)base * 16;
    *(float4*)(GLRS + tid * 4) = *(const float4*)(GLR + tid * 4);
  }
  float wf[16], wb[16];
  {
    const float* w0 = p.gla_w_up + (size_t)(l * 2 + 0) * 16 * 512 + tid;
    const float* w1 = p.gla_w_up + (size_t)(l * 2 + 1) * 16 * 512 + tid;
#pragma unroll
    for (int r = 0; r < 16; ++r) { wf[r] = w0[r * 512]; wb[r] = w1[r * 512]; }
  }
  const float bf_ = p.gla_b_up[(l * 2 + 0) * 512 + tid], bb_ = p.gla_b_up[(l * 2 + 1) * 512 + tid];
  __syncthreads();
  u16* Sq = (u16*)(p.ws + OFF_S) + (size_t)base * 4096 + 2048 + tid;
  u16* Ub = (u16*)(p.ws + OFF_U) + (size_t)base * 1024 + tid;
  float accF = 0.f, accB = 0.f;
#pragma unroll 8
  for (int u = 0; u < 32; ++u) {
    const int i = 31 - u;
    const float4* gr = (const float4*)(GLRS + i * 16);
    float4 g0 = gr[0], g1 = gr[1], g2 = gr[2], g3 = gr[3];
    float xf = bf_, xb = bb_;
    xf += g0.x * wf[0] + g0.y * wf[1] + g0.z * wf[2] + g0.w * wf[3] + g1.x * wf[4] + g1.y * wf[5] + g1.z * wf[6] + g1.w * wf[7]
        + g2.x * wf[8] + g2.y * wf[9] + g2.z * wf[10] + g2.w * wf[11] + g3.x * wf[12] + g3.y * wf[13] + g3.z * wf[14] + g3.w * wf[15];
    xb += g0.x * wb[0] + g0.y * wb[1] + g0.z * wb[2] + g0.w * wb[3] + g1.x * wb[4] + g1.y * wb[5] + g1.z * wb[6] + g1.w * wb[7]
        + g2.x * wb[8] + g2.y * wb[9] + g2.z * wb[10] + g2.w * wb[11] + g3.x * wb[12] + g3.y * wb[13] + g3.z * wb[14] + g3.w * wb[15];
    const float laf = logsig16(xf), lab = logsig16(xb);
    const float relf = -accF; accF += laf;
    accB += lab; const float relb = accB;
    const float q = bf2f(Sq[(unsigned)i * 4096u]), k = bf2f(Sq[(unsigned)i * 4096u + 512u]);
    Sq[(unsigned)i * 4096u] = f2bf(q * __expf(relf));
    Sq[(unsigned)i * 4096u + 512u] = f2bf(k * __expf(-relf));
    Ub[(unsigned)i * 1024u] = f2bf(q * __expf(relb));
    Ub[(unsigned)i * 1024u + 512u] = f2bf(k * __expf(-relb));
  }
  float accF2 = 0.f, accB2 = 0.f;
#pragma unroll 8
  for (int u = 0; u < 32; ++u) {
    const int i = 32 + u;
    const float4* gr = (const float4*)(GLRS + i * 16);
    float4 g0 = gr[0], g1 = gr[1], g2 = gr[2], g3 = gr[3];
    float xf = bf_, xb = bb_;
    xf += g0.x * wf[0] + g0.y * wf[1] + g0.z * wf[2] + g0.w * wf[3] + g1.x * wf[4] + g1.y * wf[5] + g1.z * wf[6] + g1.w * wf[7]
        + g2.x * wf[8] + g2.y * wf[9] + g2.z * wf[10] + g2.w * wf[11] + g3.x * wf[12] + g3.y * wf[13] + g3.z * wf[14] + g3.w * wf[15];
    xb += g0.x * wb[0] + g0.y * wb[1] + g0.z * wb[2] + g0.w * wb[3] + g1.x * wb[4] + g1.y * wb[5] + g1.z * wb[6] + g1.w * wb[7]
        + g2.x * wb[8] + g2.y * wb[9] + g2.z * wb[10] + g2.w * wb[11] + g3.x * wb[12] + g3.y * wb[13] + g3.z * wb[14] + g3.w * wb[15];
    const float laf = logsig16(xf), lab = logsig16(xb);
    accF2 += laf; const float relf = accF2;
    const float relb = -accB2; accB2 += lab;
    const float q = bf2f(Sq[(unsigned)i * 4096u]), k = bf2f(Sq[(unsigned)i * 4096u + 512u]);
    Sq[(unsigned)i * 4096u] = f2bf(q * __expf(relf));
    Sq[(unsigned)i * 4096u + 512u] = f2bf(k * __expf(-relf));
    Ub[(unsigned)i * 1024u] = f2bf(q * __expf(relb));
    Ub[(unsigned)i * 1024u + 512u] = f2bf(k * __expf(-relb));
  }
  float* V0 = (float*)(p.ws + OFF_VECS) + ((size_t)(0 * 544 + b * 68 + cid) * 2) * 512 + tid;
  float* V1 = (float*)(p.ws + OFF_VECS) + ((size_t)(1 * 544 + b * 68 + cid) * 2) * 512 + tid;
  V0[0] = __expf(accF);  V0[512] = __expf(accF2);
  V1[0] = __expf(accB2); V1[512] = __expf(accB);
}

#define L_QR   0
#define L_KR   17408
#define L_V    34816
#define L_SGT  44032
#define L_P    61440
#undef  SCAN_GB
#define SCAN_GB 70656

__device__ __forceinline__ int off128(int row, int col) { return row * 272 + col * 2; }
__device__ __forceinline__ int off64(int row, int col) { return row * 144 + col * 2; }

template <int RS>
__device__ __forceinline__ bf16x8 tr_frag(unsigned img_addr, int r0, int c0, int lane) {
  const int g = lane >> 4, q = (lane & 15) >> 2, pp = lane & 3;
  unsigned a = img_addr + (unsigned)((r0 + 8 * g + q) * RS + (c0 + 4 * pp) * 2);
  bf16x4 lo, hi;
  asm volatile("ds_read_b64_tr_b16 %0, %2\n\tds_read_b64_tr_b16 %1, %2 offset:%3\n\ts_waitcnt lgkmcnt(0)"
               : "=&v"(lo), "=&v"(hi) : "v"(a), "n"(4 * RS) : "memory");
  bf16x8 r;
  r[0] = lo[0]; r[1] = lo[1]; r[2] = lo[2]; r[3] = lo[3]; r[4] = hi[0]; r[5] = hi[1]; r[6] = hi[2]; r[7] = hi[3];
  return r;
}

__device__ __forceinline__ bf16x8 scale8(bf16x8 v, float f) {
  bf16x8 o;
#pragma unroll
  for (int x = 0; x < 8; ++x) o[x] = (short)f2bf(bf2f((u16)v[x]) * f);
  return o;
}

__device__ __forceinline__ void lds_barrier() { asm volatile("s_waitcnt lgkmcnt(0)" ::: "memory"); __builtin_amdgcn_s_barrier(); asm volatile("" ::: "memory"); }

template <int branch>
__device__ __forceinline__ void scan_item(const Params& p, int l, int item, char* smem) {
  const int b = (item >> 4) & 7, h = (item >> 2) & 3, slice = item & 3;
  const int tid = opaque_tid(), wid = __builtin_amdgcn_readfirstlane(tid >> 6), lane = tid & 63;
  const int dir = wid >> 2, gw = wid & 3, gt = tid & 255;
  const int fr = lane & 15, fq = lane >> 4;
  char* G = smem + dir * SCAN_GB;
  const unsigned Ga = (unsigned)(size_t)G;
  const u16* S = (const u16*)(p.ws + OFF_S);
  u16* RG = (u16*)(p.ws + OFF_RG);
  const u16* qsrc; unsigned qstride;
  if (branch == 0) { qsrc = S + h * 128; qstride = 4096; }
  else if (dir == 0) { qsrc = S + 2048 + h * 128; qstride = 4096; }
  else { qsrc = (const u16*)(p.ws + OFF_U) + h * 128; qstride = 1024; }
  const int voff = branch * 2048 + 1024 + h * 256 + slice * 64;
  const int ooff = branch * 1024 + h * 256 + slice * 64;
  float lg = 0.f, egc = 1.f;
  if (branch == 0) { lg = __logf(1.f - __expf(p.ret_decay[(l * 2 + dir) * 4 + h])); egc = __expf(32.f * lg); }
  const float* VECS = (const float*)(p.ws + OFF_VECS) + ((size_t)(dir * 544 + b * 68) * 2) * 512 + h * 128;
  f32x4 st[2][4];
#pragma unroll
  for (int m = 0; m < 2; ++m)
#pragma unroll
    for (int n = 0; n < 4; ++n) st[m][n] = (f32x4){0.f, 0.f, 0.f, 0.f};

  const int qj = gt >> 4, qc = gt & 15;
  const int vj = gt >> 3, vc = gt & 7;
  bf16x8 pq[4], pk[4], pv[2];
  float4 peg[2], pel[2];
  auto prefetch = [&](int s) {
    int base, cid;
    if (s < 4) { int cc = dir ? 3 - s : s; base = MLAT + b * 256 + cc * 64; cid = cc; }
    else { int c = s - 4; int cc = dir ? 63 - c : c; base = b * 4096 + cc * 64; cid = 4 + cc; }
#pragma unroll
    for (int i = 0; i < 4; ++i) {
      int jp = qj + 16 * i;
      unsigned ro = (unsigned)(base + (dir ? 63 - jp : jp)) * qstride + qc * 8;
      pq[i] = *(const bf16x8*)(qsrc + ro);
      pk[i] = *(const bf16x8*)(qsrc + ro + 512);
    }
#pragma unroll
    for (int i = 0; i < 2; ++i) {
      int jp = vj + 32 * i;
      pv[i] = *(const bf16x8*)(S + (size_t)(base + (dir ? 63 - jp : jp)) * 4096 + voff + vc * 8);
    }
    if (branch == 1) {
#pragma unroll
      for (int m = 0; m < 2; ++m) {
        int d0 = gw * 32 + m * 16 + fq * 4;
        peg[m] = *(const float4*)(VECS + (size_t)cid * 1024 + d0);
        pel[m] = *(const float4*)(VECS + (size_t)cid * 1024 + 512 + d0);
      }
    }
  };
  prefetch(0);
  __syncthreads();

  for (int s = 0; s < 68; ++s) {
    int base; bool first; bool wout;
    if (s < 4) { int cc = dir ? 3 - s : s; base = MLAT + b * 256 + cc * 64; first = s < 2; wout = (l == 0); }
    else { int c = s - 4; int cc = dir ? 63 - c : c; base = b * 4096 + cc * 64; first = c < 32; wout = true; }
    float4 eg[2], el[2];
#pragma unroll
    for (int m = 0; m < 2; ++m) {
      if (branch == 1) { eg[m] = peg[m]; el[m] = pel[m]; }
      else { eg[m] = make_float4(egc, egc, egc, egc); el[m] = eg[m]; }
    }
#pragma unroll
    for (int i = 0; i < 4; ++i) {
      int jp = qj + 16 * i;
      bf16x8 qv = pq[i], kv_ = pk[i];
      if (branch == 0) {
        float fqs = __expf((float)(jp - 31) * lg), fks = __expf((float)(31 - jp) * lg);
        qv = scale8(qv, fqs); kv_ = scale8(kv_, fks);
      }
      *(bf16x8*)(G + L_QR + off128(jp, qc * 8)) = qv;
      *(bf16x8*)(G + L_KR + off128(jp, qc * 8)) = kv_;
    }
#pragma unroll
    for (int i = 0; i < 2; ++i) *(bf16x8*)(G + L_V + off64(vj + 32 * i, vc * 8)) = pv[i];
#pragma unroll
    for (int m = 0; m < 2; ++m) {
      int d0 = gw * 32 + m * 16 + fq * 4;
#pragma unroll
      for (int n = 0; n < 4; ++n) {
        int e = n * 16 + fr;
        bf16x4 o4;
        o4[0] = (short)f2bf(st[m][n][0] * eg[m].x); o4[1] = (short)f2bf(st[m][n][1] * eg[m].y);
        o4[2] = (short)f2bf(st[m][n][2] * eg[m].z); o4[3] = (short)f2bf(st[m][n][3] * eg[m].w);
        *(bf16x4*)(G + L_SGT + off128(e, d0)) = o4;
      }
    }
    u16 oldv[4][4];
    u16* dstb = RG + (size_t)base * 2048 + ooff + fr;
    if (wout && !first) {
#pragma unroll
      for (int r = 0; r < 4; ++r) {
        int ip = gw * 16 + fq * 4 + r;
        unsigned ro = (unsigned)(dir ? 63 - ip : ip) * 2048u;
#pragma unroll
        for (int n = 0; n < 4; ++n) oldv[r][n] = dstb[ro + n * 16];
      }
    }
    if (s + 1 < 68) prefetch(s + 1);
    lds_barrier();
    f32x4 pt[4], o[4];
#pragma unroll
    for (int n = 0; n < 4; ++n) { pt[n] = (f32x4){0.f, 0.f, 0.f, 0.f}; o[n] = (f32x4){0.f, 0.f, 0.f, 0.f}; }
#pragma unroll
    for (int ks = 0; ks < 4; ++ks) {
      int kc = ks * 32 + fq * 8;
      bf16x8 ka = *(const bf16x8*)(G + L_KR + off128(gw * 16 + fr, kc));
      bf16x8 qa = *(const bf16x8*)(G + L_QR + off128(gw * 16 + fr, kc));
#pragma unroll
      for (int n = 0; n < 4; ++n) {
        bf16x8 qb = *(const bf16x8*)(G + L_QR + off128(n * 16 + fr, kc));
        bf16x8 sb = *(const bf16x8*)(G + L_SGT + off128(n * 16 + fr, kc));
        pt[n] = __builtin_amdgcn_mfma_f32_16x16x32_bf16(ka, qb, pt[n], 0, 0, 0);
        o[n] = __builtin_amdgcn_mfma_f32_16x16x32_bf16(qa, sb, o[n], 0, 0, 0);
      }
    }
#pragma unroll
    for (int n = 0; n < 4; ++n) {
      int ip = n * 16 + fr;
      int j0 = gw * 16 + fq * 4;
      bf16x4 w;
#pragma unroll
      for (int r = 0; r < 4; ++r) {
        int jp = j0 + r;
        bool keep = dir ? (ip > jp) : (ip >= jp);
        w[r] = (short)f2bf(keep ? pt[n][r] : 0.f);
      }
      *(bf16x4*)(G + L_P + off64(ip, j0)) = w;
    }
    lds_barrier();
    {
      const int tg = lane >> 4, tq = (lane & 15) >> 2, tp = lane & 3;
      const unsigned ka0 = Ga + L_KR + (unsigned)((8 * tg + tq) * 272 + (gw * 32 + 4 * tp) * 2);
      const unsigned va0 = Ga + L_V + (unsigned)((8 * tg + tq) * 144 + (4 * tp) * 2);
#pragma unroll
      for (int m = 0; m < 2; ++m) {
        f32x4 kv[4];
#pragma unroll
        for (int n = 0; n < 4; ++n) kv[n] = (f32x4){0.f, 0.f, 0.f, 0.f};
#pragma unroll
        for (int ks = 0; ks < 2; ++ks) {
          int kc = ks * 32 + fq * 8;
          bf16x4 r0, r1, r2, r3, r4, r5, r6, r7, r8, r9;
          asm volatile(
              "ds_read_b64_tr_b16 %0, %10\n\tds_read_b64_tr_b16 %1, %10 offset:1088\n\t"
              "ds_read_b64_tr_b16 %2, %11\n\tds_read_b64_tr_b16 %3, %11 offset:576\n\t"
              "ds_read_b64_tr_b16 %4, %11 offset:32\n\tds_read_b64_tr_b16 %5, %11 offset:608\n\t"
              "ds_read_b64_tr_b16 %6, %11 offset:64\n\tds_read_b64_tr_b16 %7, %11 offset:640\n\t"
              "ds_read_b64_tr_b16 %8, %11 offset:96\n\tds_read_b64_tr_b16 %9, %11 offset:672\n\t"
              "s_waitcnt lgkmcnt(0)"
              : "=&v"(r0), "=&v"(r1), "=&v"(r2), "=&v"(r3), "=&v"(r4), "=&v"(r5), "=&v"(r6), "=&v"(r7), "=&v"(r8), "=&v"(r9)
              : "v"(ka0 + (unsigned)(ks * 32 * 272 + m * 32)), "v"(va0 + (unsigned)(ks * 32 * 144))
              : "memory");
          bf16x8 km = __builtin_shufflevector(r0, r1, 0, 1, 2, 3, 4, 5, 6, 7);
          bf16x8 vb[4];
          vb[0] = __builtin_shufflevector(r2, r3, 0, 1, 2, 3, 4, 5, 6, 7);
          vb[1] = __builtin_shufflevector(r4, r5, 0, 1, 2, 3, 4, 5, 6, 7);
          vb[2] = __builtin_shufflevector(r6, r7, 0, 1, 2, 3, 4, 5, 6, 7);
          vb[3] = __builtin_shufflevector(r8, r9, 0, 1, 2, 3, 4, 5, 6, 7);
          bf16x8 pa;
          if (m == 0) pa = *(const bf16x8*)(G + L_P + off64(gw * 16 + fr, kc));
#pragma unroll
          for (int n = 0; n < 4; ++n) {
            if (m == 0) o[n] = __builtin_amdgcn_mfma_f32_16x16x32_bf16(pa, vb[n], o[n], 0, 0, 0);
            kv[n] = __builtin_amdgcn_mfma_f32_16x16x32_bf16(km, vb[n], kv[n], 0, 0, 0);
          }
        }
#pragma unroll
        for (int n = 0; n < 4; ++n) {
          st[m][n][0] = eg[m].x * el[m].x * st[m][n][0] + el[m].x * kv[n][0];
          st[m][n][1] = eg[m].y * el[m].y * st[m][n][1] + el[m].y * kv[n][1];
          st[m][n][2] = eg[m].z * el[m].z * st[m][n][2] + el[m].z * kv[n][2];
          st[m][n][3] = eg[m].w * el[m].w * st[m][n][3] + el[m].w * kv[n][3];
        }
      }
    }
    if (wout) {
#pragma unroll
      for (int r = 0; r < 4; ++r) {
        int ip = gw * 16 + fq * 4 + r;
        unsigned ro = (unsigned)(dir ? 63 - ip : ip) * 2048u;
#pragma unroll
        for (int n = 0; n < 4; ++n) {
          float v = o[n][r];
          if (!first) v += bf2f(oldv[r][n]);
          dstb[ro + n * 16] = f2bf(v);
        }
      }
    }
    __syncthreads();
  }
}

#define NPHASE 18
__device__ __forceinline__ void run_phase(const Params& p, int ph, char* smem) {
  const int nblk = gridDim.x, bid = blockIdx.x;
  if (ph == 0) {
#ifdef REP_P0
    for (int rep = 0; rep < REP_P0; ++rep)
#endif
    for (int u = bid; u < WT_UNITS + 96 + 1; u += nblk) {
      if (u < 96) mod_unit(p, u, smem);
      else if (u == 96) rot_unit(p);
      else wt_unit(p, 0, u - 97, smem);
    }
    return;
  }
  if (ph == NPHASE - 1) { phase_final(p); return; }
  const int l = (ph - 1) / 8, sp = (ph - 1) % 8;
  switch (sp) {
    case 0:
      phase_u(p, l);
      if (l == 1) for (int u = bid; u < WT_UNITS; u += nblk) wt_unit(p, 1, u, smem);
      break;
    case 1:
#ifdef REP_G1
      for (int rep = 0; rep < REP_G1; ++rep)
#endif
      {
        const int x = bid & 7, per = (nblk - x + 7) >> 3;
        for (int q = bid >> 3; q < 561; q += per) {
          int k = q / 33, r = q - k * 33;
          int mt = (r == 32) ? 8 * k + x : 8 * k + (r >> 2);
          int nt = (r == 32) ? 32 : x + 8 * (r & 3);
          gemm_scan_in(p, mt, nt, smem);
        }
      }
      break;
    case 2: for (int t = bid; t < 544; t += nblk) gla_prepass_unit(p, l, t, smem); break;
    case 3:
#ifdef REP_SCAN
      for (int rep = 0; rep < REP_SCAN; ++rep)
#endif
      for (int t = bid; t < 256; t += nblk) { if (t < 128) scan_item<0>(p, l, t, smem); else scan_item<1>(p, l, t, smem); } break;
    case 4:
#ifdef REP_U
      for (int rep = 0; rep < REP_U; ++rep)
#endif
      phase_u(p, l); break;
    case 5: { int MT = l == 0 ? 136 : 128;
#ifdef REP_G2
      for (int rep = 0; rep < REP_G2; ++rep)
#endif
      {
        const int x = bid & 7, per = (nblk - x + 7) >> 3;
        for (int q = bid >> 3; q < MT * 4; q += per) gemm_gate(p, l, q >> 2, x + 8 * (q & 3), smem);
      } } break;
    case 6: { int MT = l == 0 ? 136 : 128;
#ifdef REP_G3
      for (int rep = 0; rep < REP_G3; ++rep)
#endif
      {
        const int x = bid & 7, per = (nblk - x + 7) >> 3;
        for (int q = bid >> 3; q < MT; q += per) gemm_merge(p, x + 8 * (q >> 3), q & 7, smem);
      } } break;
    case 7: { int MT = l == 0 ? 136 : 128;
      {
        const int x = bid & 7, per = (nblk - x + 7) >> 3;
        for (int q = bid >> 3; q < MT; q += per) gemm_out(p, l, x + 8 * (q >> 3), q & 7, smem);
      } } break;
  }
}

__device__ __forceinline__ void grid_barrier(unsigned* cnt, unsigned target) {
  asm volatile("s_waitcnt vmcnt(0)" ::: "memory");
  __syncthreads();
  if (threadIdx.x == 0) {
    __threadfence();
    __hip_atomic_fetch_add(cnt, 1u, __ATOMIC_RELAXED, __HIP_MEMORY_SCOPE_AGENT);
    while (__hip_atomic_load(cnt, __ATOMIC_RELAXED, __HIP_MEMORY_SCOPE_AGENT) < target) __builtin_amdgcn_s_sleep(2);
    __threadfence();
  }
  __syncthreads();
}

__global__ void __launch_bounds__(NTHREADS) mega(Params p, int ph_lo, int ph_hi, int coop) {
  extern __shared__ __attribute__((aligned(16))) char smem[];
  for (int ph = ph_lo; ph < ph_hi; ++ph) {
    run_phase(p, ph, smem);
    if (coop && ph + 1 < ph_hi) {
      if (ph == ph_lo) cg::this_grid().sync();
      else grid_barrier((unsigned*)(p.ws + OFF_BAR), (unsigned)(ph - ph_lo) * gridDim.x);
    }
  }
}

extern "C" void kernel_launch(void* const* d_in, const int* in_sizes, int n_in,
                              void* d_out, int out_size, void* d_ws, size_t ws_size,
                              hipStream_t stream) {
  Params p{};
  p.x = (const float*)d_in[0]; p.c = (const float*)d_in[1]; p.ctx = (const float*)d_in[2]; p.c_ctx = (const float*)d_in[3];
  p.norm_gain = (const float*)d_in[4]; p.w_ada = (const float*)d_in[5]; p.b_ada = (const float*)d_in[6]; p.w_in = (const float*)d_in[7];
  p.ret_decay = (const float*)d_in[8]; p.gla_w_up = (const float*)d_in[9]; p.gla_b_up = (const float*)d_in[10];
  p.ret_norm_gain = (const float*)d_in[11]; p.gla_norm_gain = (const float*)d_in[12];
  p.w_br_ret = (const float*)d_in[13]; p.w_br_gla = (const float*)d_in[14]; p.w_out = (const float*)d_in[15]; p.final_gain = (const float*)d_in[16];
  p.out = (float*)d_out; p.ws = (char*)d_ws;
  static int grid_blocks = 0;
  if (!grid_blocks) {
    hipFuncSetAttribute((const void*)mega, hipFuncAttributeMaxDynamicSharedMemorySize, LDS_BYTES);
    int dev = 0, cus = 0, per_cu = 0;
    hipGetDevice(&dev);
    hipDeviceGetAttribute(&cus, hipDeviceAttributeMultiprocessorCount, dev);
    hipOccupancyMaxActiveBlocksPerMultiprocessor(&per_cu, mega, NTHREADS, LDS_BYTES);
    if (per_cu < 1) per_cu = 1;
    grid_blocks = cus * 1;
  }
#ifdef MULTI_LAUNCH
  for (int ph = 0; ph < NPHASE; ++ph) {
    mega<<<dim3(grid_blocks), dim3(NTHREADS), LDS_BYTES, stream>>>(p, ph, ph + 1, 0);
  }
#else
  hipMemsetAsync((char*)d_ws + OFF_BAR, 0, 256, stream);
  int lo = 0, hi = NPHASE, coop = 1;
  void* args[] = {&p, &lo, &hi, &coop};
  hipError_t e = hipLaunchCooperativeKernel((void*)mega, dim3(grid_blocks), dim3(NTHREADS), args, LDS_BYTES, stream);
  if (e != hipSuccess) fprintf(stderr, "cooperative launch failed: %s (grid %d)\n", hipGetErrorString(e), grid_blocks);
#endif
}
```

```cpp
#include <hip/hip_runtime.h>
#include <hip/hip_cooperative_groups.h>
#include <cstdio>
namespace cg = cooperative_groups;

typedef unsigned short u16;
using bf16x8 = __attribute__((ext_vector_type(8))) short;
using bf16x4 = __attribute__((ext_vector_type(4))) short;
using f32x4  = __attribute__((ext_vector_type(4))) float;

#define NTHREADS 512
#define DM 1024
#define NB 8
#define SEQL 4096
#define CTXL 256
#define MLAT 32768
#define MCTX 2048
#define MTOT 34816
#define INW 8208

#define OFF_S    0ull
#define OFF_RG   (OFF_S   + (size_t)MTOT * 4096 * 2)
#define OFF_U    (OFF_RG  + (size_t)MTOT * 2048 * 2)
#define OFF_WT   (OFF_U   + (size_t)MTOT * 1024 * 2)
#define WT_ROWS  11392
#define OFF_GLR  (OFF_WT  + (size_t)WT_ROWS * 1024 * 2)
#define OFF_HCTX (OFF_GLR + (size_t)MTOT * 16 * 4)
#define OFF_MOD  (OFF_HCTX+ (size_t)MCTX * 1024 * 4)
#define OFF_ROT  (OFF_MOD + (size_t)2 * 9 * 3072 * 4)
#define OFF_BAR  (OFF_ROT + (size_t)64 * 32 * 2 * 4)
#define OFF_END  (OFF_BAR + 256)

#define WT_SCAN 0
#define WT_GATE 4224
#define WT_BRR  8320
#define WT_BRG  9344
#define WT_OUT  10368

#define LDS_BYTES 161792
#define SCAN_GB   80896

struct Params {
  const float* x; const float* c; const float* ctx; const float* c_ctx;
  const float* norm_gain; const float* w_ada; const float* b_ada; const float* w_in;
  const float* ret_decay; const float* gla_w_up; const float* gla_b_up;
  const float* ret_norm_gain; const float* gla_norm_gain;
  const float* w_br_ret; const float* w_br_gla; const float* w_out; const float* final_gain;
  float* out; char* ws;
};

__device__ __forceinline__ u16 f2bf(float f) {
  __bf16 h = (__bf16)f;
  return *(u16*)&h;
}
__device__ __forceinline__ float bf2f(u16 h) { return __uint_as_float(((unsigned)h) << 16); }
__device__ __forceinline__ float sigmoidf_(float x) { return 1.f / (1.f + __expf(-x)); }
__device__ __forceinline__ float siluf_(float x) { return x / (1.f + __expf(-x)); }

__device__ __forceinline__ int opaque_tid() { int t = threadIdx.x; asm volatile("" : "+v"(t)); return t; }

__device__ __forceinline__ float wave_sum(float v) {
#pragma unroll
  for (int o = 32; o > 0; o >>= 1) v += __shfl_xor(v, o, 64);
  return v;
}

__device__ __forceinline__ const float* wt_src(const Params& p, int l, int n, int& ld) {
  if (n < WT_GATE) {
    int tile = n >> 7, cc = n & 127;
    int col;
    if (tile < 8) {
      int d = (cc & 64) | ((cc & 16) << 1) | ((cc & 32) >> 1) | (cc & 15);
      col = tile * 128 + d;
    } else if (tile < 16) col = 1024 + (tile - 8) * 128 + cc;
    else if (tile < 24) col = 3072 + (tile - 16) * 128 + cc;
    else if (tile < 32) col = 4096 + (tile - 24) * 128 + cc;
    else { if (cc >= 16) { ld = 0; return nullptr; } col = 6144 + cc; }
    ld = INW; return p.w_in + (size_t)l * DM * INW + col;
  } else if (n < WT_BRR) {
    int g = n - WT_GATE; int col;
    if (g < 1024) col = 2048 + g;
    else if (g < 2048) col = 5120 + (g - 1024);
    else if (g < 3072) col = 6160 + (g - 2048);
    else col = 7184 + (g - 3072);
    ld = INW; return p.w_in + (size_t)l * DM * INW + col;
  } else if (n < WT_BRG) { ld = DM; return p.w_br_ret + (size_t)l * DM * DM + (n - WT_BRR); }
  else if (n < WT_OUT)   { ld = DM; return p.w_br_gla + (size_t)l * DM * DM + (n - WT_BRG); }
  else                   { ld = DM; return p.w_out    + (size_t)l * DM * DM + (n - WT_OUT); }
}

#define WT_UNITS (178 * 16)
__device__ __forceinline__ void wt_unit(const Params& p, int l, int unit, char* smem) {
  float* tile = (float*)smem;
  int nb = unit >> 4, kb = unit & 15;
  int tid = opaque_tid();
  int n0 = nb * 64, k0 = kb * 64;
  {
    int nl = tid & 63, kq = tid >> 6;
    int ld; const float* src = wt_src(p, l, n0 + nl, ld);
#pragma unroll
    for (int i = 0; i < 8; ++i) {
      int kl = kq + 8 * i;
      float v = src ? src[(size_t)(k0 + kl) * ld] : 0.f;
      tile[kl * 65 + nl] = v;
    }
  }
  __syncthreads();
  {
    int nl = tid >> 3, kq = tid & 7;
    bf16x8 o;
#pragma unroll
    for (int j = 0; j < 8; ++j) o[j] = (short)f2bf(tile[(kq * 8 + j) * 65 + nl]);
    u16* wt = (u16*)(p.ws + OFF_WT);
    *(bf16x8*)(wt + (size_t)(n0 + nl) * 1024 + k0 + kq * 8) = o;
  }
  __syncthreads();
}

__device__ __forceinline__ void mod_unit(const Params& p, int unit, char* smem) {
  float* sc = (float*)smem;
  float* red = sc + 9 * 1024;
  int l = unit / 48, jb = unit % 48;
  int tid = opaque_tid();
  for (int i = tid; i < 9 * 1024; i += NTHREADS) {
    int r = i >> 10, k = i & 1023;
    float v = (r < 8) ? p.c[r * 1024 + k] : p.c_ctx[k];
    sc[i] = siluf_(v);
  }
  __syncthreads();
  int jl = tid & 63, kg = tid >> 6;
  int j = jb * 64 + jl;
  float acc[9];
#pragma unroll
  for (int r = 0; r < 9; ++r) acc[r] = 0.f;
  const float* w = p.w_ada + (size_t)l * DM * 3072 + j;
#pragma unroll 16
  for (int k = kg * 128; k < kg * 128 + 128; ++k) {
    float wv = w[(size_t)k * 3072];
#pragma unroll
    for (int r = 0; r < 9; ++r) acc[r] += sc[r * 1024 + k] * wv;
  }
#pragma unroll
  for (int r = 0; r < 9; ++r) red[(kg * 9 + r) * 64 + jl] = acc[r];
  __syncthreads();
  float* mod = (float*)(p.ws + OFF_MOD);
  for (int i = tid; i < 9 * 64; i += NTHREADS) {
    int r = i >> 6, jj = i & 63;
    float s = 0.f;
#pragma unroll
    for (int g = 0; g < 8; ++g) s += red[(g * 9 + r) * 64 + jj];
    mod[((size_t)l * 9 + r) * 3072 + jb * 64 + jj] = s + p.b_ada[l * 3072 + jb * 64 + jj];
  }
  __syncthreads();
}

__device__ __forceinline__ void rot_unit(const Params& p) {
  float* rot = (float*)(p.ws + OFF_ROT);
  for (int i = opaque_tid(); i < 64 * 32; i += NTHREADS) {
    int pos = i >> 5, f = i & 31;
    float inv = exp2f(-(float)f * (13.287712379549449f / 32.f));
    float ang = (float)pos * inv;
    rot[i * 2] = __cosf(ang);
    rot[i * 2 + 1] = __sinf(ang);
  }
}

__device__ __forceinline__ void phase_u(const Params& p, int l) {
  const int tid = opaque_tid(); int wave = tid >> 6, lane = tid & 63;
  const float* mod = (const float*)(p.ws + OFF_MOD) + (size_t)l * 9 * 3072;
  const float* gain = p.norm_gain + l * DM;
  u16* U = (u16*)(p.ws + OFF_U);
  for (int row = (blockIdx.x * 8 + wave) * 4; row < MTOT; row += gridDim.x * 32) {
    const float* h; int r;
    if (row < MLAT) { h = (l == 0 ? p.x : p.out) + (size_t)row * DM; r = row >> 12; }
    else { int cr = row - MLAT; h = (l == 0 ? p.ctx : (const float*)(p.ws + OFF_HCTX)) + (size_t)cr * DM; r = 8; }
    float4 v[4][4]; float ss[4];
#pragma unroll
    for (int q = 0; q < 4; ++q) {
      ss[q] = 0.f;
#pragma unroll
      for (int i = 0; i < 4; ++i) v[q][i] = *(const float4*)(h + q * DM + i * 256 + lane * 4);
    }
#pragma unroll
    for (int q = 0; q < 4; ++q) {
#pragma unroll
      for (int i = 0; i < 4; ++i) ss[q] += v[q][i].x * v[q][i].x + v[q][i].y * v[q][i].y + v[q][i].z * v[q][i].z + v[q][i].w * v[q][i].w;
      ss[q] = rsqrtf(wave_sum(ss[q]) * (1.f / 1024.f) + 1e-6f);
    }
    const float* sh = mod + r * 3072;
#pragma unroll
    for (int i = 0; i < 4; ++i) {
      int cidx = i * 256 + lane * 4;
      float4 g = *(const float4*)(gain + cidx);
      float4 s = *(const float4*)(sh + cidx);
      float4 sc = *(const float4*)(sh + 1024 + cidx);
      g.x *= (1.f + sc.x); g.y *= (1.f + sc.y); g.z *= (1.f + sc.z); g.w *= (1.f + sc.w);
#pragma unroll
      for (int q = 0; q < 4; ++q) {
        bf16x4 o;
        o[0] = (short)f2bf(v[q][i].x * ss[q] * g.x + s.x);
        o[1] = (short)f2bf(v[q][i].y * ss[q] * g.y + s.y);
        o[2] = (short)f2bf(v[q][i].z * ss[q] * g.z + s.z);
        o[3] = (short)f2bf(v[q][i].w * ss[q] * g.w + s.w);
        *(bf16x4*)(U + (size_t)(row + q) * DM + cidx) = o;
      }
    }
  }
}

__device__ __forceinline__ void phase_final(const Params& p) {
  const int tid = opaque_tid(); int wave = tid >> 6, lane = tid & 63;
  for (int row = blockIdx.x * 8 + wave; row < MLAT; row += gridDim.x * 8) {
    float* h = p.out + (size_t)row * DM;
    float4 v[4]; float ss = 0.f;
#pragma unroll
    for (int i = 0; i < 4; ++i) {
      v[i] = *(const float4*)(h + i * 256 + lane * 4);
      ss += v[i].x * v[i].x + v[i].y * v[i].y + v[i].z * v[i].z + v[i].w * v[i].w;
    }
    ss = wave_sum(ss);
    float rstd = rsqrtf(ss * (1.f / 1024.f) + 1e-6f);
#pragma unroll
    for (int i = 0; i < 4; ++i) {
      int cidx = i * 256 + lane * 4;
      float4 g = *(const float4*)(p.final_gain + cidx);
      float4 o;
      o.x = v[i].x * rstd * g.x; o.y = v[i].y * rstd * g.y; o.z = v[i].z * rstd * g.z; o.w = v[i].w * rstd * g.w;
      *(float4*)(h + cidx) = o;
    }
  }
}

__device__ __forceinline__ int lds_byte(int r, int c) {
  int st = (r >> 4) * 2 + (c >> 5), rr = r & 15, cc = c & 31, ob = rr * 64 + cc * 2;
  return st * 1024 + (ob ^ (((ob >> 9) & 1) << 5));
}

__device__ __forceinline__ void stage_half(int tid, const u16* __restrict__ g, size_t ld, int row0, int k0, char* lds_half) {
#pragma unroll
  for (int i = 0; i < 2; ++i) {
    int b = tid * 16 + i * 8192;
    int st = b >> 10, sb = b & 1023, swz = sb ^ (((sb >> 9) & 1) << 5);
    int R = (st >> 1) * 16 + (swz >> 6), C = (st & 1) * 32 + ((swz & 63) >> 1);
    __builtin_amdgcn_global_load_lds((const unsigned*)(g + (size_t)(row0 + R) * ld + k0 + C),
                                     (__attribute__((address_space(3))) unsigned*)(lds_half + b), 16, 0, 0);
  }
}

__device__ __forceinline__ void gemm_mainloop(const u16* __restrict__ A, size_t lda, int row0,
                                              const u16* __restrict__ Bt, size_t ldb, int col0,
                                              int K, char* smem, f32x4 (&acc)[4][4], int tid) {
  const int wid = tid >> 6, lane = tid & 63;
  const int wr = wid >> 1, wc = wid & 1, fr = lane & 15, fq = lane >> 4;
  const int nt = K / 64;
  asm volatile("s_waitcnt vmcnt(0)" ::: "memory");
  __syncthreads();
  stage_half(tid, A, lda, row0, 0, smem);
  stage_half(tid, A, lda, row0 + 128, 0, smem + 16384);
  stage_half(tid, Bt, ldb, col0, 0, smem + 32768);
  stage_half(tid, A, lda, row0, 64, smem + 49152);
  stage_half(tid, A, lda, row0 + 128, 64, smem + 49152 + 16384);
  stage_half(tid, Bt, ldb, col0, 64, smem + 49152 + 32768);
  int cb = 0;
  for (int t = 0; t < nt; ++t) {
    if (t + 1 < nt) asm volatile("s_waitcnt vmcnt(6)" ::: "memory");
    else asm volatile("s_waitcnt vmcnt(0)" ::: "memory");
    __builtin_amdgcn_s_barrier();
    asm volatile("" ::: "memory");
    char* cur = smem + cb * 49152;
    if (t + 2 < nt) {
      int nb = cb + 2; if (nb >= 3) nb -= 3;
      char* nxt = smem + nb * 49152;
      int k0 = (t + 2) * 64;
      stage_half(tid, A, lda, row0, k0, nxt);
      stage_half(tid, A, lda, row0 + 128, k0, nxt + 16384);
      stage_half(tid, Bt, ldb, col0, k0, nxt + 32768);
    }
    const char* sa = cur + (wr >> 1) * 16384;
    const char* sb = cur + 32768;
#pragma unroll
    for (int ks = 0; ks < 2; ++ks) {
      bf16x8 af[4], bfr[4];
#pragma unroll
      for (int m = 0; m < 4; ++m) af[m] = *(const bf16x8*)(sa + lds_byte((wr & 1) * 64 + m * 16 + fr, ks * 32 + fq * 8));
#pragma unroll
      for (int n = 0; n < 4; ++n) bfr[n] = *(const bf16x8*)(sb + lds_byte(wc * 64 + n * 16 + fr, ks * 32 + fq * 8));
#pragma unroll
      for (int m = 0; m < 4; ++m)
#pragma unroll
        for (int n = 0; n < 4; ++n)
          acc[m][n] = __builtin_amdgcn_mfma_f32_16x16x32_bf16(af[m], bfr[n], acc[m][n], 0, 0, 0);
    }
    cb = cb + 1; if (cb >= 3) cb -= 3;
  }
  __syncthreads();
  __builtin_amdgcn_sched_barrier(0);
}

#define ZERO_ACC(a) _Pragma("unroll") for (int _m = 0; _m < 4; ++_m) _Pragma("unroll") for (int _n = 0; _n < 4; ++_n) a[_m][_n] = (f32x4){0.f, 0.f, 0.f, 0.f}

#define EP_STRIDE 68
#define EP_BYTES  (64 * EP_STRIDE * 4)
#define STAT_OFF  159744
__device__ __forceinline__ float* stage_acc(char* smem, int wid, int fr, int fq, const f32x4 (&acc)[4][4]) {
  float* e = (float*)(smem + wid * EP_BYTES);
#pragma unroll
  for (int m = 0; m < 4; ++m)
#pragma unroll
    for (int n = 0; n < 4; ++n)
#pragma unroll
      for (int j = 0; j < 4; ++j) e[(m * 16 + fq * 4 + j) * EP_STRIDE + n * 16 + fr] = acc[m][n][j];
  return e;
}
__device__ __forceinline__ bf16x8 pack8(const float (&v)[8]) {
  bf16x8 o;
#pragma unroll
  for (int x = 0; x < 8; ++x) o[x] = (short)f2bf(v[x]);
  return o;
}
#define LOAD8(dst, ptr) { float4 _a = *(const float4*)(ptr); float4 _b = *(const float4*)((ptr) + 4); \
  dst[0] = _a.x; dst[1] = _a.y; dst[2] = _a.z; dst[3] = _a.w; dst[4] = _b.x; dst[5] = _b.y; dst[6] = _b.z; dst[7] = _b.w; }

__device__ __forceinline__ void gemm_scan_in(const Params& p, int mt, int ntile, char* smem) {
  const int tid = opaque_tid();
  const u16* U = (const u16*)(p.ws + OFF_U);
  const u16* WT = (const u16*)(p.ws + OFF_WT) + (size_t)WT_SCAN * 1024;
  f32x4 acc[4][4]; ZERO_ACC(acc);
  gemm_mainloop(U, 1024, mt * 256, WT, 1024, ntile * 128, 1024, smem, acc, tid);
  const int wid = tid >> 6, lane = tid & 63;
  const int wr = wid >> 1, wc = wid & 1, fr = lane & 15, fq = lane >> 4;
  const float* e = stage_acc(smem, wid, fr, fq, acc);
  const int rr = lane >> 3, c8 = (lane & 7) * 8;
  if (ntile == 32) {
    float* GLRb = (float*)(p.ws + OFF_GLR) + (size_t)mt * 256 * 16;
    if (wc == 0 && c8 < 16) {
#pragma unroll
      for (int i = 0; i < 8; ++i) {
        int r = rr + 8 * i;
        float v[8]; LOAD8(v, e + r * EP_STRIDE + c8);
        float* d = GLRb + (unsigned)(wr * 64 + r) * 16u + c8;
        *(float4*)d = make_float4(v[0], v[1], v[2], v[3]);
        *(float4*)(d + 4) = make_float4(v[4], v[5], v[6], v[7]);
      }
    }
    return;
  }
  u16* Sb = (u16*)(p.ws + OFF_S) + (size_t)mt * 256 * 4096 + ntile * 128 + wc * 64 + c8;
  const bool scaled = (ntile < 4) || (ntile >= 16 && ntile < 20);
  const float scl = scaled ? 0.08838834764831845f : 1.f;
  if (ntile < 8 && mt < 128) {
    const float* rot = (const float*)(p.ws + OFF_ROT);
    const int tbase = (mt & 15) * 256 + wr * 64;
    const int pair = (c8 >> 4) & 1, f0 = ((c8 >> 5) & 1) * 16 + (c8 & 15);
#pragma unroll
    for (int i = 0; i < 8; ++i) {
      int r = rr + 8 * i;
      int t = tbase + r;
      unsigned pos = (wc == 0) ? (t >> 6) : (t & 63);
      float v[8], vp[8], cs[16];
      LOAD8(v, e + r * EP_STRIDE + c8);
      LOAD8(vp, e + r * EP_STRIDE + (c8 ^ 16));
      const float* rp = rot + (pos * 32u + f0) * 2u;
      LOAD8(cs, rp); { float* c2 = cs + 8; LOAD8(c2, rp + 8); }
      float o[8];
#pragma unroll
      for (int x = 0; x < 8; ++x) {
        float c = cs[2 * x], s = cs[2 * x + 1];
        o[x] = (pair == 0 ? (v[x] * c - vp[x] * s) : (v[x] * c + vp[x] * s)) * scl;
      }
      *(bf16x8*)(Sb + (unsigned)(wr * 64 + r) * 4096u) = pack8(o);
    }
  } else {
#pragma unroll
    for (int i = 0; i < 8; ++i) {
      int r = rr + 8 * i;
      float v[8]; LOAD8(v, e + r * EP_STRIDE + c8);
#pragma unroll
      for (int x = 0; x < 8; ++x) v[x] *= scl;
      *(bf16x8*)(Sb + (unsigned)(wr * 64 + r) * 4096u) = pack8(v);
    }
  }
}

__device__ __forceinline__ void gemm_gate(const Params& p, int l, int mt, int ntile, char* smem) {
  const int tid = opaque_tid();
  const u16* U = (const u16*)(p.ws + OFF_U);
  const u16* WT = (const u16*)(p.ws + OFF_WT) + (size_t)WT_GATE * 1024;
  const int wid = tid >> 6, lane = tid & 63;
  const int wr = wid >> 1, wc = wid & 1, fr = lane & 15, fq = lane >> 4;
  float* stat = (float*)(smem + STAT_OFF);
  const bool is_norm = ntile < 16;
  const int branch = ntile >> 3;
  const u16* RGb = (const u16*)(p.ws + OFF_RG) + (size_t)mt * 256 * 2048 + (branch & 1) * 1024;
  if (is_norm) {
    __syncthreads();
    int head = (ntile & 7) >> 1;
    for (int r0 = 0; r0 < 32; r0 += 8) {
      bf16x4 vv[8];
#pragma unroll
      for (int i = 0; i < 8; ++i) vv[i] = *(const bf16x4*)(RGb + (unsigned)(wid * 32 + r0 + i) * 2048u + head * 256 + lane * 4);
#pragma unroll
      for (int i = 0; i < 8; ++i) {
        unsigned rl = wid * 32 + r0 + i;
        float a0 = bf2f((u16)vv[i][0]), a1 = bf2f((u16)vv[i][1]), a2 = bf2f((u16)vv[i][2]), a3 = bf2f((u16)vv[i][3]);
        float s1 = a0 + a1 + a2 + a3, s2 = a0 * a0 + a1 * a1 + a2 * a2 + a3 * a3;
        s1 = wave_sum(s1); s2 = wave_sum(s2);
        float sa, sb;
        if (branch == 0) {
          float mu = s1 * (1.f / 256.f);
          float var = fmaxf(s2 * (1.f / 256.f) - mu * mu, 0.f);
          sa = rsqrtf(var + 1e-6f); sb = -mu * sa;
        } else { sa = rsqrtf(s2 * (1.f / 256.f) + 1e-6f); sb = 0.f; }
        if (lane == 0) { stat[rl * 2] = sa; stat[rl * 2 + 1] = sb; }
      }
    }
  }
  f32x4 acc[4][4]; ZERO_ACC(acc);
  gemm_mainloop(U, 1024, mt * 256, WT, 1024, ntile * 128, 1024, smem, acc, tid);
  const float* e = stage_acc(smem, wid, fr, fq, acc);
  const int rr = lane >> 3, c8 = (lane & 7) * 8;
  u16* Sb = (u16*)(p.ws + OFF_S) + (size_t)mt * 256 * 4096;
  if (is_norm) {
    const float* gain = (branch == 0 ? p.ret_norm_gain : p.gla_norm_gain) + l * 1024;
    const unsigned cin = (ntile & 7) * 128 + wc * 64 + c8;
    float gn[8]; LOAD8(gn, gain + cin);
#pragma unroll
    for (int i = 0; i < 8; ++i) {
      int r = rr + 8 * i;
      unsigned rl = wr * 64 + r;
      float v[8]; LOAD8(v, e + r * EP_STRIDE + c8);
      bf16x8 xr = *(const bf16x8*)(RGb + rl * 2048u + cin);
      float sa = stat[rl * 2], sb = stat[rl * 2 + 1];
      float o[8];
#pragma unroll
      for (int x = 0; x < 8; ++x) o[x] = (bf2f((u16)xr[x]) * sa + sb) * gn[x] * siluf_(v[x]);
      *(bf16x8*)(Sb + rl * 4096u + 2048u + branch * 1024 + cin) = pack8(o);
    }
  } else {
    const unsigned cout = (ntile - 16) * 128 + wc * 64 + c8;
#pragma unroll
    for (int i = 0; i < 8; ++i) {
      int r = rr + 8 * i;
      float v[8]; LOAD8(v, e + r * EP_STRIDE + c8);
#pragma unroll
      for (int x = 0; x < 8; ++x) v[x] = sigmoidf_(v[x]);
      *(bf16x8*)(Sb + (unsigned)(wr * 64 + r) * 4096u + cout) = pack8(v);
    }
  }
}

__device__ __forceinline__ void gemm_merge(const Params& p, int mt, int ntile, char* smem) {
  const int tid = opaque_tid();
  const u16* S = (const u16*)(p.ws + OFF_S);
  const u16* WT = (const u16*)(p.ws + OFF_WT);
  const int wid = tid >> 6, lane = tid & 63;
  const int wr = wid >> 1, wc = wid & 1, fr = lane & 15, fq = lane >> 4;
  const int rr = lane >> 3, c8 = (lane & 7) * 8;
  const unsigned c0 = ntile * 128 + wc * 64 + c8;
  const u16* Sb = S + (size_t)mt * 256 * 4096;
  u16* MGb = (u16*)(p.ws + OFF_U) + (size_t)mt * 256 * 1024;
  f32x4 acc[4][4];
  ZERO_ACC(acc);
  gemm_mainloop(S + 2048, 4096, mt * 256, WT + (size_t)WT_BRR * 1024, 1024, ntile * 128, 1024, smem, acc, tid);
  {
    const float* e = stage_acc(smem, wid, fr, fq, acc);
#pragma unroll
    for (int i = 0; i < 8; ++i) {
      int r = rr + 8 * i;
      unsigned rl = wr * 64 + r;
      float v[8]; LOAD8(v, e + r * EP_STRIDE + c8);
      bf16x8 ma = *(const bf16x8*)(Sb + rl * 4096u + c0);
#pragma unroll
      for (int x = 0; x < 8; ++x) v[x] *= bf2f((u16)ma[x]);
      *(bf16x8*)(MGb + rl * 1024u + c0) = pack8(v);
    }
  }
  __builtin_amdgcn_sched_barrier(0);
  ZERO_ACC(acc);
  gemm_mainloop(S + 3072, 4096, mt * 256, WT + (size_t)WT_BRG * 1024, 1024, ntile * 128, 1024, smem, acc, tid);
  {
    const float* e = stage_acc(smem, wid, fr, fq, acc);
#pragma unroll
    for (int i = 0; i < 8; ++i) {
      int r = rr + 8 * i;
      unsigned rl = wr * 64 + r;
      float v[8]; LOAD8(v, e + r * EP_STRIDE + c8);
      bf16x8 mb = *(const bf16x8*)(Sb + rl * 4096u + 1024u + c0);
      bf16x8 t0 = *(const bf16x8*)(MGb + rl * 1024u + c0);
#pragma unroll
      for (int x = 0; x < 8; ++x) v[x] = bf2f((u16)t0[x]) + v[x] * bf2f((u16)mb[x]);
      *(bf16x8*)(MGb + rl * 1024u + c0) = pack8(v);
    }
  }
}

__device__ __forceinline__ void gemm_out(const Params& p, int l, int mt, int ntile, char* smem) {
  const int tid = opaque_tid();
  const u16* MG = (const u16*)(p.ws + OFF_U);
  const u16* WT = (const u16*)(p.ws + OFF_WT) + (size_t)WT_OUT * 1024;
  const int wid = tid >> 6, lane = tid & 63;
  const int wr = wid >> 1, wc = wid & 1, fr = lane & 15, fq = lane >> 4;
  const int rr = lane >> 3, c8 = (lane & 7) * 8;
  const unsigned c0 = ntile * 128 + wc * 64 + c8;
  f32x4 acc[4][4]; ZERO_ACC(acc);
  gemm_mainloop(MG, 1024, mt * 256, WT, 1024, ntile * 128, 1024, smem, acc, tid);
  const float* e = stage_acc(smem, wid, fr, fq, acc);
  const float* hin; float* hout; int rmod;
  if (mt < 128) { hin = (l == 0 ? p.x : p.out) + (size_t)mt * 256 * DM; hout = p.out + (size_t)mt * 256 * DM; rmod = mt >> 4; }
  else { hin = p.ctx + (size_t)(mt - 128) * 256 * DM; hout = (float*)(p.ws + OFF_HCTX) + (size_t)(mt - 128) * 256 * DM; rmod = 8; }
  const float* gate = (const float*)(p.ws + OFF_MOD) + (size_t)l * 9 * 3072 + rmod * 3072 + 2048;
  float gt8[8]; LOAD8(gt8, gate + c0);
#pragma unroll
  for (int i = 0; i < 8; ++i) {
    int r = rr + 8 * i;
    unsigned o = (unsigned)(wr * 64 + r) * 1024u + c0;
    float v[8], hv[8];
    LOAD8(v, e + r * EP_STRIDE + c8);
    LOAD8(hv, hin + o);
    *(float4*)(hout + o) = make_float4(hv[0] + gt8[0] * v[0], hv[1] + gt8[1] * v[1], hv[2] + gt8[2] * v[2], hv[3] + gt8[3] * v[3]);
    *(float4*)(hout + o + 4) = make_float4(hv[4] + gt8[4] * v[4], hv[5] + gt8[5] * v[5], hv[6] + gt8[6] * v[6], hv[7] + gt8[7] * v[7]);
  }
}

#define OFF_VECS OFF_WT
__device__ __forceinline__ float logsig16(float x) { return (fminf(x, 0.f) - __logf(1.f + __expf(-fabsf(x)))) * (1.f / 16.f); }

__device__ __forceinline__ void gla_prepass_unit(const Params& p, int l, int unit, char* smem) {
  const int tid = opaque_tid();
  const int b = unit / 68, cid = unit % 68;
  const int base = cid < 4 ? (MLAT + b * 256 + cid * 64) : (b * 4096 + (cid - 4) * 64);
  float* GLRS = (float*)smem;
  __syncthreads();
  if (tid < 256) {
    const float* GLR = (const float*)(p.ws + OFF_GLR) + (size_t)base * 16;
    *(float4*)(GLRS + tid * 4) = *(const float4*)(GLR + tid * 4);
  }
  float wf[16], wb[16];
  {
    const float* w0 = p.gla_w_up + (size_t)(l * 2 + 0) * 16 * 512 + tid;
    const float* w1 = p.gla_w_up + (size_t)(l * 2 + 1) * 16 * 512 + tid;
#pragma unroll
    for (int r = 0; r < 16; ++r) { wf[r] = w0[r * 512]; wb[r] = w1[r * 512]; }
  }
  const float bf_ = p.gla_b_up[(l * 2 + 0) * 512 + tid], bb_ = p.gla_b_up[(l * 2 + 1) * 512 + tid];
  __syncthreads();
  u16* Sq = (u16*)(p.ws + OFF_S) + (size_t)base * 4096 + 2048 + tid;
  u16* Ub = (u16*)(p.ws + OFF_U) + (size_t)base * 1024 + tid;
  float accF = 0.f, accB = 0.f;
#pragma unroll 8
  for (int u = 0; u < 32; ++u) {
    const int i = 31 - u;
    const float4* gr = (const float4*)(GLRS + i * 16);
    float4 g0 = gr[0], g1 = gr[1], g2 = gr[2], g3 = gr[3];
    float xf = bf_, xb = bb_;
    xf += g0.x * wf[0] + g0.y * wf[1] + g0.z * wf[2] + g0.w * wf[3] + g1.x * wf[4] + g1.y * wf[5] + g1.z * wf[6] + g1.w * wf[7]
        + g2.x * wf[8] + g2.y * wf[9] + g2.z * wf[10] + g2.w * wf[11] + g3.x * wf[12] + g3.y * wf[13] + g3.z * wf[14] + g3.w * wf[15];
    xb += g0.x * wb[0] + g0.y * wb[1] + g0.z * wb[2] + g0.w * wb[3] + g1.x * wb[4] + g1.y * wb[5] + g1.z * wb[6] + g1.w * wb[7]
        + g2.x * wb[8] + g2.y * wb[9] + g2.z * wb[10] + g2.w * wb[11] + g3.x * wb[12] + g3.y * wb[13] + g3.z * wb[14] + g3.w * wb[15];
    const float laf = logsig16(xf), lab = logsig16(xb);
    const float relf = -accF; accF += laf;
    accB += lab; const float relb = accB;
    const float q = bf2f(Sq[(unsigned)i * 4096u]), k = bf2f(Sq[(unsigned)i * 4096u + 512u]);
    Sq[(unsigned)i * 4096u] = f2bf(q * __expf(relf));
    Sq[(unsigned)i * 4096u + 512u] = f2bf(k * __expf(-relf));
    Ub[(unsigned)i * 1024u] = f2bf(q * __expf(relb));
    Ub[(unsigned)i * 1024u + 512u] = f2bf(k * __expf(-relb));
  }
  float accF2 = 0.f, accB2 = 0.f;
#pragma unroll 8
  for (int u = 0; u < 32; ++u) {
    const int i = 32 + u;
    const float4* gr = (const float4*)(GLRS + i * 16);
    float4 g0 = gr[0], g1 = gr[1], g2 = gr[2], g3 = gr[3];
    float xf = bf_, xb = bb_;
    xf += g0.x * wf[0] + g0.y * wf[1] + g0.z * wf[2] + g0.w * wf[3] + g1.x * wf[4] + g1.y * wf[5] + g1.z * wf[6] + g1.w * wf[7]
        + g2.x * wf[8] + g2.y * wf[9] + g2.z * wf[10] + g2.w * wf[11] + g3.x * wf[12] + g3.y * wf[13] + g3.z * wf[14] + g3.w * wf[15];
    xb += g0.x * wb[0] + g0.y * wb[1] + g0.z * wb[2] + g0.w * wb[3] + g1.x * wb[4] + g1.y * wb[5] + g1.z * wb[6] + g1.w * wb[7]
        + g2.x * wb[8] + g2.y * wb[9] + g2.z * wb[10] + g2.w * wb[11] + g3.x * wb[12] + g3.y * wb[13] + g3.z * wb[14] + g3.w * wb[15];
    const float laf = logsig16(xf), lab = logsig16(xb);
    accF2 += laf; const float relf = accF2;
    const float relb = -accB2; accB2 += lab;
    const float q = bf2f(Sq[(unsigned)i * 4096u]), k = bf2f(Sq[(unsigned)i * 4096u + 512u]);
    Sq[(unsigned)i * 4096u] = f2bf(q * __expf(relf));
    Sq[(unsigned)i * 4096u + 512u] = f2bf(k * __expf(-relf));
    Ub[(unsigned)i * 1024u] = f2bf(q * __expf(relb));
    Ub[(unsigned)i * 1024u + 512u] = f2bf(k * __expf(-relb));
  }
  float* V0 = (float*)(p.ws + OFF_VECS) + ((size_t)(0 * 544 + b * 68 + cid) * 2) * 512 + tid;
  float* V1 = (float*)(p.ws + OFF_VECS) + ((size_t)(1 * 544 + b * 68 + cid) * 2) * 512 + tid;
  V0[0] = __expf(accF);  V0[512] = __expf(accF2);
  V1[0] = __expf(accB2); V1[512] = __expf(accB);
}

#define L_QR   0
#define L_KR   17408
#define L_V    34816
#define L_SGT  44032
#define L_P    61440
#undef  SCAN_GB
#define SCAN_GB 70656

__device__ __forceinline__ int off128(int row, int col) { return row * 272 + col * 2; }
__device__ __forceinline__ int off64(int row, int col) { return row * 144 + col * 2; }

template <int RS>
__device__ __forceinline__ bf16x8 tr_frag(unsigned img_addr, int r0, int c0, int lane) {
  const int g = lane >> 4, q = (lane & 15) >> 2, pp = lane & 3;
  unsigned a = img_addr + (unsigned)((r0 + 8 * g + q) * RS + (c0 + 4 * pp) * 2);
  bf16x4 lo, hi;
  asm volatile("ds_read_b64_tr_b16 %0, %2\n\tds_read_b64_tr_b16 %1, %2 offset:%3\n\ts_waitcnt lgkmcnt(0)"
               : "=&v"(lo), "=&v"(hi) : "v"(a), "n"(4 * RS) : "memory");
  bf16x8 r;
  r[0] = lo[0]; r[1] = lo[1]; r[2] = lo[2]; r[3] = lo[3]; r[4] = hi[0]; r[5] = hi[1]; r[6] = hi[2]; r[7] = hi[3];
  return r;
}

__device__ __forceinline__ bf16x8 scale8(bf16x8 v, float f) {
  bf16x8 o;
#pragma unroll
  for (int x = 0; x < 8; ++x) o[x] = (short)f2bf(bf2f((u16)v[x]) * f);
  return o;
}

__device__ __forceinline__ void lds_barrier() { asm volatile("s_waitcnt lgkmcnt(0)" ::: "memory"); __builtin_amdgcn_s_barrier(); asm volatile("" ::: "memory"); }

template <int branch>
__device__ __forceinline__ void scan_item(const Params& p, int l, int item, char* smem) {
  const int b = (item >> 4) & 7, h = (item >> 2) & 3, slice = item & 3;
  const int tid = opaque_tid(), wid = __builtin_amdgcn_readfirstlane(tid >> 6), lane = tid & 63;
  const int dir = wid >> 2, gw = wid & 3, gt = tid & 255;
  const int fr = lane & 15, fq = lane >> 4;
  char* G = smem + dir * SCAN_GB;
  const unsigned Ga = (unsigned)(size_t)G;
  const u16* S = (const u16*)(p.ws + OFF_S);
  u16* RG = (u16*)(p.ws + OFF_RG);
  const u16* qsrc; unsigned qstride;
  if (branch == 0) { qsrc = S + h * 128; qstride = 4096; }
  else if (dir == 0) { qsrc = S + 2048 + h * 128; qstride = 4096; }
  else { qsrc = (const u16*)(p.ws + OFF_U) + h * 128; qstride = 1024; }
  const int voff = branch * 2048 + 1024 + h * 256 + slice * 64;
  const int ooff = branch * 1024 + h * 256 + slice * 64;
  float lg = 0.f, egc = 1.f;
  if (branch == 0) { lg = __logf(1.f - __expf(p.ret_decay[(l * 2 + dir) * 4 + h])); egc = __expf(32.f * lg); }
  const float* VECS = (const float*)(p.ws + OFF_VECS) + ((size_t)(dir * 544 + b * 68) * 2) * 512 + h * 128;
  f32x4 st[2][4];
#pragma unroll
  for (int m = 0; m < 2; ++m)
#pragma unroll
    for (int n = 0; n < 4; ++n) st[m][n] = (f32x4){0.f, 0.f, 0.f, 0.f};

  const int qj = gt >> 4, qc = gt & 15;
  const int vj = gt >> 3, vc = gt & 7;
  bf16x8 pq[4], pk[4], pv[2];
  float4 peg[2], pel[2];
  auto prefetch = [&](int s) {
    int base, cid;
    if (s < 4) { int cc = dir ? 3 - s : s; base = MLAT + b * 256 + cc * 64; cid = cc; }
    else { int c = s - 4; int cc = dir ? 63 - c : c; base = b * 4096 + cc * 64; cid = 4 + cc; }
#pragma unroll
    for (int i = 0; i < 4; ++i) {
      int jp = qj + 16 * i;
      unsigned ro = (unsigned)(base + (dir ? 63 - jp : jp)) * qstride + qc * 8;
      pq[i] = *(const bf16x8*)(qsrc + ro);
      pk[i] = *(const bf16x8*)(qsrc + ro + 512);
    }
#pragma unroll
    for (int i = 0; i < 2; ++i) {
      int jp = vj + 32 * i;
      pv[i] = *(const bf16x8*)(S + (size_t)(base + (dir ? 63 - jp : jp)) * 4096 + voff + vc * 8);
    }
    if (branch == 1) {
#pragma unroll
      for (int m = 0; m < 2; ++m) {
        int d0 = gw * 32 + m * 16 + fq * 4;
        peg[m] = *(const float4*)(VECS + (size_t)cid * 1024 + d0);
        pel[m] = *(const float4*)(VECS + (size_t)cid * 1024 + 512 + d0);
      }
    }
  };
  prefetch(0);
  __syncthreads();

  for (int s = 0; s < 68; ++s) {
    int base; bool first; bool wout;
    if (s < 4) { int cc = dir ? 3 - s : s; base = MLAT + b * 256 + cc * 64; first = s < 2; wout = (l == 0); }
    else { int c = s - 4; int cc = dir ? 63 - c : c; base = b * 4096 + cc * 64; first = c < 32; wout = true; }
    float4 eg[2], el[2];
#pragma unroll
    for (int m = 0; m < 2; ++m) {
      if (branch == 1) { eg[m] = peg[m]; el[m] = pel[m]; }
      else { eg[m] = make_float4(egc, egc, egc, egc); el[m] = eg[m]; }
    }
#pragma unroll
    for (int i = 0; i < 4; ++i) {
      int jp = qj + 16 * i;
      bf16x8 qv = pq[i], kv_ = pk[i];
      if (branch == 0) {
        float fqs = __expf((float)(jp - 31) * lg), fks = __expf((float)(31 - jp) * lg);
        qv = scale8(qv, fqs); kv_ = scale8(kv_, fks);
      }
      *(bf16x8*)(G + L_QR + off128(jp, qc * 8)) = qv;
      *(bf16x8*)(G + L_KR + off128(jp, qc * 8)) = kv_;
    }
#pragma unroll
    for (int i = 0; i < 2; ++i) *(bf16x8*)(G + L_V + off64(vj + 32 * i, vc * 8)) = pv[i];
#pragma unroll
    for (int m = 0; m < 2; ++m) {
      int d0 = gw * 32 + m * 16 + fq * 4;
#pragma unroll
      for (int n = 0; n < 4; ++n) {
        int e = n * 16 + fr;
        bf16x4 o4;
        o4[0] = (short)f2bf(st[m][n][0] * eg[m].x); o4[1] = (short)f2bf(st[m][n][1] * eg[m].y);
        o4[2] = (short)f2bf(st[m][n][2] * eg[m].z); o4[3] = (short)f2bf(st[m][n][3] * eg[m].w);
        *(bf16x4*)(G + L_SGT + off128(e, d0)) = o4;
      }
    }
    u16 oldv[4][4];
    u16* dstb = RG + (size_t)base * 2048 + ooff + fr;
    if (wout && !first) {
#pragma unroll
      for (int r = 0; r < 4; ++r) {
        int ip = gw * 16 + fq * 4 + r;
        unsigned ro = (unsigned)(dir ? 63 - ip : ip) * 2048u;
#pragma unroll
        for (int n = 0; n < 4; ++n) oldv[r][n] = dstb[ro + n * 16];
      }
    }
    if (s + 1 < 68) prefetch(s + 1);
    lds_barrier();
    f32x4 pt[4], o[4];
#pragma unroll
    for (int n = 0; n < 4; ++n) { pt[n] = (f32x4){0.f, 0.f, 0.f, 0.f}; o[n] = (f32x4){0.f, 0.f, 0.f, 0.f}; }
#pragma unroll
    for (int ks = 0; ks < 4; ++ks) {
      int kc = ks * 32 + fq * 8;
      bf16x8 ka = *(const bf16x8*)(G + L_KR + off128(gw * 16 + fr, kc));
      bf16x8 qa = *(const bf16x8*)(G + L_QR + off128(gw * 16 + fr, kc));
#pragma unroll
      for (int n = 0; n < 4; ++n) {
        bf16x8 qb = *(const bf16x8*)(G + L_QR + off128(n * 16 + fr, kc));
        bf16x8 sb = *(const bf16x8*)(G + L_SGT + off128(n * 16 + fr, kc));
        pt[n] = __builtin_amdgcn_mfma_f32_16x16x32_bf16(ka, qb, pt[n], 0, 0, 0);
        o[n] = __builtin_amdgcn_mfma_f32_16x16x32_bf16(qa, sb, o[n], 0, 0, 0);
      }
    }
#pragma unroll
    for (int n = 0; n < 4; ++n) {
      int ip = n * 16 + fr;
      int j0 = gw * 16 + fq * 4;
      bf16x4 w;
#pragma unroll
      for (int r = 0; r < 4; ++r) {
        int jp = j0 + r;
        bool keep = dir ? (ip > jp) : (ip >= jp);
        w[r] = (short)f2bf(keep ? pt[n][r] : 0.f);
      }
      *(bf16x4*)(G + L_P + off64(ip, j0)) = w;
    }
    lds_barrier();
    {
      const int tg = lane >> 4, tq = (lane & 15) >> 2, tp = lane & 3;
      const unsigned ka0 = Ga + L_KR + (unsigned)((8 * tg + tq) * 272 + (gw * 32 + 4 * tp) * 2);
      const unsigned va0 = Ga + L_V + (unsigned)((8 * tg + tq) * 144 + (4 * tp) * 2);
#pragma unroll
      for (int m = 0; m < 2; ++m) {
        f32x4 kv[4];
#pragma unroll
        for (int n = 0; n < 4; ++n) kv[n] = (f32x4){0.f, 0.f, 0.f, 0.f};
#pragma unroll
        for (int ks = 0; ks < 2; ++ks) {
          int kc = ks * 32 + fq * 8;
          bf16x4 r0, r1, r2, r3, r4, r5, r6, r7, r8, r9;
          asm volatile(
              "ds_read_b64_tr_b16 %0, %10\n\tds_read_b64_tr_b16 %1, %10 offset:1088\n\t"
              "ds_read_b64_tr_b16 %2, %11\n\tds_read_b64_tr_b16 %3, %11 offset:576\n\t"
              "ds_read_b64_tr_b16 %4, %11 offset:32\n\tds_read_b64_tr_b16 %5, %11 offset:608\n\t"
              "ds_read_b64_tr_b16 %6, %11 offset:64\n\tds_read_b64_tr_b16 %7, %11 offset:640\n\t"
              "ds_read_b64_tr_b16 %8, %11 offset:96\n\tds_read_b64_tr_b16 %9, %11 offset:672\n\t"
              "s_waitcnt lgkmcnt(0)"
              : "=&v"(r0), "=&v"(r1), "=&v"(r2), "=&v"(r3), "=&v"(r4), "=&v"(r5), "=&v"(r6), "=&v"(r7), "=&v"(r8), "=&v"(r9)
              : "v"(ka0 + (unsigned)(ks * 32 * 272 + m * 32)), "v"(va0 + (unsigned)(ks * 32 * 144))
              : "memory");
          bf16x8 km = __builtin_shufflevector(r0, r1, 0, 1, 2, 3, 4, 5, 6, 7);
          bf16x8 vb[4];
          vb[0] = __builtin_shufflevector(r2, r3, 0, 1, 2, 3, 4, 5, 6, 7);
          vb[1] = __builtin_shufflevector(r4, r5, 0, 1, 2, 3, 4, 5, 6, 7);
          vb[2] = __builtin_shufflevector(r6, r7, 0, 1, 2, 3, 4, 5, 6, 7);
          vb[3] = __builtin_shufflevector(r8, r9, 0, 1, 2, 3, 4, 5, 6, 7);
          bf16x8 pa;
          if (m == 0) pa = *(const bf16x8*)(G + L_P + off64(gw * 16 + fr, kc));
#pragma unroll
          for (int n = 0; n < 4; ++n) {
            if (m == 0) o[n] = __builtin_amdgcn_mfma_f32_16x16x32_bf16(pa, vb[n], o[n], 0, 0, 0);
            kv[n] = __builtin_amdgcn_mfma_f32_16x16x32_bf16(km, vb[n], kv[n], 0, 0, 0);
          }
        }
#pragma unroll
        for (int n = 0; n < 4; ++n) {
          st[m][n][0] = eg[m].x * el[m].x * st[m][n][0] + el[m].x * kv[n][0];
          st[m][n][1] = eg[m].y * el[m].y * st[m][n][1] + el[m].y * kv[n][1];
          st[m][n][2] = eg[m].z * el[m].z * st[m][n][2] + el[m].z * kv[n][2];
          st[m][n][3] = eg[m].w * el[m].w * st[m][n][3] + el[m].w * kv[n][3];
        }
      }
    }
    if (wout) {
#pragma unroll
      for (int r = 0; r < 4; ++r) {
        int ip = gw * 16 + fq * 4 + r;
        unsigned ro = (unsigned)(dir ? 63 - ip : ip) * 2048u;
#pragma unroll
        for (int n = 0; n < 4; ++n) {
          float v = o[n][r];
          if (!first) v += bf2f(oldv[r][n]);
          dstb[ro + n * 16] = f2bf(v);
        }
      }
    }
    __syncthreads();
  }
}

#define NPHASE 18
__device__ __forceinline__ void run_phase(const Params& p, int ph, char* smem) {
  const int nblk = gridDim.x, bid = blockIdx.x;
  if (ph == 0) {
#ifdef REP_P0
    for (int rep = 0; rep < REP_P0; ++rep)
#endif
    for (int u = bid; u < WT_UNITS + 96 + 1; u += nblk) {
      if (u < 96) mod_unit(p, u, smem);
      else if (u == 96) rot_unit(p);
      else wt_unit(p, 0, u - 97, smem);
    }
    return;
  }
  if (ph == NPHASE - 1) { phase_final(p); return; }
  const int l = (ph - 1) / 8, sp = (ph - 1) % 8;
  switch (sp) {
    case 0:
      phase_u(p, l);
      if (l == 1) for (int u = bid; u < WT_UNITS; u += nblk) wt_unit(p, 1, u, smem);
      break;
    case 1:
#ifdef REP_G1
      for (int rep = 0; rep < REP_G1; ++rep)
#endif
      {
        const int x = bid & 7, per = (nblk - x + 7) >> 3;
        for (int q = bid >> 3; q < 561; q += per) {
          int k = q / 33, r = q - k * 33;
          int mt = (r == 32) ? 8 * k + x : 8 * k + (r >> 2);
          int nt = (r == 32) ? 32 : x + 8 * (r & 3);
          gemm_scan_in(p, mt, nt, smem);
        }
      }
      break;
    case 2: for (int t = bid; t < 544; t += nblk) gla_prepass_unit(p, l, t, smem); break;
    case 3:
#ifdef REP_SCAN
      for (int rep = 0; rep < REP_SCAN; ++rep)
#endif
      for (int t = bid; t < 256; t += nblk) { if (t < 128) scan_item<0>(p, l, t, smem); else scan_item<1>(p, l, t, smem); } break;
    case 4:
#ifdef REP_U
      for (int rep = 0; rep < REP_U; ++rep)
#endif
      phase_u(p, l); break;
    case 5: { int MT = l == 0 ? 136 : 128;
#ifdef REP_G2
      for (int rep = 0; rep < REP_G2; ++rep)
#endif
      {
        const int x = bid & 7, per = (nblk - x + 7) >> 3;
        for (int q = bid >> 3; q < MT * 4; q += per) gemm_gate(p, l, q >> 2, x + 8 * (q & 3), smem);
      } } break;
    case 6: { int MT = l == 0 ? 136 : 128;
#ifdef REP_G3
      for (int rep = 0; rep < REP_G3; ++rep)
#endif
      {
        const int x = bid & 7, per = (nblk - x + 7) >> 3;
        for (int q = bid >> 3; q < MT; q += per) gemm_merge(p, x + 8 * (q >> 3), q & 7, smem);
      } } break;
    case 7: { int MT = l == 0 ? 136 : 128;
      {
        const int x = bid & 7, per = (nblk - x + 7) >> 3;
        for (int q = bid >> 3; q < MT; q += per) gemm_out(p, l, x + 8 * (q >> 3), q & 7, smem);
      } } break;
  }
}

__device__ __forceinline__ void grid_barrier(unsigned* cnt, unsigned target) {
  asm volatile("s_waitcnt vmcnt(0)" ::: "memory");
  __syncthreads();
  if (threadIdx.x == 0) {
    __threadfence();
    __hip_atomic_fetch_add(cnt, 1u, __ATOMIC_RELAXED, __HIP_MEMORY_SCOPE_AGENT);
    while (__hip_atomic_load(cnt, __ATOMIC_RELAXED, __HIP_MEMORY_SCOPE_AGENT) < target) __builtin_amdgcn_s_sleep(2);
    __threadfence();
  }
  __syncthreads();
}

__global__ void __launch_bounds__(NTHREADS) mega(Params p, int ph_lo, int ph_hi, int coop) {
  extern __shared__ __attribute__((aligned(16))) char smem[];
  for (int ph = ph_lo; ph < ph_hi; ++ph) {
    run_phase(p, ph, smem);
    if (coop && ph + 1 < ph_hi) {
      if (ph == ph_lo) cg::this_grid().sync();
      else grid_barrier((unsigned*)(p.ws + OFF_BAR), (unsigned)(ph - ph_lo) * gridDim.x);
    }
  }
}

extern "C" void kernel_launch(void* const* d_in, const int* in_sizes, int n_in,
                              void* d_out, int out_size, void* d_ws, size_t ws_size,
                              hipStream_t stream) {
  Params p{};
  p.x = (const float*)d_in[0]; p.c = (const float*)d_in[1]; p.ctx = (const float*)d_in[2]; p.c_ctx = (const float*)d_in[3];
  p.norm_gain = (const float*)d_in[4]; p.w_ada = (const float*)d_in[5]; p.b_ada = (const float*)d_in[6]; p.w_in = (const float*)d_in[7];
  p.ret_decay = (const float*)d_in[8]; p.gla_w_up = (const float*)d_in[9]; p.gla_b_up = (const float*)d_in[10];
  p.ret_norm_gain = (const float*)d_in[11]; p.gla_norm_gain = (const float*)d_in[12];
  p.w_br_ret = (const float*)d_in[13]; p.w_br_gla = (const float*)d_in[14]; p.w_out = (const float*)d_in[15]; p.final_gain = (const float*)d_in[16];
  p.out = (float*)d_out; p.ws = (char*)d_ws;
  static int grid_blocks = 0;
  if (!grid_blocks) {
    hipFuncSetAttribute((const void*)mega, hipFuncAttributeMaxDynamicSharedMemorySize, LDS_BYTES);
    int dev = 0, cus = 0, per_cu = 0;
    hipGetDevice(&dev);
    hipDeviceGetAttribute(&cus, hipDeviceAttributeMultiprocessorCount, dev);
    hipOccupancyMaxActiveBlocksPerMultiprocessor(&per_cu, mega, NTHREADS, LDS_BYTES);
    if (per_cu < 1) per_cu = 1;
    grid_blocks = cus * 1;
  }
#ifdef MULTI_LAUNCH
  for (int ph = 0; ph < NPHASE; ++ph) {
    mega<<<dim3(grid_blocks), dim3(NTHREADS), LDS_BYTES, stream>>>(p, ph, ph + 1, 0);
  }
#else
  hipMemsetAsync((char*)d_ws + OFF_BAR, 0, 256, stream);
  int lo = 0, hi = NPHASE, coop = 1;
  void* args[] = {&p, &lo, &hi, &coop};
  hipError_t e = hipLaunchCooperativeKernel((void*)mega, dim3(grid_blocks), dim3(NTHREADS), args, LDS_BYTES, stream);
  if (e != hipSuccess) fprintf(stderr, "cooperative launch failed: %s (grid %d)\n", hipGetErrorString(e), grid_blocks);
#endif
}
```

```cpp
#include <hip/hip_runtime.h>
#include <hip/hip_cooperative_groups.h>
#include <cstdio>
namespace cg = cooperative_groups;

typedef unsigned short u16;
using bf16x8 = __attribute__((ext_vector_type(8))) short;
using bf16x4 = __attribute__((ext_vector_type(4))) short;
using f32x4  = __attribute__((ext_vector_type(4))) float;

#define NTHREADS 512
#define DM 1024
#define NB 8
#define SEQL 4096
#define CTXL 256
#define MLAT 32768
#define MCTX 2048
#define MTOT 34816
#define INW 8208

#define OFF_S    0ull
#define OFF_RG   (OFF_S   + (size_t)MTOT * 4096 * 2)
#define OFF_U    (OFF_RG  + (size_t)MTOT * 2048 * 2)
#define OFF_WT   (OFF_U   + (size_t)MTOT * 1024 * 2)
#define WT_ROWS  11392
#define OFF_GLR  (OFF_WT  + (size_t)WT_ROWS * 1024 * 2)
#define OFF_HCTX (OFF_GLR + (size_t)MTOT * 16 * 4)
#define OFF_MOD  (OFF_HCTX+ (size_t)MCTX * 1024 * 4)
#define OFF_ROT  (OFF_MOD + (size_t)2 * 9 * 3072 * 4)
#define OFF_BAR  (OFF_ROT + (size_t)64 * 32 * 2 * 4)
#define OFF_END  (OFF_BAR + 256)

#define WT_SCAN 0
#define WT_GATE 4224
#define WT_BRR  8320
#define WT_BRG  9344
#define WT_OUT  10368

#define LDS_BYTES 161792
#define SCAN_GB   80896

struct Params {
  const float* x; const float* c; const float* ctx; const float* c_ctx;
  const float* norm_gain; const float* w_ada; const float* b_ada; const float* w_in;
  const float* ret_decay; const float* gla_w_up; const float* gla_b_up;
  const float* ret_norm_gain; const float* gla_norm_gain;
  const float* w_br_ret; const float* w_br_gla; const float* w_out; const float* final_gain;
  float* out; char* ws;
};

__device__ __forceinline__ u16 f2bf(float f) {
  __bf16 h = (__bf16)f;
  return *(u16*)&h;
}
__device__ __forceinline__ float bf2f(u16 h) { return __uint_as_float(((unsigned)h) << 16); }
__device__ __forceinline__ float sigmoidf_(float x) { return 1.f / (1.f + __expf(-x)); }
__device__ __forceinline__ float siluf_(float x) { return x / (1.f + __expf(-x)); }

__device__ __forceinline__ int opaque_tid() { int t = threadIdx.x; asm volatile("" : "+v"(t)); return t; }

__device__ __forceinline__ float wave_sum(float v) {
#pragma unroll
  for (int o = 32; o > 0; o >>= 1) v += __shfl_xor(v, o, 64);
  return v;
}

__device__ __forceinline__ const float* wt_src(const Params& p, int l, int n, int& ld) {
  if (n < WT_GATE) {
    int tile = n >> 7, cc = n & 127;
    int col;
    if (tile < 8) {
      int d = (cc & 64) | ((cc & 16) << 1) | ((cc & 32) >> 1) | (cc & 15);
      col = tile * 128 + d;
    } else if (tile < 16) col = 1024 + (tile - 8) * 128 + cc;
    else if (tile < 24) col = 3072 + (tile - 16) * 128 + cc;
    else if (tile < 32) col = 4096 + (tile - 24) * 128 + cc;
    else { if (cc >= 16) { ld = 0; return nullptr; } col = 6144 + cc; }
    ld = INW; return p.w_in + (size_t)l * DM * INW + col;
  } else if (n < WT_BRR) {
    int g = n - WT_GATE; int col;
    if (g < 1024) col = 2048 + g;
    else if (g < 2048) col = 5120 + (g - 1024);
    else if (g < 3072) col = 6160 + (g - 2048);
    else col = 7184 + (g - 3072);
    ld = INW; return p.w_in + (size_t)l * DM * INW + col;
  } else if (n < WT_BRG) { ld = DM; return p.w_br_ret + (size_t)l * DM * DM + (n - WT_BRR); }
  else if (n < WT_OUT)   { ld = DM; return p.w_br_gla + (size_t)l * DM * DM + (n - WT_BRG); }
  else                   { ld = DM; return p.w_out    + (size_t)l * DM * DM + (n - WT_OUT); }
}

#define WT_UNITS (178 * 16)
__device__ __forceinline__ void wt_unit(const Params& p, int l, int unit, char* smem) {
  float* tile = (float*)smem;
  int nb = unit >> 4, kb = unit & 15;
  int tid = opaque_tid();
  int n0 = nb * 64, k0 = kb * 64;
  {
    int nl = tid & 63, kq = tid >> 6;
    int ld; const float* src = wt_src(p, l, n0 + nl, ld);
#pragma unroll
    for (int i = 0; i < 8; ++i) {
      int kl = kq + 8 * i;
      float v = src ? src[(size_t)(k0 + kl) * ld] : 0.f;
      tile[kl * 65 + nl] = v;
    }
  }
  __syncthreads();
  {
    int nl = tid >> 3, kq = tid & 7;
    bf16x8 o;
#pragma unroll
    for (int j = 0; j < 8; ++j) o[j] = (short)f2bf(tile[(kq * 8 + j) * 65 + nl]);
    u16* wt = (u16*)(p.ws + OFF_WT);
    *(bf16x8*)(wt + (size_t)(n0 + nl) * 1024 + k0 + kq * 8) = o;
  }
  __syncthreads();
}

__device__ __forceinline__ void mod_unit(const Params& p, int unit, char* smem) {
  float* sc = (float*)smem;
  float* red = sc + 9 * 1024;
  int l = unit / 48, jb = unit % 48;
  int tid = opaque_tid();
  for (int i = tid; i < 9 * 1024; i += NTHREADS) {
    int r = i >> 10, k = i & 1023;
    float v = (r < 8) ? p.c[r * 1024 + k] : p.c_ctx[k];
    sc[i] = siluf_(v);
  }
  __syncthreads();
  int jl = tid & 63, kg = tid >> 6;
  int j = jb * 64 + jl;
  float acc[9];
#pragma unroll
  for (int r = 0; r < 9; ++r) acc[r] = 0.f;
  const float* w = p.w_ada + (size_t)l * DM * 3072 + j;
#pragma unroll 16
  for (int k = kg * 128; k < kg * 128 + 128; ++k) {
    float wv = w[(size_t)k * 3072];
#pragma unroll
    for (int r = 0; r < 9; ++r) acc[r] += sc[r * 1024 + k] * wv;
  }
#pragma unroll
  for (int r = 0; r < 9; ++r) red[(kg * 9 + r) * 64 + jl] = acc[r];
  __syncthreads();
  float* mod = (float*)(p.ws + OFF_MOD);
  for (int i = tid; i < 9 * 64; i += NTHREADS) {
    int r = i >> 6, jj = i & 63;
    float s = 0.f;
#pragma unroll
    for (int g = 0; g < 8; ++g) s += red[(g * 9 + r) * 64 + jj];
    mod[((size_t)l * 9 + r) * 3072 + jb * 64 + jj] = s + p.b_ada[l * 3072 + jb * 64 + jj];
  }
  __syncthreads();
}

__device__ __forceinline__ void rot_unit(const Params& p) {
  float* rot = (float*)(p.ws + OFF_ROT);
  for (int i = opaque_tid(); i < 64 * 32; i += NTHREADS) {
    int pos = i >> 5, f = i & 31;
    float inv = exp2f(-(float)f * (13.287712379549449f / 32.f));
    float ang = (float)pos * inv;
    rot[i * 2] = __cosf(ang);
    rot[i * 2 + 1] = __sinf(ang);
  }
}

__device__ __forceinline__ void phase_u(const Params& p, int l) {
  const int tid = opaque_tid(); int wave = tid >> 6, lane = tid & 63;
  const float* mod = (const float*)(p.ws + OFF_MOD) + (size_t)l * 9 * 3072;
  const float* gain = p.norm_gain + l * DM;
  u16* U = (u16*)(p.ws + OFF_U);
  for (int row = (blockIdx.x * 8 + wave) * 4; row < MTOT; row += gridDim.x * 32) {
    const float* h; int r;
    if (row < MLAT) { h = (l == 0 ? p.x : p.out) + (size_t)row * DM; r = row >> 12; }
    else { int cr = row - MLAT; h = (l == 0 ? p.ctx : (const float*)(p.ws + OFF_HCTX)) + (size_t)cr * DM; r = 8; }
    float4 v[4][4]; float ss[4];
#pragma unroll
    for (int q = 0; q < 4; ++q) {
      ss[q] = 0.f;
#pragma unroll
      for (int i = 0; i < 4; ++i) v[q][i] = *(const float4*)(h + q * DM + i * 256 + lane * 4);
    }
#pragma unroll
    for (int q = 0; q < 4; ++q) {
#pragma unroll
      for (int i = 0; i < 4; ++i) ss[q] += v[q][i].x * v[q][i].x + v[q][i].y * v[q][i].y + v[q][i].z * v[q][i].z + v[q][i].w * v[q][i].w;
      ss[q] = rsqrtf(wave_sum(ss[q]) * (1.f / 1024.f) + 1e-6f);
    }
    const float* sh = mod + r * 3072;
#pragma unroll
    for (int i = 0; i < 4; ++i) {
      int cidx = i * 256 + lane * 4;
      float4 g = *(const float4*)(gain + cidx);
      float4 s = *(const float4*)(sh + cidx);
      float4 sc = *(const float4*)(sh + 1024 + cidx);
      g.x *= (1.f + sc.x); g.y *= (1.f + sc.y); g.z *= (1.f + sc.z); g.w *= (1.f + sc.w);
#pragma unroll
      for (int q = 0; q < 4; ++q) {
        bf16x4 o;
        o[0] = (short)f2bf(v[q][i].x * ss[q] * g.x + s.x);
        o[1] = (short)f2bf(v[q][i].y * ss[q] * g.y + s.y);
        o[2] = (short)f2bf(v[q][i].z * ss[q] * g.z + s.z);
        o[3] = (short)f2bf(v[q][i].w * ss[q] * g.w + s.w);
        *(bf16x4*)(U + (size_t)(row + q) * DM + cidx) = o;
      }
    }
  }
}

__device__ __forceinline__ void phase_final(const Params& p) {
  const int tid = opaque_tid(); int wave = tid >> 6, lane = tid & 63;
  for (int row = (blockIdx.x * 8 + wave) * 4; row < MLAT; row += gridDim.x * 32) {
    float* h = p.out + (size_t)row * DM;
    float4 v[4][4]; float ss[4];
#pragma unroll
    for (int q = 0; q < 4; ++q) {
      ss[q] = 0.f;
#pragma unroll
      for (int i = 0; i < 4; ++i) v[q][i] = *(const float4*)(h + q * DM + i * 256 + lane * 4);
    }
#pragma unroll
    for (int q = 0; q < 4; ++q) {
#pragma unroll
      for (int i = 0; i < 4; ++i) ss[q] += v[q][i].x * v[q][i].x + v[q][i].y * v[q][i].y + v[q][i].z * v[q][i].z + v[q][i].w * v[q][i].w;
      ss[q] = rsqrtf(wave_sum(ss[q]) * (1.f / 1024.f) + 1e-6f);
    }
#pragma unroll
    for (int i = 0; i < 4; ++i) {
      int cidx = i * 256 + lane * 4;
      float4 g = *(const float4*)(p.final_gain + cidx);
#pragma unroll
      for (int q = 0; q < 4; ++q) {
        float4 o;
        o.x = v[q][i].x * ss[q] * g.x; o.y = v[q][i].y * ss[q] * g.y; o.z = v[q][i].z * ss[q] * g.z; o.w = v[q][i].w * ss[q] * g.w;
        *(float4*)(h + q * DM + cidx) = o;
      }
    }
  }
}

__device__ __forceinline__ int lds_byte(int r, int c) {
  int st = (r >> 4) * 2 + (c >> 5), rr = r & 15, cc = c & 31, ob = rr * 64 + cc * 2;
  return st * 1024 + (ob ^ (((ob >> 9) & 1) << 5));
}

__device__ __forceinline__ void stage_half(int tid, const u16* __restrict__ g, size_t ld, int row0, int k0, char* lds_half) {
#pragma unroll
  for (int i = 0; i < 2; ++i) {
    int b = tid * 16 + i * 8192;
    int st = b >> 10, sb = b & 1023, swz = sb ^ (((sb >> 9) & 1) << 5);
    int R = (st >> 1) * 16 + (swz >> 6), C = (st & 1) * 32 + ((swz & 63) >> 1);
    __builtin_amdgcn_global_load_lds((const unsigned*)(g + (size_t)(row0 + R) * ld + k0 + C),
                                     (__attribute__((address_space(3))) unsigned*)(lds_half + b), 16, 0, 0);
  }
}

__device__ __forceinline__ void gemm_mainloop(const u16* __restrict__ A, size_t lda, int row0,
                                              const u16* __restrict__ Bt, size_t ldb, int col0,
                                              int K, char* smem, f32x4 (&acc)[4][4], int tid) {
  const int wid = tid >> 6, lane = tid & 63;
  const int wr = wid >> 1, wc = wid & 1, fr = lane & 15, fq = lane >> 4;
  const int nt = K / 64;
  asm volatile("s_waitcnt vmcnt(0)" ::: "memory");
  __syncthreads();
  stage_half(tid, A, lda, row0, 0, smem);
  stage_half(tid, A, lda, row0 + 128, 0, smem + 16384);
  stage_half(tid, Bt, ldb, col0, 0, smem + 32768);
  stage_half(tid, A, lda, row0, 64, smem + 49152);
  stage_half(tid, A, lda, row0 + 128, 64, smem + 49152 + 16384);
  stage_half(tid, Bt, ldb, col0, 64, smem + 49152 + 32768);
  int cb = 0;
  for (int t = 0; t < nt; ++t) {
    if (t + 1 < nt) asm volatile("s_waitcnt vmcnt(6)" ::: "memory");
    else asm volatile("s_waitcnt vmcnt(0)" ::: "memory");
    __builtin_amdgcn_s_barrier();
    asm volatile("" ::: "memory");
    char* cur = smem + cb * 49152;
    if (t + 2 < nt) {
      int nb = cb + 2; if (nb >= 3) nb -= 3;
      char* nxt = smem + nb * 49152;
      int k0 = (t + 2) * 64;
      stage_half(tid, A, lda, row0, k0, nxt);
      stage_half(tid, A, lda, row0 + 128, k0, nxt + 16384);
      stage_half(tid, Bt, ldb, col0, k0, nxt + 32768);
    }
    const char* sa = cur + (wr >> 1) * 16384;
    const char* sb = cur + 32768;
#pragma unroll
    for (int ks = 0; ks < 2; ++ks) {
      bf16x8 af[4], bfr[4];
#pragma unroll
      for (int m = 0; m < 4; ++m) af[m] = *(const bf16x8*)(sa + lds_byte((wr & 1) * 64 + m * 16 + fr, ks * 32 + fq * 8));
#pragma unroll
      for (int n = 0; n < 4; ++n) bfr[n] = *(const bf16x8*)(sb + lds_byte(wc * 64 + n * 16 + fr, ks * 32 + fq * 8));
#pragma unroll
      for (int m = 0; m < 4; ++m)
#pragma unroll
        for (int n = 0; n < 4; ++n)
          acc[m][n] = __builtin_amdgcn_mfma_f32_16x16x32_bf16(af[m], bfr[n], acc[m][n], 0, 0, 0);
    }
    cb = cb + 1; if (cb >= 3) cb -= 3;
  }
  __syncthreads();
  __builtin_amdgcn_sched_barrier(0);
}

#define ZERO_ACC(a) _Pragma("unroll") for (int _m = 0; _m < 4; ++_m) _Pragma("unroll") for (int _n = 0; _n < 4; ++_n) a[_m][_n] = (f32x4){0.f, 0.f, 0.f, 0.f}

#define EP_STRIDE 68
#define EP_BYTES  (64 * EP_STRIDE * 4)
#define STAT_OFF  159744
__device__ __forceinline__ float* stage_acc(char* smem, int wid, int fr, int fq, const f32x4 (&acc)[4][4]) {
  float* e = (float*)(smem + wid * EP_BYTES);
#pragma unroll
  for (int m = 0; m < 4; ++m)
#pragma unroll
    for (int n = 0; n < 4; ++n)
#pragma unroll
      for (int j = 0; j < 4; ++j) e[(m * 16 + fq * 4 + j) * EP_STRIDE + n * 16 + fr] = acc[m][n][j];
  return e;
}
__device__ __forceinline__ bf16x8 pack8(const float (&v)[8]) {
  bf16x8 o;
#pragma unroll
  for (int x = 0; x < 8; ++x) o[x] = (short)f2bf(v[x]);
  return o;
}
#define LOAD8(dst, ptr) { float4 _a = *(const float4*)(ptr); float4 _b = *(const float4*)((ptr) + 4); \
  dst[0] = _a.x; dst[1] = _a.y; dst[2] = _a.z; dst[3] = _a.w; dst[4] = _b.x; dst[5] = _b.y; dst[6] = _b.z; dst[7] = _b.w; }

__device__ __forceinline__ void gemm_scan_in(const Params& p, int mt, int ntile, char* smem) {
  const int tid = opaque_tid();
  const u16* U = (const u16*)(p.ws + OFF_U);
  const u16* WT = (const u16*)(p.ws + OFF_WT) + (size_t)WT_SCAN * 1024;
  f32x4 acc[4][4]; ZERO_ACC(acc);
  gemm_mainloop(U, 1024, mt * 256, WT, 1024, ntile * 128, 1024, smem, acc, tid);
  const int wid = tid >> 6, lane = tid & 63;
  const int wr = wid >> 1, wc = wid & 1, fr = lane & 15, fq = lane >> 4;
  const float* e = stage_acc(smem, wid, fr, fq, acc);
  const int rr = lane >> 3, c8 = (lane & 7) * 8;
  if (ntile == 32) {
    float* GLRb = (float*)(p.ws + OFF_GLR) + (size_t)mt * 256 * 16;
    if (wc == 0 && c8 < 16) {
#pragma unroll
      for (int i = 0; i < 8; ++i) {
        int r = rr + 8 * i;
        float v[8]; LOAD8(v, e + r * EP_STRIDE + c8);
        float* d = GLRb + (unsigned)(wr * 64 + r) * 16u + c8;
        *(float4*)d = make_float4(v[0], v[1], v[2], v[3]);
        *(float4*)(d + 4) = make_float4(v[4], v[5], v[6], v[7]);
      }
    }
    return;
  }
  u16* Sb = (u16*)(p.ws + OFF_S) + (size_t)mt * 256 * 4096 + ntile * 128 + wc * 64 + c8;
  const bool scaled = (ntile < 4) || (ntile >= 16 && ntile < 20);
  const float scl = scaled ? 0.08838834764831845f : 1.f;
  if (ntile < 8 && mt < 128) {
    const float* rot = (const float*)(p.ws + OFF_ROT);
    const int tbase = (mt & 15) * 256 + wr * 64;
    const int pair = (c8 >> 4) & 1, f0 = ((c8 >> 5) & 1) * 16 + (c8 & 15);
#pragma unroll
    for (int i = 0; i < 8; ++i) {
      int r = rr + 8 * i;
      int t = tbase + r;
      unsigned pos = (wc == 0) ? (t >> 6) : (t & 63);
      float v[8], vp[8], cs[16];
      LOAD8(v, e + r * EP_STRIDE + c8);
      LOAD8(vp, e + r * EP_STRIDE + (c8 ^ 16));
      const float* rp = rot + (pos * 32u + f0) * 2u;
      LOAD8(cs, rp); { float* c2 = cs + 8; LOAD8(c2, rp + 8); }
      float o[8];
#pragma unroll
      for (int x = 0; x < 8; ++x) {
        float c = cs[2 * x], s = cs[2 * x + 1];
        o[x] = (pair == 0 ? (v[x] * c - vp[x] * s) : (v[x] * c + vp[x] * s)) * scl;
      }
      *(bf16x8*)(Sb + (unsigned)(wr * 64 + r) * 4096u) = pack8(o);
    }
  } else {
#pragma unroll
    for (int i = 0; i < 8; ++i) {
      int r = rr + 8 * i;
      float v[8]; LOAD8(v, e + r * EP_STRIDE + c8);
#pragma unroll
      for (int x = 0; x < 8; ++x) v[x] *= scl;
      *(bf16x8*)(Sb + (unsigned)(wr * 64 + r) * 4096u) = pack8(v);
    }
  }
}

__device__ __forceinline__ void gemm_gate(const Params& p, int l, int mt, int ntile, char* smem) {
  const int tid = opaque_tid();
  const u16* U = (const u16*)(p.ws + OFF_U);
  const u16* WT = (const u16*)(p.ws + OFF_WT) + (size_t)WT_GATE * 1024;
  const int wid = tid >> 6, lane = tid & 63;
  const int wr = wid >> 1, wc = wid & 1, fr = lane & 15, fq = lane >> 4;
  float* stat = (float*)(smem + STAT_OFF);
  const bool is_norm = ntile < 16;
  const int branch = ntile >> 3;
  const u16* RGb = (const u16*)(p.ws + OFF_RG) + (size_t)mt * 256 * 2048 + (branch & 1) * 1024;
  if (is_norm) {
    __syncthreads();
    int head = (ntile & 7) >> 1;
    for (int r0 = 0; r0 < 32; r0 += 8) {
      bf16x4 vv[8];
#pragma unroll
      for (int i = 0; i < 8; ++i) vv[i] = *(const bf16x4*)(RGb + (unsigned)(wid * 32 + r0 + i) * 2048u + head * 256 + lane * 4);
#pragma unroll
      for (int i = 0; i < 8; ++i) {
        unsigned rl = wid * 32 + r0 + i;
        float a0 = bf2f((u16)vv[i][0]), a1 = bf2f((u16)vv[i][1]), a2 = bf2f((u16)vv[i][2]), a3 = bf2f((u16)vv[i][3]);
        float s1 = a0 + a1 + a2 + a3, s2 = a0 * a0 + a1 * a1 + a2 * a2 + a3 * a3;
        s1 = wave_sum(s1); s2 = wave_sum(s2);
        float sa, sb;
        if (branch == 0) {
          float mu = s1 * (1.f / 256.f);
          float var = fmaxf(s2 * (1.f / 256.f) - mu * mu, 0.f);
          sa = rsqrtf(var + 1e-6f); sb = -mu * sa;
        } else { sa = rsqrtf(s2 * (1.f / 256.f) + 1e-6f); sb = 0.f; }
        if (lane == 0) { stat[rl * 2] = sa; stat[rl * 2 + 1] = sb; }
      }
    }
  }
  f32x4 acc[4][4]; ZERO_ACC(acc);
  gemm_mainloop(U, 1024, mt * 256, WT, 1024, ntile * 128, 1024, smem, acc, tid);
  const float* e = stage_acc(smem, wid, fr, fq, acc);
  const int rr = lane >> 3, c8 = (lane & 7) * 8;
  u16* Sb = (u16*)(p.ws + OFF_S) + (size_t)mt * 256 * 4096;
  if (is_norm) {
    const float* gain = (branch == 0 ? p.ret_norm_gain : p.gla_norm_gain) + l * 1024;
    const unsigned cin = (ntile & 7) * 128 + wc * 64 + c8;
    float gn[8]; LOAD8(gn, gain + cin);
#pragma unroll
    for (int i = 0; i < 8; ++i) {
      int r = rr + 8 * i;
      unsigned rl = wr * 64 + r;
      float v[8]; LOAD8(v, e + r * EP_STRIDE + c8);
      bf16x8 xr = *(const bf16x8*)(RGb + rl * 2048u + cin);
      float sa = stat[rl * 2], sb = stat[rl * 2 + 1];
      float o[8];
#pragma unroll
      for (int x = 0; x < 8; ++x) o[x] = (bf2f((u16)xr[x]) * sa + sb) * gn[x] * siluf_(v[x]);
      *(bf16x8*)(Sb + rl * 4096u + 2048u + branch * 1024 + cin) = pack8(o);
    }
  } else {
    const unsigned cout = (ntile - 16) * 128 + wc * 64 + c8;
#pragma unroll
    for (int i = 0; i < 8; ++i) {
      int r = rr + 8 * i;
      float v[8]; LOAD8(v, e + r * EP_STRIDE + c8);
#pragma unroll
      for (int x = 0; x < 8; ++x) v[x] = sigmoidf_(v[x]);
      *(bf16x8*)(Sb + (unsigned)(wr * 64 + r) * 4096u + cout) = pack8(v);
    }
  }
}

__device__ __forceinline__ void gemm_merge(const Params& p, int mt, int ntile, char* smem) {
  const int tid = opaque_tid();
  const u16* S = (const u16*)(p.ws + OFF_S);
  const u16* WT = (const u16*)(p.ws + OFF_WT);
  const int wid = tid >> 6, lane = tid & 63;
  const int wr = wid >> 1, wc = wid & 1, fr = lane & 15, fq = lane >> 4;
  const int rr = lane >> 3, c8 = (lane & 7) * 8;
  const unsigned c0 = ntile * 128 + wc * 64 + c8;
  const u16* Sb = S + (size_t)mt * 256 * 4096;
  u16* MGb = (u16*)(p.ws + OFF_U) + (size_t)mt * 256 * 1024;
  f32x4 acc[4][4];
  ZERO_ACC(acc);
  gemm_mainloop(S + 2048, 4096, mt * 256, WT + (size_t)WT_BRR * 1024, 1024, ntile * 128, 1024, smem, acc, tid);
  {
    const float* e = stage_acc(smem, wid, fr, fq, acc);
#pragma unroll
    for (int i = 0; i < 8; ++i) {
      int r = rr + 8 * i;
      unsigned rl = wr * 64 + r;
      float v[8]; LOAD8(v, e + r * EP_STRIDE + c8);
      bf16x8 ma = *(const bf16x8*)(Sb + rl * 4096u + c0);
#pragma unroll
      for (int x = 0; x < 8; ++x) v[x] *= bf2f((u16)ma[x]);
      *(bf16x8*)(MGb + rl * 1024u + c0) = pack8(v);
    }
  }
  __builtin_amdgcn_sched_barrier(0);
  ZERO_ACC(acc);
  gemm_mainloop(S + 3072, 4096, mt * 256, WT + (size_t)WT_BRG * 1024, 1024, ntile * 128, 1024, smem, acc, tid);
  {
    const float* e = stage_acc(smem, wid, fr, fq, acc);
#pragma unroll
    for (int i = 0; i < 8; ++i) {
      int r = rr + 8 * i;
      unsigned rl = wr * 64 + r;
      float v[8]; LOAD8(v, e + r * EP_STRIDE + c8);
      bf16x8 mb = *(const bf16x8*)(Sb + rl * 4096u + 1024u + c0);
      bf16x8 t0 = *(const bf16x8*)(MGb + rl * 1024u + c0);
#pragma unroll
      for (int x = 0; x < 8; ++x) v[x] = bf2f((u16)t0[x]) + v[x] * bf2f((u16)mb[x]);
      *(bf16x8*)(MGb + rl * 1024u + c0) = pack8(v);
    }
  }
}

__device__ __forceinline__ void gemm_out(const Params& p, int l, int mt, int ntile, char* smem) {
  const int tid = opaque_tid();
  const u16* MG = (const u16*)(p.ws + OFF_U);
  const u16* WT = (const u16*)(p.ws + OFF_WT) + (size_t)WT_OUT * 1024;
  const int wid = tid >> 6, lane = tid & 63;
  const int wr = wid >> 1, wc = wid & 1, fr = lane & 15, fq = lane >> 4;
  const int rr = lane >> 3, c8 = (lane & 7) * 8;
  const unsigned c0 = ntile * 128 + wc * 64 + c8;
  f32x4 acc[4][4]; ZERO_ACC(acc);
  gemm_mainloop(MG, 1024, mt * 256, WT, 1024, ntile * 128, 1024, smem, acc, tid);
  const float* e = stage_acc(smem, wid, fr, fq, acc);
  const float* hin; float* hout; int rmod;
  if (mt < 128) { hin = (l == 0 ? p.x : p.out) + (size_t)mt * 256 * DM; hout = p.out + (size_t)mt * 256 * DM; rmod = mt >> 4; }
  else { hin = p.ctx + (size_t)(mt - 128) * 256 * DM; hout = (float*)(p.ws + OFF_HCTX) + (size_t)(mt - 128) * 256 * DM; rmod = 8; }
  const float* gate = (const float*)(p.ws + OFF_MOD) + (size_t)l * 9 * 3072 + rmod * 3072 + 2048;
  float gt8[8]; LOAD8(gt8, gate + c0);
#pragma unroll
  for (int i = 0; i < 8; ++i) {
    int r = rr + 8 * i;
    unsigned o = (unsigned)(wr * 64 + r) * 1024u + c0;
    float v[8], hv[8];
    LOAD8(v, e + r * EP_STRIDE + c8);
    LOAD8(hv, hin + o);
    *(float4*)(hout + o) = make_float4(hv[0] + gt8[0] * v[0], hv[1] + gt8[1] * v[1], hv[2] + gt8[2] * v[2], hv[3] + gt8[3] * v[3]);
    *(float4*)(hout + o + 4) = make_float4(hv[4] + gt8[4] * v[4], hv[5] + gt8[5] * v[5], hv[6] + gt8[6] * v[6], hv[7] + gt8[7] * v[7]);
  }
}

#define OFF_VECS OFF_WT
__device__ __forceinline__ float logsig16(float x) { return (fminf(x, 0.f) - __logf(1.f + __expf(-fabsf(x)))) * (1.f / 16.f); }

__device__ __forceinline__ void gla_prepass_unit(const Params& p, int l, int unit, char* smem) {
  const int tid = opaque_tid();
  const int b = unit / 68, cid = unit % 68;
  const int base = cid < 4 ? (MLAT + b * 256 + cid * 64) : (b * 4096 + (cid - 4) * 64);
  float* GLRS = (float*)smem;
  __syncthreads();
  if (tid < 256) {
    const float* GLR = (const float*)(p.ws + OFF_GLR) + (size_t)base * 16;
    *(float4*)(GLRS + tid * 4) = *(const float4*)(GLR + tid * 4);
  }
  float wf[16], wb[16];
  {
    const float* w0 = p.gla_w_up + (size_t)(l * 2 + 0) * 16 * 512 + tid;
    const float* w1 = p.gla_w_up + (size_t)(l * 2 + 1) * 16 * 512 + tid;
#pragma unroll
    for (int r = 0; r < 16; ++r) { wf[r] = w0[r * 512]; wb[r] = w1[r * 512]; }
  }
  const float bf_ = p.gla_b_up[(l * 2 + 0) * 512 + tid], bb_ = p.gla_b_up[(l * 2 + 1) * 512 + tid];
  __syncthreads();
  u16* Sq = (u16*)(p.ws + OFF_S) + (size_t)base * 4096 + 2048 + tid;
  u16* Ub = (u16*)(p.ws + OFF_U) + (size_t)base * 1024 + tid;
  float accF = 0.f, accB = 0.f;
#pragma unroll 8
  for (int u = 0; u < 32; ++u) {
    const int i = 31 - u;
    const float4* gr = (const float4*)(GLRS + i * 16);
    float4 g0 = gr[0], g1 = gr[1], g2 = gr[2], g3 = gr[3];
    float xf = bf_, xb = bb_;
    xf += g0.x * wf[0] + g0.y * wf[1] + g0.z * wf[2] + g0.w * wf[3] + g1.x * wf[4] + g1.y * wf[5] + g1.z * wf[6] + g1.w * wf[7]
        + g2.x * wf[8] + g2.y * wf[9] + g2.z * wf[10] + g2.w * wf[11] + g3.x * wf[12] + g3.y * wf[13] + g3.z * wf[14] + g3.w * wf[15];
    xb += g0.x * wb[0] + g0.y * wb[1] + g0.z * wb[2] + g0.w * wb[3] + g1.x * wb[4] + g1.y * wb[5] + g1.z * wb[6] + g1.w * wb[7]
        + g2.x * wb[8] + g2.y * wb[9] + g2.z * wb[10] + g2.w * wb[11] + g3.x * wb[12] + g3.y * wb[13] + g3.z * wb[14] + g3.w * wb[15];
    const float laf = logsig16(xf), lab = logsig16(xb);
    const float relf = -accF; accF += laf;
    accB += lab; const float relb = accB;
    const float q = bf2f(Sq[(unsigned)i * 4096u]), k = bf2f(Sq[(unsigned)i * 4096u + 512u]);
    Sq[(unsigned)i * 4096u] = f2bf(q * __expf(relf));
    Sq[(unsigned)i * 4096u + 512u] = f2bf(k * __expf(-relf));
    Ub[(unsigned)i * 1024u] = f2bf(q * __expf(relb));
    Ub[(unsigned)i * 1024u + 512u] = f2bf(k * __expf(-relb));
  }
  float accF2 = 0.f, accB2 = 0.f;
#pragma unroll 8
  for (int u = 0; u < 32; ++u) {
    const int i = 32 + u;
    const float4* gr = (const float4*)(GLRS + i * 16);
    float4 g0 = gr[0], g1 = gr[1], g2 = gr[2], g3 = gr[3];
    float xf = bf_, xb = bb_;
    xf += g0.x * wf[0] + g0.y * wf[1] + g0.z * wf[2] + g0.w * wf[3] + g1.x * wf[4] + g1.y * wf[5] + g1.z * wf[6] + g1.w * wf[7]
        + g2.x * wf[8] + g2.y * wf[9] + g2.z * wf[10] + g2.w * wf[11] + g3.x * wf[12] + g3.y * wf[13] + g3.z * wf[14] + g3.w * wf[15];
    xb += g0.x * wb[0] + g0.y * wb[1] + g0.z * wb[2] + g0.w * wb[3] + g1.x * wb[4] + g1.y * wb[5] + g1.z * wb[6] + g1.w * wb[7]
        + g2.x * wb[8] + g2.y * wb[9] + g2.z * wb[10] + g2.w * wb[11] + g3.x * wb[12] + g3.y * wb[13] + g3.z * wb[14] + g3.w * wb[15];
    const float laf = logsig16(xf), lab = logsig16(xb);
    accF2 += laf; const float relf = accF2;
    const float relb = -accB2; accB2 += lab;
    const float q = bf2f(Sq[(unsigned)i * 4096u]), k = bf2f(Sq[(unsigned)i * 4096u + 512u]);
    Sq[(unsigned)i * 4096u] = f2bf(q * __expf(relf));
    Sq[(unsigned)i * 4096u + 512u] = f2bf(k * __expf(-relf));
    Ub[(unsigned)i * 1024u] = f2bf(q * __expf(relb));
    Ub[(unsigned)i * 1024u + 512u] = f2bf(k * __expf(-relb));
  }
  float* V0 = (float*)(p.ws + OFF_VECS) + ((size_t)(0 * 544 + b * 68 + cid) * 2) * 512 + tid;
  float* V1 = (float*)(p.ws + OFF_VECS) + ((size_t)(1 * 544 + b * 68 + cid) * 2) * 512 + tid;
  V0[0] = __expf(accF);  V0[512] = __expf(accF2);
  V1[0] = __expf(accB2); V1[512] = __expf(accB);
}

#define L_QR   0
#define L_KR   17408
#define L_V    34816
#define L_SGT  44032
#define L_P    61440
#undef  SCAN_GB
#define SCAN_GB 70656

__device__ __forceinline__ int off128(int row, int col) { return row * 272 + col * 2; }
__device__ __forceinline__ int off64(int row, int col) { return row * 144 + col * 2; }

template <int RS>
__device__ __forceinline__ bf16x8 tr_frag(unsigned img_addr, int r0, int c0, int lane) {
  const int g = lane >> 4, q = (lane & 15) >> 2, pp = lane & 3;
  unsigned a = img_addr + (unsigned)((r0 + 8 * g + q) * RS + (c0 + 4 * pp) * 2);
  bf16x4 lo, hi;
  asm volatile("ds_read_b64_tr_b16 %0, %2\n\tds_read_b64_tr_b16 %1, %2 offset:%3\n\ts_waitcnt lgkmcnt(0)"
               : "=&v"(lo), "=&v"(hi) : "v"(a), "n"(4 * RS) : "memory");
  bf16x8 r;
  r[0] = lo[0]; r[1] = lo[1]; r[2] = lo[2]; r[3] = lo[3]; r[4] = hi[0]; r[5] = hi[1]; r[6] = hi[2]; r[7] = hi[3];
  return r;
}

__device__ __forceinline__ bf16x8 scale8(bf16x8 v, float f) {
  bf16x8 o;
#pragma unroll
  for (int x = 0; x < 8; ++x) o[x] = (short)f2bf(bf2f((u16)v[x]) * f);
  return o;
}

__device__ __forceinline__ void lds_barrier() { asm volatile("s_waitcnt lgkmcnt(0)" ::: "memory"); __builtin_amdgcn_s_barrier(); asm volatile("" ::: "memory"); }

template <int branch>
__device__ __forceinline__ void scan_item(const Params& p, int l, int item, char* smem) {
  const int b = (item >> 4) & 7, h = (item >> 2) & 3, slice = item & 3;
  const int tid = opaque_tid(), wid = __builtin_amdgcn_readfirstlane(tid >> 6), lane = tid & 63;
  const int dir = wid >> 2, gw = wid & 3, gt = tid & 255;
  const int fr = lane & 15, fq = lane >> 4;
  char* G = smem + dir * SCAN_GB;
  const unsigned Ga = (unsigned)(size_t)G;
  const u16* S = (const u16*)(p.ws + OFF_S);
  u16* RG = (u16*)(p.ws + OFF_RG);
  const u16* qsrc; unsigned qstride;
  if (branch == 0) { qsrc = S + h * 128; qstride = 4096; }
  else if (dir == 0) { qsrc = S + 2048 + h * 128; qstride = 4096; }
  else { qsrc = (const u16*)(p.ws + OFF_U) + h * 128; qstride = 1024; }
  const int voff = branch * 2048 + 1024 + h * 256 + slice * 64;
  const int ooff = branch * 1024 + h * 256 + slice * 64;
  float lg = 0.f, egc = 1.f;
  if (branch == 0) { lg = __logf(1.f - __expf(p.ret_decay[(l * 2 + dir) * 4 + h])); egc = __expf(32.f * lg); }
  const float* VECS = (const float*)(p.ws + OFF_VECS) + ((size_t)(dir * 544 + b * 68) * 2) * 512 + h * 128;
  f32x4 st[2][4];
#pragma unroll
  for (int m = 0; m < 2; ++m)
#pragma unroll
    for (int n = 0; n < 4; ++n) st[m][n] = (f32x4){0.f, 0.f, 0.f, 0.f};

  const int qj = gt >> 4, qc = gt & 15;
  const int vj = gt >> 3, vc = gt & 7;
  bf16x8 pq[4], pk[4], pv[2];
  float4 peg[2], pel[2];
  auto prefetch = [&](int s) {
    int base, cid;
    if (s < 4) { int cc = dir ? 3 - s : s; base = MLAT + b * 256 + cc * 64; cid = cc; }
    else { int c = s - 4; int cc = dir ? 63 - c : c; base = b * 4096 + cc * 64; cid = 4 + cc; }
#pragma unroll
    for (int i = 0; i < 4; ++i) {
      int jp = qj + 16 * i;
      unsigned ro = (unsigned)(base + (dir ? 63 - jp : jp)) * qstride + qc * 8;
      pq[i] = *(const bf16x8*)(qsrc + ro);
      pk[i] = *(const bf16x8*)(qsrc + ro + 512);
    }
#pragma unroll
    for (int i = 0; i < 2; ++i) {
      int jp = vj + 32 * i;
      pv[i] = *(const bf16x8*)(S + (size_t)(base + (dir ? 63 - jp : jp)) * 4096 + voff + vc * 8);
    }
    if (branch == 1) {
#pragma unroll
      for (int m = 0; m < 2; ++m) {
        int d0 = gw * 32 + m * 16 + fq * 4;
        peg[m] = *(const float4*)(VECS + (size_t)cid * 1024 + d0);
        pel[m] = *(const float4*)(VECS + (size_t)cid * 1024 + 512 + d0);
      }
    }
  };
  prefetch(0);
  __syncthreads();

  for (int s = 0; s < 68; ++s) {
    int base; bool first; bool wout;
    if (s < 4) { int cc = dir ? 3 - s : s; base = MLAT + b * 256 + cc * 64; first = s < 2; wout = (l == 0); }
    else { int c = s - 4; int cc = dir ? 63 - c : c; base = b * 4096 + cc * 64; first = c < 32; wout = true; }
    float4 eg[2], el[2];
#pragma unroll
    for (int m = 0; m < 2; ++m) {
      if (branch == 1) { eg[m] = peg[m]; el[m] = pel[m]; }
      else { eg[m] = make_float4(egc, egc, egc, egc); el[m] = eg[m]; }
    }
#pragma unroll
    for (int i = 0; i < 4; ++i) {
      int jp = qj + 16 * i;
      bf16x8 qv = pq[i], kv_ = pk[i];
      if (branch == 0) {
        float fqs = __expf((float)(jp - 31) * lg), fks = __expf((float)(31 - jp) * lg);
        qv = scale8(qv, fqs); kv_ = scale8(kv_, fks);
      }
      *(bf16x8*)(G + L_QR + off128(jp, qc * 8)) = qv;
      *(bf16x8*)(G + L_KR + off128(jp, qc * 8)) = kv_;
    }
#pragma unroll
    for (int i = 0; i < 2; ++i) *(bf16x8*)(G + L_V + off64(vj + 32 * i, vc * 8)) = pv[i];
#pragma unroll
    for (int m = 0; m < 2; ++m) {
      int d0 = gw * 32 + m * 16 + fq * 4;
#pragma unroll
      for (int n = 0; n < 4; ++n) {
        int e = n * 16 + fr;
        bf16x4 o4;
        o4[0] = (short)f2bf(st[m][n][0] * eg[m].x); o4[1] = (short)f2bf(st[m][n][1] * eg[m].y);
        o4[2] = (short)f2bf(st[m][n][2] * eg[m].z); o4[3] = (short)f2bf(st[m][n][3] * eg[m].w);
        *(bf16x4*)(G + L_SGT + off128(e, d0)) = o4;
      }
    }
    u16 oldv[4][4];
    u16* dstb = RG + (size_t)base * 2048 + ooff + fr;
    if (wout && !first) {
#pragma unroll
      for (int r = 0; r < 4; ++r) {
        int ip = gw * 16 + fq * 4 + r;
        unsigned ro = (unsigned)(dir ? 63 - ip : ip) * 2048u;
#pragma unroll
        for (int n = 0; n < 4; ++n) oldv[r][n] = dstb[ro + n * 16];
      }
    }
    if (s + 1 < 68) prefetch(s + 1);
    lds_barrier();
    f32x4 pt[4], o[4];
#pragma unroll
    for (int n = 0; n < 4; ++n) { pt[n] = (f32x4){0.f, 0.f, 0.f, 0.f}; o[n] = (f32x4){0.f, 0.f, 0.f, 0.f}; }
#pragma unroll
    for (int ks = 0; ks < 4; ++ks) {
      int kc = ks * 32 + fq * 8;
      bf16x8 ka = *(const bf16x8*)(G + L_KR + off128(gw * 16 + fr, kc));
      bf16x8 qa = *(const bf16x8*)(G + L_QR + off128(gw * 16 + fr, kc));
#pragma unroll
      for (int n = 0; n < 4; ++n) {
        bf16x8 qb = *(const bf16x8*)(G + L_QR + off128(n * 16 + fr, kc));
        bf16x8 sb = *(const bf16x8*)(G + L_SGT + off128(n * 16 + fr, kc));
        pt[n] = __builtin_amdgcn_mfma_f32_16x16x32_bf16(ka, qb, pt[n], 0, 0, 0);
        o[n] = __builtin_amdgcn_mfma_f32_16x16x32_bf16(qa, sb, o[n], 0, 0, 0);
      }
    }
#pragma unroll
    for (int n = 0; n < 4; ++n) {
      int ip = n * 16 + fr;
      int j0 = gw * 16 + fq * 4;
      bf16x4 w;
#pragma unroll
      for (int r = 0; r < 4; ++r) {
        int jp = j0 + r;
        bool keep = dir ? (ip > jp) : (ip >= jp);
        w[r] = (short)f2bf(keep ? pt[n][r] : 0.f);
      }
      *(bf16x4*)(G + L_P + off64(ip, j0)) = w;
    }
    lds_barrier();
    {
      const int tg = lane >> 4, tq = (lane & 15) >> 2, tp = lane & 3;
      const unsigned ka0 = Ga + L_KR + (unsigned)((8 * tg + tq) * 272 + (gw * 32 + 4 * tp) * 2);
      const unsigned va0 = Ga + L_V + (unsigned)((8 * tg + tq) * 144 + (4 * tp) * 2);
#pragma unroll
      for (int m = 0; m < 2; ++m) {
        f32x4 kv[4];
#pragma unroll
        for (int n = 0; n < 4; ++n) kv[n] = (f32x4){0.f, 0.f, 0.f, 0.f};
#pragma unroll
        for (int ks = 0; ks < 2; ++ks) {
          int kc = ks * 32 + fq * 8;
          bf16x4 r0, r1, r2, r3, r4, r5, r6, r7, r8, r9;
          asm volatile(
              "ds_read_b64_tr_b16 %0, %10\n\tds_read_b64_tr_b16 %1, %10 offset:1088\n\t"
              "ds_read_b64_tr_b16 %2, %11\n\tds_read_b64_tr_b16 %3, %11 offset:576\n\t"
              "ds_read_b64_tr_b16 %4, %11 offset:32\n\tds_read_b64_tr_b16 %5, %11 offset:608\n\t"
              "ds_read_b64_tr_b16 %6, %11 offset:64\n\tds_read_b64_tr_b16 %7, %11 offset:640\n\t"
              "ds_read_b64_tr_b16 %8, %11 offset:96\n\tds_read_b64_tr_b16 %9, %11 offset:672\n\t"
              "s_waitcnt lgkmcnt(0)"
              : "=&v"(r0), "=&v"(r1), "=&v"(r2), "=&v"(r3), "=&v"(r4), "=&v"(r5), "=&v"(r6), "=&v"(r7), "=&v"(r8), "=&v"(r9)
              : "v"(ka0 + (unsigned)(ks * 32 * 272 + m * 32)), "v"(va0 + (unsigned)(ks * 32 * 144))
              : "memory");
          bf16x8 km = __builtin_shufflevector(r0, r1, 0, 1, 2, 3, 4, 5, 6, 7);
          bf16x8 vb[4];
          vb[0] = __builtin_shufflevector(r2, r3, 0, 1, 2, 3, 4, 5, 6, 7);
          vb[1] = __builtin_shufflevector(r4, r5, 0, 1, 2, 3, 4, 5, 6, 7);
          vb[2] = __builtin_shufflevector(r6, r7, 0, 1, 2, 3, 4, 5, 6, 7);
          vb[3] = __builtin_shufflevector(r8, r9, 0, 1, 2, 3, 4, 5, 6, 7);
          bf16x8 pa;
          if (m == 0) pa = *(const bf16x8*)(G + L_P + off64(gw * 16 + fr, kc));
#pragma unroll
          for (int n = 0; n < 4; ++n) {
            if (m == 0) o[n] = __builtin_amdgcn_mfma_f32_16x16x32_bf16(pa, vb[n], o[n], 0, 0, 0);
            kv[n] = __builtin_amdgcn_mfma_f32_16x16x32_bf16(km, vb[n], kv[n], 0, 0, 0);
          }
        }
#pragma unroll
        for (int n = 0; n < 4; ++n) {
          st[m][n][0] = eg[m].x * el[m].x * st[m][n][0] + el[m].x * kv[n][0];
          st[m][n][1] = eg[m].y * el[m].y * st[m][n][1] + el[m].y * kv[n][1];
          st[m][n][2] = eg[m].z * el[m].z * st[m][n][2] + el[m].z * kv[n][2];
          st[m][n][3] = eg[m].w * el[m].w * st[m][n][3] + el[m].w * kv[n][3];
        }
      }
    }
    if (wout) {
#pragma unroll
      for (int r = 0; r < 4; ++r) {
        int ip = gw * 16 + fq * 4 + r;
        unsigned ro = (unsigned)(dir ? 63 - ip : ip) * 2048u;
#pragma unroll
        for (int n = 0; n < 4; ++n) {
          float v = o[n][r];
          if (!first) v += bf2f(oldv[r][n]);
          dstb[ro + n * 16] = f2bf(v);
        }
      }
    }
    __syncthreads();
  }
}

#define NPHASE 18
__device__ __forceinline__ void run_phase(const Params& p, int ph, char* smem) {
  const int nblk = gridDim.x, bid = blockIdx.x;
  if (ph == 0) {
#ifdef REP_P0
    for (int rep = 0; rep < REP_P0; ++rep)
#endif
    for (int u = bid; u < WT_UNITS + 96 + 1; u += nblk) {
      if (u < 96) mod_unit(p, u, smem);
      else if (u == 96) rot_unit(p);
      else wt_unit(p, 0, u - 97, smem);
    }
    return;
  }
  if (ph == NPHASE - 1) { phase_final(p); return; }
  const int l = (ph - 1) / 8, sp = (ph - 1) % 8;
  switch (sp) {
    case 0:
      phase_u(p, l);
      if (l == 1) for (int u = bid; u < WT_UNITS; u += nblk) wt_unit(p, 1, u, smem);
      break;
    case 1:
#ifdef REP_G1
      for (int rep = 0; rep < REP_G1; ++rep)
#endif
      {
        const int x = bid & 7, per = (nblk - x + 7) >> 3;
        for (int q = bid >> 3; q < 561; q += per) {
          int k = q / 33, r = q - k * 33;
          int mt = (r == 32) ? 8 * k + x : 8 * k + (r >> 2);
          int nt = (r == 32) ? 32 : x + 8 * (r & 3);
          gemm_scan_in(p, mt, nt, smem);
        }
      }
      break;
    case 2: for (int t = bid; t < 544; t += nblk) gla_prepass_unit(p, l, t, smem); break;
    case 3:
#ifdef REP_SCAN
      for (int rep = 0; rep < REP_SCAN; ++rep)
#endif
      for (int t = bid; t < 256; t += nblk) { if (t < 128) scan_item<0>(p, l, t, smem); else scan_item<1>(p, l, t, smem); } break;
    case 4:
#ifdef REP_U
      for (int rep = 0; rep < REP_U; ++rep)
#endif
      phase_u(p, l); break;
    case 5: { int MT = l == 0 ? 136 : 128;
#ifdef REP_G2
      for (int rep = 0; rep < REP_G2; ++rep)
#endif
      {
        const int x = bid & 7, per = (nblk - x + 7) >> 3;
        for (int q = bid >> 3; q < MT * 4; q += per) gemm_gate(p, l, q >> 2, x + 8 * (q & 3), smem);
      } } break;
    case 6: { int MT = l == 0 ? 136 : 128;
#ifdef REP_G3
      for (int rep = 0; rep < REP_G3; ++rep)
#endif
      {
        const int x = bid & 7, per = (nblk - x + 7) >> 3;
        for (int q = bid >> 3; q < MT; q += per) gemm_merge(p, x + 8 * (q >> 3), q & 7, smem);
      } } break;
    case 7: { int MT = l == 0 ? 136 : 128;
      {
        const int x = bid & 7, per = (nblk - x + 7) >> 3;
        for (int q = bid >> 3; q < MT; q += per) gemm_out(p, l, x + 8 * (q >> 3), q & 7, smem);
      } } break;
  }
}

__device__ __forceinline__ void grid_barrier(unsigned* cnt, unsigned target) {
  asm volatile("s_waitcnt vmcnt(0)" ::: "memory");
  __syncthreads();
  if (threadIdx.x == 0) {
    __threadfence();
    __hip_atomic_fetch_add(cnt, 1u, __ATOMIC_RELAXED, __HIP_MEMORY_SCOPE_AGENT);
    while (__hip_atomic_load(cnt, __ATOMIC_RELAXED, __HIP_MEMORY_SCOPE_AGENT) < target) __builtin_amdgcn_s_sleep(2);
    __threadfence();
  }
  __syncthreads();
}

__global__ void __launch_bounds__(NTHREADS) mega(Params p, int ph_lo, int ph_hi, int coop) {
  extern __shared__ __attribute__((aligned(16))) char smem[];
  for (int ph = ph_lo; ph < ph_hi; ++ph) {
    run_phase(p, ph, smem);
    if (coop && ph + 1 < ph_hi) {
      if (ph == ph_lo) cg::this_grid().sync();
      else grid_barrier((unsigned*)(p.ws + OFF_BAR), (unsigned)(ph - ph_lo) * gridDim.x);
    }
  }
}

extern "C" void kernel_launch(void* const* d_in, const int* in_sizes, int n_in,
                              void* d_out, int out_size, void* d_ws, size_t ws_size,
                              hipStream_t stream) {
  Params p{};
  p.x = (const float*)d_in[0]; p.c = (const float*)d_in[1]; p.ctx = (const float*)d_in[2]; p.c_ctx = (const float*)d_in[3];
  p.norm_gain = (const float*)d_in[4]; p.w_ada = (const float*)d_in[5]; p.b_ada = (const float*)d_in[6]; p.w_in = (const float*)d_in[7];
  p.ret_decay = (const float*)d_in[8]; p.gla_w_up = (const float*)d_in[9]; p.gla_b_up = (const float*)d_in[10];
  p.ret_norm_gain = (const float*)d_in[11]; p.gla_norm_gain = (const float*)d_in[12];
  p.w_br_ret = (const float*)d_in[13]; p.w_br_gla = (const float*)d_in[14]; p.w_out = (const float*)d_in[15]; p.final_gain = (const float*)d_in[16];
  p.out = (float*)d_out; p.ws = (char*)d_ws;
  static int grid_blocks = 0;
  if (!grid_blocks) {
    hipFuncSetAttribute((const void*)mega, hipFuncAttributeMaxDynamicSharedMemorySize, LDS_BYTES);
    int dev = 0, cus = 0, per_cu = 0;
    hipGetDevice(&dev);
    hipDeviceGetAttribute(&cus, hipDeviceAttributeMultiprocessorCount, dev);
    hipOccupancyMaxActiveBlocksPerMultiprocessor(&per_cu, mega, NTHREADS, LDS_BYTES);
    if (per_cu < 1) per_cu = 1;
    grid_blocks = cus * 1;
  }
#ifdef MULTI_LAUNCH
  for (int ph = 0; ph < NPHASE; ++ph) {
    mega<<<dim3(grid_blocks), dim3(NTHREADS), LDS_BYTES, stream>>>(p, ph, ph + 1, 0);
  }
#else
  hipMemsetAsync((char*)d_ws + OFF_BAR, 0, 256, stream);
  int lo = 0, hi = NPHASE, coop = 1;
  void* args[] = {&p, &lo, &hi, &coop};
  hipError_t e = hipLaunchCooperativeKernel((void*)mega, dim3(grid_blocks), dim3(NTHREADS), args, LDS_BYTES, stream);
  if (e != hipSuccess) fprintf(stderr, "cooperative launch failed: %s (grid %d)\n", hipGetErrorString(e), grid_blocks);
#endif
}
```

```cpp
#include <hip/hip_runtime.h>
#include <hip/hip_cooperative_groups.h>
#include <cstdio>
namespace cg = cooperative_groups;

typedef unsigned short u16;
using bf16x8 = __attribute__((ext_vector_type(8))) short;
using bf16x4 = __attribute__((ext_vector_type(4))) short;
using f32x4  = __attribute__((ext_vector_type(4))) float;

#define NTHREADS 512
#define DM 1024
#define NB 8
#define SEQL 4096
#define CTXL 256
#define MLAT 32768
#define MCTX 2048
#define MTOT 34816
#define INW 8208

#define OFF_S    0ull
#define OFF_RG   (OFF_S   + (size_t)MTOT * 4096 * 2)
#define OFF_U    (OFF_RG  + (size_t)MTOT * 2048 * 2)
#define OFF_WT   (OFF_U   + (size_t)MTOT * 1024 * 2)
#define WT_ROWS  11392
#define OFF_GLR  (OFF_WT  + (size_t)WT_ROWS * 1024 * 2)
#define OFF_HCTX (OFF_GLR + (size_t)MTOT * 16 * 4)
#define OFF_MOD  (OFF_HCTX+ (size_t)MCTX * 1024 * 4)
#define OFF_ROT  (OFF_MOD + (size_t)2 * 9 * 3072 * 4)
#define OFF_BAR  (OFF_ROT + (size_t)64 * 32 * 2 * 4)
#define OFF_END  (OFF_BAR + 256)

#define WT_SCAN 0
#define WT_GATE 4224
#define WT_BRR  8320
#define WT_BRG  9344
#define WT_OUT  10368

#define LDS_BYTES 161792
#define SCAN_GB   80896

struct Params {
  const float* x; const float* c; const float* ctx; const float* c_ctx;
  const float* norm_gain; const float* w_ada; const float* b_ada; const float* w_in;
  const float* ret_decay; const float* gla_w_up; const float* gla_b_up;
  const float* ret_norm_gain; const float* gla_norm_gain;
  const float* w_br_ret; const float* w_br_gla; const float* w_out; const float* final_gain;
  float* out; char* ws;
};

__device__ __forceinline__ u16 f2bf(float f) {
  __bf16 h = (__bf16)f;
  return *(u16*)&h;
}
__device__ __forceinline__ float bf2f(u16 h) { return __uint_as_float(((unsigned)h) << 16); }
__device__ __forceinline__ float sigmoidf_(float x) { return 1.f / (1.f + __expf(-x)); }
__device__ __forceinline__ float siluf_(float x) { return x / (1.f + __expf(-x)); }

__device__ __forceinline__ int opaque_tid() { int t = threadIdx.x; asm volatile("" : "+v"(t)); return t; }

__device__ __forceinline__ float wave_sum(float v) {
#pragma unroll
  for (int o = 32; o > 0; o >>= 1) v += __shfl_xor(v, o, 64);
  return v;
}

__device__ __forceinline__ const float* wt_src(const Params& p, int l, int n, int& ld) {
  if (n < WT_GATE) {
    int tile = n >> 7, cc = n & 127;
    int col;
    if (tile < 8) {
      int d = (cc & 64) | ((cc & 16) << 1) | ((cc & 32) >> 1) | (cc & 15);
      col = tile * 128 + d;
    } else if (tile < 16) col = 1024 + (tile - 8) * 128 + cc;
    else if (tile < 24) col = 3072 + (tile - 16) * 128 + cc;
    else if (tile < 32) col = 4096 + (tile - 24) * 128 + cc;
    else { if (cc >= 16) { ld = 0; return nullptr; } col = 6144 + cc; }
    ld = INW; return p.w_in + (size_t)l * DM * INW + col;
  } else if (n < WT_BRR) {
    int g = n - WT_GATE; int col;
    if (g < 1024) col = 2048 + g;
    else if (g < 2048) col = 5120 + (g - 1024);
    else if (g < 3072) col = 6160 + (g - 2048);
    else col = 7184 + (g - 3072);
    ld = INW; return p.w_in + (size_t)l * DM * INW + col;
  } else if (n < WT_BRG) { ld = DM; return p.w_br_ret + (size_t)l * DM * DM + (n - WT_BRR); }
  else if (n < WT_OUT)   { ld = DM; return p.w_br_gla + (size_t)l * DM * DM + (n - WT_BRG); }
  else                   { ld = DM; return p.w_out    + (size_t)l * DM * DM + (n - WT_OUT); }
}

#define WT_UNITS (178 * 16)
__device__ __forceinline__ void wt_unit(const Params& p, int l, int unit, char* smem) {
  float* tile = (float*)smem;
  int nb = unit >> 4, kb = unit & 15;
  int tid = opaque_tid();
  int n0 = nb * 64, k0 = kb * 64;
  {
    int nl = tid & 63, kq = tid >> 6;
    int ld; const float* src = wt_src(p, l, n0 + nl, ld);
#pragma unroll
    for (int i = 0; i < 8; ++i) {
      int kl = kq + 8 * i;
      float v = src ? src[(size_t)(k0 + kl) * ld] : 0.f;
      tile[kl * 65 + nl] = v;
    }
  }
  __syncthreads();
  {
    int nl = tid >> 3, kq = tid & 7;
    bf16x8 o;
#pragma unroll
    for (int j = 0; j < 8; ++j) o[j] = (short)f2bf(tile[(kq * 8 + j) * 65 + nl]);
    u16* wt = (u16*)(p.ws + OFF_WT);
    *(bf16x8*)(wt + (size_t)(n0 + nl) * 1024 + k0 + kq * 8) = o;
  }
  __syncthreads();
}

__device__ __forceinline__ void mod_unit(const Params& p, int unit, char* smem) {
  float* sc = (float*)smem;
  float* red = sc + 9 * 1024;
  int l = unit / 48, jb = unit % 48;
  int tid = opaque_tid();
  for (int i = tid; i < 9 * 1024; i += NTHREADS) {
    int r = i >> 10, k = i & 1023;
    float v = (r < 8) ? p.c[r * 1024 + k] : p.c_ctx[k];
    sc[i] = siluf_(v);
  }
  __syncthreads();
  int jl = tid & 63, kg = tid >> 6;
  int j = jb * 64 + jl;
  float acc[9];
#pragma unroll
  for (int r = 0; r < 9; ++r) acc[r] = 0.f;
  const float* w = p.w_ada + (size_t)l * DM * 3072 + j;
#pragma unroll 16
  for (int k = kg * 128; k < kg * 128 + 128; ++k) {
    float wv = w[(size_t)k * 3072];
#pragma unroll
    for (int r = 0; r < 9; ++r) acc[r] += sc[r * 1024 + k] * wv;
  }
#pragma unroll
  for (int r = 0; r < 9; ++r) red[(kg * 9 + r) * 64 + jl] = acc[r];
  __syncthreads();
  float* mod = (float*)(p.ws + OFF_MOD);
  for (int i = tid; i < 9 * 64; i += NTHREADS) {
    int r = i >> 6, jj = i & 63;
    float s = 0.f;
#pragma unroll
    for (int g = 0; g < 8; ++g) s += red[(g * 9 + r) * 64 + jj];
    mod[((size_t)l * 9 + r) * 3072 + jb * 64 + jj] = s + p.b_ada[l * 3072 + jb * 64 + jj];
  }
  __syncthreads();
}

__device__ __forceinline__ void rot_unit(const Params& p) {
  float* rot = (float*)(p.ws + OFF_ROT);
  for (int i = opaque_tid(); i < 64 * 32; i += NTHREADS) {
    int pos = i >> 5, f = i & 31;
    float inv = exp2f(-(float)f * (13.287712379549449f / 32.f));
    float ang = (float)pos * inv;
    rot[i * 2] = __cosf(ang);
    rot[i * 2 + 1] = __sinf(ang);
  }
}

__device__ __forceinline__ void phase_u(const Params& p, int l) {
  const int tid = opaque_tid(); int wave = tid >> 6, lane = tid & 63;
  const float* mod = (const float*)(p.ws + OFF_MOD) + (size_t)l * 9 * 3072;
  const float* gain = p.norm_gain + l * DM;
  u16* U = (u16*)(p.ws + OFF_U);
  for (int row = (blockIdx.x * 8 + wave) * 4; row < MTOT; row += gridDim.x * 32) {
    const float* h; int r;
    if (row < MLAT) { h = (l == 0 ? p.x : p.out) + (size_t)row * DM; r = row >> 12; }
    else { int cr = row - MLAT; h = (l == 0 ? p.ctx : (const float*)(p.ws + OFF_HCTX)) + (size_t)cr * DM; r = 8; }
    float4 v[4][4]; float ss[4];
#pragma unroll
    for (int q = 0; q < 4; ++q) {
      ss[q] = 0.f;
#pragma unroll
      for (int i = 0; i < 4; ++i) v[q][i] = *(const float4*)(h + q * DM + i * 256 + lane * 4);
    }
#pragma unroll
    for (int q = 0; q < 4; ++q) {
#pragma unroll
      for (int i = 0; i < 4; ++i) ss[q] += v[q][i].x * v[q][i].x + v[q][i].y * v[q][i].y + v[q][i].z * v[q][i].z + v[q][i].w * v[q][i].w;
      ss[q] = rsqrtf(wave_sum(ss[q]) * (1.f / 1024.f) + 1e-6f);
    }
    const float* sh = mod + r * 3072;
#pragma unroll
    for (int i = 0; i < 4; ++i) {
      int cidx = i * 256 + lane * 4;
      float4 g = *(const float4*)(gain + cidx);
      float4 s = *(const float4*)(sh + cidx);
      float4 sc = *(const float4*)(sh + 1024 + cidx);
      g.x *= (1.f + sc.x); g.y *= (1.f + sc.y); g.z *= (1.f + sc.z); g.w *= (1.f + sc.w);
#pragma unroll
      for (int q = 0; q < 4; ++q) {
        bf16x4 o;
        o[0] = (short)f2bf(v[q][i].x * ss[q] * g.x + s.x);
        o[1] = (short)f2bf(v[q][i].y * ss[q] * g.y + s.y);
        o[2] = (short)f2bf(v[q][i].z * ss[q] * g.z + s.z);
        o[3] = (short)f2bf(v[q][i].w * ss[q] * g.w + s.w);
        *(bf16x4*)(U + (size_t)(row + q) * DM + cidx) = o;
      }
    }
  }
}

__device__ __forceinline__ void phase_final(const Params& p) {
  const int tid = opaque_tid(); int wave = tid >> 6, lane = tid & 63;
  for (int row = (blockIdx.x * 8 + wave) * 4; row < MLAT; row += gridDim.x * 32) {
    float* h = p.out + (size_t)row * DM;
    float4 v[4][4]; float ss[4];
#pragma unroll
    for (int q = 0; q < 4; ++q) {
      ss[q] = 0.f;
#pragma unroll
      for (int i = 0; i < 4; ++i) v[q][i] = *(const float4*)(h + q * DM + i * 256 + lane * 4);
    }
#pragma unroll
    for (int q = 0; q < 4; ++q) {
#pragma unroll
      for (int i = 0; i < 4; ++i) ss[q] += v[q][i].x * v[q][i].x + v[q][i].y * v[q][i].y + v[q][i].z * v[q][i].z + v[q][i].w * v[q][i].w;
      ss[q] = rsqrtf(wave_sum(ss[q]) * (1.f / 1024.f) + 1e-6f);
    }
#pragma unroll
    for (int i = 0; i < 4; ++i) {
      int cidx = i * 256 + lane * 4;
      float4 g = *(const float4*)(p.final_gain + cidx);
#pragma unroll
      for (int q = 0; q < 4; ++q) {
        float4 o;
        o.x = v[q][i].x * ss[q] * g.x; o.y = v[q][i].y * ss[q] * g.y; o.z = v[q][i].z * ss[q] * g.z; o.w = v[q][i].w * ss[q] * g.w;
        *(float4*)(h + q * DM + cidx) = o;
      }
    }
  }
}

#define PG8_LAS __attribute__((address_space(3)))
typedef unsigned u32x4 __attribute__((ext_vector_type(4)));
namespace pg8 {
constexpr int BM = 256, BK = 64, HALF = 128, HTB = HALF * BK * 2, STAGE_BYTES = 8 * HTB, NXCD = 8, WGM = 8;
__device__ __forceinline__ int lds_byte(int r, int c) { const int st = (r >> 4) * 2 + (c >> 5), rr = r & 15, cc = c & 31, ob = rr * 64 + cc * 2; return st * 1024 + (ob ^ (((ob >> 9) & 1) << 5)); }
__device__ __forceinline__ void stage_rc(int b, int& R, int& C) { const int st = b / 1024, sb = b % 1024, swz = sb ^ (((sb >> 9) & 1) << 5); R = (st >> 1) * 16 + swz / 64; C = (st & 1) * 32 + (swz % 64) / 2; }
__device__ __forceinline__ int perm32(int rho) { const int n = rho >> 4, i = rho & 15; return 8 * (i >> 2) + 4 * n + (i & 3); }
struct Unit { int pm, pn; };
struct Gemm { const u16* A; const u16* Bt; int lda; int M, N, K; };
struct StaticOrder {
  int nM, nN, nwg, G, c;
  __device__ void init(int M, int N, int G_, int c_) { nM = M / BM; nN = N / BM; nwg = nM * nN; G = G_; c = c_; }
  __device__ bool next(int i, Unit& u) const {
    const long L = (long)i * G + c; if (L >= nwg) return false;
    int wgid = (int)L; { const int q = nwg / NXCD, r = nwg % NXCD, xcd = wgid % NXCD, off = wgid / NXCD; wgid = (xcd < r ? xcd * (q + 1) : r * (q + 1) + (xcd - r) * q) + off; }
    const int nig = WGM * nN, gid = wgid / nig, fm = gid * WGM, gsz = (nM - fm) < WGM ? (nM - fm) : WGM;
    u.pm = fm + ((wgid % nig) % gsz); u.pn = (wgid % nig) / gsz; return true;
  }
};
__device__ __forceinline__ unsigned cvt_pk_bf16(float lo, float hi) { unsigned r; asm volatile("v_cvt_pk_bf16_f32 %0, %1, %2" : "=v"(r) : "v"(lo), "v"(hi)); return r; }

template <class Epi>
__device__ __forceinline__ void gemm_phase(PG8_LAS unsigned char* lds, const Gemm g, const StaticOrder& S, const Epi& E, const int tid) {
  const int wid = __builtin_amdgcn_readfirstlane(tid >> 6), lane = tid & 63, wr = wid >> 2, wc = wid & 3, fr = lane & 15, fq = lane >> 4;
  const int K = g.K, nt = K / BK;
  unsigned voffA[2], voffB[2];
#pragma unroll
  for (int i = 0; i < 2; ++i) { int R, C; stage_rc(tid * 16 + i * 8192, R, C); const int Rb = Epi::PERM ? ((R & ~31) + perm32(R & 31)) : R;
    voffA[i] = (unsigned)(R * g.lda + C) * 2u; voffB[i] = (unsigned)(Rb * K + C) * 2u; }
  const size_t kstep = (size_t)(BK * 2);
  const size_t hstepA = (size_t)HALF * g.lda * 2, hstepB = (size_t)HALF * K * 2;
  const size_t tstepA = 2 * hstepA, tstepB = 2 * hstepB;
  const unsigned ldsw = (unsigned)wid * 1024u;
  const int aoff = lds_byte(wr * 64 + fr, fq * 8), boff = lds_byte(wc * 32 + fr, fq * 8);
#define PG8_SA(b, h) (((b) * 2 + (h)) * HTB)
#define PG8_SB(b, h) ((4 + (b) * 2 + (h)) * HTB)
#define PG8_STAGE(bufoff, gbase, voff) do { _Pragma("unroll") for (int _i = 0; _i < 2; ++_i) \
    __builtin_amdgcn_global_load_lds((const unsigned*)((const char*)(gbase) + (voff)[_i]), (PG8_LAS unsigned*)(lds + (bufoff) + ldsw + _i * 8192), 16, 0, 0); } while (0)
#define PG8_LDA(dst, b, h) do { _Pragma("unroll") for (int m = 0; m < 4; ++m) _Pragma("unroll") for (int k = 0; k < 2; ++k) dst[m][k] = *(const PG8_LAS bf16x8*)(lds + PG8_SA(b, h) + aoff + m * 2048 + k * 1024); } while (0)
#define PG8_LDB(dst, b, h) do { _Pragma("unroll") for (int n = 0; n < 2; ++n) _Pragma("unroll") for (int k = 0; k < 2; ++k) dst[n][k] = *(const PG8_LAS bf16x8*)(lds + PG8_SB(b, h) + boff + n * 2048 + k * 1024); } while (0)
#define PG8_MMA(ai, bj, At, Bt) do { __builtin_amdgcn_s_setprio(1); _Pragma("unroll") for (int m = 0; m < 4; ++m) _Pragma("unroll") for (int n = 0; n < 2; ++n) _Pragma("unroll") for (int k = 0; k < 2; ++k) \
    acc[ai][bj][m][n] = __builtin_amdgcn_mfma_f32_16x16x32_bf16(Bt[n][k], At[m][k], acc[ai][bj][m][n], 0, 0, 0); __builtin_amdgcn_s_setprio(0); } while (0)
#define PG8_WAIT_V(n) asm volatile("s_waitcnt vmcnt(" #n ")" ::: "memory")
#define PG8_WAIT_L(n) asm volatile("s_waitcnt lgkmcnt(" #n ")" ::: "memory")
#define PG8_BAR __builtin_amdgcn_s_barrier()
#define PG8_SCHED __builtin_amdgcn_sched_barrier(0)
  Unit cur, nxt; int ui = 0;
  if (!S.next(0, cur)) return;
  f32x4 acc[2][2][4][2];
#pragma unroll
  for (int a = 0; a < 2; ++a)
#pragma unroll
    for (int b = 0; b < 2; ++b)
#pragma unroll
      for (int m = 0; m < 4; ++m)
#pragma unroll
        for (int n = 0; n < 2; ++n) acc[a][b][m][n] = (f32x4){0.f, 0.f, 0.f, 0.f};
  bf16x8 At[4][2], B0[2][2], B1[2][2];
  const char* cA = (const char*)g.A + (size_t)cur.pm * tstepA; const char* cB = (const char*)g.Bt + (size_t)cur.pn * tstepB;
  PG8_STAGE(PG8_SB(0, 0), cB, voffB); PG8_STAGE(PG8_SA(0, 0), cA, voffA); PG8_STAGE(PG8_SB(0, 1), cB + hstepB, voffB); PG8_STAGE(PG8_SA(0, 1), cA + hstepA, voffA);
  if (wr == 1) PG8_BAR;
  PG8_WAIT_V(4); PG8_BAR;
  PG8_STAGE(PG8_SB(1, 0), cB + kstep, voffB); PG8_STAGE(PG8_SA(1, 0), cA + kstep, voffA); PG8_STAGE(PG8_SB(1, 1), cB + hstepB + kstep, voffB);
  PG8_WAIT_V(6); PG8_BAR;
  for (;;) {
    const bool has_next = S.next(ui + 1, nxt);
    const char* nA = has_next ? (const char*)g.A + (size_t)nxt.pm * tstepA : cA; const char* nB = has_next ? (const char*)g.Bt + (size_t)nxt.pn * tstepB : cB;
    for (int t = 0; t < nt; t += 2) {
      const bool last = (t == nt - 2);
      const char* a1 = cA + (size_t)(t + 1) * kstep;
      const char* a2 = last ? nA : cA + (size_t)(t + 2) * kstep; const char* b2 = last ? nB : cB + (size_t)(t + 2) * kstep;
      const char* a3 = a2 + kstep; const char* b3 = b2 + kstep;
      PG8_LDB(B0, 0, 0); PG8_SCHED; PG8_LDA(At, 0, 0); PG8_STAGE(PG8_SA(1, 1), a1 + hstepA, voffA);
      PG8_WAIT_L(8); PG8_BAR; PG8_WAIT_L(0); PG8_MMA(0, 0, At, B0); PG8_BAR; PG8_SCHED;
      PG8_LDB(B1, 0, 1); PG8_STAGE(PG8_SB(0, 0), b2, voffB);
      PG8_BAR; PG8_WAIT_L(0); PG8_MMA(0, 1, At, B1); PG8_BAR;
      PG8_LDA(At, 0, 1); PG8_STAGE(PG8_SA(0, 0), a2, voffA);
      PG8_BAR; PG8_WAIT_L(0); PG8_MMA(1, 0, At, B0); PG8_BAR; PG8_SCHED;
      PG8_STAGE(PG8_SB(0, 1), b2 + hstepB, voffB);
      PG8_WAIT_V(6); PG8_BAR; PG8_MMA(1, 1, At, B1); PG8_BAR;
      PG8_LDB(B0, 1, 0); PG8_SCHED; PG8_LDA(At, 1, 0); PG8_STAGE(PG8_SA(0, 1), a2 + hstepA, voffA);
      PG8_WAIT_L(8); PG8_BAR; PG8_WAIT_L(0); PG8_MMA(0, 0, At, B0); PG8_BAR; PG8_SCHED;
      PG8_LDB(B1, 1, 1); PG8_STAGE(PG8_SB(1, 0), b3, voffB);
      PG8_BAR; PG8_WAIT_L(0); PG8_MMA(0, 1, At, B1); PG8_BAR;
      PG8_LDA(At, 1, 1); PG8_STAGE(PG8_SA(1, 0), a3, voffA);
      PG8_BAR; PG8_WAIT_L(0); PG8_MMA(1, 0, At, B0); PG8_BAR; PG8_SCHED;
      PG8_STAGE(PG8_SB(1, 1), b3 + hstepB, voffB);
      PG8_WAIT_V(6); PG8_BAR; PG8_MMA(1, 1, At, B1); PG8_BAR;
    }
    E(acc, cur, wr, wc, fr, fq, lane);
    if (!has_next) break;
#pragma unroll
    for (int a = 0; a < 2; ++a)
#pragma unroll
      for (int b = 0; b < 2; ++b)
#pragma unroll
        for (int m = 0; m < 4; ++m)
#pragma unroll
          for (int n = 0; n < 2; ++n) acc[a][b][m][n] = (f32x4){0.f, 0.f, 0.f, 0.f};
    cur = nxt; cA = nA; cB = nB; ++ui;
  }
  PG8_WAIT_V(0);
  if (wr == 0) PG8_BAR;
  PG8_BAR;
#undef PG8_SA
#undef PG8_SB
#undef PG8_STAGE
#undef PG8_LDA
#undef PG8_LDB
#undef PG8_MMA
#undef PG8_WAIT_V
#undef PG8_WAIT_L
#undef PG8_BAR
#undef PG8_SCHED
}
}

#define OFF_STATS OFF_GLR

__device__ __forceinline__ u32x4 pack8v(const f32x4& a, const f32x4& b) {
  u32x4 w; w.x = pg8::cvt_pk_bf16(a[0], a[1]); w.y = pg8::cvt_pk_bf16(a[2], a[3]); w.z = pg8::cvt_pk_bf16(b[0], b[1]); w.w = pg8::cvt_pk_bf16(b[2], b[3]); return w;
}
__device__ __forceinline__ float xlane32(float v, int lane) { return __int_as_float(__builtin_amdgcn_ds_bpermute((lane ^ 32) << 2, __float_as_int(v))); }

struct EpiScanIn {
  static constexpr bool PERM = true;
  u16* S; const float* rot;
  __device__ __forceinline__ void operator()(const f32x4 (&acc)[2][2][4][2], const pg8::Unit& u, int wr, int wc, int fr, int fq, int lane) const {
    u16* Sb = S + (size_t)u.pm * 256 * 4096;
    unsigned rl0 = wr * 64 + fr; asm volatile("" : "+v"(rl0));
#pragma unroll
    for (int bj = 0; bj < 2; ++bj) {
      const int nt128 = u.pn * 2 + bj;
      const bool scaled = (nt128 < 4) || (nt128 >= 16 && nt128 < 20);
      const float scl = scaled ? 0.08838834764831845f : 1.f;
      const unsigned cb = nt128 * 128 + wc * 32 + fq * 8;
      if (nt128 < 8 && u.pm < 128) {
        const int tb = (u.pm & 15) * 256;
        const int fo = ((wc & 1) * 16 + (fq & 1) * 8) * 2;
        const float sgn = (fq >> 1) ? 1.f : -1.f;
#pragma unroll
        for (int ai = 0; ai < 2; ++ai)
#pragma unroll
          for (int m = 0; m < 4; ++m) {
            const unsigned rl = rl0 + ai * 128 + m * 16;
            const int t = tb + rl;
            const unsigned pos = (wc >> 1) == 0 ? (t >> 6) : (t & 63);
            const float* rp = rot + pos * 64u + fo;
            const float4 c0 = *(const float4*)rp, c1 = *(const float4*)(rp + 4), c2 = *(const float4*)(rp + 8), c3 = *(const float4*)(rp + 12);
            const f32x4 v0 = acc[ai][bj][m][0], v1 = acc[ai][bj][m][1];
            f32x4 p0, p1;
#pragma unroll
            for (int j = 0; j < 4; ++j) { p0[j] = xlane32(v0[j], lane); p1[j] = xlane32(v1[j], lane); }
            f32x4 o0, o1;
            o0[0] = (v0[0] * c0.x + sgn * p0[0] * c0.y) * scl; o0[1] = (v0[1] * c0.z + sgn * p0[1] * c0.w) * scl;
            o0[2] = (v0[2] * c1.x + sgn * p0[2] * c1.y) * scl; o0[3] = (v0[3] * c1.z + sgn * p0[3] * c1.w) * scl;
            o1[0] = (v1[0] * c2.x + sgn * p1[0] * c2.y) * scl; o1[1] = (v1[1] * c2.z + sgn * p1[1] * c2.w) * scl;
            o1[2] = (v1[2] * c3.x + sgn * p1[2] * c3.y) * scl; o1[3] = (v1[3] * c3.z + sgn * p1[3] * c3.w) * scl;
            *(u32x4*)(Sb + rl * 4096u + cb) = pack8v(o0, o1);
            __builtin_amdgcn_sched_barrier(0);
          }
      } else {
#pragma unroll
        for (int ai = 0; ai < 2; ++ai)
#pragma unroll
          for (int m = 0; m < 4; ++m) {
            const unsigned rl = rl0 + ai * 128 + m * 16;
            *(u32x4*)(Sb + rl * 4096u + cb) = pack8v(acc[ai][bj][m][0] * scl, acc[ai][bj][m][1] * scl);
            __builtin_amdgcn_sched_barrier(0);
          }
      }
    }
  }
};

struct EpiGate {
  static constexpr bool PERM = true;
  const u16* RG; const float* stats; u16* S; const float* rgain; const float* ggain;
  __device__ __forceinline__ void operator()(const f32x4 (&acc)[2][2][4][2], const pg8::Unit& u, int wr, int wc, int fr, int fq, int lane) const {
    u16* Sb = S + (size_t)u.pm * 256 * 4096;
    unsigned rl0 = wr * 64 + fr; asm volatile("" : "+v"(rl0));
    if (u.pn < 8) {
      const int branch = u.pn >> 2, head = u.pn & 3;
      const u16* RGb = RG + (size_t)u.pm * 256 * 2048 + branch * 1024;
      const float* stb = stats + (size_t)u.pm * 256 * 16 + (branch * 4 + head) * 2;
      const float* gain = branch ? ggain : rgain;
#pragma unroll
      for (int bj = 0; bj < 2; ++bj) {
        const unsigned cb = head * 256 + bj * 128 + wc * 32 + fq * 8;
        const float4 g0 = *(const float4*)(gain + cb), g1 = *(const float4*)(gain + cb + 4);
#pragma unroll
        for (int ai = 0; ai < 2; ++ai)
#pragma unroll
          for (int m = 0; m < 4; ++m) {
            const unsigned rl = rl0 + ai * 128 + m * 16;
            const float2 st = *(const float2*)(stb + rl * 16u);
            const bf16x8 xr = *(const bf16x8*)(RGb + rl * 2048u + cb);
            const f32x4 v0 = acc[ai][bj][m][0], v1 = acc[ai][bj][m][1];
            f32x4 o0, o1;
            o0[0] = (bf2f((u16)xr[0]) * st.x + st.y) * g0.x * siluf_(v0[0]); o0[1] = (bf2f((u16)xr[1]) * st.x + st.y) * g0.y * siluf_(v0[1]);
            o0[2] = (bf2f((u16)xr[2]) * st.x + st.y) * g0.z * siluf_(v0[2]); o0[3] = (bf2f((u16)xr[3]) * st.x + st.y) * g0.w * siluf_(v0[3]);
            o1[0] = (bf2f((u16)xr[4]) * st.x + st.y) * g1.x * siluf_(v1[0]); o1[1] = (bf2f((u16)xr[5]) * st.x + st.y) * g1.y * siluf_(v1[1]);
            o1[2] = (bf2f((u16)xr[6]) * st.x + st.y) * g1.z * siluf_(v1[2]); o1[3] = (bf2f((u16)xr[7]) * st.x + st.y) * g1.w * siluf_(v1[3]);
            *(u32x4*)(Sb + rl * 4096u + 2048u + branch * 1024 + cb) = pack8v(o0, o1);
            __builtin_amdgcn_sched_barrier(0);
          }
      }
    } else {
#pragma unroll
      for (int bj = 0; bj < 2; ++bj) {
        const unsigned cb = (u.pn - 8) * 256 + bj * 128 + wc * 32 + fq * 8;
#pragma unroll
        for (int ai = 0; ai < 2; ++ai)
#pragma unroll
          for (int m = 0; m < 4; ++m) {
            const unsigned rl = rl0 + ai * 128 + m * 16;
            f32x4 o0, o1;
#pragma unroll
            for (int j = 0; j < 4; ++j) { o0[j] = sigmoidf_(acc[ai][bj][m][0][j]); o1[j] = sigmoidf_(acc[ai][bj][m][1][j]); }
            *(u32x4*)(Sb + rl * 4096u + cb) = pack8v(o0, o1);
            __builtin_amdgcn_sched_barrier(0);
          }
      }
    }
  }
};

struct EpiMerge {
  static constexpr bool PERM = true;
  const u16* S; u16* MG; int pass;
  __device__ __forceinline__ void operator()(const f32x4 (&acc)[2][2][4][2], const pg8::Unit& u, int wr, int wc, int fr, int fq, int lane) const {
    const u16* Sb = S + (size_t)u.pm * 256 * 4096 + pass * 1024;
    u16* MGb = MG + (size_t)u.pm * 256 * 1024;
    unsigned rl0 = wr * 64 + fr; asm volatile("" : "+v"(rl0));
#pragma unroll
    for (int bj = 0; bj < 2; ++bj) {
      const unsigned cb = u.pn * 256 + bj * 128 + wc * 32 + fq * 8;
#pragma unroll
      for (int ai = 0; ai < 2; ++ai)
#pragma unroll
        for (int m = 0; m < 4; ++m) {
          const unsigned rl = rl0 + ai * 128 + m * 16;
          const bf16x8 gt = *(const bf16x8*)(Sb + rl * 4096u + cb);
          f32x4 o0 = acc[ai][bj][m][0], o1 = acc[ai][bj][m][1];
#pragma unroll
          for (int j = 0; j < 4; ++j) { o0[j] *= bf2f((u16)gt[j]); o1[j] *= bf2f((u16)gt[4 + j]); }
          if (pass) {
            const bf16x8 old = *(const bf16x8*)(MGb + rl * 1024u + cb);
#pragma unroll
            for (int j = 0; j < 4; ++j) { o0[j] += bf2f((u16)old[j]); o1[j] += bf2f((u16)old[4 + j]); }
          }
          *(u32x4*)(MGb + rl * 1024u + cb) = pack8v(o0, o1);
            __builtin_amdgcn_sched_barrier(0);
        }
    }
  }
};

struct EpiOut {
  static constexpr bool PERM = false;
  const float* x_lat; const float* x_ctx; float* o_lat; float* o_ctx; const float* mod;
  __device__ __forceinline__ void operator()(const f32x4 (&acc)[2][2][4][2], const pg8::Unit& u, int wr, int wc, int fr, int fq, int lane) const {
    const float* hin; float* hout; int rmod;
    if (u.pm < 128) { hin = x_lat + (size_t)u.pm * 256 * DM; hout = o_lat + (size_t)u.pm * 256 * DM; rmod = u.pm >> 4; }
    else { hin = x_ctx + (size_t)(u.pm - 128) * 256 * DM; hout = o_ctx + (size_t)(u.pm - 128) * 256 * DM; rmod = 8; }
    const float* gate = mod + rmod * 3072 + 2048;
    unsigned rl0 = wr * 64 + fr; asm volatile("" : "+v"(rl0));
#pragma unroll
    for (int bj = 0; bj < 2; ++bj)
#pragma unroll
      for (int n = 0; n < 2; ++n) {
        const unsigned cb = u.pn * 256 + bj * 128 + wc * 32 + n * 16 + fq * 4;
        const float4 g = *(const float4*)(gate + cb);
#pragma unroll
        for (int ai = 0; ai < 2; ++ai)
#pragma unroll
          for (int m = 0; m < 4; ++m) {
            const unsigned o = (rl0 + ai * 128 + m * 16) * 1024u + cb;
            const float4 h = *(const float4*)(hin + o);
            const f32x4 v = acc[ai][bj][m][n];
            *(float4*)(hout + o) = make_float4(h.x + g.x * v[0], h.y + g.y * v[1], h.z + g.z * v[2], h.w + g.w * v[3]);
          }
      }
  }
};

__device__ __forceinline__ void phase_stats(const Params& p, int l) {
  const int tid = opaque_tid(); const int wave = tid >> 6, lane = tid & 63;
  const u16* RG = (const u16*)(p.ws + OFF_RG);
  float* ST = (float*)(p.ws + OFF_STATS);
  const int nrows = (l == 0) ? MTOT : MLAT;
  for (int row = (blockIdx.x * 8 + wave) * 4; row < nrows; row += gridDim.x * 32) {
    bf16x8 v[4][4];
#pragma unroll
    for (int q = 0; q < 4; ++q)
#pragma unroll
      for (int i = 0; i < 4; ++i) v[q][i] = *(const bf16x8*)(RG + (size_t)(row + q) * 2048 + i * 512 + lane * 8);
#pragma unroll
    for (int q = 0; q < 4; ++q)
#pragma unroll
      for (int i = 0; i < 4; ++i) {
        float s1 = 0.f, s2 = 0.f;
#pragma unroll
        for (int x = 0; x < 8; ++x) { float a = bf2f((u16)v[q][i][x]); s1 += a; s2 += a * a; }
#pragma unroll
        for (int o = 16; o > 0; o >>= 1) {
          s1 += __int_as_float(__builtin_amdgcn_ds_bpermute((lane ^ o) << 2, __float_as_int(s1)));
          s2 += __int_as_float(__builtin_amdgcn_ds_bpermute((lane ^ o) << 2, __float_as_int(s2)));
        }
        float sa, sb;
        if ((i >> 1) == 0) { float mu = s1 * (1.f / 256.f); float var = fmaxf(s2 * (1.f / 256.f) - mu * mu, 0.f); sa = rsqrtf(var + 1e-6f); sb = -mu * sa; }
        else { sa = rsqrtf(s2 * (1.f / 256.f) + 1e-6f); sb = 0.f; }
        if ((lane & 31) == 0) *(float2*)(ST + ((size_t)(row + q) * 8 + (i >> 1) * 4 + 2 * (i & 1) + (lane >> 5)) * 2) = make_float2(sa, sb);
      }
  }
}

#define OFF_VECS OFF_WT
__device__ __forceinline__ float logsig16(float x) { return (fminf(x, 0.f) - __logf(1.f + __expf(-fabsf(x)))) * (1.f / 16.f); }

__device__ __forceinline__ void gla_prepass_unit(const Params& p, int l, int unit, char* smem) {
  const int tid = opaque_tid();
  const int b = unit / 68, cid = unit % 68;
  const int base = cid < 4 ? (MLAT + b * 256 + cid * 64) : (b * 4096 + (cid - 4) * 64);
  float* GLRS = (float*)smem;
  __syncthreads();
  {
    const int wid = tid >> 6, lane = tid & 63, fr = lane & 15, fq = lane >> 4;
    if (wid < 4) {
      f32x4 g = (f32x4){0.f, 0.f, 0.f, 0.f};
      const u16* Ua = (const u16*)(p.ws + OFF_U) + (size_t)(base + wid * 16 + fr) * 1024 + fq * 8;
      const u16* Wb = (const u16*)(p.ws + OFF_WT) + (size_t)(4096 + fr) * 1024 + fq * 8;
#pragma unroll 8
      for (int k = 0; k < 1024; k += 32) {
        bf16x8 a = *(const bf16x8*)(Ua + k);
        bf16x8 w = *(const bf16x8*)(Wb + k);
        g = __builtin_amdgcn_mfma_f32_16x16x32_bf16(a, w, g, 0, 0, 0);
      }
#pragma unroll
      for (int j = 0; j < 4; ++j) GLRS[(wid * 16 + fq * 4 + j) * 16 + fr] = g[j];
    }
  }
  float wf[16], wb[16];
  {
    const float* w0 = p.gla_w_up + (size_t)(l * 2 + 0) * 16 * 512 + tid;
    const float* w1 = p.gla_w_up + (size_t)(l * 2 + 1) * 16 * 512 + tid;
#pragma unroll
    for (int r = 0; r < 16; ++r) { wf[r] = w0[r * 512]; wb[r] = w1[r * 512]; }
  }
  const float bf_ = p.gla_b_up[(l * 2 + 0) * 512 + tid], bb_ = p.gla_b_up[(l * 2 + 1) * 512 + tid];
  __syncthreads();
  u16* Sq = (u16*)(p.ws + OFF_S) + (size_t)base * 4096 + 2048 + tid;
  u16* Ub = (u16*)(p.ws + OFF_U) + (size_t)base * 1024 + tid;
  float accF = 0.f, accB = 0.f;
#pragma unroll 8
  for (int u = 0; u < 32; ++u) {
    const int i = 31 - u;
    const float4* gr = (const float4*)(GLRS + i * 16);
    float4 g0 = gr[0], g1 = gr[1], g2 = gr[2], g3 = gr[3];
    float xf = bf_, xb = bb_;
    xf += g0.x * wf[0] + g0.y * wf[1] + g0.z * wf[2] + g0.w * wf[3] + g1.x * wf[4] + g1.y * wf[5] + g1.z * wf[6] + g1.w * wf[7]
        + g2.x * wf[8] + g2.y * wf[9] + g2.z * wf[10] + g2.w * wf[11] + g3.x * wf[12] + g3.y * wf[13] + g3.z * wf[14] + g3.w * wf[15];
    xb += g0.x * wb[0] + g0.y * wb[1] + g0.z * wb[2] + g0.w * wb[3] + g1.x * wb[4] + g1.y * wb[5] + g1.z * wb[6] + g1.w * wb[7]
        + g2.x * wb[8] + g2.y * wb[9] + g2.z * wb[10] + g2.w * wb[11] + g3.x * wb[12] + g3.y * wb[13] + g3.z * wb[14] + g3.w * wb[15];
    const float laf = logsig16(xf), lab = logsig16(xb);
    const float relf = -accF; accF += laf;
    accB += lab; const float relb = accB;
    const float q = bf2f(Sq[(unsigned)i * 4096u]), k = bf2f(Sq[(unsigned)i * 4096u + 512u]);
    Sq[(unsigned)i * 4096u] = f2bf(q * __expf(relf));
    Sq[(unsigned)i * 4096u + 512u] = f2bf(k * __expf(-relf));
    Ub[(unsigned)i * 1024u] = f2bf(q * __expf(relb));
    Ub[(unsigned)i * 1024u + 512u] = f2bf(k * __expf(-relb));
  }
  float accF2 = 0.f, accB2 = 0.f;
#pragma unroll 8
  for (int u = 0; u < 32; ++u) {
    const int i = 32 + u;
    const float4* gr = (const float4*)(GLRS + i * 16);
    float4 g0 = gr[0], g1 = gr[1], g2 = gr[2], g3 = gr[3];
    float xf = bf_, xb = bb_;
    xf += g0.x * wf[0] + g0.y * wf[1] + g0.z * wf[2] + g0.w * wf[3] + g1.x * wf[4] + g1.y * wf[5] + g1.z * wf[6] + g1.w * wf[7]
        + g2.x * wf[8] + g2.y * wf[9] + g2.z * wf[10] + g2.w * wf[11] + g3.x * wf[12] + g3.y * wf[13] + g3.z * wf[14] + g3.w * wf[15];
    xb += g0.x * wb[0] + g0.y * wb[1] + g0.z * wb[2] + g0.w * wb[3] + g1.x * wb[4] + g1.y * wb[5] + g1.z * wb[6] + g1.w * wb[7]
        + g2.x * wb[8] + g2.y * wb[9] + g2.z * wb[10] + g2.w * wb[11] + g3.x * wb[12] + g3.y * wb[13] + g3.z * wb[14] + g3.w * wb[15];
    const float laf = logsig16(xf), lab = logsig16(xb);
    accF2 += laf; const float relf = accF2;
    const float relb = -accB2; accB2 += lab;
    const float q = bf2f(Sq[(unsigned)i * 4096u]), k = bf2f(Sq[(unsigned)i * 4096u + 512u]);
    Sq[(unsigned)i * 4096u] = f2bf(q * __expf(relf));
    Sq[(unsigned)i * 4096u + 512u] = f2bf(k * __expf(-relf));
    Ub[(unsigned)i * 1024u] = f2bf(q * __expf(relb));
    Ub[(unsigned)i * 1024u + 512u] = f2bf(k * __expf(-relb));
  }
  float* V0 = (float*)(p.ws + OFF_VECS) + ((size_t)(0 * 544 + b * 68 + cid) * 2) * 512 + tid;
  float* V1 = (float*)(p.ws + OFF_VECS) + ((size_t)(1 * 544 + b * 68 + cid) * 2) * 512 + tid;
  V0[0] = __expf(accF);  V0[512] = __expf(accF2);
  V1[0] = __expf(accB2); V1[512] = __expf(accB);
}

#define L_QR   0
#define L_KR   17408
#define L_V    34816
#define L_SGT  44032
#define L_P    61440
#undef  SCAN_GB
#define SCAN_GB 70656

__device__ __forceinline__ int off128(int row, int col) { return row * 272 + col * 2; }
__device__ __forceinline__ int off64(int row, int col) { return row * 144 + col * 2; }

template <int RS>
__device__ __forceinline__ bf16x8 tr_frag(unsigned img_addr, int r0, int c0, int lane) {
  const int g = lane >> 4, q = (lane & 15) >> 2, pp = lane & 3;
  unsigned a = img_addr + (unsigned)((r0 + 8 * g + q) * RS + (c0 + 4 * pp) * 2);
  bf16x4 lo, hi;
  asm volatile("ds_read_b64_tr_b16 %0, %2\n\tds_read_b64_tr_b16 %1, %2 offset:%3\n\ts_waitcnt lgkmcnt(0)"
               : "=&v"(lo), "=&v"(hi) : "v"(a), "n"(4 * RS) : "memory");
  bf16x8 r;
  r[0] = lo[0]; r[1] = lo[1]; r[2] = lo[2]; r[3] = lo[3]; r[4] = hi[0]; r[5] = hi[1]; r[6] = hi[2]; r[7] = hi[3];
  return r;
}

__device__ __forceinline__ bf16x8 scale8(bf16x8 v, float f) {
  bf16x8 o;
#pragma unroll
  for (int x = 0; x < 8; ++x) o[x] = (short)f2bf(bf2f((u16)v[x]) * f);
  return o;
}

__device__ __forceinline__ void lds_barrier() { asm volatile("s_waitcnt lgkmcnt(0)" ::: "memory"); __builtin_amdgcn_s_barrier(); asm volatile("" ::: "memory"); }

template <int branch>
__device__ __forceinline__ void scan_item(const Params& p, int l, int item, char* smem) {
  const int b = (item >> 4) & 7, h = (item >> 2) & 3, slice = item & 3;
  const int tid = opaque_tid(), wid = __builtin_amdgcn_readfirstlane(tid >> 6), lane = tid & 63;
  const int dir = wid >> 2, gw = wid & 3, gt = tid & 255;
  const int fr = lane & 15, fq = lane >> 4;
  char* G = smem + dir * SCAN_GB;
  const unsigned Ga = (unsigned)(size_t)G;
  const u16* S = (const u16*)(p.ws + OFF_S);
  u16* RG = (u16*)(p.ws + OFF_RG);
  const u16* qsrc; unsigned qstride;
  if (branch == 0) { qsrc = S + h * 128; qstride = 4096; }
  else if (dir == 0) { qsrc = S + 2048 + h * 128; qstride = 4096; }
  else { qsrc = (const u16*)(p.ws + OFF_U) + h * 128; qstride = 1024; }
  const int voff = branch * 2048 + 1024 + h * 256 + slice * 64;
  const int ooff = branch * 1024 + h * 256 + slice * 64;
  float lg = 0.f, egc = 1.f;
  if (branch == 0) { lg = __logf(1.f - __expf(p.ret_decay[(l * 2 + dir) * 4 + h])); egc = __expf(32.f * lg); }
  const float* VECS = (const float*)(p.ws + OFF_VECS) + ((size_t)(dir * 544 + b * 68) * 2) * 512 + h * 128;
  f32x4 st[2][4];
#pragma unroll
  for (int m = 0; m < 2; ++m)
#pragma unroll
    for (int n = 0; n < 4; ++n) st[m][n] = (f32x4){0.f, 0.f, 0.f, 0.f};

  const int qj = gt >> 4, qc = gt & 15;
  const int vj = gt >> 3, vc = gt & 7;
  bf16x8 pq[4], pk[4], pv[2];
  float4 peg[2], pel[2];
  auto prefetch = [&](int s) {
    int base, cid;
    if (s < 4) { int cc = dir ? 3 - s : s; base = MLAT + b * 256 + cc * 64; cid = cc; }
    else { int c = s - 4; int cc = dir ? 63 - c : c; base = b * 4096 + cc * 64; cid = 4 + cc; }
#pragma unroll
    for (int i = 0; i < 4; ++i) {
      int jp = qj + 16 * i;
      unsigned ro = (unsigned)(base + (dir ? 63 - jp : jp)) * qstride + qc * 8;
      pq[i] = *(const bf16x8*)(qsrc + ro);
      pk[i] = *(const bf16x8*)(qsrc + ro + 512);
    }
#pragma unroll
    for (int i = 0; i < 2; ++i) {
      int jp = vj + 32 * i;
      pv[i] = *(const bf16x8*)(S + (size_t)(base + (dir ? 63 - jp : jp)) * 4096 + voff + vc * 8);
    }
    if (branch == 1) {
#pragma unroll
      for (int m = 0; m < 2; ++m) {
        int d0 = gw * 32 + m * 16 + fq * 4;
        peg[m] = *(const float4*)(VECS + (size_t)cid * 1024 + d0);
        pel[m] = *(const float4*)(VECS + (size_t)cid * 1024 + 512 + d0);
      }
    }
  };
  prefetch(0);
  __syncthreads();

  for (int s = 0; s < 68; ++s) {
    int base; bool first; bool wout;
    if (s < 4) { int cc = dir ? 3 - s : s; base = MLAT + b * 256 + cc * 64; first = s < 2; wout = (l == 0); }
    else { int c = s - 4; int cc = dir ? 63 - c : c; base = b * 4096 + cc * 64; first = c < 32; wout = true; }
    float4 eg[2], el[2];
#pragma unroll
    for (int m = 0; m < 2; ++m) {
      if (branch == 1) { eg[m] = peg[m]; el[m] = pel[m]; }
      else { eg[m] = make_float4(egc, egc, egc, egc); el[m] = eg[m]; }
    }
#pragma unroll
    for (int i = 0; i < 4; ++i) {
      int jp = qj + 16 * i;
      bf16x8 qv = pq[i], kv_ = pk[i];
      if (branch == 0) {
        float fqs = __expf((float)(jp - 31) * lg), fks = __expf((float)(31 - jp) * lg);
        qv = scale8(qv, fqs); kv_ = scale8(kv_, fks);
      }
      *(bf16x8*)(G + L_QR + off128(jp, qc * 8)) = qv;
      *(bf16x8*)(G + L_KR + off128(jp, qc * 8)) = kv_;
    }
#pragma unroll
    for (int i = 0; i < 2; ++i) *(bf16x8*)(G + L_V + off64(vj + 32 * i, vc * 8)) = pv[i];
#pragma unroll
    for (int m = 0; m < 2; ++m) {
      int d0 = gw * 32 + m * 16 + fq * 4;
#pragma unroll
      for (int n = 0; n < 4; ++n) {
        int e = n * 16 + fr;
        bf16x4 o4;
        o4[0] = (short)f2bf(st[m][n][0] * eg[m].x); o4[1] = (short)f2bf(st[m][n][1] * eg[m].y);
        o4[2] = (short)f2bf(st[m][n][2] * eg[m].z); o4[3] = (short)f2bf(st[m][n][3] * eg[m].w);
        *(bf16x4*)(G + L_SGT + off128(e, d0)) = o4;
      }
    }
    u16 oldv[4][4];
    u16* dstb = RG + (size_t)base * 2048 + ooff + fr;
    if (wout && !first) {
#pragma unroll
      for (int r = 0; r < 4; ++r) {
        int ip = gw * 16 + fq * 4 + r;
        unsigned ro = (unsigned)(dir ? 63 - ip : ip) * 2048u;
#pragma unroll
        for (int n = 0; n < 4; ++n) oldv[r][n] = dstb[ro + n * 16];
      }
    }
    if (s + 1 < 68) prefetch(s + 1);
    lds_barrier();
    f32x4 pt[4], o[4];
#pragma unroll
    for (int n = 0; n < 4; ++n) { pt[n] = (f32x4){0.f, 0.f, 0.f, 0.f}; o[n] = (f32x4){0.f, 0.f, 0.f, 0.f}; }
#pragma unroll
    for (int ks = 0; ks < 4; ++ks) {
      int kc = ks * 32 + fq * 8;
      bf16x8 ka = *(const bf16x8*)(G + L_KR + off128(gw * 16 + fr, kc));
      bf16x8 qa = *(const bf16x8*)(G + L_QR + off128(gw * 16 + fr, kc));
#pragma unroll
      for (int n = 0; n < 4; ++n) {
        bf16x8 qb = *(const bf16x8*)(G + L_QR + off128(n * 16 + fr, kc));
        bf16x8 sb = *(const bf16x8*)(G + L_SGT + off128(n * 16 + fr, kc));
        pt[n] = __builtin_amdgcn_mfma_f32_16x16x32_bf16(ka, qb, pt[n], 0, 0, 0);
        o[n] = __builtin_amdgcn_mfma_f32_16x16x32_bf16(qa, sb, o[n], 0, 0, 0);
      }
    }
#pragma unroll
    for (int n = 0; n < 4; ++n) {
      int ip = n * 16 + fr;
      int j0 = gw * 16 + fq * 4;
      bf16x4 w;
#pragma unroll
      for (int r = 0; r < 4; ++r) {
        int jp = j0 + r;
        bool keep = dir ? (ip > jp) : (ip >= jp);
        w[r] = (short)f2bf(keep ? pt[n][r] : 0.f);
      }
      *(bf16x4*)(G + L_P + off64(ip, j0)) = w;
    }
    lds_barrier();
    {
      const int tg = lane >> 4, tq = (lane & 15) >> 2, tp = lane & 3;
      const unsigned ka0 = Ga + L_KR + (unsigned)((8 * tg + tq) * 272 + (gw * 32 + 4 * tp) * 2);
      const unsigned va0 = Ga + L_V + (unsigned)((8 * tg + tq) * 144 + (4 * tp) * 2);
#pragma unroll
      for (int m = 0; m < 2; ++m) {
        f32x4 kv[4];
#pragma unroll
        for (int n = 0; n < 4; ++n) kv[n] = (f32x4){0.f, 0.f, 0.f, 0.f};
#pragma unroll
        for (int ks = 0; ks < 2; ++ks) {
          int kc = ks * 32 + fq * 8;
          bf16x4 r0, r1, r2, r3, r4, r5, r6, r7, r8, r9;
          asm volatile(
              "ds_read_b64_tr_b16 %0, %10\n\tds_read_b64_tr_b16 %1, %10 offset:1088\n\t"
              "ds_read_b64_tr_b16 %2, %11\n\tds_read_b64_tr_b16 %3, %11 offset:576\n\t"
              "ds_read_b64_tr_b16 %4, %11 offset:32\n\tds_read_b64_tr_b16 %5, %11 offset:608\n\t"
              "ds_read_b64_tr_b16 %6, %11 offset:64\n\tds_read_b64_tr_b16 %7, %11 offset:640\n\t"
              "ds_read_b64_tr_b16 %8, %11 offset:96\n\tds_read_b64_tr_b16 %9, %11 offset:672\n\t"
              "s_waitcnt lgkmcnt(0)"
              : "=&v"(r0), "=&v"(r1), "=&v"(r2), "=&v"(r3), "=&v"(r4), "=&v"(r5), "=&v"(r6), "=&v"(r7), "=&v"(r8), "=&v"(r9)
              : "v"(ka0 + (unsigned)(ks * 32 * 272 + m * 32)), "v"(va0 + (unsigned)(ks * 32 * 144))
              : "memory");
          bf16x8 km = __builtin_shufflevector(r0, r1, 0, 1, 2, 3, 4, 5, 6, 7);
          bf16x8 vb[4];
          vb[0] = __builtin_shufflevector(r2, r3, 0, 1, 2, 3, 4, 5, 6, 7);
          vb[1] = __builtin_shufflevector(r4, r5, 0, 1, 2, 3, 4, 5, 6, 7);
          vb[2] = __builtin_shufflevector(r6, r7, 0, 1, 2, 3, 4, 5, 6, 7);
          vb[3] = __builtin_shufflevector(r8, r9, 0, 1, 2, 3, 4, 5, 6, 7);
          bf16x8 pa;
          if (m == 0) pa = *(const bf16x8*)(G + L_P + off64(gw * 16 + fr, kc));
#pragma unroll
          for (int n = 0; n < 4; ++n) {
            if (m == 0) o[n] = __builtin_amdgcn_mfma_f32_16x16x32_bf16(pa, vb[n], o[n], 0, 0, 0);
            kv[n] = __builtin_amdgcn_mfma_f32_16x16x32_bf16(km, vb[n], kv[n], 0, 0, 0);
          }
        }
#pragma unroll
        for (int n = 0; n < 4; ++n) {
          st[m][n][0] = eg[m].x * el[m].x * st[m][n][0] + el[m].x * kv[n][0];
          st[m][n][1] = eg[m].y * el[m].y * st[m][n][1] + el[m].y * kv[n][1];
          st[m][n][2] = eg[m].z * el[m].z * st[m][n][2] + el[m].z * kv[n][2];
          st[m][n][3] = eg[m].w * el[m].w * st[m][n][3] + el[m].w * kv[n][3];
        }
      }
    }
    if (wout) {
#pragma unroll
      for (int r = 0; r < 4; ++r) {
        int ip = gw * 16 + fq * 4 + r;
        unsigned ro = (unsigned)(dir ? 63 - ip : ip) * 2048u;
#pragma unroll
        for (int n = 0; n < 4; ++n) {
          float v = o[n][r];
          if (!first) v += bf2f(oldv[r][n]);
          dstb[ro + n * 16] = f2bf(v);
        }
      }
    }
    __syncthreads();
  }
}

#define NPHASE 18
__device__ __forceinline__ void run_phase(const Params& p, int ph, char* smem) {
  const int nblk = gridDim.x, bid = blockIdx.x;
  if (ph == 0) {
#ifdef REP_P0
    for (int rep = 0; rep < REP_P0; ++rep)
#endif
    for (int u = bid; u < WT_UNITS + 96 + 1; u += nblk) {
      if (u < 96) mod_unit(p, u, smem);
      else if (u == 96) rot_unit(p);
      else wt_unit(p, 0, u - 97, smem);
    }
    return;
  }
  if (ph == NPHASE - 1) { phase_final(p); return; }
  const int l = (ph - 1) / 8, sp = (ph - 1) % 8;
  PG8_LAS unsigned char* lds = (PG8_LAS unsigned char*)smem;
  switch (sp) {
    case 0:
      phase_u(p, l);
      if (l == 1) for (int u = bid; u < WT_UNITS; u += nblk) wt_unit(p, 1, u, smem);
      break;
    case 1: {
      pg8::Gemm g{(const u16*)(p.ws + OFF_U), (const u16*)(p.ws + OFF_WT) + (size_t)WT_SCAN * 1024, 1024, MTOT, 4096, 1024};
      pg8::StaticOrder S; S.init(g.M, g.N, nblk, bid);
      EpiScanIn E{(u16*)(p.ws + OFF_S), (const float*)(p.ws + OFF_ROT)};
      pg8::gemm_phase(lds, g, S, E, opaque_tid());
    } break;
    case 2: for (int t = bid; t < 544; t += nblk) gla_prepass_unit(p, l, t, smem); break;
    case 3:
#ifdef REP_SCAN
      for (int rep = 0; rep < REP_SCAN; ++rep)
#endif
      for (int t = bid; t < 256; t += nblk) { if (t < 128) scan_item<0>(p, l, t, smem); else scan_item<1>(p, l, t, smem); } break;
    case 4:
      phase_u(p, l);
      phase_stats(p, l);
      break;
    case 5: {
      pg8::Gemm g{(const u16*)(p.ws + OFF_U), (const u16*)(p.ws + OFF_WT) + (size_t)WT_GATE * 1024, 1024, l == 0 ? MTOT : MLAT, 4096, 1024};
      pg8::StaticOrder S; S.init(g.M, g.N, nblk, bid);
      EpiGate E{(const u16*)(p.ws + OFF_RG), (const float*)(p.ws + OFF_STATS), (u16*)(p.ws + OFF_S), p.ret_norm_gain + l * 1024, p.gla_norm_gain + l * 1024};
      pg8::gemm_phase(lds, g, S, E, opaque_tid());
    } break;
    case 6: {
#pragma unroll 1
      for (int pass = 0; pass < 2; ++pass) {
        pg8::Gemm g{(const u16*)(p.ws + OFF_S) + 2048 + pass * 1024, (const u16*)(p.ws + OFF_WT) + (size_t)(WT_BRR + pass * 1024) * 1024, 4096, l == 0 ? MTOT : MLAT, 1024, 1024};
        pg8::StaticOrder S; S.init(g.M, g.N, nblk, bid);
        EpiMerge E{(const u16*)(p.ws + OFF_S), (u16*)(p.ws + OFF_U), pass};
        pg8::gemm_phase(lds, g, S, E, opaque_tid());
      }
    } break;
    case 7: {
      pg8::Gemm g{(const u16*)(p.ws + OFF_U), (const u16*)(p.ws + OFF_WT) + (size_t)WT_OUT * 1024, 1024, l == 0 ? MTOT : MLAT, 1024, 1024};
      pg8::StaticOrder S; S.init(g.M, g.N, nblk, bid);
      EpiOut E{l == 0 ? p.x : p.out, p.ctx, p.out, (float*)(p.ws + OFF_HCTX), (const float*)(p.ws + OFF_MOD) + (size_t)l * 9 * 3072};
      pg8::gemm_phase(lds, g, S, E, opaque_tid());
    } break;
  }
}

__device__ __forceinline__ void grid_barrier(unsigned* cnt, unsigned target) {
  asm volatile("s_waitcnt vmcnt(0)" ::: "memory");
  __syncthreads();
  if (threadIdx.x == 0) {
    __threadfence();
    __hip_atomic_fetch_add(cnt, 1u, __ATOMIC_RELAXED, __HIP_MEMORY_SCOPE_AGENT);
    while (__hip_atomic_load(cnt, __ATOMIC_RELAXED, __HIP_MEMORY_SCOPE_AGENT) < target) __builtin_amdgcn_s_sleep(2);
    __threadfence();
  }
  __syncthreads();
}

__global__ void __launch_bounds__(NTHREADS) mega(Params p, int ph_lo, int ph_hi, int coop) {
  extern __shared__ __attribute__((aligned(16))) char smem[];
  for (int ph = ph_lo; ph < ph_hi; ++ph) {
    run_phase(p, ph, smem);
    if (coop && ph + 1 < ph_hi) {
      if (ph == ph_lo) cg::this_grid().sync();
      else grid_barrier((unsigned*)(p.ws + OFF_BAR), (unsigned)(ph - ph_lo) * gridDim.x);
    }
  }
}

extern "C" void kernel_launch(void* const* d_in, const int* in_sizes, int n_in,
                              void* d_out, int out_size, void* d_ws, size_t ws_size,
                              hipStream_t stream) {
  Params p{};
  p.x = (const float*)d_in[0]; p.c = (const float*)d_in[1]; p.ctx = (const float*)d_in[2]; p.c_ctx = (const float*)d_in[3];
  p.norm_gain = (const float*)d_in[4]; p.w_ada = (const float*)d_in[5]; p.b_ada = (const float*)d_in[6]; p.w_in = (const float*)d_in[7];
  p.ret_decay = (const float*)d_in[8]; p.gla_w_up = (const float*)d_in[9]; p.gla_b_up = (const float*)d_in[10];
  p.ret_norm_gain = (const float*)d_in[11]; p.gla_norm_gain = (const float*)d_in[12];
  p.w_br_ret = (const float*)d_in[13]; p.w_br_gla = (const float*)d_in[14]; p.w_out = (const float*)d_in[15]; p.final_gain = (const float*)d_in[16];
  p.out = (float*)d_out; p.ws = (char*)d_ws;
  static int grid_blocks = 0;
  if (!grid_blocks) {
    hipFuncSetAttribute((const void*)mega, hipFuncAttributeMaxDynamicSharedMemorySize, LDS_BYTES);
    int dev = 0, cus = 0, per_cu = 0;
    hipGetDevice(&dev);
    hipDeviceGetAttribute(&cus, hipDeviceAttributeMultiprocessorCount, dev);
    hipOccupancyMaxActiveBlocksPerMultiprocessor(&per_cu, mega, NTHREADS, LDS_BYTES);
    if (per_cu < 1) per_cu = 1;
    grid_blocks = cus * 1;
  }
#ifdef MULTI_LAUNCH
  for (int ph = 0; ph < NPHASE; ++ph) {
    mega<<<dim3(grid_blocks), dim3(NTHREADS), LDS_BYTES, stream>>>(p, ph, ph + 1, 0);
  }
#else
  hipMemsetAsync((char*)d_ws + OFF_BAR, 0, 256, stream);
  int lo = 0, hi = NPHASE, coop = 1;
  void* args[] = {&p, &lo, &hi, &coop};
  hipError_t e = hipLaunchCooperativeKernel((void*)mega, dim3(grid_blocks), dim3(NTHREADS), args, LDS_BYTES, stream);
  if (e != hipSuccess) fprintf(stderr, "cooperative launch failed: %s (grid %d)\n", hipGetErrorString(e), grid_blocks);
#endif
}
```

```cpp
#include <hip/hip_runtime.h>
#include <hip/hip_cooperative_groups.h>
#include <cstdio>
namespace cg = cooperative_groups;

typedef unsigned short u16;
using bf16x8 = __attribute__((ext_vector_type(8))) short;
using bf16x4 = __attribute__((ext_vector_type(4))) short;
using f32x4  = __attribute__((ext_vector_type(4))) float;

#define NTHREADS 512
#define DM 1024
#define NB 8
#define SEQL 4096
#define CTXL 256
#define MLAT 32768
#define MCTX 2048
#define MTOT 34816
#define INW 8208

#define OFF_S    0ull
#define OFF_RG   (OFF_S   + (size_t)MTOT * 4096 * 2)
#define OFF_U    (OFF_RG  + (size_t)MTOT * 2048 * 2)
#define OFF_WT   (OFF_U   + (size_t)MTOT * 1024 * 2)
#define WT_ROWS  11392
#define OFF_GLR  (OFF_WT  + (size_t)WT_ROWS * 1024 * 2)
#define OFF_HCTX (OFF_GLR + (size_t)MTOT * 16 * 4)
#define OFF_MOD  (OFF_HCTX+ (size_t)MCTX * 1024 * 4)
#define OFF_ROT  (OFF_MOD + (size_t)2 * 9 * 3072 * 4)
#define OFF_BAR  (OFF_ROT + (size_t)64 * 32 * 2 * 4)
#define OFF_END  (OFF_BAR + 256)

#define WT_SCAN 0
#define WT_GATE 4224
#define WT_BRR  8320
#define WT_BRG  9344
#define WT_OUT  10368

#define LDS_BYTES 161792
#define SCAN_GB   80896

struct Params {
  const float* x; const float* c; const float* ctx; const float* c_ctx;
  const float* norm_gain; const float* w_ada; const float* b_ada; const float* w_in;
  const float* ret_decay; const float* gla_w_up; const float* gla_b_up;
  const float* ret_norm_gain; const float* gla_norm_gain;
  const float* w_br_ret; const float* w_br_gla; const float* w_out; const float* final_gain;
  float* out; char* ws;
};

__device__ __forceinline__ u16 f2bf(float f) {
  __bf16 h = (__bf16)f;
  return *(u16*)&h;
}
__device__ __forceinline__ float bf2f(u16 h) { return __uint_as_float(((unsigned)h) << 16); }
__device__ __forceinline__ float sigmoidf_(float x) { return __builtin_amdgcn_rcpf(1.f + __expf(-x)); }
__device__ __forceinline__ float siluf_(float x) { return x * __builtin_amdgcn_rcpf(1.f + __expf(-x)); }

__device__ __forceinline__ int opaque_tid() { int t = threadIdx.x; asm volatile("" : "+v"(t)); return t; }

__device__ __forceinline__ float wave_sum(float v) {
#pragma unroll
  for (int o = 32; o > 0; o >>= 1) v += __shfl_xor(v, o, 64);
  return v;
}

__device__ __forceinline__ const float* wt_src(const Params& p, int l, int n, int& ld) {
  if (n < WT_GATE) {
    int tile = n >> 7, cc = n & 127;
    int col;
    if (tile < 8) {
      int d = (cc & 64) | ((cc & 16) << 1) | ((cc & 32) >> 1) | (cc & 15);
      col = tile * 128 + d;
    } else if (tile < 16) col = 1024 + (tile - 8) * 128 + cc;
    else if (tile < 24) col = 3072 + (tile - 16) * 128 + cc;
    else if (tile < 32) col = 4096 + (tile - 24) * 128 + cc;
    else { if (cc >= 16) { ld = 0; return nullptr; } col = 6144 + cc; }
    ld = INW; return p.w_in + (size_t)l * DM * INW + col;
  } else if (n < WT_BRR) {
    int g = n - WT_GATE; int col;
    if (g < 1024) col = 2048 + g;
    else if (g < 2048) col = 5120 + (g - 1024);
    else if (g < 3072) col = 6160 + (g - 2048);
    else col = 7184 + (g - 3072);
    ld = INW; return p.w_in + (size_t)l * DM * INW + col;
  } else if (n < WT_BRG) { ld = DM; return p.w_br_ret + (size_t)l * DM * DM + (n - WT_BRR); }
  else if (n < WT_OUT)   { ld = DM; return p.w_br_gla + (size_t)l * DM * DM + (n - WT_BRG); }
  else                   { ld = DM; return p.w_out    + (size_t)l * DM * DM + (n - WT_OUT); }
}

#define WT_UNITS (178 * 16)
__device__ __forceinline__ void wt_unit(const Params& p, int l, int unit, char* smem) {
  float* tile = (float*)smem;
  int nb = unit >> 4, kb = unit & 15;
  int tid = opaque_tid();
  int n0 = nb * 64, k0 = kb * 64;
  {
    int nl = tid & 63, kq = tid >> 6;
    int ld; const float* src = wt_src(p, l, n0 + nl, ld);
#pragma unroll
    for (int i = 0; i < 8; ++i) {
      int kl = kq + 8 * i;
      float v = src ? src[(size_t)(k0 + kl) * ld] : 0.f;
      tile[kl * 65 + nl] = v;
    }
  }
  __syncthreads();
  {
    int nl = tid >> 3, kq = tid & 7;
    bf16x8 o;
#pragma unroll
    for (int j = 0; j < 8; ++j) o[j] = (short)f2bf(tile[(kq * 8 + j) * 65 + nl]);
    u16* wt = (u16*)(p.ws + OFF_WT);
    *(bf16x8*)(wt + (size_t)(n0 + nl) * 1024 + k0 + kq * 8) = o;
  }
  __syncthreads();
}

__device__ __forceinline__ void mod_unit(const Params& p, int unit, char* smem) {
  float* sc = (float*)smem;
  float* red = sc + 9 * 1024;
  int l = unit / 48, jb = unit % 48;
  int tid = opaque_tid();
  for (int i = tid; i < 9 * 1024; i += NTHREADS) {
    int r = i >> 10, k = i & 1023;
    float v = (r < 8) ? p.c[r * 1024 + k] : p.c_ctx[k];
    sc[i] = siluf_(v);
  }
  __syncthreads();
  int jl = tid & 63, kg = tid >> 6;
  int j = jb * 64 + jl;
  float acc[9];
#pragma unroll
  for (int r = 0; r < 9; ++r) acc[r] = 0.f;
  const float* w = p.w_ada + (size_t)l * DM * 3072 + j;
#pragma unroll 16
  for (int k = kg * 128; k < kg * 128 + 128; ++k) {
    float wv = w[(size_t)k * 3072];
#pragma unroll
    for (int r = 0; r < 9; ++r) acc[r] += sc[r * 1024 + k] * wv;
  }
#pragma unroll
  for (int r = 0; r < 9; ++r) red[(kg * 9 + r) * 64 + jl] = acc[r];
  __syncthreads();
  float* mod = (float*)(p.ws + OFF_MOD);
  for (int i = tid; i < 9 * 64; i += NTHREADS) {
    int r = i >> 6, jj = i & 63;
    float s = 0.f;
#pragma unroll
    for (int g = 0; g < 8; ++g) s += red[(g * 9 + r) * 64 + jj];
    mod[((size_t)l * 9 + r) * 3072 + jb * 64 + jj] = s + p.b_ada[l * 3072 + jb * 64 + jj];
  }
  __syncthreads();
}

__device__ __forceinline__ void rot_unit(const Params& p) {
  float* rot = (float*)(p.ws + OFF_ROT);
  for (int i = opaque_tid(); i < 64 * 32; i += NTHREADS) {
    int pos = i >> 5, f = i & 31;
    float inv = exp2f(-(float)f * (13.287712379549449f / 32.f));
    float ang = (float)pos * inv;
    rot[i * 2] = __cosf(ang);
    rot[i * 2 + 1] = __sinf(ang);
  }
}

__device__ __forceinline__ void phase_u(const Params& p, int l) {
  const int tid = opaque_tid(); int wave = tid >> 6, lane = tid & 63;
  const float* mod = (const float*)(p.ws + OFF_MOD) + (size_t)l * 9 * 3072;
  const float* gain = p.norm_gain + l * DM;
  u16* U = (u16*)(p.ws + OFF_U);
  for (int row = (blockIdx.x * 8 + wave) * 4; row < MTOT; row += gridDim.x * 32) {
    const float* h; int r;
    if (row < MLAT) { h = (l == 0 ? p.x : p.out) + (size_t)row * DM; r = row >> 12; }
    else { int cr = row - MLAT; h = (l == 0 ? p.ctx : (const float*)(p.ws + OFF_HCTX)) + (size_t)cr * DM; r = 8; }
    float4 v[4][4]; float ss[4];
#pragma unroll
    for (int q = 0; q < 4; ++q) {
      ss[q] = 0.f;
#pragma unroll
      for (int i = 0; i < 4; ++i) v[q][i] = *(const float4*)(h + q * DM + i * 256 + lane * 4);
    }
#pragma unroll
    for (int q = 0; q < 4; ++q) {
#pragma unroll
      for (int i = 0; i < 4; ++i) ss[q] += v[q][i].x * v[q][i].x + v[q][i].y * v[q][i].y + v[q][i].z * v[q][i].z + v[q][i].w * v[q][i].w;
      ss[q] = rsqrtf(wave_sum(ss[q]) * (1.f / 1024.f) + 1e-6f);
    }
    const float* sh = mod + r * 3072;
#pragma unroll
    for (int i = 0; i < 4; ++i) {
      int cidx = i * 256 + lane * 4;
      float4 g = *(const float4*)(gain + cidx);
      float4 s = *(const float4*)(sh + cidx);
      float4 sc = *(const float4*)(sh + 1024 + cidx);
      g.x *= (1.f + sc.x); g.y *= (1.f + sc.y); g.z *= (1.f + sc.z); g.w *= (1.f + sc.w);
#pragma unroll
      for (int q = 0; q < 4; ++q) {
        bf16x4 o;
        o[0] = (short)f2bf(v[q][i].x * ss[q] * g.x + s.x);
        o[1] = (short)f2bf(v[q][i].y * ss[q] * g.y + s.y);
        o[2] = (short)f2bf(v[q][i].z * ss[q] * g.z + s.z);
        o[3] = (short)f2bf(v[q][i].w * ss[q] * g.w + s.w);
        *(bf16x4*)(U + (size_t)(row + q) * DM + cidx) = o;
      }
    }
  }
}

__device__ __forceinline__ void phase_final(const Params& p) {
  const int tid = opaque_tid(); int wave = tid >> 6, lane = tid & 63;
  for (int row = (blockIdx.x * 8 + wave) * 4; row < MLAT; row += gridDim.x * 32) {
    float* h = p.out + (size_t)row * DM;
    float4 v[4][4]; float ss[4];
#pragma unroll
    for (int q = 0; q < 4; ++q) {
      ss[q] = 0.f;
#pragma unroll
      for (int i = 0; i < 4; ++i) v[q][i] = *(const float4*)(h + q * DM + i * 256 + lane * 4);
    }
#pragma unroll
    for (int q = 0; q < 4; ++q) {
#pragma unroll
      for (int i = 0; i < 4; ++i) ss[q] += v[q][i].x * v[q][i].x + v[q][i].y * v[q][i].y + v[q][i].z * v[q][i].z + v[q][i].w * v[q][i].w;
      ss[q] = rsqrtf(wave_sum(ss[q]) * (1.f / 1024.f) + 1e-6f);
    }
#pragma unroll
    for (int i = 0; i < 4; ++i) {
      int cidx = i * 256 + lane * 4;
      float4 g = *(const float4*)(p.final_gain + cidx);
#pragma unroll
      for (int q = 0; q < 4; ++q) {
        float4 o;
        o.x = v[q][i].x * ss[q] * g.x; o.y = v[q][i].y * ss[q] * g.y; o.z = v[q][i].z * ss[q] * g.z; o.w = v[q][i].w * ss[q] * g.w;
        *(float4*)(h + q * DM + cidx) = o;
      }
    }
  }
}

#define PG8_LAS __attribute__((address_space(3)))
typedef unsigned u32x4 __attribute__((ext_vector_type(4)));
namespace pg8 {
constexpr int BM = 256, BK = 64, HALF = 128, HTB = HALF * BK * 2, STAGE_BYTES = 8 * HTB, NXCD = 8, WGM = 8;
__device__ __forceinline__ int lds_byte(int r, int c) { const int st = (r >> 4) * 2 + (c >> 5), rr = r & 15, cc = c & 31, ob = rr * 64 + cc * 2; return st * 1024 + (ob ^ (((ob >> 9) & 1) << 5)); }
__device__ __forceinline__ void stage_rc(int b, int& R, int& C) { const int st = b / 1024, sb = b % 1024, swz = sb ^ (((sb >> 9) & 1) << 5); R = (st >> 1) * 16 + swz / 64; C = (st & 1) * 32 + (swz % 64) / 2; }
__device__ __forceinline__ int perm32(int rho) { const int n = rho >> 4, i = rho & 15; return 8 * (i >> 2) + 4 * n + (i & 3); }
struct Unit { int pm, pn; };
struct Gemm { const u16* A; const u16* Bt; int lda; int M, N, K; };
struct StaticOrder {
  int nM, nN, nwg, G, c;
  __device__ void init(int M, int N, int G_, int c_) { nM = M / BM; nN = N / BM; nwg = nM * nN; G = G_; c = c_; }
  __device__ bool next(int i, Unit& u) const {
    const long L = (long)i * G + c; if (L >= nwg) return false;
    int wgid = (int)L; { const int q = nwg / NXCD, r = nwg % NXCD, xcd = wgid % NXCD, off = wgid / NXCD; wgid = (xcd < r ? xcd * (q + 1) : r * (q + 1) + (xcd - r) * q) + off; }
    const int nig = WGM * nN, gid = wgid / nig, fm = gid * WGM, gsz = (nM - fm) < WGM ? (nM - fm) : WGM;
    u.pm = fm + ((wgid % nig) % gsz); u.pn = (wgid % nig) / gsz; return true;
  }
};
typedef __attribute__((ext_vector_type(2))) float cvt_f2_t;
typedef __attribute__((ext_vector_type(2))) __bf16 cvt_b2_t;
__device__ __forceinline__ unsigned cvt_pk_bf16(float lo, float hi) { cvt_f2_t f = {lo, hi}; cvt_b2_t r = __builtin_convertvector(f, cvt_b2_t); return __builtin_bit_cast(unsigned, r); }

template <class Epi>
__device__ __forceinline__ void gemm_phase(PG8_LAS unsigned char* lds, const Gemm g, const StaticOrder& S, const Epi& E, const int tid) {
  const int wid = __builtin_amdgcn_readfirstlane(tid >> 6), lane = tid & 63, wr = wid >> 2, wc = wid & 3, fr = lane & 15, fq = lane >> 4;
  const int K = g.K, nt = K / BK;
  unsigned voffA[2], voffB[2];
#pragma unroll
  for (int i = 0; i < 2; ++i) { int R, C; stage_rc(tid * 16 + i * 8192, R, C); const int Rb = Epi::PERM ? ((R & ~31) + perm32(R & 31)) : R;
    voffA[i] = (unsigned)(R * g.lda + C) * 2u; voffB[i] = (unsigned)(Rb * K + C) * 2u; }
  const size_t kstep = (size_t)(BK * 2);
  const size_t hstepA = (size_t)HALF * g.lda * 2, hstepB = (size_t)HALF * K * 2;
  const size_t tstepA = 2 * hstepA, tstepB = 2 * hstepB;
  const unsigned ldsw = (unsigned)wid * 1024u;
  const int aoff = lds_byte(wr * 64 + fr, fq * 8), boff = lds_byte(wc * 32 + fr, fq * 8);
#define PG8_SA(b, h) (((b) * 2 + (h)) * HTB)
#define PG8_SB(b, h) ((4 + (b) * 2 + (h)) * HTB)
#define PG8_STAGE(bufoff, gbase, voff) do { _Pragma("unroll") for (int _i = 0; _i < 2; ++_i) \
    __builtin_amdgcn_global_load_lds((const unsigned*)((const char*)(gbase) + (voff)[_i]), (PG8_LAS unsigned*)(lds + (bufoff) + ldsw + _i * 8192), 16, 0, 0); } while (0)
#define PG8_LDA(dst, b, h) do { _Pragma("unroll") for (int m = 0; m < 4; ++m) _Pragma("unroll") for (int k = 0; k < 2; ++k) dst[m][k] = *(const PG8_LAS bf16x8*)(lds + PG8_SA(b, h) + aoff + m * 2048 + k * 1024); } while (0)
#define PG8_LDB(dst, b, h) do { _Pragma("unroll") for (int n = 0; n < 2; ++n) _Pragma("unroll") for (int k = 0; k < 2; ++k) dst[n][k] = *(const PG8_LAS bf16x8*)(lds + PG8_SB(b, h) + boff + n * 2048 + k * 1024); } while (0)
#define PG8_MMA(ai, bj, At, Bt) do { __builtin_amdgcn_s_setprio(1); _Pragma("unroll") for (int m = 0; m < 4; ++m) _Pragma("unroll") for (int n = 0; n < 2; ++n) _Pragma("unroll") for (int k = 0; k < 2; ++k) \
    acc[ai][bj][m][n] = __builtin_amdgcn_mfma_f32_16x16x32_bf16(Bt[n][k], At[m][k], acc[ai][bj][m][n], 0, 0, 0); __builtin_amdgcn_s_setprio(0); } while (0)
#define PG8_WAIT_V(n) asm volatile("s_waitcnt vmcnt(" #n ")" ::: "memory")
#define PG8_WAIT_L(n) asm volatile("s_waitcnt lgkmcnt(" #n ")" ::: "memory")
#define PG8_BAR __builtin_amdgcn_s_barrier()
#define PG8_SCHED __builtin_amdgcn_sched_barrier(0)
  Unit cur, nxt; int ui = 0;
  if (!S.next(0, cur)) return;
  f32x4 acc[2][2][4][2];
#pragma unroll
  for (int a = 0; a < 2; ++a)
#pragma unroll
    for (int b = 0; b < 2; ++b)
#pragma unroll
      for (int m = 0; m < 4; ++m)
#pragma unroll
        for (int n = 0; n < 2; ++n) acc[a][b][m][n] = (f32x4){0.f, 0.f, 0.f, 0.f};
  bf16x8 At[4][2], B0[2][2], B1[2][2];
  const char* cA = (const char*)g.A + (size_t)cur.pm * tstepA; const char* cB = (const char*)g.Bt + (size_t)cur.pn * tstepB;
  PG8_STAGE(PG8_SB(0, 0), cB, voffB); PG8_STAGE(PG8_SA(0, 0), cA, voffA); PG8_STAGE(PG8_SB(0, 1), cB + hstepB, voffB); PG8_STAGE(PG8_SA(0, 1), cA + hstepA, voffA);
  if (wr == 1) PG8_BAR;
  PG8_WAIT_V(4); PG8_BAR;
  PG8_STAGE(PG8_SB(1, 0), cB + kstep, voffB); PG8_STAGE(PG8_SA(1, 0), cA + kstep, voffA); PG8_STAGE(PG8_SB(1, 1), cB + hstepB + kstep, voffB);
  PG8_WAIT_V(6); PG8_BAR;
  for (;;) {
    const bool has_next = S.next(ui + 1, nxt);
    const char* nA = has_next ? (const char*)g.A + (size_t)nxt.pm * tstepA : cA; const char* nB = has_next ? (const char*)g.Bt + (size_t)nxt.pn * tstepB : cB;
    for (int t = 0; t < nt; t += 2) {
      const bool last = (t == nt - 2);
      const char* a1 = cA + (size_t)(t + 1) * kstep;
      const char* a2 = last ? nA : cA + (size_t)(t + 2) * kstep; const char* b2 = last ? nB : cB + (size_t)(t + 2) * kstep;
      const char* a3 = a2 + kstep; const char* b3 = b2 + kstep;
      PG8_LDB(B0, 0, 0); PG8_SCHED; PG8_LDA(At, 0, 0); PG8_STAGE(PG8_SA(1, 1), a1 + hstepA, voffA);
      PG8_WAIT_L(8); PG8_BAR; PG8_WAIT_L(0); PG8_MMA(0, 0, At, B0); PG8_BAR; PG8_SCHED;
      PG8_LDB(B1, 0, 1); PG8_STAGE(PG8_SB(0, 0), b2, voffB);
      PG8_BAR; PG8_WAIT_L(0); PG8_MMA(0, 1, At, B1); PG8_BAR;
      PG8_LDA(At, 0, 1); PG8_STAGE(PG8_SA(0, 0), a2, voffA);
      PG8_BAR; PG8_WAIT_L(0); PG8_MMA(1, 0, At, B0); PG8_BAR; PG8_SCHED;
      PG8_STAGE(PG8_SB(0, 1), b2 + hstepB, voffB);
      PG8_WAIT_V(6); PG8_BAR; PG8_MMA(1, 1, At, B1); PG8_BAR;
      PG8_LDB(B0, 1, 0); PG8_SCHED; PG8_LDA(At, 1, 0); PG8_STAGE(PG8_SA(0, 1), a2 + hstepA, voffA);
      PG8_WAIT_L(8); PG8_BAR; PG8_WAIT_L(0); PG8_MMA(0, 0, At, B0); PG8_BAR; PG8_SCHED;
      PG8_LDB(B1, 1, 1); PG8_STAGE(PG8_SB(1, 0), b3, voffB);
      PG8_BAR; PG8_WAIT_L(0); PG8_MMA(0, 1, At, B1); PG8_BAR;
      PG8_LDA(At, 1, 1); PG8_STAGE(PG8_SA(1, 0), a3, voffA);
      PG8_BAR; PG8_WAIT_L(0); PG8_MMA(1, 0, At, B0); PG8_BAR; PG8_SCHED;
      PG8_STAGE(PG8_SB(1, 1), b3 + hstepB, voffB);
      PG8_WAIT_V(6); PG8_BAR; PG8_MMA(1, 1, At, B1); PG8_BAR;
    }
    E(acc, cur, wr, wc, fr, fq, lane);
    if (!has_next) break;
#pragma unroll
    for (int a = 0; a < 2; ++a)
#pragma unroll
      for (int b = 0; b < 2; ++b)
#pragma unroll
        for (int m = 0; m < 4; ++m)
#pragma unroll
          for (int n = 0; n < 2; ++n) acc[a][b][m][n] = (f32x4){0.f, 0.f, 0.f, 0.f};
    cur = nxt; cA = nA; cB = nB; ++ui;
  }
  PG8_WAIT_V(0);
  if (wr == 0) PG8_BAR;
  PG8_BAR;
#undef PG8_SA
#undef PG8_SB
#undef PG8_STAGE
#undef PG8_LDA
#undef PG8_LDB
#undef PG8_MMA
#undef PG8_WAIT_V
#undef PG8_WAIT_L
#undef PG8_BAR
#undef PG8_SCHED
}
}

#define OFF_STATS OFF_GLR

__device__ __forceinline__ u32x4 pack8v(const f32x4& a, const f32x4& b) {
  u32x4 w; w.x = pg8::cvt_pk_bf16(a[0], a[1]); w.y = pg8::cvt_pk_bf16(a[2], a[3]); w.z = pg8::cvt_pk_bf16(b[0], b[1]); w.w = pg8::cvt_pk_bf16(b[2], b[3]); return w;
}
__device__ __forceinline__ float xlane32(float v, int lane) { return __int_as_float(__builtin_amdgcn_ds_bpermute((lane ^ 32) << 2, __float_as_int(v))); }

struct EpiScanIn {
  static constexpr bool PERM = true;
  u16* S; const float* rot;
  __device__ __forceinline__ void operator()(const f32x4 (&acc)[2][2][4][2], const pg8::Unit& u, int wr, int wc, int fr, int fq, int lane) const {
    u16* Sb = S + (size_t)u.pm * 256 * 4096;
    unsigned rl0 = wr * 64 + fr; asm volatile("" : "+v"(rl0));
#pragma unroll
    for (int bj = 0; bj < 2; ++bj) {
      const int nt128 = u.pn * 2 + bj;
      const bool scaled = (nt128 < 4) || (nt128 >= 16 && nt128 < 20);
      const float scl = scaled ? 0.08838834764831845f : 1.f;
      const unsigned cb = nt128 * 128 + wc * 32 + fq * 8;
      if (nt128 < 8 && u.pm < 128) {
        const int tb = (u.pm & 15) * 256;
        const int fo = ((wc & 1) * 16 + (fq & 1) * 8) * 2;
        const float sgn = (fq >> 1) ? 1.f : -1.f;
#pragma unroll
        for (int ai = 0; ai < 2; ++ai)
#pragma unroll
          for (int m = 0; m < 4; ++m) {
            const unsigned rl = rl0 + ai * 128 + m * 16;
            const int t = tb + rl;
            const unsigned pos = (wc >> 1) == 0 ? (t >> 6) : (t & 63);
            const float* rp = rot + pos * 64u + fo;
            const float4 c0 = *(const float4*)rp, c1 = *(const float4*)(rp + 4), c2 = *(const float4*)(rp + 8), c3 = *(const float4*)(rp + 12);
            const f32x4 v0 = acc[ai][bj][m][0], v1 = acc[ai][bj][m][1];
            f32x4 p0, p1;
#pragma unroll
            for (int j = 0; j < 4; ++j) { p0[j] = xlane32(v0[j], lane); p1[j] = xlane32(v1[j], lane); }
            f32x4 o0, o1;
            o0[0] = (v0[0] * c0.x + sgn * p0[0] * c0.y) * scl; o0[1] = (v0[1] * c0.z + sgn * p0[1] * c0.w) * scl;
            o0[2] = (v0[2] * c1.x + sgn * p0[2] * c1.y) * scl; o0[3] = (v0[3] * c1.z + sgn * p0[3] * c1.w) * scl;
            o1[0] = (v1[0] * c2.x + sgn * p1[0] * c2.y) * scl; o1[1] = (v1[1] * c2.z + sgn * p1[1] * c2.w) * scl;
            o1[2] = (v1[2] * c3.x + sgn * p1[2] * c3.y) * scl; o1[3] = (v1[3] * c3.z + sgn * p1[3] * c3.w) * scl;
            *(u32x4*)(Sb + rl * 4096u + cb) = pack8v(o0, o1);
            __builtin_amdgcn_sched_barrier(0);
          }
      } else {
#pragma unroll
        for (int ai = 0; ai < 2; ++ai)
#pragma unroll
          for (int m = 0; m < 4; ++m) {
            const unsigned rl = rl0 + ai * 128 + m * 16;
            *(u32x4*)(Sb + rl * 4096u + cb) = pack8v(acc[ai][bj][m][0] * scl, acc[ai][bj][m][1] * scl);
            __builtin_amdgcn_sched_barrier(0);
          }
      }
    }
  }
};

struct EpiGate {
  static constexpr bool PERM = true;
  const u16* RG; const float* stats; u16* S; const float* rgain; const float* ggain;
  __device__ __forceinline__ void operator()(const f32x4 (&acc)[2][2][4][2], const pg8::Unit& u, int wr, int wc, int fr, int fq, int lane) const {
    u16* Sb = S + (size_t)u.pm * 256 * 4096;
    unsigned rl0 = wr * 64 + fr; asm volatile("" : "+v"(rl0));
    if (u.pn < 8) {
      const int branch = u.pn >> 2, head = u.pn & 3;
      const u16* RGb = RG + (size_t)u.pm * 256 * 2048 + branch * 1024;
      const float* stb = stats + (size_t)u.pm * 256 * 16 + (branch * 4 + head) * 2;
      const float* gain = branch ? ggain : rgain;
#pragma unroll
      for (int bj = 0; bj < 2; ++bj) {
        const unsigned cb = head * 256 + bj * 128 + wc * 32 + fq * 8;
        const float4 g0 = *(const float4*)(gain + cb), g1 = *(const float4*)(gain + cb + 4);
#pragma unroll
        for (int ai = 0; ai < 2; ++ai)
#pragma unroll
          for (int m = 0; m < 4; ++m) {
            const unsigned rl = rl0 + ai * 128 + m * 16;
            const float2 st = *(const float2*)(stb + rl * 16u);
            const bf16x8 xr = *(const bf16x8*)(RGb + rl * 2048u + cb);
            f32x4 v0 = acc[ai][bj][m][0], v1 = acc[ai][bj][m][1];
            asm volatile("" : "+v"(v0), "+v"(v1));
            f32x4 o0, o1;
            o0[0] = (bf2f((u16)xr[0]) * st.x + st.y) * g0.x * siluf_(v0[0]); o0[1] = (bf2f((u16)xr[1]) * st.x + st.y) * g0.y * siluf_(v0[1]);
            o0[2] = (bf2f((u16)xr[2]) * st.x + st.y) * g0.z * siluf_(v0[2]); o0[3] = (bf2f((u16)xr[3]) * st.x + st.y) * g0.w * siluf_(v0[3]);
            o1[0] = (bf2f((u16)xr[4]) * st.x + st.y) * g1.x * siluf_(v1[0]); o1[1] = (bf2f((u16)xr[5]) * st.x + st.y) * g1.y * siluf_(v1[1]);
            o1[2] = (bf2f((u16)xr[6]) * st.x + st.y) * g1.z * siluf_(v1[2]); o1[3] = (bf2f((u16)xr[7]) * st.x + st.y) * g1.w * siluf_(v1[3]);
            *(u32x4*)(Sb + rl * 4096u + 2048u + branch * 1024 + cb) = pack8v(o0, o1);
            __builtin_amdgcn_sched_barrier(0);
          }
      }
    } else {
#pragma unroll
      for (int bj = 0; bj < 2; ++bj) {
        const unsigned cb = (u.pn - 8) * 256 + bj * 128 + wc * 32 + fq * 8;
#pragma unroll
        for (int ai = 0; ai < 2; ++ai)
#pragma unroll
          for (int m = 0; m < 4; ++m) {
            const unsigned rl = rl0 + ai * 128 + m * 16;
            f32x4 v0 = acc[ai][bj][m][0], v1 = acc[ai][bj][m][1];
            asm volatile("" : "+v"(v0), "+v"(v1));
            f32x4 o0, o1;
#pragma unroll
            for (int j = 0; j < 4; ++j) { o0[j] = sigmoidf_(v0[j]); o1[j] = sigmoidf_(v1[j]); }
            *(u32x4*)(Sb + rl * 4096u + cb) = pack8v(o0, o1);
            __builtin_amdgcn_sched_barrier(0);
          }
      }
    }
  }
};

struct EpiMerge {
  static constexpr bool PERM = true;
  const u16* S; u16* MG; int pass;
  __device__ __forceinline__ void operator()(const f32x4 (&acc)[2][2][4][2], const pg8::Unit& u, int wr, int wc, int fr, int fq, int lane) const {
    const u16* Sb = S + (size_t)u.pm * 256 * 4096 + pass * 1024;
    u16* MGb = MG + (size_t)u.pm * 256 * 1024;
    unsigned rl0 = wr * 64 + fr; asm volatile("" : "+v"(rl0));
#pragma unroll
    for (int bj = 0; bj < 2; ++bj) {
      const unsigned cb = u.pn * 256 + bj * 128 + wc * 32 + fq * 8;
#pragma unroll
      for (int ai = 0; ai < 2; ++ai)
#pragma unroll
        for (int m = 0; m < 4; ++m) {
          const unsigned rl = rl0 + ai * 128 + m * 16;
          const bf16x8 gt = *(const bf16x8*)(Sb + rl * 4096u + cb);
          f32x4 o0 = acc[ai][bj][m][0], o1 = acc[ai][bj][m][1];
#pragma unroll
          for (int j = 0; j < 4; ++j) { o0[j] *= bf2f((u16)gt[j]); o1[j] *= bf2f((u16)gt[4 + j]); }
          if (pass) {
            const bf16x8 old = *(const bf16x8*)(MGb + rl * 1024u + cb);
#pragma unroll
            for (int j = 0; j < 4; ++j) { o0[j] += bf2f((u16)old[j]); o1[j] += bf2f((u16)old[4 + j]); }
          }
          *(u32x4*)(MGb + rl * 1024u + cb) = pack8v(o0, o1);
            __builtin_amdgcn_sched_barrier(0);
        }
    }
  }
};

struct EpiOut {
  static constexpr bool PERM = false;
  const float* x_lat; const float* x_ctx; float* o_lat; float* o_ctx; const float* mod;
  __device__ __forceinline__ void operator()(const f32x4 (&acc)[2][2][4][2], const pg8::Unit& u, int wr, int wc, int fr, int fq, int lane) const {
    const float* hin; float* hout; int rmod;
    if (u.pm < 128) { hin = x_lat + (size_t)u.pm * 256 * DM; hout = o_lat + (size_t)u.pm * 256 * DM; rmod = u.pm >> 4; }
    else { hin = x_ctx + (size_t)(u.pm - 128) * 256 * DM; hout = o_ctx + (size_t)(u.pm - 128) * 256 * DM; rmod = 8; }
    const float* gate = mod + rmod * 3072 + 2048;
    unsigned rl0 = wr * 64 + fr; asm volatile("" : "+v"(rl0));
#pragma unroll
    for (int bj = 0; bj < 2; ++bj)
#pragma unroll
      for (int n = 0; n < 2; ++n) {
        const unsigned cb = u.pn * 256 + bj * 128 + wc * 32 + n * 16 + fq * 4;
        const float4 g = *(const float4*)(gate + cb);
#pragma unroll
        for (int ai = 0; ai < 2; ++ai)
#pragma unroll
          for (int m = 0; m < 4; ++m) {
            const unsigned o = (rl0 + ai * 128 + m * 16) * 1024u + cb;
            const float4 h = *(const float4*)(hin + o);
            const f32x4 v = acc[ai][bj][m][n];
            *(float4*)(hout + o) = make_float4(h.x + g.x * v[0], h.y + g.y * v[1], h.z + g.z * v[2], h.w + g.w * v[3]);
          }
      }
  }
};

__device__ __forceinline__ void phase_stats(const Params& p, int l) {
  const int tid = opaque_tid(); const int wave = tid >> 6, lane = tid & 63;
  const u16* RG = (const u16*)(p.ws + OFF_RG);
  float* ST = (float*)(p.ws + OFF_STATS);
  const int nrows = (l == 0) ? MTOT : MLAT;
  for (int row = (blockIdx.x * 8 + wave) * 4; row < nrows; row += gridDim.x * 32) {
    bf16x8 v[4][4];
#pragma unroll
    for (int q = 0; q < 4; ++q)
#pragma unroll
      for (int i = 0; i < 4; ++i) v[q][i] = *(const bf16x8*)(RG + (size_t)(row + q) * 2048 + i * 512 + lane * 8);
#pragma unroll
    for (int q = 0; q < 4; ++q)
#pragma unroll
      for (int i = 0; i < 4; ++i) {
        float s1 = 0.f, s2 = 0.f;
#pragma unroll
        for (int x = 0; x < 8; ++x) { float a = bf2f((u16)v[q][i][x]); s1 += a; s2 += a * a; }
#pragma unroll
        for (int o = 16; o > 0; o >>= 1) {
          s1 += __int_as_float(__builtin_amdgcn_ds_bpermute((lane ^ o) << 2, __float_as_int(s1)));
          s2 += __int_as_float(__builtin_amdgcn_ds_bpermute((lane ^ o) << 2, __float_as_int(s2)));
        }
        float sa, sb;
        if ((i >> 1) == 0) { float mu = s1 * (1.f / 256.f); float var = fmaxf(s2 * (1.f / 256.f) - mu * mu, 0.f); sa = rsqrtf(var + 1e-6f); sb = -mu * sa; }
        else { sa = rsqrtf(s2 * (1.f / 256.f) + 1e-6f); sb = 0.f; }
        if ((lane & 31) == 0) *(float2*)(ST + ((size_t)(row + q) * 8 + (i >> 1) * 4 + 2 * (i & 1) + (lane >> 5)) * 2) = make_float2(sa, sb);
      }
  }
}

#define OFF_VECS OFF_WT
__device__ __forceinline__ float logsig16(float x) { return (fminf(x, 0.f) - __logf(1.f + __expf(-fabsf(x)))) * (1.f / 16.f); }

__device__ __forceinline__ void gla_prepass_unit(const Params& p, int l, int unit, char* smem) {
  const int tid = opaque_tid();
  const int b = unit / 68, cid = unit % 68;
  const int base = cid < 4 ? (MLAT + b * 256 + cid * 64) : (b * 4096 + (cid - 4) * 64);
  float* GLRS = (float*)smem;
  __syncthreads();
  {
    const int wid = tid >> 6, lane = tid & 63, fr = lane & 15, fq = lane >> 4;
    if (wid < 4) {
      f32x4 g = (f32x4){0.f, 0.f, 0.f, 0.f};
      const u16* Ua = (const u16*)(p.ws + OFF_U) + (size_t)(base + wid * 16 + fr) * 1024 + fq * 8;
      const u16* Wb = (const u16*)(p.ws + OFF_WT) + (size_t)(4096 + fr) * 1024 + fq * 8;
#pragma unroll 8
      for (int k = 0; k < 1024; k += 32) {
        bf16x8 a = *(const bf16x8*)(Ua + k);
        bf16x8 w = *(const bf16x8*)(Wb + k);
        g = __builtin_amdgcn_mfma_f32_16x16x32_bf16(a, w, g, 0, 0, 0);
      }
#pragma unroll
      for (int j = 0; j < 4; ++j) GLRS[(wid * 16 + fq * 4 + j) * 16 + fr] = g[j];
    }
  }
  float wf[16], wb[16];
  {
    const float* w0 = p.gla_w_up + (size_t)(l * 2 + 0) * 16 * 512 + tid;
    const float* w1 = p.gla_w_up + (size_t)(l * 2 + 1) * 16 * 512 + tid;
#pragma unroll
    for (int r = 0; r < 16; ++r) { wf[r] = w0[r * 512]; wb[r] = w1[r * 512]; }
  }
  const float bf_ = p.gla_b_up[(l * 2 + 0) * 512 + tid], bb_ = p.gla_b_up[(l * 2 + 1) * 512 + tid];
  __syncthreads();
  u16* Sq = (u16*)(p.ws + OFF_S) + (size_t)base * 4096 + 2048 + tid;
  u16* Ub = (u16*)(p.ws + OFF_U) + (size_t)base * 1024 + tid;
  float accF = 0.f, accB = 0.f;
#pragma unroll 8
  for (int u = 0; u < 32; ++u) {
    const int i = 31 - u;
    const float4* gr = (const float4*)(GLRS + i * 16);
    float4 g0 = gr[0], g1 = gr[1], g2 = gr[2], g3 = gr[3];
    float xf = bf_, xb = bb_;
    xf += g0.x * wf[0] + g0.y * wf[1] + g0.z * wf[2] + g0.w * wf[3] + g1.x * wf[4] + g1.y * wf[5] + g1.z * wf[6] + g1.w * wf[7]
        + g2.x * wf[8] + g2.y * wf[9] + g2.z * wf[10] + g2.w * wf[11] + g3.x * wf[12] + g3.y * wf[13] + g3.z * wf[14] + g3.w * wf[15];
    xb += g0.x * wb[0] + g0.y * wb[1] + g0.z * wb[2] + g0.w * wb[3] + g1.x * wb[4] + g1.y * wb[5] + g1.z * wb[6] + g1.w * wb[7]
        + g2.x * wb[8] + g2.y * wb[9] + g2.z * wb[10] + g2.w * wb[11] + g3.x * wb[12] + g3.y * wb[13] + g3.z * wb[14] + g3.w * wb[15];
    const float laf = logsig16(xf), lab = logsig16(xb);
    const float relf = -accF; accF += laf;
    accB += lab; const float relb = accB;
    const float q = bf2f(Sq[(unsigned)i * 4096u]), k = bf2f(Sq[(unsigned)i * 4096u + 512u]);
    Sq[(unsigned)i * 4096u] = f2bf(q * __expf(relf));
    Sq[(unsigned)i * 4096u + 512u] = f2bf(k * __expf(-relf));
    Ub[(unsigned)i * 1024u] = f2bf(q * __expf(relb));
    Ub[(unsigned)i * 1024u + 512u] = f2bf(k * __expf(-relb));
  }
  float accF2 = 0.f, accB2 = 0.f;
#pragma unroll 8
  for (int u = 0; u < 32; ++u) {
    const int i = 32 + u;
    const float4* gr = (const float4*)(GLRS + i * 16);
    float4 g0 = gr[0], g1 = gr[1], g2 = gr[2], g3 = gr[3];
    float xf = bf_, xb = bb_;
    xf += g0.x * wf[0] + g0.y * wf[1] + g0.z * wf[2] + g0.w * wf[3] + g1.x * wf[4] + g1.y * wf[5] + g1.z * wf[6] + g1.w * wf[7]
        + g2.x * wf[8] + g2.y * wf[9] + g2.z * wf[10] + g2.w * wf[11] + g3.x * wf[12] + g3.y * wf[13] + g3.z * wf[14] + g3.w * wf[15];
    xb += g0.x * wb[0] + g0.y * wb[1] + g0.z * wb[2] + g0.w * wb[3] + g1.x * wb[4] + g1.y * wb[5] + g1.z * wb[6] + g1.w * wb[7]
        + g2.x * wb[8] + g2.y * wb[9] + g2.z * wb[10] + g2.w * wb[11] + g3.x * wb[12] + g3.y * wb[13] + g3.z * wb[14] + g3.w * wb[15];
    const float laf = logsig16(xf), lab = logsig16(xb);
    accF2 += laf; const float relf = accF2;
    const float relb = -accB2; accB2 += lab;
    const float q = bf2f(Sq[(unsigned)i * 4096u]), k = bf2f(Sq[(unsigned)i * 4096u + 512u]);
    Sq[(unsigned)i * 4096u] = f2bf(q * __expf(relf));
    Sq[(unsigned)i * 4096u + 512u] = f2bf(k * __expf(-relf));
    Ub[(unsigned)i * 1024u] = f2bf(q * __expf(relb));
    Ub[(unsigned)i * 1024u + 512u] = f2bf(k * __expf(-relb));
  }
  float* V0 = (float*)(p.ws + OFF_VECS) + ((size_t)(0 * 544 + b * 68 + cid) * 2) * 512 + tid;
  float* V1 = (float*)(p.ws + OFF_VECS) + ((size_t)(1 * 544 + b * 68 + cid) * 2) * 512 + tid;
  V0[0] = __expf(accF);  V0[512] = __expf(accF2);
  V1[0] = __expf(accB2); V1[512] = __expf(accB);
}

#define L_QR   0
#define L_KR   17408
#define L_V    34816
#define L_SGT  44032
#define L_P    61440
#undef  SCAN_GB
#define SCAN_GB 70656

__device__ __forceinline__ int off128(int row, int col) { return row * 272 + col * 2; }
__device__ __forceinline__ int off64(int row, int col) { return row * 144 + col * 2; }

template <int RS>
__device__ __forceinline__ bf16x8 tr_frag(unsigned img_addr, int r0, int c0, int lane) {
  const int g = lane >> 4, q = (lane & 15) >> 2, pp = lane & 3;
  unsigned a = img_addr + (unsigned)((r0 + 8 * g + q) * RS + (c0 + 4 * pp) * 2);
  bf16x4 lo, hi;
  asm volatile("ds_read_b64_tr_b16 %0, %2\n\tds_read_b64_tr_b16 %1, %2 offset:%3\n\ts_waitcnt lgkmcnt(0)"
               : "=&v"(lo), "=&v"(hi) : "v"(a), "n"(4 * RS) : "memory");
  bf16x8 r;
  r[0] = lo[0]; r[1] = lo[1]; r[2] = lo[2]; r[3] = lo[3]; r[4] = hi[0]; r[5] = hi[1]; r[6] = hi[2]; r[7] = hi[3];
  return r;
}

__device__ __forceinline__ bf16x8 scale8(bf16x8 v, float f) {
  bf16x8 o;
#pragma unroll
  for (int x = 0; x < 8; ++x) o[x] = (short)f2bf(bf2f((u16)v[x]) * f);
  return o;
}

__device__ __forceinline__ void lds_barrier() { asm volatile("s_waitcnt lgkmcnt(0)" ::: "memory"); __builtin_amdgcn_s_barrier(); asm volatile("" ::: "memory"); }

template <int branch>
__device__ __forceinline__ void scan_item(const Params& p, int l, int item, char* smem) {
  const int b = (item >> 4) & 7, h = (item >> 2) & 3, slice = item & 3;
  const int tid = opaque_tid(), wid = __builtin_amdgcn_readfirstlane(tid >> 6), lane = tid & 63;
  const int dir = wid >> 2, gw = wid & 3, gt = tid & 255;
  const int fr = lane & 15, fq = lane >> 4;
  char* G = smem + dir * SCAN_GB;
  const unsigned Ga = (unsigned)(size_t)G;
  const u16* S = (const u16*)(p.ws + OFF_S);
  u16* RG = (u16*)(p.ws + OFF_RG);
  const u16* qsrc; unsigned qstride;
  if (branch == 0) { qsrc = S + h * 128; qstride = 4096; }
  else if (dir == 0) { qsrc = S + 2048 + h * 128; qstride = 4096; }
  else { qsrc = (const u16*)(p.ws + OFF_U) + h * 128; qstride = 1024; }
  const int voff = branch * 2048 + 1024 + h * 256 + slice * 64;
  const int ooff = branch * 1024 + h * 256 + slice * 64;
  float lg = 0.f, egc = 1.f;
  if (branch == 0) { lg = __logf(1.f - __expf(p.ret_decay[(l * 2 + dir) * 4 + h])); egc = __expf(32.f * lg); }
  const float* VECS = (const float*)(p.ws + OFF_VECS) + ((size_t)(dir * 544 + b * 68) * 2) * 512 + h * 128;
  f32x4 st[2][4];
#pragma unroll
  for (int m = 0; m < 2; ++m)
#pragma unroll
    for (int n = 0; n < 4; ++n) st[m][n] = (f32x4){0.f, 0.f, 0.f, 0.f};

  const int qj = gt >> 4, qc = gt & 15;
  const int vj = gt >> 3, vc = gt & 7;
  bf16x8 pq[4], pk[4], pv[2];
  float4 peg[2], pel[2];
  auto prefetch = [&](int s) {
    int base, cid;
    if (s < 4) { int cc = dir ? 3 - s : s; base = MLAT + b * 256 + cc * 64; cid = cc; }
    else { int c = s - 4; int cc = dir ? 63 - c : c; base = b * 4096 + cc * 64; cid = 4 + cc; }
#pragma unroll
    for (int i = 0; i < 4; ++i) {
      int jp = qj + 16 * i;
      unsigned ro = (unsigned)(base + (dir ? 63 - jp : jp)) * qstride + qc * 8;
      pq[i] = *(const bf16x8*)(qsrc + ro);
      pk[i] = *(const bf16x8*)(qsrc + ro + 512);
    }
#pragma unroll
    for (int i = 0; i < 2; ++i) {
      int jp = vj + 32 * i;
      pv[i] = *(const bf16x8*)(S + (size_t)(base + (dir ? 63 - jp : jp)) * 4096 + voff + vc * 8);
    }
    if (branch == 1) {
#pragma unroll
      for (int m = 0; m < 2; ++m) {
        int d0 = gw * 32 + m * 16 + fq * 4;
        peg[m] = *(const float4*)(VECS + (size_t)cid * 1024 + d0);
        pel[m] = *(const float4*)(VECS + (size_t)cid * 1024 + 512 + d0);
      }
    }
  };
  prefetch(0);
  __syncthreads();

  for (int s = 0; s < 68; ++s) {
    int base; bool first; bool wout;
    if (s < 4) { int cc = dir ? 3 - s : s; base = MLAT + b * 256 + cc * 64; first = s < 2; wout = (l == 0); }
    else { int c = s - 4; int cc = dir ? 63 - c : c; base = b * 4096 + cc * 64; first = c < 32; wout = true; }
    float4 eg[2], el[2];
#pragma unroll
    for (int m = 0; m < 2; ++m) {
      if (branch == 1) { eg[m] = peg[m]; el[m] = pel[m]; }
      else { eg[m] = make_float4(egc, egc, egc, egc); el[m] = eg[m]; }
    }
#pragma unroll
    for (int i = 0; i < 4; ++i) {
      int jp = qj + 16 * i;
      bf16x8 qv = pq[i], kv_ = pk[i];
      if (branch == 0) {
        float fqs = __expf((float)(jp - 31) * lg), fks = __expf((float)(31 - jp) * lg);
        qv = scale8(qv, fqs); kv_ = scale8(kv_, fks);
      }
      *(bf16x8*)(G + L_QR + off128(jp, qc * 8)) = qv;
      *(bf16x8*)(G + L_KR + off128(jp, qc * 8)) = kv_;
    }
#pragma unroll
    for (int i = 0; i < 2; ++i) *(bf16x8*)(G + L_V + off64(vj + 32 * i, vc * 8)) = pv[i];
#pragma unroll
    for (int m = 0; m < 2; ++m) {
      int d0 = gw * 32 + m * 16 + fq * 4;
#pragma unroll
      for (int n = 0; n < 4; ++n) {
        int e = n * 16 + fr;
        bf16x4 o4;
        o4[0] = (short)f2bf(st[m][n][0] * eg[m].x); o4[1] = (short)f2bf(st[m][n][1] * eg[m].y);
        o4[2] = (short)f2bf(st[m][n][2] * eg[m].z); o4[3] = (short)f2bf(st[m][n][3] * eg[m].w);
        *(bf16x4*)(G + L_SGT + off128(e, d0)) = o4;
      }
    }
    u16 oldv[4][4];
    u16* dstb = RG + (size_t)base * 2048 + ooff + fr;
    if (wout && !first) {
#pragma unroll
      for (int r = 0; r < 4; ++r) {
        int ip = gw * 16 + fq * 4 + r;
        unsigned ro = (unsigned)(dir ? 63 - ip : ip) * 2048u;
#pragma unroll
        for (int n = 0; n < 4; ++n) oldv[r][n] = dstb[ro + n * 16];
      }
    }
    if (s + 1 < 68) prefetch(s + 1);
    lds_barrier();
    f32x4 pt[4], o[4];
#pragma unroll
    for (int n = 0; n < 4; ++n) { pt[n] = (f32x4){0.f, 0.f, 0.f, 0.f}; o[n] = (f32x4){0.f, 0.f, 0.f, 0.f}; }
#pragma unroll
    for (int ks = 0; ks < 4; ++ks) {
      int kc = ks * 32 + fq * 8;
      bf16x8 ka = *(const bf16x8*)(G + L_KR + off128(gw * 16 + fr, kc));
      bf16x8 qa = *(const bf16x8*)(G + L_QR + off128(gw * 16 + fr, kc));
#pragma unroll
      for (int n = 0; n < 4; ++n) {
        bf16x8 qb = *(const bf16x8*)(G + L_QR + off128(n * 16 + fr, kc));
        bf16x8 sb = *(const bf16x8*)(G + L_SGT + off128(n * 16 + fr, kc));
        pt[n] = __builtin_amdgcn_mfma_f32_16x16x32_bf16(ka, qb, pt[n], 0, 0, 0);
        o[n] = __builtin_amdgcn_mfma_f32_16x16x32_bf16(qa, sb, o[n], 0, 0, 0);
      }
    }
#pragma unroll
    for (int n = 0; n < 4; ++n) {
      int ip = n * 16 + fr;
      int j0 = gw * 16 + fq * 4;
      bf16x4 w;
#pragma unroll
      for (int r = 0; r < 4; ++r) {
        int jp = j0 + r;
        bool keep = dir ? (ip > jp) : (ip >= jp);
        w[r] = (short)f2bf(keep ? pt[n][r] : 0.f);
      }
      *(bf16x4*)(G + L_P + off64(ip, j0)) = w;
    }
    lds_barrier();
    {
      const int tg = lane >> 4, tq = (lane & 15) >> 2, tp = lane & 3;
      const unsigned ka0 = Ga + L_KR + (unsigned)((8 * tg + tq) * 272 + (gw * 32 + 4 * tp) * 2);
      const unsigned va0 = Ga + L_V + (unsigned)((8 * tg + tq) * 144 + (4 * tp) * 2);
#pragma unroll
      for (int m = 0; m < 2; ++m) {
        f32x4 kv[4];
#pragma unroll
        for (int n = 0; n < 4; ++n) kv[n] = (f32x4){0.f, 0.f, 0.f, 0.f};
#pragma unroll
        for (int ks = 0; ks < 2; ++ks) {
          int kc = ks * 32 + fq * 8;
          bf16x4 r0, r1, r2, r3, r4, r5, r6, r7, r8, r9;
          asm volatile(
              "ds_read_b64_tr_b16 %0, %10\n\tds_read_b64_tr_b16 %1, %10 offset:1088\n\t"
              "ds_read_b64_tr_b16 %2, %11\n\tds_read_b64_tr_b16 %3, %11 offset:576\n\t"
              "ds_read_b64_tr_b16 %4, %11 offset:32\n\tds_read_b64_tr_b16 %5, %11 offset:608\n\t"
              "ds_read_b64_tr_b16 %6, %11 offset:64\n\tds_read_b64_tr_b16 %7, %11 offset:640\n\t"
              "ds_read_b64_tr_b16 %8, %11 offset:96\n\tds_read_b64_tr_b16 %9, %11 offset:672\n\t"
              "s_waitcnt lgkmcnt(0)"
              : "=&v"(r0), "=&v"(r1), "=&v"(r2), "=&v"(r3), "=&v"(r4), "=&v"(r5), "=&v"(r6), "=&v"(r7), "=&v"(r8), "=&v"(r9)
              : "v"(ka0 + (unsigned)(ks * 32 * 272 + m * 32)), "v"(va0 + (unsigned)(ks * 32 * 144))
              : "memory");
          bf16x8 km = __builtin_shufflevector(r0, r1, 0, 1, 2, 3, 4, 5, 6, 7);
          bf16x8 vb[4];
          vb[0] = __builtin_shufflevector(r2, r3, 0, 1, 2, 3, 4, 5, 6, 7);
          vb[1] = __builtin_shufflevector(r4, r5, 0, 1, 2, 3, 4, 5, 6, 7);
          vb[2] = __builtin_shufflevector(r6, r7, 0, 1, 2, 3, 4, 5, 6, 7);
          vb[3] = __builtin_shufflevector(r8, r9, 0, 1, 2, 3, 4, 5, 6, 7);
          bf16x8 pa;
          if (m == 0) pa = *(const bf16x8*)(G + L_P + off64(gw * 16 + fr, kc));
#pragma unroll
          for (int n = 0; n < 4; ++n) {
            if (m == 0) o[n] = __builtin_amdgcn_mfma_f32_16x16x32_bf16(pa, vb[n], o[n], 0, 0, 0);
            kv[n] = __builtin_amdgcn_mfma_f32_16x16x32_bf16(km, vb[n], kv[n], 0, 0, 0);
          }
        }
#pragma unroll
        for (int n = 0; n < 4; ++n) {
          st[m][n][0] = eg[m].x * el[m].x * st[m][n][0] + el[m].x * kv[n][0];
          st[m][n][1] = eg[m].y * el[m].y * st[m][n][1] + el[m].y * kv[n][1];
          st[m][n][2] = eg[m].z * el[m].z * st[m][n][2] + el[m].z * kv[n][2];
          st[m][n][3] = eg[m].w * el[m].w * st[m][n][3] + el[m].w * kv[n][3];
        }
      }
    }
    if (wout) {
#pragma unroll
      for (int r = 0; r < 4; ++r) {
        int ip = gw * 16 + fq * 4 + r;
        unsigned ro = (unsigned)(dir ? 63 - ip : ip) * 2048u;
#pragma unroll
        for (int n = 0; n < 4; ++n) {
          float v = o[n][r];
          if (!first) v += bf2f(oldv[r][n]);
          dstb[ro + n * 16] = f2bf(v);
        }
      }
    }
    __syncthreads();
  }
}

#define NPHASE 18
__device__ __forceinline__ void run_phase(const Params& p, int ph, char* smem) {
  const int nblk = gridDim.x, bid = blockIdx.x;
  if (ph == 0) {
#ifdef REP_P0
    for (int rep = 0; rep < REP_P0; ++rep)
#endif
    for (int u = bid; u < WT_UNITS + 96 + 1; u += nblk) {
      if (u < 96) mod_unit(p, u, smem);
      else if (u == 96) rot_unit(p);
      else wt_unit(p, 0, u - 97, smem);
    }
    return;
  }
  if (ph == NPHASE - 1) { phase_final(p); return; }
  const int l = (ph - 1) / 8, sp = (ph - 1) % 8;
  PG8_LAS unsigned char* lds = (PG8_LAS unsigned char*)smem;
  switch (sp) {
    case 0:
      phase_u(p, l);
      if (l == 1) for (int u = bid; u < WT_UNITS; u += nblk) wt_unit(p, 1, u, smem);
      break;
    case 1: {
      pg8::Gemm g{(const u16*)(p.ws + OFF_U), (const u16*)(p.ws + OFF_WT) + (size_t)WT_SCAN * 1024, 1024, MTOT, 4096, 1024};
      pg8::StaticOrder S; S.init(g.M, g.N, nblk, bid);
      EpiScanIn E{(u16*)(p.ws + OFF_S), (const float*)(p.ws + OFF_ROT)};
      pg8::gemm_phase(lds, g, S, E, opaque_tid());
    } break;
    case 2: for (int t = bid; t < 544; t += nblk) gla_prepass_unit(p, l, t, smem); break;
    case 3:
#ifdef REP_SCAN
      for (int rep = 0; rep < REP_SCAN; ++rep)
#endif
      for (int t = bid; t < 256; t += nblk) { if (t < 128) scan_item<0>(p, l, t, smem); else scan_item<1>(p, l, t, smem); } break;
    case 4:
      phase_u(p, l);
      phase_stats(p, l);
      break;
    case 5: {
      pg8::Gemm g{(const u16*)(p.ws + OFF_U), (const u16*)(p.ws + OFF_WT) + (size_t)WT_GATE * 1024, 1024, l == 0 ? MTOT : MLAT, 4096, 1024};
      pg8::StaticOrder S; S.init(g.M, g.N, nblk, bid);
      EpiGate E{(const u16*)(p.ws + OFF_RG), (const float*)(p.ws + OFF_STATS), (u16*)(p.ws + OFF_S), p.ret_norm_gain + l * 1024, p.gla_norm_gain + l * 1024};
      pg8::gemm_phase(lds, g, S, E, opaque_tid());
    } break;
    case 6: {
#pragma unroll 1
      for (int pass = 0; pass < 2; ++pass) {
        pg8::Gemm g{(const u16*)(p.ws + OFF_S) + 2048 + pass * 1024, (const u16*)(p.ws + OFF_WT) + (size_t)(WT_BRR + pass * 1024) * 1024, 4096, l == 0 ? MTOT : MLAT, 1024, 1024};
        pg8::StaticOrder S; S.init(g.M, g.N, nblk, bid);
        EpiMerge E{(const u16*)(p.ws + OFF_S), (u16*)(p.ws + OFF_U), pass};
        pg8::gemm_phase(lds, g, S, E, opaque_tid());
      }
    } break;
    case 7: {
      pg8::Gemm g{(const u16*)(p.ws + OFF_U), (const u16*)(p.ws + OFF_WT) + (size_t)WT_OUT * 1024, 1024, l == 0 ? MTOT : MLAT, 1024, 1024};
      pg8::StaticOrder S; S.init(g.M, g.N, nblk, bid);
      EpiOut E{l == 0 ? p.x : p.out, p.ctx, p.out, (float*)(p.ws + OFF_HCTX), (const float*)(p.ws + OFF_MOD) + (size_t)l * 9 * 3072};
      pg8::gemm_phase(lds, g, S, E, opaque_tid());
    } break;
  }
}

__device__ __forceinline__ void grid_barrier(unsigned* cnt, unsigned target) {
  asm volatile("s_waitcnt vmcnt(0)" ::: "memory");
  __syncthreads();
  if (threadIdx.x == 0) {
    __threadfence();
    __hip_atomic_fetch_add(cnt, 1u, __ATOMIC_RELAXED, __HIP_MEMORY_SCOPE_AGENT);
    while (__hip_atomic_load(cnt, __ATOMIC_RELAXED, __HIP_MEMORY_SCOPE_AGENT) < target) __builtin_amdgcn_s_sleep(2);
    __threadfence();
  }
  __syncthreads();
}

__global__ void __launch_bounds__(NTHREADS) mega(Params p, int ph_lo, int ph_hi, int coop) {
  extern __shared__ __attribute__((aligned(16))) char smem[];
  for (int ph = ph_lo; ph < ph_hi; ++ph) {
    run_phase(p, ph, smem);
    if (coop && ph + 1 < ph_hi) {
      if (ph == ph_lo) cg::this_grid().sync();
      else grid_barrier((unsigned*)(p.ws + OFF_BAR), (unsigned)(ph - ph_lo) * gridDim.x);
    }
  }
}

extern "C" void kernel_launch(void* const* d_in, const int* in_sizes, int n_in,
                              void* d_out, int out_size, void* d_ws, size_t ws_size,
                              hipStream_t stream) {
  Params p{};
  p.x = (const float*)d_in[0]; p.c = (const float*)d_in[1]; p.ctx = (const float*)d_in[2]; p.c_ctx = (const float*)d_in[3];
  p.norm_gain = (const float*)d_in[4]; p.w_ada = (const float*)d_in[5]; p.b_ada = (const float*)d_in[6]; p.w_in = (const float*)d_in[7];
  p.ret_decay = (const float*)d_in[8]; p.gla_w_up = (const float*)d_in[9]; p.gla_b_up = (const float*)d_in[10];
  p.ret_norm_gain = (const float*)d_in[11]; p.gla_norm_gain = (const float*)d_in[12];
  p.w_br_ret = (const float*)d_in[13]; p.w_br_gla = (const float*)d_in[14]; p.w_out = (const float*)d_in[15]; p.final_gain = (const float*)d_in[16];
  p.out = (float*)d_out; p.ws = (char*)d_ws;
  static int grid_blocks = 0;
  if (!grid_blocks) {
    hipFuncSetAttribute((const void*)mega, hipFuncAttributeMaxDynamicSharedMemorySize, LDS_BYTES);
    int dev = 0, cus = 0, per_cu = 0;
    hipGetDevice(&dev);
    hipDeviceGetAttribute(&cus, hipDeviceAttributeMultiprocessorCount, dev);
    hipOccupancyMaxActiveBlocksPerMultiprocessor(&per_cu, mega, NTHREADS, LDS_BYTES);
    if (per_cu < 1) per_cu = 1;
    grid_blocks = cus * 1;
  }
#ifdef MULTI_LAUNCH
  for (int ph = 0; ph < NPHASE; ++ph) {
    mega<<<dim3(grid_blocks), dim3(NTHREADS), LDS_BYTES, stream>>>(p, ph, ph + 1, 0);
  }
#else
  hipMemsetAsync((char*)d_ws + OFF_BAR, 0, 256, stream);
  int lo = 0, hi = NPHASE, coop = 1;
  void* args[] = {&p, &lo, &hi, &coop};
  hipError_t e = hipLaunchCooperativeKernel((void*)mega, dim3(grid_blocks), dim3(NTHREADS), args, LDS_BYTES, stream);
  if (e != hipSuccess) fprintf(stderr, "cooperative launch failed: %s (grid %d)\n", hipGetErrorString(e), grid_blocks);
#endif
}
```

```cpp
#include <hip/hip_runtime.h>
#include <hip/hip_cooperative_groups.h>
#include <cstdio>
namespace cg = cooperative_groups;

typedef unsigned short u16;
using bf16x8 = __attribute__((ext_vector_type(8))) short;
using bf16x4 = __attribute__((ext_vector_type(4))) short;
using f32x4  = __attribute__((ext_vector_type(4))) float;

#define NTHREADS 512
#define DM 1024
#define NB 8
#define SEQL 4096
#define CTXL 256
#define MLAT 32768
#define MCTX 2048
#define MTOT 34816
#define INW 8208

#define OFF_S    0ull
#define OFF_RG   (OFF_S   + (size_t)MTOT * 4096 * 2)
#define OFF_U    (OFF_RG  + (size_t)MTOT * 2048 * 2)
#define OFF_WT   (OFF_U   + (size_t)MTOT * 1024 * 2)
#define WT_ROWS  11392
#define OFF_GLR  (OFF_WT  + (size_t)WT_ROWS * 1024 * 2)
#define OFF_HCTX (OFF_GLR + (size_t)MTOT * 16 * 4)
#define OFF_MOD  (OFF_HCTX+ (size_t)MCTX * 1024 * 4)
#define OFF_ROT  (OFF_MOD + (size_t)2 * 9 * 3072 * 4)
#define OFF_BAR  (OFF_ROT + (size_t)64 * 32 * 2 * 4)
#define OFF_END  (OFF_BAR + 256)

#define WT_SCAN 0
#define WT_GATE 4224
#define WT_BRR  8320
#define WT_BRG  9344
#define WT_OUT  10368

#define LDS_BYTES 161792
#define SCAN_GB   80896

struct Params {
  const float* x; const float* c; const float* ctx; const float* c_ctx;
  const float* norm_gain; const float* w_ada; const float* b_ada; const float* w_in;
  const float* ret_decay; const float* gla_w_up; const float* gla_b_up;
  const float* ret_norm_gain; const float* gla_norm_gain;
  const float* w_br_ret; const float* w_br_gla; const float* w_out; const float* final_gain;
  float* out; char* ws;
};

__device__ __forceinline__ u16 f2bf(float f) {
  __bf16 h = (__bf16)f;
  return *(u16*)&h;
}
__device__ __forceinline__ float bf2f(u16 h) { return __uint_as_float(((unsigned)h) << 16); }
__device__ __forceinline__ float sigmoidf_(float x) { return __builtin_amdgcn_rcpf(1.f + __expf(-x)); }
__device__ __forceinline__ float siluf_(float x) { return x * __builtin_amdgcn_rcpf(1.f + __expf(-x)); }

__device__ __forceinline__ int opaque_tid() { int t = threadIdx.x; asm volatile("" : "+v"(t)); return t; }

__device__ __forceinline__ float wave_sum(float v) {
#pragma unroll
  for (int o = 32; o > 0; o >>= 1) v += __shfl_xor(v, o, 64);
  return v;
}

__device__ __forceinline__ const float* wt_src(const Params& p, int l, int n, int& ld) {
  if (n < WT_GATE) {
    int tile = n >> 7, cc = n & 127;
    int col;
    if (tile < 8) {
      int d = (cc & 64) | ((cc & 16) << 1) | ((cc & 32) >> 1) | (cc & 15);
      col = tile * 128 + d;
    } else if (tile < 16) col = 1024 + (tile - 8) * 128 + cc;
    else if (tile < 24) col = 3072 + (tile - 16) * 128 + cc;
    else if (tile < 32) col = 4096 + (tile - 24) * 128 + cc;
    else { if (cc >= 16) { ld = 0; return nullptr; } col = 6144 + cc; }
    ld = INW; return p.w_in + (size_t)l * DM * INW + col;
  } else if (n < WT_BRR) {
    int g = n - WT_GATE; int col;
    if (g < 1024) col = 2048 + g;
    else if (g < 2048) col = 5120 + (g - 1024);
    else if (g < 3072) col = 6160 + (g - 2048);
    else col = 7184 + (g - 3072);
    ld = INW; return p.w_in + (size_t)l * DM * INW + col;
  } else if (n < WT_BRG) { ld = DM; return p.w_br_ret + (size_t)l * DM * DM + (n - WT_BRR); }
  else if (n < WT_OUT)   { ld = DM; return p.w_br_gla + (size_t)l * DM * DM + (n - WT_BRG); }
  else                   { ld = DM; return p.w_out    + (size_t)l * DM * DM + (n - WT_OUT); }
}

#define WT_UNITS (178 * 16)
__device__ __forceinline__ void wt_unit(const Params& p, int l, int unit, char* smem) {
  float* tile = (float*)smem;
  int nb = unit >> 4, kb = unit & 15;
  int tid = opaque_tid();
  int n0 = nb * 64, k0 = kb * 64;
  {
    int nl = tid & 63, kq = tid >> 6;
    int ld; const float* src = wt_src(p, l, n0 + nl, ld);
#pragma unroll
    for (int i = 0; i < 8; ++i) {
      int kl = kq + 8 * i;
      float v = src ? src[(size_t)(k0 + kl) * ld] : 0.f;
      tile[kl * 65 + nl] = v;
    }
  }
  __syncthreads();
  {
    int nl = tid >> 3, kq = tid & 7;
    bf16x8 o;
#pragma unroll
    for (int j = 0; j < 8; ++j) o[j] = (short)f2bf(tile[(kq * 8 + j) * 65 + nl]);
    u16* wt = (u16*)(p.ws + OFF_WT);
    *(bf16x8*)(wt + (size_t)(n0 + nl) * 1024 + k0 + kq * 8) = o;
  }
  __syncthreads();
}

__device__ __forceinline__ void mod_unit(const Params& p, int unit, char* smem) {
  float* sc = (float*)smem;
  float* red = sc + 9 * 1024;
  int l = unit / 48, jb = unit % 48;
  int tid = opaque_tid();
  for (int i = tid; i < 9 * 1024; i += NTHREADS) {
    int r = i >> 10, k = i & 1023;
    float v = (r < 8) ? p.c[r * 1024 + k] : p.c_ctx[k];
    sc[i] = siluf_(v);
  }
  __syncthreads();
  int jl = tid & 63, kg = tid >> 6;
  int j = jb * 64 + jl;
  float acc[9];
#pragma unroll
  for (int r = 0; r < 9; ++r) acc[r] = 0.f;
  const float* w = p.w_ada + (size_t)l * DM * 3072 + j;
#pragma unroll 16
  for (int k = kg * 128; k < kg * 128 + 128; ++k) {
    float wv = w[(size_t)k * 3072];
#pragma unroll
    for (int r = 0; r < 9; ++r) acc[r] += sc[r * 1024 + k] * wv;
  }
#pragma unroll
  for (int r = 0; r < 9; ++r) red[(kg * 9 + r) * 64 + jl] = acc[r];
  __syncthreads();
  float* mod = (float*)(p.ws + OFF_MOD);
  for (int i = tid; i < 9 * 64; i += NTHREADS) {
    int r = i >> 6, jj = i & 63;
    float s = 0.f;
#pragma unroll
    for (int g = 0; g < 8; ++g) s += red[(g * 9 + r) * 64 + jj];
    mod[((size_t)l * 9 + r) * 3072 + jb * 64 + jj] = s + p.b_ada[l * 3072 + jb * 64 + jj];
  }
  __syncthreads();
}

__device__ __forceinline__ void rot_unit(const Params& p) {
  float* rot = (float*)(p.ws + OFF_ROT);
  for (int i = opaque_tid(); i < 64 * 32; i += NTHREADS) {
    int pos = i >> 5, f = i & 31;
    float inv = exp2f(-(float)f * (13.287712379549449f / 32.f));
    float ang = (float)pos * inv;
    rot[i * 2] = __cosf(ang);
    rot[i * 2 + 1] = __sinf(ang);
  }
}

__device__ __forceinline__ void phase_u(const Params& p, int l) {
  const int tid = opaque_tid(); int wave = tid >> 6, lane = tid & 63;
  const float* mod = (const float*)(p.ws + OFF_MOD) + (size_t)l * 9 * 3072;
  const float* gain = p.norm_gain + l * DM;
  u16* U = (u16*)(p.ws + OFF_U);
  for (int row = (blockIdx.x * 8 + wave) * 4; row < MTOT; row += gridDim.x * 32) {
    const float* h; int r;
    if (row < MLAT) { h = (l == 0 ? p.x : p.out) + (size_t)row * DM; r = row >> 12; }
    else { int cr = row - MLAT; h = (l == 0 ? p.ctx : (const float*)(p.ws + OFF_HCTX)) + (size_t)cr * DM; r = 8; }
    float4 v[4][4]; float ss[4];
#pragma unroll
    for (int q = 0; q < 4; ++q) {
      ss[q] = 0.f;
#pragma unroll
      for (int i = 0; i < 4; ++i) v[q][i] = *(const float4*)(h + q * DM + i * 256 + lane * 4);
    }
#pragma unroll
    for (int q = 0; q < 4; ++q) {
#pragma unroll
      for (int i = 0; i < 4; ++i) ss[q] += v[q][i].x * v[q][i].x + v[q][i].y * v[q][i].y + v[q][i].z * v[q][i].z + v[q][i].w * v[q][i].w;
      ss[q] = rsqrtf(wave_sum(ss[q]) * (1.f / 1024.f) + 1e-6f);
    }
    const float* sh = mod + r * 3072;
#pragma unroll
    for (int i = 0; i < 4; ++i) {
      int cidx = i * 256 + lane * 4;
      float4 g = *(const float4*)(gain + cidx);
      float4 s = *(const float4*)(sh + cidx);
      float4 sc = *(const float4*)(sh + 1024 + cidx);
      g.x *= (1.f + sc.x); g.y *= (1.f + sc.y); g.z *= (1.f + sc.z); g.w *= (1.f + sc.w);
#pragma unroll
      for (int q = 0; q < 4; ++q) {
        bf16x4 o;
        o[0] = (short)f2bf(v[q][i].x * ss[q] * g.x + s.x);
        o[1] = (short)f2bf(v[q][i].y * ss[q] * g.y + s.y);
        o[2] = (short)f2bf(v[q][i].z * ss[q] * g.z + s.z);
        o[3] = (short)f2bf(v[q][i].w * ss[q] * g.w + s.w);
        *(bf16x4*)(U + (size_t)(row + q) * DM + cidx) = o;
      }
    }
  }
}

__device__ __forceinline__ void phase_final(const Params& p) {
  const int tid = opaque_tid(); int wave = tid >> 6, lane = tid & 63;
  for (int row = (blockIdx.x * 8 + wave) * 4; row < MLAT; row += gridDim.x * 32) {
    float* h = p.out + (size_t)row * DM;
    float4 v[4][4]; float ss[4];
#pragma unroll
    for (int q = 0; q < 4; ++q) {
      ss[q] = 0.f;
#pragma unroll
      for (int i = 0; i < 4; ++i) v[q][i] = *(const float4*)(h + q * DM + i * 256 + lane * 4);
    }
#pragma unroll
    for (int q = 0; q < 4; ++q) {
#pragma unroll
      for (int i = 0; i < 4; ++i) ss[q] += v[q][i].x * v[q][i].x + v[q][i].y * v[q][i].y + v[q][i].z * v[q][i].z + v[q][i].w * v[q][i].w;
      ss[q] = rsqrtf(wave_sum(ss[q]) * (1.f / 1024.f) + 1e-6f);
    }
#pragma unroll
    for (int i = 0; i < 4; ++i) {
      int cidx = i * 256 + lane * 4;
      float4 g = *(const float4*)(p.final_gain + cidx);
#pragma unroll
      for (int q = 0; q < 4; ++q) {
        float4 o;
        o.x = v[q][i].x * ss[q] * g.x; o.y = v[q][i].y * ss[q] * g.y; o.z = v[q][i].z * ss[q] * g.z; o.w = v[q][i].w * ss[q] * g.w;
        *(float4*)(h + q * DM + cidx) = o;
      }
    }
  }
}

#define PG8_LAS __attribute__((address_space(3)))
typedef unsigned u32x4 __attribute__((ext_vector_type(4)));
namespace pg8 {
constexpr int BM = 256, BK = 64, HALF = 128, HTB = HALF * BK * 2, STAGE_BYTES = 8 * HTB, NXCD = 8, WGM = 8;
__device__ __forceinline__ int lds_byte(int r, int c) { const int st = (r >> 4) * 2 + (c >> 5), rr = r & 15, cc = c & 31, ob = rr * 64 + cc * 2; return st * 1024 + (ob ^ (((ob >> 9) & 1) << 5)); }
__device__ __forceinline__ void stage_rc(int b, int& R, int& C) { const int st = b / 1024, sb = b % 1024, swz = sb ^ (((sb >> 9) & 1) << 5); R = (st >> 1) * 16 + swz / 64; C = (st & 1) * 32 + (swz % 64) / 2; }
__device__ __forceinline__ int perm32(int rho) { const int n = rho >> 4, i = rho & 15; return 8 * (i >> 2) + 4 * n + (i & 3); }
struct Unit { int pm, pn; };
struct Gemm { const u16* A; const u16* Bt; int lda; int M, N, K; };
struct StaticOrder {
  int nM, nN, nwg, G, c;
  __device__ void init(int M, int N, int G_, int c_) { nM = M / BM; nN = N / BM; nwg = nM * nN; G = G_; c = c_; }
  __device__ bool next(int i, Unit& u) const {
    const long L = (long)i * G + c; if (L >= nwg) return false;
    int wgid = (int)L; { const int q = nwg / NXCD, r = nwg % NXCD, xcd = wgid % NXCD, off = wgid / NXCD; wgid = (xcd < r ? xcd * (q + 1) : r * (q + 1) + (xcd - r) * q) + off; }
    const int nig = WGM * nN, gid = wgid / nig, fm = gid * WGM, gsz = (nM - fm) < WGM ? (nM - fm) : WGM;
    u.pm = fm + ((wgid % nig) % gsz); u.pn = (wgid % nig) / gsz; return true;
  }
};
typedef __attribute__((ext_vector_type(2))) float cvt_f2_t;
typedef __attribute__((ext_vector_type(2))) __bf16 cvt_b2_t;
__device__ __forceinline__ unsigned cvt_pk_bf16(float lo, float hi) { cvt_f2_t f = {lo, hi}; cvt_b2_t r = __builtin_convertvector(f, cvt_b2_t); return __builtin_bit_cast(unsigned, r); }

template <class Epi>
__device__ __forceinline__ void gemm_phase(PG8_LAS unsigned char* lds, const Gemm g, const StaticOrder& S, const Epi& E, const int tid) {
  const int wid = __builtin_amdgcn_readfirstlane(tid >> 6), lane = tid & 63, wr = wid >> 2, wc = wid & 3, fr = lane & 15, fq = lane >> 4;
  const int K = g.K, nt = K / BK;
  unsigned voffA[2], voffB[2];
#pragma unroll
  for (int i = 0; i < 2; ++i) { int R, C; stage_rc(tid * 16 + i * 8192, R, C); const int Rb = Epi::PERM ? ((R & ~31) + perm32(R & 31)) : R;
    voffA[i] = (unsigned)(R * g.lda + C) * 2u; voffB[i] = (unsigned)(Rb * K + C) * 2u; }
  const size_t kstep = (size_t)(BK * 2);
  const size_t hstepA = (size_t)HALF * g.lda * 2, hstepB = (size_t)HALF * K * 2;
  const size_t tstepA = 2 * hstepA, tstepB = 2 * hstepB;
  const unsigned ldsw = (unsigned)wid * 1024u;
  const int aoff = lds_byte(wr * 64 + fr, fq * 8), boff = lds_byte(wc * 32 + fr, fq * 8);
#define PG8_SA(b, h) (((b) * 2 + (h)) * HTB)
#define PG8_SB(b, h) ((4 + (b) * 2 + (h)) * HTB)
#define PG8_STAGE(bufoff, gbase, voff) do { _Pragma("unroll") for (int _i = 0; _i < 2; ++_i) \
    __builtin_amdgcn_global_load_lds((const unsigned*)((const char*)(gbase) + (voff)[_i]), (PG8_LAS unsigned*)(lds + (bufoff) + ldsw + _i * 8192), 16, 0, 0); } while (0)
#define PG8_LDA(dst, b, h) do { _Pragma("unroll") for (int m = 0; m < 4; ++m) _Pragma("unroll") for (int k = 0; k < 2; ++k) dst[m][k] = *(const PG8_LAS bf16x8*)(lds + PG8_SA(b, h) + aoff + m * 2048 + k * 1024); } while (0)
#define PG8_LDB(dst, b, h) do { _Pragma("unroll") for (int n = 0; n < 2; ++n) _Pragma("unroll") for (int k = 0; k < 2; ++k) dst[n][k] = *(const PG8_LAS bf16x8*)(lds + PG8_SB(b, h) + boff + n * 2048 + k * 1024); } while (0)
#define PG8_MMA(ai, bj, At, Bt) do { __builtin_amdgcn_s_setprio(1); _Pragma("unroll") for (int m = 0; m < 4; ++m) _Pragma("unroll") for (int n = 0; n < 2; ++n) _Pragma("unroll") for (int k = 0; k < 2; ++k) \
    acc[ai][bj][m][n] = __builtin_amdgcn_mfma_f32_16x16x32_bf16(Bt[n][k], At[m][k], acc[ai][bj][m][n], 0, 0, 0); __builtin_amdgcn_s_setprio(0); } while (0)
#define PG8_WAIT_V(n) asm volatile("s_waitcnt vmcnt(" #n ")" ::: "memory")
#define PG8_WAIT_L(n) asm volatile("s_waitcnt lgkmcnt(" #n ")" ::: "memory")
#define PG8_BAR __builtin_amdgcn_s_barrier()
#define PG8_SCHED __builtin_amdgcn_sched_barrier(0)
  Unit cur, nxt; int ui = 0;
  if (!S.next(0, cur)) return;
  f32x4 acc[2][2][4][2];
#pragma unroll
  for (int a = 0; a < 2; ++a)
#pragma unroll
    for (int b = 0; b < 2; ++b)
#pragma unroll
      for (int m = 0; m < 4; ++m)
#pragma unroll
        for (int n = 0; n < 2; ++n) acc[a][b][m][n] = (f32x4){0.f, 0.f, 0.f, 0.f};
  bf16x8 At[4][2], B0[2][2], B1[2][2];
  const char* cA = (const char*)g.A + (size_t)cur.pm * tstepA; const char* cB = (const char*)g.Bt + (size_t)cur.pn * tstepB;
  PG8_STAGE(PG8_SB(0, 0), cB, voffB); PG8_STAGE(PG8_SA(0, 0), cA, voffA); PG8_STAGE(PG8_SB(0, 1), cB + hstepB, voffB); PG8_STAGE(PG8_SA(0, 1), cA + hstepA, voffA);
  if (wr == 1) PG8_BAR;
  PG8_WAIT_V(4); PG8_BAR;
  PG8_STAGE(PG8_SB(1, 0), cB + kstep, voffB); PG8_STAGE(PG8_SA(1, 0), cA + kstep, voffA); PG8_STAGE(PG8_SB(1, 1), cB + hstepB + kstep, voffB);
  PG8_WAIT_V(6); PG8_BAR;
  for (;;) {
    const bool has_next = S.next(ui + 1, nxt);
    const char* nA = has_next ? (const char*)g.A + (size_t)nxt.pm * tstepA : cA; const char* nB = has_next ? (const char*)g.Bt + (size_t)nxt.pn * tstepB : cB;
    for (int t = 0; t < nt; t += 2) {
      const bool last = (t == nt - 2);
      const char* a1 = cA + (size_t)(t + 1) * kstep;
      const char* a2 = last ? nA : cA + (size_t)(t + 2) * kstep; const char* b2 = last ? nB : cB + (size_t)(t + 2) * kstep;
      const char* a3 = a2 + kstep; const char* b3 = b2 + kstep;
      PG8_LDB(B0, 0, 0); PG8_SCHED; PG8_LDA(At, 0, 0); PG8_STAGE(PG8_SA(1, 1), a1 + hstepA, voffA);
      PG8_WAIT_L(8); PG8_BAR; PG8_WAIT_L(0); PG8_MMA(0, 0, At, B0); PG8_BAR; PG8_SCHED;
      PG8_LDB(B1, 0, 1); PG8_STAGE(PG8_SB(0, 0), b2, voffB);
      PG8_BAR; PG8_WAIT_L(0); PG8_MMA(0, 1, At, B1); PG8_BAR;
      PG8_LDA(At, 0, 1); PG8_STAGE(PG8_SA(0, 0), a2, voffA);
      PG8_BAR; PG8_WAIT_L(0); PG8_MMA(1, 0, At, B0); PG8_BAR; PG8_SCHED;
      PG8_STAGE(PG8_SB(0, 1), b2 + hstepB, voffB);
      PG8_WAIT_V(6); PG8_BAR; PG8_MMA(1, 1, At, B1); PG8_BAR;
      PG8_LDB(B0, 1, 0); PG8_SCHED; PG8_LDA(At, 1, 0); PG8_STAGE(PG8_SA(0, 1), a2 + hstepA, voffA);
      PG8_WAIT_L(8); PG8_BAR; PG8_WAIT_L(0); PG8_MMA(0, 0, At, B0); PG8_BAR; PG8_SCHED;
      PG8_LDB(B1, 1, 1); PG8_STAGE(PG8_SB(1, 0), b3, voffB);
      PG8_BAR; PG8_WAIT_L(0); PG8_MMA(0, 1, At, B1); PG8_BAR;
      PG8_LDA(At, 1, 1); PG8_STAGE(PG8_SA(1, 0), a3, voffA);
      PG8_BAR; PG8_WAIT_L(0); PG8_MMA(1, 0, At, B0); PG8_BAR; PG8_SCHED;
      PG8_STAGE(PG8_SB(1, 1), b3 + hstepB, voffB);
      PG8_WAIT_V(6); PG8_BAR; PG8_MMA(1, 1, At, B1); PG8_BAR;
    }
    E(acc, cur, wr, wc, fr, fq, lane);
    if (!has_next) break;
#pragma unroll
    for (int a = 0; a < 2; ++a)
#pragma unroll
      for (int b = 0; b < 2; ++b)
#pragma unroll
        for (int m = 0; m < 4; ++m)
#pragma unroll
          for (int n = 0; n < 2; ++n) acc[a][b][m][n] = (f32x4){0.f, 0.f, 0.f, 0.f};
    cur = nxt; cA = nA; cB = nB; ++ui;
  }
  PG8_WAIT_V(0);
  if (wr == 0) PG8_BAR;
  PG8_BAR;
#undef PG8_SA
#undef PG8_SB
#undef PG8_STAGE
#undef PG8_LDA
#undef PG8_LDB
#undef PG8_MMA
#undef PG8_WAIT_V
#undef PG8_WAIT_L
#undef PG8_BAR
#undef PG8_SCHED
}
}

#define OFF_STATS OFF_GLR

__device__ __forceinline__ u32x4 pack8v(const f32x4& a, const f32x4& b) {
  u32x4 w; w.x = pg8::cvt_pk_bf16(a[0], a[1]); w.y = pg8::cvt_pk_bf16(a[2], a[3]); w.z = pg8::cvt_pk_bf16(b[0], b[1]); w.w = pg8::cvt_pk_bf16(b[2], b[3]); return w;
}
__device__ __forceinline__ float xlane32(float v, int lane) { return __int_as_float(__builtin_amdgcn_ds_bpermute((lane ^ 32) << 2, __float_as_int(v))); }

struct EpiScanIn {
  static constexpr bool PERM = true;
  u16* S; const float* rot;
  __device__ __forceinline__ void operator()(const f32x4 (&acc)[2][2][4][2], const pg8::Unit& u, int wr, int wc, int fr, int fq, int lane) const {
    u16* Sb = S + (size_t)u.pm * 256 * 4096;
    unsigned rl0 = wr * 64 + fr; asm volatile("" : "+v"(rl0));
#pragma unroll
    for (int bj = 0; bj < 2; ++bj) {
      const int nt128 = u.pn * 2 + bj;
      const bool scaled = (nt128 < 4) || (nt128 >= 16 && nt128 < 20);
      const float scl = scaled ? 0.08838834764831845f : 1.f;
      const unsigned cb = nt128 * 128 + wc * 32 + fq * 8;
      if (nt128 < 8 && u.pm < 128) {
        const int tb = (u.pm & 15) * 256;
        const int fo = ((wc & 1) * 16 + (fq & 1) * 8) * 2;
        const float sgn = (fq >> 1) ? 1.f : -1.f;
#pragma unroll
        for (int ai = 0; ai < 2; ++ai)
#pragma unroll
          for (int m = 0; m < 4; ++m) {
            const unsigned rl = rl0 + ai * 128 + m * 16;
            const int t = tb + rl;
            const unsigned pos = (wc >> 1) == 0 ? (t >> 6) : (t & 63);
            const float* rp = rot + pos * 64u + fo;
            const float4 c0 = *(const float4*)rp, c1 = *(const float4*)(rp + 4), c2 = *(const float4*)(rp + 8), c3 = *(const float4*)(rp + 12);
            const f32x4 v0 = acc[ai][bj][m][0], v1 = acc[ai][bj][m][1];
            f32x4 p0, p1;
#pragma unroll
            for (int j = 0; j < 4; ++j) { p0[j] = xlane32(v0[j], lane); p1[j] = xlane32(v1[j], lane); }
            f32x4 o0, o1;
            o0[0] = (v0[0] * c0.x + sgn * p0[0] * c0.y) * scl; o0[1] = (v0[1] * c0.z + sgn * p0[1] * c0.w) * scl;
            o0[2] = (v0[2] * c1.x + sgn * p0[2] * c1.y) * scl; o0[3] = (v0[3] * c1.z + sgn * p0[3] * c1.w) * scl;
            o1[0] = (v1[0] * c2.x + sgn * p1[0] * c2.y) * scl; o1[1] = (v1[1] * c2.z + sgn * p1[1] * c2.w) * scl;
            o1[2] = (v1[2] * c3.x + sgn * p1[2] * c3.y) * scl; o1[3] = (v1[3] * c3.z + sgn * p1[3] * c3.w) * scl;
            *(u32x4*)(Sb + rl * 4096u + cb) = pack8v(o0, o1);
            __builtin_amdgcn_sched_barrier(0);
          }
      } else {
#pragma unroll
        for (int ai = 0; ai < 2; ++ai)
#pragma unroll
          for (int m = 0; m < 4; ++m) {
            const unsigned rl = rl0 + ai * 128 + m * 16;
            *(u32x4*)(Sb + rl * 4096u + cb) = pack8v(acc[ai][bj][m][0] * scl, acc[ai][bj][m][1] * scl);
            __builtin_amdgcn_sched_barrier(0);
          }
      }
    }
  }
};

struct EpiGate {
  static constexpr bool PERM = true;
  const u16* RG; const float* stats; u16* S; const float* rgain; const float* ggain;
  __device__ __forceinline__ void operator()(const f32x4 (&acc)[2][2][4][2], const pg8::Unit& u, int wr, int wc, int fr, int fq, int lane) const {
    u16* Sb = S + (size_t)u.pm * 256 * 4096;
    unsigned rl0 = wr * 64 + fr; asm volatile("" : "+v"(rl0));
    if (u.pn < 8) {
      const int branch = u.pn >> 2, head = u.pn & 3;
      const u16* RGb = RG + (size_t)u.pm * 256 * 2048 + branch * 1024;
      const float* stb = stats + (size_t)u.pm * 256 * 16 + (branch * 4 + head) * 2;
      const float* gain = branch ? ggain : rgain;
#pragma unroll
      for (int bj = 0; bj < 2; ++bj) {
        const unsigned cb = head * 256 + bj * 128 + wc * 32 + fq * 8;
        const float4 g0 = *(const float4*)(gain + cb), g1 = *(const float4*)(gain + cb + 4);
#pragma unroll
        for (int ai = 0; ai < 2; ++ai)
#pragma unroll
          for (int m = 0; m < 4; ++m) {
            const unsigned rl = rl0 + ai * 128 + m * 16;
            const float2 st = *(const float2*)(stb + rl * 16u);
            const bf16x8 xr = *(const bf16x8*)(RGb + rl * 2048u + cb);
            f32x4 v0 = acc[ai][bj][m][0], v1 = acc[ai][bj][m][1];
            asm volatile("" : "+v"(v0), "+v"(v1));
            f32x4 o0, o1;
            o0[0] = (bf2f((u16)xr[0]) * st.x + st.y) * g0.x * siluf_(v0[0]); o0[1] = (bf2f((u16)xr[1]) * st.x + st.y) * g0.y * siluf_(v0[1]);
            o0[2] = (bf2f((u16)xr[2]) * st.x + st.y) * g0.z * siluf_(v0[2]); o0[3] = (bf2f((u16)xr[3]) * st.x + st.y) * g0.w * siluf_(v0[3]);
            o1[0] = (bf2f((u16)xr[4]) * st.x + st.y) * g1.x * siluf_(v1[0]); o1[1] = (bf2f((u16)xr[5]) * st.x + st.y) * g1.y * siluf_(v1[1]);
            o1[2] = (bf2f((u16)xr[6]) * st.x + st.y) * g1.z * siluf_(v1[2]); o1[3] = (bf2f((u16)xr[7]) * st.x + st.y) * g1.w * siluf_(v1[3]);
            *(u32x4*)(Sb + rl * 4096u + 2048u + branch * 1024 + cb) = pack8v(o0, o1);
            __builtin_amdgcn_sched_barrier(0);
          }
      }
    } else {
#pragma unroll
      for (int bj = 0; bj < 2; ++bj) {
        const unsigned cb = (u.pn - 8) * 256 + bj * 128 + wc * 32 + fq * 8;
#pragma unroll
        for (int ai = 0; ai < 2; ++ai)
#pragma unroll
          for (int m = 0; m < 4; ++m) {
            const unsigned rl = rl0 + ai * 128 + m * 16;
            f32x4 v0 = acc[ai][bj][m][0], v1 = acc[ai][bj][m][1];
            asm volatile("" : "+v"(v0), "+v"(v1));
            f32x4 o0, o1;
#pragma unroll
            for (int j = 0; j < 4; ++j) { o0[j] = sigmoidf_(v0[j]); o1[j] = sigmoidf_(v1[j]); }
            *(u32x4*)(Sb + rl * 4096u + cb) = pack8v(o0, o1);
            __builtin_amdgcn_sched_barrier(0);
          }
      }
    }
  }
};

struct EpiMerge {
  static constexpr bool PERM = true;
  const u16* S; u16* MG; int pass;
  __device__ __forceinline__ void operator()(const f32x4 (&acc)[2][2][4][2], const pg8::Unit& u, int wr, int wc, int fr, int fq, int lane) const {
    const u16* Sb = S + (size_t)u.pm * 256 * 4096 + pass * 1024;
    u16* MGb = MG + (size_t)u.pm * 256 * 1024;
    unsigned rl0 = wr * 64 + fr; asm volatile("" : "+v"(rl0));
#pragma unroll
    for (int bj = 0; bj < 2; ++bj) {
      const unsigned cb = u.pn * 256 + bj * 128 + wc * 32 + fq * 8;
#pragma unroll
      for (int ai = 0; ai < 2; ++ai)
#pragma unroll
        for (int m = 0; m < 4; ++m) {
          const unsigned rl = rl0 + ai * 128 + m * 16;
          const bf16x8 gt = *(const bf16x8*)(Sb + rl * 4096u + cb);
          f32x4 o0 = acc[ai][bj][m][0], o1 = acc[ai][bj][m][1];
#pragma unroll
          for (int j = 0; j < 4; ++j) { o0[j] *= bf2f((u16)gt[j]); o1[j] *= bf2f((u16)gt[4 + j]); }
          if (pass) {
            const bf16x8 old = *(const bf16x8*)(MGb + rl * 1024u + cb);
#pragma unroll
            for (int j = 0; j < 4; ++j) { o0[j] += bf2f((u16)old[j]); o1[j] += bf2f((u16)old[4 + j]); }
          }
          *(u32x4*)(MGb + rl * 1024u + cb) = pack8v(o0, o1);
            __builtin_amdgcn_sched_barrier(0);
        }
    }
  }
};

struct EpiOut {
  static constexpr bool PERM = false;
  const float* x_lat; const float* x_ctx; float* o_lat; float* o_ctx; const float* mod;
  __device__ __forceinline__ void operator()(const f32x4 (&acc)[2][2][4][2], const pg8::Unit& u, int wr, int wc, int fr, int fq, int lane) const {
    const float* hin; float* hout; int rmod;
    if (u.pm < 128) { hin = x_lat + (size_t)u.pm * 256 * DM; hout = o_lat + (size_t)u.pm * 256 * DM; rmod = u.pm >> 4; }
    else { hin = x_ctx + (size_t)(u.pm - 128) * 256 * DM; hout = o_ctx + (size_t)(u.pm - 128) * 256 * DM; rmod = 8; }
    const float* gate = mod + rmod * 3072 + 2048;
    unsigned rl0 = wr * 64 + fr; asm volatile("" : "+v"(rl0));
#pragma unroll
    for (int bj = 0; bj < 2; ++bj)
#pragma unroll
      for (int n = 0; n < 2; ++n) {
        const unsigned cb = u.pn * 256 + bj * 128 + wc * 32 + n * 16 + fq * 4;
        const float4 g = *(const float4*)(gate + cb);
#pragma unroll
        for (int ai = 0; ai < 2; ++ai)
#pragma unroll
          for (int m = 0; m < 4; ++m) {
            const unsigned o = (rl0 + ai * 128 + m * 16) * 1024u + cb;
            const float4 h = *(const float4*)(hin + o);
            const f32x4 v = acc[ai][bj][m][n];
            *(float4*)(hout + o) = make_float4(h.x + g.x * v[0], h.y + g.y * v[1], h.z + g.z * v[2], h.w + g.w * v[3]);
          }
      }
  }
};

__device__ __forceinline__ void phase_stats(const Params& p, int l) {
  const int tid = opaque_tid(); const int wave = tid >> 6, lane = tid & 63;
  const u16* RG = (const u16*)(p.ws + OFF_RG);
  float* ST = (float*)(p.ws + OFF_STATS);
  const int nrows = (l == 0) ? MTOT : MLAT;
  for (int row = (blockIdx.x * 8 + wave) * 4; row < nrows; row += gridDim.x * 32) {
    bf16x8 v[4][4];
#pragma unroll
    for (int q = 0; q < 4; ++q)
#pragma unroll
      for (int i = 0; i < 4; ++i) v[q][i] = *(const bf16x8*)(RG + (size_t)(row + q) * 2048 + i * 512 + lane * 8);
#pragma unroll
    for (int q = 0; q < 4; ++q)
#pragma unroll
      for (int i = 0; i < 4; ++i) {
        float s1 = 0.f, s2 = 0.f;
#pragma unroll
        for (int x = 0; x < 8; ++x) { float a = bf2f((u16)v[q][i][x]); s1 += a; s2 += a * a; }
#pragma unroll
        for (int o = 16; o > 0; o >>= 1) {
          s1 += __int_as_float(__builtin_amdgcn_ds_bpermute((lane ^ o) << 2, __float_as_int(s1)));
          s2 += __int_as_float(__builtin_amdgcn_ds_bpermute((lane ^ o) << 2, __float_as_int(s2)));
        }
        float sa, sb;
        if ((i >> 1) == 0) { float mu = s1 * (1.f / 256.f); float var = fmaxf(s2 * (1.f / 256.f) - mu * mu, 0.f); sa = rsqrtf(var + 1e-6f); sb = -mu * sa; }
        else { sa = rsqrtf(s2 * (1.f / 256.f) + 1e-6f); sb = 0.f; }
        if ((lane & 31) == 0) *(float2*)(ST + ((size_t)(row + q) * 8 + (i >> 1) * 4 + 2 * (i & 1) + (lane >> 5)) * 2) = make_float2(sa, sb);
      }
  }
}

#define OFF_VECS OFF_WT
__device__ __forceinline__ float logsig16(float x) { return (fminf(x, 0.f) - __logf(1.f + __expf(-fabsf(x)))) * (1.f / 16.f); }

typedef __attribute__((ext_vector_type(2))) float f32x2_t;

template <int SW>
__device__ __forceinline__ void prepass_sweep(const float* GLRS, const f32x2_t (&w2)[16], f32x2_t b2, u16* Sq, u16* Ub, float& accF, float& accB) {
  accF = 0.f; accB = 0.f;
#pragma unroll 16
  for (int u = 0; u < 32; ++u) {
    const int i = SW ? 32 + u : 31 - u;
    const float4* gr = (const float4*)(GLRS + i * 16);
    const float4 g0 = gr[0], g1 = gr[1], g2 = gr[2], g3 = gr[3];
    f32x2_t x = b2;
    x = w2[0] * g0.x + x;  x = w2[1] * g0.y + x;  x = w2[2] * g0.z + x;  x = w2[3] * g0.w + x;
    x = w2[4] * g1.x + x;  x = w2[5] * g1.y + x;  x = w2[6] * g1.z + x;  x = w2[7] * g1.w + x;
    x = w2[8] * g2.x + x;  x = w2[9] * g2.y + x;  x = w2[10] * g2.z + x; x = w2[11] * g2.w + x;
    x = w2[12] * g3.x + x; x = w2[13] * g3.y + x; x = w2[14] * g3.z + x; x = w2[15] * g3.w + x;
    const float laf = logsig16(x.x), lab = logsig16(x.y);
    float relf, relb;
    if (SW == 0) { relf = -accF; accF += laf; accB += lab; relb = accB; }
    else         { accF += laf; relf = accF; relb = -accB; accB += lab; }
    const float q = bf2f(Sq[(unsigned)i * 4096u]), k = bf2f(Sq[(unsigned)i * 4096u + 512u]);
    Sq[(unsigned)i * 4096u] = f2bf(q * __expf(relf));
    Sq[(unsigned)i * 4096u + 512u] = f2bf(k * __expf(-relf));
    Ub[(unsigned)i * 1024u] = f2bf(q * __expf(relb));
    Ub[(unsigned)i * 1024u + 512u] = f2bf(k * __expf(-relb));
  }
}

__device__ __forceinline__ void gla_prepass_unit(const Params& p, int l, int unit, char* smem) {
  const int tid = opaque_tid();
  const int sw = unit & 1, ch = unit >> 1;
  const int b = ch / 68, cid = ch % 68;
  const int base = cid < 4 ? (MLAT + b * 256 + cid * 64) : (b * 4096 + (cid - 4) * 64);
  float* GLRS = (float*)smem;
  __syncthreads();
  {
    const int wid = tid >> 6, lane = tid & 63, fr = lane & 15, fq = lane >> 4;
    if (wid < 2) {
      const int r0 = sw * 32 + wid * 16;
      f32x4 g = (f32x4){0.f, 0.f, 0.f, 0.f};
      const u16* Ua = (const u16*)(p.ws + OFF_U) + (size_t)(base + r0 + fr) * 1024 + fq * 8;
      const u16* Wb = (const u16*)(p.ws + OFF_WT) + (size_t)(4096 + fr) * 1024 + fq * 8;
#pragma unroll 16
      for (int k = 0; k < 1024; k += 32) {
        bf16x8 a = *(const bf16x8*)(Ua + k);
        bf16x8 w = *(const bf16x8*)(Wb + k);
        g = __builtin_amdgcn_mfma_f32_16x16x32_bf16(a, w, g, 0, 0, 0);
      }
#pragma unroll
      for (int j = 0; j < 4; ++j) GLRS[(r0 + fq * 4 + j) * 16 + fr] = g[j];
    }
  }
  f32x2_t w2[16];
  {
    const float* w0 = p.gla_w_up + (size_t)(l * 2 + 0) * 16 * 512 + tid;
    const float* w1 = p.gla_w_up + (size_t)(l * 2 + 1) * 16 * 512 + tid;
#pragma unroll
    for (int r = 0; r < 16; ++r) { w2[r].x = w0[r * 512]; w2[r].y = w1[r * 512]; }
  }
  f32x2_t b2; b2.x = p.gla_b_up[(l * 2 + 0) * 512 + tid]; b2.y = p.gla_b_up[(l * 2 + 1) * 512 + tid];
  __syncthreads();
  u16* Sq = (u16*)(p.ws + OFF_S) + (size_t)base * 4096 + 2048 + tid;
  u16* Ub = (u16*)(p.ws + OFF_U) + (size_t)base * 1024 + tid;
  float* V0 = (float*)(p.ws + OFF_VECS) + ((size_t)(0 * 544 + b * 68 + cid) * 2) * 512 + tid;
  float* V1 = (float*)(p.ws + OFF_VECS) + ((size_t)(1 * 544 + b * 68 + cid) * 2) * 512 + tid;
  float accF, accB;
  if (sw == 0) {
    prepass_sweep<0>(GLRS, w2, b2, Sq, Ub, accF, accB);
    V0[0] = __expf(accF);
    V1[512] = __expf(accB);
  } else {
    prepass_sweep<1>(GLRS, w2, b2, Sq, Ub, accF, accB);
    V0[512] = __expf(accF);
    V1[0] = __expf(accB);
  }
}

#define L_QR   0
#define L_KR   17408
#define L_V    34816
#define L_SGT  44032
#define L_P    61440
#undef  SCAN_GB
#define SCAN_GB 70656

__device__ __forceinline__ int off128(int row, int col) { return row * 272 + col * 2; }
__device__ __forceinline__ int off64(int row, int col) { return row * 144 + col * 2; }

template <int RS>
__device__ __forceinline__ bf16x8 tr_frag(unsigned img_addr, int r0, int c0, int lane) {
  const int g = lane >> 4, q = (lane & 15) >> 2, pp = lane & 3;
  unsigned a = img_addr + (unsigned)((r0 + 8 * g + q) * RS + (c0 + 4 * pp) * 2);
  bf16x4 lo, hi;
  asm volatile("ds_read_b64_tr_b16 %0, %2\n\tds_read_b64_tr_b16 %1, %2 offset:%3\n\ts_waitcnt lgkmcnt(0)"
               : "=&v"(lo), "=&v"(hi) : "v"(a), "n"(4 * RS) : "memory");
  bf16x8 r;
  r[0] = lo[0]; r[1] = lo[1]; r[2] = lo[2]; r[3] = lo[3]; r[4] = hi[0]; r[5] = hi[1]; r[6] = hi[2]; r[7] = hi[3];
  return r;
}

__device__ __forceinline__ bf16x8 scale8(bf16x8 v, float f) {
  bf16x8 o;
#pragma unroll
  for (int x = 0; x < 8; ++x) o[x] = (short)f2bf(bf2f((u16)v[x]) * f);
  return o;
}

__device__ __forceinline__ void lds_barrier() { asm volatile("s_waitcnt lgkmcnt(0)" ::: "memory"); __builtin_amdgcn_s_barrier(); asm volatile("" ::: "memory"); }

template <int branch>
__device__ __forceinline__ void scan_item(const Params& p, int l, int item, char* smem) {
  const int b = (item >> 4) & 7, h = (item >> 2) & 3, slice = item & 3;
  const int tid = opaque_tid(), wid = __builtin_amdgcn_readfirstlane(tid >> 6), lane = tid & 63;
  const int dir = wid >> 2, gw = wid & 3, gt = tid & 255;
  const int fr = lane & 15, fq = lane >> 4;
  char* G = smem + dir * SCAN_GB;
  const unsigned Ga = (unsigned)(size_t)G;
  const u16* S = (const u16*)(p.ws + OFF_S);
  u16* RG = (u16*)(p.ws + OFF_RG);
  const u16* qsrc; unsigned qstride;
  if (branch == 0) { qsrc = S + h * 128; qstride = 4096; }
  else if (dir == 0) { qsrc = S + 2048 + h * 128; qstride = 4096; }
  else { qsrc = (const u16*)(p.ws + OFF_U) + h * 128; qstride = 1024; }
  const int voff = branch * 2048 + 1024 + h * 256 + slice * 64;
  const int ooff = branch * 1024 + h * 256 + slice * 64;
  float lg = 0.f, egc = 1.f;
  if (branch == 0) { lg = __logf(1.f - __expf(p.ret_decay[(l * 2 + dir) * 4 + h])); egc = __expf(32.f * lg); }
  const float* VECS = (const float*)(p.ws + OFF_VECS) + ((size_t)(dir * 544 + b * 68) * 2) * 512 + h * 128;
  f32x4 st[2][4];
#pragma unroll
  for (int m = 0; m < 2; ++m)
#pragma unroll
    for (int n = 0; n < 4; ++n) st[m][n] = (f32x4){0.f, 0.f, 0.f, 0.f};

  const int qj = gt >> 4, qc = gt & 15;
  const int vj = gt >> 3, vc = gt & 7;
  bf16x8 pq[4], pk[4], pv[2];
  float4 peg[2], pel[2];
  auto prefetch = [&](int s) {
    int base, cid;
    if (s < 4) { int cc = dir ? 3 - s : s; base = MLAT + b * 256 + cc * 64; cid = cc; }
    else { int c = s - 4; int cc = dir ? 63 - c : c; base = b * 4096 + cc * 64; cid = 4 + cc; }
#pragma unroll
    for (int i = 0; i < 4; ++i) {
      int jp = qj + 16 * i;
      unsigned ro = (unsigned)(base + (dir ? 63 - jp : jp)) * qstride + qc * 8;
      pq[i] = *(const bf16x8*)(qsrc + ro);
      pk[i] = *(const bf16x8*)(qsrc + ro + 512);
    }
#pragma unroll
    for (int i = 0; i < 2; ++i) {
      int jp = vj + 32 * i;
      pv[i] = *(const bf16x8*)(S + (size_t)(base + (dir ? 63 - jp : jp)) * 4096 + voff + vc * 8);
    }
    if (branch == 1) {
#pragma unroll
      for (int m = 0; m < 2; ++m) {
        int d0 = gw * 32 + m * 16 + fq * 4;
        peg[m] = *(const float4*)(VECS + (size_t)cid * 1024 + d0);
        pel[m] = *(const float4*)(VECS + (size_t)cid * 1024 + 512 + d0);
      }
    }
  };
  prefetch(0);
  __syncthreads();

  for (int s = 0; s < 68; ++s) {
    int base; bool first; bool wout;
    if (s < 4) { int cc = dir ? 3 - s : s; base = MLAT + b * 256 + cc * 64; first = s < 2; wout = (l == 0); }
    else { int c = s - 4; int cc = dir ? 63 - c : c; base = b * 4096 + cc * 64; first = c < 32; wout = true; }
    float4 eg[2], el[2];
#pragma unroll
    for (int m = 0; m < 2; ++m) {
      if (branch == 1) { eg[m] = peg[m]; el[m] = pel[m]; }
      else { eg[m] = make_float4(egc, egc, egc, egc); el[m] = eg[m]; }
    }
#pragma unroll
    for (int i = 0; i < 4; ++i) {
      int jp = qj + 16 * i;
      bf16x8 qv = pq[i], kv_ = pk[i];
      if (branch == 0) {
        float fqs = __expf((float)(jp - 31) * lg), fks = __expf((float)(31 - jp) * lg);
        qv = scale8(qv, fqs); kv_ = scale8(kv_, fks);
      }
      *(bf16x8*)(G + L_QR + off128(jp, qc * 8)) = qv;
      *(bf16x8*)(G + L_KR + off128(jp, qc * 8)) = kv_;
    }
#pragma unroll
    for (int i = 0; i < 2; ++i) *(bf16x8*)(G + L_V + off64(vj + 32 * i, vc * 8)) = pv[i];
#pragma unroll
    for (int m = 0; m < 2; ++m) {
      int d0 = gw * 32 + m * 16 + fq * 4;
#pragma unroll
      for (int n = 0; n < 4; ++n) {
        int e = n * 16 + fr;
        bf16x4 o4;
        o4[0] = (short)f2bf(st[m][n][0] * eg[m].x); o4[1] = (short)f2bf(st[m][n][1] * eg[m].y);
        o4[2] = (short)f2bf(st[m][n][2] * eg[m].z); o4[3] = (short)f2bf(st[m][n][3] * eg[m].w);
        *(bf16x4*)(G + L_SGT + off128(e, d0)) = o4;
      }
    }
    u16 oldv[4][4];
    u16* dstb = RG + (size_t)base * 2048 + ooff + fr;
    if (wout && !first) {
#pragma unroll
      for (int r = 0; r < 4; ++r) {
        int ip = gw * 16 + fq * 4 + r;
        unsigned ro = (unsigned)(dir ? 63 - ip : ip) * 2048u;
#pragma unroll
        for (int n = 0; n < 4; ++n) oldv[r][n] = dstb[ro + n * 16];
      }
    }
    if (s + 1 < 68) prefetch(s + 1);
    lds_barrier();
    f32x4 pt[4], o[4];
#pragma unroll
    for (int n = 0; n < 4; ++n) { pt[n] = (f32x4){0.f, 0.f, 0.f, 0.f}; o[n] = (f32x4){0.f, 0.f, 0.f, 0.f}; }
#pragma unroll
    for (int ks = 0; ks < 4; ++ks) {
      int kc = ks * 32 + fq * 8;
      bf16x8 ka = *(const bf16x8*)(G + L_KR + off128(gw * 16 + fr, kc));
      bf16x8 qa = *(const bf16x8*)(G + L_QR + off128(gw * 16 + fr, kc));
#pragma unroll
      for (int n = 0; n < 4; ++n) {
        bf16x8 qb = *(const bf16x8*)(G + L_QR + off128(n * 16 + fr, kc));
        bf16x8 sb = *(const bf16x8*)(G + L_SGT + off128(n * 16 + fr, kc));
        pt[n] = __builtin_amdgcn_mfma_f32_16x16x32_bf16(ka, qb, pt[n], 0, 0, 0);
        o[n] = __builtin_amdgcn_mfma_f32_16x16x32_bf16(qa, sb, o[n], 0, 0, 0);
      }
    }
#pragma unroll
    for (int n = 0; n < 4; ++n) {
      int ip = n * 16 + fr;
      int j0 = gw * 16 + fq * 4;
      bf16x4 w;
#pragma unroll
      for (int r = 0; r < 4; ++r) {
        int jp = j0 + r;
        bool keep = dir ? (ip > jp) : (ip >= jp);
        w[r] = (short)f2bf(keep ? pt[n][r] : 0.f);
      }
      *(bf16x4*)(G + L_P + off64(ip, j0)) = w;
    }
    lds_barrier();
    {
      const int tg = lane >> 4, tq = (lane & 15) >> 2, tp = lane & 3;
      const unsigned ka0 = Ga + L_KR + (unsigned)((8 * tg + tq) * 272 + (gw * 32 + 4 * tp) * 2);
      const unsigned va0 = Ga + L_V + (unsigned)((8 * tg + tq) * 144 + (4 * tp) * 2);
#pragma unroll
      for (int m = 0; m < 2; ++m) {
        f32x4 kv[4];
#pragma unroll
        for (int n = 0; n < 4; ++n) kv[n] = (f32x4){0.f, 0.f, 0.f, 0.f};
#pragma unroll
        for (int ks = 0; ks < 2; ++ks) {
          int kc = ks * 32 + fq * 8;
          bf16x4 r0, r1, r2, r3, r4, r5, r6, r7, r8, r9;
          asm volatile(
              "ds_read_b64_tr_b16 %0, %10\n\tds_read_b64_tr_b16 %1, %10 offset:1088\n\t"
              "ds_read_b64_tr_b16 %2, %11\n\tds_read_b64_tr_b16 %3, %11 offset:576\n\t"
              "ds_read_b64_tr_b16 %4, %11 offset:32\n\tds_read_b64_tr_b16 %5, %11 offset:608\n\t"
              "ds_read_b64_tr_b16 %6, %11 offset:64\n\tds_read_b64_tr_b16 %7, %11 offset:640\n\t"
              "ds_read_b64_tr_b16 %8, %11 offset:96\n\tds_read_b64_tr_b16 %9, %11 offset:672\n\t"
              "s_waitcnt lgkmcnt(0)"
              : "=&v"(r0), "=&v"(r1), "=&v"(r2), "=&v"(r3), "=&v"(r4), "=&v"(r5), "=&v"(r6), "=&v"(r7), "=&v"(r8), "=&v"(r9)
              : "v"(ka0 + (unsigned)(ks * 32 * 272 + m * 32)), "v"(va0 + (unsigned)(ks * 32 * 144))
              : "memory");
          bf16x8 km = __builtin_shufflevector(r0, r1, 0, 1, 2, 3, 4, 5, 6, 7);
          bf16x8 vb[4];
          vb[0] = __builtin_shufflevector(r2, r3, 0, 1, 2, 3, 4, 5, 6, 7);
          vb[1] = __builtin_shufflevector(r4, r5, 0, 1, 2, 3, 4, 5, 6, 7);
          vb[2] = __builtin_shufflevector(r6, r7, 0, 1, 2, 3, 4, 5, 6, 7);
          vb[3] = __builtin_shufflevector(r8, r9, 0, 1, 2, 3, 4, 5, 6, 7);
          bf16x8 pa;
          if (m == 0) pa = *(const bf16x8*)(G + L_P + off64(gw * 16 + fr, kc));
#pragma unroll
          for (int n = 0; n < 4; ++n) {
            if (m == 0) o[n] = __builtin_amdgcn_mfma_f32_16x16x32_bf16(pa, vb[n], o[n], 0, 0, 0);
            kv[n] = __builtin_amdgcn_mfma_f32_16x16x32_bf16(km, vb[n], kv[n], 0, 0, 0);
          }
        }
#pragma unroll
        for (int n = 0; n < 4; ++n) {
          st[m][n][0] = eg[m].x * el[m].x * st[m][n][0] + el[m].x * kv[n][0];
          st[m][n][1] = eg[m].y * el[m].y * st[m][n][1] + el[m].y * kv[n][1];
          st[m][n][2] = eg[m].z * el[m].z * st[m][n][2] + el[m].z * kv[n][2];
          st[m][n][3] = eg[m].w * el[m].w * st[m][n][3] + el[m].w * kv[n][3];
        }
      }
    }
    if (wout) {
#pragma unroll
      for (int r = 0; r < 4; ++r) {
        int ip = gw * 16 + fq * 4 + r;
        unsigned ro = (unsigned)(dir ? 63 - ip : ip) * 2048u;
#pragma unroll
        for (int n = 0; n < 4; ++n) {
          float v = o[n][r];
          if (!first) v += bf2f(oldv[r][n]);
          dstb[ro + n * 16] = f2bf(v);
        }
      }
    }
    __syncthreads();
  }
}

#define NPHASE 18
__device__ __forceinline__ void run_phase(const Params& p, int ph, char* smem) {
  const int nblk = gridDim.x, bid = blockIdx.x;
  if (ph == 0) {
#ifdef REP_P0
    for (int rep = 0; rep < REP_P0; ++rep)
#endif
    for (int u = bid; u < WT_UNITS + 96 + 1; u += nblk) {
      if (u < 96) mod_unit(p, u, smem);
      else if (u == 96) rot_unit(p);
      else wt_unit(p, 0, u - 97, smem);
    }
    return;
  }
  if (ph == NPHASE - 1) { phase_final(p); return; }
  const int l = (ph - 1) / 8, sp = (ph - 1) % 8;
  PG8_LAS unsigned char* lds = (PG8_LAS unsigned char*)smem;
  switch (sp) {
    case 0:
      phase_u(p, l);
      if (l == 1) for (int u = bid; u < WT_UNITS; u += nblk) wt_unit(p, 1, u, smem);
      break;
    case 1: {
      pg8::Gemm g{(const u16*)(p.ws + OFF_U), (const u16*)(p.ws + OFF_WT) + (size_t)WT_SCAN * 1024, 1024, MTOT, 4096, 1024};
      pg8::StaticOrder S; S.init(g.M, g.N, nblk, bid);
      EpiScanIn E{(u16*)(p.ws + OFF_S), (const float*)(p.ws + OFF_ROT)};
      pg8::gemm_phase(lds, g, S, E, opaque_tid());
    } break;
    case 2: for (int t = bid; t < 1088; t += nblk) gla_prepass_unit(p, l, t, smem); break;
    case 3:
#ifdef REP_SCAN
      for (int rep = 0; rep < REP_SCAN; ++rep)
#endif
      for (int t = bid; t < 256; t += nblk) { if (t < 128) scan_item<0>(p, l, t, smem); else scan_item<1>(p, l, t, smem); } break;
    case 4:
      phase_u(p, l);
      phase_stats(p, l);
      break;
    case 5: {
      pg8::Gemm g{(const u16*)(p.ws + OFF_U), (const u16*)(p.ws + OFF_WT) + (size_t)WT_GATE * 1024, 1024, l == 0 ? MTOT : MLAT, 4096, 1024};
      pg8::StaticOrder S; S.init(g.M, g.N, nblk, bid);
      EpiGate E{(const u16*)(p.ws + OFF_RG), (const float*)(p.ws + OFF_STATS), (u16*)(p.ws + OFF_S), p.ret_norm_gain + l * 1024, p.gla_norm_gain + l * 1024};
      pg8::gemm_phase(lds, g, S, E, opaque_tid());
    } break;
    case 6: {
#pragma unroll 1
      for (int pass = 0; pass < 2; ++pass) {
        pg8::Gemm g{(const u16*)(p.ws + OFF_S) + 2048 + pass * 1024, (const u16*)(p.ws + OFF_WT) + (size_t)(WT_BRR + pass * 1024) * 1024, 4096, l == 0 ? MTOT : MLAT, 1024, 1024};
        pg8::StaticOrder S; S.init(g.M, g.N, nblk, bid);
        EpiMerge E{(const u16*)(p.ws + OFF_S), (u16*)(p.ws + OFF_U), pass};
        pg8::gemm_phase(lds, g, S, E, opaque_tid());
      }
    } break;
    case 7: {
      pg8::Gemm g{(const u16*)(p.ws + OFF_U), (const u16*)(p.ws + OFF_WT) + (size_t)WT_OUT * 1024, 1024, l == 0 ? MTOT : MLAT, 1024, 1024};
      pg8::StaticOrder S; S.init(g.M, g.N, nblk, bid);
      EpiOut E{l == 0 ? p.x : p.out, p.ctx, p.out, (float*)(p.ws + OFF_HCTX), (const float*)(p.ws + OFF_MOD) + (size_t)l * 9 * 3072};
      pg8::gemm_phase(lds, g, S, E, opaque_tid());
    } break;
  }
}

__device__ __forceinline__ void grid_barrier(unsigned* cnt, unsigned target) {
  asm volatile("s_waitcnt vmcnt(0)" ::: "memory");
  __syncthreads();
  if (threadIdx.x == 0) {
    __threadfence();
    __hip_atomic_fetch_add(cnt, 1u, __ATOMIC_RELAXED, __HIP_MEMORY_SCOPE_AGENT);
    while (__hip_atomic_load(cnt, __ATOMIC_RELAXED, __HIP_MEMORY_SCOPE_AGENT) < target) __builtin_amdgcn_s_sleep(2);
    __threadfence();
  }
  __syncthreads();
}

__global__ void __launch_bounds__(NTHREADS) mega(Params p, int ph_lo, int ph_hi, int coop) {
  extern __shared__ __attribute__((aligned(16))) char smem[];
  for (int ph = ph_lo; ph < ph_hi; ++ph) {
    run_phase(p, ph, smem);
    if (coop && ph + 1 < ph_hi) {
      if (ph == ph_lo) cg::this_grid().sync();
      else grid_barrier((unsigned*)(p.ws + OFF_BAR), (unsigned)(ph - ph_lo) * gridDim.x);
    }
  }
}

extern "C" void kernel_launch(void* const* d_in, const int* in_sizes, int n_in,
                              void* d_out, int out_size, void* d_ws, size_t ws_size,
                              hipStream_t stream) {
  Params p{};
  p.x = (const float*)d_in[0]; p.c = (const float*)d_in[1]; p.ctx = (const float*)d_in[2]; p.c_ctx = (const float*)d_in[3];
  p.norm_gain = (const float*)d_in[4]; p.w_ada = (const float*)d_in[5]; p.b_ada = (const float*)d_in[6]; p.w_in = (const float*)d_in[7];
  p.ret_decay = (const float*)d_in[8]; p.gla_w_up = (const float*)d_in[9]; p.gla_b_up = (const float*)d_in[10];
  p.ret_norm_gain = (const float*)d_in[11]; p.gla_norm_gain = (const float*)d_in[12];
  p.w_br_ret = (const float*)d_in[13]; p.w_br_gla = (const float*)d_in[14]; p.w_out = (const float*)d_in[15]; p.final_gain = (const float*)d_in[16];
  p.out = (float*)d_out; p.ws = (char*)d_ws;
  static int grid_blocks = 0;
  if (!grid_blocks) {
    hipFuncSetAttribute((const void*)mega, hipFuncAttributeMaxDynamicSharedMemorySize, LDS_BYTES);
    int dev = 0, cus = 0, per_cu = 0;
    hipGetDevice(&dev);
    hipDeviceGetAttribute(&cus, hipDeviceAttributeMultiprocessorCount, dev);
    hipOccupancyMaxActiveBlocksPerMultiprocessor(&per_cu, mega, NTHREADS, LDS_BYTES);
    if (per_cu < 1) per_cu = 1;
    grid_blocks = cus * 1;
  }
#ifdef MULTI_LAUNCH
  for (int ph = 0; ph < NPHASE; ++ph) {
    mega<<<dim3(grid_blocks), dim3(NTHREADS), LDS_BYTES, stream>>>(p, ph, ph + 1, 0);
  }
#else
  hipMemsetAsync((char*)d_ws + OFF_BAR, 0, 256, stream);
  int lo = 0, hi = NPHASE, coop = 1;
  void* args[] = {&p, &lo, &hi, &coop};
  hipError_t e = hipLaunchCooperativeKernel((void*)mega, dim3(grid_blocks), dim3(NTHREADS), args, LDS_BYTES, stream);
  if (e != hipSuccess) fprintf(stderr, "cooperative launch failed: %s (grid %d)\n", hipGetErrorString(e), grid_blocks);
#endif
}
```

```cpp
#include <hip/hip_runtime.h>
#include <hip/hip_cooperative_groups.h>
#include <cstdio>
namespace cg = cooperative_groups;

typedef unsigned short u16;
using bf16x8 = __attribute__((ext_vector_type(8))) short;
using bf16x4 = __attribute__((ext_vector_type(4))) short;
using f32x4  = __attribute__((ext_vector_type(4))) float;

#define NTHREADS 512
#define DM 1024
#define NB 8
#define SEQL 4096
#define CTXL 256
#define MLAT 32768
#define MCTX 2048
#define MTOT 34816
#define INW 8208

#define OFF_S    0ull
#define OFF_RG   (OFF_S   + (size_t)MTOT * 4096 * 2)
#define OFF_U    (OFF_RG  + (size_t)MTOT * 2048 * 2)
#define OFF_WT   (OFF_U   + (size_t)MTOT * 1024 * 2)
#define WT_ROWS  11392
#define OFF_GLR  (OFF_WT  + (size_t)WT_ROWS * 1024 * 2)
#define OFF_HCTX (OFF_GLR + (size_t)MTOT * 16 * 4)
#define OFF_MOD  (OFF_HCTX+ (size_t)MCTX * 1024 * 4)
#define OFF_ROT  (OFF_MOD + (size_t)2 * 9 * 3072 * 4)
#define OFF_BAR  (OFF_ROT + (size_t)64 * 32 * 2 * 4)
#define OFF_END  (OFF_BAR + 256)

#define WT_SCAN 0
#define WT_GATE 4224
#define WT_BRR  8320
#define WT_BRG  9344
#define WT_OUT  10368

#define LDS_BYTES 161792
#define SCAN_GB   80896

struct Params {
  const float* x; const float* c; const float* ctx; const float* c_ctx;
  const float* norm_gain; const float* w_ada; const float* b_ada; const float* w_in;
  const float* ret_decay; const float* gla_w_up; const float* gla_b_up;
  const float* ret_norm_gain; const float* gla_norm_gain;
  const float* w_br_ret; const float* w_br_gla; const float* w_out; const float* final_gain;
  float* out; char* ws;
};

__device__ __forceinline__ u16 f2bf(float f) {
  __bf16 h = (__bf16)f;
  return *(u16*)&h;
}
__device__ __forceinline__ float bf2f(u16 h) { return __uint_as_float(((unsigned)h) << 16); }
__device__ __forceinline__ float sigmoidf_(float x) { return __builtin_amdgcn_rcpf(1.f + __expf(-x)); }
__device__ __forceinline__ float siluf_(float x) { return x * __builtin_amdgcn_rcpf(1.f + __expf(-x)); }

__device__ __forceinline__ int opaque_tid() { int t = threadIdx.x; asm volatile("" : "+v"(t)); return t; }

__device__ __forceinline__ float wave_sum(float v) {
#pragma unroll
  for (int o = 32; o > 0; o >>= 1) v += __shfl_xor(v, o, 64);
  return v;
}

__device__ __forceinline__ const float* wt_src(const Params& p, int l, int n, int& ld) {
  if (n < WT_GATE) {
    int tile = n >> 7, cc = n & 127;
    int col;
    if (tile < 8) {
      int d = (cc & 64) | ((cc & 16) << 1) | ((cc & 32) >> 1) | (cc & 15);
      col = tile * 128 + d;
    } else if (tile < 16) col = 1024 + (tile - 8) * 128 + cc;
    else if (tile < 24) col = 3072 + (tile - 16) * 128 + cc;
    else if (tile < 32) col = 4096 + (tile - 24) * 128 + cc;
    else { if (cc >= 16) { ld = 0; return nullptr; } col = 6144 + cc; }
    ld = INW; return p.w_in + (size_t)l * DM * INW + col;
  } else if (n < WT_BRR) {
    int g = n - WT_GATE; int col;
    if (g < 1024) col = 2048 + g;
    else if (g < 2048) col = 5120 + (g - 1024);
    else if (g < 3072) col = 6160 + (g - 2048);
    else col = 7184 + (g - 3072);
    ld = INW; return p.w_in + (size_t)l * DM * INW + col;
  } else if (n < WT_BRG) { ld = DM; return p.w_br_ret + (size_t)l * DM * DM + (n - WT_BRR); }
  else if (n < WT_OUT)   { ld = DM; return p.w_br_gla + (size_t)l * DM * DM + (n - WT_BRG); }
  else                   { ld = DM; return p.w_out    + (size_t)l * DM * DM + (n - WT_OUT); }
}

#define WT_UNITS (178 * 16)
__device__ __forceinline__ void wt_unit(const Params& p, int l, int unit, char* smem) {
  float* tile = (float*)smem;
  int nb = unit >> 4, kb = unit & 15;
  int tid = opaque_tid();
  int n0 = nb * 64, k0 = kb * 64;
  {
    int nl = tid & 63, kq = tid >> 6;
    int ld; const float* src = wt_src(p, l, n0 + nl, ld);
#pragma unroll
    for (int i = 0; i < 8; ++i) {
      int kl = kq + 8 * i;
      float v = src ? src[(size_t)(k0 + kl) * ld] : 0.f;
      tile[kl * 65 + nl] = v;
    }
  }
  __syncthreads();
  {
    int nl = tid >> 3, kq = tid & 7;
    bf16x8 o;
#pragma unroll
    for (int j = 0; j < 8; ++j) o[j] = (short)f2bf(tile[(kq * 8 + j) * 65 + nl]);
    u16* wt = (u16*)(p.ws + OFF_WT);
    *(bf16x8*)(wt + (size_t)(n0 + nl) * 1024 + k0 + kq * 8) = o;
  }
  __syncthreads();
}

__device__ __forceinline__ void mod_unit(const Params& p, int unit, char* smem) {
  float* sc = (float*)smem;
  float* red = sc + 9 * 1024;
  int l = unit / 48, jb = unit % 48;
  int tid = opaque_tid();
  for (int i = tid; i < 9 * 1024; i += NTHREADS) {
    int r = i >> 10, k = i & 1023;
    float v = (r < 8) ? p.c[r * 1024 + k] : p.c_ctx[k];
    sc[i] = siluf_(v);
  }
  __syncthreads();
  int jl = tid & 63, kg = tid >> 6;
  int j = jb * 64 + jl;
  float acc[9];
#pragma unroll
  for (int r = 0; r < 9; ++r) acc[r] = 0.f;
  const float* w = p.w_ada + (size_t)l * DM * 3072 + j;
#pragma unroll 16
  for (int k = kg * 128; k < kg * 128 + 128; ++k) {
    float wv = w[(size_t)k * 3072];
#pragma unroll
    for (int r = 0; r < 9; ++r) acc[r] += sc[r * 1024 + k] * wv;
  }
#pragma unroll
  for (int r = 0; r < 9; ++r) red[(kg * 9 + r) * 64 + jl] = acc[r];
  __syncthreads();
  float* mod = (float*)(p.ws + OFF_MOD);
  for (int i = tid; i < 9 * 64; i += NTHREADS) {
    int r = i >> 6, jj = i & 63;
    float s = 0.f;
#pragma unroll
    for (int g = 0; g < 8; ++g) s += red[(g * 9 + r) * 64 + jj];
    mod[((size_t)l * 9 + r) * 3072 + jb * 64 + jj] = s + p.b_ada[l * 3072 + jb * 64 + jj];
  }
  __syncthreads();
}

__device__ __forceinline__ void rot_unit(const Params& p) {
  float* rot = (float*)(p.ws + OFF_ROT);
  for (int i = opaque_tid(); i < 64 * 32; i += NTHREADS) {
    int pos = i >> 5, f = i & 31;
    float inv = exp2f(-(float)f * (13.287712379549449f / 32.f));
    float ang = (float)pos * inv;
    rot[i * 2] = __cosf(ang);
    rot[i * 2 + 1] = __sinf(ang);
  }
}

__device__ __forceinline__ void phase_u(const Params& p, int l) {
  const int tid = opaque_tid(); int wave = tid >> 6, lane = tid & 63;
  const float* mod = (const float*)(p.ws + OFF_MOD) + (size_t)l * 9 * 3072;
  const float* gain = p.norm_gain + l * DM;
  u16* U = (u16*)(p.ws + OFF_U);
  for (int row = (blockIdx.x * 8 + wave) * 4; row < MTOT; row += gridDim.x * 32) {
    const float* h; int r;
    if (row < MLAT) { h = (l == 0 ? p.x : p.out) + (size_t)row * DM; r = row >> 12; }
    else { int cr = row - MLAT; h = (l == 0 ? p.ctx : (const float*)(p.ws + OFF_HCTX)) + (size_t)cr * DM; r = 8; }
    float4 v[4][4]; float ss[4];
#pragma unroll
    for (int q = 0; q < 4; ++q) {
      ss[q] = 0.f;
#pragma unroll
      for (int i = 0; i < 4; ++i) v[q][i] = *(const float4*)(h + q * DM + i * 256 + lane * 4);
    }
#pragma unroll
    for (int q = 0; q < 4; ++q) {
#pragma unroll
      for (int i = 0; i < 4; ++i) ss[q] += v[q][i].x * v[q][i].x + v[q][i].y * v[q][i].y + v[q][i].z * v[q][i].z + v[q][i].w * v[q][i].w;
      ss[q] = rsqrtf(wave_sum(ss[q]) * (1.f / 1024.f) + 1e-6f);
    }
    const float* sh = mod + r * 3072;
#pragma unroll
    for (int i = 0; i < 4; ++i) {
      int cidx = i * 256 + lane * 4;
      float4 g = *(const float4*)(gain + cidx);
      float4 s = *(const float4*)(sh + cidx);
      float4 sc = *(const float4*)(sh + 1024 + cidx);
      g.x *= (1.f + sc.x); g.y *= (1.f + sc.y); g.z *= (1.f + sc.z); g.w *= (1.f + sc.w);
#pragma unroll
      for (int q = 0; q < 4; ++q) {
        bf16x4 o;
        o[0] = (short)f2bf(v[q][i].x * ss[q] * g.x + s.x);
        o[1] = (short)f2bf(v[q][i].y * ss[q] * g.y + s.y);
        o[2] = (short)f2bf(v[q][i].z * ss[q] * g.z + s.z);
        o[3] = (short)f2bf(v[q][i].w * ss[q] * g.w + s.w);
        *(bf16x4*)(U + (size_t)(row + q) * DM + cidx) = o;
      }
    }
  }
}

__device__ __forceinline__ void phase_final(const Params& p) {
  const int tid = opaque_tid(); int wave = tid >> 6, lane = tid & 63;
  for (int row = (blockIdx.x * 8 + wave) * 4; row < MLAT; row += gridDim.x * 32) {
    float* h = p.out + (size_t)row * DM;
    float4 v[4][4]; float ss[4];
#pragma unroll
    for (int q = 0; q < 4; ++q) {
      ss[q] = 0.f;
#pragma unroll
      for (int i = 0; i < 4; ++i) v[q][i] = *(const float4*)(h + q * DM + i * 256 + lane * 4);
    }
#pragma unroll
    for (int q = 0; q < 4; ++q) {
#pragma unroll
      for (int i = 0; i < 4; ++i) ss[q] += v[q][i].x * v[q][i].x + v[q][i].y * v[q][i].y + v[q][i].z * v[q][i].z + v[q][i].w * v[q][i].w;
      ss[q] = rsqrtf(wave_sum(ss[q]) * (1.f / 1024.f) + 1e-6f);
    }
#pragma unroll
    for (int i = 0; i < 4; ++i) {
      int cidx = i * 256 + lane * 4;
      float4 g = *(const float4*)(p.final_gain + cidx);
#pragma unroll
      for (int q = 0; q < 4; ++q) {
        float4 o;
        o.x = v[q][i].x * ss[q] * g.x; o.y = v[q][i].y * ss[q] * g.y; o.z = v[q][i].z * ss[q] * g.z; o.w = v[q][i].w * ss[q] * g.w;
        *(float4*)(h + q * DM + cidx) = o;
      }
    }
  }
}

#define PG8_LAS __attribute__((address_space(3)))
typedef unsigned u32x4 __attribute__((ext_vector_type(4)));
namespace pg8 {
constexpr int BM = 256, BK = 64, HALF = 128, HTB = HALF * BK * 2, STAGE_BYTES = 8 * HTB, NXCD = 8, WGM = 8;
__device__ __forceinline__ int lds_byte(int r, int c) { const int st = (r >> 4) * 2 + (c >> 5), rr = r & 15, cc = c & 31, ob = rr * 64 + cc * 2; return st * 1024 + (ob ^ (((ob >> 9) & 1) << 5)); }
__device__ __forceinline__ void stage_rc(int b, int& R, int& C) { const int st = b / 1024, sb = b % 1024, swz = sb ^ (((sb >> 9) & 1) << 5); R = (st >> 1) * 16 + swz / 64; C = (st & 1) * 32 + (swz % 64) / 2; }
__device__ __forceinline__ int perm32(int rho) { const int n = rho >> 4, i = rho & 15; return 8 * (i >> 2) + 4 * n + (i & 3); }
struct Unit { int pm, pn; };
struct Gemm { const u16* A; const u16* Bt; int lda; int M, N, K; };
struct StaticOrder {
  int nM, nN, nwg, G, c;
  __device__ void init(int M, int N, int G_, int c_) { nM = M / BM; nN = N / BM; nwg = nM * nN; G = G_; c = c_; }
  __device__ bool next(int i, Unit& u) const {
    const long L = (long)i * G + c; if (L >= nwg) return false;
    int wgid = (int)L; { const int q = nwg / NXCD, r = nwg % NXCD, xcd = wgid % NXCD, off = wgid / NXCD; wgid = (xcd < r ? xcd * (q + 1) : r * (q + 1) + (xcd - r) * q) + off; }
    const int nig = WGM * nN, gid = wgid / nig, fm = gid * WGM, gsz = (nM - fm) < WGM ? (nM - fm) : WGM;
    u.pm = fm + ((wgid % nig) % gsz); u.pn = (wgid % nig) / gsz; return true;
  }
};
typedef __attribute__((ext_vector_type(2))) float cvt_f2_t;
typedef __attribute__((ext_vector_type(2))) __bf16 cvt_b2_t;
__device__ __forceinline__ unsigned cvt_pk_bf16(float lo, float hi) { cvt_f2_t f = {lo, hi}; cvt_b2_t r = __builtin_convertvector(f, cvt_b2_t); return __builtin_bit_cast(unsigned, r); }

template <class Epi>
__device__ __forceinline__ void gemm_phase(PG8_LAS unsigned char* lds, const Gemm g, const StaticOrder& S, const Epi& E, const int tid) {
  const int wid = __builtin_amdgcn_readfirstlane(tid >> 6), lane = tid & 63, wr = wid >> 2, wc = wid & 3, fr = lane & 15, fq = lane >> 4;
  const int K = g.K, nt = K / BK;
  unsigned voffA[2], voffB[2];
#pragma unroll
  for (int i = 0; i < 2; ++i) { int R, C; stage_rc(tid * 16 + i * 8192, R, C); const int Rb = Epi::PERM ? ((R & ~31) + perm32(R & 31)) : R;
    voffA[i] = (unsigned)(R * g.lda + C) * 2u; voffB[i] = (unsigned)(Rb * K + C) * 2u; }
  const size_t kstep = (size_t)(BK * 2);
  const size_t hstepA = (size_t)HALF * g.lda * 2, hstepB = (size_t)HALF * K * 2;
  const size_t tstepA = 2 * hstepA, tstepB = 2 * hstepB;
  const unsigned ldsw = (unsigned)wid * 1024u;
  const int aoff = lds_byte(wr * 64 + fr, fq * 8), boff = lds_byte(wc * 32 + fr, fq * 8);
#define PG8_SA(b, h) (((b) * 2 + (h)) * HTB)
#define PG8_SB(b, h) ((4 + (b) * 2 + (h)) * HTB)
#define PG8_STAGE(bufoff, gbase, voff) do { _Pragma("unroll") for (int _i = 0; _i < 2; ++_i) \
    __builtin_amdgcn_global_load_lds((const unsigned*)((const char*)(gbase) + (voff)[_i]), (PG8_LAS unsigned*)(lds + (bufoff) + ldsw + _i * 8192), 16, 0, 0); } while (0)
#define PG8_LDA(dst, b, h) do { _Pragma("unroll") for (int m = 0; m < 4; ++m) _Pragma("unroll") for (int k = 0; k < 2; ++k) dst[m][k] = *(const PG8_LAS bf16x8*)(lds + PG8_SA(b, h) + aoff + m * 2048 + k * 1024); } while (0)
#define PG8_LDB(dst, b, h) do { _Pragma("unroll") for (int n = 0; n < 2; ++n) _Pragma("unroll") for (int k = 0; k < 2; ++k) dst[n][k] = *(const PG8_LAS bf16x8*)(lds + PG8_SB(b, h) + boff + n * 2048 + k * 1024); } while (0)
#define PG8_MMA(ai, bj, At, Bt) do { __builtin_amdgcn_s_setprio(1); _Pragma("unroll") for (int m = 0; m < 4; ++m) _Pragma("unroll") for (int n = 0; n < 2; ++n) _Pragma("unroll") for (int k = 0; k < 2; ++k) \
    acc[ai][bj][m][n] = __builtin_amdgcn_mfma_f32_16x16x32_bf16(Bt[n][k], At[m][k], acc[ai][bj][m][n], 0, 0, 0); __builtin_amdgcn_s_setprio(0); } while (0)
#define PG8_WAIT_V(n) asm volatile("s_waitcnt vmcnt(" #n ")" ::: "memory")
#define PG8_WAIT_L(n) asm volatile("s_waitcnt lgkmcnt(" #n ")" ::: "memory")
#define PG8_BAR __builtin_amdgcn_s_barrier()
#define PG8_SCHED __builtin_amdgcn_sched_barrier(0)
  Unit cur, nxt; int ui = 0;
  if (!S.next(0, cur)) return;
  f32x4 acc[2][2][4][2];
#pragma unroll
  for (int a = 0; a < 2; ++a)
#pragma unroll
    for (int b = 0; b < 2; ++b)
#pragma unroll
      for (int m = 0; m < 4; ++m)
#pragma unroll
        for (int n = 0; n < 2; ++n) acc[a][b][m][n] = (f32x4){0.f, 0.f, 0.f, 0.f};
  bf16x8 At[4][2], B0[2][2], B1[2][2];
  const char* cA = (const char*)g.A + (size_t)cur.pm * tstepA; const char* cB = (const char*)g.Bt + (size_t)cur.pn * tstepB;
  PG8_STAGE(PG8_SB(0, 0), cB, voffB); PG8_STAGE(PG8_SA(0, 0), cA, voffA); PG8_STAGE(PG8_SB(0, 1), cB + hstepB, voffB); PG8_STAGE(PG8_SA(0, 1), cA + hstepA, voffA);
  if (wr == 1) PG8_BAR;
  PG8_WAIT_V(4); PG8_BAR;
  PG8_STAGE(PG8_SB(1, 0), cB + kstep, voffB); PG8_STAGE(PG8_SA(1, 0), cA + kstep, voffA); PG8_STAGE(PG8_SB(1, 1), cB + hstepB + kstep, voffB);
  PG8_WAIT_V(6); PG8_BAR;
  for (;;) {
    const bool has_next = S.next(ui + 1, nxt);
    const char* nA = has_next ? (const char*)g.A + (size_t)nxt.pm * tstepA : cA; const char* nB = has_next ? (const char*)g.Bt + (size_t)nxt.pn * tstepB : cB;
    for (int t = 0; t < nt; t += 2) {
      const bool last = (t == nt - 2);
      const char* a1 = cA + (size_t)(t + 1) * kstep;
      const char* a2 = last ? nA : cA + (size_t)(t + 2) * kstep; const char* b2 = last ? nB : cB + (size_t)(t + 2) * kstep;
      const char* a3 = a2 + kstep; const char* b3 = b2 + kstep;
      PG8_LDB(B0, 0, 0); PG8_SCHED; PG8_LDA(At, 0, 0); PG8_STAGE(PG8_SA(1, 1), a1 + hstepA, voffA);
      PG8_WAIT_L(8); PG8_BAR; PG8_WAIT_L(0); PG8_MMA(0, 0, At, B0); PG8_BAR; PG8_SCHED;
      PG8_LDB(B1, 0, 1); PG8_STAGE(PG8_SB(0, 0), b2, voffB);
      PG8_BAR; PG8_WAIT_L(0); PG8_MMA(0, 1, At, B1); PG8_BAR;
      PG8_LDA(At, 0, 1); PG8_STAGE(PG8_SA(0, 0), a2, voffA);
      PG8_BAR; PG8_WAIT_L(0); PG8_MMA(1, 0, At, B0); PG8_BAR; PG8_SCHED;
      PG8_STAGE(PG8_SB(0, 1), b2 + hstepB, voffB);
      PG8_WAIT_V(6); PG8_BAR; PG8_MMA(1, 1, At, B1); PG8_BAR;
      PG8_LDB(B0, 1, 0); PG8_SCHED; PG8_LDA(At, 1, 0); PG8_STAGE(PG8_SA(0, 1), a2 + hstepA, voffA);
      PG8_WAIT_L(8); PG8_BAR; PG8_WAIT_L(0); PG8_MMA(0, 0, At, B0); PG8_BAR; PG8_SCHED;
      PG8_LDB(B1, 1, 1); PG8_STAGE(PG8_SB(1, 0), b3, voffB);
      PG8_BAR; PG8_WAIT_L(0); PG8_MMA(0, 1, At, B1); PG8_BAR;
      PG8_LDA(At, 1, 1); PG8_STAGE(PG8_SA(1, 0), a3, voffA);
      PG8_BAR; PG8_WAIT_L(0); PG8_MMA(1, 0, At, B0); PG8_BAR; PG8_SCHED;
      PG8_STAGE(PG8_SB(1, 1), b3 + hstepB, voffB);
      PG8_WAIT_V(6); PG8_BAR; PG8_MMA(1, 1, At, B1); PG8_BAR;
    }
    E(acc, cur, wr, wc, fr, fq, lane);
    if (!has_next) break;
#pragma unroll
    for (int a = 0; a < 2; ++a)
#pragma unroll
      for (int b = 0; b < 2; ++b)
#pragma unroll
        for (int m = 0; m < 4; ++m)
#pragma unroll
          for (int n = 0; n < 2; ++n) acc[a][b][m][n] = (f32x4){0.f, 0.f, 0.f, 0.f};
    cur = nxt; cA = nA; cB = nB; ++ui;
  }
  PG8_WAIT_V(0);
  if (wr == 0) PG8_BAR;
  PG8_BAR;
#undef PG8_SA
#undef PG8_SB
#undef PG8_STAGE
#undef PG8_LDA
#undef PG8_LDB
#undef PG8_MMA
#undef PG8_WAIT_V
#undef PG8_WAIT_L
#undef PG8_BAR
#undef PG8_SCHED
}
}

#define OFF_STATS OFF_GLR

__device__ __forceinline__ u32x4 pack8v(const f32x4& a, const f32x4& b) {
  u32x4 w; w.x = pg8::cvt_pk_bf16(a[0], a[1]); w.y = pg8::cvt_pk_bf16(a[2], a[3]); w.z = pg8::cvt_pk_bf16(b[0], b[1]); w.w = pg8::cvt_pk_bf16(b[2], b[3]); return w;
}
__device__ __forceinline__ float xlane32(float v, int lane) { return __int_as_float(__builtin_amdgcn_ds_bpermute((lane ^ 32) << 2, __float_as_int(v))); }

struct EpiScanIn {
  static constexpr bool PERM = true;
  u16* S; const float* rot;
  __device__ __forceinline__ void operator()(const f32x4 (&acc)[2][2][4][2], const pg8::Unit& u, int wr, int wc, int fr, int fq, int lane) const {
    u16* Sb = S + (size_t)u.pm * 256 * 4096;
    unsigned rl0 = wr * 64 + fr; asm volatile("" : "+v"(rl0));
#pragma unroll
    for (int bj = 0; bj < 2; ++bj) {
      const int nt128 = u.pn * 2 + bj;
      const bool scaled = (nt128 < 4) || (nt128 >= 16 && nt128 < 20);
      const float scl = scaled ? 0.08838834764831845f : 1.f;
      const unsigned cb = nt128 * 128 + wc * 32 + fq * 8;
      if (nt128 < 8 && u.pm < 128) {
        const int tb = (u.pm & 15) * 256;
        const int fo = ((wc & 1) * 16 + (fq & 1) * 8) * 2;
        const float sgn = (fq >> 1) ? 1.f : -1.f;
#pragma unroll
        for (int ai = 0; ai < 2; ++ai)
#pragma unroll
          for (int m = 0; m < 4; ++m) {
            const unsigned rl = rl0 + ai * 128 + m * 16;
            const int t = tb + rl;
            const unsigned pos = (wc >> 1) == 0 ? (t >> 6) : (t & 63);
            const float* rp = rot + pos * 64u + fo;
            const float4 c0 = *(const float4*)rp, c1 = *(const float4*)(rp + 4), c2 = *(const float4*)(rp + 8), c3 = *(const float4*)(rp + 12);
            const f32x4 v0 = acc[ai][bj][m][0], v1 = acc[ai][bj][m][1];
            f32x4 p0, p1;
#pragma unroll
            for (int j = 0; j < 4; ++j) { p0[j] = xlane32(v0[j], lane); p1[j] = xlane32(v1[j], lane); }
            f32x4 o0, o1;
            o0[0] = (v0[0] * c0.x + sgn * p0[0] * c0.y) * scl; o0[1] = (v0[1] * c0.z + sgn * p0[1] * c0.w) * scl;
            o0[2] = (v0[2] * c1.x + sgn * p0[2] * c1.y) * scl; o0[3] = (v0[3] * c1.z + sgn * p0[3] * c1.w) * scl;
            o1[0] = (v1[0] * c2.x + sgn * p1[0] * c2.y) * scl; o1[1] = (v1[1] * c2.z + sgn * p1[1] * c2.w) * scl;
            o1[2] = (v1[2] * c3.x + sgn * p1[2] * c3.y) * scl; o1[3] = (v1[3] * c3.z + sgn * p1[3] * c3.w) * scl;
            *(u32x4*)(Sb + rl * 4096u + cb) = pack8v(o0, o1);
            __builtin_amdgcn_sched_barrier(0);
          }
      } else {
#pragma unroll
        for (int ai = 0; ai < 2; ++ai)
#pragma unroll
          for (int m = 0; m < 4; ++m) {
            const unsigned rl = rl0 + ai * 128 + m * 16;
            *(u32x4*)(Sb + rl * 4096u + cb) = pack8v(acc[ai][bj][m][0] * scl, acc[ai][bj][m][1] * scl);
            __builtin_amdgcn_sched_barrier(0);
          }
      }
    }
  }
};

struct EpiGate {
  static constexpr bool PERM = true;
  const u16* RG; const float* stats; u16* S; const float* rgain; const float* ggain;
  __device__ __forceinline__ void operator()(const f32x4 (&acc)[2][2][4][2], const pg8::Unit& u, int wr, int wc, int fr, int fq, int lane) const {
    u16* Sb = S + (size_t)u.pm * 256 * 4096;
    unsigned rl0 = wr * 64 + fr; asm volatile("" : "+v"(rl0));
    if (u.pn < 8) {
      const int branch = u.pn >> 2, head = u.pn & 3;
      const u16* RGb = RG + (size_t)u.pm * 256 * 2048 + branch * 1024;
      const float* stb = stats + (size_t)u.pm * 256 * 16 + (branch * 4 + head) * 2;
      const float* gain = branch ? ggain : rgain;
#pragma unroll
      for (int bj = 0; bj < 2; ++bj) {
        const unsigned cb = head * 256 + bj * 128 + wc * 32 + fq * 8;
        const float4 g0 = *(const float4*)(gain + cb), g1 = *(const float4*)(gain + cb + 4);
#pragma unroll
        for (int ai = 0; ai < 2; ++ai)
#pragma unroll
          for (int m = 0; m < 4; ++m) {
            const unsigned rl = rl0 + ai * 128 + m * 16;
            const float2 st = *(const float2*)(stb + rl * 16u);
            const bf16x8 xr = *(const bf16x8*)(RGb + rl * 2048u + cb);
            f32x4 v0 = acc[ai][bj][m][0], v1 = acc[ai][bj][m][1];
            asm volatile("" : "+v"(v0), "+v"(v1));
            f32x4 o0, o1;
            o0[0] = (bf2f((u16)xr[0]) * st.x + st.y) * g0.x * siluf_(v0[0]); o0[1] = (bf2f((u16)xr[1]) * st.x + st.y) * g0.y * siluf_(v0[1]);
            o0[2] = (bf2f((u16)xr[2]) * st.x + st.y) * g0.z * siluf_(v0[2]); o0[3] = (bf2f((u16)xr[3]) * st.x + st.y) * g0.w * siluf_(v0[3]);
            o1[0] = (bf2f((u16)xr[4]) * st.x + st.y) * g1.x * siluf_(v1[0]); o1[1] = (bf2f((u16)xr[5]) * st.x + st.y) * g1.y * siluf_(v1[1]);
            o1[2] = (bf2f((u16)xr[6]) * st.x + st.y) * g1.z * siluf_(v1[2]); o1[3] = (bf2f((u16)xr[7]) * st.x + st.y) * g1.w * siluf_(v1[3]);
            *(u32x4*)(Sb + rl * 4096u + 2048u + branch * 1024 + cb) = pack8v(o0, o1);
            __builtin_amdgcn_sched_barrier(0);
          }
      }
    } else {
#pragma unroll
      for (int bj = 0; bj < 2; ++bj) {
        const unsigned cb = (u.pn - 8) * 256 + bj * 128 + wc * 32 + fq * 8;
#pragma unroll
        for (int ai = 0; ai < 2; ++ai)
#pragma unroll
          for (int m = 0; m < 4; ++m) {
            const unsigned rl = rl0 + ai * 128 + m * 16;
            f32x4 v0 = acc[ai][bj][m][0], v1 = acc[ai][bj][m][1];
            asm volatile("" : "+v"(v0), "+v"(v1));
            f32x4 o0, o1;
#pragma unroll
            for (int j = 0; j < 4; ++j) { o0[j] = sigmoidf_(v0[j]); o1[j] = sigmoidf_(v1[j]); }
            *(u32x4*)(Sb + rl * 4096u + cb) = pack8v(o0, o1);
            __builtin_amdgcn_sched_barrier(0);
          }
      }
    }
  }
};

struct EpiMerge {
  static constexpr bool PERM = true;
  const u16* S; u16* MG; int pass;
  __device__ __forceinline__ void operator()(const f32x4 (&acc)[2][2][4][2], const pg8::Unit& u, int wr, int wc, int fr, int fq, int lane) const {
    const u16* Sb = S + (size_t)u.pm * 256 * 4096 + pass * 1024;
    u16* MGb = MG + (size_t)u.pm * 256 * 1024;
    unsigned rl0 = wr * 64 + fr; asm volatile("" : "+v"(rl0));
#pragma unroll
    for (int bj = 0; bj < 2; ++bj) {
      const unsigned cb = u.pn * 256 + bj * 128 + wc * 32 + fq * 8;
#pragma unroll
      for (int ai = 0; ai < 2; ++ai)
#pragma unroll
        for (int m = 0; m < 4; ++m) {
          const unsigned rl = rl0 + ai * 128 + m * 16;
          const bf16x8 gt = *(const bf16x8*)(Sb + rl * 4096u + cb);
          f32x4 o0 = acc[ai][bj][m][0], o1 = acc[ai][bj][m][1];
#pragma unroll
          for (int j = 0; j < 4; ++j) { o0[j] *= bf2f((u16)gt[j]); o1[j] *= bf2f((u16)gt[4 + j]); }
          if (pass) {
            const bf16x8 old = *(const bf16x8*)(MGb + rl * 1024u + cb);
#pragma unroll
            for (int j = 0; j < 4; ++j) { o0[j] += bf2f((u16)old[j]); o1[j] += bf2f((u16)old[4 + j]); }
          }
          *(u32x4*)(MGb + rl * 1024u + cb) = pack8v(o0, o1);
            __builtin_amdgcn_sched_barrier(0);
        }
    }
  }
};

struct EpiOut {
  static constexpr bool PERM = false;
  const float* x_lat; const float* x_ctx; float* o_lat; float* o_ctx; const float* mod;
  __device__ __forceinline__ void operator()(const f32x4 (&acc)[2][2][4][2], const pg8::Unit& u, int wr, int wc, int fr, int fq, int lane) const {
    const float* hin; float* hout; int rmod;
    if (u.pm < 128) { hin = x_lat + (size_t)u.pm * 256 * DM; hout = o_lat + (size_t)u.pm * 256 * DM; rmod = u.pm >> 4; }
    else { hin = x_ctx + (size_t)(u.pm - 128) * 256 * DM; hout = o_ctx + (size_t)(u.pm - 128) * 256 * DM; rmod = 8; }
    const float* gate = mod + rmod * 3072 + 2048;
    unsigned rl0 = wr * 64 + fr; asm volatile("" : "+v"(rl0));
#pragma unroll
    for (int bj = 0; bj < 2; ++bj)
#pragma unroll
      for (int n = 0; n < 2; ++n) {
        const unsigned cb = u.pn * 256 + bj * 128 + wc * 32 + n * 16 + fq * 4;
        const float4 g = *(const float4*)(gate + cb);
#pragma unroll
        for (int ai = 0; ai < 2; ++ai)
#pragma unroll
          for (int m = 0; m < 4; ++m) {
            const unsigned o = (rl0 + ai * 128 + m * 16) * 1024u + cb;
            const float4 h = *(const float4*)(hin + o);
            const f32x4 v = acc[ai][bj][m][n];
            *(float4*)(hout + o) = make_float4(h.x + g.x * v[0], h.y + g.y * v[1], h.z + g.z * v[2], h.w + g.w * v[3]);
          }
      }
  }
};

__device__ __forceinline__ void phase_stats(const Params& p, int l) {
  const int tid = opaque_tid(); const int wave = tid >> 6, lane = tid & 63;
  const u16* RG = (const u16*)(p.ws + OFF_RG);
  float* ST = (float*)(p.ws + OFF_STATS);
  const int nrows = (l == 0) ? MTOT : MLAT;
  for (int row = (blockIdx.x * 8 + wave) * 4; row < nrows; row += gridDim.x * 32) {
    bf16x8 v[4][4];
#pragma unroll
    for (int q = 0; q < 4; ++q)
#pragma unroll
      for (int i = 0; i < 4; ++i) v[q][i] = *(const bf16x8*)(RG + (size_t)(row + q) * 2048 + i * 512 + lane * 8);
#pragma unroll
    for (int q = 0; q < 4; ++q)
#pragma unroll
      for (int i = 0; i < 4; ++i) {
        float s1 = 0.f, s2 = 0.f;
#pragma unroll
        for (int x = 0; x < 8; ++x) { float a = bf2f((u16)v[q][i][x]); s1 += a; s2 += a * a; }
#pragma unroll
        for (int o = 16; o > 0; o >>= 1) {
          s1 += __int_as_float(__builtin_amdgcn_ds_bpermute((lane ^ o) << 2, __float_as_int(s1)));
          s2 += __int_as_float(__builtin_amdgcn_ds_bpermute((lane ^ o) << 2, __float_as_int(s2)));
        }
        float sa, sb;
        if ((i >> 1) == 0) { float mu = s1 * (1.f / 256.f); float var = fmaxf(s2 * (1.f / 256.f) - mu * mu, 0.f); sa = rsqrtf(var + 1e-6f); sb = -mu * sa; }
        else { sa = rsqrtf(s2 * (1.f / 256.f) + 1e-6f); sb = 0.f; }
        if ((lane & 31) == 0) *(float2*)(ST + ((size_t)(row + q) * 8 + (i >> 1) * 4 + 2 * (i & 1) + (lane >> 5)) * 2) = make_float2(sa, sb);
      }
  }
}

#define OFF_VECS OFF_WT
__device__ __forceinline__ float logsig16(float x) { return (fminf(x, 0.f) - __logf(1.f + __expf(-fabsf(x)))) * (1.f / 16.f); }

typedef __attribute__((ext_vector_type(2))) float f32x2_t;

template <int SW>
__device__ __forceinline__ void prepass_sweep(const float* GLRS, const f32x2_t (&w2)[16], f32x2_t b2, u16* Sq, u16* Ub, float& accF, float& accB) {
  accF = 0.f; accB = 0.f;
#pragma unroll 16
  for (int u = 0; u < 32; ++u) {
    const int i = SW ? 32 + u : 31 - u;
    const float4* gr = (const float4*)(GLRS + i * 16);
    const float4 g0 = gr[0], g1 = gr[1], g2 = gr[2], g3 = gr[3];
    f32x2_t x = b2;
    x = w2[0] * g0.x + x;  x = w2[1] * g0.y + x;  x = w2[2] * g0.z + x;  x = w2[3] * g0.w + x;
    x = w2[4] * g1.x + x;  x = w2[5] * g1.y + x;  x = w2[6] * g1.z + x;  x = w2[7] * g1.w + x;
    x = w2[8] * g2.x + x;  x = w2[9] * g2.y + x;  x = w2[10] * g2.z + x; x = w2[11] * g2.w + x;
    x = w2[12] * g3.x + x; x = w2[13] * g3.y + x; x = w2[14] * g3.z + x; x = w2[15] * g3.w + x;
    const float laf = logsig16(x.x), lab = logsig16(x.y);
    float relf, relb;
    if (SW == 0) { relf = -accF; accF += laf; accB += lab; relb = accB; }
    else         { accF += laf; relf = accF; relb = -accB; accB += lab; }
    const float q = bf2f(Sq[(unsigned)i * 4096u]), k = bf2f(Sq[(unsigned)i * 4096u + 512u]);
    Sq[(unsigned)i * 4096u] = f2bf(q * __expf(relf));
    Sq[(unsigned)i * 4096u + 512u] = f2bf(k * __expf(-relf));
    Ub[(unsigned)i * 1024u] = f2bf(q * __expf(relb));
    Ub[(unsigned)i * 1024u + 512u] = f2bf(k * __expf(-relb));
  }
}

__device__ __forceinline__ void gla_prepass_unit(const Params& p, int l, int unit, char* smem) {
  const int tid = opaque_tid();
  const int sw = unit & 1, ch = unit >> 1;
  const int b = ch / 68, cid = ch % 68;
  const int base = cid < 4 ? (MLAT + b * 256 + cid * 64) : (b * 4096 + (cid - 4) * 64);
  float* GLRS = (float*)smem;
  __syncthreads();
  {
    const int wid = tid >> 6, lane = tid & 63, fr = lane & 15, fq = lane >> 4;
    if (wid < 2) {
      const int r0 = sw * 32 + wid * 16;
      f32x4 g = (f32x4){0.f, 0.f, 0.f, 0.f};
      const u16* Ua = (const u16*)(p.ws + OFF_U) + (size_t)(base + r0 + fr) * 1024 + fq * 8;
      const u16* Wb = (const u16*)(p.ws + OFF_WT) + (size_t)(4096 + fr) * 1024 + fq * 8;
#pragma unroll 16
      for (int k = 0; k < 1024; k += 32) {
        bf16x8 a = *(const bf16x8*)(Ua + k);
        bf16x8 w = *(const bf16x8*)(Wb + k);
        g = __builtin_amdgcn_mfma_f32_16x16x32_bf16(a, w, g, 0, 0, 0);
      }
#pragma unroll
      for (int j = 0; j < 4; ++j) GLRS[(r0 + fq * 4 + j) * 16 + fr] = g[j];
    }
  }
  f32x2_t w2[16];
  {
    const float* w0 = p.gla_w_up + (size_t)(l * 2 + 0) * 16 * 512 + tid;
    const float* w1 = p.gla_w_up + (size_t)(l * 2 + 1) * 16 * 512 + tid;
#pragma unroll
    for (int r = 0; r < 16; ++r) { w2[r].x = w0[r * 512]; w2[r].y = w1[r * 512]; }
  }
  f32x2_t b2; b2.x = p.gla_b_up[(l * 2 + 0) * 512 + tid]; b2.y = p.gla_b_up[(l * 2 + 1) * 512 + tid];
  __syncthreads();
  u16* Sq = (u16*)(p.ws + OFF_S) + (size_t)base * 4096 + 2048 + tid;
  u16* Ub = (u16*)(p.ws + OFF_U) + (size_t)base * 1024 + tid;
  float* V0 = (float*)(p.ws + OFF_VECS) + ((size_t)(0 * 544 + b * 68 + cid) * 2) * 512 + tid;
  float* V1 = (float*)(p.ws + OFF_VECS) + ((size_t)(1 * 544 + b * 68 + cid) * 2) * 512 + tid;
  float accF, accB;
  if (sw == 0) {
    prepass_sweep<0>(GLRS, w2, b2, Sq, Ub, accF, accB);
    V0[0] = __expf(accF);
    V1[512] = __expf(accB);
  } else {
    prepass_sweep<1>(GLRS, w2, b2, Sq, Ub, accF, accB);
    V0[512] = __expf(accF);
    V1[0] = __expf(accB);
  }
}

#define L_QR   0
#define L_KR   17408
#define L_V    34816
#define L_SGT  44032
#define L_P    61440
#undef  SCAN_GB
#define SCAN_GB 70656

__device__ __forceinline__ int off128(int row, int col) { return row * 272 + col * 2; }
__device__ __forceinline__ int off64(int row, int col) { return row * 144 + col * 2; }

template <int RS>
__device__ __forceinline__ bf16x8 tr_frag(unsigned img_addr, int r0, int c0, int lane) {
  const int g = lane >> 4, q = (lane & 15) >> 2, pp = lane & 3;
  unsigned a = img_addr + (unsigned)((r0 + 8 * g + q) * RS + (c0 + 4 * pp) * 2);
  bf16x4 lo, hi;
  asm volatile("ds_read_b64_tr_b16 %0, %2\n\tds_read_b64_tr_b16 %1, %2 offset:%3\n\ts_waitcnt lgkmcnt(0)"
               : "=&v"(lo), "=&v"(hi) : "v"(a), "n"(4 * RS) : "memory");
  bf16x8 r;
  r[0] = lo[0]; r[1] = lo[1]; r[2] = lo[2]; r[3] = lo[3]; r[4] = hi[0]; r[5] = hi[1]; r[6] = hi[2]; r[7] = hi[3];
  return r;
}

__device__ __forceinline__ bf16x8 scale8(bf16x8 v, float f) {
  bf16x8 o;
#pragma unroll
  for (int x = 0; x < 8; ++x) o[x] = (short)f2bf(bf2f((u16)v[x]) * f);
  return o;
}

__device__ __forceinline__ void lds_barrier() { asm volatile("s_waitcnt lgkmcnt(0)" ::: "memory"); __builtin_amdgcn_s_barrier(); asm volatile("" ::: "memory"); }

template <int branch>
__device__ __forceinline__ void scan_item(const Params& p, int l, int item, char* smem) {
  const int b = (item >> 4) & 7, h = (item >> 2) & 3, slice = item & 3;
  const int tid = opaque_tid(), wid = __builtin_amdgcn_readfirstlane(tid >> 6), lane = tid & 63;
  const int dir = wid >> 2, gw = wid & 3, gt = tid & 255;
  const int fr = lane & 15, fq = lane >> 4;
  char* G = smem + dir * SCAN_GB;
  const unsigned Ga = (unsigned)(size_t)G;
  const u16* S = (const u16*)(p.ws + OFF_S);
  u16* RG = (u16*)(p.ws + OFF_RG);
  const u16* qsrc; unsigned qstride;
  if (branch == 0) { qsrc = S + h * 128; qstride = 4096; }
  else if (dir == 0) { qsrc = S + 2048 + h * 128; qstride = 4096; }
  else { qsrc = (const u16*)(p.ws + OFF_U) + h * 128; qstride = 1024; }
  const int voff = branch * 2048 + 1024 + h * 256 + slice * 64;
  const int ooff = branch * 1024 + h * 256 + slice * 64;
  float lg = 0.f, egc = 1.f;
  if (branch == 0) { lg = __logf(1.f - __expf(p.ret_decay[(l * 2 + dir) * 4 + h])); egc = __expf(32.f * lg); }
  const float* VECS = (const float*)(p.ws + OFF_VECS) + ((size_t)(dir * 544 + b * 68) * 2) * 512 + h * 128;
  f32x4 st[2][4];
#pragma unroll
  for (int m = 0; m < 2; ++m)
#pragma unroll
    for (int n = 0; n < 4; ++n) st[m][n] = (f32x4){0.f, 0.f, 0.f, 0.f};

  const int qj = gt >> 4, qc = gt & 15;
  const int vj = gt >> 3, vc = gt & 7;
  bf16x8 pq[4], pk[4], pv[2];
  float4 peg[2], pel[2];
  auto prefetch = [&](int s) {
    int base, cid;
    if (s < 4) { int cc = dir ? 3 - s : s; base = MLAT + b * 256 + cc * 64; cid = cc; }
    else { int c = s - 4; int cc = dir ? 63 - c : c; base = b * 4096 + cc * 64; cid = 4 + cc; }
#pragma unroll
    for (int i = 0; i < 4; ++i) {
      int jp = qj + 16 * i;
      unsigned ro = (unsigned)(base + (dir ? 63 - jp : jp)) * qstride + qc * 8;
      pq[i] = *(const bf16x8*)(qsrc + ro);
      pk[i] = *(const bf16x8*)(qsrc + ro + 512);
    }
#pragma unroll
    for (int i = 0; i < 2; ++i) {
      int jp = vj + 32 * i;
      pv[i] = *(const bf16x8*)(S + (size_t)(base + (dir ? 63 - jp : jp)) * 4096 + voff + vc * 8);
    }
    if (branch == 1) {
#pragma unroll
      for (int m = 0; m < 2; ++m) {
        int d0 = gw * 32 + m * 16 + fq * 4;
        peg[m] = *(const float4*)(VECS + (size_t)cid * 1024 + d0);
        pel[m] = *(const float4*)(VECS + (size_t)cid * 1024 + 512 + d0);
      }
    }
  };
  prefetch(0);
  __syncthreads();

  for (int s = 0; s < 68; ++s) {
    int base; bool first; bool wout;
    if (s < 4) { int cc = dir ? 3 - s : s; base = MLAT + b * 256 + cc * 64; first = s < 2; wout = (l == 0); }
    else { int c = s - 4; int cc = dir ? 63 - c : c; base = b * 4096 + cc * 64; first = c < 32; wout = true; }
    float4 eg[2], el[2];
#pragma unroll
    for (int m = 0; m < 2; ++m) {
      if (branch == 1) { eg[m] = peg[m]; el[m] = pel[m]; }
      else { eg[m] = make_float4(egc, egc, egc, egc); el[m] = eg[m]; }
    }
#pragma unroll
    for (int i = 0; i < 4; ++i) {
      int jp = qj + 16 * i;
      bf16x8 qv = pq[i], kv_ = pk[i];
      if (branch == 0) {
        float fqs = __expf((float)(jp - 31) * lg), fks = __expf((float)(31 - jp) * lg);
        qv = scale8(qv, fqs); kv_ = scale8(kv_, fks);
      }
      *(bf16x8*)(G + L_QR + off128(jp, qc * 8)) = qv;
      *(bf16x8*)(G + L_KR + off128(jp, qc * 8)) = kv_;
    }
#pragma unroll
    for (int i = 0; i < 2; ++i) *(bf16x8*)(G + L_V + off64(vj + 32 * i, vc * 8)) = pv[i];
#pragma unroll
    for (int m = 0; m < 2; ++m) {
      int d0 = gw * 32 + m * 16 + fq * 4;
#pragma unroll
      for (int n = 0; n < 4; ++n) {
        int e = n * 16 + fr;
        bf16x4 o4;
        o4[0] = (short)f2bf(st[m][n][0] * eg[m].x); o4[1] = (short)f2bf(st[m][n][1] * eg[m].y);
        o4[2] = (short)f2bf(st[m][n][2] * eg[m].z); o4[3] = (short)f2bf(st[m][n][3] * eg[m].w);
        *(bf16x4*)(G + L_SGT + off128(e, d0)) = o4;
      }
    }
    u16 oldv[4][4];
    u16* dstb = RG + (size_t)base * 2048 + ooff + fr;
    if (wout && !first) {
#pragma unroll
      for (int r = 0; r < 4; ++r) {
        int ip = gw * 16 + fq * 4 + r;
        unsigned ro = (unsigned)(dir ? 63 - ip : ip) * 2048u;
#pragma unroll
        for (int n = 0; n < 4; ++n) oldv[r][n] = dstb[ro + n * 16];
      }
    }
    if (s + 1 < 68) prefetch(s + 1);
    lds_barrier();
    f32x4 pt[4], o[4];
#pragma unroll
    for (int n = 0; n < 4; ++n) { pt[n] = (f32x4){0.f, 0.f, 0.f, 0.f}; o[n] = (f32x4){0.f, 0.f, 0.f, 0.f}; }
#pragma unroll
    for (int ks = 0; ks < 4; ++ks) {
      int kc = ks * 32 + fq * 8;
      bf16x8 qa = *(const bf16x8*)(G + L_QR + off128(gw * 16 + fr, kc));
#pragma unroll
      for (int n = 0; n < 4; ++n) {
        bf16x8 ka = *(const bf16x8*)(G + L_KR + off128(n * 16 + fr, kc));
        bf16x8 sb = *(const bf16x8*)(G + L_SGT + off128(n * 16 + fr, kc));
        pt[n] = __builtin_amdgcn_mfma_f32_16x16x32_bf16(ka, qa, pt[n], 0, 0, 0);
        o[n] = __builtin_amdgcn_mfma_f32_16x16x32_bf16(qa, sb, o[n], 0, 0, 0);
      }
    }
    {
      const int ip = gw * 16 + fr;
#pragma unroll
      for (int n = 0; n < 4; ++n) {
        const int j0 = n * 16 + fq * 4;
        bf16x4 w;
#pragma unroll
        for (int r = 0; r < 4; ++r) {
          int jp = j0 + r;
          bool keep = dir ? (ip > jp) : (ip >= jp);
          w[r] = (short)f2bf(keep ? pt[n][r] : 0.f);
        }
        *(bf16x4*)(G + L_P + off64(ip, j0)) = w;
      }
    }
    asm volatile("s_waitcnt lgkmcnt(0)" ::: "memory");
    {
      const int tg = lane >> 4, tq = (lane & 15) >> 2, tp = lane & 3;
      const unsigned ka0 = Ga + L_KR + (unsigned)((8 * tg + tq) * 272 + (gw * 32 + 4 * tp) * 2);
      const unsigned va0 = Ga + L_V + (unsigned)((8 * tg + tq) * 144 + (4 * tp) * 2);
#pragma unroll
      for (int m = 0; m < 2; ++m) {
        f32x4 kv[4];
#pragma unroll
        for (int n = 0; n < 4; ++n) kv[n] = (f32x4){0.f, 0.f, 0.f, 0.f};
#pragma unroll
        for (int ks = 0; ks < 2; ++ks) {
          int kc = ks * 32 + fq * 8;
          bf16x4 r0, r1, r2, r3, r4, r5, r6, r7, r8, r9;
          asm volatile(
              "ds_read_b64_tr_b16 %0, %10\n\tds_read_b64_tr_b16 %1, %10 offset:1088\n\t"
              "ds_read_b64_tr_b16 %2, %11\n\tds_read_b64_tr_b16 %3, %11 offset:576\n\t"
              "ds_read_b64_tr_b16 %4, %11 offset:32\n\tds_read_b64_tr_b16 %5, %11 offset:608\n\t"
              "ds_read_b64_tr_b16 %6, %11 offset:64\n\tds_read_b64_tr_b16 %7, %11 offset:640\n\t"
              "ds_read_b64_tr_b16 %8, %11 offset:96\n\tds_read_b64_tr_b16 %9, %11 offset:672\n\t"
              "s_waitcnt lgkmcnt(0)"
              : "=&v"(r0), "=&v"(r1), "=&v"(r2), "=&v"(r3), "=&v"(r4), "=&v"(r5), "=&v"(r6), "=&v"(r7), "=&v"(r8), "=&v"(r9)
              : "v"(ka0 + (unsigned)(ks * 32 * 272 + m * 32)), "v"(va0 + (unsigned)(ks * 32 * 144))
              : "memory");
          bf16x8 km = __builtin_shufflevector(r0, r1, 0, 1, 2, 3, 4, 5, 6, 7);
          bf16x8 vb[4];
          vb[0] = __builtin_shufflevector(r2, r3, 0, 1, 2, 3, 4, 5, 6, 7);
          vb[1] = __builtin_shufflevector(r4, r5, 0, 1, 2, 3, 4, 5, 6, 7);
          vb[2] = __builtin_shufflevector(r6, r7, 0, 1, 2, 3, 4, 5, 6, 7);
          vb[3] = __builtin_shufflevector(r8, r9, 0, 1, 2, 3, 4, 5, 6, 7);
          bf16x8 pa;
          if (m == 0) pa = *(const bf16x8*)(G + L_P + off64(gw * 16 + fr, kc));
#pragma unroll
          for (int n = 0; n < 4; ++n) {
            if (m == 0) o[n] = __builtin_amdgcn_mfma_f32_16x16x32_bf16(pa, vb[n], o[n], 0, 0, 0);
            kv[n] = __builtin_amdgcn_mfma_f32_16x16x32_bf16(km, vb[n], kv[n], 0, 0, 0);
          }
        }
#pragma unroll
        for (int n = 0; n < 4; ++n) {
          st[m][n][0] = eg[m].x * el[m].x * st[m][n][0] + el[m].x * kv[n][0];
          st[m][n][1] = eg[m].y * el[m].y * st[m][n][1] + el[m].y * kv[n][1];
          st[m][n][2] = eg[m].z * el[m].z * st[m][n][2] + el[m].z * kv[n][2];
          st[m][n][3] = eg[m].w * el[m].w * st[m][n][3] + el[m].w * kv[n][3];
        }
      }
    }
    if (wout) {
#pragma unroll
      for (int r = 0; r < 4; ++r) {
        int ip = gw * 16 + fq * 4 + r;
        unsigned ro = (unsigned)(dir ? 63 - ip : ip) * 2048u;
#pragma unroll
        for (int n = 0; n < 4; ++n) {
          float v = o[n][r];
          if (!first) v += bf2f(oldv[r][n]);
          dstb[ro + n * 16] = f2bf(v);
        }
      }
    }
    __syncthreads();
  }
}

#define NPHASE 18
__device__ __forceinline__ void run_phase(const Params& p, int ph, char* smem) {
  const int nblk = gridDim.x, bid = blockIdx.x;
  if (ph == 0) {
#ifdef REP_P0
    for (int rep = 0; rep < REP_P0; ++rep)
#endif
    for (int u = bid; u < WT_UNITS + 96 + 1; u += nblk) {
      if (u < 96) mod_unit(p, u, smem);
      else if (u == 96) rot_unit(p);
      else wt_unit(p, 0, u - 97, smem);
    }
    return;
  }
  if (ph == NPHASE - 1) { phase_final(p); return; }
  const int l = (ph - 1) / 8, sp = (ph - 1) % 8;
  PG8_LAS unsigned char* lds = (PG8_LAS unsigned char*)smem;
  switch (sp) {
    case 0:
      phase_u(p, l);
      if (l == 1) for (int u = bid; u < WT_UNITS; u += nblk) wt_unit(p, 1, u, smem);
      break;
    case 1: {
      pg8::Gemm g{(const u16*)(p.ws + OFF_U), (const u16*)(p.ws + OFF_WT) + (size_t)WT_SCAN * 1024, 1024, MTOT, 4096, 1024};
      pg8::StaticOrder S; S.init(g.M, g.N, nblk, bid);
      EpiScanIn E{(u16*)(p.ws + OFF_S), (const float*)(p.ws + OFF_ROT)};
      pg8::gemm_phase(lds, g, S, E, opaque_tid());
    } break;
    case 2: for (int t = bid; t < 1088; t += nblk) gla_prepass_unit(p, l, t, smem); break;
    case 3:
#ifdef REP_SCAN
      for (int rep = 0; rep < REP_SCAN; ++rep)
#endif
      for (int t = bid; t < 256; t += nblk) { if (t < 128) scan_item<0>(p, l, t, smem); else scan_item<1>(p, l, t, smem); } break;
    case 4:
      phase_u(p, l);
      phase_stats(p, l);
      break;
    case 5: {
      pg8::Gemm g{(const u16*)(p.ws + OFF_U), (const u16*)(p.ws + OFF_WT) + (size_t)WT_GATE * 1024, 1024, l == 0 ? MTOT : MLAT, 4096, 1024};
      pg8::StaticOrder S; S.init(g.M, g.N, nblk, bid);
      EpiGate E{(const u16*)(p.ws + OFF_RG), (const float*)(p.ws + OFF_STATS), (u16*)(p.ws + OFF_S), p.ret_norm_gain + l * 1024, p.gla_norm_gain + l * 1024};
      pg8::gemm_phase(lds, g, S, E, opaque_tid());
    } break;
    case 6: {
#pragma unroll 1
      for (int pass = 0; pass < 2; ++pass) {
        pg8::Gemm g{(const u16*)(p.ws + OFF_S) + 2048 + pass * 1024, (const u16*)(p.ws + OFF_WT) + (size_t)(WT_BRR + pass * 1024) * 1024, 4096, l == 0 ? MTOT : MLAT, 1024, 1024};
        pg8::StaticOrder S; S.init(g.M, g.N, nblk, bid);
        EpiMerge E{(const u16*)(p.ws + OFF_S), (u16*)(p.ws + OFF_U), pass};
        pg8::gemm_phase(lds, g, S, E, opaque_tid());
      }
    } break;
    case 7: {
      pg8::Gemm g{(const u16*)(p.ws + OFF_U), (const u16*)(p.ws + OFF_WT) + (size_t)WT_OUT * 1024, 1024, l == 0 ? MTOT : MLAT, 1024, 1024};
      pg8::StaticOrder S; S.init(g.M, g.N, nblk, bid);
      EpiOut E{l == 0 ? p.x : p.out, p.ctx, p.out, (float*)(p.ws + OFF_HCTX), (const float*)(p.ws + OFF_MOD) + (size_t)l * 9 * 3072};
      pg8::gemm_phase(lds, g, S, E, opaque_tid());
    } break;
  }
}

__device__ __forceinline__ void grid_barrier(unsigned* cnt, unsigned target) {
  asm volatile("s_waitcnt vmcnt(0)" ::: "memory");
  __syncthreads();
  if (threadIdx.x == 0) {
    __threadfence();
    __hip_atomic_fetch_add(cnt, 1u, __ATOMIC_RELAXED, __HIP_MEMORY_SCOPE_AGENT);
    while (__hip_atomic_load(cnt, __ATOMIC_RELAXED, __HIP_MEMORY_SCOPE_AGENT) < target) __builtin_amdgcn_s_sleep(2);
    __threadfence();
  }
  __syncthreads();
}

__global__ void __launch_bounds__(NTHREADS) mega(Params p, int ph_lo, int ph_hi, int coop) {
  extern __shared__ __attribute__((aligned(16))) char smem[];
  for (int ph = ph_lo; ph < ph_hi; ++ph) {
    run_phase(p, ph, smem);
    if (coop && ph + 1 < ph_hi) {
      if (ph == ph_lo) cg::this_grid().sync();
      else grid_barrier((unsigned*)(p.ws + OFF_BAR), (unsigned)(ph - ph_lo) * gridDim.x);
    }
  }
}

extern "C" void kernel_launch(void* const* d_in, const int* in_sizes, int n_in,
                              void* d_out, int out_size, void* d_ws, size_t ws_size,
                              hipStream_t stream) {
  Params p{};
  p.x = (const float*)d_in[0]; p.c = (const float*)d_in[1]; p.ctx = (const float*)d_in[2]; p.c_ctx = (const float*)d_in[3];
  p.norm_gain = (const float*)d_in[4]; p.w_ada = (const float*)d_in[5]; p.b_ada = (const float*)d_in[6]; p.w_in = (const float*)d_in[7];
  p.ret_decay = (const float*)d_in[8]; p.gla_w_up = (const float*)d_in[9]; p.gla_b_up = (const float*)d_in[10];
  p.ret_norm_gain = (const float*)d_in[11]; p.gla_norm_gain = (const float*)d_in[12];
  p.w_br_ret = (const float*)d_in[13]; p.w_br_gla = (const float*)d_in[14]; p.w_out = (const float*)d_in[15]; p.final_gain = (const float*)d_in[16];
  p.out = (float*)d_out; p.ws = (char*)d_ws;
  static int grid_blocks = 0;
  if (!grid_blocks) {
    hipFuncSetAttribute((const void*)mega, hipFuncAttributeMaxDynamicSharedMemorySize, LDS_BYTES);
    int dev = 0, cus = 0, per_cu = 0;
    hipGetDevice(&dev);
    hipDeviceGetAttribute(&cus, hipDeviceAttributeMultiprocessorCount, dev);
    hipOccupancyMaxActiveBlocksPerMultiprocessor(&per_cu, mega, NTHREADS, LDS_BYTES);
    if (per_cu < 1) per_cu = 1;
    grid_blocks = cus * 1;
  }
#ifdef MULTI_LAUNCH
  for (int ph = 0; ph < NPHASE; ++ph) {
    mega<<<dim3(grid_blocks), dim3(NTHREADS), LDS_BYTES, stream>>>(p, ph, ph + 1, 0);
  }
#else
  hipMemsetAsync((char*)d_ws + OFF_BAR, 0, 256, stream);
  int lo = 0, hi = NPHASE, coop = 1;
  void* args[] = {&p, &lo, &hi, &coop};
  hipError_t e = hipLaunchCooperativeKernel((void*)mega, dim3(grid_blocks), dim3(NTHREADS), args, LDS_BYTES, stream);
  if (e != hipSuccess) fprintf(stderr, "cooperative launch failed: %s (grid %d)\n", hipGetErrorString(e), grid_blocks);
#endif
}
```

```cpp
#include <hip/hip_runtime.h>
#include <hip/hip_cooperative_groups.h>
#include <cstdio>
namespace cg = cooperative_groups;

typedef unsigned short u16;
using bf16x8 = __attribute__((ext_vector_type(8))) short;
using bf16x4 = __attribute__((ext_vector_type(4))) short;
using f32x4  = __attribute__((ext_vector_type(4))) float;

#define NTHREADS 512
#define DM 1024
#define NB 8
#define SEQL 4096
#define CTXL 256
#define MLAT 32768
#define MCTX 2048
#define MTOT 34816
#define INW 8208

#define OFF_S    0ull
#define OFF_RG   (OFF_S   + (size_t)MTOT * 4096 * 2)
#define OFF_U    (OFF_RG  + (size_t)MTOT * 2048 * 2)
#define OFF_WT   (OFF_U   + (size_t)MTOT * 1024 * 2)
#define WT_ROWS  11392
#define OFF_GLR  (OFF_WT  + (size_t)WT_ROWS * 1024 * 2)
#define OFF_HCTX (OFF_GLR + (size_t)MTOT * 16 * 4)
#define OFF_MOD  (OFF_HCTX+ (size_t)MCTX * 1024 * 4)
#define OFF_ROT  (OFF_MOD + (size_t)2 * 9 * 3072 * 4)
#define OFF_BAR  (OFF_ROT + (size_t)64 * 32 * 2 * 4)
#define OFF_END  (OFF_BAR + 256)

#define WT_SCAN 0
#define WT_GATE 4224
#define WT_BRR  8320
#define WT_BRG  9344
#define WT_OUT  10368

#define LDS_BYTES 161792
#define SCAN_GB   80896

struct Params {
  const float* x; const float* c; const float* ctx; const float* c_ctx;
  const float* norm_gain; const float* w_ada; const float* b_ada; const float* w_in;
  const float* ret_decay; const float* gla_w_up; const float* gla_b_up;
  const float* ret_norm_gain; const float* gla_norm_gain;
  const float* w_br_ret; const float* w_br_gla; const float* w_out; const float* final_gain;
  float* out; char* ws;
};

__device__ __forceinline__ u16 f2bf(float f) {
  __bf16 h = (__bf16)f;
  return *(u16*)&h;
}
__device__ __forceinline__ float bf2f(u16 h) { return __uint_as_float(((unsigned)h) << 16); }
__device__ __forceinline__ float sigmoidf_(float x) { return __builtin_amdgcn_rcpf(1.f + __expf(-x)); }
__device__ __forceinline__ float siluf_(float x) { return x * __builtin_amdgcn_rcpf(1.f + __expf(-x)); }

__device__ __forceinline__ int opaque_tid() { int t = threadIdx.x; asm volatile("" : "+v"(t)); return t; }

__device__ __forceinline__ float wave_sum(float v) {
#pragma unroll
  for (int o = 32; o > 0; o >>= 1) v += __shfl_xor(v, o, 64);
  return v;
}

__device__ __forceinline__ const float* wt_src(const Params& p, int l, int n, int& ld) {
  if (n < WT_GATE) {
    int tile = n >> 7, cc = n & 127;
    int col;
    if (tile < 8) {
      int d = (cc & 64) | ((cc & 16) << 1) | ((cc & 32) >> 1) | (cc & 15);
      col = tile * 128 + d;
    } else if (tile < 16) col = 1024 + (tile - 8) * 128 + cc;
    else if (tile < 24) col = 3072 + (tile - 16) * 128 + cc;
    else if (tile < 32) col = 4096 + (tile - 24) * 128 + cc;
    else { if (cc >= 16) { ld = 0; return nullptr; } col = 6144 + cc; }
    ld = INW; return p.w_in + (size_t)l * DM * INW + col;
  } else if (n < WT_BRR) {
    int g = n - WT_GATE; int col;
    if (g < 1024) col = 2048 + g;
    else if (g < 2048) col = 5120 + (g - 1024);
    else if (g < 3072) col = 6160 + (g - 2048);
    else col = 7184 + (g - 3072);
    ld = INW; return p.w_in + (size_t)l * DM * INW + col;
  } else if (n < WT_BRG) { ld = DM; return p.w_br_ret + (size_t)l * DM * DM + (n - WT_BRR); }
  else if (n < WT_OUT)   { ld = DM; return p.w_br_gla + (size_t)l * DM * DM + (n - WT_BRG); }
  else                   { ld = DM; return p.w_out    + (size_t)l * DM * DM + (n - WT_OUT); }
}

#define WT_UNITS (178 * 16)
__device__ __forceinline__ void wt_unit(const Params& p, int l, int unit, char* smem) {
  float* tile = (float*)smem;
  int nb = unit >> 4, kb = unit & 15;
  int tid = opaque_tid();
  int n0 = nb * 64, k0 = kb * 64;
  {
    int nl = tid & 63, kq = tid >> 6;
    int ld; const float* src = wt_src(p, l, n0 + nl, ld);
#pragma unroll
    for (int i = 0; i < 8; ++i) {
      int kl = kq + 8 * i;
      float v = src ? src[(size_t)(k0 + kl) * ld] : 0.f;
      tile[kl * 65 + nl] = v;
    }
  }
  __syncthreads();
  {
    int nl = tid >> 3, kq = tid & 7;
    bf16x8 o;
#pragma unroll
    for (int j = 0; j < 8; ++j) o[j] = (short)f2bf(tile[(kq * 8 + j) * 65 + nl]);
    u16* wt = (u16*)(p.ws + OFF_WT);
    *(bf16x8*)(wt + (size_t)(n0 + nl) * 1024 + k0 + kq * 8) = o;
  }
  __syncthreads();
}

__device__ __forceinline__ void mod_unit(const Params& p, int unit, char* smem) {
  float* sc = (float*)smem;
  float* red = sc + 9 * 1024;
  int l = unit / 48, jb = unit % 48;
  int tid = opaque_tid();
  for (int i = tid; i < 9 * 1024; i += NTHREADS) {
    int r = i >> 10, k = i & 1023;
    float v = (r < 8) ? p.c[r * 1024 + k] : p.c_ctx[k];
    sc[i] = siluf_(v);
  }
  __syncthreads();
  int jl = tid & 63, kg = tid >> 6;
  int j = jb * 64 + jl;
  float acc[9];
#pragma unroll
  for (int r = 0; r < 9; ++r) acc[r] = 0.f;
  const float* w = p.w_ada + (size_t)l * DM * 3072 + j;
#pragma unroll 16
  for (int k = kg * 128; k < kg * 128 + 128; ++k) {
    float wv = w[(size_t)k * 3072];
#pragma unroll
    for (int r = 0; r < 9; ++r) acc[r] += sc[r * 1024 + k] * wv;
  }
#pragma unroll
  for (int r = 0; r < 9; ++r) red[(kg * 9 + r) * 64 + jl] = acc[r];
  __syncthreads();
  float* mod = (float*)(p.ws + OFF_MOD);
  for (int i = tid; i < 9 * 64; i += NTHREADS) {
    int r = i >> 6, jj = i & 63;
    float s = 0.f;
#pragma unroll
    for (int g = 0; g < 8; ++g) s += red[(g * 9 + r) * 64 + jj];
    mod[((size_t)l * 9 + r) * 3072 + jb * 64 + jj] = s + p.b_ada[l * 3072 + jb * 64 + jj];
  }
  __syncthreads();
}

__device__ __forceinline__ void rot_unit(const Params& p) {
  float* rot = (float*)(p.ws + OFF_ROT);
  for (int i = opaque_tid(); i < 64 * 32; i += NTHREADS) {
    int pos = i >> 5, f = i & 31;
    float inv = exp2f(-(float)f * (13.287712379549449f / 32.f));
    float ang = (float)pos * inv;
    rot[i * 2] = __cosf(ang);
    rot[i * 2 + 1] = __sinf(ang);
  }
}

__device__ __forceinline__ void phase_u(const Params& p, int l) {
  const int tid = opaque_tid(); int wave = tid >> 6, lane = tid & 63;
  const float* mod = (const float*)(p.ws + OFF_MOD) + (size_t)l * 9 * 3072;
  const float* gain = p.norm_gain + l * DM;
  u16* U = (u16*)(p.ws + OFF_U);
  for (int row = (blockIdx.x * 8 + wave) * 4; row < MTOT; row += gridDim.x * 32) {
    const float* h; int r;
    if (row < MLAT) { h = (l == 0 ? p.x : p.out) + (size_t)row * DM; r = row >> 12; }
    else { int cr = row - MLAT; h = (l == 0 ? p.ctx : (const float*)(p.ws + OFF_HCTX)) + (size_t)cr * DM; r = 8; }
    float4 v[4][4]; float ss[4];
#pragma unroll
    for (int q = 0; q < 4; ++q) {
      ss[q] = 0.f;
#pragma unroll
      for (int i = 0; i < 4; ++i) v[q][i] = *(const float4*)(h + q * DM + i * 256 + lane * 4);
    }
#pragma unroll
    for (int q = 0; q < 4; ++q) {
#pragma unroll
      for (int i = 0; i < 4; ++i) ss[q] += v[q][i].x * v[q][i].x + v[q][i].y * v[q][i].y + v[q][i].z * v[q][i].z + v[q][i].w * v[q][i].w;
      ss[q] = rsqrtf(wave_sum(ss[q]) * (1.f / 1024.f) + 1e-6f);
    }
    const float* sh = mod + r * 3072;
#pragma unroll
    for (int i = 0; i < 4; ++i) {
      int cidx = i * 256 + lane * 4;
      float4 g = *(const float4*)(gain + cidx);
      float4 s = *(const float4*)(sh + cidx);
      float4 sc = *(const float4*)(sh + 1024 + cidx);
      g.x *= (1.f + sc.x); g.y *= (1.f + sc.y); g.z *= (1.f + sc.z); g.w *= (1.f + sc.w);
#pragma unroll
      for (int q = 0; q < 4; ++q) {
        bf16x4 o;
        o[0] = (short)f2bf(v[q][i].x * ss[q] * g.x + s.x);
        o[1] = (short)f2bf(v[q][i].y * ss[q] * g.y + s.y);
        o[2] = (short)f2bf(v[q][i].z * ss[q] * g.z + s.z);
        o[3] = (short)f2bf(v[q][i].w * ss[q] * g.w + s.w);
        *(bf16x4*)(U + (size_t)(row + q) * DM + cidx) = o;
      }
    }
  }
}

__device__ __forceinline__ void phase_final(const Params& p) {
  const int tid = opaque_tid(); int wave = tid >> 6, lane = tid & 63;
  for (int row = (blockIdx.x * 8 + wave) * 4; row < MLAT; row += gridDim.x * 32) {
    float* h = p.out + (size_t)row * DM;
    float4 v[4][4]; float ss[4];
#pragma unroll
    for (int q = 0; q < 4; ++q) {
      ss[q] = 0.f;
#pragma unroll
      for (int i = 0; i < 4; ++i) v[q][i] = *(const float4*)(h + q * DM + i * 256 + lane * 4);
    }
#pragma unroll
    for (int q = 0; q < 4; ++q) {
#pragma unroll
      for (int i = 0; i < 4; ++i) ss[q] += v[q][i].x * v[q][i].x + v[q][i].y * v[q][i].y + v[q][i].z * v[q][i].z + v[q][i].w * v[q][i].w;
      ss[q] = rsqrtf(wave_sum(ss[q]) * (1.f / 1024.f) + 1e-6f);
    }
#pragma unroll
    for (int i = 0; i < 4; ++i) {
      int cidx = i * 256 + lane * 4;
      float4 g = *(const float4*)(p.final_gain + cidx);
#pragma unroll
      for (int q = 0; q < 4; ++q) {
        float4 o;
        o.x = v[q][i].x * ss[q] * g.x; o.y = v[q][i].y * ss[q] * g.y; o.z = v[q][i].z * ss[q] * g.z; o.w = v[q][i].w * ss[q] * g.w;
        *(float4*)(h + q * DM + cidx) = o;
      }
    }
  }
}

#define PG8_LAS __attribute__((address_space(3)))
typedef unsigned u32x4 __attribute__((ext_vector_type(4)));
namespace pg8 {
constexpr int BM = 256, BK = 64, HALF = 128, HTB = HALF * BK * 2, STAGE_BYTES = 8 * HTB, NXCD = 8, WGM = 8;
__device__ __forceinline__ int lds_byte(int r, int c) { const int st = (r >> 4) * 2 + (c >> 5), rr = r & 15, cc = c & 31, ob = rr * 64 + cc * 2; return st * 1024 + (ob ^ (((ob >> 9) & 1) << 5)); }
__device__ __forceinline__ void stage_rc(int b, int& R, int& C) { const int st = b / 1024, sb = b % 1024, swz = sb ^ (((sb >> 9) & 1) << 5); R = (st >> 1) * 16 + swz / 64; C = (st & 1) * 32 + (swz % 64) / 2; }
__device__ __forceinline__ int perm32(int rho) { const int n = rho >> 4, i = rho & 15; return 8 * (i >> 2) + 4 * n + (i & 3); }
struct Unit { int pm, pn; };
struct Gemm { const u16* A; const u16* Bt; int lda; int M, N, K; };
struct StaticOrder {
  int nM, nN, nwg, G, c;
  __device__ void init(int M, int N, int G_, int c_) { nM = M / BM; nN = N / BM; nwg = nM * nN; G = G_; c = c_; }
  __device__ bool next(int i, Unit& u) const {
    const long L = (long)i * G + c; if (L >= nwg) return false;
    int wgid = (int)L; { const int q = nwg / NXCD, r = nwg % NXCD, xcd = wgid % NXCD, off = wgid / NXCD; wgid = (xcd < r ? xcd * (q + 1) : r * (q + 1) + (xcd - r) * q) + off; }
    const int nig = WGM * nN, gid = wgid / nig, fm = gid * WGM, gsz = (nM - fm) < WGM ? (nM - fm) : WGM;
    u.pm = fm + ((wgid % nig) % gsz); u.pn = (wgid % nig) / gsz; return true;
  }
};
typedef __attribute__((ext_vector_type(2))) float cvt_f2_t;
typedef __attribute__((ext_vector_type(2))) __bf16 cvt_b2_t;
__device__ __forceinline__ unsigned cvt_pk_bf16(float lo, float hi) { cvt_f2_t f = {lo, hi}; cvt_b2_t r = __builtin_convertvector(f, cvt_b2_t); return __builtin_bit_cast(unsigned, r); }

template <class Epi>
__device__ __forceinline__ void gemm_phase(PG8_LAS unsigned char* lds, const Gemm g, const StaticOrder& S, const Epi& E, const int tid) {
  const int wid = __builtin_amdgcn_readfirstlane(tid >> 6), lane = tid & 63, wr = wid >> 2, wc = wid & 3, fr = lane & 15, fq = lane >> 4;
  const int K = g.K, nt = K / BK;
  unsigned voffA[2], voffB[2];
#pragma unroll
  for (int i = 0; i < 2; ++i) { int R, C; stage_rc(tid * 16 + i * 8192, R, C); const int Rb = Epi::PERM ? ((R & ~31) + perm32(R & 31)) : R;
    voffA[i] = (unsigned)(R * g.lda + C) * 2u; voffB[i] = (unsigned)(Rb * K + C) * 2u; }
  const size_t kstep = (size_t)(BK * 2);
  const size_t hstepA = (size_t)HALF * g.lda * 2, hstepB = (size_t)HALF * K * 2;
  const size_t tstepA = 2 * hstepA, tstepB = 2 * hstepB;
  const unsigned ldsw = (unsigned)wid * 1024u;
  const int aoff = lds_byte(wr * 64 + fr, fq * 8), boff = lds_byte(wc * 32 + fr, fq * 8);
#define PG8_SA(b, h) (((b) * 2 + (h)) * HTB)
#define PG8_SB(b, h) ((4 + (b) * 2 + (h)) * HTB)
#define PG8_STAGE(bufoff, gbase, voff) do { _Pragma("unroll") for (int _i = 0; _i < 2; ++_i) \
    __builtin_amdgcn_global_load_lds((const unsigned*)((const char*)(gbase) + (voff)[_i]), (PG8_LAS unsigned*)(lds + (bufoff) + ldsw + _i * 8192), 16, 0, 0); } while (0)
#define PG8_LDA(dst, b, h) do { _Pragma("unroll") for (int m = 0; m < 4; ++m) _Pragma("unroll") for (int k = 0; k < 2; ++k) dst[m][k] = *(const PG8_LAS bf16x8*)(lds + PG8_SA(b, h) + aoff + m * 2048 + k * 1024); } while (0)
#define PG8_LDB(dst, b, h) do { _Pragma("unroll") for (int n = 0; n < 2; ++n) _Pragma("unroll") for (int k = 0; k < 2; ++k) dst[n][k] = *(const PG8_LAS bf16x8*)(lds + PG8_SB(b, h) + boff + n * 2048 + k * 1024); } while (0)
#define PG8_MMA(ai, bj, At, Bt) do { __builtin_amdgcn_s_setprio(1); _Pragma("unroll") for (int m = 0; m < 4; ++m) _Pragma("unroll") for (int n = 0; n < 2; ++n) _Pragma("unroll") for (int k = 0; k < 2; ++k) \
    acc[ai][bj][m][n] = __builtin_amdgcn_mfma_f32_16x16x32_bf16(Bt[n][k], At[m][k], acc[ai][bj][m][n], 0, 0, 0); __builtin_amdgcn_s_setprio(0); } while (0)
#define PG8_WAIT_V(n) asm volatile("s_waitcnt vmcnt(" #n ")" ::: "memory")
#define PG8_WAIT_L(n) asm volatile("s_waitcnt lgkmcnt(" #n ")" ::: "memory")
#define PG8_BAR __builtin_amdgcn_s_barrier()
#define PG8_SCHED __builtin_amdgcn_sched_barrier(0)
  Unit cur, nxt; int ui = 0;
  if (!S.next(0, cur)) return;
  f32x4 acc[2][2][4][2];
#pragma unroll
  for (int a = 0; a < 2; ++a)
#pragma unroll
    for (int b = 0; b < 2; ++b)
#pragma unroll
      for (int m = 0; m < 4; ++m)
#pragma unroll
        for (int n = 0; n < 2; ++n) acc[a][b][m][n] = (f32x4){0.f, 0.f, 0.f, 0.f};
  bf16x8 At[4][2], B0[2][2], B1[2][2];
  const char* cA = (const char*)g.A + (size_t)cur.pm * tstepA; const char* cB = (const char*)g.Bt + (size_t)cur.pn * tstepB;
  PG8_STAGE(PG8_SB(0, 0), cB, voffB); PG8_STAGE(PG8_SA(0, 0), cA, voffA); PG8_STAGE(PG8_SB(0, 1), cB + hstepB, voffB); PG8_STAGE(PG8_SA(0, 1), cA + hstepA, voffA);
  if (wr == 1) PG8_BAR;
  PG8_WAIT_V(4); PG8_BAR;
  PG8_STAGE(PG8_SB(1, 0), cB + kstep, voffB); PG8_STAGE(PG8_SA(1, 0), cA + kstep, voffA); PG8_STAGE(PG8_SB(1, 1), cB + hstepB + kstep, voffB);
  PG8_WAIT_V(6); PG8_BAR;
  for (;;) {
    const bool has_next = S.next(ui + 1, nxt);
    const char* nA = has_next ? (const char*)g.A + (size_t)nxt.pm * tstepA : cA; const char* nB = has_next ? (const char*)g.Bt + (size_t)nxt.pn * tstepB : cB;
    for (int t = 0; t < nt; t += 2) {
      const bool last = (t == nt - 2);
      const char* a1 = cA + (size_t)(t + 1) * kstep;
      const char* a2 = last ? nA : cA + (size_t)(t + 2) * kstep; const char* b2 = last ? nB : cB + (size_t)(t + 2) * kstep;
      const char* a3 = a2 + kstep; const char* b3 = b2 + kstep;
      PG8_LDB(B0, 0, 0); PG8_SCHED; PG8_LDA(At, 0, 0); PG8_STAGE(PG8_SA(1, 1), a1 + hstepA, voffA);
      PG8_WAIT_L(8); PG8_BAR; PG8_WAIT_L(0); PG8_MMA(0, 0, At, B0); PG8_BAR; PG8_SCHED;
      PG8_LDB(B1, 0, 1); PG8_STAGE(PG8_SB(0, 0), b2, voffB);
      PG8_BAR; PG8_WAIT_L(0); PG8_MMA(0, 1, At, B1); PG8_BAR;
      PG8_LDA(At, 0, 1); PG8_STAGE(PG8_SA(0, 0), a2, voffA);
      PG8_BAR; PG8_WAIT_L(0); PG8_MMA(1, 0, At, B0); PG8_BAR; PG8_SCHED;
      PG8_STAGE(PG8_SB(0, 1), b2 + hstepB, voffB);
      PG8_WAIT_V(6); PG8_BAR; PG8_MMA(1, 1, At, B1); PG8_BAR;
      PG8_LDB(B0, 1, 0); PG8_SCHED; PG8_LDA(At, 1, 0); PG8_STAGE(PG8_SA(0, 1), a2 + hstepA, voffA);
      PG8_WAIT_L(8); PG8_BAR; PG8_WAIT_L(0); PG8_MMA(0, 0, At, B0); PG8_BAR; PG8_SCHED;
      PG8_LDB(B1, 1, 1); PG8_STAGE(PG8_SB(1, 0), b3, voffB);
      PG8_BAR; PG8_WAIT_L(0); PG8_MMA(0, 1, At, B1); PG8_BAR;
      PG8_LDA(At, 1, 1); PG8_STAGE(PG8_SA(1, 0), a3, voffA);
      PG8_BAR; PG8_WAIT_L(0); PG8_MMA(1, 0, At, B0); PG8_BAR; PG8_SCHED;
      PG8_STAGE(PG8_SB(1, 1), b3 + hstepB, voffB);
      PG8_WAIT_V(6); PG8_BAR; PG8_MMA(1, 1, At, B1); PG8_BAR;
    }
    E(acc, cur, wr, wc, fr, fq, lane);
    if (!has_next) break;
#pragma unroll
    for (int a = 0; a < 2; ++a)
#pragma unroll
      for (int b = 0; b < 2; ++b)
#pragma unroll
        for (int m = 0; m < 4; ++m)
#pragma unroll
          for (int n = 0; n < 2; ++n) acc[a][b][m][n] = (f32x4){0.f, 0.f, 0.f, 0.f};
    cur = nxt; cA = nA; cB = nB; ++ui;
  }
  PG8_WAIT_V(0);
  if (wr == 0) PG8_BAR;
  PG8_BAR;
#undef PG8_SA
#undef PG8_SB
#undef PG8_STAGE
#undef PG8_LDA
#undef PG8_LDB
#undef PG8_MMA
#undef PG8_WAIT_V
#undef PG8_WAIT_L
#undef PG8_BAR
#undef PG8_SCHED
}
}

#define OFF_STATS OFF_GLR

__device__ __forceinline__ u32x4 pack8v(const f32x4& a, const f32x4& b) {
  u32x4 w; w.x = pg8::cvt_pk_bf16(a[0], a[1]); w.y = pg8::cvt_pk_bf16(a[2], a[3]); w.z = pg8::cvt_pk_bf16(b[0], b[1]); w.w = pg8::cvt_pk_bf16(b[2], b[3]); return w;
}
__device__ __forceinline__ float xlane32(float v, int lane) { return __int_as_float(__builtin_amdgcn_ds_bpermute((lane ^ 32) << 2, __float_as_int(v))); }

struct EpiScanIn {
  static constexpr bool PERM = true;
  u16* S; const float* rot;
  __device__ __forceinline__ void operator()(const f32x4 (&acc)[2][2][4][2], const pg8::Unit& u, int wr, int wc, int fr, int fq, int lane) const {
    u16* Sb = S + (size_t)u.pm * 256 * 4096;
    unsigned rl0 = wr * 64 + fr; asm volatile("" : "+v"(rl0));
#pragma unroll
    for (int bj = 0; bj < 2; ++bj) {
      const int nt128 = u.pn * 2 + bj;
      const bool scaled = (nt128 < 4) || (nt128 >= 16 && nt128 < 20);
      const float scl = scaled ? 0.08838834764831845f : 1.f;
      const unsigned cb = nt128 * 128 + wc * 32 + fq * 8;
      if (nt128 < 8 && u.pm < 128) {
        const int tb = (u.pm & 15) * 256;
        const int fo = ((wc & 1) * 16 + (fq & 1) * 8) * 2;
        const float sgn = (fq >> 1) ? 1.f : -1.f;
#pragma unroll
        for (int ai = 0; ai < 2; ++ai)
#pragma unroll
          for (int m = 0; m < 4; ++m) {
            const unsigned rl = rl0 + ai * 128 + m * 16;
            const int t = tb + rl;
            const unsigned pos = (wc >> 1) == 0 ? (t >> 6) : (t & 63);
            const float* rp = rot + pos * 64u + fo;
            const float4 c0 = *(const float4*)rp, c1 = *(const float4*)(rp + 4), c2 = *(const float4*)(rp + 8), c3 = *(const float4*)(rp + 12);
            const f32x4 v0 = acc[ai][bj][m][0], v1 = acc[ai][bj][m][1];
            f32x4 p0, p1;
#pragma unroll
            for (int j = 0; j < 4; ++j) { p0[j] = xlane32(v0[j], lane); p1[j] = xlane32(v1[j], lane); }
            f32x4 o0, o1;
            o0[0] = (v0[0] * c0.x + sgn * p0[0] * c0.y) * scl; o0[1] = (v0[1] * c0.z + sgn * p0[1] * c0.w) * scl;
            o0[2] = (v0[2] * c1.x + sgn * p0[2] * c1.y) * scl; o0[3] = (v0[3] * c1.z + sgn * p0[3] * c1.w) * scl;
            o1[0] = (v1[0] * c2.x + sgn * p1[0] * c2.y) * scl; o1[1] = (v1[1] * c2.z + sgn * p1[1] * c2.w) * scl;
            o1[2] = (v1[2] * c3.x + sgn * p1[2] * c3.y) * scl; o1[3] = (v1[3] * c3.z + sgn * p1[3] * c3.w) * scl;
            *(u32x4*)(Sb + rl * 4096u + cb) = pack8v(o0, o1);
            __builtin_amdgcn_sched_barrier(0);
          }
      } else {
#pragma unroll
        for (int ai = 0; ai < 2; ++ai)
#pragma unroll
          for (int m = 0; m < 4; ++m) {
            const unsigned rl = rl0 + ai * 128 + m * 16;
            *(u32x4*)(Sb + rl * 4096u + cb) = pack8v(acc[ai][bj][m][0] * scl, acc[ai][bj][m][1] * scl);
            __builtin_amdgcn_sched_barrier(0);
          }
      }
    }
  }
};

struct EpiGate {
  static constexpr bool PERM = true;
  const u16* RG; const float* stats; u16* S; const float* rgain; const float* ggain;
  __device__ __forceinline__ void operator()(const f32x4 (&acc)[2][2][4][2], const pg8::Unit& u, int wr, int wc, int fr, int fq, int lane) const {
    u16* Sb = S + (size_t)u.pm * 256 * 4096;
    unsigned rl0 = wr * 64 + fr; asm volatile("" : "+v"(rl0));
    if (u.pn < 8) {
      const int branch = u.pn >> 2, head = u.pn & 3;
      const u16* RGb = RG + (size_t)u.pm * 256 * 2048 + branch * 1024;
      const float* stb = stats + (size_t)u.pm * 256 * 16 + (branch * 4 + head) * 2;
      const float* gain = branch ? ggain : rgain;
#pragma unroll
      for (int bj = 0; bj < 2; ++bj) {
        const unsigned cb = head * 256 + bj * 128 + wc * 32 + fq * 8;
        const float4 g0 = *(const float4*)(gain + cb), g1 = *(const float4*)(gain + cb + 4);
#pragma unroll
        for (int ai = 0; ai < 2; ++ai)
#pragma unroll
          for (int m = 0; m < 4; ++m) {
            const unsigned rl = rl0 + ai * 128 + m * 16;
            const float2 st = *(const float2*)(stb + rl * 16u);
            const bf16x8 xr = *(const bf16x8*)(RGb + rl * 2048u + cb);
            f32x4 v0 = acc[ai][bj][m][0], v1 = acc[ai][bj][m][1];
            asm volatile("" : "+v"(v0), "+v"(v1));
            f32x4 o0, o1;
            o0[0] = (bf2f((u16)xr[0]) * st.x + st.y) * g0.x * siluf_(v0[0]); o0[1] = (bf2f((u16)xr[1]) * st.x + st.y) * g0.y * siluf_(v0[1]);
            o0[2] = (bf2f((u16)xr[2]) * st.x + st.y) * g0.z * siluf_(v0[2]); o0[3] = (bf2f((u16)xr[3]) * st.x + st.y) * g0.w * siluf_(v0[3]);
            o1[0] = (bf2f((u16)xr[4]) * st.x + st.y) * g1.x * siluf_(v1[0]); o1[1] = (bf2f((u16)xr[5]) * st.x + st.y) * g1.y * siluf_(v1[1]);
            o1[2] = (bf2f((u16)xr[6]) * st.x + st.y) * g1.z * siluf_(v1[2]); o1[3] = (bf2f((u16)xr[7]) * st.x + st.y) * g1.w * siluf_(v1[3]);
            *(u32x4*)(Sb + rl * 4096u + 2048u + branch * 1024 + cb) = pack8v(o0, o1);
            __builtin_amdgcn_sched_barrier(0);
          }
      }
    } else {
#pragma unroll
      for (int bj = 0; bj < 2; ++bj) {
        const unsigned cb = (u.pn - 8) * 256 + bj * 128 + wc * 32 + fq * 8;
#pragma unroll
        for (int ai = 0; ai < 2; ++ai)
#pragma unroll
          for (int m = 0; m < 4; ++m) {
            const unsigned rl = rl0 + ai * 128 + m * 16;
            f32x4 v0 = acc[ai][bj][m][0], v1 = acc[ai][bj][m][1];
            asm volatile("" : "+v"(v0), "+v"(v1));
            f32x4 o0, o1;
#pragma unroll
            for (int j = 0; j < 4; ++j) { o0[j] = sigmoidf_(v0[j]); o1[j] = sigmoidf_(v1[j]); }
            *(u32x4*)(Sb + rl * 4096u + cb) = pack8v(o0, o1);
            __builtin_amdgcn_sched_barrier(0);
          }
      }
    }
  }
};

struct EpiMerge {
  static constexpr bool PERM = true;
  const u16* S; u16* MG; int pass;
  __device__ __forceinline__ void operator()(const f32x4 (&acc)[2][2][4][2], const pg8::Unit& u, int wr, int wc, int fr, int fq, int lane) const {
    const u16* Sb = S + (size_t)u.pm * 256 * 4096 + pass * 1024;
    u16* MGb = MG + (size_t)u.pm * 256 * 1024;
    unsigned rl0 = wr * 64 + fr; asm volatile("" : "+v"(rl0));
#pragma unroll
    for (int bj = 0; bj < 2; ++bj) {
      const unsigned cb = u.pn * 256 + bj * 128 + wc * 32 + fq * 8;
#pragma unroll
      for (int ai = 0; ai < 2; ++ai)
#pragma unroll
        for (int m = 0; m < 4; ++m) {
          const unsigned rl = rl0 + ai * 128 + m * 16;
          const bf16x8 gt = *(const bf16x8*)(Sb + rl * 4096u + cb);
          f32x4 o0 = acc[ai][bj][m][0], o1 = acc[ai][bj][m][1];
#pragma unroll
          for (int j = 0; j < 4; ++j) { o0[j] *= bf2f((u16)gt[j]); o1[j] *= bf2f((u16)gt[4 + j]); }
          if (pass) {
            const bf16x8 old = *(const bf16x8*)(MGb + rl * 1024u + cb);
#pragma unroll
            for (int j = 0; j < 4; ++j) { o0[j] += bf2f((u16)old[j]); o1[j] += bf2f((u16)old[4 + j]); }
          }
          *(u32x4*)(MGb + rl * 1024u + cb) = pack8v(o0, o1);
            __builtin_amdgcn_sched_barrier(0);
        }
    }
  }
};

struct EpiOut {
  static constexpr bool PERM = false;
  const float* x_lat; const float* x_ctx; float* o_lat; float* o_ctx; const float* mod;
  __device__ __forceinline__ void operator()(const f32x4 (&acc)[2][2][4][2], const pg8::Unit& u, int wr, int wc, int fr, int fq, int lane) const {
    const float* hin; float* hout; int rmod;
    if (u.pm < 128) { hin = x_lat + (size_t)u.pm * 256 * DM; hout = o_lat + (size_t)u.pm * 256 * DM; rmod = u.pm >> 4; }
    else { hin = x_ctx + (size_t)(u.pm - 128) * 256 * DM; hout = o_ctx + (size_t)(u.pm - 128) * 256 * DM; rmod = 8; }
    const float* gate = mod + rmod * 3072 + 2048;
    unsigned rl0 = wr * 64 + fr; asm volatile("" : "+v"(rl0));
#pragma unroll
    for (int bj = 0; bj < 2; ++bj)
#pragma unroll
      for (int n = 0; n < 2; ++n) {
        const unsigned cb = u.pn * 256 + bj * 128 + wc * 32 + n * 16 + fq * 4;
        const float4 g = *(const float4*)(gate + cb);
#pragma unroll
        for (int ai = 0; ai < 2; ++ai)
#pragma unroll
          for (int m = 0; m < 4; ++m) {
            const unsigned o = (rl0 + ai * 128 + m * 16) * 1024u + cb;
            const float4 h = *(const float4*)(hin + o);
            const f32x4 v = acc[ai][bj][m][n];
            *(float4*)(hout + o) = make_float4(h.x + g.x * v[0], h.y + g.y * v[1], h.z + g.z * v[2], h.w + g.w * v[3]);
          }
      }
  }
};

__device__ __forceinline__ void phase_stats(const Params& p, int l) {
  const int tid = opaque_tid(); const int wave = tid >> 6, lane = tid & 63;
  const u16* RG = (const u16*)(p.ws + OFF_RG);
  float* ST = (float*)(p.ws + OFF_STATS);
  const int nrows = (l == 0) ? MTOT : MLAT;
  for (int row = (blockIdx.x * 8 + wave) * 4; row < nrows; row += gridDim.x * 32) {
    bf16x8 v[4][4];
#pragma unroll
    for (int q = 0; q < 4; ++q)
#pragma unroll
      for (int i = 0; i < 4; ++i) v[q][i] = *(const bf16x8*)(RG + (size_t)(row + q) * 2048 + i * 512 + lane * 8);
#pragma unroll
    for (int q = 0; q < 4; ++q)
#pragma unroll
      for (int i = 0; i < 4; ++i) {
        float s1 = 0.f, s2 = 0.f;
#pragma unroll
        for (int x = 0; x < 8; ++x) { float a = bf2f((u16)v[q][i][x]); s1 += a; s2 += a * a; }
#pragma unroll
        for (int o = 16; o > 0; o >>= 1) {
          s1 += __int_as_float(__builtin_amdgcn_ds_bpermute((lane ^ o) << 2, __float_as_int(s1)));
          s2 += __int_as_float(__builtin_amdgcn_ds_bpermute((lane ^ o) << 2, __float_as_int(s2)));
        }
        float sa, sb;
        if ((i >> 1) == 0) { float mu = s1 * (1.f / 256.f); float var = fmaxf(s2 * (1.f / 256.f) - mu * mu, 0.f); sa = rsqrtf(var + 1e-6f); sb = -mu * sa; }
        else { sa = rsqrtf(s2 * (1.f / 256.f) + 1e-6f); sb = 0.f; }
        if ((lane & 31) == 0) *(float2*)(ST + ((size_t)(row + q) * 8 + (i >> 1) * 4 + 2 * (i & 1) + (lane >> 5)) * 2) = make_float2(sa, sb);
      }
  }
}

#define OFF_VECS OFF_WT
__device__ __forceinline__ float logsig16(float x) { return (fminf(x, 0.f) - __logf(1.f + __expf(-fabsf(x)))) * (1.f / 16.f); }

typedef __attribute__((ext_vector_type(2))) float f32x2_t;

template <int SW>
__device__ __forceinline__ void prepass_sweep4(const float* GLRS, const f32x2_t (&w2)[4][16], const f32x2_t (&b2)[4], u16* Sq, u16* Ub,
                                               float (&accF)[4], float (&accB)[4]) {
#pragma unroll
  for (int c = 0; c < 4; ++c) { accF[c] = 0.f; accB[c] = 0.f; }
#pragma unroll 2
  for (int u = 0; u < 32; ++u) {
    const int i = SW ? 32 + u : 31 - u;
    const bf16x4 q4 = *(const bf16x4*)(Sq + (unsigned)i * 4096u);
    const bf16x4 k4 = *(const bf16x4*)(Sq + (unsigned)i * 4096u + 512u);
    const float4* gr = (const float4*)(GLRS + (i & 31) * 16);
    const float4 g0 = gr[0], g1 = gr[1], g2 = gr[2], g3 = gr[3];
    bf16x4 oqf, okf, oqb, okb;
#pragma unroll
    for (int c = 0; c < 4; ++c) {
      f32x2_t x = b2[c];
      x = w2[c][0] * g0.x + x;  x = w2[c][1] * g0.y + x;  x = w2[c][2] * g0.z + x;  x = w2[c][3] * g0.w + x;
      x = w2[c][4] * g1.x + x;  x = w2[c][5] * g1.y + x;  x = w2[c][6] * g1.z + x;  x = w2[c][7] * g1.w + x;
      x = w2[c][8] * g2.x + x;  x = w2[c][9] * g2.y + x;  x = w2[c][10] * g2.z + x; x = w2[c][11] * g2.w + x;
      x = w2[c][12] * g3.x + x; x = w2[c][13] * g3.y + x; x = w2[c][14] * g3.z + x; x = w2[c][15] * g3.w + x;
      const float laf = logsig16(x.x), lab = logsig16(x.y);
      float relf, relb;
      if (SW == 0) { relf = -accF[c]; accF[c] += laf; accB[c] += lab; relb = accB[c]; }
      else         { accF[c] += laf; relf = accF[c]; relb = -accB[c]; accB[c] += lab; }
      const float q = bf2f((u16)q4[c]), k = bf2f((u16)k4[c]);
      oqf[c] = (short)f2bf(q * __expf(relf)); okf[c] = (short)f2bf(k * __expf(-relf));
      oqb[c] = (short)f2bf(q * __expf(relb)); okb[c] = (short)f2bf(k * __expf(-relb));
    }
    *(bf16x4*)(Sq + (unsigned)i * 4096u) = oqf;
    *(bf16x4*)(Sq + (unsigned)i * 4096u + 512u) = okf;
    *(bf16x4*)(Ub + (unsigned)i * 1024u) = oqb;
    *(bf16x4*)(Ub + (unsigned)i * 1024u + 512u) = okb;
  }
}

__device__ __forceinline__ void gla_prepass_unit(const Params& p, int l, int bunit, char* smem) {
  const int tid = opaque_tid();
  const int ul = __builtin_amdgcn_readfirstlane(tid >> 7);
  const int gu = bunit * 4 + ul;
  const int sw = gu & 1, ch = gu >> 1;
  const int b = ch / 68, cid = ch % 68;
  const int base = cid < 4 ? (MLAT + b * 256 + cid * 64) : (b * 4096 + (cid - 4) * 64);
  float* GLRS = (float*)smem + ul * 512;
  const int col0 = (tid & 127) * 4;
  __syncthreads();
  {
    const int uw = (tid >> 6) & 1, lane = tid & 63, fr = lane & 15, fq = lane >> 4;
    f32x4 g = (f32x4){0.f, 0.f, 0.f, 0.f};
    const u16* Ua = (const u16*)(p.ws + OFF_U) + (size_t)(base + sw * 32 + uw * 16 + fr) * 1024 + fq * 8;
    const u16* Wb = (const u16*)(p.ws + OFF_WT) + (size_t)(4096 + fr) * 1024 + fq * 8;
#pragma unroll 16
    for (int k = 0; k < 1024; k += 32) {
      bf16x8 a = *(const bf16x8*)(Ua + k);
      bf16x8 w = *(const bf16x8*)(Wb + k);
      g = __builtin_amdgcn_mfma_f32_16x16x32_bf16(a, w, g, 0, 0, 0);
    }
#pragma unroll
    for (int j = 0; j < 4; ++j) GLRS[(uw * 16 + fq * 4 + j) * 16 + fr] = g[j];
  }
  f32x2_t w2[4][16], b2[4];
  {
    const float* w0 = p.gla_w_up + (size_t)(l * 2 + 0) * 16 * 512 + col0;
    const float* w1 = p.gla_w_up + (size_t)(l * 2 + 1) * 16 * 512 + col0;
#pragma unroll
    for (int r = 0; r < 16; ++r) {
      const float4 a = *(const float4*)(w0 + r * 512), c = *(const float4*)(w1 + r * 512);
      w2[0][r].x = a.x; w2[1][r].x = a.y; w2[2][r].x = a.z; w2[3][r].x = a.w;
      w2[0][r].y = c.x; w2[1][r].y = c.y; w2[2][r].y = c.z; w2[3][r].y = c.w;
    }
    const float4 a = *(const float4*)(p.gla_b_up + (l * 2 + 0) * 512 + col0), c = *(const float4*)(p.gla_b_up + (l * 2 + 1) * 512 + col0);
    b2[0].x = a.x; b2[1].x = a.y; b2[2].x = a.z; b2[3].x = a.w;
    b2[0].y = c.x; b2[1].y = c.y; b2[2].y = c.z; b2[3].y = c.w;
  }
  __syncthreads();
  u16* Sq = (u16*)(p.ws + OFF_S) + (size_t)base * 4096 + 2048 + col0;
  u16* Ub = (u16*)(p.ws + OFF_U) + (size_t)base * 1024 + col0;
  float* V0 = (float*)(p.ws + OFF_VECS) + ((size_t)(0 * 544 + b * 68 + cid) * 2) * 512 + col0;
  float* V1 = (float*)(p.ws + OFF_VECS) + ((size_t)(1 * 544 + b * 68 + cid) * 2) * 512 + col0;
  float accF[4], accB[4];
  if (sw == 0) {
    prepass_sweep4<0>(GLRS, w2, b2, Sq, Ub, accF, accB);
    *(float4*)(V0) = make_float4(__expf(accF[0]), __expf(accF[1]), __expf(accF[2]), __expf(accF[3]));
    *(float4*)(V1 + 512) = make_float4(__expf(accB[0]), __expf(accB[1]), __expf(accB[2]), __expf(accB[3]));
  } else {
    prepass_sweep4<1>(GLRS, w2, b2, Sq, Ub, accF, accB);
    *(float4*)(V0 + 512) = make_float4(__expf(accF[0]), __expf(accF[1]), __expf(accF[2]), __expf(accF[3]));
    *(float4*)(V1) = make_float4(__expf(accB[0]), __expf(accB[1]), __expf(accB[2]), __expf(accB[3]));
  }
}

#define L_QR   0
#define L_KR   17408
#define L_V    34816
#define L_SGT  44032
#define L_P    61440
#undef  SCAN_GB
#define SCAN_GB 70656

__device__ __forceinline__ int off128(int row, int col) { return row * 272 + col * 2; }
__device__ __forceinline__ int off64(int row, int col) { return row * 144 + col * 2; }

template <int RS>
__device__ __forceinline__ bf16x8 tr_frag(unsigned img_addr, int r0, int c0, int lane) {
  const int g = lane >> 4, q = (lane & 15) >> 2, pp = lane & 3;
  unsigned a = img_addr + (unsigned)((r0 + 8 * g + q) * RS + (c0 + 4 * pp) * 2);
  bf16x4 lo, hi;
  asm volatile("ds_read_b64_tr_b16 %0, %2\n\tds_read_b64_tr_b16 %1, %2 offset:%3\n\ts_waitcnt lgkmcnt(0)"
               : "=&v"(lo), "=&v"(hi) : "v"(a), "n"(4 * RS) : "memory");
  bf16x8 r;
  r[0] = lo[0]; r[1] = lo[1]; r[2] = lo[2]; r[3] = lo[3]; r[4] = hi[0]; r[5] = hi[1]; r[6] = hi[2]; r[7] = hi[3];
  return r;
}

__device__ __forceinline__ bf16x8 scale8(bf16x8 v, float f) {
  bf16x8 o;
#pragma unroll
  for (int x = 0; x < 8; ++x) o[x] = (short)f2bf(bf2f((u16)v[x]) * f);
  return o;
}

__device__ __forceinline__ void lds_barrier() { asm volatile("s_waitcnt lgkmcnt(0)" ::: "memory"); __builtin_amdgcn_s_barrier(); asm volatile("" ::: "memory"); }

template <int branch>
__device__ __forceinline__ void scan_item(const Params& p, int l, int item, char* smem) {
  const int b = (item >> 4) & 7, h = (item >> 2) & 3, slice = item & 3;
  const int tid = opaque_tid(), wid = __builtin_amdgcn_readfirstlane(tid >> 6), lane = tid & 63;
  const int dir = wid >> 2, gw = wid & 3, gt = tid & 255;
  const int fr = lane & 15, fq = lane >> 4;
  char* G = smem + dir * SCAN_GB;
  const unsigned Ga = (unsigned)(size_t)G;
  const u16* S = (const u16*)(p.ws + OFF_S);
  u16* RG = (u16*)(p.ws + OFF_RG);
  const u16* qsrc; unsigned qstride;
  if (branch == 0) { qsrc = S + h * 128; qstride = 4096; }
  else if (dir == 0) { qsrc = S + 2048 + h * 128; qstride = 4096; }
  else { qsrc = (const u16*)(p.ws + OFF_U) + h * 128; qstride = 1024; }
  const int voff = branch * 2048 + 1024 + h * 256 + slice * 64;
  const int ooff = branch * 1024 + h * 256 + slice * 64;
  float lg = 0.f, egc = 1.f;
  if (branch == 0) { lg = __logf(1.f - __expf(p.ret_decay[(l * 2 + dir) * 4 + h])); egc = __expf(32.f * lg); }
  const float* VECS = (const float*)(p.ws + OFF_VECS) + ((size_t)(dir * 544 + b * 68) * 2) * 512 + h * 128;
  f32x4 st[2][4];
#pragma unroll
  for (int m = 0; m < 2; ++m)
#pragma unroll
    for (int n = 0; n < 4; ++n) st[m][n] = (f32x4){0.f, 0.f, 0.f, 0.f};

  const int qj = gt >> 4, qc = gt & 15;
  const int vj = gt >> 3, vc = gt & 7;
  bf16x8 pq[4], pk[4], pv[2];
  float4 peg[2], pel[2];
  auto prefetch = [&](int s) {
    int base, cid;
    if (s < 4) { int cc = dir ? 3 - s : s; base = MLAT + b * 256 + cc * 64; cid = cc; }
    else { int c = s - 4; int cc = dir ? 63 - c : c; base = b * 4096 + cc * 64; cid = 4 + cc; }
#pragma unroll
    for (int i = 0; i < 4; ++i) {
      int jp = qj + 16 * i;
      unsigned ro = (unsigned)(base + (dir ? 63 - jp : jp)) * qstride + qc * 8;
      pq[i] = *(const bf16x8*)(qsrc + ro);
      pk[i] = *(const bf16x8*)(qsrc + ro + 512);
    }
#pragma unroll
    for (int i = 0; i < 2; ++i) {
      int jp = vj + 32 * i;
      pv[i] = *(const bf16x8*)(S + (size_t)(base + (dir ? 63 - jp : jp)) * 4096 + voff + vc * 8);
    }
    if (branch == 1) {
#pragma unroll
      for (int m = 0; m < 2; ++m) {
        int d0 = gw * 32 + m * 16 + fq * 4;
        peg[m] = *(const float4*)(VECS + (size_t)cid * 1024 + d0);
        pel[m] = *(const float4*)(VECS + (size_t)cid * 1024 + 512 + d0);
      }
    }
  };
  prefetch(0);
  __syncthreads();

  for (int s = 0; s < 68; ++s) {
    int base; bool first; bool wout;
    if (s < 4) { int cc = dir ? 3 - s : s; base = MLAT + b * 256 + cc * 64; first = s < 2; wout = (l == 0); }
    else { int c = s - 4; int cc = dir ? 63 - c : c; base = b * 4096 + cc * 64; first = c < 32; wout = true; }
    float4 eg[2], el[2];
#pragma unroll
    for (int m = 0; m < 2; ++m) {
      if (branch == 1) { eg[m] = peg[m]; el[m] = pel[m]; }
      else { eg[m] = make_float4(egc, egc, egc, egc); el[m] = eg[m]; }
    }
#pragma unroll
    for (int i = 0; i < 4; ++i) {
      int jp = qj + 16 * i;
      bf16x8 qv = pq[i], kv_ = pk[i];
      if (branch == 0) {
        float fqs = __expf((float)(jp - 31) * lg), fks = __expf((float)(31 - jp) * lg);
        qv = scale8(qv, fqs); kv_ = scale8(kv_, fks);
      }
      *(bf16x8*)(G + L_QR + off128(jp, qc * 8)) = qv;
      *(bf16x8*)(G + L_KR + off128(jp, qc * 8)) = kv_;
    }
#pragma unroll
    for (int i = 0; i < 2; ++i) *(bf16x8*)(G + L_V + off64(vj + 32 * i, vc * 8)) = pv[i];
#pragma unroll
    for (int m = 0; m < 2; ++m) {
      int d0 = gw * 32 + m * 16 + fq * 4;
#pragma unroll
      for (int n = 0; n < 4; ++n) {
        int e = n * 16 + fr;
        bf16x4 o4;
        o4[0] = (short)f2bf(st[m][n][0] * eg[m].x); o4[1] = (short)f2bf(st[m][n][1] * eg[m].y);
        o4[2] = (short)f2bf(st[m][n][2] * eg[m].z); o4[3] = (short)f2bf(st[m][n][3] * eg[m].w);
        *(bf16x4*)(G + L_SGT + off128(e, d0)) = o4;
      }
    }
    u16 oldv[4][4];
    u16* dstb = RG + (size_t)base * 2048 + ooff + fr;
    if (wout && !first) {
#pragma unroll
      for (int r = 0; r < 4; ++r) {
        int ip = gw * 16 + fq * 4 + r;
        unsigned ro = (unsigned)(dir ? 63 - ip : ip) * 2048u;
#pragma unroll
        for (int n = 0; n < 4; ++n) oldv[r][n] = dstb[ro + n * 16];
      }
    }
    if (s + 1 < 68) prefetch(s + 1);
    lds_barrier();
    f32x4 pt[4], o[4];
#pragma unroll
    for (int n = 0; n < 4; ++n) { pt[n] = (f32x4){0.f, 0.f, 0.f, 0.f}; o[n] = (f32x4){0.f, 0.f, 0.f, 0.f}; }
#pragma unroll
    for (int ks = 0; ks < 4; ++ks) {
      int kc = ks * 32 + fq * 8;
      bf16x8 qa = *(const bf16x8*)(G + L_QR + off128(gw * 16 + fr, kc));
#pragma unroll
      for (int n = 0; n < 4; ++n) {
        bf16x8 ka = *(const bf16x8*)(G + L_KR + off128(n * 16 + fr, kc));
        bf16x8 sb = *(const bf16x8*)(G + L_SGT + off128(n * 16 + fr, kc));
        pt[n] = __builtin_amdgcn_mfma_f32_16x16x32_bf16(ka, qa, pt[n], 0, 0, 0);
        o[n] = __builtin_amdgcn_mfma_f32_16x16x32_bf16(qa, sb, o[n], 0, 0, 0);
      }
    }
    {
      const int ip = gw * 16 + fr;
#pragma unroll
      for (int n = 0; n < 4; ++n) {
        const int j0 = n * 16 + fq * 4;
        bf16x4 w;
#pragma unroll
        for (int r = 0; r < 4; ++r) {
          int jp = j0 + r;
          bool keep = dir ? (ip > jp) : (ip >= jp);
          w[r] = (short)f2bf(keep ? pt[n][r] : 0.f);
        }
        *(bf16x4*)(G + L_P + off64(ip, j0)) = w;
      }
    }
    asm volatile("s_waitcnt lgkmcnt(0)" ::: "memory");
    {
      const int tg = lane >> 4, tq = (lane & 15) >> 2, tp = lane & 3;
      const unsigned ka0 = Ga + L_KR + (unsigned)((8 * tg + tq) * 272 + (gw * 32 + 4 * tp) * 2);
      const unsigned va0 = Ga + L_V + (unsigned)((8 * tg + tq) * 144 + (4 * tp) * 2);
#pragma unroll
      for (int m = 0; m < 2; ++m) {
        f32x4 kv[4];
#pragma unroll
        for (int n = 0; n < 4; ++n) kv[n] = (f32x4){0.f, 0.f, 0.f, 0.f};
#pragma unroll
        for (int ks = 0; ks < 2; ++ks) {
          int kc = ks * 32 + fq * 8;
          bf16x4 r0, r1, r2, r3, r4, r5, r6, r7, r8, r9;
          asm volatile(
              "ds_read_b64_tr_b16 %0, %10\n\tds_read_b64_tr_b16 %1, %10 offset:1088\n\t"
              "ds_read_b64_tr_b16 %2, %11\n\tds_read_b64_tr_b16 %3, %11 offset:576\n\t"
              "ds_read_b64_tr_b16 %4, %11 offset:32\n\tds_read_b64_tr_b16 %5, %11 offset:608\n\t"
              "ds_read_b64_tr_b16 %6, %11 offset:64\n\tds_read_b64_tr_b16 %7, %11 offset:640\n\t"
              "ds_read_b64_tr_b16 %8, %11 offset:96\n\tds_read_b64_tr_b16 %9, %11 offset:672\n\t"
              "s_waitcnt lgkmcnt(0)"
              : "=&v"(r0), "=&v"(r1), "=&v"(r2), "=&v"(r3), "=&v"(r4), "=&v"(r5), "=&v"(r6), "=&v"(r7), "=&v"(r8), "=&v"(r9)
              : "v"(ka0 + (unsigned)(ks * 32 * 272 + m * 32)), "v"(va0 + (unsigned)(ks * 32 * 144))
              : "memory");
          bf16x8 km = __builtin_shufflevector(r0, r1, 0, 1, 2, 3, 4, 5, 6, 7);
          bf16x8 vb[4];
          vb[0] = __builtin_shufflevector(r2, r3, 0, 1, 2, 3, 4, 5, 6, 7);
          vb[1] = __builtin_shufflevector(r4, r5, 0, 1, 2, 3, 4, 5, 6, 7);
          vb[2] = __builtin_shufflevector(r6, r7, 0, 1, 2, 3, 4, 5, 6, 7);
          vb[3] = __builtin_shufflevector(r8, r9, 0, 1, 2, 3, 4, 5, 6, 7);
          bf16x8 pa;
          if (m == 0) pa = *(const bf16x8*)(G + L_P + off64(gw * 16 + fr, kc));
#pragma unroll
          for (int n = 0; n < 4; ++n) {
            if (m == 0) o[n] = __builtin_amdgcn_mfma_f32_16x16x32_bf16(pa, vb[n], o[n], 0, 0, 0);
            kv[n] = __builtin_amdgcn_mfma_f32_16x16x32_bf16(km, vb[n], kv[n], 0, 0, 0);
          }
        }
#pragma unroll
        for (int n = 0; n < 4; ++n) {
          st[m][n][0] = eg[m].x * el[m].x * st[m][n][0] + el[m].x * kv[n][0];
          st[m][n][1] = eg[m].y * el[m].y * st[m][n][1] + el[m].y * kv[n][1];
          st[m][n][2] = eg[m].z * el[m].z * st[m][n][2] + el[m].z * kv[n][2];
          st[m][n][3] = eg[m].w * el[m].w * st[m][n][3] + el[m].w * kv[n][3];
        }
      }
    }
    if (wout) {
#pragma unroll
      for (int r = 0; r < 4; ++r) {
        int ip = gw * 16 + fq * 4 + r;
        unsigned ro = (unsigned)(dir ? 63 - ip : ip) * 2048u;
#pragma unroll
        for (int n = 0; n < 4; ++n) {
          float v = o[n][r];
          if (!first) v += bf2f(oldv[r][n]);
          dstb[ro + n * 16] = f2bf(v);
        }
      }
    }
    __syncthreads();
  }
}

#define NPHASE 18
__device__ __forceinline__ void run_phase(const Params& p, int ph, char* smem) {
  const int nblk = gridDim.x, bid = blockIdx.x;
  if (ph == 0) {
#ifdef REP_P0
    for (int rep = 0; rep < REP_P0; ++rep)
#endif
    for (int u = bid; u < WT_UNITS + 96 + 1; u += nblk) {
      if (u < 96) mod_unit(p, u, smem);
      else if (u == 96) rot_unit(p);
      else wt_unit(p, 0, u - 97, smem);
    }
    return;
  }
  if (ph == NPHASE - 1) { phase_final(p); return; }
  const int l = (ph - 1) / 8, sp = (ph - 1) % 8;
  PG8_LAS unsigned char* lds = (PG8_LAS unsigned char*)smem;
  switch (sp) {
    case 0:
      phase_u(p, l);
      if (l == 1) for (int u = bid; u < WT_UNITS; u += nblk) wt_unit(p, 1, u, smem);
      break;
    case 1: {
      pg8::Gemm g{(const u16*)(p.ws + OFF_U), (const u16*)(p.ws + OFF_WT) + (size_t)WT_SCAN * 1024, 1024, MTOT, 4096, 1024};
      pg8::StaticOrder S; S.init(g.M, g.N, nblk, bid);
      EpiScanIn E{(u16*)(p.ws + OFF_S), (const float*)(p.ws + OFF_ROT)};
      pg8::gemm_phase(lds, g, S, E, opaque_tid());
    } break;
    case 2: for (int t = bid; t < 272; t += nblk) gla_prepass_unit(p, l, t, smem); break;
    case 3:
#ifdef REP_SCAN
      for (int rep = 0; rep < REP_SCAN; ++rep)
#endif
      for (int t = bid; t < 256; t += nblk) { if (t < 128) scan_item<0>(p, l, t, smem); else scan_item<1>(p, l, t, smem); } break;
    case 4:
      phase_u(p, l);
      phase_stats(p, l);
      break;
    case 5: {
      pg8::Gemm g{(const u16*)(p.ws + OFF_U), (const u16*)(p.ws + OFF_WT) + (size_t)WT_GATE * 1024, 1024, l == 0 ? MTOT : MLAT, 4096, 1024};
      pg8::StaticOrder S; S.init(g.M, g.N, nblk, bid);
      EpiGate E{(const u16*)(p.ws + OFF_RG), (const float*)(p.ws + OFF_STATS), (u16*)(p.ws + OFF_S), p.ret_norm_gain + l * 1024, p.gla_norm_gain + l * 1024};
      pg8::gemm_phase(lds, g, S, E, opaque_tid());
    } break;
    case 6: {
#pragma unroll 1
      for (int pass = 0; pass < 2; ++pass) {
        pg8::Gemm g{(const u16*)(p.ws + OFF_S) + 2048 + pass * 1024, (const u16*)(p.ws + OFF_WT) + (size_t)(WT_BRR + pass * 1024) * 1024, 4096, l == 0 ? MTOT : MLAT, 1024, 1024};
        pg8::StaticOrder S; S.init(g.M, g.N, nblk, bid);
        EpiMerge E{(const u16*)(p.ws + OFF_S), (u16*)(p.ws + OFF_U), pass};
        pg8::gemm_phase(lds, g, S, E, opaque_tid());
      }
    } break;
    case 7: {
      pg8::Gemm g{(const u16*)(p.ws + OFF_U), (const u16*)(p.ws + OFF_WT) + (size_t)WT_OUT * 1024, 1024, l == 0 ? MTOT : MLAT, 1024, 1024};
      pg8::StaticOrder S; S.init(g.M, g.N, nblk, bid);
      EpiOut E{l == 0 ? p.x : p.out, p.ctx, p.out, (float*)(p.ws + OFF_HCTX), (const float*)(p.ws + OFF_MOD) + (size_t)l * 9 * 3072};
      pg8::gemm_phase(lds, g, S, E, opaque_tid());
    } break;
  }
}

__device__ __forceinline__ void grid_barrier(unsigned* cnt, unsigned target) {
  asm volatile("s_waitcnt vmcnt(0)" ::: "memory");
  __syncthreads();
  if (threadIdx.x == 0) {
    __threadfence();
    __hip_atomic_fetch_add(cnt, 1u, __ATOMIC_RELAXED, __HIP_MEMORY_SCOPE_AGENT);
    while (__hip_atomic_load(cnt, __ATOMIC_RELAXED, __HIP_MEMORY_SCOPE_AGENT) < target) __builtin_amdgcn_s_sleep(2);
    __threadfence();
  }
  __syncthreads();
}

__global__ void __launch_bounds__(NTHREADS) mega(Params p, int ph_lo, int ph_hi, int coop) {
  extern __shared__ __attribute__((aligned(16))) char smem[];
  for (int ph = ph_lo; ph < ph_hi; ++ph) {
    run_phase(p, ph, smem);
    if (coop && ph + 1 < ph_hi) {
      if (ph == ph_lo) cg::this_grid().sync();
      else grid_barrier((unsigned*)(p.ws + OFF_BAR), (unsigned)(ph - ph_lo) * gridDim.x);
    }
  }
}

extern "C" void kernel_launch(void* const* d_in, const int* in_sizes, int n_in,
                              void* d_out, int out_size, void* d_ws, size_t ws_size,
                              hipStream_t stream) {
  Params p{};
  p.x = (const float*)d_in[0]; p.c = (const float*)d_in[1]; p.ctx = (const float*)d_in[2]; p.c_ctx = (const float*)d_in[3];
  p.norm_gain = (const float*)d_in[4]; p.w_ada = (const float*)d_in[5]; p.b_ada = (const float*)d_in[6]; p.w_in = (const float*)d_in[7];
  p.ret_decay = (const float*)d_in[8]; p.gla_w_up = (const float*)d_in[9]; p.gla_b_up = (const float*)d_in[10];
  p.ret_norm_gain = (const float*)d_in[11]; p.gla_norm_gain = (const float*)d_in[12];
  p.w_br_ret = (const float*)d_in[13]; p.w_br_gla = (const float*)d_in[14]; p.w_out = (const float*)d_in[15]; p.final_gain = (const float*)d_in[16];
  p.out = (float*)d_out; p.ws = (char*)d_ws;
  static int grid_blocks = 0;
  if (!grid_blocks) {
    hipFuncSetAttribute((const void*)mega, hipFuncAttributeMaxDynamicSharedMemorySize, LDS_BYTES);
    int dev = 0, cus = 0, per_cu = 0;
    hipGetDevice(&dev);
    hipDeviceGetAttribute(&cus, hipDeviceAttributeMultiprocessorCount, dev);
    hipOccupancyMaxActiveBlocksPerMultiprocessor(&per_cu, mega, NTHREADS, LDS_BYTES);
    if (per_cu < 1) per_cu = 1;
    grid_blocks = cus * 1;
  }
#ifdef MULTI_LAUNCH
  for (int ph = 0; ph < NPHASE; ++ph) {
    mega<<<dim3(grid_blocks), dim3(NTHREADS), LDS_BYTES, stream>>>(p, ph, ph + 1, 0);
  }
#else
  hipMemsetAsync((char*)d_ws + OFF_BAR, 0, 256, stream);
  int lo = 0, hi = NPHASE, coop = 1;
  void* args[] = {&p, &lo, &hi, &coop};
  hipError_t e = hipLaunchCooperativeKernel((void*)mega, dim3(grid_blocks), dim3(NTHREADS), args, LDS_BYTES, stream);
  if (e != hipSuccess) fprintf(stderr, "cooperative launch failed: %s (grid %d)\n", hipGetErrorString(e), grid_blocks);
#endif
}
```

```cpp
#include <hip/hip_runtime.h>
#include <hip/hip_cooperative_groups.h>
#include <cstdio>
namespace cg = cooperative_groups;

typedef unsigned short u16;
using bf16x8 = __attribute__((ext_vector_type(8))) short;
using bf16x4 = __attribute__((ext_vector_type(4))) short;
using f32x4  = __attribute__((ext_vector_type(4))) float;

#define NTHREADS 512
#define DM 1024
#define NB 8
#define SEQL 4096
#define CTXL 256
#define MLAT 32768
#define MCTX 2048
#define MTOT 34816
#define INW 8208

#define OFF_S    0ull
#define OFF_RG   (OFF_S   + (size_t)MTOT * 4096 * 2)
#define OFF_U    (OFF_RG  + (size_t)MTOT * 2048 * 2)
#define OFF_WT   (OFF_U   + (size_t)MTOT * 1024 * 2)
#define WT_ROWS  11392
#define OFF_GLR  (OFF_WT  + (size_t)WT_ROWS * 1024 * 2)
#define OFF_HCTX (OFF_GLR + (size_t)MTOT * 16 * 4)
#define OFF_MOD  (OFF_HCTX+ (size_t)MCTX * 1024 * 4)
#define OFF_ROT  (OFF_MOD + (size_t)2 * 9 * 3072 * 4)
#define OFF_BAR  (OFF_ROT + (size_t)64 * 32 * 2 * 4)
#define OFF_END  (OFF_BAR + 256)

#define WT_SCAN 0
#define WT_GATE 4224
#define WT_BRR  8320
#define WT_BRG  9344
#define WT_OUT  10368

#define LDS_BYTES 161792
#define SCAN_GB   80896

struct Params {
  const float* x; const float* c; const float* ctx; const float* c_ctx;
  const float* norm_gain; const float* w_ada; const float* b_ada; const float* w_in;
  const float* ret_decay; const float* gla_w_up; const float* gla_b_up;
  const float* ret_norm_gain; const float* gla_norm_gain;
  const float* w_br_ret; const float* w_br_gla; const float* w_out; const float* final_gain;
  float* out; char* ws;
};

__device__ __forceinline__ u16 f2bf(float f) {
  __bf16 h = (__bf16)f;
  return *(u16*)&h;
}
__device__ __forceinline__ float bf2f(u16 h) { return __uint_as_float(((unsigned)h) << 16); }
__device__ __forceinline__ float sigmoidf_(float x) { return __builtin_amdgcn_rcpf(1.f + __expf(-x)); }
__device__ __forceinline__ float siluf_(float x) { return x * __builtin_amdgcn_rcpf(1.f + __expf(-x)); }

__device__ __forceinline__ int opaque_tid() { int t = threadIdx.x; asm volatile("" : "+v"(t)); return t; }

__device__ __forceinline__ float wave_sum(float v) {
#pragma unroll
  for (int o = 32; o > 0; o >>= 1) v += __shfl_xor(v, o, 64);
  return v;
}

__device__ __forceinline__ const float* wt_src(const Params& p, int l, int n, int& ld) {
  if (n < WT_GATE) {
    int tile = n >> 7, cc = n & 127;
    int col;
    if (tile < 8) {
      int d = (cc & 64) | ((cc & 16) << 1) | ((cc & 32) >> 1) | (cc & 15);
      col = tile * 128 + d;
    } else if (tile < 16) col = 1024 + (tile - 8) * 128 + cc;
    else if (tile < 24) col = 3072 + (tile - 16) * 128 + cc;
    else if (tile < 32) col = 4096 + (tile - 24) * 128 + cc;
    else { if (cc >= 16) { ld = 0; return nullptr; } col = 6144 + cc; }
    ld = INW; return p.w_in + (size_t)l * DM * INW + col;
  } else if (n < WT_BRR) {
    int g = n - WT_GATE; int col;
    if (g < 1024) col = 2048 + g;
    else if (g < 2048) col = 5120 + (g - 1024);
    else if (g < 3072) col = 6160 + (g - 2048);
    else col = 7184 + (g - 3072);
    ld = INW; return p.w_in + (size_t)l * DM * INW + col;
  } else if (n < WT_BRG) { ld = DM; return p.w_br_ret + (size_t)l * DM * DM + (n - WT_BRR); }
  else if (n < WT_OUT)   { ld = DM; return p.w_br_gla + (size_t)l * DM * DM + (n - WT_BRG); }
  else                   { ld = DM; return p.w_out    + (size_t)l * DM * DM + (n - WT_OUT); }
}

#define WT_UNITS (178 * 16)
__device__ __forceinline__ void wt_unit(const Params& p, int l, int unit, char* smem) {
  float* tile = (float*)smem;
  int nb = unit >> 4, kb = unit & 15;
  int tid = opaque_tid();
  int n0 = nb * 64, k0 = kb * 64;
  {
    int nl = tid & 63, kq = tid >> 6;
    int ld; const float* src = wt_src(p, l, n0 + nl, ld);
#pragma unroll
    for (int i = 0; i < 8; ++i) {
      int kl = kq + 8 * i;
      float v = src ? src[(size_t)(k0 + kl) * ld] : 0.f;
      tile[kl * 65 + nl] = v;
    }
  }
  __syncthreads();
  {
    int nl = tid >> 3, kq = tid & 7;
    bf16x8 o;
#pragma unroll
    for (int j = 0; j < 8; ++j) o[j] = (short)f2bf(tile[(kq * 8 + j) * 65 + nl]);
    u16* wt = (u16*)(p.ws + OFF_WT);
    *(bf16x8*)(wt + (size_t)(n0 + nl) * 1024 + k0 + kq * 8) = o;
  }
  __syncthreads();
}

__device__ __forceinline__ void mod_unit(const Params& p, int unit, char* smem) {
  float* sc = (float*)smem;
  float* red = sc + 9 * 1024;
  int l = unit / 48, jb = unit % 48;
  int tid = opaque_tid();
  for (int i = tid; i < 9 * 1024; i += NTHREADS) {
    int r = i >> 10, k = i & 1023;
    float v = (r < 8) ? p.c[r * 1024 + k] : p.c_ctx[k];
    sc[i] = siluf_(v);
  }
  __syncthreads();
  int jl = tid & 63, kg = tid >> 6;
  int j = jb * 64 + jl;
  float acc[9];
#pragma unroll
  for (int r = 0; r < 9; ++r) acc[r] = 0.f;
  const float* w = p.w_ada + (size_t)l * DM * 3072 + j;
#pragma unroll 16
  for (int k = kg * 128; k < kg * 128 + 128; ++k) {
    float wv = w[(size_t)k * 3072];
#pragma unroll
    for (int r = 0; r < 9; ++r) acc[r] += sc[r * 1024 + k] * wv;
  }
#pragma unroll
  for (int r = 0; r < 9; ++r) red[(kg * 9 + r) * 64 + jl] = acc[r];
  __syncthreads();
  float* mod = (float*)(p.ws + OFF_MOD);
  for (int i = tid; i < 9 * 64; i += NTHREADS) {
    int r = i >> 6, jj = i & 63;
    float s = 0.f;
#pragma unroll
    for (int g = 0; g < 8; ++g) s += red[(g * 9 + r) * 64 + jj];
    mod[((size_t)l * 9 + r) * 3072 + jb * 64 + jj] = s + p.b_ada[l * 3072 + jb * 64 + jj];
  }
  __syncthreads();
}

__device__ __forceinline__ void rot_unit(const Params& p) {
  float* rot = (float*)(p.ws + OFF_ROT);
  for (int i = opaque_tid(); i < 64 * 32; i += NTHREADS) {
    int pos = i >> 5, f = i & 31;
    float inv = exp2f(-(float)f * (13.287712379549449f / 32.f));
    float ang = (float)pos * inv;
    rot[i * 2] = __cosf(ang);
    rot[i * 2 + 1] = __sinf(ang);
  }
}

__device__ __forceinline__ void phase_u(const Params& p, int l) {
  const int tid = opaque_tid(); int wave = tid >> 6, lane = tid & 63;
  const float* mod = (const float*)(p.ws + OFF_MOD) + (size_t)l * 9 * 3072;
  const float* gain = p.norm_gain + l * DM;
  u16* U = (u16*)(p.ws + OFF_U);
  for (int row = (blockIdx.x * 8 + wave) * 4; row < MTOT; row += gridDim.x * 32) {
    const float* h; int r;
    if (row < MLAT) { h = (l == 0 ? p.x : p.out) + (size_t)row * DM; r = row >> 12; }
    else { int cr = row - MLAT; h = (l == 0 ? p.ctx : (const float*)(p.ws + OFF_HCTX)) + (size_t)cr * DM; r = 8; }
    float4 v[4][4]; float ss[4];
#pragma unroll
    for (int q = 0; q < 4; ++q) {
      ss[q] = 0.f;
#pragma unroll
      for (int i = 0; i < 4; ++i) v[q][i] = *(const float4*)(h + q * DM + i * 256 + lane * 4);
    }
#pragma unroll
    for (int q = 0; q < 4; ++q) {
#pragma unroll
      for (int i = 0; i < 4; ++i) ss[q] += v[q][i].x * v[q][i].x + v[q][i].y * v[q][i].y + v[q][i].z * v[q][i].z + v[q][i].w * v[q][i].w;
      ss[q] = rsqrtf(wave_sum(ss[q]) * (1.f / 1024.f) + 1e-6f);
    }
    const float* sh = mod + r * 3072;
#pragma unroll
    for (int i = 0; i < 4; ++i) {
      int cidx = i * 256 + lane * 4;
      float4 g = *(const float4*)(gain + cidx);
      float4 s = *(const float4*)(sh + cidx);
      float4 sc = *(const float4*)(sh + 1024 + cidx);
      g.x *= (1.f + sc.x); g.y *= (1.f + sc.y); g.z *= (1.f + sc.z); g.w *= (1.f + sc.w);
#pragma unroll
      for (int q = 0; q < 4; ++q) {
        bf16x4 o;
        o[0] = (short)f2bf(v[q][i].x * ss[q] * g.x + s.x);
        o[1] = (short)f2bf(v[q][i].y * ss[q] * g.y + s.y);
        o[2] = (short)f2bf(v[q][i].z * ss[q] * g.z + s.z);
        o[3] = (short)f2bf(v[q][i].w * ss[q] * g.w + s.w);
        *(bf16x4*)(U + (size_t)(row + q) * DM + cidx) = o;
      }
    }
  }
}

__device__ __forceinline__ void phase_final(const Params& p) {
  const int tid = opaque_tid(); int wave = tid >> 6, lane = tid & 63;
  for (int row = (blockIdx.x * 8 + wave) * 4; row < MLAT; row += gridDim.x * 32) {
    float* h = p.out + (size_t)row * DM;
    float4 v[4][4]; float ss[4];
#pragma unroll
    for (int q = 0; q < 4; ++q) {
      ss[q] = 0.f;
#pragma unroll
      for (int i = 0; i < 4; ++i) v[q][i] = *(const float4*)(h + q * DM + i * 256 + lane * 4);
    }
#pragma unroll
    for (int q = 0; q < 4; ++q) {
#pragma unroll
      for (int i = 0; i < 4; ++i) ss[q] += v[q][i].x * v[q][i].x + v[q][i].y * v[q][i].y + v[q][i].z * v[q][i].z + v[q][i].w * v[q][i].w;
      ss[q] = rsqrtf(wave_sum(ss[q]) * (1.f / 1024.f) + 1e-6f);
    }
#pragma unroll
    for (int i = 0; i < 4; ++i) {
      int cidx = i * 256 + lane * 4;
      float4 g = *(const float4*)(p.final_gain + cidx);
#pragma unroll
      for (int q = 0; q < 4; ++q) {
        float4 o;
        o.x = v[q][i].x * ss[q] * g.x; o.y = v[q][i].y * ss[q] * g.y; o.z = v[q][i].z * ss[q] * g.z; o.w = v[q][i].w * ss[q] * g.w;
        *(float4*)(h + q * DM + cidx) = o;
      }
    }
  }
}

#define PG8_LAS __attribute__((address_space(3)))
typedef unsigned u32x4 __attribute__((ext_vector_type(4)));
namespace pg8 {
constexpr int BM = 256, BK = 64, HALF = 128, HTB = HALF * BK * 2, STAGE_BYTES = 8 * HTB, NXCD = 8, WGM = 8;
__device__ __forceinline__ int lds_byte(int r, int c) { const int st = (r >> 4) * 2 + (c >> 5), rr = r & 15, cc = c & 31, ob = rr * 64 + cc * 2; return st * 1024 + (ob ^ (((ob >> 9) & 1) << 5)); }
__device__ __forceinline__ void stage_rc(int b, int& R, int& C) { const int st = b / 1024, sb = b % 1024, swz = sb ^ (((sb >> 9) & 1) << 5); R = (st >> 1) * 16 + swz / 64; C = (st & 1) * 32 + (swz % 64) / 2; }
__device__ __forceinline__ int perm32(int rho) { const int n = rho >> 4, i = rho & 15; return 8 * (i >> 2) + 4 * n + (i & 3); }
struct Unit { int pm, pn; };
struct Gemm { const u16* A; const u16* Bt; int lda; int M, N, K; };
struct StaticOrder {
  int nM, nN, nwg, G, c;
  __device__ void init(int M, int N, int G_, int c_) { nM = M / BM; nN = N / BM; nwg = nM * nN; G = G_; c = c_; }
  __device__ bool next(int i, Unit& u) const {
    const long L = (long)i * G + c; if (L >= nwg) return false;
    int wgid = (int)L; { const int q = nwg / NXCD, r = nwg % NXCD, xcd = wgid % NXCD, off = wgid / NXCD; wgid = (xcd < r ? xcd * (q + 1) : r * (q + 1) + (xcd - r) * q) + off; }
    const int nig = WGM * nN, gid = wgid / nig, fm = gid * WGM, gsz = (nM - fm) < WGM ? (nM - fm) : WGM;
    u.pm = fm + ((wgid % nig) % gsz); u.pn = (wgid % nig) / gsz; return true;
  }
};
typedef __attribute__((ext_vector_type(2))) float cvt_f2_t;
typedef __attribute__((ext_vector_type(2))) __bf16 cvt_b2_t;
__device__ __forceinline__ unsigned cvt_pk_bf16(float lo, float hi) { cvt_f2_t f = {lo, hi}; cvt_b2_t r = __builtin_convertvector(f, cvt_b2_t); return __builtin_bit_cast(unsigned, r); }

template <class Epi>
__device__ __forceinline__ void gemm_phase(PG8_LAS unsigned char* lds, const Gemm g, const StaticOrder& S, const Epi& E, const int tid) {
  const int wid = __builtin_amdgcn_readfirstlane(tid >> 6), lane = tid & 63, wr = wid >> 2, wc = wid & 3, fr = lane & 15, fq = lane >> 4;
  const int K = g.K, nt = K / BK;
  unsigned voffA[2], voffB[2];
#pragma unroll
  for (int i = 0; i < 2; ++i) { int R, C; stage_rc(tid * 16 + i * 8192, R, C); const int Rb = Epi::PERM ? ((R & ~31) + perm32(R & 31)) : R;
    voffA[i] = (unsigned)(R * g.lda + C) * 2u; voffB[i] = (unsigned)(Rb * K + C) * 2u; }
  const size_t kstep = (size_t)(BK * 2);
  const size_t hstepA = (size_t)HALF * g.lda * 2, hstepB = (size_t)HALF * K * 2;
  const size_t tstepA = 2 * hstepA, tstepB = 2 * hstepB;
  const unsigned ldsw = (unsigned)wid * 1024u;
  const int aoff = lds_byte(wr * 64 + fr, fq * 8), boff = lds_byte(wc * 32 + fr, fq * 8);
#define PG8_SA(b, h) (((b) * 2 + (h)) * HTB)
#define PG8_SB(b, h) ((4 + (b) * 2 + (h)) * HTB)
#define PG8_STAGE(bufoff, gbase, voff) do { _Pragma("unroll") for (int _i = 0; _i < 2; ++_i) \
    __builtin_amdgcn_global_load_lds((const unsigned*)((const char*)(gbase) + (voff)[_i]), (PG8_LAS unsigned*)(lds + (bufoff) + ldsw + _i * 8192), 16, 0, 0); } while (0)
#define PG8_LDA(dst, b, h) do { _Pragma("unroll") for (int m = 0; m < 4; ++m) _Pragma("unroll") for (int k = 0; k < 2; ++k) dst[m][k] = *(const PG8_LAS bf16x8*)(lds + PG8_SA(b, h) + aoff + m * 2048 + k * 1024); } while (0)
#define PG8_LDB(dst, b, h) do { _Pragma("unroll") for (int n = 0; n < 2; ++n) _Pragma("unroll") for (int k = 0; k < 2; ++k) dst[n][k] = *(const PG8_LAS bf16x8*)(lds + PG8_SB(b, h) + boff + n * 2048 + k * 1024); } while (0)
#define PG8_MMA(ai, bj, At, Bt) do { __builtin_amdgcn_s_setprio(1); _Pragma("unroll") for (int m = 0; m < 4; ++m) _Pragma("unroll") for (int n = 0; n < 2; ++n) _Pragma("unroll") for (int k = 0; k < 2; ++k) \
    acc[ai][bj][m][n] = __builtin_amdgcn_mfma_f32_16x16x32_bf16(Bt[n][k], At[m][k], acc[ai][bj][m][n], 0, 0, 0); __builtin_amdgcn_s_setprio(0); } while (0)
#define PG8_WAIT_V(n) asm volatile("s_waitcnt vmcnt(" #n ")" ::: "memory")
#define PG8_WAIT_L(n) asm volatile("s_waitcnt lgkmcnt(" #n ")" ::: "memory")
#define PG8_BAR __builtin_amdgcn_s_barrier()
#define PG8_SCHED __builtin_amdgcn_sched_barrier(0)
  Unit cur, nxt; int ui = 0;
  if (!S.next(0, cur)) return;
  f32x4 acc[2][2][4][2];
#pragma unroll
  for (int a = 0; a < 2; ++a)
#pragma unroll
    for (int b = 0; b < 2; ++b)
#pragma unroll
      for (int m = 0; m < 4; ++m)
#pragma unroll
        for (int n = 0; n < 2; ++n) acc[a][b][m][n] = (f32x4){0.f, 0.f, 0.f, 0.f};
  bf16x8 At[4][2], B0[2][2], B1[2][2];
  const char* cA = (const char*)g.A + (size_t)cur.pm * tstepA; const char* cB = (const char*)g.Bt + (size_t)cur.pn * tstepB;
  PG8_STAGE(PG8_SB(0, 0), cB, voffB); PG8_STAGE(PG8_SA(0, 0), cA, voffA); PG8_STAGE(PG8_SB(0, 1), cB + hstepB, voffB); PG8_STAGE(PG8_SA(0, 1), cA + hstepA, voffA);
  if (wr == 1) PG8_BAR;
  PG8_WAIT_V(4); PG8_BAR;
  PG8_STAGE(PG8_SB(1, 0), cB + kstep, voffB); PG8_STAGE(PG8_SA(1, 0), cA + kstep, voffA); PG8_STAGE(PG8_SB(1, 1), cB + hstepB + kstep, voffB);
  PG8_WAIT_V(6); PG8_BAR;
  for (;;) {
    const bool has_next = S.next(ui + 1, nxt);
    const char* nA = has_next ? (const char*)g.A + (size_t)nxt.pm * tstepA : cA; const char* nB = has_next ? (const char*)g.Bt + (size_t)nxt.pn * tstepB : cB;
    for (int t = 0; t < nt; t += 2) {
      const bool last = (t == nt - 2);
      const char* a1 = cA + (size_t)(t + 1) * kstep;
      const char* a2 = last ? nA : cA + (size_t)(t + 2) * kstep; const char* b2 = last ? nB : cB + (size_t)(t + 2) * kstep;
      const char* a3 = a2 + kstep; const char* b3 = b2 + kstep;
      PG8_LDB(B0, 0, 0); PG8_SCHED; PG8_LDA(At, 0, 0); PG8_STAGE(PG8_SA(1, 1), a1 + hstepA, voffA);
      PG8_WAIT_L(8); PG8_BAR; PG8_WAIT_L(0); PG8_MMA(0, 0, At, B0); PG8_BAR; PG8_SCHED;
      PG8_LDB(B1, 0, 1); PG8_STAGE(PG8_SB(0, 0), b2, voffB);
      PG8_BAR; PG8_WAIT_L(0); PG8_MMA(0, 1, At, B1); PG8_BAR;
      PG8_LDA(At, 0, 1); PG8_STAGE(PG8_SA(0, 0), a2, voffA);
      PG8_BAR; PG8_WAIT_L(0); PG8_MMA(1, 0, At, B0); PG8_BAR; PG8_SCHED;
      PG8_STAGE(PG8_SB(0, 1), b2 + hstepB, voffB);
      PG8_WAIT_V(6); PG8_BAR; PG8_MMA(1, 1, At, B1); PG8_BAR;
      PG8_LDB(B0, 1, 0); PG8_SCHED; PG8_LDA(At, 1, 0); PG8_STAGE(PG8_SA(0, 1), a2 + hstepA, voffA);
      PG8_WAIT_L(8); PG8_BAR; PG8_WAIT_L(0); PG8_MMA(0, 0, At, B0); PG8_BAR; PG8_SCHED;
      PG8_LDB(B1, 1, 1); PG8_STAGE(PG8_SB(1, 0), b3, voffB);
      PG8_BAR; PG8_WAIT_L(0); PG8_MMA(0, 1, At, B1); PG8_BAR;
      PG8_LDA(At, 1, 1); PG8_STAGE(PG8_SA(1, 0), a3, voffA);
      PG8_BAR; PG8_WAIT_L(0); PG8_MMA(1, 0, At, B0); PG8_BAR; PG8_SCHED;
      PG8_STAGE(PG8_SB(1, 1), b3 + hstepB, voffB);
      PG8_WAIT_V(6); PG8_BAR; PG8_MMA(1, 1, At, B1); PG8_BAR;
    }
    E(acc, cur, wr, wc, fr, fq, lane);
    if (!has_next) break;
#pragma unroll
    for (int a = 0; a < 2; ++a)
#pragma unroll
      for (int b = 0; b < 2; ++b)
#pragma unroll
        for (int m = 0; m < 4; ++m)
#pragma unroll
          for (int n = 0; n < 2; ++n) acc[a][b][m][n] = (f32x4){0.f, 0.f, 0.f, 0.f};
    cur = nxt; cA = nA; cB = nB; ++ui;
  }
  PG8_WAIT_V(0);
  if (wr == 0) PG8_BAR;
  PG8_BAR;
#undef PG8_SA
#undef PG8_SB
#undef PG8_STAGE
#undef PG8_LDA
#undef PG8_LDB
#undef PG8_MMA
#undef PG8_WAIT_V
#undef PG8_WAIT_L
#undef PG8_BAR
#undef PG8_SCHED
}
}

#define OFF_STATS OFF_GLR

__device__ __forceinline__ u32x4 pack8v(const f32x4& a, const f32x4& b) {
  u32x4 w; w.x = pg8::cvt_pk_bf16(a[0], a[1]); w.y = pg8::cvt_pk_bf16(a[2], a[3]); w.z = pg8::cvt_pk_bf16(b[0], b[1]); w.w = pg8::cvt_pk_bf16(b[2], b[3]); return w;
}
__device__ __forceinline__ float xlane32(float v, int lane) { return __int_as_float(__builtin_amdgcn_ds_bpermute((lane ^ 32) << 2, __float_as_int(v))); }

struct EpiScanIn {
  static constexpr bool PERM = true;
  u16* S; const float* rot;
  __device__ __forceinline__ void operator()(const f32x4 (&acc)[2][2][4][2], const pg8::Unit& u, int wr, int wc, int fr, int fq, int lane) const {
    u16* Sb = S + (size_t)u.pm * 256 * 4096;
    unsigned rl0 = wr * 64 + fr; asm volatile("" : "+v"(rl0));
#pragma unroll
    for (int bj = 0; bj < 2; ++bj) {
      const int nt128 = u.pn * 2 + bj;
      const bool scaled = (nt128 < 4) || (nt128 >= 16 && nt128 < 20);
      const float scl = scaled ? 0.08838834764831845f : 1.f;
      const unsigned cb = nt128 * 128 + wc * 32 + fq * 8;
      if (nt128 < 8 && u.pm < 128) {
        const int tb = (u.pm & 15) * 256;
        const int fo = ((wc & 1) * 16 + (fq & 1) * 8) * 2;
        const float sgn = (fq >> 1) ? 1.f : -1.f;
#pragma unroll
        for (int ai = 0; ai < 2; ++ai)
#pragma unroll
          for (int m = 0; m < 4; ++m) {
            const unsigned rl = rl0 + ai * 128 + m * 16;
            const int t = tb + rl;
            const unsigned pos = (wc >> 1) == 0 ? (t >> 6) : (t & 63);
            const float* rp = rot + pos * 64u + fo;
            const float4 c0 = *(const float4*)rp, c1 = *(const float4*)(rp + 4), c2 = *(const float4*)(rp + 8), c3 = *(const float4*)(rp + 12);
            const f32x4 v0 = acc[ai][bj][m][0], v1 = acc[ai][bj][m][1];
            f32x4 p0, p1;
#pragma unroll
            for (int j = 0; j < 4; ++j) { p0[j] = xlane32(v0[j], lane); p1[j] = xlane32(v1[j], lane); }
            f32x4 o0, o1;
            o0[0] = (v0[0] * c0.x + sgn * p0[0] * c0.y) * scl; o0[1] = (v0[1] * c0.z + sgn * p0[1] * c0.w) * scl;
            o0[2] = (v0[2] * c1.x + sgn * p0[2] * c1.y) * scl; o0[3] = (v0[3] * c1.z + sgn * p0[3] * c1.w) * scl;
            o1[0] = (v1[0] * c2.x + sgn * p1[0] * c2.y) * scl; o1[1] = (v1[1] * c2.z + sgn * p1[1] * c2.w) * scl;
            o1[2] = (v1[2] * c3.x + sgn * p1[2] * c3.y) * scl; o1[3] = (v1[3] * c3.z + sgn * p1[3] * c3.w) * scl;
            *(u32x4*)(Sb + rl * 4096u + cb) = pack8v(o0, o1);
            __builtin_amdgcn_sched_barrier(0);
          }
      } else {
#pragma unroll
        for (int ai = 0; ai < 2; ++ai)
#pragma unroll
          for (int m = 0; m < 4; ++m) {
            const unsigned rl = rl0 + ai * 128 + m * 16;
            *(u32x4*)(Sb + rl * 4096u + cb) = pack8v(acc[ai][bj][m][0] * scl, acc[ai][bj][m][1] * scl);
            __builtin_amdgcn_sched_barrier(0);
          }
      }
    }
  }
};

struct EpiGate {
  static constexpr bool PERM = true;
  const u16* RG; const float* stats; u16* S; const float* rgain; const float* ggain;
  __device__ __forceinline__ void operator()(const f32x4 (&acc)[2][2][4][2], const pg8::Unit& u, int wr, int wc, int fr, int fq, int lane) const {
    u16* Sb = S + (size_t)u.pm * 256 * 4096;
    unsigned rl0 = wr * 64 + fr; asm volatile("" : "+v"(rl0));
    if (u.pn < 8) {
      const int branch = u.pn >> 2, head = u.pn & 3;
      const u16* RGb = RG + (size_t)u.pm * 256 * 2048 + branch * 1024;
      const float* stb = stats + (size_t)u.pm * 256 * 16 + (branch * 4 + head) * 2;
      const float* gain = branch ? ggain : rgain;
#pragma unroll
      for (int bj = 0; bj < 2; ++bj) {
        const unsigned cb = head * 256 + bj * 128 + wc * 32 + fq * 8;
        const float4 g0 = *(const float4*)(gain + cb), g1 = *(const float4*)(gain + cb + 4);
#pragma unroll
        for (int ai = 0; ai < 2; ++ai)
#pragma unroll
          for (int m = 0; m < 4; ++m) {
            const unsigned rl = rl0 + ai * 128 + m * 16;
            const float2 st = *(const float2*)(stb + rl * 16u);
            const bf16x8 xr = *(const bf16x8*)(RGb + rl * 2048u + cb);
            f32x4 v0 = acc[ai][bj][m][0], v1 = acc[ai][bj][m][1];
            asm volatile("" : "+v"(v0), "+v"(v1));
            f32x4 o0, o1;
            o0[0] = (bf2f((u16)xr[0]) * st.x + st.y) * g0.x * siluf_(v0[0]); o0[1] = (bf2f((u16)xr[1]) * st.x + st.y) * g0.y * siluf_(v0[1]);
            o0[2] = (bf2f((u16)xr[2]) * st.x + st.y) * g0.z * siluf_(v0[2]); o0[3] = (bf2f((u16)xr[3]) * st.x + st.y) * g0.w * siluf_(v0[3]);
            o1[0] = (bf2f((u16)xr[4]) * st.x + st.y) * g1.x * siluf_(v1[0]); o1[1] = (bf2f((u16)xr[5]) * st.x + st.y) * g1.y * siluf_(v1[1]);
            o1[2] = (bf2f((u16)xr[6]) * st.x + st.y) * g1.z * siluf_(v1[2]); o1[3] = (bf2f((u16)xr[7]) * st.x + st.y) * g1.w * siluf_(v1[3]);
            *(u32x4*)(Sb + rl * 4096u + 2048u + branch * 1024 + cb) = pack8v(o0, o1);
            __builtin_amdgcn_sched_barrier(0);
          }
      }
    } else {
#pragma unroll
      for (int bj = 0; bj < 2; ++bj) {
        const unsigned cb = (u.pn - 8) * 256 + bj * 128 + wc * 32 + fq * 8;
#pragma unroll
        for (int ai = 0; ai < 2; ++ai)
#pragma unroll
          for (int m = 0; m < 4; ++m) {
            const unsigned rl = rl0 + ai * 128 + m * 16;
            f32x4 v0 = acc[ai][bj][m][0], v1 = acc[ai][bj][m][1];
            asm volatile("" : "+v"(v0), "+v"(v1));
            f32x4 o0, o1;
#pragma unroll
            for (int j = 0; j < 4; ++j) { o0[j] = sigmoidf_(v0[j]); o1[j] = sigmoidf_(v1[j]); }
            *(u32x4*)(Sb + rl * 4096u + cb) = pack8v(o0, o1);
            __builtin_amdgcn_sched_barrier(0);
          }
      }
    }
  }
};

struct EpiMerge {
  static constexpr bool PERM = true;
  const u16* S; u16* MG; int pass;
  __device__ __forceinline__ void operator()(const f32x4 (&acc)[2][2][4][2], const pg8::Unit& u, int wr, int wc, int fr, int fq, int lane) const {
    const u16* Sb = S + (size_t)u.pm * 256 * 4096 + pass * 1024;
    u16* MGb = MG + (size_t)u.pm * 256 * 1024;
    unsigned rl0 = wr * 64 + fr; asm volatile("" : "+v"(rl0));
#pragma unroll
    for (int bj = 0; bj < 2; ++bj) {
      const unsigned cb = u.pn * 256 + bj * 128 + wc * 32 + fq * 8;
#pragma unroll
      for (int ai = 0; ai < 2; ++ai)
#pragma unroll
        for (int m = 0; m < 4; ++m) {
          const unsigned rl = rl0 + ai * 128 + m * 16;
          const bf16x8 gt = *(const bf16x8*)(Sb + rl * 4096u + cb);
          f32x4 o0 = acc[ai][bj][m][0], o1 = acc[ai][bj][m][1];
#pragma unroll
          for (int j = 0; j < 4; ++j) { o0[j] *= bf2f((u16)gt[j]); o1[j] *= bf2f((u16)gt[4 + j]); }
          if (pass) {
            const bf16x8 old = *(const bf16x8*)(MGb + rl * 1024u + cb);
#pragma unroll
            for (int j = 0; j < 4; ++j) { o0[j] += bf2f((u16)old[j]); o1[j] += bf2f((u16)old[4 + j]); }
          }
          *(u32x4*)(MGb + rl * 1024u + cb) = pack8v(o0, o1);
            __builtin_amdgcn_sched_barrier(0);
        }
    }
  }
};

struct EpiOut {
  static constexpr bool PERM = false;
  const float* x_lat; const float* x_ctx; float* o_lat; float* o_ctx; const float* mod;
  __device__ __forceinline__ void operator()(const f32x4 (&acc)[2][2][4][2], const pg8::Unit& u, int wr, int wc, int fr, int fq, int lane) const {
    const float* hin; float* hout; int rmod;
    if (u.pm < 128) { hin = x_lat + (size_t)u.pm * 256 * DM; hout = o_lat + (size_t)u.pm * 256 * DM; rmod = u.pm >> 4; }
    else { hin = x_ctx + (size_t)(u.pm - 128) * 256 * DM; hout = o_ctx + (size_t)(u.pm - 128) * 256 * DM; rmod = 8; }
    const float* gate = mod + rmod * 3072 + 2048;
    unsigned rl0 = wr * 64 + fr; asm volatile("" : "+v"(rl0));
#pragma unroll
    for (int bj = 0; bj < 2; ++bj)
#pragma unroll
      for (int n = 0; n < 2; ++n) {
        const unsigned cb = u.pn * 256 + bj * 128 + wc * 32 + n * 16 + fq * 4;
        const float4 g = *(const float4*)(gate + cb);
#pragma unroll
        for (int ai = 0; ai < 2; ++ai)
#pragma unroll
          for (int m = 0; m < 4; ++m) {
            const unsigned o = (rl0 + ai * 128 + m * 16) * 1024u + cb;
            const float4 h = *(const float4*)(hin + o);
            const f32x4 v = acc[ai][bj][m][n];
            *(float4*)(hout + o) = make_float4(h.x + g.x * v[0], h.y + g.y * v[1], h.z + g.z * v[2], h.w + g.w * v[3]);
          }
      }
  }
};

__device__ __forceinline__ void phase_stats(const Params& p, int l) {
  const int tid = opaque_tid(); const int wave = tid >> 6, lane = tid & 63;
  const u16* RG = (const u16*)(p.ws + OFF_RG);
  float* ST = (float*)(p.ws + OFF_STATS);
  const int nrows = (l == 0) ? MTOT : MLAT;
  for (int row = (blockIdx.x * 8 + wave) * 4; row < nrows; row += gridDim.x * 32) {
    bf16x8 v[4][4];
#pragma unroll
    for (int q = 0; q < 4; ++q)
#pragma unroll
      for (int i = 0; i < 4; ++i) v[q][i] = *(const bf16x8*)(RG + (size_t)(row + q) * 2048 + i * 512 + lane * 8);
#pragma unroll
    for (int q = 0; q < 4; ++q)
#pragma unroll
      for (int i = 0; i < 4; ++i) {
        float s1 = 0.f, s2 = 0.f;
#pragma unroll
        for (int x = 0; x < 8; ++x) { float a = bf2f((u16)v[q][i][x]); s1 += a; s2 += a * a; }
#pragma unroll
        for (int o = 16; o > 0; o >>= 1) {
          s1 += __int_as_float(__builtin_amdgcn_ds_bpermute((lane ^ o) << 2, __float_as_int(s1)));
          s2 += __int_as_float(__builtin_amdgcn_ds_bpermute((lane ^ o) << 2, __float_as_int(s2)));
        }
        float sa, sb;
        if ((i >> 1) == 0) { float mu = s1 * (1.f / 256.f); float var = fmaxf(s2 * (1.f / 256.f) - mu * mu, 0.f); sa = rsqrtf(var + 1e-6f); sb = -mu * sa; }
        else { sa = rsqrtf(s2 * (1.f / 256.f) + 1e-6f); sb = 0.f; }
        if ((lane & 31) == 0) *(float2*)(ST + ((size_t)(row + q) * 8 + (i >> 1) * 4 + 2 * (i & 1) + (lane >> 5)) * 2) = make_float2(sa, sb);
      }
  }
}

#define OFF_VECS OFF_WT
__device__ __forceinline__ float logsig16(float x) { return (fminf(x, 0.f) - __logf(1.f + __expf(-fabsf(x)))) * (1.f / 16.f); }

typedef __attribute__((ext_vector_type(2))) float f32x2_t;

template <int SW>
__device__ __forceinline__ void prepass_sweep4(const float* GLRS, const f32x2_t (&w2)[4][16], const f32x2_t (&b2)[4], u16* Sq, u16* Ub,
                                               float (&accF)[4], float (&accB)[4]) {
#pragma unroll
  for (int c = 0; c < 4; ++c) { accF[c] = 0.f; accB[c] = 0.f; }
#pragma unroll 2
  for (int u = 0; u < 32; ++u) {
    const int i = SW ? 32 + u : 31 - u;
    const bf16x4 q4 = *(const bf16x4*)(Sq + (unsigned)i * 4096u);
    const bf16x4 k4 = *(const bf16x4*)(Sq + (unsigned)i * 4096u + 512u);
    const float4* gr = (const float4*)(GLRS + (i & 31) * 16);
    const float4 g0 = gr[0], g1 = gr[1], g2 = gr[2], g3 = gr[3];
    bf16x4 oqf, okf, oqb, okb;
#pragma unroll
    for (int c = 0; c < 4; ++c) {
      f32x2_t x = b2[c];
      x = w2[c][0] * g0.x + x;  x = w2[c][1] * g0.y + x;  x = w2[c][2] * g0.z + x;  x = w2[c][3] * g0.w + x;
      x = w2[c][4] * g1.x + x;  x = w2[c][5] * g1.y + x;  x = w2[c][6] * g1.z + x;  x = w2[c][7] * g1.w + x;
      x = w2[c][8] * g2.x + x;  x = w2[c][9] * g2.y + x;  x = w2[c][10] * g2.z + x; x = w2[c][11] * g2.w + x;
      x = w2[c][12] * g3.x + x; x = w2[c][13] * g3.y + x; x = w2[c][14] * g3.z + x; x = w2[c][15] * g3.w + x;
      const float laf = logsig16(x.x), lab = logsig16(x.y);
      float relf, relb;
      if (SW == 0) { relf = -accF[c]; accF[c] += laf; accB[c] += lab; relb = accB[c]; }
      else         { accF[c] += laf; relf = accF[c]; relb = -accB[c]; accB[c] += lab; }
      const float q = bf2f((u16)q4[c]), k = bf2f((u16)k4[c]);
      oqf[c] = (short)f2bf(q * __expf(relf)); okf[c] = (short)f2bf(k * __expf(-relf));
      oqb[c] = (short)f2bf(q * __expf(relb)); okb[c] = (short)f2bf(k * __expf(-relb));
    }
    *(bf16x4*)(Sq + (unsigned)i * 4096u) = oqf;
    *(bf16x4*)(Sq + (unsigned)i * 4096u + 512u) = okf;
    *(bf16x4*)(Ub + (unsigned)i * 1024u) = oqb;
    *(bf16x4*)(Ub + (unsigned)i * 1024u + 512u) = okb;
  }
}

__device__ __forceinline__ void gla_prepass_unit(const Params& p, int l, int bunit, char* smem) {
  const int tid = opaque_tid();
  const int ul = __builtin_amdgcn_readfirstlane(tid >> 7);
  const int gu = bunit * 4 + ul;
  const int sw = gu & 1, ch = gu >> 1;
  const int b = ch / 68, cid = ch % 68;
  const int base = cid < 4 ? (MLAT + b * 256 + cid * 64) : (b * 4096 + (cid - 4) * 64);
  float* GLRS = (float*)smem + ul * 512;
  const int col0 = (tid & 127) * 4;
  __syncthreads();
  {
    const int uw = (tid >> 6) & 1, lane = tid & 63, fr = lane & 15, fq = lane >> 4;
    f32x4 g = (f32x4){0.f, 0.f, 0.f, 0.f};
    const u16* Ua = (const u16*)(p.ws + OFF_U) + (size_t)(base + sw * 32 + uw * 16 + fr) * 1024 + fq * 8;
    const u16* Wb = (const u16*)(p.ws + OFF_WT) + (size_t)(4096 + fr) * 1024 + fq * 8;
#pragma unroll 16
    for (int k = 0; k < 1024; k += 32) {
      bf16x8 a = *(const bf16x8*)(Ua + k);
      bf16x8 w = *(const bf16x8*)(Wb + k);
      g = __builtin_amdgcn_mfma_f32_16x16x32_bf16(a, w, g, 0, 0, 0);
    }
#pragma unroll
    for (int j = 0; j < 4; ++j) GLRS[(uw * 16 + fq * 4 + j) * 16 + fr] = g[j];
  }
  f32x2_t w2[4][16], b2[4];
  {
    const float* w0 = p.gla_w_up + (size_t)(l * 2 + 0) * 16 * 512 + col0;
    const float* w1 = p.gla_w_up + (size_t)(l * 2 + 1) * 16 * 512 + col0;
#pragma unroll
    for (int r = 0; r < 16; ++r) {
      const float4 a = *(const float4*)(w0 + r * 512), c = *(const float4*)(w1 + r * 512);
      w2[0][r].x = a.x; w2[1][r].x = a.y; w2[2][r].x = a.z; w2[3][r].x = a.w;
      w2[0][r].y = c.x; w2[1][r].y = c.y; w2[2][r].y = c.z; w2[3][r].y = c.w;
    }
    const float4 a = *(const float4*)(p.gla_b_up + (l * 2 + 0) * 512 + col0), c = *(const float4*)(p.gla_b_up + (l * 2 + 1) * 512 + col0);
    b2[0].x = a.x; b2[1].x = a.y; b2[2].x = a.z; b2[3].x = a.w;
    b2[0].y = c.x; b2[1].y = c.y; b2[2].y = c.z; b2[3].y = c.w;
  }
  __syncthreads();
  u16* Sq = (u16*)(p.ws + OFF_S) + (size_t)base * 4096 + 2048 + col0;
  u16* Ub = (u16*)(p.ws + OFF_U) + (size_t)base * 1024 + col0;
  float* V0 = (float*)(p.ws + OFF_VECS) + ((size_t)(0 * 544 + b * 68 + cid) * 2) * 512 + col0;
  float* V1 = (float*)(p.ws + OFF_VECS) + ((size_t)(1 * 544 + b * 68 + cid) * 2) * 512 + col0;
  float accF[4], accB[4];
  if (sw == 0) {
    prepass_sweep4<0>(GLRS, w2, b2, Sq, Ub, accF, accB);
    *(float4*)(V0) = make_float4(__expf(accF[0]), __expf(accF[1]), __expf(accF[2]), __expf(accF[3]));
    *(float4*)(V1 + 512) = make_float4(__expf(accB[0]), __expf(accB[1]), __expf(accB[2]), __expf(accB[3]));
  } else {
    prepass_sweep4<1>(GLRS, w2, b2, Sq, Ub, accF, accB);
    *(float4*)(V0 + 512) = make_float4(__expf(accF[0]), __expf(accF[1]), __expf(accF[2]), __expf(accF[3]));
    *(float4*)(V1) = make_float4(__expf(accB[0]), __expf(accB[1]), __expf(accB[2]), __expf(accB[3]));
  }
}

template <int SW>
__device__ __forceinline__ void prepass_sweep(const float* GLRS, const f32x2_t (&w2)[16], f32x2_t b2, u16* Sq, u16* Ub, float& accF, float& accB) {
  accF = 0.f; accB = 0.f;
#pragma unroll 16
  for (int u = 0; u < 32; ++u) {
    const int i = SW ? 32 + u : 31 - u;
    const float4* gr = (const float4*)(GLRS + i * 16);
    const float4 g0 = gr[0], g1 = gr[1], g2 = gr[2], g3 = gr[3];
    f32x2_t x = b2;
    x = w2[0] * g0.x + x;  x = w2[1] * g0.y + x;  x = w2[2] * g0.z + x;  x = w2[3] * g0.w + x;
    x = w2[4] * g1.x + x;  x = w2[5] * g1.y + x;  x = w2[6] * g1.z + x;  x = w2[7] * g1.w + x;
    x = w2[8] * g2.x + x;  x = w2[9] * g2.y + x;  x = w2[10] * g2.z + x; x = w2[11] * g2.w + x;
    x = w2[12] * g3.x + x; x = w2[13] * g3.y + x; x = w2[14] * g3.z + x; x = w2[15] * g3.w + x;
    const float laf = logsig16(x.x), lab = logsig16(x.y);
    float relf, relb;
    if (SW == 0) { relf = -accF; accF += laf; accB += lab; relb = accB; }
    else         { accF += laf; relf = accF; relb = -accB; accB += lab; }
    const float q = bf2f(Sq[(unsigned)i * 4096u]), k = bf2f(Sq[(unsigned)i * 4096u + 512u]);
    Sq[(unsigned)i * 4096u] = f2bf(q * __expf(relf));
    Sq[(unsigned)i * 4096u + 512u] = f2bf(k * __expf(-relf));
    Ub[(unsigned)i * 1024u] = f2bf(q * __expf(relb));
    Ub[(unsigned)i * 1024u + 512u] = f2bf(k * __expf(-relb));
  }
}

__device__ __forceinline__ void gla_prepass_unit1(const Params& p, int l, int unit, char* smem) {
  const int tid = opaque_tid();
  const int sw = unit & 1, ch = unit >> 1;
  const int b = ch / 68, cid = ch % 68;
  const int base = cid < 4 ? (MLAT + b * 256 + cid * 64) : (b * 4096 + (cid - 4) * 64);
  float* GLRS = (float*)smem;
  __syncthreads();
  {
    const int wid = tid >> 6, lane = tid & 63, fr = lane & 15, fq = lane >> 4;
    if (wid < 2) {
      const int r0 = sw * 32 + wid * 16;
      f32x4 g = (f32x4){0.f, 0.f, 0.f, 0.f};
      const u16* Ua = (const u16*)(p.ws + OFF_U) + (size_t)(base + r0 + fr) * 1024 + fq * 8;
      const u16* Wb = (const u16*)(p.ws + OFF_WT) + (size_t)(4096 + fr) * 1024 + fq * 8;
#pragma unroll 16
      for (int k = 0; k < 1024; k += 32) {
        bf16x8 a = *(const bf16x8*)(Ua + k);
        bf16x8 w = *(const bf16x8*)(Wb + k);
        g = __builtin_amdgcn_mfma_f32_16x16x32_bf16(a, w, g, 0, 0, 0);
      }
#pragma unroll
      for (int j = 0; j < 4; ++j) GLRS[(r0 + fq * 4 + j) * 16 + fr] = g[j];
    }
  }
  f32x2_t w2[16];
  {
    const float* w0 = p.gla_w_up + (size_t)(l * 2 + 0) * 16 * 512 + tid;
    const float* w1 = p.gla_w_up + (size_t)(l * 2 + 1) * 16 * 512 + tid;
#pragma unroll
    for (int r = 0; r < 16; ++r) { w2[r].x = w0[r * 512]; w2[r].y = w1[r * 512]; }
  }
  f32x2_t b2; b2.x = p.gla_b_up[(l * 2 + 0) * 512 + tid]; b2.y = p.gla_b_up[(l * 2 + 1) * 512 + tid];
  __syncthreads();
  u16* Sq = (u16*)(p.ws + OFF_S) + (size_t)base * 4096 + 2048 + tid;
  u16* Ub = (u16*)(p.ws + OFF_U) + (size_t)base * 1024 + tid;
  float* V0 = (float*)(p.ws + OFF_VECS) + ((size_t)(0 * 544 + b * 68 + cid) * 2) * 512 + tid;
  float* V1 = (float*)(p.ws + OFF_VECS) + ((size_t)(1 * 544 + b * 68 + cid) * 2) * 512 + tid;
  float accF, accB;
  if (sw == 0) {
    prepass_sweep<0>(GLRS, w2, b2, Sq, Ub, accF, accB);
    V0[0] = __expf(accF);
    V1[512] = __expf(accB);
  } else {
    prepass_sweep<1>(GLRS, w2, b2, Sq, Ub, accF, accB);
    V0[512] = __expf(accF);
    V1[0] = __expf(accB);
  }
}

#define L_QR   0
#define L_KR   17408
#define L_V    34816
#define L_SGT  44032
#define L_P    61440
#undef  SCAN_GB
#define SCAN_GB 70656

__device__ __forceinline__ int off128(int row, int col) { return row * 272 + col * 2; }
__device__ __forceinline__ int off64(int row, int col) { return row * 144 + col * 2; }

template <int RS>
__device__ __forceinline__ bf16x8 tr_frag(unsigned img_addr, int r0, int c0, int lane) {
  const int g = lane >> 4, q = (lane & 15) >> 2, pp = lane & 3;
  unsigned a = img_addr + (unsigned)((r0 + 8 * g + q) * RS + (c0 + 4 * pp) * 2);
  bf16x4 lo, hi;
  asm volatile("ds_read_b64_tr_b16 %0, %2\n\tds_read_b64_tr_b16 %1, %2 offset:%3\n\ts_waitcnt lgkmcnt(0)"
               : "=&v"(lo), "=&v"(hi) : "v"(a), "n"(4 * RS) : "memory");
  bf16x8 r;
  r[0] = lo[0]; r[1] = lo[1]; r[2] = lo[2]; r[3] = lo[3]; r[4] = hi[0]; r[5] = hi[1]; r[6] = hi[2]; r[7] = hi[3];
  return r;
}

__device__ __forceinline__ bf16x8 scale8(bf16x8 v, float f) {
  bf16x8 o;
#pragma unroll
  for (int x = 0; x < 8; ++x) o[x] = (short)f2bf(bf2f((u16)v[x]) * f);
  return o;
}

__device__ __forceinline__ void lds_barrier() { asm volatile("s_waitcnt lgkmcnt(0)" ::: "memory"); __builtin_amdgcn_s_barrier(); asm volatile("" ::: "memory"); }

template <int branch>
__device__ __forceinline__ void scan_item(const Params& p, int l, int item, char* smem) {
  const int b = (item >> 4) & 7, h = (item >> 2) & 3, slice = item & 3;
  const int tid = opaque_tid(), wid = __builtin_amdgcn_readfirstlane(tid >> 6), lane = tid & 63;
  const int dir = wid >> 2, gw = wid & 3, gt = tid & 255;
  const int fr = lane & 15, fq = lane >> 4;
  char* G = smem + dir * SCAN_GB;
  const unsigned Ga = (unsigned)(size_t)G;
  const u16* S = (const u16*)(p.ws + OFF_S);
  u16* RG = (u16*)(p.ws + OFF_RG);
  const u16* qsrc; unsigned qstride;
  if (branch == 0) { qsrc = S + h * 128; qstride = 4096; }
  else if (dir == 0) { qsrc = S + 2048 + h * 128; qstride = 4096; }
  else { qsrc = (const u16*)(p.ws + OFF_U) + h * 128; qstride = 1024; }
  const int voff = branch * 2048 + 1024 + h * 256 + slice * 64;
  const int ooff = branch * 1024 + h * 256 + slice * 64;
  float lg = 0.f, egc = 1.f;
  if (branch == 0) { lg = __logf(1.f - __expf(p.ret_decay[(l * 2 + dir) * 4 + h])); egc = __expf(32.f * lg); }
  const float* VECS = (const float*)(p.ws + OFF_VECS) + ((size_t)(dir * 544 + b * 68) * 2) * 512 + h * 128;
  f32x4 st[2][4];
#pragma unroll
  for (int m = 0; m < 2; ++m)
#pragma unroll
    for (int n = 0; n < 4; ++n) st[m][n] = (f32x4){0.f, 0.f, 0.f, 0.f};

  const int qj = gt >> 4, qc = gt & 15;
  const int vj = gt >> 3, vc = gt & 7;
  bf16x8 pq[4], pk[4], pv[2];
  float4 peg[2], pel[2];
  auto prefetch = [&](int s) {
    int base, cid;
    if (s < 4) { int cc = dir ? 3 - s : s; base = MLAT + b * 256 + cc * 64; cid = cc; }
    else { int c = s - 4; int cc = dir ? 63 - c : c; base = b * 4096 + cc * 64; cid = 4 + cc; }
#pragma unroll
    for (int i = 0; i < 4; ++i) {
      int jp = qj + 16 * i;
      unsigned ro = (unsigned)(base + (dir ? 63 - jp : jp)) * qstride + qc * 8;
      pq[i] = *(const bf16x8*)(qsrc + ro);
      pk[i] = *(const bf16x8*)(qsrc + ro + 512);
    }
#pragma unroll
    for (int i = 0; i < 2; ++i) {
      int jp = vj + 32 * i;
      pv[i] = *(const bf16x8*)(S + (size_t)(base + (dir ? 63 - jp : jp)) * 4096 + voff + vc * 8);
    }
    if (branch == 1) {
#pragma unroll
      for (int m = 0; m < 2; ++m) {
        int d0 = gw * 32 + m * 16 + fq * 4;
        peg[m] = *(const float4*)(VECS + (size_t)cid * 1024 + d0);
        pel[m] = *(const float4*)(VECS + (size_t)cid * 1024 + 512 + d0);
      }
    }
  };
  prefetch(0);
  __syncthreads();

  for (int s = 0; s < 68; ++s) {
    int base; bool first; bool wout;
    if (s < 4) { int cc = dir ? 3 - s : s; base = MLAT + b * 256 + cc * 64; first = s < 2; wout = (l == 0); }
    else { int c = s - 4; int cc = dir ? 63 - c : c; base = b * 4096 + cc * 64; first = c < 32; wout = true; }
    float4 eg[2], el[2];
#pragma unroll
    for (int m = 0; m < 2; ++m) {
      if (branch == 1) { eg[m] = peg[m]; el[m] = pel[m]; }
      else { eg[m] = make_float4(egc, egc, egc, egc); el[m] = eg[m]; }
    }
#pragma unroll
    for (int i = 0; i < 4; ++i) {
      int jp = qj + 16 * i;
      bf16x8 qv = pq[i], kv_ = pk[i];
      if (branch == 0) {
        float fqs = __expf((float)(jp - 31) * lg), fks = __expf((float)(31 - jp) * lg);
        qv = scale8(qv, fqs); kv_ = scale8(kv_, fks);
      }
      *(bf16x8*)(G + L_QR + off128(jp, qc * 8)) = qv;
      *(bf16x8*)(G + L_KR + off128(jp, qc * 8)) = kv_;
    }
#pragma unroll
    for (int i = 0; i < 2; ++i) *(bf16x8*)(G + L_V + off64(vj + 32 * i, vc * 8)) = pv[i];
#pragma unroll
    for (int m = 0; m < 2; ++m) {
      int d0 = gw * 32 + m * 16 + fq * 4;
#pragma unroll
      for (int n = 0; n < 4; ++n) {
        int e = n * 16 + fr;
        bf16x4 o4;
        o4[0] = (short)f2bf(st[m][n][0] * eg[m].x); o4[1] = (short)f2bf(st[m][n][1] * eg[m].y);
        o4[2] = (short)f2bf(st[m][n][2] * eg[m].z); o4[3] = (short)f2bf(st[m][n][3] * eg[m].w);
        *(bf16x4*)(G + L_SGT + off128(e, d0)) = o4;
      }
    }
    u16 oldv[4][4];
    u16* dstb = RG + (size_t)base * 2048 + ooff + fr;
    if (wout && !first) {
#pragma unroll
      for (int r = 0; r < 4; ++r) {
        int ip = gw * 16 + fq * 4 + r;
        unsigned ro = (unsigned)(dir ? 63 - ip : ip) * 2048u;
#pragma unroll
        for (int n = 0; n < 4; ++n) oldv[r][n] = dstb[ro + n * 16];
      }
    }
    if (s + 1 < 68) prefetch(s + 1);
    lds_barrier();
    f32x4 pt[4], o[4];
#pragma unroll
    for (int n = 0; n < 4; ++n) { pt[n] = (f32x4){0.f, 0.f, 0.f, 0.f}; o[n] = (f32x4){0.f, 0.f, 0.f, 0.f}; }
#pragma unroll
    for (int ks = 0; ks < 4; ++ks) {
      int kc = ks * 32 + fq * 8;
      bf16x8 qa = *(const bf16x8*)(G + L_QR + off128(gw * 16 + fr, kc));
#pragma unroll
      for (int n = 0; n < 4; ++n) {
        bf16x8 ka = *(const bf16x8*)(G + L_KR + off128(n * 16 + fr, kc));
        bf16x8 sb = *(const bf16x8*)(G + L_SGT + off128(n * 16 + fr, kc));
        pt[n] = __builtin_amdgcn_mfma_f32_16x16x32_bf16(ka, qa, pt[n], 0, 0, 0);
        o[n] = __builtin_amdgcn_mfma_f32_16x16x32_bf16(qa, sb, o[n], 0, 0, 0);
      }
    }
    {
      const int ip = gw * 16 + fr;
#pragma unroll
      for (int n = 0; n < 4; ++n) {
        const int j0 = n * 16 + fq * 4;
        bf16x4 w;
#pragma unroll
        for (int r = 0; r < 4; ++r) {
          int jp = j0 + r;
          bool keep = dir ? (ip > jp) : (ip >= jp);
          w[r] = (short)f2bf(keep ? pt[n][r] : 0.f);
        }
        *(bf16x4*)(G + L_P + off64(ip, j0)) = w;
      }
    }
    asm volatile("s_waitcnt lgkmcnt(0)" ::: "memory");
    {
      const int tg = lane >> 4, tq = (lane & 15) >> 2, tp = lane & 3;
      const unsigned ka0 = Ga + L_KR + (unsigned)((8 * tg + tq) * 272 + (gw * 32 + 4 * tp) * 2);
      const unsigned va0 = Ga + L_V + (unsigned)((8 * tg + tq) * 144 + (4 * tp) * 2);
#pragma unroll
      for (int m = 0; m < 2; ++m) {
        f32x4 kv[4];
#pragma unroll
        for (int n = 0; n < 4; ++n) kv[n] = (f32x4){0.f, 0.f, 0.f, 0.f};
#pragma unroll
        for (int ks = 0; ks < 2; ++ks) {
          int kc = ks * 32 + fq * 8;
          bf16x4 r0, r1, r2, r3, r4, r5, r6, r7, r8, r9;
          asm volatile(
              "ds_read_b64_tr_b16 %0, %10\n\tds_read_b64_tr_b16 %1, %10 offset:1088\n\t"
              "ds_read_b64_tr_b16 %2, %11\n\tds_read_b64_tr_b16 %3, %11 offset:576\n\t"
              "ds_read_b64_tr_b16 %4, %11 offset:32\n\tds_read_b64_tr_b16 %5, %11 offset:608\n\t"
              "ds_read_b64_tr_b16 %6, %11 offset:64\n\tds_read_b64_tr_b16 %7, %11 offset:640\n\t"
              "ds_read_b64_tr_b16 %8, %11 offset:96\n\tds_read_b64_tr_b16 %9, %11 offset:672\n\t"
              "s_waitcnt lgkmcnt(0)"
              : "=&v"(r0), "=&v"(r1), "=&v"(r2), "=&v"(r3), "=&v"(r4), "=&v"(r5), "=&v"(r6), "=&v"(r7), "=&v"(r8), "=&v"(r9)
              : "v"(ka0 + (unsigned)(ks * 32 * 272 + m * 32)), "v"(va0 + (unsigned)(ks * 32 * 144))
              : "memory");
          bf16x8 km = __builtin_shufflevector(r0, r1, 0, 1, 2, 3, 4, 5, 6, 7);
          bf16x8 vb[4];
          vb[0] = __builtin_shufflevector(r2, r3, 0, 1, 2, 3, 4, 5, 6, 7);
          vb[1] = __builtin_shufflevector(r4, r5, 0, 1, 2, 3, 4, 5, 6, 7);
          vb[2] = __builtin_shufflevector(r6, r7, 0, 1, 2, 3, 4, 5, 6, 7);
          vb[3] = __builtin_shufflevector(r8, r9, 0, 1, 2, 3, 4, 5, 6, 7);
          bf16x8 pa;
          if (m == 0) pa = *(const bf16x8*)(G + L_P + off64(gw * 16 + fr, kc));
#pragma unroll
          for (int n = 0; n < 4; ++n) {
            if (m == 0) o[n] = __builtin_amdgcn_mfma_f32_16x16x32_bf16(pa, vb[n], o[n], 0, 0, 0);
            kv[n] = __builtin_amdgcn_mfma_f32_16x16x32_bf16(km, vb[n], kv[n], 0, 0, 0);
          }
        }
#pragma unroll
        for (int n = 0; n < 4; ++n) {
          st[m][n][0] = eg[m].x * el[m].x * st[m][n][0] + el[m].x * kv[n][0];
          st[m][n][1] = eg[m].y * el[m].y * st[m][n][1] + el[m].y * kv[n][1];
          st[m][n][2] = eg[m].z * el[m].z * st[m][n][2] + el[m].z * kv[n][2];
          st[m][n][3] = eg[m].w * el[m].w * st[m][n][3] + el[m].w * kv[n][3];
        }
      }
    }
    if (wout) {
#pragma unroll
      for (int r = 0; r < 4; ++r) {
        int ip = gw * 16 + fq * 4 + r;
        unsigned ro = (unsigned)(dir ? 63 - ip : ip) * 2048u;
#pragma unroll
        for (int n = 0; n < 4; ++n) {
          float v = o[n][r];
          if (!first) v += bf2f(oldv[r][n]);
          dstb[ro + n * 16] = f2bf(v);
        }
      }
    }
    __syncthreads();
  }
}

#define NPHASE 18
__device__ __forceinline__ void run_phase(const Params& p, int ph, char* smem) {
  const int nblk = gridDim.x, bid = blockIdx.x;
  if (ph == 0) {
#ifdef REP_P0
    for (int rep = 0; rep < REP_P0; ++rep)
#endif
    for (int u = bid; u < WT_UNITS + 96 + 1; u += nblk) {
      if (u < 96) mod_unit(p, u, smem);
      else if (u == 96) rot_unit(p);
      else wt_unit(p, 0, u - 97, smem);
    }
    return;
  }
  if (ph == NPHASE - 1) { phase_final(p); return; }
  const int l = (ph - 1) / 8, sp = (ph - 1) % 8;
  PG8_LAS unsigned char* lds = (PG8_LAS unsigned char*)smem;
  switch (sp) {
    case 0:
      phase_u(p, l);
      if (l == 1) for (int u = bid; u < WT_UNITS; u += nblk) wt_unit(p, 1, u, smem);
      break;
    case 1: {
      pg8::Gemm g{(const u16*)(p.ws + OFF_U), (const u16*)(p.ws + OFF_WT) + (size_t)WT_SCAN * 1024, 1024, MTOT, 4096, 1024};
      pg8::StaticOrder S; S.init(g.M, g.N, nblk, bid);
      EpiScanIn E{(u16*)(p.ws + OFF_S), (const float*)(p.ws + OFF_ROT)};
      pg8::gemm_phase(lds, g, S, E, opaque_tid());
    } break;
    case 2:
      for (int t = bid; t < 256; t += nblk) gla_prepass_unit(p, l, t, smem);
      for (int t = 1024 + (bid + 96) % nblk; t < 1088; t += nblk) gla_prepass_unit1(p, l, t, smem);
      break;
    case 3:
#ifdef REP_SCAN
      for (int rep = 0; rep < REP_SCAN; ++rep)
#endif
      for (int t = bid; t < 256; t += nblk) { if (t < 128) scan_item<0>(p, l, t, smem); else scan_item<1>(p, l, t, smem); } break;
    case 4:
      phase_u(p, l);
      phase_stats(p, l);
      break;
    case 5: {
      pg8::Gemm g{(const u16*)(p.ws + OFF_U), (const u16*)(p.ws + OFF_WT) + (size_t)WT_GATE * 1024, 1024, l == 0 ? MTOT : MLAT, 4096, 1024};
      pg8::StaticOrder S; S.init(g.M, g.N, nblk, bid);
      EpiGate E{(const u16*)(p.ws + OFF_RG), (const float*)(p.ws + OFF_STATS), (u16*)(p.ws + OFF_S), p.ret_norm_gain + l * 1024, p.gla_norm_gain + l * 1024};
      pg8::gemm_phase(lds, g, S, E, opaque_tid());
    } break;
    case 6: {
#pragma unroll 1
      for (int pass = 0; pass < 2; ++pass) {
        pg8::Gemm g{(const u16*)(p.ws + OFF_S) + 2048 + pass * 1024, (const u16*)(p.ws + OFF_WT) + (size_t)(WT_BRR + pass * 1024) * 1024, 4096, l == 0 ? MTOT : MLAT, 1024, 1024};
        pg8::StaticOrder S; S.init(g.M, g.N, nblk, bid);
        EpiMerge E{(const u16*)(p.ws + OFF_S), (u16*)(p.ws + OFF_U), pass};
        pg8::gemm_phase(lds, g, S, E, opaque_tid());
      }
    } break;
    case 7: {
      pg8::Gemm g{(const u16*)(p.ws + OFF_U), (const u16*)(p.ws + OFF_WT) + (size_t)WT_OUT * 1024, 1024, l == 0 ? MTOT : MLAT, 1024, 1024};
      pg8::StaticOrder S; S.init(g.M, g.N, nblk, bid);
      EpiOut E{l == 0 ? p.x : p.out, p.ctx, p.out, (float*)(p.ws + OFF_HCTX), (const float*)(p.ws + OFF_MOD) + (size_t)l * 9 * 3072};
      pg8::gemm_phase(lds, g, S, E, opaque_tid());
    } break;
  }
}

__device__ __forceinline__ void grid_barrier(unsigned* cnt, unsigned target) {
  asm volatile("s_waitcnt vmcnt(0)" ::: "memory");
  __syncthreads();
  if (threadIdx.x == 0) {
    __threadfence();
    __hip_atomic_fetch_add(cnt, 1u, __ATOMIC_RELAXED, __HIP_MEMORY_SCOPE_AGENT);
    while (__hip_atomic_load(cnt, __ATOMIC_RELAXED, __HIP_MEMORY_SCOPE_AGENT) < target) __builtin_amdgcn_s_sleep(2);
    __threadfence();
  }
  __syncthreads();
}

__global__ void __launch_bounds__(NTHREADS) mega(Params p, int ph_lo, int ph_hi, int coop) {
  extern __shared__ __attribute__((aligned(16))) char smem[];
  for (int ph = ph_lo; ph < ph_hi; ++ph) {
    run_phase(p, ph, smem);
    if (coop && ph + 1 < ph_hi) {
      if (ph == ph_lo) cg::this_grid().sync();
      else grid_barrier((unsigned*)(p.ws + OFF_BAR), (unsigned)(ph - ph_lo) * gridDim.x);
    }
  }
}

extern "C" void kernel_launch(void* const* d_in, const int* in_sizes, int n_in,
                              void* d_out, int out_size, void* d_ws, size_t ws_size,
                              hipStream_t stream) {
  Params p{};
  p.x = (const float*)d_in[0]; p.c = (const float*)d_in[1]; p.ctx = (const float*)d_in[2]; p.c_ctx = (const float*)d_in[3];
  p.norm_gain = (const float*)d_in[4]; p.w_ada = (const float*)d_in[5]; p.b_ada = (const float*)d_in[6]; p.w_in = (const float*)d_in[7];
  p.ret_decay = (const float*)d_in[8]; p.gla_w_up = (const float*)d_in[9]; p.gla_b_up = (const float*)d_in[10];
  p.ret_norm_gain = (const float*)d_in[11]; p.gla_norm_gain = (const float*)d_in[12];
  p.w_br_ret = (const float*)d_in[13]; p.w_br_gla = (const float*)d_in[14]; p.w_out = (const float*)d_in[15]; p.final_gain = (const float*)d_in[16];
  p.out = (float*)d_out; p.ws = (char*)d_ws;
  static int grid_blocks = 0;
  if (!grid_blocks) {
    hipFuncSetAttribute((const void*)mega, hipFuncAttributeMaxDynamicSharedMemorySize, LDS_BYTES);
    int dev = 0, cus = 0, per_cu = 0;
    hipGetDevice(&dev);
    hipDeviceGetAttribute(&cus, hipDeviceAttributeMultiprocessorCount, dev);
    hipOccupancyMaxActiveBlocksPerMultiprocessor(&per_cu, mega, NTHREADS, LDS_BYTES);
    if (per_cu < 1) per_cu = 1;
    grid_blocks = cus * 1;
  }
#ifdef MULTI_LAUNCH
  for (int ph = 0; ph < NPHASE; ++ph) {
    mega<<<dim3(grid_blocks), dim3(NTHREADS), LDS_BYTES, stream>>>(p, ph, ph + 1, 0);
  }
#else
  hipMemsetAsync((char*)d_ws + OFF_BAR, 0, 256, stream);
  int lo = 0, hi = NPHASE, coop = 1;
  void* args[] = {&p, &lo, &hi, &coop};
  hipError_t e = hipLaunchCooperativeKernel((void*)mega, dim3(grid_blocks), dim3(NTHREADS), args, LDS_BYTES, stream);
  if (e != hipSuccess) fprintf(stderr, "cooperative launch failed: %s (grid %d)\n", hipGetErrorString(e), grid_blocks);
#endif
}
```

```cpp
#include <hip/hip_runtime.h>
#include <hip/hip_cooperative_groups.h>
#include <cstdio>
namespace cg = cooperative_groups;

typedef unsigned short u16;
using bf16x8 = __attribute__((ext_vector_type(8))) short;
using bf16x4 = __attribute__((ext_vector_type(4))) short;
using f32x4  = __attribute__((ext_vector_type(4))) float;

#define NTHREADS 512
#define DM 1024
#define NB 8
#define SEQL 4096
#define CTXL 256
#define MLAT 32768
#define MCTX 2048
#define MTOT 34816
#define INW 8208

#define OFF_S    0ull
#define OFF_RG   (OFF_S   + (size_t)MTOT * 4096 * 2)
#define OFF_U    (OFF_RG  + (size_t)MTOT * 2048 * 2)
#define OFF_WT   (OFF_U   + (size_t)MTOT * 1024 * 2)
#define WT_ROWS  11392
#define OFF_GLR  (OFF_WT  + (size_t)WT_ROWS * 1024 * 2)
#define OFF_HCTX (OFF_GLR + (size_t)MTOT * 16 * 4)
#define OFF_MOD  (OFF_HCTX+ (size_t)MCTX * 1024 * 4)
#define OFF_ROT  (OFF_MOD + (size_t)2 * 9 * 3072 * 4)
#define OFF_BAR  (OFF_ROT + (size_t)64 * 32 * 2 * 4)
#define OFF_END  (OFF_BAR + 256)

#define WT_SCAN 0
#define WT_GATE 4224
#define WT_BRR  8320
#define WT_BRG  9344
#define WT_OUT  10368

#define LDS_BYTES 161792
#define SCAN_GB   80896

struct Params {
  const float* x; const float* c; const float* ctx; const float* c_ctx;
  const float* norm_gain; const float* w_ada; const float* b_ada; const float* w_in;
  const float* ret_decay; const float* gla_w_up; const float* gla_b_up;
  const float* ret_norm_gain; const float* gla_norm_gain;
  const float* w_br_ret; const float* w_br_gla; const float* w_out; const float* final_gain;
  float* out; char* ws;
};

__device__ __forceinline__ u16 f2bf(float f) {
  __bf16 h = (__bf16)f;
  return *(u16*)&h;
}
__device__ __forceinline__ float bf2f(u16 h) { return __uint_as_float(((unsigned)h) << 16); }
__device__ __forceinline__ float sigmoidf_(float x) { return __builtin_amdgcn_rcpf(1.f + __expf(-x)); }
__device__ __forceinline__ float siluf_(float x) { return x * __builtin_amdgcn_rcpf(1.f + __expf(-x)); }

__device__ __forceinline__ int opaque_tid() { int t = threadIdx.x; asm volatile("" : "+v"(t)); return t; }

__device__ __forceinline__ float wave_sum(float v) {
#pragma unroll
  for (int o = 32; o > 0; o >>= 1) v += __shfl_xor(v, o, 64);
  return v;
}

__device__ __forceinline__ const float* wt_src(const Params& p, int l, int n, int& ld) {
  if (n < WT_GATE) {
    int tile = n >> 7, cc = n & 127;
    int col;
    if (tile < 8) {
      int d = (cc & 64) | ((cc & 16) << 1) | ((cc & 32) >> 1) | (cc & 15);
      col = tile * 128 + d;
    } else if (tile < 16) col = 1024 + (tile - 8) * 128 + cc;
    else if (tile < 24) col = 3072 + (tile - 16) * 128 + cc;
    else if (tile < 32) col = 4096 + (tile - 24) * 128 + cc;
    else { if (cc >= 16) { ld = 0; return nullptr; } col = 6144 + cc; }
    ld = INW; return p.w_in + (size_t)l * DM * INW + col;
  } else if (n < WT_BRR) {
    int g = n - WT_GATE; int col;
    if (g < 1024) col = 2048 + g;
    else if (g < 2048) col = 5120 + (g - 1024);
    else if (g < 3072) col = 6160 + (g - 2048);
    else col = 7184 + (g - 3072);
    ld = INW; return p.w_in + (size_t)l * DM * INW + col;
  } else if (n < WT_BRG) { ld = DM; return p.w_br_ret + (size_t)l * DM * DM + (n - WT_BRR); }
  else if (n < WT_OUT)   { ld = DM; return p.w_br_gla + (size_t)l * DM * DM + (n - WT_BRG); }
  else                   { ld = DM; return p.w_out    + (size_t)l * DM * DM + (n - WT_OUT); }
}

#define WT_UNITS (178 * 16)
__device__ __forceinline__ void wt_unit(const Params& p, int l, int unit, char* smem) {
  float* tile = (float*)smem;
  int nb = unit >> 4, kb = unit & 15;
  int tid = opaque_tid();
  int n0 = nb * 64, k0 = kb * 64;
  {
    int nl = tid & 63, kq = tid >> 6;
    int ld; const float* src = wt_src(p, l, n0 + nl, ld);
#pragma unroll
    for (int i = 0; i < 8; ++i) {
      int kl = kq + 8 * i;
      float v = src ? src[(size_t)(k0 + kl) * ld] : 0.f;
      tile[kl * 65 + nl] = v;
    }
  }
  __syncthreads();
  {
    int nl = tid >> 3, kq = tid & 7;
    bf16x8 o;
#pragma unroll
    for (int j = 0; j < 8; ++j) o[j] = (short)f2bf(tile[(kq * 8 + j) * 65 + nl]);
    u16* wt = (u16*)(p.ws + OFF_WT);
    *(bf16x8*)(wt + (size_t)(n0 + nl) * 1024 + k0 + kq * 8) = o;
  }
  __syncthreads();
}

__device__ __forceinline__ void mod_unit(const Params& p, int unit, char* smem) {
  float* sc = (float*)smem;
  float* red = sc + 9 * 1024;
  int l = unit / 48, jb = unit % 48;
  int tid = opaque_tid();
  for (int i = tid; i < 9 * 1024; i += NTHREADS) {
    int r = i >> 10, k = i & 1023;
    float v = (r < 8) ? p.c[r * 1024 + k] : p.c_ctx[k];
    sc[i] = siluf_(v);
  }
  __syncthreads();
  int jl = tid & 63, kg = tid >> 6;
  int j = jb * 64 + jl;
  float acc[9];
#pragma unroll
  for (int r = 0; r < 9; ++r) acc[r] = 0.f;
  const float* w = p.w_ada + (size_t)l * DM * 3072 + j;
#pragma unroll 16
  for (int k = kg * 128; k < kg * 128 + 128; ++k) {
    float wv = w[(size_t)k * 3072];
#pragma unroll
    for (int r = 0; r < 9; ++r) acc[r] += sc[r * 1024 + k] * wv;
  }
#pragma unroll
  for (int r = 0; r < 9; ++r) red[(kg * 9 + r) * 64 + jl] = acc[r];
  __syncthreads();
  float* mod = (float*)(p.ws + OFF_MOD);
  for (int i = tid; i < 9 * 64; i += NTHREADS) {
    int r = i >> 6, jj = i & 63;
    float s = 0.f;
#pragma unroll
    for (int g = 0; g < 8; ++g) s += red[(g * 9 + r) * 64 + jj];
    mod[((size_t)l * 9 + r) * 3072 + jb * 64 + jj] = s + p.b_ada[l * 3072 + jb * 64 + jj];
  }
  __syncthreads();
}

__device__ __forceinline__ void rot_unit(const Params& p) {
  float* rot = (float*)(p.ws + OFF_ROT);
  for (int i = opaque_tid(); i < 64 * 32; i += NTHREADS) {
    int pos = i >> 5, f = i & 31;
    float inv = exp2f(-(float)f * (13.287712379549449f / 32.f));
    float ang = (float)pos * inv;
    rot[i * 2] = __cosf(ang);
    rot[i * 2 + 1] = __sinf(ang);
  }
}

__device__ __forceinline__ void phase_u(const Params& p, int l) {
  const int tid = opaque_tid(); int wave = tid >> 6, lane = tid & 63;
  const float* mod = (const float*)(p.ws + OFF_MOD) + (size_t)l * 9 * 3072;
  const float* gain = p.norm_gain + l * DM;
  u16* U = (u16*)(p.ws + OFF_U);
  for (int row = (blockIdx.x * 8 + wave) * 4; row < MTOT; row += gridDim.x * 32) {
    const float* h; int r;
    if (row < MLAT) { h = (l == 0 ? p.x : p.out) + (size_t)row * DM; r = row >> 12; }
    else { int cr = row - MLAT; h = (l == 0 ? p.ctx : (const float*)(p.ws + OFF_HCTX)) + (size_t)cr * DM; r = 8; }
    float4 v[4][4]; float ss[4];
#pragma unroll
    for (int q = 0; q < 4; ++q) {
      ss[q] = 0.f;
#pragma unroll
      for (int i = 0; i < 4; ++i) v[q][i] = *(const float4*)(h + q * DM + i * 256 + lane * 4);
    }
#pragma unroll
    for (int q = 0; q < 4; ++q) {
#pragma unroll
      for (int i = 0; i < 4; ++i) ss[q] += v[q][i].x * v[q][i].x + v[q][i].y * v[q][i].y + v[q][i].z * v[q][i].z + v[q][i].w * v[q][i].w;
      ss[q] = rsqrtf(wave_sum(ss[q]) * (1.f / 1024.f) + 1e-6f);
    }
    const float* sh = mod + r * 3072;
#pragma unroll
    for (int i = 0; i < 4; ++i) {
      int cidx = i * 256 + lane * 4;
      float4 g = *(const float4*)(gain + cidx);
      float4 s = *(const float4*)(sh + cidx);
      float4 sc = *(const float4*)(sh + 1024 + cidx);
      g.x *= (1.f + sc.x); g.y *= (1.f + sc.y); g.z *= (1.f + sc.z); g.w *= (1.f + sc.w);
#pragma unroll
      for (int q = 0; q < 4; ++q) {
        bf16x4 o;
        o[0] = (short)f2bf(v[q][i].x * ss[q] * g.x + s.x);
        o[1] = (short)f2bf(v[q][i].y * ss[q] * g.y + s.y);
        o[2] = (short)f2bf(v[q][i].z * ss[q] * g.z + s.z);
        o[3] = (short)f2bf(v[q][i].w * ss[q] * g.w + s.w);
        *(bf16x4*)(U + (size_t)(row + q) * DM + cidx) = o;
      }
    }
  }
}

__device__ __forceinline__ void phase_final(const Params& p) {
  const int tid = opaque_tid(); int wave = tid >> 6, lane = tid & 63;
  for (int row = (blockIdx.x * 8 + wave) * 4; row < MLAT; row += gridDim.x * 32) {
    float* h = p.out + (size_t)row * DM;
    float4 v[4][4]; float ss[4];
#pragma unroll
    for (int q = 0; q < 4; ++q) {
      ss[q] = 0.f;
#pragma unroll
      for (int i = 0; i < 4; ++i) v[q][i] = *(const float4*)(h + q * DM + i * 256 + lane * 4);
    }
#pragma unroll
    for (int q = 0; q < 4; ++q) {
#pragma unroll
      for (int i = 0; i < 4; ++i) ss[q] += v[q][i].x * v[q][i].x + v[q][i].y * v[q][i].y + v[q][i].z * v[q][i].z + v[q][i].w * v[q][i].w;
      ss[q] = rsqrtf(wave_sum(ss[q]) * (1.f / 1024.f) + 1e-6f);
    }
#pragma unroll
    for (int i = 0; i < 4; ++i) {
      int cidx = i * 256 + lane * 4;
      float4 g = *(const float4*)(p.final_gain + cidx);
#pragma unroll
      for (int q = 0; q < 4; ++q) {
        float4 o;
        o.x = v[q][i].x * ss[q] * g.x; o.y = v[q][i].y * ss[q] * g.y; o.z = v[q][i].z * ss[q] * g.z; o.w = v[q][i].w * ss[q] * g.w;
        *(float4*)(h + q * DM + cidx) = o;
      }
    }
  }
}

#define PG8_LAS __attribute__((address_space(3)))
typedef unsigned u32x4 __attribute__((ext_vector_type(4)));
namespace pg8 {
constexpr int BM = 256, BK = 64, HALF = 128, HTB = HALF * BK * 2, STAGE_BYTES = 8 * HTB, NXCD = 8, WGM = 8;
__device__ __forceinline__ int lds_byte(int r, int c) { const int st = (r >> 4) * 2 + (c >> 5), rr = r & 15, cc = c & 31, ob = rr * 64 + cc * 2; return st * 1024 + (ob ^ (((ob >> 9) & 1) << 5)); }
__device__ __forceinline__ void stage_rc(int b, int& R, int& C) { const int st = b / 1024, sb = b % 1024, swz = sb ^ (((sb >> 9) & 1) << 5); R = (st >> 1) * 16 + swz / 64; C = (st & 1) * 32 + (swz % 64) / 2; }
__device__ __forceinline__ int perm32(int rho) { const int n = rho >> 4, i = rho & 15; return 8 * (i >> 2) + 4 * n + (i & 3); }
struct Unit { int pm, pn; };
struct Gemm { const u16* A; const u16* Bt; int lda; int M, N, K; };
struct StaticOrder {
  int nM, nN, nwg, G, c;
  __device__ void init(int M, int N, int G_, int c_) { nM = M / BM; nN = N / BM; nwg = nM * nN; G = G_; c = c_; }
  __device__ bool next(int i, Unit& u) const {
    const long L = (long)i * G + c; if (L >= nwg) return false;
    int wgid = (int)L; { const int q = nwg / NXCD, r = nwg % NXCD, xcd = wgid % NXCD, off = wgid / NXCD; wgid = (xcd < r ? xcd * (q + 1) : r * (q + 1) + (xcd - r) * q) + off; }
    const int nig = WGM * nN, gid = wgid / nig, fm = gid * WGM, gsz = (nM - fm) < WGM ? (nM - fm) : WGM;
    u.pm = fm + ((wgid % nig) % gsz); u.pn = (wgid % nig) / gsz; return true;
  }
};
typedef __attribute__((ext_vector_type(2))) float cvt_f2_t;
typedef __attribute__((ext_vector_type(2))) __bf16 cvt_b2_t;
__device__ __forceinline__ unsigned cvt_pk_bf16(float lo, float hi) { cvt_f2_t f = {lo, hi}; cvt_b2_t r = __builtin_convertvector(f, cvt_b2_t); return __builtin_bit_cast(unsigned, r); }

template <class Epi>
__device__ __forceinline__ void gemm_phase(PG8_LAS unsigned char* lds, const Gemm g, const StaticOrder& S, const Epi& E, const int tid) {
  const int wid = __builtin_amdgcn_readfirstlane(tid >> 6), lane = tid & 63, wr = wid >> 2, wc = wid & 3, fr = lane & 15, fq = lane >> 4;
  const int K = g.K, nt = K / BK;
  unsigned voffA[2], voffB[2];
#pragma unroll
  for (int i = 0; i < 2; ++i) { int R, C; stage_rc(tid * 16 + i * 8192, R, C); const int Rb = Epi::PERM ? ((R & ~31) + perm32(R & 31)) : R;
    voffA[i] = (unsigned)(R * g.lda + C) * 2u; voffB[i] = (unsigned)(Rb * K + C) * 2u; }
  const size_t kstep = (size_t)(BK * 2);
  const size_t hstepA = (size_t)HALF * g.lda * 2, hstepB = (size_t)HALF * K * 2;
  const size_t tstepA = 2 * hstepA, tstepB = 2 * hstepB;
  const unsigned ldsw = (unsigned)wid * 1024u;
  const int aoff = lds_byte(wr * 64 + fr, fq * 8), boff = lds_byte(wc * 32 + fr, fq * 8);
#define PG8_SA(b, h) (((b) * 2 + (h)) * HTB)
#define PG8_SB(b, h) ((4 + (b) * 2 + (h)) * HTB)
#define PG8_STAGE(bufoff, gbase, voff) do { _Pragma("unroll") for (int _i = 0; _i < 2; ++_i) \
    __builtin_amdgcn_global_load_lds((const unsigned*)((const char*)(gbase) + (voff)[_i]), (PG8_LAS unsigned*)(lds + (bufoff) + ldsw + _i * 8192), 16, 0, 0); } while (0)
#define PG8_LDA(dst, b, h) do { _Pragma("unroll") for (int m = 0; m < 4; ++m) _Pragma("unroll") for (int k = 0; k < 2; ++k) dst[m][k] = *(const PG8_LAS bf16x8*)(lds + PG8_SA(b, h) + aoff + m * 2048 + k * 1024); } while (0)
#define PG8_LDB(dst, b, h) do { _Pragma("unroll") for (int n = 0; n < 2; ++n) _Pragma("unroll") for (int k = 0; k < 2; ++k) dst[n][k] = *(const PG8_LAS bf16x8*)(lds + PG8_SB(b, h) + boff + n * 2048 + k * 1024); } while (0)
#define PG8_MMA(ai, bj, At, Bt) do { __builtin_amdgcn_s_setprio(1); _Pragma("unroll") for (int m = 0; m < 4; ++m) _Pragma("unroll") for (int n = 0; n < 2; ++n) _Pragma("unroll") for (int k = 0; k < 2; ++k) \
    acc[ai][bj][m][n] = __builtin_amdgcn_mfma_f32_16x16x32_bf16(Bt[n][k], At[m][k], acc[ai][bj][m][n], 0, 0, 0); __builtin_amdgcn_s_setprio(0); } while (0)
#define PG8_WAIT_V(n) asm volatile("s_waitcnt vmcnt(" #n ")" ::: "memory")
#define PG8_WAIT_L(n) asm volatile("s_waitcnt lgkmcnt(" #n ")" ::: "memory")
#define PG8_BAR __builtin_amdgcn_s_barrier()
#define PG8_SCHED __builtin_amdgcn_sched_barrier(0)
  Unit cur, nxt; int ui = 0;
  if (!S.next(0, cur)) return;
  f32x4 acc[2][2][4][2];
#pragma unroll
  for (int a = 0; a < 2; ++a)
#pragma unroll
    for (int b = 0; b < 2; ++b)
#pragma unroll
      for (int m = 0; m < 4; ++m)
#pragma unroll
        for (int n = 0; n < 2; ++n) acc[a][b][m][n] = (f32x4){0.f, 0.f, 0.f, 0.f};
  bf16x8 At[4][2], B0[2][2], B1[2][2];
  const char* cA = (const char*)g.A + (size_t)cur.pm * tstepA; const char* cB = (const char*)g.Bt + (size_t)cur.pn * tstepB;
  PG8_STAGE(PG8_SB(0, 0), cB, voffB); PG8_STAGE(PG8_SA(0, 0), cA, voffA); PG8_STAGE(PG8_SB(0, 1), cB + hstepB, voffB); PG8_STAGE(PG8_SA(0, 1), cA + hstepA, voffA);
  if (wr == 1) PG8_BAR;
  PG8_WAIT_V(4); PG8_BAR;
  PG8_STAGE(PG8_SB(1, 0), cB + kstep, voffB); PG8_STAGE(PG8_SA(1, 0), cA + kstep, voffA); PG8_STAGE(PG8_SB(1, 1), cB + hstepB + kstep, voffB);
  PG8_WAIT_V(6); PG8_BAR;
  for (;;) {
    const bool has_next = S.next(ui + 1, nxt);
    const char* nA = has_next ? (const char*)g.A + (size_t)nxt.pm * tstepA : cA; const char* nB = has_next ? (const char*)g.Bt + (size_t)nxt.pn * tstepB : cB;
    for (int t = 0; t < nt; t += 2) {
      const bool last = (t == nt - 2);
      const char* a1 = cA + (size_t)(t + 1) * kstep;
      const char* a2 = last ? nA : cA + (size_t)(t + 2) * kstep; const char* b2 = last ? nB : cB + (size_t)(t + 2) * kstep;
      const char* a3 = a2 + kstep; const char* b3 = b2 + kstep;
      PG8_LDB(B0, 0, 0); PG8_SCHED; PG8_LDA(At, 0, 0); PG8_STAGE(PG8_SA(1, 1), a1 + hstepA, voffA);
      PG8_WAIT_L(8); PG8_BAR; PG8_WAIT_L(0); PG8_MMA(0, 0, At, B0); PG8_BAR; PG8_SCHED;
      PG8_LDB(B1, 0, 1); PG8_STAGE(PG8_SB(0, 0), b2, voffB);
      PG8_BAR; PG8_WAIT_L(0); PG8_MMA(0, 1, At, B1); PG8_BAR;
      PG8_LDA(At, 0, 1); PG8_STAGE(PG8_SA(0, 0), a2, voffA);
      PG8_BAR; PG8_WAIT_L(0); PG8_MMA(1, 0, At, B0); PG8_BAR; PG8_SCHED;
      PG8_STAGE(PG8_SB(0, 1), b2 + hstepB, voffB);
      PG8_WAIT_V(6); PG8_BAR; PG8_MMA(1, 1, At, B1); PG8_BAR;
      PG8_LDB(B0, 1, 0); PG8_SCHED; PG8_LDA(At, 1, 0); PG8_STAGE(PG8_SA(0, 1), a2 + hstepA, voffA);
      PG8_WAIT_L(8); PG8_BAR; PG8_WAIT_L(0); PG8_MMA(0, 0, At, B0); PG8_BAR; PG8_SCHED;
      PG8_LDB(B1, 1, 1); PG8_STAGE(PG8_SB(1, 0), b3, voffB);
      PG8_BAR; PG8_WAIT_L(0); PG8_MMA(0, 1, At, B1); PG8_BAR;
      PG8_LDA(At, 1, 1); PG8_STAGE(PG8_SA(1, 0), a3, voffA);
      PG8_BAR; PG8_WAIT_L(0); PG8_MMA(1, 0, At, B0); PG8_BAR; PG8_SCHED;
      PG8_STAGE(PG8_SB(1, 1), b3 + hstepB, voffB);
      PG8_WAIT_V(6); PG8_BAR; PG8_MMA(1, 1, At, B1); PG8_BAR;
    }
    E(acc, cur, wr, wc, fr, fq, lane);
    if (!has_next) break;
#pragma unroll
    for (int a = 0; a < 2; ++a)
#pragma unroll
      for (int b = 0; b < 2; ++b)
#pragma unroll
        for (int m = 0; m < 4; ++m)
#pragma unroll
          for (int n = 0; n < 2; ++n) acc[a][b][m][n] = (f32x4){0.f, 0.f, 0.f, 0.f};
    cur = nxt; cA = nA; cB = nB; ++ui;
  }
  PG8_WAIT_V(0);
  if (wr == 0) PG8_BAR;
  PG8_BAR;
#undef PG8_SA
#undef PG8_SB
#undef PG8_STAGE
#undef PG8_LDA
#undef PG8_LDB
#undef PG8_MMA
#undef PG8_WAIT_V
#undef PG8_WAIT_L
#undef PG8_BAR
#undef PG8_SCHED
}
}

#define OFF_STATS OFF_GLR

__device__ __forceinline__ u32x4 pack8v(const f32x4& a, const f32x4& b) {
  u32x4 w; w.x = pg8::cvt_pk_bf16(a[0], a[1]); w.y = pg8::cvt_pk_bf16(a[2], a[3]); w.z = pg8::cvt_pk_bf16(b[0], b[1]); w.w = pg8::cvt_pk_bf16(b[2], b[3]); return w;
}
__device__ __forceinline__ float xlane32(float v, int lane) { return __int_as_float(__builtin_amdgcn_ds_bpermute((lane ^ 32) << 2, __float_as_int(v))); }

struct EpiScanIn {
  static constexpr bool PERM = true;
  u16* S; const float* rot;
  __device__ __forceinline__ void operator()(const f32x4 (&acc)[2][2][4][2], const pg8::Unit& u, int wr, int wc, int fr, int fq, int lane) const {
    u16* Sb = S + (size_t)u.pm * 256 * 4096;
    unsigned rl0 = wr * 64 + fr; asm volatile("" : "+v"(rl0));
#pragma unroll
    for (int bj = 0; bj < 2; ++bj) {
      const int nt128 = u.pn * 2 + bj;
      const bool scaled = (nt128 < 4) || (nt128 >= 16 && nt128 < 20);
      const float scl = scaled ? 0.08838834764831845f : 1.f;
      const unsigned cb = nt128 * 128 + wc * 32 + fq * 8;
      if (nt128 < 8 && u.pm < 128) {
        const int tb = (u.pm & 15) * 256;
        const int fo = ((wc & 1) * 16 + (fq & 1) * 8) * 2;
        const float sgn = (fq >> 1) ? 1.f : -1.f;
#pragma unroll
        for (int ai = 0; ai < 2; ++ai)
#pragma unroll
          for (int m = 0; m < 4; ++m) {
            const unsigned rl = rl0 + ai * 128 + m * 16;
            const int t = tb + rl;
            const unsigned pos = (wc >> 1) == 0 ? (t >> 6) : (t & 63);
            const float* rp = rot + pos * 64u + fo;
            const float4 c0 = *(const float4*)rp, c1 = *(const float4*)(rp + 4), c2 = *(const float4*)(rp + 8), c3 = *(const float4*)(rp + 12);
            const f32x4 v0 = acc[ai][bj][m][0], v1 = acc[ai][bj][m][1];
            f32x4 p0, p1;
#pragma unroll
            for (int j = 0; j < 4; ++j) { p0[j] = xlane32(v0[j], lane); p1[j] = xlane32(v1[j], lane); }
            f32x4 o0, o1;
            o0[0] = (v0[0] * c0.x + sgn * p0[0] * c0.y) * scl; o0[1] = (v0[1] * c0.z + sgn * p0[1] * c0.w) * scl;
            o0[2] = (v0[2] * c1.x + sgn * p0[2] * c1.y) * scl; o0[3] = (v0[3] * c1.z + sgn * p0[3] * c1.w) * scl;
            o1[0] = (v1[0] * c2.x + sgn * p1[0] * c2.y) * scl; o1[1] = (v1[1] * c2.z + sgn * p1[1] * c2.w) * scl;
            o1[2] = (v1[2] * c3.x + sgn * p1[2] * c3.y) * scl; o1[3] = (v1[3] * c3.z + sgn * p1[3] * c3.w) * scl;
            *(u32x4*)(Sb + rl * 4096u + cb) = pack8v(o0, o1);
            __builtin_amdgcn_sched_barrier(0);
          }
      } else {
#pragma unroll
        for (int ai = 0; ai < 2; ++ai)
#pragma unroll
          for (int m = 0; m < 4; ++m) {
            const unsigned rl = rl0 + ai * 128 + m * 16;
            *(u32x4*)(Sb + rl * 4096u + cb) = pack8v(acc[ai][bj][m][0] * scl, acc[ai][bj][m][1] * scl);
            __builtin_amdgcn_sched_barrier(0);
          }
      }
    }
  }
};

struct EpiGate {
  static constexpr bool PERM = true;
  const u16* RG; const float* stats; u16* S; const float* rgain; const float* ggain;
  __device__ __forceinline__ void operator()(const f32x4 (&acc)[2][2][4][2], const pg8::Unit& u, int wr, int wc, int fr, int fq, int lane) const {
    u16* Sb = S + (size_t)u.pm * 256 * 4096;
    unsigned rl0 = wr * 64 + fr; asm volatile("" : "+v"(rl0));
    if (u.pn < 8) {
      const int branch = u.pn >> 2, head = u.pn & 3;
      const u16* RGb = RG + (size_t)u.pm * 256 * 2048 + branch * 1024;
      const float* stb = stats + (size_t)u.pm * 256 * 16 + (branch * 4 + head) * 2;
      const float* gain = branch ? ggain : rgain;
#pragma unroll
      for (int bj = 0; bj < 2; ++bj) {
        const unsigned cb = head * 256 + bj * 128 + wc * 32 + fq * 8;
        const float4 g0 = *(const float4*)(gain + cb), g1 = *(const float4*)(gain + cb + 4);
#pragma unroll
        for (int ai = 0; ai < 2; ++ai)
#pragma unroll
          for (int m = 0; m < 4; ++m) {
            const unsigned rl = rl0 + ai * 128 + m * 16;
            const float2 st = *(const float2*)(stb + rl * 16u);
            const bf16x8 xr = *(const bf16x8*)(RGb + rl * 2048u + cb);
            f32x4 v0 = acc[ai][bj][m][0], v1 = acc[ai][bj][m][1];
            asm volatile("" : "+v"(v0), "+v"(v1));
            f32x4 o0, o1;
            o0[0] = (bf2f((u16)xr[0]) * st.x + st.y) * g0.x * siluf_(v0[0]); o0[1] = (bf2f((u16)xr[1]) * st.x + st.y) * g0.y * siluf_(v0[1]);
            o0[2] = (bf2f((u16)xr[2]) * st.x + st.y) * g0.z * siluf_(v0[2]); o0[3] = (bf2f((u16)xr[3]) * st.x + st.y) * g0.w * siluf_(v0[3]);
            o1[0] = (bf2f((u16)xr[4]) * st.x + st.y) * g1.x * siluf_(v1[0]); o1[1] = (bf2f((u16)xr[5]) * st.x + st.y) * g1.y * siluf_(v1[1]);
            o1[2] = (bf2f((u16)xr[6]) * st.x + st.y) * g1.z * siluf_(v1[2]); o1[3] = (bf2f((u16)xr[7]) * st.x + st.y) * g1.w * siluf_(v1[3]);
            *(u32x4*)(Sb + rl * 4096u + 2048u + branch * 1024 + cb) = pack8v(o0, o1);
            __builtin_amdgcn_sched_barrier(0);
          }
      }
    } else {
#pragma unroll
      for (int bj = 0; bj < 2; ++bj) {
        const unsigned cb = (u.pn - 8) * 256 + bj * 128 + wc * 32 + fq * 8;
#pragma unroll
        for (int ai = 0; ai < 2; ++ai)
#pragma unroll
          for (int m = 0; m < 4; ++m) {
            const unsigned rl = rl0 + ai * 128 + m * 16;
            f32x4 v0 = acc[ai][bj][m][0], v1 = acc[ai][bj][m][1];
            asm volatile("" : "+v"(v0), "+v"(v1));
            f32x4 o0, o1;
#pragma unroll
            for (int j = 0; j < 4; ++j) { o0[j] = sigmoidf_(v0[j]); o1[j] = sigmoidf_(v1[j]); }
            *(u32x4*)(Sb + rl * 4096u + cb) = pack8v(o0, o1);
            __builtin_amdgcn_sched_barrier(0);
          }
      }
    }
  }
};

struct EpiMerge {
  static constexpr bool PERM = true;
  const u16* S; u16* MG; int pass;
  __device__ __forceinline__ void operator()(const f32x4 (&acc)[2][2][4][2], const pg8::Unit& u, int wr, int wc, int fr, int fq, int lane) const {
    const u16* Sb = S + (size_t)u.pm * 256 * 4096 + pass * 1024;
    u16* MGb = MG + (size_t)u.pm * 256 * 1024;
    unsigned rl0 = wr * 64 + fr; asm volatile("" : "+v"(rl0));
#pragma unroll
    for (int bj = 0; bj < 2; ++bj) {
      const unsigned cb = u.pn * 256 + bj * 128 + wc * 32 + fq * 8;
#pragma unroll
      for (int ai = 0; ai < 2; ++ai)
#pragma unroll
        for (int m = 0; m < 4; ++m) {
          const unsigned rl = rl0 + ai * 128 + m * 16;
          const bf16x8 gt = *(const bf16x8*)(Sb + rl * 4096u + cb);
          f32x4 o0 = acc[ai][bj][m][0], o1 = acc[ai][bj][m][1];
#pragma unroll
          for (int j = 0; j < 4; ++j) { o0[j] *= bf2f((u16)gt[j]); o1[j] *= bf2f((u16)gt[4 + j]); }
          if (pass) {
            const bf16x8 old = *(const bf16x8*)(MGb + rl * 1024u + cb);
#pragma unroll
            for (int j = 0; j < 4; ++j) { o0[j] += bf2f((u16)old[j]); o1[j] += bf2f((u16)old[4 + j]); }
          }
          *(u32x4*)(MGb + rl * 1024u + cb) = pack8v(o0, o1);
            __builtin_amdgcn_sched_barrier(0);
        }
    }
  }
};

struct EpiOut {
  static constexpr bool PERM = false;
  const float* x_lat; const float* x_ctx; float* o_lat; float* o_ctx; const float* mod;
  __device__ __forceinline__ void operator()(const f32x4 (&acc)[2][2][4][2], const pg8::Unit& u, int wr, int wc, int fr, int fq, int lane) const {
    const float* hin; float* hout; int rmod;
    if (u.pm < 128) { hin = x_lat + (size_t)u.pm * 256 * DM; hout = o_lat + (size_t)u.pm * 256 * DM; rmod = u.pm >> 4; }
    else { hin = x_ctx + (size_t)(u.pm - 128) * 256 * DM; hout = o_ctx + (size_t)(u.pm - 128) * 256 * DM; rmod = 8; }
    const float* gate = mod + rmod * 3072 + 2048;
    unsigned rl0 = wr * 64 + fr; asm volatile("" : "+v"(rl0));
#pragma unroll
    for (int bj = 0; bj < 2; ++bj)
#pragma unroll
      for (int n = 0; n < 2; ++n) {
        const unsigned cb = u.pn * 256 + bj * 128 + wc * 32 + n * 16 + fq * 4;
        const float4 g = *(const float4*)(gate + cb);
#pragma unroll
        for (int ai = 0; ai < 2; ++ai)
#pragma unroll
          for (int m = 0; m < 4; ++m) {
            const unsigned o = (rl0 + ai * 128 + m * 16) * 1024u + cb;
            const float4 h = *(const float4*)(hin + o);
            const f32x4 v = acc[ai][bj][m][n];
            *(float4*)(hout + o) = make_float4(h.x + g.x * v[0], h.y + g.y * v[1], h.z + g.z * v[2], h.w + g.w * v[3]);
          }
      }
  }
};

__device__ __forceinline__ void phase_stats(const Params& p, int l) {
  const int tid = opaque_tid(); const int wave = tid >> 6, lane = tid & 63;
  const u16* RG = (const u16*)(p.ws + OFF_RG);
  float* ST = (float*)(p.ws + OFF_STATS);
  const int nrows = (l == 0) ? MTOT : MLAT;
  for (int row = (blockIdx.x * 8 + wave) * 4; row < nrows; row += gridDim.x * 32) {
    bf16x8 v[4][4];
#pragma unroll
    for (int q = 0; q < 4; ++q)
#pragma unroll
      for (int i = 0; i < 4; ++i) v[q][i] = *(const bf16x8*)(RG + (size_t)(row + q) * 2048 + i * 512 + lane * 8);
#pragma unroll
    for (int q = 0; q < 4; ++q)
#pragma unroll
      for (int i = 0; i < 4; ++i) {
        float s1 = 0.f, s2 = 0.f;
#pragma unroll
        for (int x = 0; x < 8; ++x) { float a = bf2f((u16)v[q][i][x]); s1 += a; s2 += a * a; }
#pragma unroll
        for (int o = 16; o > 0; o >>= 1) {
          s1 += __int_as_float(__builtin_amdgcn_ds_bpermute((lane ^ o) << 2, __float_as_int(s1)));
          s2 += __int_as_float(__builtin_amdgcn_ds_bpermute((lane ^ o) << 2, __float_as_int(s2)));
        }
        float sa, sb;
        if ((i >> 1) == 0) { float mu = s1 * (1.f / 256.f); float var = fmaxf(s2 * (1.f / 256.f) - mu * mu, 0.f); sa = rsqrtf(var + 1e-6f); sb = -mu * sa; }
        else { sa = rsqrtf(s2 * (1.f / 256.f) + 1e-6f); sb = 0.f; }
        if ((lane & 31) == 0) *(float2*)(ST + ((size_t)(row + q) * 8 + (i >> 1) * 4 + 2 * (i & 1) + (lane >> 5)) * 2) = make_float2(sa, sb);
      }
  }
}

#define OFF_VECS OFF_WT
__device__ __forceinline__ float logsig16(float x) { return (fminf(x, 0.f) - __logf(1.f + __expf(-fabsf(x)))) * (1.f / 16.f); }

typedef __attribute__((ext_vector_type(2))) float f32x2_t;

template <int SW>
__device__ __forceinline__ void prepass_sweep4(const float* GLRS, const f32x2_t (&w2)[4][16], const f32x2_t (&b2)[4], u16* Sq, u16* Ub,
                                               float (&accF)[4], float (&accB)[4]) {
#pragma unroll
  for (int c = 0; c < 4; ++c) { accF[c] = 0.f; accB[c] = 0.f; }
#pragma unroll 2
  for (int u = 0; u < 32; ++u) {
    const int i = SW ? 32 + u : 31 - u;
    const bf16x4 q4 = *(const bf16x4*)(Sq + (unsigned)i * 4096u);
    const bf16x4 k4 = *(const bf16x4*)(Sq + (unsigned)i * 4096u + 512u);
    const float4* gr = (const float4*)(GLRS + (i & 31) * 16);
    const float4 g0 = gr[0], g1 = gr[1], g2 = gr[2], g3 = gr[3];
    bf16x4 oqf, okf, oqb, okb;
#pragma unroll
    for (int c = 0; c < 4; ++c) {
      f32x2_t x = b2[c];
      x = w2[c][0] * g0.x + x;  x = w2[c][1] * g0.y + x;  x = w2[c][2] * g0.z + x;  x = w2[c][3] * g0.w + x;
      x = w2[c][4] * g1.x + x;  x = w2[c][5] * g1.y + x;  x = w2[c][6] * g1.z + x;  x = w2[c][7] * g1.w + x;
      x = w2[c][8] * g2.x + x;  x = w2[c][9] * g2.y + x;  x = w2[c][10] * g2.z + x; x = w2[c][11] * g2.w + x;
      x = w2[c][12] * g3.x + x; x = w2[c][13] * g3.y + x; x = w2[c][14] * g3.z + x; x = w2[c][15] * g3.w + x;
      const float laf = logsig16(x.x), lab = logsig16(x.y);
      float relf, relb;
      if (SW == 0) { relf = -accF[c]; accF[c] += laf; accB[c] += lab; relb = accB[c]; }
      else         { accF[c] += laf; relf = accF[c]; relb = -accB[c]; accB[c] += lab; }
      const float q = bf2f((u16)q4[c]), k = bf2f((u16)k4[c]);
      oqf[c] = (short)f2bf(q * __expf(relf)); okf[c] = (short)f2bf(k * __expf(-relf));
      oqb[c] = (short)f2bf(q * __expf(relb)); okb[c] = (short)f2bf(k * __expf(-relb));
    }
    *(bf16x4*)(Sq + (unsigned)i * 4096u) = oqf;
    *(bf16x4*)(Sq + (unsigned)i * 4096u + 512u) = okf;
    *(bf16x4*)(Ub + (unsigned)i * 1024u) = oqb;
    *(bf16x4*)(Ub + (unsigned)i * 1024u + 512u) = okb;
  }
}

__device__ __forceinline__ void gla_prepass_unit(const Params& p, int l, int bunit, char* smem) {
  const int tid = opaque_tid();
  const int ul = __builtin_amdgcn_readfirstlane(tid >> 7);
  const int gu = bunit * 4 + ul;
  const int sw = gu & 1, ch = gu >> 1;
  const int b = ch / 68, cid = ch % 68;
  const int base = cid < 4 ? (MLAT + b * 256 + cid * 64) : (b * 4096 + (cid - 4) * 64);
  float* GLRS = (float*)smem + ul * 512;
  const int col0 = (tid & 127) * 4;
  __syncthreads();
  {
    const int uw = (tid >> 6) & 1, lane = tid & 63, fr = lane & 15, fq = lane >> 4;
    f32x4 g = (f32x4){0.f, 0.f, 0.f, 0.f};
    const u16* Ua = (const u16*)(p.ws + OFF_U) + (size_t)(base + sw * 32 + uw * 16 + fr) * 1024 + fq * 8;
    const u16* Wb = (const u16*)(p.ws + OFF_WT) + (size_t)(4096 + fr) * 1024 + fq * 8;
#pragma unroll 16
    for (int k = 0; k < 1024; k += 32) {
      bf16x8 a = *(const bf16x8*)(Ua + k);
      bf16x8 w = *(const bf16x8*)(Wb + k);
      g = __builtin_amdgcn_mfma_f32_16x16x32_bf16(a, w, g, 0, 0, 0);
    }
#pragma unroll
    for (int j = 0; j < 4; ++j) GLRS[(uw * 16 + fq * 4 + j) * 16 + fr] = g[j];
  }
  f32x2_t w2[4][16], b2[4];
  {
    const float* w0 = p.gla_w_up + (size_t)(l * 2 + 0) * 16 * 512 + col0;
    const float* w1 = p.gla_w_up + (size_t)(l * 2 + 1) * 16 * 512 + col0;
#pragma unroll
    for (int r = 0; r < 16; ++r) {
      const float4 a = *(const float4*)(w0 + r * 512), c = *(const float4*)(w1 + r * 512);
      w2[0][r].x = a.x; w2[1][r].x = a.y; w2[2][r].x = a.z; w2[3][r].x = a.w;
      w2[0][r].y = c.x; w2[1][r].y = c.y; w2[2][r].y = c.z; w2[3][r].y = c.w;
    }
    const float4 a = *(const float4*)(p.gla_b_up + (l * 2 + 0) * 512 + col0), c = *(const float4*)(p.gla_b_up + (l * 2 + 1) * 512 + col0);
    b2[0].x = a.x; b2[1].x = a.y; b2[2].x = a.z; b2[3].x = a.w;
    b2[0].y = c.x; b2[1].y = c.y; b2[2].y = c.z; b2[3].y = c.w;
  }
  __syncthreads();
  u16* Sq = (u16*)(p.ws + OFF_S) + (size_t)base * 4096 + 2048 + col0;
  u16* Ub = (l == 0 ? (u16*)p.out : (u16*)(p.ws + OFF_U)) + (size_t)base * 1024 + col0;
  float* V0 = (float*)(p.ws + OFF_VECS) + ((size_t)(0 * 544 + b * 68 + cid) * 2) * 512 + col0;
  float* V1 = (float*)(p.ws + OFF_VECS) + ((size_t)(1 * 544 + b * 68 + cid) * 2) * 512 + col0;
  float accF[4], accB[4];
  if (sw == 0) {
    prepass_sweep4<0>(GLRS, w2, b2, Sq, Ub, accF, accB);
    *(float4*)(V0) = make_float4(__expf(accF[0]), __expf(accF[1]), __expf(accF[2]), __expf(accF[3]));
    *(float4*)(V1 + 512) = make_float4(__expf(accB[0]), __expf(accB[1]), __expf(accB[2]), __expf(accB[3]));
  } else {
    prepass_sweep4<1>(GLRS, w2, b2, Sq, Ub, accF, accB);
    *(float4*)(V0 + 512) = make_float4(__expf(accF[0]), __expf(accF[1]), __expf(accF[2]), __expf(accF[3]));
    *(float4*)(V1) = make_float4(__expf(accB[0]), __expf(accB[1]), __expf(accB[2]), __expf(accB[3]));
  }
}

template <int SW>
__device__ __forceinline__ void prepass_sweep(const float* GLRS, const f32x2_t (&w2)[16], f32x2_t b2, u16* Sq, u16* Ub, float& accF, float& accB) {
  accF = 0.f; accB = 0.f;
#pragma unroll 16
  for (int u = 0; u < 32; ++u) {
    const int i = SW ? 32 + u : 31 - u;
    const float4* gr = (const float4*)(GLRS + i * 16);
    const float4 g0 = gr[0], g1 = gr[1], g2 = gr[2], g3 = gr[3];
    f32x2_t x = b2;
    x = w2[0] * g0.x + x;  x = w2[1] * g0.y + x;  x = w2[2] * g0.z + x;  x = w2[3] * g0.w + x;
    x = w2[4] * g1.x + x;  x = w2[5] * g1.y + x;  x = w2[6] * g1.z + x;  x = w2[7] * g1.w + x;
    x = w2[8] * g2.x + x;  x = w2[9] * g2.y + x;  x = w2[10] * g2.z + x; x = w2[11] * g2.w + x;
    x = w2[12] * g3.x + x; x = w2[13] * g3.y + x; x = w2[14] * g3.z + x; x = w2[15] * g3.w + x;
    const float laf = logsig16(x.x), lab = logsig16(x.y);
    float relf, relb;
    if (SW == 0) { relf = -accF; accF += laf; accB += lab; relb = accB; }
    else         { accF += laf; relf = accF; relb = -accB; accB += lab; }
    const float q = bf2f(Sq[(unsigned)i * 4096u]), k = bf2f(Sq[(unsigned)i * 4096u + 512u]);
    Sq[(unsigned)i * 4096u] = f2bf(q * __expf(relf));
    Sq[(unsigned)i * 4096u + 512u] = f2bf(k * __expf(-relf));
    Ub[(unsigned)i * 1024u] = f2bf(q * __expf(relb));
    Ub[(unsigned)i * 1024u + 512u] = f2bf(k * __expf(-relb));
  }
}

__device__ __forceinline__ void gla_prepass_unit1(const Params& p, int l, int unit, char* smem) {
  const int tid = opaque_tid();
  const int sw = unit & 1, ch = unit >> 1;
  const int b = ch / 68, cid = ch % 68;
  const int base = cid < 4 ? (MLAT + b * 256 + cid * 64) : (b * 4096 + (cid - 4) * 64);
  float* GLRS = (float*)smem;
  __syncthreads();
  {
    const int wid = tid >> 6, lane = tid & 63, fr = lane & 15, fq = lane >> 4;
    if (wid < 2) {
      const int r0 = sw * 32 + wid * 16;
      f32x4 g = (f32x4){0.f, 0.f, 0.f, 0.f};
      const u16* Ua = (const u16*)(p.ws + OFF_U) + (size_t)(base + r0 + fr) * 1024 + fq * 8;
      const u16* Wb = (const u16*)(p.ws + OFF_WT) + (size_t)(4096 + fr) * 1024 + fq * 8;
#pragma unroll 16
      for (int k = 0; k < 1024; k += 32) {
        bf16x8 a = *(const bf16x8*)(Ua + k);
        bf16x8 w = *(const bf16x8*)(Wb + k);
        g = __builtin_amdgcn_mfma_f32_16x16x32_bf16(a, w, g, 0, 0, 0);
      }
#pragma unroll
      for (int j = 0; j < 4; ++j) GLRS[(r0 + fq * 4 + j) * 16 + fr] = g[j];
    }
  }
  f32x2_t w2[16];
  {
    const float* w0 = p.gla_w_up + (size_t)(l * 2 + 0) * 16 * 512 + tid;
    const float* w1 = p.gla_w_up + (size_t)(l * 2 + 1) * 16 * 512 + tid;
#pragma unroll
    for (int r = 0; r < 16; ++r) { w2[r].x = w0[r * 512]; w2[r].y = w1[r * 512]; }
  }
  f32x2_t b2; b2.x = p.gla_b_up[(l * 2 + 0) * 512 + tid]; b2.y = p.gla_b_up[(l * 2 + 1) * 512 + tid];
  __syncthreads();
  u16* Sq = (u16*)(p.ws + OFF_S) + (size_t)base * 4096 + 2048 + tid;
  u16* Ub = (l == 0 ? (u16*)p.out : (u16*)(p.ws + OFF_U)) + (size_t)base * 1024 + tid;
  float* V0 = (float*)(p.ws + OFF_VECS) + ((size_t)(0 * 544 + b * 68 + cid) * 2) * 512 + tid;
  float* V1 = (float*)(p.ws + OFF_VECS) + ((size_t)(1 * 544 + b * 68 + cid) * 2) * 512 + tid;
  float accF, accB;
  if (sw == 0) {
    prepass_sweep<0>(GLRS, w2, b2, Sq, Ub, accF, accB);
    V0[0] = __expf(accF);
    V1[512] = __expf(accB);
  } else {
    prepass_sweep<1>(GLRS, w2, b2, Sq, Ub, accF, accB);
    V0[512] = __expf(accF);
    V1[0] = __expf(accB);
  }
}

#define L_QR   0
#define L_KR   17408
#define L_V    34816
#define L_SGT  44032
#define L_P    61440
#undef  SCAN_GB
#define SCAN_GB 70656

__device__ __forceinline__ int off128(int row, int col) { return row * 272 + col * 2; }
__device__ __forceinline__ int off64(int row, int col) { return row * 144 + col * 2; }

template <int RS>
__device__ __forceinline__ bf16x8 tr_frag(unsigned img_addr, int r0, int c0, int lane) {
  const int g = lane >> 4, q = (lane & 15) >> 2, pp = lane & 3;
  unsigned a = img_addr + (unsigned)((r0 + 8 * g + q) * RS + (c0 + 4 * pp) * 2);
  bf16x4 lo, hi;
  asm volatile("ds_read_b64_tr_b16 %0, %2\n\tds_read_b64_tr_b16 %1, %2 offset:%3\n\ts_waitcnt lgkmcnt(0)"
               : "=&v"(lo), "=&v"(hi) : "v"(a), "n"(4 * RS) : "memory");
  bf16x8 r;
  r[0] = lo[0]; r[1] = lo[1]; r[2] = lo[2]; r[3] = lo[3]; r[4] = hi[0]; r[5] = hi[1]; r[6] = hi[2]; r[7] = hi[3];
  return r;
}

__device__ __forceinline__ bf16x8 scale8(bf16x8 v, float f) {
  bf16x8 o;
#pragma unroll
  for (int x = 0; x < 8; ++x) o[x] = (short)f2bf(bf2f((u16)v[x]) * f);
  return o;
}

__device__ __forceinline__ void lds_barrier() { asm volatile("s_waitcnt lgkmcnt(0)" ::: "memory"); __builtin_amdgcn_s_barrier(); asm volatile("" ::: "memory"); }

template <int branch>
__device__ __forceinline__ void scan_item(const Params& p, int l, int item, char* smem) {
  const int b = (item >> 4) & 7, h = (item >> 2) & 3, slice = item & 3;
  const int tid = opaque_tid(), wid = __builtin_amdgcn_readfirstlane(tid >> 6), lane = tid & 63;
  const int dir = wid >> 2, gw = wid & 3, gt = tid & 255;
  const int fr = lane & 15, fq = lane >> 4;
  char* G = smem + dir * SCAN_GB;
  const unsigned Ga = (unsigned)(size_t)G;
  const u16* S = (const u16*)(p.ws + OFF_S);
  u16* RG = (u16*)(p.ws + OFF_RG);
  const u16* qsrc; unsigned qstride;
  if (branch == 0) { qsrc = S + h * 128; qstride = 4096; }
  else if (dir == 0) { qsrc = S + 2048 + h * 128; qstride = 4096; }
  else { qsrc = (l == 0 ? (const u16*)p.out : (const u16*)(p.ws + OFF_U)) + h * 128; qstride = 1024; }
  const int voff = branch * 2048 + 1024 + h * 256 + slice * 64;
  const int ooff = branch * 1024 + h * 256 + slice * 64;
  float lg = 0.f, egc = 1.f;
  if (branch == 0) { lg = __logf(1.f - __expf(p.ret_decay[(l * 2 + dir) * 4 + h])); egc = __expf(32.f * lg); }
  const float* VECS = (const float*)(p.ws + OFF_VECS) + ((size_t)(dir * 544 + b * 68) * 2) * 512 + h * 128;
  f32x4 st[2][4];
#pragma unroll
  for (int m = 0; m < 2; ++m)
#pragma unroll
    for (int n = 0; n < 4; ++n) st[m][n] = (f32x4){0.f, 0.f, 0.f, 0.f};

  const int qj = gt >> 4, qc = gt & 15;
  const int vj = gt >> 3, vc = gt & 7;
  bf16x8 pq[4], pk[4], pv[2];
  float4 peg[2], pel[2];
  auto prefetch = [&](int s) {
    int base, cid;
    if (s < 4) { int cc = dir ? 3 - s : s; base = MLAT + b * 256 + cc * 64; cid = cc; }
    else { int c = s - 4; int cc = dir ? 63 - c : c; base = b * 4096 + cc * 64; cid = 4 + cc; }
#pragma unroll
    for (int i = 0; i < 4; ++i) {
      int jp = qj + 16 * i;
      unsigned ro = (unsigned)(base + (dir ? 63 - jp : jp)) * qstride + qc * 8;
      pq[i] = *(const bf16x8*)(qsrc + ro);
      pk[i] = *(const bf16x8*)(qsrc + ro + 512);
    }
#pragma unroll
    for (int i = 0; i < 2; ++i) {
      int jp = vj + 32 * i;
      pv[i] = *(const bf16x8*)(S + (size_t)(base + (dir ? 63 - jp : jp)) * 4096 + voff + vc * 8);
    }
    if (branch == 1) {
#pragma unroll
      for (int m = 0; m < 2; ++m) {
        int d0 = gw * 32 + m * 16 + fq * 4;
        peg[m] = *(const float4*)(VECS + (size_t)cid * 1024 + d0);
        pel[m] = *(const float4*)(VECS + (size_t)cid * 1024 + 512 + d0);
      }
    }
  };
  prefetch(0);
  __syncthreads();

  for (int s = 0; s < 68; ++s) {
    int base; bool first; bool wout;
    if (s < 4) { int cc = dir ? 3 - s : s; base = MLAT + b * 256 + cc * 64; first = s < 2; wout = (l == 0); }
    else { int c = s - 4; int cc = dir ? 63 - c : c; base = b * 4096 + cc * 64; first = c < 32; wout = true; }
    float4 eg[2], el[2];
#pragma unroll
    for (int m = 0; m < 2; ++m) {
      if (branch == 1) { eg[m] = peg[m]; el[m] = pel[m]; }
      else { eg[m] = make_float4(egc, egc, egc, egc); el[m] = eg[m]; }
    }
#pragma unroll
    for (int i = 0; i < 4; ++i) {
      int jp = qj + 16 * i;
      bf16x8 qv = pq[i], kv_ = pk[i];
      if (branch == 0) {
        float fqs = __expf((float)(jp - 31) * lg), fks = __expf((float)(31 - jp) * lg);
        qv = scale8(qv, fqs); kv_ = scale8(kv_, fks);
      }
      *(bf16x8*)(G + L_QR + off128(jp, qc * 8)) = qv;
      *(bf16x8*)(G + L_KR + off128(jp, qc * 8)) = kv_;
    }
#pragma unroll
    for (int i = 0; i < 2; ++i) *(bf16x8*)(G + L_V + off64(vj + 32 * i, vc * 8)) = pv[i];
#pragma unroll
    for (int m = 0; m < 2; ++m) {
      int d0 = gw * 32 + m * 16 + fq * 4;
#pragma unroll
      for (int n = 0; n < 4; ++n) {
        int e = n * 16 + fr;
        bf16x4 o4;
        o4[0] = (short)f2bf(st[m][n][0] * eg[m].x); o4[1] = (short)f2bf(st[m][n][1] * eg[m].y);
        o4[2] = (short)f2bf(st[m][n][2] * eg[m].z); o4[3] = (short)f2bf(st[m][n][3] * eg[m].w);
        *(bf16x4*)(G + L_SGT + off128(e, d0)) = o4;
      }
    }
    u16 oldv[4][4];
    u16* dstb = RG + (size_t)base * 2048 + ooff + fr;
    if (wout && !first) {
#pragma unroll
      for (int r = 0; r < 4; ++r) {
        int ip = gw * 16 + fq * 4 + r;
        unsigned ro = (unsigned)(dir ? 63 - ip : ip) * 2048u;
#pragma unroll
        for (int n = 0; n < 4; ++n) oldv[r][n] = dstb[ro + n * 16];
      }
    }
    if (s + 1 < 68) prefetch(s + 1);
    lds_barrier();
    f32x4 pt[4], o[4];
#pragma unroll
    for (int n = 0; n < 4; ++n) { pt[n] = (f32x4){0.f, 0.f, 0.f, 0.f}; o[n] = (f32x4){0.f, 0.f, 0.f, 0.f}; }
#pragma unroll
    for (int ks = 0; ks < 4; ++ks) {
      int kc = ks * 32 + fq * 8;
      bf16x8 qa = *(const bf16x8*)(G + L_QR + off128(gw * 16 + fr, kc));
#pragma unroll
      for (int n = 0; n < 4; ++n) {
        bf16x8 ka = *(const bf16x8*)(G + L_KR + off128(n * 16 + fr, kc));
        bf16x8 sb = *(const bf16x8*)(G + L_SGT + off128(n * 16 + fr, kc));
        pt[n] = __builtin_amdgcn_mfma_f32_16x16x32_bf16(ka, qa, pt[n], 0, 0, 0);
        o[n] = __builtin_amdgcn_mfma_f32_16x16x32_bf16(qa, sb, o[n], 0, 0, 0);
      }
    }
    {
      const int ip = gw * 16 + fr;
#pragma unroll
      for (int n = 0; n < 4; ++n) {
        const int j0 = n * 16 + fq * 4;
        bf16x4 w;
#pragma unroll
        for (int r = 0; r < 4; ++r) {
          int jp = j0 + r;
          bool keep = dir ? (ip > jp) : (ip >= jp);
          w[r] = (short)f2bf(keep ? pt[n][r] : 0.f);
        }
        *(bf16x4*)(G + L_P + off64(ip, j0)) = w;
      }
    }
    asm volatile("s_waitcnt lgkmcnt(0)" ::: "memory");
    {
      const int tg = lane >> 4, tq = (lane & 15) >> 2, tp = lane & 3;
      const unsigned ka0 = Ga + L_KR + (unsigned)((8 * tg + tq) * 272 + (gw * 32 + 4 * tp) * 2);
      const unsigned va0 = Ga + L_V + (unsigned)((8 * tg + tq) * 144 + (4 * tp) * 2);
#pragma unroll
      for (int m = 0; m < 2; ++m) {
        f32x4 kv[4];
#pragma unroll
        for (int n = 0; n < 4; ++n) kv[n] = (f32x4){0.f, 0.f, 0.f, 0.f};
#pragma unroll
        for (int ks = 0; ks < 2; ++ks) {
          int kc = ks * 32 + fq * 8;
          bf16x4 r0, r1, r2, r3, r4, r5, r6, r7, r8, r9;
          asm volatile(
              "ds_read_b64_tr_b16 %0, %10\n\tds_read_b64_tr_b16 %1, %10 offset:1088\n\t"
              "ds_read_b64_tr_b16 %2, %11\n\tds_read_b64_tr_b16 %3, %11 offset:576\n\t"
              "ds_read_b64_tr_b16 %4, %11 offset:32\n\tds_read_b64_tr_b16 %5, %11 offset:608\n\t"
              "ds_read_b64_tr_b16 %6, %11 offset:64\n\tds_read_b64_tr_b16 %7, %11 offset:640\n\t"
              "ds_read_b64_tr_b16 %8, %11 offset:96\n\tds_read_b64_tr_b16 %9, %11 offset:672\n\t"
              "s_waitcnt lgkmcnt(0)"
              : "=&v"(r0), "=&v"(r1), "=&v"(r2), "=&v"(r3), "=&v"(r4), "=&v"(r5), "=&v"(r6), "=&v"(r7), "=&v"(r8), "=&v"(r9)
              : "v"(ka0 + (unsigned)(ks * 32 * 272 + m * 32)), "v"(va0 + (unsigned)(ks * 32 * 144))
              : "memory");
          bf16x8 km = __builtin_shufflevector(r0, r1, 0, 1, 2, 3, 4, 5, 6, 7);
          bf16x8 vb[4];
          vb[0] = __builtin_shufflevector(r2, r3, 0, 1, 2, 3, 4, 5, 6, 7);
          vb[1] = __builtin_shufflevector(r4, r5, 0, 1, 2, 3, 4, 5, 6, 7);
          vb[2] = __builtin_shufflevector(r6, r7, 0, 1, 2, 3, 4, 5, 6, 7);
          vb[3] = __builtin_shufflevector(r8, r9, 0, 1, 2, 3, 4, 5, 6, 7);
          bf16x8 pa;
          if (m == 0) pa = *(const bf16x8*)(G + L_P + off64(gw * 16 + fr, kc));
#pragma unroll
          for (int n = 0; n < 4; ++n) {
            if (m == 0) o[n] = __builtin_amdgcn_mfma_f32_16x16x32_bf16(pa, vb[n], o[n], 0, 0, 0);
            kv[n] = __builtin_amdgcn_mfma_f32_16x16x32_bf16(km, vb[n], kv[n], 0, 0, 0);
          }
        }
#pragma unroll
        for (int n = 0; n < 4; ++n) {
          st[m][n][0] = eg[m].x * el[m].x * st[m][n][0] + el[m].x * kv[n][0];
          st[m][n][1] = eg[m].y * el[m].y * st[m][n][1] + el[m].y * kv[n][1];
          st[m][n][2] = eg[m].z * el[m].z * st[m][n][2] + el[m].z * kv[n][2];
          st[m][n][3] = eg[m].w * el[m].w * st[m][n][3] + el[m].w * kv[n][3];
        }
      }
    }
    if (wout) {
#pragma unroll
      for (int r = 0; r < 4; ++r) {
        int ip = gw * 16 + fq * 4 + r;
        unsigned ro = (unsigned)(dir ? 63 - ip : ip) * 2048u;
#pragma unroll
        for (int n = 0; n < 4; ++n) {
          float v = o[n][r];
          if (!first) v += bf2f(oldv[r][n]);
          dstb[ro + n * 16] = f2bf(v);
        }
      }
    }
    __syncthreads();
  }
}

#define NPHASE 18
__device__ __forceinline__ void run_phase(const Params& p, int ph, char* smem) {
  const int nblk = gridDim.x, bid = blockIdx.x;
  if (ph == 0) {
#ifdef REP_P0
    for (int rep = 0; rep < REP_P0; ++rep)
#endif
    for (int u = bid; u < WT_UNITS + 96 + 1; u += nblk) {
      if (u < 96) mod_unit(p, u, smem);
      else if (u == 96) rot_unit(p);
      else wt_unit(p, 0, u - 97, smem);
    }
    return;
  }
  if (ph == NPHASE - 1) { phase_final(p); return; }
  const int l = (ph - 1) / 8, sp = (ph - 1) % 8;
  PG8_LAS unsigned char* lds = (PG8_LAS unsigned char*)smem;
  switch (sp) {
    case 0:
      phase_u(p, l);
      if (l == 1) for (int u = bid; u < WT_UNITS; u += nblk) wt_unit(p, 1, u, smem);
      break;
    case 1: {
      pg8::Gemm g{(const u16*)(p.ws + OFF_U), (const u16*)(p.ws + OFF_WT) + (size_t)WT_SCAN * 1024, 1024, MTOT, 4096, 1024};
      pg8::StaticOrder S; S.init(g.M, g.N, nblk, bid);
      EpiScanIn E{(u16*)(p.ws + OFF_S), (const float*)(p.ws + OFF_ROT)};
      pg8::gemm_phase(lds, g, S, E, opaque_tid());
    } break;
    case 2:
      for (int t = bid; t < 256; t += nblk) gla_prepass_unit(p, l, t, smem);
      for (int t = 1024 + (bid + 96) % nblk; t < 1088; t += nblk) gla_prepass_unit1(p, l, t, smem);
      break;
    case 3:
#ifdef REP_SCAN
      for (int rep = 0; rep < REP_SCAN; ++rep)
#endif
      for (int t = bid; t < 256; t += nblk) { if (t < 128) scan_item<0>(p, l, t, smem); else scan_item<1>(p, l, t, smem); } break;
    case 4:
      if (l != 0) phase_u(p, l);
      phase_stats(p, l);
      break;
    case 5: {
      pg8::Gemm g{(const u16*)(p.ws + OFF_U), (const u16*)(p.ws + OFF_WT) + (size_t)WT_GATE * 1024, 1024, l == 0 ? MTOT : MLAT, 4096, 1024};
      pg8::StaticOrder S; S.init(g.M, g.N, nblk, bid);
      EpiGate E{(const u16*)(p.ws + OFF_RG), (const float*)(p.ws + OFF_STATS), (u16*)(p.ws + OFF_S), p.ret_norm_gain + l * 1024, p.gla_norm_gain + l * 1024};
      pg8::gemm_phase(lds, g, S, E, opaque_tid());
    } break;
    case 6: {
#pragma unroll 1
      for (int pass = 0; pass < 2; ++pass) {
        pg8::Gemm g{(const u16*)(p.ws + OFF_S) + 2048 + pass * 1024, (const u16*)(p.ws + OFF_WT) + (size_t)(WT_BRR + pass * 1024) * 1024, 4096, l == 0 ? MTOT : MLAT, 1024, 1024};
        pg8::StaticOrder S; S.init(g.M, g.N, nblk, bid);
        EpiMerge E{(const u16*)(p.ws + OFF_S), (u16*)(p.ws + OFF_U), pass};
        pg8::gemm_phase(lds, g, S, E, opaque_tid());
      }
    } break;
    case 7: {
      pg8::Gemm g{(const u16*)(p.ws + OFF_U), (const u16*)(p.ws + OFF_WT) + (size_t)WT_OUT * 1024, 1024, l == 0 ? MTOT : MLAT, 1024, 1024};
      pg8::StaticOrder S; S.init(g.M, g.N, nblk, bid);
      EpiOut E{l == 0 ? p.x : p.out, p.ctx, p.out, (float*)(p.ws + OFF_HCTX), (const float*)(p.ws + OFF_MOD) + (size_t)l * 9 * 3072};
      pg8::gemm_phase(lds, g, S, E, opaque_tid());
    } break;
  }
}

__device__ __forceinline__ void grid_barrier(unsigned* cnt, unsigned target) {
  asm volatile("s_waitcnt vmcnt(0)" ::: "memory");
  __syncthreads();
  if (threadIdx.x == 0) {
    __threadfence();
    __hip_atomic_fetch_add(cnt, 1u, __ATOMIC_RELAXED, __HIP_MEMORY_SCOPE_AGENT);
    while (__hip_atomic_load(cnt, __ATOMIC_RELAXED, __HIP_MEMORY_SCOPE_AGENT) < target) __builtin_amdgcn_s_sleep(2);
    __threadfence();
  }
  __syncthreads();
}

__global__ void __launch_bounds__(NTHREADS) mega(Params p, int ph_lo, int ph_hi, int coop) {
  extern __shared__ __attribute__((aligned(16))) char smem[];
  for (int ph = ph_lo; ph < ph_hi; ++ph) {
    run_phase(p, ph, smem);
    if (coop && ph + 1 < ph_hi) {
      if (ph == ph_lo) cg::this_grid().sync();
      else grid_barrier((unsigned*)(p.ws + OFF_BAR), (unsigned)(ph - ph_lo) * gridDim.x);
    }
  }
}

extern "C" void kernel_launch(void* const* d_in, const int* in_sizes, int n_in,
                              void* d_out, int out_size, void* d_ws, size_t ws_size,
                              hipStream_t stream) {
  Params p{};
  p.x = (const float*)d_in[0]; p.c = (const float*)d_in[1]; p.ctx = (const float*)d_in[2]; p.c_ctx = (const float*)d_in[3];
  p.norm_gain = (const float*)d_in[4]; p.w_ada = (const float*)d_in[5]; p.b_ada = (const float*)d_in[6]; p.w_in = (const float*)d_in[7];
  p.ret_decay = (const float*)d_in[8]; p.gla_w_up = (const float*)d_in[9]; p.gla_b_up = (const float*)d_in[10];
  p.ret_norm_gain = (const float*)d_in[11]; p.gla_norm_gain = (const float*)d_in[12];
  p.w_br_ret = (const float*)d_in[13]; p.w_br_gla = (const float*)d_in[14]; p.w_out = (const float*)d_in[15]; p.final_gain = (const float*)d_in[16];
  p.out = (float*)d_out; p.ws = (char*)d_ws;
  static int grid_blocks = 0;
  if (!grid_blocks) {
    hipFuncSetAttribute((const void*)mega, hipFuncAttributeMaxDynamicSharedMemorySize, LDS_BYTES);
    int dev = 0, cus = 0, per_cu = 0;
    hipGetDevice(&dev);
    hipDeviceGetAttribute(&cus, hipDeviceAttributeMultiprocessorCount, dev);
    hipOccupancyMaxActiveBlocksPerMultiprocessor(&per_cu, mega, NTHREADS, LDS_BYTES);
    if (per_cu < 1) per_cu = 1;
    grid_blocks = cus * 1;
  }
#ifdef MULTI_LAUNCH
  for (int ph = 0; ph < NPHASE; ++ph) {
    mega<<<dim3(grid_blocks), dim3(NTHREADS), LDS_BYTES, stream>>>(p, ph, ph + 1, 0);
  }
#else
  hipMemsetAsync((char*)d_ws + OFF_BAR, 0, 256, stream);
  int lo = 0, hi = NPHASE, coop = 1;
  void* args[] = {&p, &lo, &hi, &coop};
  hipError_t e = hipLaunchCooperativeKernel((void*)mega, dim3(grid_blocks), dim3(NTHREADS), args, LDS_BYTES, stream);
  if (e != hipSuccess) fprintf(stderr, "cooperative launch failed: %s (grid %d)\n", hipGetErrorString(e), grid_blocks);
#endif
}
```

```cpp
#include <hip/hip_runtime.h>
#include <hip/hip_cooperative_groups.h>
#include <cstdio>
namespace cg = cooperative_groups;

typedef unsigned short u16;
using bf16x8 = __attribute__((ext_vector_type(8))) short;
using bf16x4 = __attribute__((ext_vector_type(4))) short;
using f32x4  = __attribute__((ext_vector_type(4))) float;

#define NTHREADS 512
#define DM 1024
#define NB 8
#define SEQL 4096
#define CTXL 256
#define MLAT 32768
#define MCTX 2048
#define MTOT 34816
#define INW 8208

#define OFF_S    0ull
#define OFF_RG   (OFF_S   + (size_t)MTOT * 4096 * 2)
#define OFF_U    (OFF_RG  + (size_t)MTOT * 2048 * 2)
#define OFF_WT   (OFF_U   + (size_t)MTOT * 1024 * 2)
#define WT_ROWS  11392
#define OFF_GLR  (OFF_WT  + (size_t)WT_ROWS * 1024 * 2)
#define OFF_HCTX (OFF_GLR + (size_t)MTOT * 16 * 4)
#define OFF_MOD  (OFF_HCTX+ (size_t)MCTX * 1024 * 4)
#define OFF_ROT  (OFF_MOD + (size_t)2 * 9 * 3072 * 4)
#define OFF_BAR  (OFF_ROT + (size_t)64 * 32 * 2 * 4)
#define OFF_END  (OFF_BAR + 256)

#define WT_SCAN 0
#define WT_GATE 4224
#define WT_BRR  8320
#define WT_BRG  9344
#define WT_OUT  10368

#define LDS_BYTES 161792
#define SCAN_GB   80896

struct Params {
  const float* x; const float* c; const float* ctx; const float* c_ctx;
  const float* norm_gain; const float* w_ada; const float* b_ada; const float* w_in;
  const float* ret_decay; const float* gla_w_up; const float* gla_b_up;
  const float* ret_norm_gain; const float* gla_norm_gain;
  const float* w_br_ret; const float* w_br_gla; const float* w_out; const float* final_gain;
  float* out; char* ws;
};

__device__ __forceinline__ u16 f2bf(float f) {
  __bf16 h = (__bf16)f;
  return *(u16*)&h;
}
__device__ __forceinline__ float bf2f(u16 h) { return __uint_as_float(((unsigned)h) << 16); }
__device__ __forceinline__ float sigmoidf_(float x) { return __builtin_amdgcn_rcpf(1.f + __expf(-x)); }
__device__ __forceinline__ float siluf_(float x) { return x * __builtin_amdgcn_rcpf(1.f + __expf(-x)); }

__device__ __forceinline__ int opaque_tid() { int t = threadIdx.x; asm volatile("" : "+v"(t)); return t; }

__device__ __forceinline__ float wave_sum(float v) {
#pragma unroll
  for (int o = 32; o > 0; o >>= 1) v += __shfl_xor(v, o, 64);
  return v;
}

__device__ __forceinline__ const float* wt_src(const Params& p, int l, int n, int& ld) {
  if (n < WT_GATE) {
    int tile = n >> 7, cc = n & 127;
    int col;
    if (tile < 8) {
      int d = (cc & 64) | ((cc & 16) << 1) | ((cc & 32) >> 1) | (cc & 15);
      col = tile * 128 + d;
    } else if (tile < 16) col = 1024 + (tile - 8) * 128 + cc;
    else if (tile < 24) col = 3072 + (tile - 16) * 128 + cc;
    else if (tile < 32) col = 4096 + (tile - 24) * 128 + cc;
    else { if (cc >= 16) { ld = 0; return nullptr; } col = 6144 + cc; }
    ld = INW; return p.w_in + (size_t)l * DM * INW + col;
  } else if (n < WT_BRR) {
    int g = n - WT_GATE; int col;
    if (g < 1024) col = 2048 + g;
    else if (g < 2048) col = 5120 + (g - 1024);
    else if (g < 3072) col = 6160 + (g - 2048);
    else col = 7184 + (g - 3072);
    ld = INW; return p.w_in + (size_t)l * DM * INW + col;
  } else if (n < WT_BRG) { ld = DM; return p.w_br_ret + (size_t)l * DM * DM + (n - WT_BRR); }
  else if (n < WT_OUT)   { ld = DM; return p.w_br_gla + (size_t)l * DM * DM + (n - WT_BRG); }
  else                   { ld = DM; return p.w_out    + (size_t)l * DM * DM + (n - WT_OUT); }
}

#define WT_UNITS (178 * 4)
__device__ __forceinline__ void wt_unit(const Params& p, int l, int unit, char* smem) {
  float* tile = (float*)smem;
  int nb = unit >> 2, kg = unit & 3;
  int tid = opaque_tid();
  int n0 = nb * 64, kbase = kg * 256;
  float v[4][8];
  {
    int nl = tid & 63, kq = tid >> 6;
    int ld; const float* src = wt_src(p, l, n0 + nl, ld);
#pragma unroll
    for (int q = 0; q < 4; ++q)
#pragma unroll
      for (int i = 0; i < 8; ++i) v[q][i] = src ? src[(size_t)(kbase + q * 64 + kq + 8 * i) * ld] : 0.f;
  }
  u16* wt = (u16*)(p.ws + OFF_WT);
#pragma unroll
  for (int q = 0; q < 4; ++q) {
    __syncthreads();
    {
      int nl = tid & 63, kq = tid >> 6;
#pragma unroll
      for (int i = 0; i < 8; ++i) tile[(kq + 8 * i) * 65 + nl] = v[q][i];
    }
    __syncthreads();
    {
      int nl = tid >> 3, kq = tid & 7;
      bf16x8 o;
#pragma unroll
      for (int j = 0; j < 8; ++j) o[j] = (short)f2bf(tile[(kq * 8 + j) * 65 + nl]);
      *(bf16x8*)(wt + (size_t)(n0 + nl) * 1024 + kbase + q * 64 + kq * 8) = o;
    }
  }
  __syncthreads();
}

__device__ __forceinline__ void mod_unit(const Params& p, int unit, char* smem) {
  float* sc = (float*)smem;
  float* red = sc + 9 * 1024;
  int l = unit / 48, jb = unit % 48;
  int tid = opaque_tid();
  for (int i = tid; i < 9 * 1024; i += NTHREADS) {
    int r = i >> 10, k = i & 1023;
    float v = (r < 8) ? p.c[r * 1024 + k] : p.c_ctx[k];
    sc[i] = siluf_(v);
  }
  __syncthreads();
  int jl = tid & 63, kg = tid >> 6;
  int j = jb * 64 + jl;
  float acc[9];
#pragma unroll
  for (int r = 0; r < 9; ++r) acc[r] = 0.f;
  const float* w = p.w_ada + (size_t)l * DM * 3072 + j;
#pragma unroll 16
  for (int k = kg * 128; k < kg * 128 + 128; ++k) {
    float wv = w[(size_t)k * 3072];
#pragma unroll
    for (int r = 0; r < 9; ++r) acc[r] += sc[r * 1024 + k] * wv;
  }
#pragma unroll
  for (int r = 0; r < 9; ++r) red[(kg * 9 + r) * 64 + jl] = acc[r];
  __syncthreads();
  float* mod = (float*)(p.ws + OFF_MOD);
  for (int i = tid; i < 9 * 64; i += NTHREADS) {
    int r = i >> 6, jj = i & 63;
    float s = 0.f;
#pragma unroll
    for (int g = 0; g < 8; ++g) s += red[(g * 9 + r) * 64 + jj];
    mod[((size_t)l * 9 + r) * 3072 + jb * 64 + jj] = s + p.b_ada[l * 3072 + jb * 64 + jj];
  }
  __syncthreads();
}

__device__ __forceinline__ void rot_unit(const Params& p) {
  float* rot = (float*)(p.ws + OFF_ROT);
  for (int i = opaque_tid(); i < 64 * 32; i += NTHREADS) {
    int pos = i >> 5, f = i & 31;
    float inv = exp2f(-(float)f * (13.287712379549449f / 32.f));
    float ang = (float)pos * inv;
    rot[i * 2] = __cosf(ang);
    rot[i * 2 + 1] = __sinf(ang);
  }
}

__device__ __forceinline__ void phase_u(const Params& p, int l) {
  const int tid = opaque_tid(); int wave = tid >> 6, lane = tid & 63;
  const float* mod = (const float*)(p.ws + OFF_MOD) + (size_t)l * 9 * 3072;
  const float* gain = p.norm_gain + l * DM;
  u16* U = (u16*)(p.ws + OFF_U);
  for (int row = (blockIdx.x * 8 + wave) * 4; row < MTOT; row += gridDim.x * 32) {
    const float* h; int r;
    if (row < MLAT) { h = (l == 0 ? p.x : p.out) + (size_t)row * DM; r = row >> 12; }
    else { int cr = row - MLAT; h = (l == 0 ? p.ctx : (const float*)(p.ws + OFF_HCTX)) + (size_t)cr * DM; r = 8; }
    float4 v[4][4]; float ss[4];
#pragma unroll
    for (int q = 0; q < 4; ++q) {
      ss[q] = 0.f;
#pragma unroll
      for (int i = 0; i < 4; ++i) v[q][i] = *(const float4*)(h + q * DM + i * 256 + lane * 4);
    }
#pragma unroll
    for (int q = 0; q < 4; ++q) {
#pragma unroll
      for (int i = 0; i < 4; ++i) ss[q] += v[q][i].x * v[q][i].x + v[q][i].y * v[q][i].y + v[q][i].z * v[q][i].z + v[q][i].w * v[q][i].w;
      ss[q] = rsqrtf(wave_sum(ss[q]) * (1.f / 1024.f) + 1e-6f);
    }
    const float* sh = mod + r * 3072;
#pragma unroll
    for (int i = 0; i < 4; ++i) {
      int cidx = i * 256 + lane * 4;
      float4 g = *(const float4*)(gain + cidx);
      float4 s = *(const float4*)(sh + cidx);
      float4 sc = *(const float4*)(sh + 1024 + cidx);
      g.x *= (1.f + sc.x); g.y *= (1.f + sc.y); g.z *= (1.f + sc.z); g.w *= (1.f + sc.w);
#pragma unroll
      for (int q = 0; q < 4; ++q) {
        bf16x4 o;
        o[0] = (short)f2bf(v[q][i].x * ss[q] * g.x + s.x);
        o[1] = (short)f2bf(v[q][i].y * ss[q] * g.y + s.y);
        o[2] = (short)f2bf(v[q][i].z * ss[q] * g.z + s.z);
        o[3] = (short)f2bf(v[q][i].w * ss[q] * g.w + s.w);
        *(bf16x4*)(U + (size_t)(row + q) * DM + cidx) = o;
      }
    }
  }
}

__device__ __forceinline__ void phase_final(const Params& p) {
  const int tid = opaque_tid(); int wave = tid >> 6, lane = tid & 63;
  for (int row = (blockIdx.x * 8 + wave) * 4; row < MLAT; row += gridDim.x * 32) {
    float* h = p.out + (size_t)row * DM;
    float4 v[4][4]; float ss[4];
#pragma unroll
    for (int q = 0; q < 4; ++q) {
      ss[q] = 0.f;
#pragma unroll
      for (int i = 0; i < 4; ++i) v[q][i] = *(const float4*)(h + q * DM + i * 256 + lane * 4);
    }
#pragma unroll
    for (int q = 0; q < 4; ++q) {
#pragma unroll
      for (int i = 0; i < 4; ++i) ss[q] += v[q][i].x * v[q][i].x + v[q][i].y * v[q][i].y + v[q][i].z * v[q][i].z + v[q][i].w * v[q][i].w;
      ss[q] = rsqrtf(wave_sum(ss[q]) * (1.f / 1024.f) + 1e-6f);
    }
#pragma unroll
    for (int i = 0; i < 4; ++i) {
      int cidx = i * 256 + lane * 4;
      float4 g = *(const float4*)(p.final_gain + cidx);
#pragma unroll
      for (int q = 0; q < 4; ++q) {
        float4 o;
        o.x = v[q][i].x * ss[q] * g.x; o.y = v[q][i].y * ss[q] * g.y; o.z = v[q][i].z * ss[q] * g.z; o.w = v[q][i].w * ss[q] * g.w;
        *(float4*)(h + q * DM + cidx) = o;
      }
    }
  }
}

#define PG8_LAS __attribute__((address_space(3)))
typedef unsigned u32x4 __attribute__((ext_vector_type(4)));
namespace pg8 {
constexpr int BM = 256, BK = 64, HALF = 128, HTB = HALF * BK * 2, STAGE_BYTES = 8 * HTB, NXCD = 8, WGM = 8;
__device__ __forceinline__ int lds_byte(int r, int c) { const int st = (r >> 4) * 2 + (c >> 5), rr = r & 15, cc = c & 31, ob = rr * 64 + cc * 2; return st * 1024 + (ob ^ (((ob >> 9) & 1) << 5)); }
__device__ __forceinline__ void stage_rc(int b, int& R, int& C) { const int st = b / 1024, sb = b % 1024, swz = sb ^ (((sb >> 9) & 1) << 5); R = (st >> 1) * 16 + swz / 64; C = (st & 1) * 32 + (swz % 64) / 2; }
__device__ __forceinline__ int perm32(int rho) { const int n = rho >> 4, i = rho & 15; return 8 * (i >> 2) + 4 * n + (i & 3); }
struct Unit { int pm, pn; };
struct Gemm { const u16* A; const u16* Bt; int lda; int M, N, K; };
struct StaticOrder {
  int nM, nN, nwg, G, c;
  __device__ void init(int M, int N, int G_, int c_) { nM = M / BM; nN = N / BM; nwg = nM * nN; G = G_; c = c_; }
  __device__ bool next(int i, Unit& u) const {
    const long L = (long)i * G + c; if (L >= nwg) return false;
    int wgid = (int)L; { const int q = nwg / NXCD, r = nwg % NXCD, xcd = wgid % NXCD, off = wgid / NXCD; wgid = (xcd < r ? xcd * (q + 1) : r * (q + 1) + (xcd - r) * q) + off; }
    const int nig = WGM * nN, gid = wgid / nig, fm = gid * WGM, gsz = (nM - fm) < WGM ? (nM - fm) : WGM;
    u.pm = fm + ((wgid % nig) % gsz); u.pn = (wgid % nig) / gsz; return true;
  }
};
typedef __attribute__((ext_vector_type(2))) float cvt_f2_t;
typedef __attribute__((ext_vector_type(2))) __bf16 cvt_b2_t;
__device__ __forceinline__ unsigned cvt_pk_bf16(float lo, float hi) { cvt_f2_t f = {lo, hi}; cvt_b2_t r = __builtin_convertvector(f, cvt_b2_t); return __builtin_bit_cast(unsigned, r); }

template <class Epi>
__device__ __forceinline__ void gemm_phase(PG8_LAS unsigned char* lds, const Gemm g, const StaticOrder& S, const Epi& E, const int tid) {
  const int wid = __builtin_amdgcn_readfirstlane(tid >> 6), lane = tid & 63, wr = wid >> 2, wc = wid & 3, fr = lane & 15, fq = lane >> 4;
  const int K = g.K, nt = K / BK;
  unsigned voffA[2], voffB[2];
#pragma unroll
  for (int i = 0; i < 2; ++i) { int R, C; stage_rc(tid * 16 + i * 8192, R, C); const int Rb = Epi::PERM ? ((R & ~31) + perm32(R & 31)) : R;
    voffA[i] = (unsigned)(R * g.lda + C) * 2u; voffB[i] = (unsigned)(Rb * K + C) * 2u; }
  const size_t kstep = (size_t)(BK * 2);
  const size_t hstepA = (size_t)HALF * g.lda * 2, hstepB = (size_t)HALF * K * 2;
  const size_t tstepA = 2 * hstepA, tstepB = 2 * hstepB;
  const unsigned ldsw = (unsigned)wid * 1024u;
  const int aoff = lds_byte(wr * 64 + fr, fq * 8), boff = lds_byte(wc * 32 + fr, fq * 8);
#define PG8_SA(b, h) (((b) * 2 + (h)) * HTB)
#define PG8_SB(b, h) ((4 + (b) * 2 + (h)) * HTB)
#define PG8_STAGE(bufoff, gbase, voff) do { _Pragma("unroll") for (int _i = 0; _i < 2; ++_i) \
    __builtin_amdgcn_global_load_lds((const unsigned*)((const char*)(gbase) + (voff)[_i]), (PG8_LAS unsigned*)(lds + (bufoff) + ldsw + _i * 8192), 16, 0, 0); } while (0)
#define PG8_LDA(dst, b, h) do { _Pragma("unroll") for (int m = 0; m < 4; ++m) _Pragma("unroll") for (int k = 0; k < 2; ++k) dst[m][k] = *(const PG8_LAS bf16x8*)(lds + PG8_SA(b, h) + aoff + m * 2048 + k * 1024); } while (0)
#define PG8_LDB(dst, b, h) do { _Pragma("unroll") for (int n = 0; n < 2; ++n) _Pragma("unroll") for (int k = 0; k < 2; ++k) dst[n][k] = *(const PG8_LAS bf16x8*)(lds + PG8_SB(b, h) + boff + n * 2048 + k * 1024); } while (0)
#define PG8_MMA(ai, bj, At, Bt) do { __builtin_amdgcn_s_setprio(1); _Pragma("unroll") for (int m = 0; m < 4; ++m) _Pragma("unroll") for (int n = 0; n < 2; ++n) _Pragma("unroll") for (int k = 0; k < 2; ++k) \
    acc[ai][bj][m][n] = __builtin_amdgcn_mfma_f32_16x16x32_bf16(Bt[n][k], At[m][k], acc[ai][bj][m][n], 0, 0, 0); __builtin_amdgcn_s_setprio(0); } while (0)
#define PG8_WAIT_V(n) asm volatile("s_waitcnt vmcnt(" #n ")" ::: "memory")
#define PG8_WAIT_L(n) asm volatile("s_waitcnt lgkmcnt(" #n ")" ::: "memory")
#define PG8_BAR __builtin_amdgcn_s_barrier()
#define PG8_SCHED __builtin_amdgcn_sched_barrier(0)
  Unit cur, nxt; int ui = 0;
  if (!S.next(0, cur)) return;
  f32x4 acc[2][2][4][2];
#pragma unroll
  for (int a = 0; a < 2; ++a)
#pragma unroll
    for (int b = 0; b < 2; ++b)
#pragma unroll
      for (int m = 0; m < 4; ++m)
#pragma unroll
        for (int n = 0; n < 2; ++n) acc[a][b][m][n] = (f32x4){0.f, 0.f, 0.f, 0.f};
  bf16x8 At[4][2], B0[2][2], B1[2][2];
  const char* cA = (const char*)g.A + (size_t)cur.pm * tstepA; const char* cB = (const char*)g.Bt + (size_t)cur.pn * tstepB;
  PG8_STAGE(PG8_SB(0, 0), cB, voffB); PG8_STAGE(PG8_SA(0, 0), cA, voffA); PG8_STAGE(PG8_SB(0, 1), cB + hstepB, voffB); PG8_STAGE(PG8_SA(0, 1), cA + hstepA, voffA);
  if (wr == 1) PG8_BAR;
  PG8_WAIT_V(4); PG8_BAR;
  PG8_STAGE(PG8_SB(1, 0), cB + kstep, voffB); PG8_STAGE(PG8_SA(1, 0), cA + kstep, voffA); PG8_STAGE(PG8_SB(1, 1), cB + hstepB + kstep, voffB);
  PG8_WAIT_V(6); PG8_BAR;
  for (;;) {
    const bool has_next = S.next(ui + 1, nxt);
    const char* nA = has_next ? (const char*)g.A + (size_t)nxt.pm * tstepA : cA; const char* nB = has_next ? (const char*)g.Bt + (size_t)nxt.pn * tstepB : cB;
    for (int t = 0; t < nt; t += 2) {
      const bool last = (t == nt - 2);
      const char* a1 = cA + (size_t)(t + 1) * kstep;
      const char* a2 = last ? nA : cA + (size_t)(t + 2) * kstep; const char* b2 = last ? nB : cB + (size_t)(t + 2) * kstep;
      const char* a3 = a2 + kstep; const char* b3 = b2 + kstep;
      PG8_LDB(B0, 0, 0); PG8_SCHED; PG8_LDA(At, 0, 0); PG8_STAGE(PG8_SA(1, 1), a1 + hstepA, voffA);
      PG8_WAIT_L(8); PG8_BAR; PG8_WAIT_L(0); PG8_MMA(0, 0, At, B0); PG8_BAR; PG8_SCHED;
      PG8_LDB(B1, 0, 1); PG8_STAGE(PG8_SB(0, 0), b2, voffB);
      PG8_BAR; PG8_WAIT_L(0); PG8_MMA(0, 1, At, B1); PG8_BAR;
      PG8_LDA(At, 0, 1); PG8_STAGE(PG8_SA(0, 0), a2, voffA);
      PG8_BAR; PG8_WAIT_L(0); PG8_MMA(1, 0, At, B0); PG8_BAR; PG8_SCHED;
      PG8_STAGE(PG8_SB(0, 1), b2 + hstepB, voffB);
      PG8_WAIT_V(6); PG8_BAR; PG8_MMA(1, 1, At, B1); PG8_BAR;
      PG8_LDB(B0, 1, 0); PG8_SCHED; PG8_LDA(At, 1, 0); PG8_STAGE(PG8_SA(0, 1), a2 + hstepA, voffA);
      PG8_WAIT_L(8); PG8_BAR; PG8_WAIT_L(0); PG8_MMA(0, 0, At, B0); PG8_BAR; PG8_SCHED;
      PG8_LDB(B1, 1, 1); PG8_STAGE(PG8_SB(1, 0), b3, voffB);
      PG8_BAR; PG8_WAIT_L(0); PG8_MMA(0, 1, At, B1); PG8_BAR;
      PG8_LDA(At, 1, 1); PG8_STAGE(PG8_SA(1, 0), a3, voffA);
      PG8_BAR; PG8_WAIT_L(0); PG8_MMA(1, 0, At, B0); PG8_BAR; PG8_SCHED;
      PG8_STAGE(PG8_SB(1, 1), b3 + hstepB, voffB);
      PG8_WAIT_V(6); PG8_BAR; PG8_MMA(1, 1, At, B1); PG8_BAR;
    }
    E(acc, cur, wr, wc, fr, fq, lane);
    if (!has_next) break;
#pragma unroll
    for (int a = 0; a < 2; ++a)
#pragma unroll
      for (int b = 0; b < 2; ++b)
#pragma unroll
        for (int m = 0; m < 4; ++m)
#pragma unroll
          for (int n = 0; n < 2; ++n) acc[a][b][m][n] = (f32x4){0.f, 0.f, 0.f, 0.f};
    cur = nxt; cA = nA; cB = nB; ++ui;
  }
  PG8_WAIT_V(0);
  if (wr == 0) PG8_BAR;
  PG8_BAR;
#undef PG8_SA
#undef PG8_SB
#undef PG8_STAGE
#undef PG8_LDA
#undef PG8_LDB
#undef PG8_MMA
#undef PG8_WAIT_V
#undef PG8_WAIT_L
#undef PG8_BAR
#undef PG8_SCHED
}
}

#define OFF_STATS OFF_GLR

__device__ __forceinline__ u32x4 pack8v(const f32x4& a, const f32x4& b) {
  u32x4 w; w.x = pg8::cvt_pk_bf16(a[0], a[1]); w.y = pg8::cvt_pk_bf16(a[2], a[3]); w.z = pg8::cvt_pk_bf16(b[0], b[1]); w.w = pg8::cvt_pk_bf16(b[2], b[3]); return w;
}
__device__ __forceinline__ float xlane32(float v, int lane) { return __int_as_float(__builtin_amdgcn_ds_bpermute((lane ^ 32) << 2, __float_as_int(v))); }

struct EpiScanIn {
  static constexpr bool PERM = true;
  u16* S; const float* rot;
  __device__ __forceinline__ void operator()(const f32x4 (&acc)[2][2][4][2], const pg8::Unit& u, int wr, int wc, int fr, int fq, int lane) const {
    u16* Sb = S + (size_t)u.pm * 256 * 4096;
    unsigned rl0 = wr * 64 + fr; asm volatile("" : "+v"(rl0));
#pragma unroll
    for (int bj = 0; bj < 2; ++bj) {
      const int nt128 = u.pn * 2 + bj;
      const bool scaled = (nt128 < 4) || (nt128 >= 16 && nt128 < 20);
      const float scl = scaled ? 0.08838834764831845f : 1.f;
      const unsigned cb = nt128 * 128 + wc * 32 + fq * 8;
      if (nt128 < 8 && u.pm < 128) {
        const int tb = (u.pm & 15) * 256;
        const int fo = ((wc & 1) * 16 + (fq & 1) * 8) * 2;
        const float sgn = (fq >> 1) ? 1.f : -1.f;
#pragma unroll
        for (int ai = 0; ai < 2; ++ai)
#pragma unroll
          for (int m = 0; m < 4; ++m) {
            const unsigned rl = rl0 + ai * 128 + m * 16;
            const int t = tb + rl;
            const unsigned pos = (wc >> 1) == 0 ? (t >> 6) : (t & 63);
            const float* rp = rot + pos * 64u + fo;
            const float4 c0 = *(const float4*)rp, c1 = *(const float4*)(rp + 4), c2 = *(const float4*)(rp + 8), c3 = *(const float4*)(rp + 12);
            const f32x4 v0 = acc[ai][bj][m][0], v1 = acc[ai][bj][m][1];
            f32x4 p0, p1;
#pragma unroll
            for (int j = 0; j < 4; ++j) { p0[j] = xlane32(v0[j], lane); p1[j] = xlane32(v1[j], lane); }
            f32x4 o0, o1;
            o0[0] = (v0[0] * c0.x + sgn * p0[0] * c0.y) * scl; o0[1] = (v0[1] * c0.z + sgn * p0[1] * c0.w) * scl;
            o0[2] = (v0[2] * c1.x + sgn * p0[2] * c1.y) * scl; o0[3] = (v0[3] * c1.z + sgn * p0[3] * c1.w) * scl;
            o1[0] = (v1[0] * c2.x + sgn * p1[0] * c2.y) * scl; o1[1] = (v1[1] * c2.z + sgn * p1[1] * c2.w) * scl;
            o1[2] = (v1[2] * c3.x + sgn * p1[2] * c3.y) * scl; o1[3] = (v1[3] * c3.z + sgn * p1[3] * c3.w) * scl;
            *(u32x4*)(Sb + rl * 4096u + cb) = pack8v(o0, o1);
            __builtin_amdgcn_sched_barrier(0);
          }
      } else {
#pragma unroll
        for (int ai = 0; ai < 2; ++ai)
#pragma unroll
          for (int m = 0; m < 4; ++m) {
            const unsigned rl = rl0 + ai * 128 + m * 16;
            *(u32x4*)(Sb + rl * 4096u + cb) = pack8v(acc[ai][bj][m][0] * scl, acc[ai][bj][m][1] * scl);
            __builtin_amdgcn_sched_barrier(0);
          }
      }
    }
  }
};

struct EpiGate {
  static constexpr bool PERM = true;
  const u16* RG; const float* stats; u16* S; const float* rgain; const float* ggain;
  __device__ __forceinline__ void operator()(const f32x4 (&acc)[2][2][4][2], const pg8::Unit& u, int wr, int wc, int fr, int fq, int lane) const {
    u16* Sb = S + (size_t)u.pm * 256 * 4096;
    unsigned rl0 = wr * 64 + fr; asm volatile("" : "+v"(rl0));
    if (u.pn < 8) {
      const int branch = u.pn >> 2, head = u.pn & 3;
      const u16* RGb = RG + (size_t)u.pm * 256 * 2048 + branch * 1024;
      const float* stb = stats + (size_t)u.pm * 256 * 16 + (branch * 4 + head) * 2;
      const float* gain = branch ? ggain : rgain;
#pragma unroll
      for (int bj = 0; bj < 2; ++bj) {
        const unsigned cb = head * 256 + bj * 128 + wc * 32 + fq * 8;
        const float4 g0 = *(const float4*)(gain + cb), g1 = *(const float4*)(gain + cb + 4);
#pragma unroll
        for (int ai = 0; ai < 2; ++ai)
#pragma unroll
          for (int m = 0; m < 4; ++m) {
            const unsigned rl = rl0 + ai * 128 + m * 16;
            const float2 st = *(const float2*)(stb + rl * 16u);
            const bf16x8 xr = *(const bf16x8*)(RGb + rl * 2048u + cb);
            f32x4 v0 = acc[ai][bj][m][0], v1 = acc[ai][bj][m][1];
            asm volatile("" : "+v"(v0), "+v"(v1));
            f32x4 o0, o1;
            o0[0] = (bf2f((u16)xr[0]) * st.x + st.y) * g0.x * siluf_(v0[0]); o0[1] = (bf2f((u16)xr[1]) * st.x + st.y) * g0.y * siluf_(v0[1]);
            o0[2] = (bf2f((u16)xr[2]) * st.x + st.y) * g0.z * siluf_(v0[2]); o0[3] = (bf2f((u16)xr[3]) * st.x + st.y) * g0.w * siluf_(v0[3]);
            o1[0] = (bf2f((u16)xr[4]) * st.x + st.y) * g1.x * siluf_(v1[0]); o1[1] = (bf2f((u16)xr[5]) * st.x + st.y) * g1.y * siluf_(v1[1]);
            o1[2] = (bf2f((u16)xr[6]) * st.x + st.y) * g1.z * siluf_(v1[2]); o1[3] = (bf2f((u16)xr[7]) * st.x + st.y) * g1.w * siluf_(v1[3]);
            *(u32x4*)(Sb + rl * 4096u + 2048u + branch * 1024 + cb) = pack8v(o0, o1);
            __builtin_amdgcn_sched_barrier(0);
          }
      }
    } else {
#pragma unroll
      for (int bj = 0; bj < 2; ++bj) {
        const unsigned cb = (u.pn - 8) * 256 + bj * 128 + wc * 32 + fq * 8;
#pragma unroll
        for (int ai = 0; ai < 2; ++ai)
#pragma unroll
          for (int m = 0; m < 4; ++m) {
            const unsigned rl = rl0 + ai * 128 + m * 16;
            f32x4 v0 = acc[ai][bj][m][0], v1 = acc[ai][bj][m][1];
            asm volatile("" : "+v"(v0), "+v"(v1));
            f32x4 o0, o1;
#pragma unroll
            for (int j = 0; j < 4; ++j) { o0[j] = sigmoidf_(v0[j]); o1[j] = sigmoidf_(v1[j]); }
            *(u32x4*)(Sb + rl * 4096u + cb) = pack8v(o0, o1);
            __builtin_amdgcn_sched_barrier(0);
          }
      }
    }
  }
};

struct EpiMerge {
  static constexpr bool PERM = true;
  const u16* S; u16* MG; int pass;
  __device__ __forceinline__ void operator()(const f32x4 (&acc)[2][2][4][2], const pg8::Unit& u, int wr, int wc, int fr, int fq, int lane) const {
    const u16* Sb = S + (size_t)u.pm * 256 * 4096 + pass * 1024;
    u16* MGb = MG + (size_t)u.pm * 256 * 1024;
    unsigned rl0 = wr * 64 + fr; asm volatile("" : "+v"(rl0));
#pragma unroll
    for (int bj = 0; bj < 2; ++bj) {
      const unsigned cb = u.pn * 256 + bj * 128 + wc * 32 + fq * 8;
#pragma unroll
      for (int ai = 0; ai < 2; ++ai)
#pragma unroll
        for (int m = 0; m < 4; ++m) {
          const unsigned rl = rl0 + ai * 128 + m * 16;
          const bf16x8 gt = *(const bf16x8*)(Sb + rl * 4096u + cb);
          f32x4 o0 = acc[ai][bj][m][0], o1 = acc[ai][bj][m][1];
#pragma unroll
          for (int j = 0; j < 4; ++j) { o0[j] *= bf2f((u16)gt[j]); o1[j] *= bf2f((u16)gt[4 + j]); }
          if (pass) {
            const bf16x8 old = *(const bf16x8*)(MGb + rl * 1024u + cb);
#pragma unroll
            for (int j = 0; j < 4; ++j) { o0[j] += bf2f((u16)old[j]); o1[j] += bf2f((u16)old[4 + j]); }
          }
          *(u32x4*)(MGb + rl * 1024u + cb) = pack8v(o0, o1);
            __builtin_amdgcn_sched_barrier(0);
        }
    }
  }
};

struct EpiOut {
  static constexpr bool PERM = false;
  const float* x_lat; const float* x_ctx; float* o_lat; float* o_ctx; const float* mod;
  __device__ __forceinline__ void operator()(const f32x4 (&acc)[2][2][4][2], const pg8::Unit& u, int wr, int wc, int fr, int fq, int lane) const {
    const float* hin; float* hout; int rmod;
    if (u.pm < 128) { hin = x_lat + (size_t)u.pm * 256 * DM; hout = o_lat + (size_t)u.pm * 256 * DM; rmod = u.pm >> 4; }
    else { hin = x_ctx + (size_t)(u.pm - 128) * 256 * DM; hout = o_ctx + (size_t)(u.pm - 128) * 256 * DM; rmod = 8; }
    const float* gate = mod + rmod * 3072 + 2048;
    unsigned rl0 = wr * 64 + fr; asm volatile("" : "+v"(rl0));
#pragma unroll
    for (int bj = 0; bj < 2; ++bj)
#pragma unroll
      for (int n = 0; n < 2; ++n) {
        const unsigned cb = u.pn * 256 + bj * 128 + wc * 32 + n * 16 + fq * 4;
        const float4 g = *(const float4*)(gate + cb);
#pragma unroll
        for (int ai = 0; ai < 2; ++ai)
#pragma unroll
          for (int m = 0; m < 4; ++m) {
            const unsigned o = (rl0 + ai * 128 + m * 16) * 1024u + cb;
            const float4 h = *(const float4*)(hin + o);
            const f32x4 v = acc[ai][bj][m][n];
            *(float4*)(hout + o) = make_float4(h.x + g.x * v[0], h.y + g.y * v[1], h.z + g.z * v[2], h.w + g.w * v[3]);
          }
      }
  }
};

__device__ __forceinline__ void phase_stats(const Params& p, int l) {
  const int tid = opaque_tid(); const int wave = tid >> 6, lane = tid & 63;
  const u16* RG = (const u16*)(p.ws + OFF_RG);
  float* ST = (float*)(p.ws + OFF_STATS);
  const int nrows = (l == 0) ? MTOT : MLAT;
  for (int row = (blockIdx.x * 8 + wave) * 4; row < nrows; row += gridDim.x * 32) {
    bf16x8 v[4][4];
#pragma unroll
    for (int q = 0; q < 4; ++q)
#pragma unroll
      for (int i = 0; i < 4; ++i) v[q][i] = *(const bf16x8*)(RG + (size_t)(row + q) * 2048 + i * 512 + lane * 8);
#pragma unroll
    for (int q = 0; q < 4; ++q)
#pragma unroll
      for (int i = 0; i < 4; ++i) {
        float s1 = 0.f, s2 = 0.f;
#pragma unroll
        for (int x = 0; x < 8; ++x) { float a = bf2f((u16)v[q][i][x]); s1 += a; s2 += a * a; }
#pragma unroll
        for (int o = 16; o > 0; o >>= 1) {
          s1 += __int_as_float(__builtin_amdgcn_ds_bpermute((lane ^ o) << 2, __float_as_int(s1)));
          s2 += __int_as_float(__builtin_amdgcn_ds_bpermute((lane ^ o) << 2, __float_as_int(s2)));
        }
        float sa, sb;
        if ((i >> 1) == 0) { float mu = s1 * (1.f / 256.f); float var = fmaxf(s2 * (1.f / 256.f) - mu * mu, 0.f); sa = rsqrtf(var + 1e-6f); sb = -mu * sa; }
        else { sa = rsqrtf(s2 * (1.f / 256.f) + 1e-6f); sb = 0.f; }
        if ((lane & 31) == 0) *(float2*)(ST + ((size_t)(row + q) * 8 + (i >> 1) * 4 + 2 * (i & 1) + (lane >> 5)) * 2) = make_float2(sa, sb);
      }
  }
}

#define OFF_VECS OFF_WT
__device__ __forceinline__ float logsig16(float x) { return (fminf(x, 0.f) - __logf(1.f + __expf(-fabsf(x)))) * (1.f / 16.f); }

typedef __attribute__((ext_vector_type(2))) float f32x2_t;

template <int SW>
__device__ __forceinline__ void prepass_sweep4(const float* GLRS, const f32x2_t (&w2)[4][16], const f32x2_t (&b2)[4], u16* Sq, u16* Ub,
                                               float (&accF)[4], float (&accB)[4]) {
#pragma unroll
  for (int c = 0; c < 4; ++c) { accF[c] = 0.f; accB[c] = 0.f; }
#pragma unroll 2
  for (int u = 0; u < 32; ++u) {
    const int i = SW ? 32 + u : 31 - u;
    const bf16x4 q4 = *(const bf16x4*)(Sq + (unsigned)i * 4096u);
    const bf16x4 k4 = *(const bf16x4*)(Sq + (unsigned)i * 4096u + 512u);
    const float4* gr = (const float4*)(GLRS + (i & 31) * 16);
    const float4 g0 = gr[0], g1 = gr[1], g2 = gr[2], g3 = gr[3];
    bf16x4 oqf, okf, oqb, okb;
#pragma unroll
    for (int c = 0; c < 4; ++c) {
      f32x2_t x = b2[c];
      x = w2[c][0] * g0.x + x;  x = w2[c][1] * g0.y + x;  x = w2[c][2] * g0.z + x;  x = w2[c][3] * g0.w + x;
      x = w2[c][4] * g1.x + x;  x = w2[c][5] * g1.y + x;  x = w2[c][6] * g1.z + x;  x = w2[c][7] * g1.w + x;
      x = w2[c][8] * g2.x + x;  x = w2[c][9] * g2.y + x;  x = w2[c][10] * g2.z + x; x = w2[c][11] * g2.w + x;
      x = w2[c][12] * g3.x + x; x = w2[c][13] * g3.y + x; x = w2[c][14] * g3.z + x; x = w2[c][15] * g3.w + x;
      const float laf = logsig16(x.x), lab = logsig16(x.y);
      float relf, relb;
      if (SW == 0) { relf = -accF[c]; accF[c] += laf; accB[c] += lab; relb = accB[c]; }
      else         { accF[c] += laf; relf = accF[c]; relb = -accB[c]; accB[c] += lab; }
      const float q = bf2f((u16)q4[c]), k = bf2f((u16)k4[c]);
      oqf[c] = (short)f2bf(q * __expf(relf)); okf[c] = (short)f2bf(k * __expf(-relf));
      oqb[c] = (short)f2bf(q * __expf(relb)); okb[c] = (short)f2bf(k * __expf(-relb));
    }
    *(bf16x4*)(Sq + (unsigned)i * 4096u) = oqf;
    *(bf16x4*)(Sq + (unsigned)i * 4096u + 512u) = okf;
    *(bf16x4*)(Ub + (unsigned)i * 1024u) = oqb;
    *(bf16x4*)(Ub + (unsigned)i * 1024u + 512u) = okb;
  }
}

__device__ __forceinline__ void gla_prepass_unit(const Params& p, int l, int bunit, char* smem) {
  const int tid = opaque_tid();
  const int ul = __builtin_amdgcn_readfirstlane(tid >> 7);
  const int gu = bunit * 4 + ul;
  const int sw = gu & 1, ch = gu >> 1;
  const int b = ch / 68, cid = ch % 68;
  const int base = cid < 4 ? (MLAT + b * 256 + cid * 64) : (b * 4096 + (cid - 4) * 64);
  float* GLRS = (float*)smem + ul * 512;
  const int col0 = (tid & 127) * 4;
  __syncthreads();
  {
    const int uw = (tid >> 6) & 1, lane = tid & 63, fr = lane & 15, fq = lane >> 4;
    f32x4 g = (f32x4){0.f, 0.f, 0.f, 0.f};
    const u16* Ua = (const u16*)(p.ws + OFF_U) + (size_t)(base + sw * 32 + uw * 16 + fr) * 1024 + fq * 8;
    const u16* Wb = (const u16*)(p.ws + OFF_WT) + (size_t)(4096 + fr) * 1024 + fq * 8;
#pragma unroll 16
    for (int k = 0; k < 1024; k += 32) {
      bf16x8 a = *(const bf16x8*)(Ua + k);
      bf16x8 w = *(const bf16x8*)(Wb + k);
      g = __builtin_amdgcn_mfma_f32_16x16x32_bf16(a, w, g, 0, 0, 0);
    }
#pragma unroll
    for (int j = 0; j < 4; ++j) GLRS[(uw * 16 + fq * 4 + j) * 16 + fr] = g[j];
  }
  f32x2_t w2[4][16], b2[4];
  {
    const float* w0 = p.gla_w_up + (size_t)(l * 2 + 0) * 16 * 512 + col0;
    const float* w1 = p.gla_w_up + (size_t)(l * 2 + 1) * 16 * 512 + col0;
#pragma unroll
    for (int r = 0; r < 16; ++r) {
      const float4 a = *(const float4*)(w0 + r * 512), c = *(const float4*)(w1 + r * 512);
      w2[0][r].x = a.x; w2[1][r].x = a.y; w2[2][r].x = a.z; w2[3][r].x = a.w;
      w2[0][r].y = c.x; w2[1][r].y = c.y; w2[2][r].y = c.z; w2[3][r].y = c.w;
    }
    const float4 a = *(const float4*)(p.gla_b_up + (l * 2 + 0) * 512 + col0), c = *(const float4*)(p.gla_b_up + (l * 2 + 1) * 512 + col0);
    b2[0].x = a.x; b2[1].x = a.y; b2[2].x = a.z; b2[3].x = a.w;
    b2[0].y = c.x; b2[1].y = c.y; b2[2].y = c.z; b2[3].y = c.w;
  }
  __syncthreads();
  u16* Sq = (u16*)(p.ws + OFF_S) + (size_t)base * 4096 + 2048 + col0;
  u16* Ub = (l == 0 ? (u16*)p.out : (u16*)(p.ws + OFF_U)) + (size_t)base * 1024 + col0;
  float* V0 = (float*)(p.ws + OFF_VECS) + ((size_t)(0 * 544 + b * 68 + cid) * 2) * 512 + col0;
  float* V1 = (float*)(p.ws + OFF_VECS) + ((size_t)(1 * 544 + b * 68 + cid) * 2) * 512 + col0;
  float accF[4], accB[4];
  if (sw == 0) {
    prepass_sweep4<0>(GLRS, w2, b2, Sq, Ub, accF, accB);
    *(float4*)(V0) = make_float4(__expf(accF[0]), __expf(accF[1]), __expf(accF[2]), __expf(accF[3]));
    *(float4*)(V1 + 512) = make_float4(__expf(accB[0]), __expf(accB[1]), __expf(accB[2]), __expf(accB[3]));
  } else {
    prepass_sweep4<1>(GLRS, w2, b2, Sq, Ub, accF, accB);
    *(float4*)(V0 + 512) = make_float4(__expf(accF[0]), __expf(accF[1]), __expf(accF[2]), __expf(accF[3]));
    *(float4*)(V1) = make_float4(__expf(accB[0]), __expf(accB[1]), __expf(accB[2]), __expf(accB[3]));
  }
}

template <int SW>
__device__ __forceinline__ void prepass_sweep(const float* GLRS, const f32x2_t (&w2)[16], f32x2_t b2, u16* Sq, u16* Ub, float& accF, float& accB) {
  accF = 0.f; accB = 0.f;
#pragma unroll 16
  for (int u = 0; u < 32; ++u) {
    const int i = SW ? 32 + u : 31 - u;
    const float4* gr = (const float4*)(GLRS + i * 16);
    const float4 g0 = gr[0], g1 = gr[1], g2 = gr[2], g3 = gr[3];
    f32x2_t x = b2;
    x = w2[0] * g0.x + x;  x = w2[1] * g0.y + x;  x = w2[2] * g0.z + x;  x = w2[3] * g0.w + x;
    x = w2[4] * g1.x + x;  x = w2[5] * g1.y + x;  x = w2[6] * g1.z + x;  x = w2[7] * g1.w + x;
    x = w2[8] * g2.x + x;  x = w2[9] * g2.y + x;  x = w2[10] * g2.z + x; x = w2[11] * g2.w + x;
    x = w2[12] * g3.x + x; x = w2[13] * g3.y + x; x = w2[14] * g3.z + x; x = w2[15] * g3.w + x;
    const float laf = logsig16(x.x), lab = logsig16(x.y);
    float relf, relb;
    if (SW == 0) { relf = -accF; accF += laf; accB += lab; relb = accB; }
    else         { accF += laf; relf = accF; relb = -accB; accB += lab; }
    const float q = bf2f(Sq[(unsigned)i * 4096u]), k = bf2f(Sq[(unsigned)i * 4096u + 512u]);
    Sq[(unsigned)i * 4096u] = f2bf(q * __expf(relf));
    Sq[(unsigned)i * 4096u + 512u] = f2bf(k * __expf(-relf));
    Ub[(unsigned)i * 1024u] = f2bf(q * __expf(relb));
    Ub[(unsigned)i * 1024u + 512u] = f2bf(k * __expf(-relb));
  }
}

__device__ __forceinline__ void gla_prepass_unit1(const Params& p, int l, int unit, char* smem) {
  const int tid = opaque_tid();
  const int sw = unit & 1, ch = unit >> 1;
  const int b = ch / 68, cid = ch % 68;
  const int base = cid < 4 ? (MLAT + b * 256 + cid * 64) : (b * 4096 + (cid - 4) * 64);
  float* GLRS = (float*)smem;
  __syncthreads();
  {
    const int wid = tid >> 6, lane = tid & 63, fr = lane & 15, fq = lane >> 4;
    if (wid < 2) {
      const int r0 = sw * 32 + wid * 16;
      f32x4 g = (f32x4){0.f, 0.f, 0.f, 0.f};
      const u16* Ua = (const u16*)(p.ws + OFF_U) + (size_t)(base + r0 + fr) * 1024 + fq * 8;
      const u16* Wb = (const u16*)(p.ws + OFF_WT) + (size_t)(4096 + fr) * 1024 + fq * 8;
#pragma unroll 16
      for (int k = 0; k < 1024; k += 32) {
        bf16x8 a = *(const bf16x8*)(Ua + k);
        bf16x8 w = *(const bf16x8*)(Wb + k);
        g = __builtin_amdgcn_mfma_f32_16x16x32_bf16(a, w, g, 0, 0, 0);
      }
#pragma unroll
      for (int j = 0; j < 4; ++j) GLRS[(r0 + fq * 4 + j) * 16 + fr] = g[j];
    }
  }
  f32x2_t w2[16];
  {
    const float* w0 = p.gla_w_up + (size_t)(l * 2 + 0) * 16 * 512 + tid;
    const float* w1 = p.gla_w_up + (size_t)(l * 2 + 1) * 16 * 512 + tid;
#pragma unroll
    for (int r = 0; r < 16; ++r) { w2[r].x = w0[r * 512]; w2[r].y = w1[r * 512]; }
  }
  f32x2_t b2; b2.x = p.gla_b_up[(l * 2 + 0) * 512 + tid]; b2.y = p.gla_b_up[(l * 2 + 1) * 512 + tid];
  __syncthreads();
  u16* Sq = (u16*)(p.ws + OFF_S) + (size_t)base * 4096 + 2048 + tid;
  u16* Ub = (l == 0 ? (u16*)p.out : (u16*)(p.ws + OFF_U)) + (size_t)base * 1024 + tid;
  float* V0 = (float*)(p.ws + OFF_VECS) + ((size_t)(0 * 544 + b * 68 + cid) * 2) * 512 + tid;
  float* V1 = (float*)(p.ws + OFF_VECS) + ((size_t)(1 * 544 + b * 68 + cid) * 2) * 512 + tid;
  float accF, accB;
  if (sw == 0) {
    prepass_sweep<0>(GLRS, w2, b2, Sq, Ub, accF, accB);
    V0[0] = __expf(accF);
    V1[512] = __expf(accB);
  } else {
    prepass_sweep<1>(GLRS, w2, b2, Sq, Ub, accF, accB);
    V0[512] = __expf(accF);
    V1[0] = __expf(accB);
  }
}

#define L_QR   0
#define L_KR   17408
#define L_V    34816
#define L_SGT  44032
#define L_P    61440
#undef  SCAN_GB
#define SCAN_GB 70656

__device__ __forceinline__ int off128(int row, int col) { return row * 272 + col * 2; }
__device__ __forceinline__ int off64(int row, int col) { return row * 144 + col * 2; }

template <int RS>
__device__ __forceinline__ bf16x8 tr_frag(unsigned img_addr, int r0, int c0, int lane) {
  const int g = lane >> 4, q = (lane & 15) >> 2, pp = lane & 3;
  unsigned a = img_addr + (unsigned)((r0 + 8 * g + q) * RS + (c0 + 4 * pp) * 2);
  bf16x4 lo, hi;
  asm volatile("ds_read_b64_tr_b16 %0, %2\n\tds_read_b64_tr_b16 %1, %2 offset:%3\n\ts_waitcnt lgkmcnt(0)"
               : "=&v"(lo), "=&v"(hi) : "v"(a), "n"(4 * RS) : "memory");
  bf16x8 r;
  r[0] = lo[0]; r[1] = lo[1]; r[2] = lo[2]; r[3] = lo[3]; r[4] = hi[0]; r[5] = hi[1]; r[6] = hi[2]; r[7] = hi[3];
  return r;
}

__device__ __forceinline__ bf16x8 scale8(bf16x8 v, float f) {
  bf16x8 o;
#pragma unroll
  for (int x = 0; x < 8; ++x) o[x] = (short)f2bf(bf2f((u16)v[x]) * f);
  return o;
}

__device__ __forceinline__ void lds_barrier() { asm volatile("s_waitcnt lgkmcnt(0)" ::: "memory"); __builtin_amdgcn_s_barrier(); asm volatile("" ::: "memory"); }

template <int branch>
__device__ __forceinline__ void scan_item(const Params& p, int l, int item, char* smem) {
  const int b = (item >> 4) & 7, h = (item >> 2) & 3, slice = item & 3;
  const int tid = opaque_tid(), wid = __builtin_amdgcn_readfirstlane(tid >> 6), lane = tid & 63;
  const int dir = wid >> 2, gw = wid & 3, gt = tid & 255;
  const int fr = lane & 15, fq = lane >> 4;
  char* G = smem + dir * SCAN_GB;
  const unsigned Ga = (unsigned)(size_t)G;
  const u16* S = (const u16*)(p.ws + OFF_S);
  u16* RG = (u16*)(p.ws + OFF_RG);
  const u16* qsrc; unsigned qstride;
  if (branch == 0) { qsrc = S + h * 128; qstride = 4096; }
  else if (dir == 0) { qsrc = S + 2048 + h * 128; qstride = 4096; }
  else { qsrc = (l == 0 ? (const u16*)p.out : (const u16*)(p.ws + OFF_U)) + h * 128; qstride = 1024; }
  const int voff = branch * 2048 + 1024 + h * 256 + slice * 64;
  const int ooff = branch * 1024 + h * 256 + slice * 64;
  float lg = 0.f, egc = 1.f;
  if (branch == 0) { lg = __logf(1.f - __expf(p.ret_decay[(l * 2 + dir) * 4 + h])); egc = __expf(32.f * lg); }
  const float* VECS = (const float*)(p.ws + OFF_VECS) + ((size_t)(dir * 544 + b * 68) * 2) * 512 + h * 128;
  f32x4 st[2][4];
#pragma unroll
  for (int m = 0; m < 2; ++m)
#pragma unroll
    for (int n = 0; n < 4; ++n) st[m][n] = (f32x4){0.f, 0.f, 0.f, 0.f};

  const int qj = gt >> 4, qc = gt & 15;
  const int vj = gt >> 3, vc = gt & 7;
  bf16x8 pq[4], pk[4], pv[2];
  float4 peg[2], pel[2];
  auto prefetch = [&](int s) {
    int base, cid;
    if (s < 4) { int cc = dir ? 3 - s : s; base = MLAT + b * 256 + cc * 64; cid = cc; }
    else { int c = s - 4; int cc = dir ? 63 - c : c; base = b * 4096 + cc * 64; cid = 4 + cc; }
#pragma unroll
    for (int i = 0; i < 4; ++i) {
      int jp = qj + 16 * i;
      unsigned ro = (unsigned)(base + (dir ? 63 - jp : jp)) * qstride + qc * 8;
      pq[i] = *(const bf16x8*)(qsrc + ro);
      pk[i] = *(const bf16x8*)(qsrc + ro + 512);
    }
#pragma unroll
    for (int i = 0; i < 2; ++i) {
      int jp = vj + 32 * i;
      pv[i] = *(const bf16x8*)(S + (size_t)(base + (dir ? 63 - jp : jp)) * 4096 + voff + vc * 8);
    }
    if (branch == 1) {
#pragma unroll
      for (int m = 0; m < 2; ++m) {
        int d0 = gw * 32 + m * 16 + fq * 4;
        peg[m] = *(const float4*)(VECS + (size_t)cid * 1024 + d0);
        pel[m] = *(const float4*)(VECS + (size_t)cid * 1024 + 512 + d0);
      }
    }
  };
  prefetch(0);
  __syncthreads();

  for (int s = 0; s < 68; ++s) {
    int base; bool first; bool wout;
    if (s < 4) { int cc = dir ? 3 - s : s; base = MLAT + b * 256 + cc * 64; first = s < 2; wout = (l == 0); }
    else { int c = s - 4; int cc = dir ? 63 - c : c; base = b * 4096 + cc * 64; first = c < 32; wout = true; }
    float4 eg[2], el[2];
#pragma unroll
    for (int m = 0; m < 2; ++m) {
      if (branch == 1) { eg[m] = peg[m]; el[m] = pel[m]; }
      else { eg[m] = make_float4(egc, egc, egc, egc); el[m] = eg[m]; }
    }
#pragma unroll
    for (int i = 0; i < 4; ++i) {
      int jp = qj + 16 * i;
      bf16x8 qv = pq[i], kv_ = pk[i];
      if (branch == 0) {
        float fqs = __expf((float)(jp - 31) * lg), fks = __expf((float)(31 - jp) * lg);
        qv = scale8(qv, fqs); kv_ = scale8(kv_, fks);
      }
      *(bf16x8*)(G + L_QR + off128(jp, qc * 8)) = qv;
      *(bf16x8*)(G + L_KR + off128(jp, qc * 8)) = kv_;
    }
#pragma unroll
    for (int i = 0; i < 2; ++i) *(bf16x8*)(G + L_V + off64(vj + 32 * i, vc * 8)) = pv[i];
#pragma unroll
    for (int m = 0; m < 2; ++m) {
      int d0 = gw * 32 + m * 16 + fq * 4;
#pragma unroll
      for (int n = 0; n < 4; ++n) {
        int e = n * 16 + fr;
        bf16x4 o4;
        o4[0] = (short)f2bf(st[m][n][0] * eg[m].x); o4[1] = (short)f2bf(st[m][n][1] * eg[m].y);
        o4[2] = (short)f2bf(st[m][n][2] * eg[m].z); o4[3] = (short)f2bf(st[m][n][3] * eg[m].w);
        *(bf16x4*)(G + L_SGT + off128(e, d0)) = o4;
      }
    }
    u16 oldv[4][4];
    u16* dstb = RG + (size_t)base * 2048 + ooff + fr;
    if (wout && !first) {
#pragma unroll
      for (int r = 0; r < 4; ++r) {
        int ip = gw * 16 + fq * 4 + r;
        unsigned ro = (unsigned)(dir ? 63 - ip : ip) * 2048u;
#pragma unroll
        for (int n = 0; n < 4; ++n) oldv[r][n] = dstb[ro + n * 16];
      }
    }
    if (s + 1 < 68) prefetch(s + 1);
    lds_barrier();
    f32x4 pt[4], o[4];
#pragma unroll
    for (int n = 0; n < 4; ++n) { pt[n] = (f32x4){0.f, 0.f, 0.f, 0.f}; o[n] = (f32x4){0.f, 0.f, 0.f, 0.f}; }
#pragma unroll
    for (int ks = 0; ks < 4; ++ks) {
      int kc = ks * 32 + fq * 8;
      bf16x8 qa = *(const bf16x8*)(G + L_QR + off128(gw * 16 + fr, kc));
#pragma unroll
      for (int n = 0; n < 4; ++n) {
        bf16x8 ka = *(const bf16x8*)(G + L_KR + off128(n * 16 + fr, kc));
        bf16x8 sb = *(const bf16x8*)(G + L_SGT + off128(n * 16 + fr, kc));
        pt[n] = __builtin_amdgcn_mfma_f32_16x16x32_bf16(ka, qa, pt[n], 0, 0, 0);
        o[n] = __builtin_amdgcn_mfma_f32_16x16x32_bf16(qa, sb, o[n], 0, 0, 0);
      }
    }
    {
      const int ip = gw * 16 + fr;
#pragma unroll
      for (int n = 0; n < 4; ++n) {
        const int j0 = n * 16 + fq * 4;
        bf16x4 w;
#pragma unroll
        for (int r = 0; r < 4; ++r) {
          int jp = j0 + r;
          bool keep = dir ? (ip > jp) : (ip >= jp);
          w[r] = (short)f2bf(keep ? pt[n][r] : 0.f);
        }
        *(bf16x4*)(G + L_P + off64(ip, j0)) = w;
      }
    }
    asm volatile("s_waitcnt lgkmcnt(0)" ::: "memory");
    {
      const int tg = lane >> 4, tq = (lane & 15) >> 2, tp = lane & 3;
      const unsigned ka0 = Ga + L_KR + (unsigned)((8 * tg + tq) * 272 + (gw * 32 + 4 * tp) * 2);
      const unsigned va0 = Ga + L_V + (unsigned)((8 * tg + tq) * 144 + (4 * tp) * 2);
#pragma unroll
      for (int m = 0; m < 2; ++m) {
        f32x4 kv[4];
#pragma unroll
        for (int n = 0; n < 4; ++n) kv[n] = (f32x4){0.f, 0.f, 0.f, 0.f};
#pragma unroll
        for (int ks = 0; ks < 2; ++ks) {
          int kc = ks * 32 + fq * 8;
          bf16x4 r0, r1, r2, r3, r4, r5, r6, r7, r8, r9;
          asm volatile(
              "ds_read_b64_tr_b16 %0, %10\n\tds_read_b64_tr_b16 %1, %10 offset:1088\n\t"
              "ds_read_b64_tr_b16 %2, %11\n\tds_read_b64_tr_b16 %3, %11 offset:576\n\t"
              "ds_read_b64_tr_b16 %4, %11 offset:32\n\tds_read_b64_tr_b16 %5, %11 offset:608\n\t"
              "ds_read_b64_tr_b16 %6, %11 offset:64\n\tds_read_b64_tr_b16 %7, %11 offset:640\n\t"
              "ds_read_b64_tr_b16 %8, %11 offset:96\n\tds_read_b64_tr_b16 %9, %11 offset:672\n\t"
              "s_waitcnt lgkmcnt(0)"
              : "=&v"(r0), "=&v"(r1), "=&v"(r2), "=&v"(r3), "=&v"(r4), "=&v"(r5), "=&v"(r6), "=&v"(r7), "=&v"(r8), "=&v"(r9)
              : "v"(ka0 + (unsigned)(ks * 32 * 272 + m * 32)), "v"(va0 + (unsigned)(ks * 32 * 144))
              : "memory");
          bf16x8 km = __builtin_shufflevector(r0, r1, 0, 1, 2, 3, 4, 5, 6, 7);
          bf16x8 vb[4];
          vb[0] = __builtin_shufflevector(r2, r3, 0, 1, 2, 3, 4, 5, 6, 7);
          vb[1] = __builtin_shufflevector(r4, r5, 0, 1, 2, 3, 4, 5, 6, 7);
          vb[2] = __builtin_shufflevector(r6, r7, 0, 1, 2, 3, 4, 5, 6, 7);
          vb[3] = __builtin_shufflevector(r8, r9, 0, 1, 2, 3, 4, 5, 6, 7);
          bf16x8 pa;
          if (m == 0) pa = *(const bf16x8*)(G + L_P + off64(gw * 16 + fr, kc));
#pragma unroll
          for (int n = 0; n < 4; ++n) {
            if (m == 0) o[n] = __builtin_amdgcn_mfma_f32_16x16x32_bf16(pa, vb[n], o[n], 0, 0, 0);
            kv[n] = __builtin_amdgcn_mfma_f32_16x16x32_bf16(km, vb[n], kv[n], 0, 0, 0);
          }
        }
#pragma unroll
        for (int n = 0; n < 4; ++n) {
          st[m][n][0] = eg[m].x * el[m].x * st[m][n][0] + el[m].x * kv[n][0];
          st[m][n][1] = eg[m].y * el[m].y * st[m][n][1] + el[m].y * kv[n][1];
          st[m][n][2] = eg[m].z * el[m].z * st[m][n][2] + el[m].z * kv[n][2];
          st[m][n][3] = eg[m].w * el[m].w * st[m][n][3] + el[m].w * kv[n][3];
        }
      }
    }
    if (wout) {
#pragma unroll
      for (int r = 0; r < 4; ++r) {
        int ip = gw * 16 + fq * 4 + r;
        unsigned ro = (unsigned)(dir ? 63 - ip : ip) * 2048u;
#pragma unroll
        for (int n = 0; n < 4; ++n) {
          float v = o[n][r];
          if (!first) v += bf2f(oldv[r][n]);
          dstb[ro + n * 16] = f2bf(v);
        }
      }
    }
    __syncthreads();
  }
}

#define NPHASE 18
__device__ __forceinline__ void run_phase(const Params& p, int ph, char* smem) {
  const int nblk = gridDim.x, bid = blockIdx.x;
  if (ph == 0) {
#ifdef REP_P0
    for (int rep = 0; rep < REP_P0; ++rep)
#endif
    for (int u = bid; u < WT_UNITS + 96 + 1; u += nblk) {
      if (u < 96) mod_unit(p, u, smem);
      else if (u == 96) rot_unit(p);
      else wt_unit(p, 0, u - 97, smem);
    }
    return;
  }
  if (ph == NPHASE - 1) { phase_final(p); return; }
  const int l = (ph - 1) / 8, sp = (ph - 1) % 8;
  PG8_LAS unsigned char* lds = (PG8_LAS unsigned char*)smem;
  switch (sp) {
    case 0:
      phase_u(p, l);
      if (l == 1) for (int u = bid; u < WT_UNITS; u += nblk) wt_unit(p, 1, u, smem);
      break;
    case 1: {
      pg8::Gemm g{(const u16*)(p.ws + OFF_U), (const u16*)(p.ws + OFF_WT) + (size_t)WT_SCAN * 1024, 1024, MTOT, 4096, 1024};
      pg8::StaticOrder S; S.init(g.M, g.N, nblk, bid);
      EpiScanIn E{(u16*)(p.ws + OFF_S), (const float*)(p.ws + OFF_ROT)};
      pg8::gemm_phase(lds, g, S, E, opaque_tid());
    } break;
    case 2:
      for (int t = bid; t < 256; t += nblk) gla_prepass_unit(p, l, t, smem);
      for (int t = 1024 + (bid + 96) % nblk; t < 1088; t += nblk) gla_prepass_unit1(p, l, t, smem);
      break;
    case 3:
#ifdef REP_SCAN
      for (int rep = 0; rep < REP_SCAN; ++rep)
#endif
      for (int t = bid; t < 256; t += nblk) { if (t < 128) scan_item<0>(p, l, t, smem); else scan_item<1>(p, l, t, smem); } break;
    case 4:
      if (l != 0) phase_u(p, l);
      phase_stats(p, l);
      break;
    case 5: {
      pg8::Gemm g{(const u16*)(p.ws + OFF_U), (const u16*)(p.ws + OFF_WT) + (size_t)WT_GATE * 1024, 1024, l == 0 ? MTOT : MLAT, 4096, 1024};
      pg8::StaticOrder S; S.init(g.M, g.N, nblk, bid);
      EpiGate E{(const u16*)(p.ws + OFF_RG), (const float*)(p.ws + OFF_STATS), (u16*)(p.ws + OFF_S), p.ret_norm_gain + l * 1024, p.gla_norm_gain + l * 1024};
      pg8::gemm_phase(lds, g, S, E, opaque_tid());
    } break;
    case 6: {
#pragma unroll 1
      for (int pass = 0; pass < 2; ++pass) {
        pg8::Gemm g{(const u16*)(p.ws + OFF_S) + 2048 + pass * 1024, (const u16*)(p.ws + OFF_WT) + (size_t)(WT_BRR + pass * 1024) * 1024, 4096, l == 0 ? MTOT : MLAT, 1024, 1024};
        pg8::StaticOrder S; S.init(g.M, g.N, nblk, bid);
        EpiMerge E{(const u16*)(p.ws + OFF_S), (u16*)(p.ws + OFF_U), pass};
        pg8::gemm_phase(lds, g, S, E, opaque_tid());
      }
    } break;
    case 7: {
      pg8::Gemm g{(const u16*)(p.ws + OFF_U), (const u16*)(p.ws + OFF_WT) + (size_t)WT_OUT * 1024, 1024, l == 0 ? MTOT : MLAT, 1024, 1024};
      pg8::StaticOrder S; S.init(g.M, g.N, nblk, bid);
      EpiOut E{l == 0 ? p.x : p.out, p.ctx, p.out, (float*)(p.ws + OFF_HCTX), (const float*)(p.ws + OFF_MOD) + (size_t)l * 9 * 3072};
      pg8::gemm_phase(lds, g, S, E, opaque_tid());
    } break;
  }
}

__device__ __forceinline__ void grid_barrier(unsigned* cnt, unsigned target) {
  asm volatile("s_waitcnt vmcnt(0)" ::: "memory");
  __syncthreads();
  if (threadIdx.x == 0) {
    __threadfence();
    __hip_atomic_fetch_add(cnt, 1u, __ATOMIC_RELAXED, __HIP_MEMORY_SCOPE_AGENT);
    while (__hip_atomic_load(cnt, __ATOMIC_RELAXED, __HIP_MEMORY_SCOPE_AGENT) < target) __builtin_amdgcn_s_sleep(2);
    __threadfence();
  }
  __syncthreads();
}

__global__ void __launch_bounds__(NTHREADS) mega(Params p, int ph_lo, int ph_hi, int coop) {
  extern __shared__ __attribute__((aligned(16))) char smem[];
  for (int ph = ph_lo; ph < ph_hi; ++ph) {
    run_phase(p, ph, smem);
    if (coop && ph + 1 < ph_hi) {
      if (ph == ph_lo) cg::this_grid().sync();
      else grid_barrier((unsigned*)(p.ws + OFF_BAR), (unsigned)(ph - ph_lo) * gridDim.x);
    }
  }
}

extern "C" void kernel_launch(void* const* d_in, const int* in_sizes, int n_in,
                              void* d_out, int out_size, void* d_ws, size_t ws_size,
                              hipStream_t stream) {
  Params p{};
  p.x = (const float*)d_in[0]; p.c = (const float*)d_in[1]; p.ctx = (const float*)d_in[2]; p.c_ctx = (const float*)d_in[3];
  p.norm_gain = (const float*)d_in[4]; p.w_ada = (const float*)d_in[5]; p.b_ada = (const float*)d_in[6]; p.w_in = (const float*)d_in[7];
  p.ret_decay = (const float*)d_in[8]; p.gla_w_up = (const float*)d_in[9]; p.gla_b_up = (const float*)d_in[10];
  p.ret_norm_gain = (const float*)d_in[11]; p.gla_norm_gain = (const float*)d_in[12];
  p.w_br_ret = (const float*)d_in[13]; p.w_br_gla = (const float*)d_in[14]; p.w_out = (const float*)d_in[15]; p.final_gain = (const float*)d_in[16];
  p.out = (float*)d_out; p.ws = (char*)d_ws;
  static int grid_blocks = 0;
  if (!grid_blocks) {
    hipFuncSetAttribute((const void*)mega, hipFuncAttributeMaxDynamicSharedMemorySize, LDS_BYTES);
    int dev = 0, cus = 0, per_cu = 0;
    hipGetDevice(&dev);
    hipDeviceGetAttribute(&cus, hipDeviceAttributeMultiprocessorCount, dev);
    hipOccupancyMaxActiveBlocksPerMultiprocessor(&per_cu, mega, NTHREADS, LDS_BYTES);
    if (per_cu < 1) per_cu = 1;
    grid_blocks = cus * 1;
  }
#ifdef MULTI_LAUNCH
  for (int ph = 0; ph < NPHASE; ++ph) {
    mega<<<dim3(grid_blocks), dim3(NTHREADS), LDS_BYTES, stream>>>(p, ph, ph + 1, 0);
  }
#else
  hipMemsetAsync((char*)d_ws + OFF_BAR, 0, 256, stream);
  int lo = 0, hi = NPHASE, coop = 1;
  void* args[] = {&p, &lo, &hi, &coop};
  hipError_t e = hipLaunchCooperativeKernel((void*)mega, dim3(grid_blocks), dim3(NTHREADS), args, LDS_BYTES, stream);
  if (e != hipSuccess) fprintf(stderr, "cooperative launch failed: %s (grid %d)\n", hipGetErrorString(e), grid_blocks);
#endif
}
```

```cpp
#include <hip/hip_runtime.h>
#include <hip/hip_cooperative_groups.h>
#include <cstdio>
namespace cg = cooperative_groups;

typedef unsigned short u16;
using bf16x8 = __attribute__((ext_vector_type(8))) short;
using bf16x4 = __attribute__((ext_vector_type(4))) short;
using f32x4  = __attribute__((ext_vector_type(4))) float;

#define NTHREADS 512
#define DM 1024
#define NB 8
#define SEQL 4096
#define CTXL 256
#define MLAT 32768
#define MCTX 2048
#define MTOT 34816
#define INW 8208

#define OFF_S    0ull
#define OFF_RG   (OFF_S   + (size_t)MTOT * 4096 * 2)
#define OFF_U    (OFF_RG  + (size_t)MTOT * 2048 * 2)
#define OFF_WT   (OFF_U   + (size_t)MTOT * 1024 * 2)
#define WT_ROWS  11392
#define OFF_GLR  (OFF_WT  + (size_t)WT_ROWS * 1024 * 2)
#define OFF_HCTX (OFF_GLR + (size_t)MTOT * 16 * 4)
#define OFF_MOD  (OFF_HCTX+ (size_t)MCTX * 1024 * 4)
#define OFF_ROT  (OFF_MOD + (size_t)2 * 9 * 3072 * 4)
#define OFF_BAR  (OFF_ROT + (size_t)64 * 32 * 2 * 4)
#define OFF_END  (OFF_BAR + 256)

#define WT_SCAN 0
#define WT_GATE 4224
#define WT_BRR  8320
#define WT_BRG  9344
#define WT_OUT  10368

#define LDS_BYTES 161792
#define SCAN_GB   80896

struct Params {
  const float* x; const float* c; const float* ctx; const float* c_ctx;
  const float* norm_gain; const float* w_ada; const float* b_ada; const float* w_in;
  const float* ret_decay; const float* gla_w_up; const float* gla_b_up;
  const float* ret_norm_gain; const float* gla_norm_gain;
  const float* w_br_ret; const float* w_br_gla; const float* w_out; const float* final_gain;
  float* out; char* ws;
};

__device__ __forceinline__ u16 f2bf(float f) {
  __bf16 h = (__bf16)f;
  return *(u16*)&h;
}
__device__ __forceinline__ float bf2f(u16 h) { return __uint_as_float(((unsigned)h) << 16); }
__device__ __forceinline__ float sigmoidf_(float x) { return __builtin_amdgcn_rcpf(1.f + __expf(-x)); }
__device__ __forceinline__ float siluf_(float x) { return x * __builtin_amdgcn_rcpf(1.f + __expf(-x)); }

__device__ __forceinline__ int opaque_tid() { int t = threadIdx.x; asm volatile("" : "+v"(t)); return t; }

__device__ __forceinline__ float wave_sum(float v) {
#pragma unroll
  for (int o = 32; o > 0; o >>= 1) v += __shfl_xor(v, o, 64);
  return v;
}

__device__ __forceinline__ const float* wt_src(const Params& p, int l, int n, int& ld) {
  if (n < WT_GATE) {
    int tile = n >> 7, cc = n & 127;
    int col;
    if (tile < 8) {
      int d = (cc & 64) | ((cc & 16) << 1) | ((cc & 32) >> 1) | (cc & 15);
      col = tile * 128 + d;
    } else if (tile < 16) col = 1024 + (tile - 8) * 128 + cc;
    else if (tile < 24) col = 3072 + (tile - 16) * 128 + cc;
    else if (tile < 32) col = 4096 + (tile - 24) * 128 + cc;
    else { if (cc >= 16) { ld = 0; return nullptr; } col = 6144 + cc; }
    ld = INW; return p.w_in + (size_t)l * DM * INW + col;
  } else if (n < WT_BRR) {
    int g = n - WT_GATE; int col;
    if (g < 1024) col = 2048 + g;
    else if (g < 2048) col = 5120 + (g - 1024);
    else if (g < 3072) col = 6160 + (g - 2048);
    else col = 7184 + (g - 3072);
    ld = INW; return p.w_in + (size_t)l * DM * INW + col;
  } else if (n < WT_BRG) { ld = DM; return p.w_br_ret + (size_t)l * DM * DM + (n - WT_BRR); }
  else if (n < WT_OUT)   { ld = DM; return p.w_br_gla + (size_t)l * DM * DM + (n - WT_BRG); }
  else                   { ld = DM; return p.w_out    + (size_t)l * DM * DM + (n - WT_OUT); }
}

#define WT_UNITS (178 * 4)
__device__ __forceinline__ void wt_unit(const Params& p, int l, int unit, char* smem) {
  float* tile = (float*)smem;
  int nb = unit >> 2, kg = unit & 3;
  int tid = opaque_tid();
  int n0 = nb * 64, kbase = kg * 256;
  float v[4][8];
  {
    int nl = tid & 63, kq = tid >> 6;
    int ld; const float* src = wt_src(p, l, n0 + nl, ld);
#pragma unroll
    for (int q = 0; q < 4; ++q)
#pragma unroll
      for (int i = 0; i < 8; ++i) v[q][i] = src ? src[(size_t)(kbase + q * 64 + kq + 8 * i) * ld] : 0.f;
  }
  u16* wt = (u16*)(p.ws + OFF_WT);
#pragma unroll
  for (int q = 0; q < 4; ++q) {
    __syncthreads();
    {
      int nl = tid & 63, kq = tid >> 6;
#pragma unroll
      for (int i = 0; i < 8; ++i) tile[(kq + 8 * i) * 65 + nl] = v[q][i];
    }
    __syncthreads();
    {
      int nl = tid >> 3, kq = tid & 7;
      bf16x8 o;
#pragma unroll
      for (int j = 0; j < 8; ++j) o[j] = (short)f2bf(tile[(kq * 8 + j) * 65 + nl]);
      *(bf16x8*)(wt + (size_t)(n0 + nl) * 1024 + kbase + q * 64 + kq * 8) = o;
    }
  }
  __syncthreads();
}

__device__ __forceinline__ void mod_unit(const Params& p, int unit, char* smem) {
  float* sc = (float*)smem;
  float* red = sc + 9 * 1024;
  int l = unit / 48, jb = unit % 48;
  int tid = opaque_tid();
  for (int i = tid; i < 9 * 1024; i += NTHREADS) {
    int r = i >> 10, k = i & 1023;
    float v = (r < 8) ? p.c[r * 1024 + k] : p.c_ctx[k];
    sc[i] = siluf_(v);
  }
  __syncthreads();
  int jl = tid & 63, kg = tid >> 6;
  int j = jb * 64 + jl;
  float acc[9];
#pragma unroll
  for (int r = 0; r < 9; ++r) acc[r] = 0.f;
  const float* w = p.w_ada + (size_t)l * DM * 3072 + j;
#pragma unroll 16
  for (int k = kg * 128; k < kg * 128 + 128; ++k) {
    float wv = w[(size_t)k * 3072];
#pragma unroll
    for (int r = 0; r < 9; ++r) acc[r] += sc[r * 1024 + k] * wv;
  }
#pragma unroll
  for (int r = 0; r < 9; ++r) red[(kg * 9 + r) * 64 + jl] = acc[r];
  __syncthreads();
  float* mod = (float*)(p.ws + OFF_MOD);
  for (int i = tid; i < 9 * 64; i += NTHREADS) {
    int r = i >> 6, jj = i & 63;
    float s = 0.f;
#pragma unroll
    for (int g = 0; g < 8; ++g) s += red[(g * 9 + r) * 64 + jj];
    mod[((size_t)l * 9 + r) * 3072 + jb * 64 + jj] = s + p.b_ada[l * 3072 + jb * 64 + jj];
  }
  __syncthreads();
}

__device__ __forceinline__ void rot_unit(const Params& p) {
  float* rot = (float*)(p.ws + OFF_ROT);
  for (int i = opaque_tid(); i < 64 * 32; i += NTHREADS) {
    int pos = i >> 5, f = i & 31;
    float inv = exp2f(-(float)f * (13.287712379549449f / 32.f));
    float ang = (float)pos * inv;
    rot[i * 2] = __cosf(ang);
    rot[i * 2 + 1] = __sinf(ang);
  }
}

__device__ __forceinline__ void phase_u(const Params& p, int l) {
  const int tid = opaque_tid(); int wave = tid >> 6, lane = tid & 63;
  const float* mod = (const float*)(p.ws + OFF_MOD) + (size_t)l * 9 * 3072;
  const float* gain = p.norm_gain + l * DM;
  u16* U = (u16*)(p.ws + OFF_U);
  for (int row = (blockIdx.x * 8 + wave) * 4; row < MTOT; row += gridDim.x * 32) {
    const float* h; int r;
    if (row < MLAT) { h = (l == 0 ? p.x : p.out) + (size_t)row * DM; r = row >> 12; }
    else { int cr = row - MLAT; h = (l == 0 ? p.ctx : (const float*)(p.ws + OFF_HCTX)) + (size_t)cr * DM; r = 8; }
    float4 v[4][4]; float ss[4];
#pragma unroll
    for (int q = 0; q < 4; ++q) {
      ss[q] = 0.f;
#pragma unroll
      for (int i = 0; i < 4; ++i) v[q][i] = *(const float4*)(h + q * DM + i * 256 + lane * 4);
    }
#pragma unroll
    for (int q = 0; q < 4; ++q) {
#pragma unroll
      for (int i = 0; i < 4; ++i) ss[q] += v[q][i].x * v[q][i].x + v[q][i].y * v[q][i].y + v[q][i].z * v[q][i].z + v[q][i].w * v[q][i].w;
      ss[q] = rsqrtf(wave_sum(ss[q]) * (1.f / 1024.f) + 1e-6f);
    }
    const float* sh = mod + r * 3072;
#pragma unroll
    for (int i = 0; i < 4; ++i) {
      int cidx = i * 256 + lane * 4;
      float4 g = *(const float4*)(gain + cidx);
      float4 s = *(const float4*)(sh + cidx);
      float4 sc = *(const float4*)(sh + 1024 + cidx);
      g.x *= (1.f + sc.x); g.y *= (1.f + sc.y); g.z *= (1.f + sc.z); g.w *= (1.f + sc.w);
#pragma unroll
      for (int q = 0; q < 4; ++q) {
        bf16x4 o;
        o[0] = (short)f2bf(v[q][i].x * ss[q] * g.x + s.x);
        o[1] = (short)f2bf(v[q][i].y * ss[q] * g.y + s.y);
        o[2] = (short)f2bf(v[q][i].z * ss[q] * g.z + s.z);
        o[3] = (short)f2bf(v[q][i].w * ss[q] * g.w + s.w);
        *(bf16x4*)(U + (size_t)(row + q) * DM + cidx) = o;
      }
    }
  }
}

__device__ __forceinline__ void phase_final(const Params& p) {
  const int tid = opaque_tid(); int wave = tid >> 6, lane = tid & 63;
  for (int row = (blockIdx.x * 8 + wave) * 4; row < MLAT; row += gridDim.x * 32) {
    float* h = p.out + (size_t)row * DM;
    float4 v[4][4]; float ss[4];
#pragma unroll
    for (int q = 0; q < 4; ++q) {
      ss[q] = 0.f;
#pragma unroll
      for (int i = 0; i < 4; ++i) v[q][i] = *(const float4*)(h + q * DM + i * 256 + lane * 4);
    }
#pragma unroll
    for (int q = 0; q < 4; ++q) {
#pragma unroll
      for (int i = 0; i < 4; ++i) ss[q] += v[q][i].x * v[q][i].x + v[q][i].y * v[q][i].y + v[q][i].z * v[q][i].z + v[q][i].w * v[q][i].w;
      ss[q] = rsqrtf(wave_sum(ss[q]) * (1.f / 1024.f) + 1e-6f);
    }
#pragma unroll
    for (int i = 0; i < 4; ++i) {
      int cidx = i * 256 + lane * 4;
      float4 g = *(const float4*)(p.final_gain + cidx);
#pragma unroll
      for (int q = 0; q < 4; ++q) {
        float4 o;
        o.x = v[q][i].x * ss[q] * g.x; o.y = v[q][i].y * ss[q] * g.y; o.z = v[q][i].z * ss[q] * g.z; o.w = v[q][i].w * ss[q] * g.w;
        *(float4*)(h + q * DM + cidx) = o;
      }
    }
  }
}

#define PG8_LAS __attribute__((address_space(3)))
typedef unsigned u32x4 __attribute__((ext_vector_type(4)));
namespace pg8 {
constexpr int BM = 256, BK = 64, HALF = 128, HTB = HALF * BK * 2, STAGE_BYTES = 8 * HTB, NXCD = 8, WGM = 8;
__device__ __forceinline__ int lds_byte(int r, int c) { const int st = (r >> 4) * 2 + (c >> 5), rr = r & 15, cc = c & 31, ob = rr * 64 + cc * 2; return st * 1024 + (ob ^ (((ob >> 9) & 1) << 5)); }
__device__ __forceinline__ void stage_rc(int b, int& R, int& C) { const int st = b / 1024, sb = b % 1024, swz = sb ^ (((sb >> 9) & 1) << 5); R = (st >> 1) * 16 + swz / 64; C = (st & 1) * 32 + (swz % 64) / 2; }
__device__ __forceinline__ int perm32(int rho) { const int n = rho >> 4, i = rho & 15; return 8 * (i >> 2) + 4 * n + (i & 3); }
struct Unit { int pm, pn; };
struct Gemm { const u16* A; const u16* Bt; int lda; int M, N, K; };
struct StaticOrder {
  int nM, nN, nwg, G, c;
  __device__ void init(int M, int N, int G_, int c_) { nM = M / BM; nN = N / BM; nwg = nM * nN; G = G_; c = c_; }
  __device__ bool next(int i, Unit& u) const {
    const long L = (long)i * G + c; if (L >= nwg) return false;
    int wgid = (int)L; { const int q = nwg / NXCD, r = nwg % NXCD, xcd = wgid % NXCD, off = wgid / NXCD; wgid = (xcd < r ? xcd * (q + 1) : r * (q + 1) + (xcd - r) * q) + off; }
    const int nig = WGM * nN, gid = wgid / nig, fm = gid * WGM, gsz = (nM - fm) < WGM ? (nM - fm) : WGM;
    u.pm = fm + ((wgid % nig) % gsz); u.pn = (wgid % nig) / gsz; return true;
  }
};
typedef __attribute__((ext_vector_type(2))) float cvt_f2_t;
typedef __attribute__((ext_vector_type(2))) __bf16 cvt_b2_t;
__device__ __forceinline__ unsigned cvt_pk_bf16(float lo, float hi) { cvt_f2_t f = {lo, hi}; cvt_b2_t r = __builtin_convertvector(f, cvt_b2_t); return __builtin_bit_cast(unsigned, r); }

template <class Epi>
__device__ __forceinline__ void gemm_phase(PG8_LAS unsigned char* lds, const Gemm g, const StaticOrder& S, const Epi& E, const int tid) {
  const int wid = __builtin_amdgcn_readfirstlane(tid >> 6), lane = tid & 63, wr = wid >> 2, wc = wid & 3, fr = lane & 15, fq = lane >> 4;
  const int K = g.K, nt = K / BK;
  unsigned voffA[2], voffB[2];
#pragma unroll
  for (int i = 0; i < 2; ++i) { int R, C; stage_rc(tid * 16 + i * 8192, R, C); const int Rb = Epi::PERM ? ((R & ~31) + perm32(R & 31)) : R;
    voffA[i] = (unsigned)(R * g.lda + C) * 2u; voffB[i] = (unsigned)(Rb * K + C) * 2u; }
  const size_t kstep = (size_t)(BK * 2);
  const size_t hstepA = (size_t)HALF * g.lda * 2, hstepB = (size_t)HALF * K * 2;
  const size_t tstepA = 2 * hstepA, tstepB = 2 * hstepB;
  const unsigned ldsw = (unsigned)wid * 1024u;
  const int aoff = lds_byte(wr * 64 + fr, fq * 8), boff = lds_byte(wc * 32 + fr, fq * 8);
#define PG8_SA(b, h) (((b) * 2 + (h)) * HTB)
#define PG8_SB(b, h) ((4 + (b) * 2 + (h)) * HTB)
#define PG8_STAGE(bufoff, gbase, voff) do { _Pragma("unroll") for (int _i = 0; _i < 2; ++_i) \
    __builtin_amdgcn_global_load_lds((const unsigned*)((const char*)(gbase) + (voff)[_i]), (PG8_LAS unsigned*)(lds + (bufoff) + ldsw + _i * 8192), 16, 0, 0); } while (0)
#define PG8_LDA(dst, b, h) do { _Pragma("unroll") for (int m = 0; m < 4; ++m) _Pragma("unroll") for (int k = 0; k < 2; ++k) dst[m][k] = *(const PG8_LAS bf16x8*)(lds + PG8_SA(b, h) + aoff + m * 2048 + k * 1024); } while (0)
#define PG8_LDB(dst, b, h) do { _Pragma("unroll") for (int n = 0; n < 2; ++n) _Pragma("unroll") for (int k = 0; k < 2; ++k) dst[n][k] = *(const PG8_LAS bf16x8*)(lds + PG8_SB(b, h) + boff + n * 2048 + k * 1024); } while (0)
#define PG8_MMA(ai, bj, At, Bt) do { __builtin_amdgcn_s_setprio(1); _Pragma("unroll") for (int m = 0; m < 4; ++m) _Pragma("unroll") for (int n = 0; n < 2; ++n) _Pragma("unroll") for (int k = 0; k < 2; ++k) \
    acc[ai][bj][m][n] = __builtin_amdgcn_mfma_f32_16x16x32_bf16(Bt[n][k], At[m][k], acc[ai][bj][m][n], 0, 0, 0); __builtin_amdgcn_s_setprio(0); } while (0)
#define PG8_WAIT_V(n) asm volatile("s_waitcnt vmcnt(" #n ")" ::: "memory")
#define PG8_WAIT_L(n) asm volatile("s_waitcnt lgkmcnt(" #n ")" ::: "memory")
#define PG8_BAR __builtin_amdgcn_s_barrier()
#define PG8_SCHED __builtin_amdgcn_sched_barrier(0)
  Unit cur, nxt; int ui = 0;
  if (!S.next(0, cur)) return;
  f32x4 acc[2][2][4][2];
#pragma unroll
  for (int a = 0; a < 2; ++a)
#pragma unroll
    for (int b = 0; b < 2; ++b)
#pragma unroll
      for (int m = 0; m < 4; ++m)
#pragma unroll
        for (int n = 0; n < 2; ++n) acc[a][b][m][n] = (f32x4){0.f, 0.f, 0.f, 0.f};
  bf16x8 At[4][2], B0[2][2], B1[2][2];
  const char* cA = (const char*)g.A + (size_t)cur.pm * tstepA; const char* cB = (const char*)g.Bt + (size_t)cur.pn * tstepB;
  PG8_STAGE(PG8_SB(0, 0), cB, voffB); PG8_STAGE(PG8_SA(0, 0), cA, voffA); PG8_STAGE(PG8_SB(0, 1), cB + hstepB, voffB); PG8_STAGE(PG8_SA(0, 1), cA + hstepA, voffA);
  if (wr == 1) PG8_BAR;
  PG8_WAIT_V(4); PG8_BAR;
  PG8_STAGE(PG8_SB(1, 0), cB + kstep, voffB); PG8_STAGE(PG8_SA(1, 0), cA + kstep, voffA); PG8_STAGE(PG8_SB(1, 1), cB + hstepB + kstep, voffB);
  PG8_WAIT_V(6); PG8_BAR;
  for (;;) {
    const bool has_next = S.next(ui + 1, nxt);
    const char* nA = has_next ? (const char*)g.A + (size_t)nxt.pm * tstepA : cA; const char* nB = has_next ? (const char*)g.Bt + (size_t)nxt.pn * tstepB : cB;
    for (int t = 0; t < nt; t += 2) {
      const bool last = (t == nt - 2);
      const char* a1 = cA + (size_t)(t + 1) * kstep;
      const char* a2 = last ? nA : cA + (size_t)(t + 2) * kstep; const char* b2 = last ? nB : cB + (size_t)(t + 2) * kstep;
      const char* a3 = a2 + kstep; const char* b3 = b2 + kstep;
      PG8_LDB(B0, 0, 0); PG8_SCHED; PG8_LDA(At, 0, 0); PG8_STAGE(PG8_SA(1, 1), a1 + hstepA, voffA);
      PG8_WAIT_L(8); PG8_BAR; PG8_WAIT_L(0); PG8_MMA(0, 0, At, B0); PG8_BAR; PG8_SCHED;
      PG8_LDB(B1, 0, 1); PG8_STAGE(PG8_SB(0, 0), b2, voffB);
      PG8_BAR; PG8_WAIT_L(0); PG8_MMA(0, 1, At, B1); PG8_BAR;
      PG8_LDA(At, 0, 1); PG8_STAGE(PG8_SA(0, 0), a2, voffA);
      PG8_BAR; PG8_WAIT_L(0); PG8_MMA(1, 0, At, B0); PG8_BAR; PG8_SCHED;
      PG8_STAGE(PG8_SB(0, 1), b2 + hstepB, voffB);
      PG8_WAIT_V(6); PG8_BAR; PG8_MMA(1, 1, At, B1); PG8_BAR;
      PG8_LDB(B0, 1, 0); PG8_SCHED; PG8_LDA(At, 1, 0); PG8_STAGE(PG8_SA(0, 1), a2 + hstepA, voffA);
      PG8_WAIT_L(8); PG8_BAR; PG8_WAIT_L(0); PG8_MMA(0, 0, At, B0); PG8_BAR; PG8_SCHED;
      PG8_LDB(B1, 1, 1); PG8_STAGE(PG8_SB(1, 0), b3, voffB);
      PG8_BAR; PG8_WAIT_L(0); PG8_MMA(0, 1, At, B1); PG8_BAR;
      PG8_LDA(At, 1, 1); PG8_STAGE(PG8_SA(1, 0), a3, voffA);
      PG8_BAR; PG8_WAIT_L(0); PG8_MMA(1, 0, At, B0); PG8_BAR; PG8_SCHED;
      PG8_STAGE(PG8_SB(1, 1), b3 + hstepB, voffB);
      PG8_WAIT_V(6); PG8_BAR; PG8_MMA(1, 1, At, B1); PG8_BAR;
    }
    E(acc, cur, wr, wc, fr, fq, lane);
    if (!has_next) break;
#pragma unroll
    for (int a = 0; a < 2; ++a)
#pragma unroll
      for (int b = 0; b < 2; ++b)
#pragma unroll
        for (int m = 0; m < 4; ++m)
#pragma unroll
          for (int n = 0; n < 2; ++n) acc[a][b][m][n] = (f32x4){0.f, 0.f, 0.f, 0.f};
    cur = nxt; cA = nA; cB = nB; ++ui;
  }
  PG8_WAIT_V(0);
  if (wr == 0) PG8_BAR;
  PG8_BAR;
#undef PG8_SA
#undef PG8_SB
#undef PG8_STAGE
#undef PG8_LDA
#undef PG8_LDB
#undef PG8_MMA
#undef PG8_WAIT_V
#undef PG8_WAIT_L
#undef PG8_BAR
#undef PG8_SCHED
}
}

#define OFF_STATS OFF_GLR

__device__ __forceinline__ u32x4 pack8v(const f32x4& a, const f32x4& b) {
  u32x4 w; w.x = pg8::cvt_pk_bf16(a[0], a[1]); w.y = pg8::cvt_pk_bf16(a[2], a[3]); w.z = pg8::cvt_pk_bf16(b[0], b[1]); w.w = pg8::cvt_pk_bf16(b[2], b[3]); return w;
}
__device__ __forceinline__ float xlane32(float v, int lane) { return __int_as_float(__builtin_amdgcn_ds_bpermute((lane ^ 32) << 2, __float_as_int(v))); }

struct EpiScanIn {
  static constexpr bool PERM = true;
  u16* S; const float* rot;
  __device__ __forceinline__ void operator()(const f32x4 (&acc)[2][2][4][2], const pg8::Unit& u, int wr, int wc, int fr, int fq, int lane) const {
    u16* Sb = S + (size_t)u.pm * 256 * 4096;
    unsigned rl0 = wr * 64 + fr; asm volatile("" : "+v"(rl0));
#pragma unroll
    for (int bj = 0; bj < 2; ++bj) {
      const int nt128 = u.pn * 2 + bj;
      const bool scaled = (nt128 < 4) || (nt128 >= 16 && nt128 < 20);
      const float scl = scaled ? 0.08838834764831845f : 1.f;
      const unsigned cb = nt128 * 128 + wc * 32 + fq * 8;
      if (nt128 < 8 && u.pm < 128) {
        const int tb = (u.pm & 15) * 256;
        const int fo = ((wc & 1) * 16 + (fq & 1) * 8) * 2;
        const float sgn = (fq >> 1) ? 1.f : -1.f;
#pragma unroll
        for (int ai = 0; ai < 2; ++ai)
#pragma unroll
          for (int m = 0; m < 4; ++m) {
            const unsigned rl = rl0 + ai * 128 + m * 16;
            const int t = tb + rl;
            const unsigned pos = (wc >> 1) == 0 ? (t >> 6) : (t & 63);
            const float* rp = rot + pos * 64u + fo;
            const float4 c0 = *(const float4*)rp, c1 = *(const float4*)(rp + 4), c2 = *(const float4*)(rp + 8), c3 = *(const float4*)(rp + 12);
            const f32x4 v0 = acc[ai][bj][m][0], v1 = acc[ai][bj][m][1];
            f32x4 p0, p1;
#pragma unroll
            for (int j = 0; j < 4; ++j) { p0[j] = xlane32(v0[j], lane); p1[j] = xlane32(v1[j], lane); }
            f32x4 o0, o1;
            o0[0] = (v0[0] * c0.x + sgn * p0[0] * c0.y) * scl; o0[1] = (v0[1] * c0.z + sgn * p0[1] * c0.w) * scl;
            o0[2] = (v0[2] * c1.x + sgn * p0[2] * c1.y) * scl; o0[3] = (v0[3] * c1.z + sgn * p0[3] * c1.w) * scl;
            o1[0] = (v1[0] * c2.x + sgn * p1[0] * c2.y) * scl; o1[1] = (v1[1] * c2.z + sgn * p1[1] * c2.w) * scl;
            o1[2] = (v1[2] * c3.x + sgn * p1[2] * c3.y) * scl; o1[3] = (v1[3] * c3.z + sgn * p1[3] * c3.w) * scl;
            *(u32x4*)(Sb + rl * 4096u + cb) = pack8v(o0, o1);
            __builtin_amdgcn_sched_barrier(0);
          }
      } else {
#pragma unroll
        for (int ai = 0; ai < 2; ++ai)
#pragma unroll
          for (int m = 0; m < 4; ++m) {
            const unsigned rl = rl0 + ai * 128 + m * 16;
            *(u32x4*)(Sb + rl * 4096u + cb) = pack8v(acc[ai][bj][m][0] * scl, acc[ai][bj][m][1] * scl);
            __builtin_amdgcn_sched_barrier(0);
          }
      }
    }
  }
};

struct EpiGate {
  static constexpr bool PERM = true;
  const u16* RG; const float* stats; u16* S; const float* rgain; const float* ggain;
  __device__ __forceinline__ void operator()(const f32x4 (&acc)[2][2][4][2], const pg8::Unit& u, int wr, int wc, int fr, int fq, int lane) const {
    u16* Sb = S + (size_t)u.pm * 256 * 4096;
    unsigned rl0 = wr * 64 + fr; asm volatile("" : "+v"(rl0));
    if (u.pn < 8) {
      const int branch = u.pn >> 2, head = u.pn & 3;
      const u16* RGb = RG + (size_t)u.pm * 256 * 2048 + branch * 1024;
      const float* stb = stats + (size_t)u.pm * 256 * 16 + (branch * 4 + head) * 2;
      const float* gain = branch ? ggain : rgain;
#pragma unroll
      for (int bj = 0; bj < 2; ++bj) {
        const unsigned cb = head * 256 + bj * 128 + wc * 32 + fq * 8;
        const float4 g0 = *(const float4*)(gain + cb), g1 = *(const float4*)(gain + cb + 4);
#pragma unroll
        for (int ai = 0; ai < 2; ++ai)
#pragma unroll
          for (int m = 0; m < 4; ++m) {
            const unsigned rl = rl0 + ai * 128 + m * 16;
            const float2 st = *(const float2*)(stb + rl * 16u);
            const bf16x8 xr = *(const bf16x8*)(RGb + rl * 2048u + cb);
            f32x4 v0 = acc[ai][bj][m][0], v1 = acc[ai][bj][m][1];
            asm volatile("" : "+v"(v0), "+v"(v1));
            f32x4 o0, o1;
            o0[0] = (bf2f((u16)xr[0]) * st.x + st.y) * g0.x * siluf_(v0[0]); o0[1] = (bf2f((u16)xr[1]) * st.x + st.y) * g0.y * siluf_(v0[1]);
            o0[2] = (bf2f((u16)xr[2]) * st.x + st.y) * g0.z * siluf_(v0[2]); o0[3] = (bf2f((u16)xr[3]) * st.x + st.y) * g0.w * siluf_(v0[3]);
            o1[0] = (bf2f((u16)xr[4]) * st.x + st.y) * g1.x * siluf_(v1[0]); o1[1] = (bf2f((u16)xr[5]) * st.x + st.y) * g1.y * siluf_(v1[1]);
            o1[2] = (bf2f((u16)xr[6]) * st.x + st.y) * g1.z * siluf_(v1[2]); o1[3] = (bf2f((u16)xr[7]) * st.x + st.y) * g1.w * siluf_(v1[3]);
            *(u32x4*)(Sb + rl * 4096u + 2048u + branch * 1024 + cb) = pack8v(o0, o1);
            __builtin_amdgcn_sched_barrier(0);
          }
      }
    } else {
#pragma unroll
      for (int bj = 0; bj < 2; ++bj) {
        const unsigned cb = (u.pn - 8) * 256 + bj * 128 + wc * 32 + fq * 8;
#pragma unroll
        for (int ai = 0; ai < 2; ++ai)
#pragma unroll
          for (int m = 0; m < 4; ++m) {
            const unsigned rl = rl0 + ai * 128 + m * 16;
            f32x4 v0 = acc[ai][bj][m][0], v1 = acc[ai][bj][m][1];
            asm volatile("" : "+v"(v0), "+v"(v1));
            f32x4 o0, o1;
#pragma unroll
            for (int j = 0; j < 4; ++j) { o0[j] = sigmoidf_(v0[j]); o1[j] = sigmoidf_(v1[j]); }
            *(u32x4*)(Sb + rl * 4096u + cb) = pack8v(o0, o1);
            __builtin_amdgcn_sched_barrier(0);
          }
      }
    }
  }
};

struct EpiMerge {
  static constexpr bool PERM = true;
  const u16* S; u16* MG; int pass;
  __device__ __forceinline__ void operator()(const f32x4 (&acc)[2][2][4][2], const pg8::Unit& u, int wr, int wc, int fr, int fq, int lane) const {
    const u16* Sb = S + (size_t)u.pm * 256 * 4096 + pass * 1024;
    u16* MGb = MG + (size_t)u.pm * 256 * 1024;
    unsigned rl0 = wr * 64 + fr; asm volatile("" : "+v"(rl0));
#pragma unroll
    for (int bj = 0; bj < 2; ++bj) {
      const unsigned cb = u.pn * 256 + bj * 128 + wc * 32 + fq * 8;
#pragma unroll
      for (int ai = 0; ai < 2; ++ai)
#pragma unroll
        for (int m = 0; m < 4; ++m) {
          const unsigned rl = rl0 + ai * 128 + m * 16;
          const bf16x8 gt = *(const bf16x8*)(Sb + rl * 4096u + cb);
          f32x4 o0 = acc[ai][bj][m][0], o1 = acc[ai][bj][m][1];
#pragma unroll
          for (int j = 0; j < 4; ++j) { o0[j] *= bf2f((u16)gt[j]); o1[j] *= bf2f((u16)gt[4 + j]); }
          if (pass) {
            const bf16x8 old = *(const bf16x8*)(MGb + rl * 1024u + cb);
#pragma unroll
            for (int j = 0; j < 4; ++j) { o0[j] += bf2f((u16)old[j]); o1[j] += bf2f((u16)old[4 + j]); }
          }
          *(u32x4*)(MGb + rl * 1024u + cb) = pack8v(o0, o1);
            __builtin_amdgcn_sched_barrier(0);
        }
    }
  }
};

struct EpiOut {
  static constexpr bool PERM = false;
  const float* x_lat; const float* x_ctx; float* o_lat; float* o_ctx; const float* mod;
  __device__ __forceinline__ void operator()(const f32x4 (&acc)[2][2][4][2], const pg8::Unit& u, int wr, int wc, int fr, int fq, int lane) const {
    const float* hin; float* hout; int rmod;
    if (u.pm < 128) { hin = x_lat + (size_t)u.pm * 256 * DM; hout = o_lat + (size_t)u.pm * 256 * DM; rmod = u.pm >> 4; }
    else { hin = x_ctx + (size_t)(u.pm - 128) * 256 * DM; hout = o_ctx + (size_t)(u.pm - 128) * 256 * DM; rmod = 8; }
    const float* gate = mod + rmod * 3072 + 2048;
    unsigned rl0 = wr * 64 + fr; asm volatile("" : "+v"(rl0));
#pragma unroll
    for (int bj = 0; bj < 2; ++bj)
#pragma unroll
      for (int n = 0; n < 2; ++n) {
        const unsigned cb = u.pn * 256 + bj * 128 + wc * 32 + n * 16 + fq * 4;
        const float4 g = *(const float4*)(gate + cb);
#pragma unroll
        for (int ai = 0; ai < 2; ++ai)
#pragma unroll
          for (int m = 0; m < 4; ++m) {
            const unsigned o = (rl0 + ai * 128 + m * 16) * 1024u + cb;
            const float4 h = *(const float4*)(hin + o);
            const f32x4 v = acc[ai][bj][m][n];
            *(float4*)(hout + o) = make_float4(h.x + g.x * v[0], h.y + g.y * v[1], h.z + g.z * v[2], h.w + g.w * v[3]);
          }
      }
  }
};

__device__ __forceinline__ void phase_stats(const Params& p, int l) {
  const int tid = opaque_tid(); const int wave = tid >> 6, lane = tid & 63;
  const u16* RG = (const u16*)(p.ws + OFF_RG);
  float* ST = (float*)(p.ws + OFF_STATS);
  const int nrows = (l == 0) ? MTOT : MLAT;
  for (int row = (blockIdx.x * 8 + wave) * 4; row < nrows; row += gridDim.x * 32) {
    bf16x8 v[4][4];
#pragma unroll
    for (int q = 0; q < 4; ++q)
#pragma unroll
      for (int i = 0; i < 4; ++i) v[q][i] = *(const bf16x8*)(RG + (size_t)(row + q) * 2048 + i * 512 + lane * 8);
#pragma unroll
    for (int q = 0; q < 4; ++q)
#pragma unroll
      for (int i = 0; i < 4; ++i) {
        float s1 = 0.f, s2 = 0.f;
#pragma unroll
        for (int x = 0; x < 8; ++x) { float a = bf2f((u16)v[q][i][x]); s1 += a; s2 += a * a; }
#pragma unroll
        for (int o = 16; o > 0; o >>= 1) {
          s1 += __int_as_float(__builtin_amdgcn_ds_bpermute((lane ^ o) << 2, __float_as_int(s1)));
          s2 += __int_as_float(__builtin_amdgcn_ds_bpermute((lane ^ o) << 2, __float_as_int(s2)));
        }
        float sa, sb;
        if ((i >> 1) == 0) { float mu = s1 * (1.f / 256.f); float var = fmaxf(s2 * (1.f / 256.f) - mu * mu, 0.f); sa = rsqrtf(var + 1e-6f); sb = -mu * sa; }
        else { sa = rsqrtf(s2 * (1.f / 256.f) + 1e-6f); sb = 0.f; }
        if ((lane & 31) == 0) *(float2*)(ST + ((size_t)(row + q) * 8 + (i >> 1) * 4 + 2 * (i & 1) + (lane >> 5)) * 2) = make_float2(sa, sb);
      }
  }
}

#define OFF_VECS OFF_WT
__device__ __forceinline__ float logsig16(float x) { return (fminf(x, 0.f) - __logf(1.f + __expf(-fabsf(x)))) * (1.f / 16.f); }

typedef __attribute__((ext_vector_type(2))) float f32x2_t;

template <int SW>
__device__ __forceinline__ void prepass_sweep4(const float* GLRS, const f32x2_t (&w2)[4][16], const f32x2_t (&b2)[4], u16* Sq, u16* Ub,
                                               float (&accF)[4], float (&accB)[4]) {
#pragma unroll
  for (int c = 0; c < 4; ++c) { accF[c] = 0.f; accB[c] = 0.f; }
#pragma unroll 2
  for (int u = 0; u < 32; ++u) {
    const int i = SW ? 32 + u : 31 - u;
    const bf16x4 q4 = *(const bf16x4*)(Sq + (unsigned)i * 4096u);
    const bf16x4 k4 = *(const bf16x4*)(Sq + (unsigned)i * 4096u + 512u);
    const float4* gr = (const float4*)(GLRS + (i & 31) * 16);
    const float4 g0 = gr[0], g1 = gr[1], g2 = gr[2], g3 = gr[3];
    bf16x4 oqf, okf, oqb, okb;
#pragma unroll
    for (int c = 0; c < 4; ++c) {
      f32x2_t x = b2[c];
      x = w2[c][0] * g0.x + x;  x = w2[c][1] * g0.y + x;  x = w2[c][2] * g0.z + x;  x = w2[c][3] * g0.w + x;
      x = w2[c][4] * g1.x + x;  x = w2[c][5] * g1.y + x;  x = w2[c][6] * g1.z + x;  x = w2[c][7] * g1.w + x;
      x = w2[c][8] * g2.x + x;  x = w2[c][9] * g2.y + x;  x = w2[c][10] * g2.z + x; x = w2[c][11] * g2.w + x;
      x = w2[c][12] * g3.x + x; x = w2[c][13] * g3.y + x; x = w2[c][14] * g3.z + x; x = w2[c][15] * g3.w + x;
      const float laf = logsig16(x.x), lab = logsig16(x.y);
      float relf, relb;
      if (SW == 0) { relf = -accF[c]; accF[c] += laf; accB[c] += lab; relb = accB[c]; }
      else         { accF[c] += laf; relf = accF[c]; relb = -accB[c]; accB[c] += lab; }
      const float q = bf2f((u16)q4[c]), k = bf2f((u16)k4[c]);
      oqf[c] = (short)f2bf(q * __expf(relf)); okf[c] = (short)f2bf(k * __expf(-relf));
      oqb[c] = (short)f2bf(q * __expf(relb)); okb[c] = (short)f2bf(k * __expf(-relb));
    }
    *(bf16x4*)(Sq + (unsigned)i * 4096u) = oqf;
    *(bf16x4*)(Sq + (unsigned)i * 4096u + 512u) = okf;
    *(bf16x4*)(Ub + (unsigned)i * 1024u) = oqb;
    *(bf16x4*)(Ub + (unsigned)i * 1024u + 512u) = okb;
  }
}

__device__ __forceinline__ void gla_prepass_unit(const Params& p, int l, int bunit, char* smem) {
  const int tid = opaque_tid();
  const int ul = __builtin_amdgcn_readfirstlane(tid >> 7);
  const int gu = bunit * 4 + ul;
  const int sw = gu & 1, ch = gu >> 1;
  const int b = ch / 68, cid = ch % 68;
  const int base = cid < 4 ? (MLAT + b * 256 + cid * 64) : (b * 4096 + (cid - 4) * 64);
  float* GLRS = (float*)smem + ul * 512;
  const int col0 = (tid & 127) * 4;
  __syncthreads();
  {
    const int uw = (tid >> 6) & 1, lane = tid & 63, fr = lane & 15, fq = lane >> 4;
    f32x4 g = (f32x4){0.f, 0.f, 0.f, 0.f};
    const u16* Ua = (const u16*)(p.ws + OFF_U) + (size_t)(base + sw * 32 + uw * 16 + fr) * 1024 + fq * 8;
    const u16* Wb = (const u16*)(p.ws + OFF_WT) + (size_t)(4096 + fr) * 1024 + fq * 8;
#pragma unroll 16
    for (int k = 0; k < 1024; k += 32) {
      bf16x8 a = *(const bf16x8*)(Ua + k);
      bf16x8 w = *(const bf16x8*)(Wb + k);
      g = __builtin_amdgcn_mfma_f32_16x16x32_bf16(a, w, g, 0, 0, 0);
    }
#pragma unroll
    for (int j = 0; j < 4; ++j) GLRS[(uw * 16 + fq * 4 + j) * 16 + fr] = g[j];
  }
  f32x2_t w2[4][16], b2[4];
  {
    const float* w0 = p.gla_w_up + (size_t)(l * 2 + 0) * 16 * 512 + col0;
    const float* w1 = p.gla_w_up + (size_t)(l * 2 + 1) * 16 * 512 + col0;
#pragma unroll
    for (int r = 0; r < 16; ++r) {
      const float4 a = *(const float4*)(w0 + r * 512), c = *(const float4*)(w1 + r * 512);
      w2[0][r].x = a.x; w2[1][r].x = a.y; w2[2][r].x = a.z; w2[3][r].x = a.w;
      w2[0][r].y = c.x; w2[1][r].y = c.y; w2[2][r].y = c.z; w2[3][r].y = c.w;
    }
    const float4 a = *(const float4*)(p.gla_b_up + (l * 2 + 0) * 512 + col0), c = *(const float4*)(p.gla_b_up + (l * 2 + 1) * 512 + col0);
    b2[0].x = a.x; b2[1].x = a.y; b2[2].x = a.z; b2[3].x = a.w;
    b2[0].y = c.x; b2[1].y = c.y; b2[2].y = c.z; b2[3].y = c.w;
  }
  __syncthreads();
  u16* Sq = (u16*)(p.ws + OFF_S) + (size_t)base * 4096 + 2048 + col0;
  u16* Ub = (l == 0 ? (u16*)p.out : (u16*)(p.ws + OFF_U)) + (size_t)base * 1024 + col0;
  float* V0 = (float*)(p.ws + OFF_VECS) + ((size_t)(0 * 544 + b * 68 + cid) * 2) * 512 + col0;
  float* V1 = (float*)(p.ws + OFF_VECS) + ((size_t)(1 * 544 + b * 68 + cid) * 2) * 512 + col0;
  float accF[4], accB[4];
  if (sw == 0) {
    prepass_sweep4<0>(GLRS, w2, b2, Sq, Ub, accF, accB);
    *(float4*)(V0) = make_float4(__expf(accF[0]), __expf(accF[1]), __expf(accF[2]), __expf(accF[3]));
    *(float4*)(V1 + 512) = make_float4(__expf(accB[0]), __expf(accB[1]), __expf(accB[2]), __expf(accB[3]));
  } else {
    prepass_sweep4<1>(GLRS, w2, b2, Sq, Ub, accF, accB);
    *(float4*)(V0 + 512) = make_float4(__expf(accF[0]), __expf(accF[1]), __expf(accF[2]), __expf(accF[3]));
    *(float4*)(V1) = make_float4(__expf(accB[0]), __expf(accB[1]), __expf(accB[2]), __expf(accB[3]));
  }
}

template <int SW>
__device__ __forceinline__ void prepass_sweep(const float* GLRS, const f32x2_t (&w2)[16], f32x2_t b2, u16* Sq, u16* Ub, float& accF, float& accB) {
  accF = 0.f; accB = 0.f;
#pragma unroll 16
  for (int u = 0; u < 32; ++u) {
    const int i = SW ? 32 + u : 31 - u;
    const float4* gr = (const float4*)(GLRS + i * 16);
    const float4 g0 = gr[0], g1 = gr[1], g2 = gr[2], g3 = gr[3];
    f32x2_t x = b2;
    x = w2[0] * g0.x + x;  x = w2[1] * g0.y + x;  x = w2[2] * g0.z + x;  x = w2[3] * g0.w + x;
    x = w2[4] * g1.x + x;  x = w2[5] * g1.y + x;  x = w2[6] * g1.z + x;  x = w2[7] * g1.w + x;
    x = w2[8] * g2.x + x;  x = w2[9] * g2.y + x;  x = w2[10] * g2.z + x; x = w2[11] * g2.w + x;
    x = w2[12] * g3.x + x; x = w2[13] * g3.y + x; x = w2[14] * g3.z + x; x = w2[15] * g3.w + x;
    const float laf = logsig16(x.x), lab = logsig16(x.y);
    float relf, relb;
    if (SW == 0) { relf = -accF; accF += laf; accB += lab; relb = accB; }
    else         { accF += laf; relf = accF; relb = -accB; accB += lab; }
    const float q = bf2f(Sq[(unsigned)i * 4096u]), k = bf2f(Sq[(unsigned)i * 4096u + 512u]);
    Sq[(unsigned)i * 4096u] = f2bf(q * __expf(relf));
    Sq[(unsigned)i * 4096u + 512u] = f2bf(k * __expf(-relf));
    Ub[(unsigned)i * 1024u] = f2bf(q * __expf(relb));
    Ub[(unsigned)i * 1024u + 512u] = f2bf(k * __expf(-relb));
  }
}

__device__ __forceinline__ void gla_prepass_unit1(const Params& p, int l, int unit, char* smem) {
  const int tid = opaque_tid();
  const int sw = unit & 1, ch = unit >> 1;
  const int b = ch / 68, cid = ch % 68;
  const int base = cid < 4 ? (MLAT + b * 256 + cid * 64) : (b * 4096 + (cid - 4) * 64);
  float* GLRS = (float*)smem;
  __syncthreads();
  {
    const int wid = tid >> 6, lane = tid & 63, fr = lane & 15, fq = lane >> 4;
    if (wid < 2) {
      const int r0 = sw * 32 + wid * 16;
      f32x4 g = (f32x4){0.f, 0.f, 0.f, 0.f};
      const u16* Ua = (const u16*)(p.ws + OFF_U) + (size_t)(base + r0 + fr) * 1024 + fq * 8;
      const u16* Wb = (const u16*)(p.ws + OFF_WT) + (size_t)(4096 + fr) * 1024 + fq * 8;
#pragma unroll 16
      for (int k = 0; k < 1024; k += 32) {
        bf16x8 a = *(const bf16x8*)(Ua + k);
        bf16x8 w = *(const bf16x8*)(Wb + k);
        g = __builtin_amdgcn_mfma_f32_16x16x32_bf16(a, w, g, 0, 0, 0);
      }
#pragma unroll
      for (int j = 0; j < 4; ++j) GLRS[(r0 + fq * 4 + j) * 16 + fr] = g[j];
    }
  }
  f32x2_t w2[16];
  {
    const float* w0 = p.gla_w_up + (size_t)(l * 2 + 0) * 16 * 512 + tid;
    const float* w1 = p.gla_w_up + (size_t)(l * 2 + 1) * 16 * 512 + tid;
#pragma unroll
    for (int r = 0; r < 16; ++r) { w2[r].x = w0[r * 512]; w2[r].y = w1[r * 512]; }
  }
  f32x2_t b2; b2.x = p.gla_b_up[(l * 2 + 0) * 512 + tid]; b2.y = p.gla_b_up[(l * 2 + 1) * 512 + tid];
  __syncthreads();
  u16* Sq = (u16*)(p.ws + OFF_S) + (size_t)base * 4096 + 2048 + tid;
  u16* Ub = (l == 0 ? (u16*)p.out : (u16*)(p.ws + OFF_U)) + (size_t)base * 1024 + tid;
  float* V0 = (float*)(p.ws + OFF_VECS) + ((size_t)(0 * 544 + b * 68 + cid) * 2) * 512 + tid;
  float* V1 = (float*)(p.ws + OFF_VECS) + ((size_t)(1 * 544 + b * 68 + cid) * 2) * 512 + tid;
  float accF, accB;
  if (sw == 0) {
    prepass_sweep<0>(GLRS, w2, b2, Sq, Ub, accF, accB);
    V0[0] = __expf(accF);
    V1[512] = __expf(accB);
  } else {
    prepass_sweep<1>(GLRS, w2, b2, Sq, Ub, accF, accB);
    V0[512] = __expf(accF);
    V1[0] = __expf(accB);
  }
}

#define L_QR   0
#define L_KR   17408
#define L_V    34816
#define L_SGT  44032
#define L_P    61440
#undef  SCAN_GB
#define SCAN_GB 70656

__device__ __forceinline__ int off128(int row, int col) { return row * 272 + col * 2; }
__device__ __forceinline__ int off64(int row, int col) { return row * 144 + col * 2; }

template <int RS>
__device__ __forceinline__ bf16x8 tr_frag(unsigned img_addr, int r0, int c0, int lane) {
  const int g = lane >> 4, q = (lane & 15) >> 2, pp = lane & 3;
  unsigned a = img_addr + (unsigned)((r0 + 8 * g + q) * RS + (c0 + 4 * pp) * 2);
  bf16x4 lo, hi;
  asm volatile("ds_read_b64_tr_b16 %0, %2\n\tds_read_b64_tr_b16 %1, %2 offset:%3\n\ts_waitcnt lgkmcnt(0)"
               : "=&v"(lo), "=&v"(hi) : "v"(a), "n"(4 * RS) : "memory");
  bf16x8 r;
  r[0] = lo[0]; r[1] = lo[1]; r[2] = lo[2]; r[3] = lo[3]; r[4] = hi[0]; r[5] = hi[1]; r[6] = hi[2]; r[7] = hi[3];
  return r;
}

__device__ __forceinline__ bf16x8 scale8(bf16x8 v, float f) {
  bf16x8 o;
#pragma unroll
  for (int x = 0; x < 8; ++x) o[x] = (short)f2bf(bf2f((u16)v[x]) * f);
  return o;
}

__device__ __forceinline__ void lds_barrier() { asm volatile("s_waitcnt lgkmcnt(0)" ::: "memory"); __builtin_amdgcn_s_barrier(); asm volatile("" ::: "memory"); }

template <int branch>
__device__ __forceinline__ void scan_item(const Params& p, int l, int item, char* smem) {
  const int b = (item >> 4) & 7, h = (item >> 2) & 3, slice = item & 3;
  const int tid = opaque_tid(), wid = __builtin_amdgcn_readfirstlane(tid >> 6), lane = tid & 63;
  const int dir = wid >> 2, gw = wid & 3, gt = tid & 255;
  const int fr = lane & 15, fq = lane >> 4;
  char* G = smem + dir * SCAN_GB;
  const unsigned Ga = (unsigned)(size_t)G;
  const u16* S = (const u16*)(p.ws + OFF_S);
  u16* RG = (u16*)(p.ws + OFF_RG);
  const u16* qsrc; unsigned qstride;
  if (branch == 0) { qsrc = S + h * 128; qstride = 4096; }
  else if (dir == 0) { qsrc = S + 2048 + h * 128; qstride = 4096; }
  else { qsrc = (l == 0 ? (const u16*)p.out : (const u16*)(p.ws + OFF_U)) + h * 128; qstride = 1024; }
  const int voff = branch * 2048 + 1024 + h * 256 + slice * 64;
  const int ooff = branch * 1024 + h * 256 + slice * 64;
  float lg = 0.f, egc = 1.f;
  if (branch == 0) { lg = __logf(1.f - __expf(p.ret_decay[(l * 2 + dir) * 4 + h])); egc = __expf(32.f * lg); }
  const float* VECS = (const float*)(p.ws + OFF_VECS) + ((size_t)(dir * 544 + b * 68) * 2) * 512 + h * 128;
  f32x4 st[2][4];
#pragma unroll
  for (int m = 0; m < 2; ++m)
#pragma unroll
    for (int n = 0; n < 4; ++n) st[m][n] = (f32x4){0.f, 0.f, 0.f, 0.f};

  const int qj = gt >> 4, qc = gt & 15;
  const int vj = gt >> 3, vc = gt & 7;
  bf16x8 pq[4], pk[4], pv[2];
  float4 peg[2], pel[2];
  auto prefetch = [&](int s) {
    int base, cid;
    if (s < 4) { int cc = dir ? 3 - s : s; base = MLAT + b * 256 + cc * 64; cid = cc; }
    else { int c = s - 4; int cc = dir ? 63 - c : c; base = b * 4096 + cc * 64; cid = 4 + cc; }
#pragma unroll
    for (int i = 0; i < 4; ++i) {
      int jp = qj + 16 * i;
      unsigned ro = (unsigned)(base + (dir ? 63 - jp : jp)) * qstride + qc * 8;
      pq[i] = *(const bf16x8*)(qsrc + ro);
      pk[i] = *(const bf16x8*)(qsrc + ro + 512);
    }
#pragma unroll
    for (int i = 0; i < 2; ++i) {
      int jp = vj + 32 * i;
      pv[i] = *(const bf16x8*)(S + (size_t)(base + (dir ? 63 - jp : jp)) * 4096 + voff + vc * 8);
    }
    if (branch == 1) {
#pragma unroll
      for (int m = 0; m < 2; ++m) {
        int d0 = gw * 32 + m * 16 + fq * 4;
        peg[m] = *(const float4*)(VECS + (size_t)cid * 1024 + d0);
        pel[m] = *(const float4*)(VECS + (size_t)cid * 1024 + 512 + d0);
      }
    }
  };
  prefetch(0);
  __syncthreads();

  for (int s = 0; s < 68; ++s) {
    int base; bool first; bool wout;
    if (s < 4) { int cc = dir ? 3 - s : s; base = MLAT + b * 256 + cc * 64; first = s < 2; wout = (l == 0); }
    else { int c = s - 4; int cc = dir ? 63 - c : c; base = b * 4096 + cc * 64; first = c < 32; wout = true; }
    float4 eg[2], el[2];
#pragma unroll
    for (int m = 0; m < 2; ++m) {
      if (branch == 1) { eg[m] = peg[m]; el[m] = pel[m]; }
      else { eg[m] = make_float4(egc, egc, egc, egc); el[m] = eg[m]; }
    }
#pragma unroll
    for (int i = 0; i < 4; ++i) {
      int jp = qj + 16 * i;
      bf16x8 qv = pq[i], kv_ = pk[i];
      if (branch == 0) {
        float fqs = __expf((float)(jp - 31) * lg), fks = __expf((float)(31 - jp) * lg);
        qv = scale8(qv, fqs); kv_ = scale8(kv_, fks);
      }
      *(bf16x8*)(G + L_QR + off128(jp, qc * 8)) = qv;
      *(bf16x8*)(G + L_KR + off128(jp, qc * 8)) = kv_;
    }
#pragma unroll
    for (int i = 0; i < 2; ++i) *(bf16x8*)(G + L_V + off64(vj + 32 * i, vc * 8)) = pv[i];
#pragma unroll
    for (int m = 0; m < 2; ++m) {
      int d0 = gw * 32 + m * 16 + fq * 4;
#pragma unroll
      for (int n = 0; n < 4; ++n) {
        int e = n * 16 + fr;
        bf16x4 o4;
        o4[0] = (short)f2bf(st[m][n][0] * eg[m].x); o4[1] = (short)f2bf(st[m][n][1] * eg[m].y);
        o4[2] = (short)f2bf(st[m][n][2] * eg[m].z); o4[3] = (short)f2bf(st[m][n][3] * eg[m].w);
        *(bf16x4*)(G + L_SGT + off128(e, d0)) = o4;
      }
    }
    u16 oldv[4][4];
    u16* dstb = RG + (size_t)base * 2048 + ooff + fr;
    if (wout && !first) {
#pragma unroll
      for (int r = 0; r < 4; ++r) {
        int ip = gw * 16 + fq * 4 + r;
        unsigned ro = (unsigned)(dir ? 63 - ip : ip) * 2048u;
#pragma unroll
        for (int n = 0; n < 4; ++n) oldv[r][n] = dstb[ro + n * 16];
      }
    }
    if (s + 1 < 68) prefetch(s + 1);
    lds_barrier();
    f32x4 pt[4], o[4];
#pragma unroll
    for (int n = 0; n < 4; ++n) { pt[n] = (f32x4){0.f, 0.f, 0.f, 0.f}; o[n] = (f32x4){0.f, 0.f, 0.f, 0.f}; }
#pragma unroll
    for (int ks = 0; ks < 4; ++ks) {
      int kc = ks * 32 + fq * 8;
      bf16x8 qa = *(const bf16x8*)(G + L_QR + off128(gw * 16 + fr, kc));
#pragma unroll
      for (int n = 0; n < 4; ++n) {
        bf16x8 ka = *(const bf16x8*)(G + L_KR + off128(n * 16 + fr, kc));
        bf16x8 sb = *(const bf16x8*)(G + L_SGT + off128(n * 16 + fr, kc));
        pt[n] = __builtin_amdgcn_mfma_f32_16x16x32_bf16(ka, qa, pt[n], 0, 0, 0);
        o[n] = __builtin_amdgcn_mfma_f32_16x16x32_bf16(qa, sb, o[n], 0, 0, 0);
      }
    }
    {
      const int ip = gw * 16 + fr;
#pragma unroll
      for (int n = 0; n < 4; ++n) {
        const int j0 = n * 16 + fq * 4;
        bf16x4 w;
#pragma unroll
        for (int r = 0; r < 4; ++r) {
          int jp = j0 + r;
          bool keep = dir ? (ip > jp) : (ip >= jp);
          w[r] = (short)f2bf(keep ? pt[n][r] : 0.f);
        }
        *(bf16x4*)(G + L_P + off64(ip, j0)) = w;
      }
    }
    asm volatile("s_waitcnt lgkmcnt(0)" ::: "memory");
    {
      const int tg = lane >> 4, tq = (lane & 15) >> 2, tp = lane & 3;
      const unsigned ka0 = Ga + L_KR + (unsigned)((8 * tg + tq) * 272 + (gw * 32 + 4 * tp) * 2);
      const unsigned va0 = Ga + L_V + (unsigned)((8 * tg + tq) * 144 + (4 * tp) * 2);
#pragma unroll
      for (int m = 0; m < 2; ++m) {
        f32x4 kv[4];
#pragma unroll
        for (int n = 0; n < 4; ++n) kv[n] = (f32x4){0.f, 0.f, 0.f, 0.f};
#pragma unroll
        for (int ks = 0; ks < 2; ++ks) {
          int kc = ks * 32 + fq * 8;
          bf16x4 r0, r1, r2, r3, r4, r5, r6, r7, r8, r9;
          asm volatile(
              "ds_read_b64_tr_b16 %0, %10\n\tds_read_b64_tr_b16 %1, %10 offset:1088\n\t"
              "ds_read_b64_tr_b16 %2, %11\n\tds_read_b64_tr_b16 %3, %11 offset:576\n\t"
              "ds_read_b64_tr_b16 %4, %11 offset:32\n\tds_read_b64_tr_b16 %5, %11 offset:608\n\t"
              "ds_read_b64_tr_b16 %6, %11 offset:64\n\tds_read_b64_tr_b16 %7, %11 offset:640\n\t"
              "ds_read_b64_tr_b16 %8, %11 offset:96\n\tds_read_b64_tr_b16 %9, %11 offset:672\n\t"
              "s_waitcnt lgkmcnt(0)"
              : "=&v"(r0), "=&v"(r1), "=&v"(r2), "=&v"(r3), "=&v"(r4), "=&v"(r5), "=&v"(r6), "=&v"(r7), "=&v"(r8), "=&v"(r9)
              : "v"(ka0 + (unsigned)(ks * 32 * 272 + m * 32)), "v"(va0 + (unsigned)(ks * 32 * 144))
              : "memory");
          bf16x8 km = __builtin_shufflevector(r0, r1, 0, 1, 2, 3, 4, 5, 6, 7);
          bf16x8 vb[4];
          vb[0] = __builtin_shufflevector(r2, r3, 0, 1, 2, 3, 4, 5, 6, 7);
          vb[1] = __builtin_shufflevector(r4, r5, 0, 1, 2, 3, 4, 5, 6, 7);
          vb[2] = __builtin_shufflevector(r6, r7, 0, 1, 2, 3, 4, 5, 6, 7);
          vb[3] = __builtin_shufflevector(r8, r9, 0, 1, 2, 3, 4, 5, 6, 7);
          bf16x8 pa;
          if (m == 0) pa = *(const bf16x8*)(G + L_P + off64(gw * 16 + fr, kc));
#pragma unroll
          for (int n = 0; n < 4; ++n) {
            if (m == 0) o[n] = __builtin_amdgcn_mfma_f32_16x16x32_bf16(pa, vb[n], o[n], 0, 0, 0);
            kv[n] = __builtin_amdgcn_mfma_f32_16x16x32_bf16(km, vb[n], kv[n], 0, 0, 0);
          }
        }
#pragma unroll
        for (int n = 0; n < 4; ++n) {
          st[m][n][0] = eg[m].x * el[m].x * st[m][n][0] + el[m].x * kv[n][0];
          st[m][n][1] = eg[m].y * el[m].y * st[m][n][1] + el[m].y * kv[n][1];
          st[m][n][2] = eg[m].z * el[m].z * st[m][n][2] + el[m].z * kv[n][2];
          st[m][n][3] = eg[m].w * el[m].w * st[m][n][3] + el[m].w * kv[n][3];
        }
      }
    }
    if (wout) {
#pragma unroll
      for (int r = 0; r < 4; ++r) {
        int ip = gw * 16 + fq * 4 + r;
        unsigned ro = (unsigned)(dir ? 63 - ip : ip) * 2048u;
#pragma unroll
        for (int n = 0; n < 4; ++n) {
          float v = o[n][r];
          if (!first) v += bf2f(oldv[r][n]);
          dstb[ro + n * 16] = f2bf(v);
        }
      }
    }
    __syncthreads();
  }
}

#define NPHASE 18
__device__ __forceinline__ void run_phase(const Params& p, int ph, char* smem) {
  const int nblk = gridDim.x, bid = blockIdx.x;
  if (ph == 0) {
#ifdef REP_P0
    for (int rep = 0; rep < REP_P0; ++rep)
#endif
    for (int u = bid; u < WT_UNITS + 96 + 1; u += nblk) {
      if (u < 96) mod_unit(p, u, smem);
      else if (u == 96) rot_unit(p);
      else wt_unit(p, 0, u - 97, smem);
    }
    return;
  }
  if (ph == NPHASE - 1) { phase_final(p); return; }
  const int l = (ph - 1) / 8, sp = (ph - 1) % 8;
  PG8_LAS unsigned char* lds = (PG8_LAS unsigned char*)smem;
  switch (sp) {
    case 0:
      phase_u(p, l);
      if (l == 1) for (int u = bid; u < WT_UNITS; u += nblk) wt_unit(p, 1, u, smem);
      break;
    case 1: {
      pg8::Gemm g{(const u16*)(p.ws + OFF_U), (const u16*)(p.ws + OFF_WT) + (size_t)WT_SCAN * 1024, 1024, MTOT, 4096, 1024};
      pg8::StaticOrder S; S.init(g.M, g.N, nblk, bid);
      EpiScanIn E{(u16*)(p.ws + OFF_S), (const float*)(p.ws + OFF_ROT)};
      pg8::gemm_phase(lds, g, S, E, opaque_tid());
    } break;
    case 2:
      for (int t = bid; t < 256; t += nblk) gla_prepass_unit(p, l, t, smem);
      for (int t = 1024 + (bid + 96) % nblk; t < 1088; t += nblk) gla_prepass_unit1(p, l, t, smem);
      break;
    case 3:
#ifdef REP_SCAN
      for (int rep = 0; rep < REP_SCAN; ++rep)
#endif
      for (int t = bid; t < 256; t += nblk) { if (t < 128) scan_item<0>(p, l, t, smem); else scan_item<1>(p, l, t, smem); } break;
    case 4:
      if (l != 0) phase_u(p, l);
      phase_stats(p, l);
      break;
    case 5: {
      pg8::Gemm g{(const u16*)(p.ws + OFF_U), (const u16*)(p.ws + OFF_WT) + (size_t)WT_GATE * 1024, 1024, l == 0 ? MTOT : MLAT, 4096, 1024};
      pg8::StaticOrder S; S.init(g.M, g.N, nblk, bid);
      EpiGate E{(const u16*)(p.ws + OFF_RG), (const float*)(p.ws + OFF_STATS), (u16*)(p.ws + OFF_S), p.ret_norm_gain + l * 1024, p.gla_norm_gain + l * 1024};
      pg8::gemm_phase(lds, g, S, E, opaque_tid());
    } break;
    case 6: {
#pragma unroll 1
      for (int pass = 0; pass < 2; ++pass) {
        pg8::Gemm g{(const u16*)(p.ws + OFF_S) + 2048 + pass * 1024, (const u16*)(p.ws + OFF_WT) + (size_t)(WT_BRR + pass * 1024) * 1024, 4096, l == 0 ? MTOT : MLAT, 1024, 1024};
        pg8::StaticOrder S; S.init(g.M, g.N, nblk, bid);
        EpiMerge E{(const u16*)(p.ws + OFF_S), (u16*)(p.ws + OFF_U), pass};
        pg8::gemm_phase(lds, g, S, E, opaque_tid());
      }
    } break;
    case 7: {
      pg8::Gemm g{(const u16*)(p.ws + OFF_U), (const u16*)(p.ws + OFF_WT) + (size_t)WT_OUT * 1024, 1024, l == 0 ? MTOT : MLAT, 1024, 1024};
      pg8::StaticOrder S; S.init(g.M, g.N, nblk, bid);
      EpiOut E{l == 0 ? p.x : p.out, p.ctx, p.out, (float*)(p.ws + OFF_HCTX), (const float*)(p.ws + OFF_MOD) + (size_t)l * 9 * 3072};
      pg8::gemm_phase(lds, g, S, E, opaque_tid());
    } break;
  }
}

__device__ __forceinline__ void grid_barrier(unsigned* cnt, unsigned target) {
  asm volatile("s_waitcnt vmcnt(0)" ::: "memory");
  __syncthreads();
  if (threadIdx.x == 0) {
    __builtin_amdgcn_fence(__ATOMIC_RELEASE, "agent");
    asm volatile("s_waitcnt vmcnt(0)" ::: "memory");
    __hip_atomic_fetch_add(cnt, 1u, __ATOMIC_RELAXED, __HIP_MEMORY_SCOPE_AGENT);
    while (__hip_atomic_load(cnt, __ATOMIC_RELAXED, __HIP_MEMORY_SCOPE_AGENT) < target) __builtin_amdgcn_s_sleep(1);
    __builtin_amdgcn_fence(__ATOMIC_ACQUIRE, "agent");
    asm volatile("s_waitcnt vmcnt(0)" ::: "memory");
  }
  __syncthreads();
}

__global__ void __launch_bounds__(NTHREADS) mega(Params p, int ph_lo, int ph_hi, int coop) {
  extern __shared__ __attribute__((aligned(16))) char smem[];
  for (int ph = ph_lo; ph < ph_hi; ++ph) {
    run_phase(p, ph, smem);
    if (coop && ph + 1 < ph_hi) {
      if (ph == ph_lo) cg::this_grid().sync();
      else grid_barrier((unsigned*)(p.ws + OFF_BAR), (unsigned)(ph - ph_lo) * gridDim.x);
    }
  }
}

extern "C" void kernel_launch(void* const* d_in, const int* in_sizes, int n_in,
                              void* d_out, int out_size, void* d_ws, size_t ws_size,
                              hipStream_t stream) {
  Params p{};
  p.x = (const float*)d_in[0]; p.c = (const float*)d_in[1]; p.ctx = (const float*)d_in[2]; p.c_ctx = (const float*)d_in[3];
  p.norm_gain = (const float*)d_in[4]; p.w_ada = (const float*)d_in[5]; p.b_ada = (const float*)d_in[6]; p.w_in = (const float*)d_in[7];
  p.ret_decay = (const float*)d_in[8]; p.gla_w_up = (const float*)d_in[9]; p.gla_b_up = (const float*)d_in[10];
  p.ret_norm_gain = (const float*)d_in[11]; p.gla_norm_gain = (const float*)d_in[12];
  p.w_br_ret = (const float*)d_in[13]; p.w_br_gla = (const float*)d_in[14]; p.w_out = (const float*)d_in[15]; p.final_gain = (const float*)d_in[16];
  p.out = (float*)d_out; p.ws = (char*)d_ws;
  static int grid_blocks = 0;
  if (!grid_blocks) {
    hipFuncSetAttribute((const void*)mega, hipFuncAttributeMaxDynamicSharedMemorySize, LDS_BYTES);
    int dev = 0, cus = 0, per_cu = 0;
    hipGetDevice(&dev);
    hipDeviceGetAttribute(&cus, hipDeviceAttributeMultiprocessorCount, dev);
    hipOccupancyMaxActiveBlocksPerMultiprocessor(&per_cu, mega, NTHREADS, LDS_BYTES);
    if (per_cu < 1) per_cu = 1;
    grid_blocks = cus * 1;
  }
#ifdef MULTI_LAUNCH
  for (int ph = 0; ph < NPHASE; ++ph) {
    mega<<<dim3(grid_blocks), dim3(NTHREADS), LDS_BYTES, stream>>>(p, ph, ph + 1, 0);
  }
#else
  hipMemsetAsync((char*)d_ws + OFF_BAR, 0, 256, stream);
  int lo = 0, hi = NPHASE, coop = 1;
  void* args[] = {&p, &lo, &hi, &coop};
  hipError_t e = hipLaunchCooperativeKernel((void*)mega, dim3(grid_blocks), dim3(NTHREADS), args, LDS_BYTES, stream);
  if (e != hipSuccess) fprintf(stderr, "cooperative launch failed: %s (grid %d)\n", hipGetErrorString(e), grid_blocks);
#endif
}
```

```cpp
#include <hip/hip_runtime.h>
#include <hip/hip_cooperative_groups.h>
#include <cstdio>
namespace cg = cooperative_groups;

typedef unsigned short u16;
using bf16x8 = __attribute__((ext_vector_type(8))) short;
using bf16x4 = __attribute__((ext_vector_type(4))) short;
using f32x4  = __attribute__((ext_vector_type(4))) float;

#define NTHREADS 512
#define DM 1024
#define NB 8
#define SEQL 4096
#define CTXL 256
#define MLAT 32768
#define MCTX 2048
#define MTOT 34816
#define INW 8208

#define OFF_S    0ull
#define OFF_RG   (OFF_S   + (size_t)MTOT * 4096 * 2)
#define OFF_U    (OFF_RG  + (size_t)MTOT * 2048 * 2)
#define OFF_WT   (OFF_U   + (size_t)MTOT * 1024 * 2)
#define WT_ROWS  11392
#define OFF_GLR  (OFF_WT  + (size_t)WT_ROWS * 1024 * 2)
#define OFF_HCTX (OFF_GLR + (size_t)MTOT * 16 * 4)
#define OFF_MOD  (OFF_HCTX+ (size_t)MCTX * 1024 * 4)
#define OFF_ROT  (OFF_MOD + (size_t)2 * 9 * 3072 * 4)
#define OFF_BAR  (OFF_ROT + (size_t)64 * 32 * 2 * 4)
#define OFF_END  (OFF_BAR + 16384)

#define WT_SCAN 0
#define WT_GATE 4224
#define WT_BRR  8320
#define WT_BRG  9344
#define WT_OUT  10368

#define XB_LDS_OFF 161792
#define LDS_BYTES 161808
#define SCAN_GB   80896

struct Params {
  const float* x; const float* c; const float* ctx; const float* c_ctx;
  const float* norm_gain; const float* w_ada; const float* b_ada; const float* w_in;
  const float* ret_decay; const float* gla_w_up; const float* gla_b_up;
  const float* ret_norm_gain; const float* gla_norm_gain;
  const float* w_br_ret; const float* w_br_gla; const float* w_out; const float* final_gain;
  float* out; char* ws;
};

__device__ __forceinline__ u16 f2bf(float f) {
  __bf16 h = (__bf16)f;
  return *(u16*)&h;
}
__device__ __forceinline__ float bf2f(u16 h) { return __uint_as_float(((unsigned)h) << 16); }
__device__ __forceinline__ float sigmoidf_(float x) { return __builtin_amdgcn_rcpf(1.f + __expf(-x)); }
__device__ __forceinline__ float siluf_(float x) { return x * __builtin_amdgcn_rcpf(1.f + __expf(-x)); }

__device__ __forceinline__ int opaque_tid() { int t = threadIdx.x; asm volatile("" : "+v"(t)); return t; }

__device__ __forceinline__ float wave_sum(float v) {
#pragma unroll
  for (int o = 32; o > 0; o >>= 1) v += __shfl_xor(v, o, 64);
  return v;
}

__device__ __forceinline__ const float* wt_src(const Params& p, int l, int n, int& ld) {
  if (n < WT_GATE) {
    int tile = n >> 7, cc = n & 127;
    int col;
    if (tile < 8) {
      int d = (cc & 64) | ((cc & 16) << 1) | ((cc & 32) >> 1) | (cc & 15);
      col = tile * 128 + d;
    } else if (tile < 16) col = 1024 + (tile - 8) * 128 + cc;
    else if (tile < 24) col = 3072 + (tile - 16) * 128 + cc;
    else if (tile < 32) col = 4096 + (tile - 24) * 128 + cc;
    else { if (cc >= 16) { ld = 0; return nullptr; } col = 6144 + cc; }
    ld = INW; return p.w_in + (size_t)l * DM * INW + col;
  } else if (n < WT_BRR) {
    int g = n - WT_GATE; int col;
    if (g < 1024) col = 2048 + g;
    else if (g < 2048) col = 5120 + (g - 1024);
    else if (g < 3072) col = 6160 + (g - 2048);
    else col = 7184 + (g - 3072);
    ld = INW; return p.w_in + (size_t)l * DM * INW + col;
  } else if (n < WT_BRG) { ld = DM; return p.w_br_ret + (size_t)l * DM * DM + (n - WT_BRR); }
  else if (n < WT_OUT)   { ld = DM; return p.w_br_gla + (size_t)l * DM * DM + (n - WT_BRG); }
  else                   { ld = DM; return p.w_out    + (size_t)l * DM * DM + (n - WT_OUT); }
}

#define WT_UNITS (178 * 4)
__device__ __forceinline__ void wt_unit(const Params& p, int l, int unit, char* smem) {
  float* tile = (float*)smem;
  int nb = unit >> 2, kg = unit & 3;
  int tid = opaque_tid();
  int n0 = nb * 64, kbase = kg * 256;
  float v[4][8];
  {
    int nl = tid & 63, kq = tid >> 6;
    int ld; const float* src = wt_src(p, l, n0 + nl, ld);
#pragma unroll
    for (int q = 0; q < 4; ++q)
#pragma unroll
      for (int i = 0; i < 8; ++i) v[q][i] = src ? src[(size_t)(kbase + q * 64 + kq + 8 * i) * ld] : 0.f;
  }
  u16* wt = (u16*)(p.ws + OFF_WT);
#pragma unroll
  for (int q = 0; q < 4; ++q) {
    __syncthreads();
    {
      int nl = tid & 63, kq = tid >> 6;
#pragma unroll
      for (int i = 0; i < 8; ++i) tile[(kq + 8 * i) * 65 + nl] = v[q][i];
    }
    __syncthreads();
    {
      int nl = tid >> 3, kq = tid & 7;
      bf16x8 o;
#pragma unroll
      for (int j = 0; j < 8; ++j) o[j] = (short)f2bf(tile[(kq * 8 + j) * 65 + nl]);
      *(bf16x8*)(wt + (size_t)(n0 + nl) * 1024 + kbase + q * 64 + kq * 8) = o;
    }
  }
  __syncthreads();
}

__device__ __forceinline__ void mod_unit(const Params& p, int unit, char* smem) {
  float* sc = (float*)smem;
  float* red = sc + 9 * 1024;
  int l = unit / 48, jb = unit % 48;
  int tid = opaque_tid();
  for (int i = tid; i < 9 * 1024; i += NTHREADS) {
    int r = i >> 10, k = i & 1023;
    float v = (r < 8) ? p.c[r * 1024 + k] : p.c_ctx[k];
    sc[i] = siluf_(v);
  }
  __syncthreads();
  int jl = tid & 63, kg = tid >> 6;
  int j = jb * 64 + jl;
  float acc[9];
#pragma unroll
  for (int r = 0; r < 9; ++r) acc[r] = 0.f;
  const float* w = p.w_ada + (size_t)l * DM * 3072 + j;
#pragma unroll 16
  for (int k = kg * 128; k < kg * 128 + 128; ++k) {
    float wv = w[(size_t)k * 3072];
#pragma unroll
    for (int r = 0; r < 9; ++r) acc[r] += sc[r * 1024 + k] * wv;
  }
#pragma unroll
  for (int r = 0; r < 9; ++r) red[(kg * 9 + r) * 64 + jl] = acc[r];
  __syncthreads();
  float* mod = (float*)(p.ws + OFF_MOD);
  for (int i = tid; i < 9 * 64; i += NTHREADS) {
    int r = i >> 6, jj = i & 63;
    float s = 0.f;
#pragma unroll
    for (int g = 0; g < 8; ++g) s += red[(g * 9 + r) * 64 + jj];
    mod[((size_t)l * 9 + r) * 3072 + jb * 64 + jj] = s + p.b_ada[l * 3072 + jb * 64 + jj];
  }
  __syncthreads();
}

__device__ __forceinline__ void rot_unit(const Params& p) {
  float* rot = (float*)(p.ws + OFF_ROT);
  for (int i = opaque_tid(); i < 64 * 32; i += NTHREADS) {
    int pos = i >> 5, f = i & 31;
    float inv = exp2f(-(float)f * (13.287712379549449f / 32.f));
    float ang = (float)pos * inv;
    rot[i * 2] = __cosf(ang);
    rot[i * 2 + 1] = __sinf(ang);
  }
}

__device__ __forceinline__ void phase_u(const Params& p, int l) {
  const int tid = opaque_tid(); int wave = tid >> 6, lane = tid & 63;
  const float* mod = (const float*)(p.ws + OFF_MOD) + (size_t)l * 9 * 3072;
  const float* gain = p.norm_gain + l * DM;
  u16* U = (u16*)(p.ws + OFF_U);
  for (int row = (blockIdx.x * 8 + wave) * 4; row < MTOT; row += gridDim.x * 32) {
    const float* h; int r;
    if (row < MLAT) { h = (l == 0 ? p.x : p.out) + (size_t)row * DM; r = row >> 12; }
    else { int cr = row - MLAT; h = (l == 0 ? p.ctx : (const float*)(p.ws + OFF_HCTX)) + (size_t)cr * DM; r = 8; }
    float4 v[4][4]; float ss[4];
#pragma unroll
    for (int q = 0; q < 4; ++q) {
      ss[q] = 0.f;
#pragma unroll
      for (int i = 0; i < 4; ++i) v[q][i] = *(const float4*)(h + q * DM + i * 256 + lane * 4);
    }
#pragma unroll
    for (int q = 0; q < 4; ++q) {
#pragma unroll
      for (int i = 0; i < 4; ++i) ss[q] += v[q][i].x * v[q][i].x + v[q][i].y * v[q][i].y + v[q][i].z * v[q][i].z + v[q][i].w * v[q][i].w;
      ss[q] = rsqrtf(wave_sum(ss[q]) * (1.f / 1024.f) + 1e-6f);
    }
    const float* sh = mod + r * 3072;
#pragma unroll
    for (int i = 0; i < 4; ++i) {
      int cidx = i * 256 + lane * 4;
      float4 g = *(const float4*)(gain + cidx);
      float4 s = *(const float4*)(sh + cidx);
      float4 sc = *(const float4*)(sh + 1024 + cidx);
      g.x *= (1.f + sc.x); g.y *= (1.f + sc.y); g.z *= (1.f + sc.z); g.w *= (1.f + sc.w);
#pragma unroll
      for (int q = 0; q < 4; ++q) {
        bf16x4 o;
        o[0] = (short)f2bf(v[q][i].x * ss[q] * g.x + s.x);
        o[1] = (short)f2bf(v[q][i].y * ss[q] * g.y + s.y);
        o[2] = (short)f2bf(v[q][i].z * ss[q] * g.z + s.z);
        o[3] = (short)f2bf(v[q][i].w * ss[q] * g.w + s.w);
        *(bf16x4*)(U + (size_t)(row + q) * DM + cidx) = o;
      }
    }
  }
}

__device__ __forceinline__ void phase_final(const Params& p) {
  const int tid = opaque_tid(); int wave = tid >> 6, lane = tid & 63;
  for (int row = (blockIdx.x * 8 + wave) * 4; row < MLAT; row += gridDim.x * 32) {
    float* h = p.out + (size_t)row * DM;
    float4 v[4][4]; float ss[4];
#pragma unroll
    for (int q = 0; q < 4; ++q) {
      ss[q] = 0.f;
#pragma unroll
      for (int i = 0; i < 4; ++i) v[q][i] = *(const float4*)(h + q * DM + i * 256 + lane * 4);
    }
#pragma unroll
    for (int q = 0; q < 4; ++q) {
#pragma unroll
      for (int i = 0; i < 4; ++i) ss[q] += v[q][i].x * v[q][i].x + v[q][i].y * v[q][i].y + v[q][i].z * v[q][i].z + v[q][i].w * v[q][i].w;
      ss[q] = rsqrtf(wave_sum(ss[q]) * (1.f / 1024.f) + 1e-6f);
    }
#pragma unroll
    for (int i = 0; i < 4; ++i) {
      int cidx = i * 256 + lane * 4;
      float4 g = *(const float4*)(p.final_gain + cidx);
#pragma unroll
      for (int q = 0; q < 4; ++q) {
        float4 o;
        o.x = v[q][i].x * ss[q] * g.x; o.y = v[q][i].y * ss[q] * g.y; o.z = v[q][i].z * ss[q] * g.z; o.w = v[q][i].w * ss[q] * g.w;
        *(float4*)(h + q * DM + cidx) = o;
      }
    }
  }
}

#define PG8_LAS __attribute__((address_space(3)))
typedef unsigned u32x4 __attribute__((ext_vector_type(4)));
namespace pg8 {
constexpr int BM = 256, BK = 64, HALF = 128, HTB = HALF * BK * 2, STAGE_BYTES = 8 * HTB, NXCD = 8, WGM = 8;
__device__ __forceinline__ int lds_byte(int r, int c) { const int st = (r >> 4) * 2 + (c >> 5), rr = r & 15, cc = c & 31, ob = rr * 64 + cc * 2; return st * 1024 + (ob ^ (((ob >> 9) & 1) << 5)); }
__device__ __forceinline__ void stage_rc(int b, int& R, int& C) { const int st = b / 1024, sb = b % 1024, swz = sb ^ (((sb >> 9) & 1) << 5); R = (st >> 1) * 16 + swz / 64; C = (st & 1) * 32 + (swz % 64) / 2; }
__device__ __forceinline__ int perm32(int rho) { const int n = rho >> 4, i = rho & 15; return 8 * (i >> 2) + 4 * n + (i & 3); }
struct Unit { int pm, pn; };
struct Gemm { const u16* A; const u16* Bt; int lda; int M, N, K; };
struct StaticOrder {
  int nM, nN, nwg, G, c;
  __device__ void init(int M, int N, int G_, int c_) { nM = M / BM; nN = N / BM; nwg = nM * nN; G = G_; c = c_; }
  __device__ bool next(int i, Unit& u) const {
    const long L = (long)i * G + c; if (L >= nwg) return false;
    int wgid = (int)L; { const int q = nwg / NXCD, r = nwg % NXCD, xcd = wgid % NXCD, off = wgid / NXCD; wgid = (xcd < r ? xcd * (q + 1) : r * (q + 1) + (xcd - r) * q) + off; }
    const int nig = WGM * nN, gid = wgid / nig, fm = gid * WGM, gsz = (nM - fm) < WGM ? (nM - fm) : WGM;
    u.pm = fm + ((wgid % nig) % gsz); u.pn = (wgid % nig) / gsz; return true;
  }
};
typedef __attribute__((ext_vector_type(2))) float cvt_f2_t;
typedef __attribute__((ext_vector_type(2))) __bf16 cvt_b2_t;
__device__ __forceinline__ unsigned cvt_pk_bf16(float lo, float hi) { cvt_f2_t f = {lo, hi}; cvt_b2_t r = __builtin_convertvector(f, cvt_b2_t); return __builtin_bit_cast(unsigned, r); }

template <class Epi>
__device__ __forceinline__ void gemm_phase(PG8_LAS unsigned char* lds, const Gemm g, const StaticOrder& S, const Epi& E, const int tid) {
  const int wid = __builtin_amdgcn_readfirstlane(tid >> 6), lane = tid & 63, wr = wid >> 2, wc = wid & 3, fr = lane & 15, fq = lane >> 4;
  const int K = g.K, nt = K / BK;
  unsigned voffA[2], voffB[2];
#pragma unroll
  for (int i = 0; i < 2; ++i) { int R, C; stage_rc(tid * 16 + i * 8192, R, C); const int Rb = Epi::PERM ? ((R & ~31) + perm32(R & 31)) : R;
    voffA[i] = (unsigned)(R * g.lda + C) * 2u; voffB[i] = (unsigned)(Rb * K + C) * 2u; }
  const size_t kstep = (size_t)(BK * 2);
  const size_t hstepA = (size_t)HALF * g.lda * 2, hstepB = (size_t)HALF * K * 2;
  const size_t tstepA = 2 * hstepA, tstepB = 2 * hstepB;
  const unsigned ldsw = (unsigned)wid * 1024u;
  const int aoff = lds_byte(wr * 64 + fr, fq * 8), boff = lds_byte(wc * 32 + fr, fq * 8);
#define PG8_SA(b, h) (((b) * 2 + (h)) * HTB)
#define PG8_SB(b, h) ((4 + (b) * 2 + (h)) * HTB)
#define PG8_STAGE(bufoff, gbase, voff) do { _Pragma("unroll") for (int _i = 0; _i < 2; ++_i) \
    __builtin_amdgcn_global_load_lds((const unsigned*)((const char*)(gbase) + (voff)[_i]), (PG8_LAS unsigned*)(lds + (bufoff) + ldsw + _i * 8192), 16, 0, 0); } while (0)
#define PG8_LDA(dst, b, h) do { _Pragma("unroll") for (int m = 0; m < 4; ++m) _Pragma("unroll") for (int k = 0; k < 2; ++k) dst[m][k] = *(const PG8_LAS bf16x8*)(lds + PG8_SA(b, h) + aoff + m * 2048 + k * 1024); } while (0)
#define PG8_LDB(dst, b, h) do { _Pragma("unroll") for (int n = 0; n < 2; ++n) _Pragma("unroll") for (int k = 0; k < 2; ++k) dst[n][k] = *(const PG8_LAS bf16x8*)(lds + PG8_SB(b, h) + boff + n * 2048 + k * 1024); } while (0)
#define PG8_MMA(ai, bj, At, Bt) do { __builtin_amdgcn_s_setprio(1); _Pragma("unroll") for (int m = 0; m < 4; ++m) _Pragma("unroll") for (int n = 0; n < 2; ++n) _Pragma("unroll") for (int k = 0; k < 2; ++k) \
    acc[ai][bj][m][n] = __builtin_amdgcn_mfma_f32_16x16x32_bf16(Bt[n][k], At[m][k], acc[ai][bj][m][n], 0, 0, 0); __builtin_amdgcn_s_setprio(0); } while (0)
#define PG8_WAIT_V(n) asm volatile("s_waitcnt vmcnt(" #n ")" ::: "memory")
#define PG8_WAIT_L(n) asm volatile("s_waitcnt lgkmcnt(" #n ")" ::: "memory")
#define PG8_BAR __builtin_amdgcn_s_barrier()
#define PG8_SCHED __builtin_amdgcn_sched_barrier(0)
  Unit cur, nxt; int ui = 0;
  if (!S.next(0, cur)) return;
  f32x4 acc[2][2][4][2];
#pragma unroll
  for (int a = 0; a < 2; ++a)
#pragma unroll
    for (int b = 0; b < 2; ++b)
#pragma unroll
      for (int m = 0; m < 4; ++m)
#pragma unroll
        for (int n = 0; n < 2; ++n) acc[a][b][m][n] = (f32x4){0.f, 0.f, 0.f, 0.f};
  bf16x8 At[4][2], B0[2][2], B1[2][2];
  const char* cA = (const char*)g.A + (size_t)cur.pm * tstepA; const char* cB = (const char*)g.Bt + (size_t)cur.pn * tstepB;
  PG8_STAGE(PG8_SB(0, 0), cB, voffB); PG8_STAGE(PG8_SA(0, 0), cA, voffA); PG8_STAGE(PG8_SB(0, 1), cB + hstepB, voffB); PG8_STAGE(PG8_SA(0, 1), cA + hstepA, voffA);
  if (wr == 1) PG8_BAR;
  PG8_WAIT_V(4); PG8_BAR;
  PG8_STAGE(PG8_SB(1, 0), cB + kstep, voffB); PG8_STAGE(PG8_SA(1, 0), cA + kstep, voffA); PG8_STAGE(PG8_SB(1, 1), cB + hstepB + kstep, voffB);
  PG8_WAIT_V(6); PG8_BAR;
  for (;;) {
    const bool has_next = S.next(ui + 1, nxt);
    const char* nA = has_next ? (const char*)g.A + (size_t)nxt.pm * tstepA : cA; const char* nB = has_next ? (const char*)g.Bt + (size_t)nxt.pn * tstepB : cB;
    for (int t = 0; t < nt; t += 2) {
      const bool last = (t == nt - 2);
      const char* a1 = cA + (size_t)(t + 1) * kstep;
      const char* a2 = last ? nA : cA + (size_t)(t + 2) * kstep; const char* b2 = last ? nB : cB + (size_t)(t + 2) * kstep;
      const char* a3 = a2 + kstep; const char* b3 = b2 + kstep;
      PG8_LDB(B0, 0, 0); PG8_SCHED; PG8_LDA(At, 0, 0); PG8_STAGE(PG8_SA(1, 1), a1 + hstepA, voffA);
      PG8_WAIT_L(8); PG8_BAR; PG8_WAIT_L(0); PG8_MMA(0, 0, At, B0); PG8_BAR; PG8_SCHED;
      PG8_LDB(B1, 0, 1); PG8_STAGE(PG8_SB(0, 0), b2, voffB);
      PG8_BAR; PG8_WAIT_L(0); PG8_MMA(0, 1, At, B1); PG8_BAR;
      PG8_LDA(At, 0, 1); PG8_STAGE(PG8_SA(0, 0), a2, voffA);
      PG8_BAR; PG8_WAIT_L(0); PG8_MMA(1, 0, At, B0); PG8_BAR; PG8_SCHED;
      PG8_STAGE(PG8_SB(0, 1), b2 + hstepB, voffB);
      PG8_WAIT_V(6); PG8_BAR; PG8_MMA(1, 1, At, B1); PG8_BAR;
      PG8_LDB(B0, 1, 0); PG8_SCHED; PG8_LDA(At, 1, 0); PG8_STAGE(PG8_SA(0, 1), a2 + hstepA, voffA);
      PG8_WAIT_L(8); PG8_BAR; PG8_WAIT_L(0); PG8_MMA(0, 0, At, B0); PG8_BAR; PG8_SCHED;
      PG8_LDB(B1, 1, 1); PG8_STAGE(PG8_SB(1, 0), b3, voffB);
      PG8_BAR; PG8_WAIT_L(0); PG8_MMA(0, 1, At, B1); PG8_BAR;
      PG8_LDA(At, 1, 1); PG8_STAGE(PG8_SA(1, 0), a3, voffA);
      PG8_BAR; PG8_WAIT_L(0); PG8_MMA(1, 0, At, B0); PG8_BAR; PG8_SCHED;
      PG8_STAGE(PG8_SB(1, 1), b3 + hstepB, voffB);
      PG8_WAIT_V(6); PG8_BAR; PG8_MMA(1, 1, At, B1); PG8_BAR;
    }
    E(acc, cur, wr, wc, fr, fq, lane);
    if (!has_next) break;
#pragma unroll
    for (int a = 0; a < 2; ++a)
#pragma unroll
      for (int b = 0; b < 2; ++b)
#pragma unroll
        for (int m = 0; m < 4; ++m)
#pragma unroll
          for (int n = 0; n < 2; ++n) acc[a][b][m][n] = (f32x4){0.f, 0.f, 0.f, 0.f};
    cur = nxt; cA = nA; cB = nB; ++ui;
  }
  PG8_WAIT_V(0);
  if (wr == 0) PG8_BAR;
  PG8_BAR;
#undef PG8_SA
#undef PG8_SB
#undef PG8_STAGE
#undef PG8_LDA
#undef PG8_LDB
#undef PG8_MMA
#undef PG8_WAIT_V
#undef PG8_WAIT_L
#undef PG8_BAR
#undef PG8_SCHED
}
}

#define OFF_STATS OFF_GLR

__device__ __forceinline__ u32x4 pack8v(const f32x4& a, const f32x4& b) {
  u32x4 w; w.x = pg8::cvt_pk_bf16(a[0], a[1]); w.y = pg8::cvt_pk_bf16(a[2], a[3]); w.z = pg8::cvt_pk_bf16(b[0], b[1]); w.w = pg8::cvt_pk_bf16(b[2], b[3]); return w;
}
__device__ __forceinline__ float xlane32(float v, int lane) { return __int_as_float(__builtin_amdgcn_ds_bpermute((lane ^ 32) << 2, __float_as_int(v))); }

struct EpiScanIn {
  static constexpr bool PERM = true;
  u16* S; const float* rot;
  __device__ __forceinline__ void operator()(const f32x4 (&acc)[2][2][4][2], const pg8::Unit& u, int wr, int wc, int fr, int fq, int lane) const {
    u16* Sb = S + (size_t)u.pm * 256 * 4096;
    unsigned rl0 = wr * 64 + fr; asm volatile("" : "+v"(rl0));
#pragma unroll
    for (int bj = 0; bj < 2; ++bj) {
      const int nt128 = u.pn * 2 + bj;
      const bool scaled = (nt128 < 4) || (nt128 >= 16 && nt128 < 20);
      const float scl = scaled ? 0.08838834764831845f : 1.f;
      const unsigned cb = nt128 * 128 + wc * 32 + fq * 8;
      if (nt128 < 8 && u.pm < 128) {
        const int tb = (u.pm & 15) * 256;
        const int fo = ((wc & 1) * 16 + (fq & 1) * 8) * 2;
        const float sgn = (fq >> 1) ? 1.f : -1.f;
#pragma unroll
        for (int ai = 0; ai < 2; ++ai)
#pragma unroll
          for (int m = 0; m < 4; ++m) {
            const unsigned rl = rl0 + ai * 128 + m * 16;
            const int t = tb + rl;
            const unsigned pos = (wc >> 1) == 0 ? (t >> 6) : (t & 63);
            const float* rp = rot + pos * 64u + fo;
            const float4 c0 = *(const float4*)rp, c1 = *(const float4*)(rp + 4), c2 = *(const float4*)(rp + 8), c3 = *(const float4*)(rp + 12);
            const f32x4 v0 = acc[ai][bj][m][0], v1 = acc[ai][bj][m][1];
            f32x4 p0, p1;
#pragma unroll
            for (int j = 0; j < 4; ++j) { p0[j] = xlane32(v0[j], lane); p1[j] = xlane32(v1[j], lane); }
            f32x4 o0, o1;
            o0[0] = (v0[0] * c0.x + sgn * p0[0] * c0.y) * scl; o0[1] = (v0[1] * c0.z + sgn * p0[1] * c0.w) * scl;
            o0[2] = (v0[2] * c1.x + sgn * p0[2] * c1.y) * scl; o0[3] = (v0[3] * c1.z + sgn * p0[3] * c1.w) * scl;
            o1[0] = (v1[0] * c2.x + sgn * p1[0] * c2.y) * scl; o1[1] = (v1[1] * c2.z + sgn * p1[1] * c2.w) * scl;
            o1[2] = (v1[2] * c3.x + sgn * p1[2] * c3.y) * scl; o1[3] = (v1[3] * c3.z + sgn * p1[3] * c3.w) * scl;
            *(u32x4*)(Sb + rl * 4096u + cb) = pack8v(o0, o1);
            __builtin_amdgcn_sched_barrier(0);
          }
      } else {
#pragma unroll
        for (int ai = 0; ai < 2; ++ai)
#pragma unroll
          for (int m = 0; m < 4; ++m) {
            const unsigned rl = rl0 + ai * 128 + m * 16;
            *(u32x4*)(Sb + rl * 4096u + cb) = pack8v(acc[ai][bj][m][0] * scl, acc[ai][bj][m][1] * scl);
            __builtin_amdgcn_sched_barrier(0);
          }
      }
    }
  }
};

struct EpiGate {
  static constexpr bool PERM = true;
  const u16* RG; const float* stats; u16* S; const float* rgain; const float* ggain;
  __device__ __forceinline__ void operator()(const f32x4 (&acc)[2][2][4][2], const pg8::Unit& u, int wr, int wc, int fr, int fq, int lane) const {
    u16* Sb = S + (size_t)u.pm * 256 * 4096;
    unsigned rl0 = wr * 64 + fr; asm volatile("" : "+v"(rl0));
    if (u.pn < 8) {
      const int branch = u.pn >> 2, head = u.pn & 3;
      const u16* RGb = RG + (size_t)u.pm * 256 * 2048 + branch * 1024;
      const float* stb = stats + (size_t)u.pm * 256 * 16 + (branch * 4 + head) * 2;
      const float* gain = branch ? ggain : rgain;
#pragma unroll
      for (int bj = 0; bj < 2; ++bj) {
        const unsigned cb = head * 256 + bj * 128 + wc * 32 + fq * 8;
        const float4 g0 = *(const float4*)(gain + cb), g1 = *(const float4*)(gain + cb + 4);
#pragma unroll
        for (int ai = 0; ai < 2; ++ai)
#pragma unroll
          for (int m = 0; m < 4; ++m) {
            const unsigned rl = rl0 + ai * 128 + m * 16;
            const float2 st = *(const float2*)(stb + rl * 16u);
            const bf16x8 xr = *(const bf16x8*)(RGb + rl * 2048u + cb);
            f32x4 v0 = acc[ai][bj][m][0], v1 = acc[ai][bj][m][1];
            asm volatile("" : "+v"(v0), "+v"(v1));
            f32x4 o0, o1;
            o0[0] = (bf2f((u16)xr[0]) * st.x + st.y) * g0.x * siluf_(v0[0]); o0[1] = (bf2f((u16)xr[1]) * st.x + st.y) * g0.y * siluf_(v0[1]);
            o0[2] = (bf2f((u16)xr[2]) * st.x + st.y) * g0.z * siluf_(v0[2]); o0[3] = (bf2f((u16)xr[3]) * st.x + st.y) * g0.w * siluf_(v0[3]);
            o1[0] = (bf2f((u16)xr[4]) * st.x + st.y) * g1.x * siluf_(v1[0]); o1[1] = (bf2f((u16)xr[5]) * st.x + st.y) * g1.y * siluf_(v1[1]);
            o1[2] = (bf2f((u16)xr[6]) * st.x + st.y) * g1.z * siluf_(v1[2]); o1[3] = (bf2f((u16)xr[7]) * st.x + st.y) * g1.w * siluf_(v1[3]);
            *(u32x4*)(Sb + rl * 4096u + 2048u + branch * 1024 + cb) = pack8v(o0, o1);
            __builtin_amdgcn_sched_barrier(0);
          }
      }
    } else {
#pragma unroll
      for (int bj = 0; bj < 2; ++bj) {
        const unsigned cb = (u.pn - 8) * 256 + bj * 128 + wc * 32 + fq * 8;
#pragma unroll
        for (int ai = 0; ai < 2; ++ai)
#pragma unroll
          for (int m = 0; m < 4; ++m) {
            const unsigned rl = rl0 + ai * 128 + m * 16;
            f32x4 v0 = acc[ai][bj][m][0], v1 = acc[ai][bj][m][1];
            asm volatile("" : "+v"(v0), "+v"(v1));
            f32x4 o0, o1;
#pragma unroll
            for (int j = 0; j < 4; ++j) { o0[j] = sigmoidf_(v0[j]); o1[j] = sigmoidf_(v1[j]); }
            *(u32x4*)(Sb + rl * 4096u + cb) = pack8v(o0, o1);
            __builtin_amdgcn_sched_barrier(0);
          }
      }
    }
  }
};

struct EpiMerge {
  static constexpr bool PERM = true;
  const u16* S; u16* MG; int pass;
  __device__ __forceinline__ void operator()(const f32x4 (&acc)[2][2][4][2], const pg8::Unit& u, int wr, int wc, int fr, int fq, int lane) const {
    const u16* Sb = S + (size_t)u.pm * 256 * 4096 + pass * 1024;
    u16* MGb = MG + (size_t)u.pm * 256 * 1024;
    unsigned rl0 = wr * 64 + fr; asm volatile("" : "+v"(rl0));
#pragma unroll
    for (int bj = 0; bj < 2; ++bj) {
      const unsigned cb = u.pn * 256 + bj * 128 + wc * 32 + fq * 8;
#pragma unroll
      for (int ai = 0; ai < 2; ++ai)
#pragma unroll
        for (int m = 0; m < 4; ++m) {
          const unsigned rl = rl0 + ai * 128 + m * 16;
          const bf16x8 gt = *(const bf16x8*)(Sb + rl * 4096u + cb);
          f32x4 o0 = acc[ai][bj][m][0], o1 = acc[ai][bj][m][1];
#pragma unroll
          for (int j = 0; j < 4; ++j) { o0[j] *= bf2f((u16)gt[j]); o1[j] *= bf2f((u16)gt[4 + j]); }
          if (pass) {
            const bf16x8 old = *(const bf16x8*)(MGb + rl * 1024u + cb);
#pragma unroll
            for (int j = 0; j < 4; ++j) { o0[j] += bf2f((u16)old[j]); o1[j] += bf2f((u16)old[4 + j]); }
          }
          *(u32x4*)(MGb + rl * 1024u + cb) = pack8v(o0, o1);
            __builtin_amdgcn_sched_barrier(0);
        }
    }
  }
};

struct EpiOut {
  static constexpr bool PERM = false;
  const float* x_lat; const float* x_ctx; float* o_lat; float* o_ctx; const float* mod;
  __device__ __forceinline__ void operator()(const f32x4 (&acc)[2][2][4][2], const pg8::Unit& u, int wr, int wc, int fr, int fq, int lane) const {
    const float* hin; float* hout; int rmod;
    if (u.pm < 128) { hin = x_lat + (size_t)u.pm * 256 * DM; hout = o_lat + (size_t)u.pm * 256 * DM; rmod = u.pm >> 4; }
    else { hin = x_ctx + (size_t)(u.pm - 128) * 256 * DM; hout = o_ctx + (size_t)(u.pm - 128) * 256 * DM; rmod = 8; }
    const float* gate = mod + rmod * 3072 + 2048;
    unsigned rl0 = wr * 64 + fr; asm volatile("" : "+v"(rl0));
#pragma unroll
    for (int bj = 0; bj < 2; ++bj)
#pragma unroll
      for (int n = 0; n < 2; ++n) {
        const unsigned cb = u.pn * 256 + bj * 128 + wc * 32 + n * 16 + fq * 4;
        const float4 g = *(const float4*)(gate + cb);
#pragma unroll
        for (int ai = 0; ai < 2; ++ai)
#pragma unroll
          for (int m = 0; m < 4; ++m) {
            const unsigned o = (rl0 + ai * 128 + m * 16) * 1024u + cb;
            const float4 h = *(const float4*)(hin + o);
            const f32x4 v = acc[ai][bj][m][n];
            *(float4*)(hout + o) = make_float4(h.x + g.x * v[0], h.y + g.y * v[1], h.z + g.z * v[2], h.w + g.w * v[3]);
          }
      }
  }
};

__device__ __forceinline__ void phase_stats(const Params& p, int l) {
  const int tid = opaque_tid(); const int wave = tid >> 6, lane = tid & 63;
  const u16* RG = (const u16*)(p.ws + OFF_RG);
  float* ST = (float*)(p.ws + OFF_STATS);
  const int nrows = (l == 0) ? MTOT : MLAT;
  for (int row = (blockIdx.x * 8 + wave) * 4; row < nrows; row += gridDim.x * 32) {
    bf16x8 v[4][4];
#pragma unroll
    for (int q = 0; q < 4; ++q)
#pragma unroll
      for (int i = 0; i < 4; ++i) v[q][i] = *(const bf16x8*)(RG + (size_t)(row + q) * 2048 + i * 512 + lane * 8);
#pragma unroll
    for (int q = 0; q < 4; ++q)
#pragma unroll
      for (int i = 0; i < 4; ++i) {
        float s1 = 0.f, s2 = 0.f;
#pragma unroll
        for (int x = 0; x < 8; ++x) { float a = bf2f((u16)v[q][i][x]); s1 += a; s2 += a * a; }
#pragma unroll
        for (int o = 16; o > 0; o >>= 1) {
          s1 += __int_as_float(__builtin_amdgcn_ds_bpermute((lane ^ o) << 2, __float_as_int(s1)));
          s2 += __int_as_float(__builtin_amdgcn_ds_bpermute((lane ^ o) << 2, __float_as_int(s2)));
        }
        float sa, sb;
        if ((i >> 1) == 0) { float mu = s1 * (1.f / 256.f); float var = fmaxf(s2 * (1.f / 256.f) - mu * mu, 0.f); sa = rsqrtf(var + 1e-6f); sb = -mu * sa; }
        else { sa = rsqrtf(s2 * (1.f / 256.f) + 1e-6f); sb = 0.f; }
        if ((lane & 31) == 0) *(float2*)(ST + ((size_t)(row + q) * 8 + (i >> 1) * 4 + 2 * (i & 1) + (lane >> 5)) * 2) = make_float2(sa, sb);
      }
  }
}

#define OFF_VECS OFF_WT
__device__ __forceinline__ float logsig16(float x) { return (fminf(x, 0.f) - __logf(1.f + __expf(-fabsf(x)))) * (1.f / 16.f); }

typedef __attribute__((ext_vector_type(2))) float f32x2_t;

template <int SW>
__device__ __forceinline__ void prepass_sweep4(const float* GLRS, const f32x2_t (&w2)[4][16], const f32x2_t (&b2)[4], u16* Sq, u16* Ub,
                                               float (&accF)[4], float (&accB)[4]) {
#pragma unroll
  for (int c = 0; c < 4; ++c) { accF[c] = 0.f; accB[c] = 0.f; }
#pragma unroll 2
  for (int u = 0; u < 32; ++u) {
    const int i = SW ? 32 + u : 31 - u;
    const bf16x4 q4 = *(const bf16x4*)(Sq + (unsigned)i * 4096u);
    const bf16x4 k4 = *(const bf16x4*)(Sq + (unsigned)i * 4096u + 512u);
    const float4* gr = (const float4*)(GLRS + (i & 31) * 16);
    const float4 g0 = gr[0], g1 = gr[1], g2 = gr[2], g3 = gr[3];
    bf16x4 oqf, okf, oqb, okb;
#pragma unroll
    for (int c = 0; c < 4; ++c) {
      f32x2_t x = b2[c];
      x = w2[c][0] * g0.x + x;  x = w2[c][1] * g0.y + x;  x = w2[c][2] * g0.z + x;  x = w2[c][3] * g0.w + x;
      x = w2[c][4] * g1.x + x;  x = w2[c][5] * g1.y + x;  x = w2[c][6] * g1.z + x;  x = w2[c][7] * g1.w + x;
      x = w2[c][8] * g2.x + x;  x = w2[c][9] * g2.y + x;  x = w2[c][10] * g2.z + x; x = w2[c][11] * g2.w + x;
      x = w2[c][12] * g3.x + x; x = w2[c][13] * g3.y + x; x = w2[c][14] * g3.z + x; x = w2[c][15] * g3.w + x;
      const float laf = logsig16(x.x), lab = logsig16(x.y);
      float relf, relb;
      if (SW == 0) { relf = -accF[c]; accF[c] += laf; accB[c] += lab; relb = accB[c]; }
      else         { accF[c] += laf; relf = accF[c]; relb = -accB[c]; accB[c] += lab; }
      const float q = bf2f((u16)q4[c]), k = bf2f((u16)k4[c]);
      oqf[c] = (short)f2bf(q * __expf(relf)); okf[c] = (short)f2bf(k * __expf(-relf));
      oqb[c] = (short)f2bf(q * __expf(relb)); okb[c] = (short)f2bf(k * __expf(-relb));
    }
    *(bf16x4*)(Sq + (unsigned)i * 4096u) = oqf;
    *(bf16x4*)(Sq + (unsigned)i * 4096u + 512u) = okf;
    *(bf16x4*)(Ub + (unsigned)i * 1024u) = oqb;
    *(bf16x4*)(Ub + (unsigned)i * 1024u + 512u) = okb;
  }
}

__device__ __forceinline__ void gla_prepass_unit(const Params& p, int l, int bunit, char* smem) {
  const int tid = opaque_tid();
  const int ul = __builtin_amdgcn_readfirstlane(tid >> 7);
  const int gu = bunit * 4 + ul;
  const int sw = gu & 1, ch = gu >> 1;
  const int b = ch / 68, cid = ch % 68;
  const int base = cid < 4 ? (MLAT + b * 256 + cid * 64) : (b * 4096 + (cid - 4) * 64);
  float* GLRS = (float*)smem + ul * 512;
  const int col0 = (tid & 127) * 4;
  __syncthreads();
  {
    const int uw = (tid >> 6) & 1, lane = tid & 63, fr = lane & 15, fq = lane >> 4;
    f32x4 g = (f32x4){0.f, 0.f, 0.f, 0.f};
    const u16* Ua = (const u16*)(p.ws + OFF_U) + (size_t)(base + sw * 32 + uw * 16 + fr) * 1024 + fq * 8;
    const u16* Wb = (const u16*)(p.ws + OFF_WT) + (size_t)(4096 + fr) * 1024 + fq * 8;
#pragma unroll 16
    for (int k = 0; k < 1024; k += 32) {
      bf16x8 a = *(const bf16x8*)(Ua + k);
      bf16x8 w = *(const bf16x8*)(Wb + k);
      g = __builtin_amdgcn_mfma_f32_16x16x32_bf16(a, w, g, 0, 0, 0);
    }
#pragma unroll
    for (int j = 0; j < 4; ++j) GLRS[(uw * 16 + fq * 4 + j) * 16 + fr] = g[j];
  }
  f32x2_t w2[4][16], b2[4];
  {
    const float* w0 = p.gla_w_up + (size_t)(l * 2 + 0) * 16 * 512 + col0;
    const float* w1 = p.gla_w_up + (size_t)(l * 2 + 1) * 16 * 512 + col0;
#pragma unroll
    for (int r = 0; r < 16; ++r) {
      const float4 a = *(const float4*)(w0 + r * 512), c = *(const float4*)(w1 + r * 512);
      w2[0][r].x = a.x; w2[1][r].x = a.y; w2[2][r].x = a.z; w2[3][r].x = a.w;
      w2[0][r].y = c.x; w2[1][r].y = c.y; w2[2][r].y = c.z; w2[3][r].y = c.w;
    }
    const float4 a = *(const float4*)(p.gla_b_up + (l * 2 + 0) * 512 + col0), c = *(const float4*)(p.gla_b_up + (l * 2 + 1) * 512 + col0);
    b2[0].x = a.x; b2[1].x = a.y; b2[2].x = a.z; b2[3].x = a.w;
    b2[0].y = c.x; b2[1].y = c.y; b2[2].y = c.z; b2[3].y = c.w;
  }
  __syncthreads();
  u16* Sq = (u16*)(p.ws + OFF_S) + (size_t)base * 4096 + 2048 + col0;
  u16* Ub = (l == 0 ? (u16*)p.out : (u16*)(p.ws + OFF_U)) + (size_t)base * 1024 + col0;
  float* V0 = (float*)(p.ws + OFF_VECS) + ((size_t)(0 * 544 + b * 68 + cid) * 2) * 512 + col0;
  float* V1 = (float*)(p.ws + OFF_VECS) + ((size_t)(1 * 544 + b * 68 + cid) * 2) * 512 + col0;
  float accF[4], accB[4];
  if (sw == 0) {
    prepass_sweep4<0>(GLRS, w2, b2, Sq, Ub, accF, accB);
    *(float4*)(V0) = make_float4(__expf(accF[0]), __expf(accF[1]), __expf(accF[2]), __expf(accF[3]));
    *(float4*)(V1 + 512) = make_float4(__expf(accB[0]), __expf(accB[1]), __expf(accB[2]), __expf(accB[3]));
  } else {
    prepass_sweep4<1>(GLRS, w2, b2, Sq, Ub, accF, accB);
    *(float4*)(V0 + 512) = make_float4(__expf(accF[0]), __expf(accF[1]), __expf(accF[2]), __expf(accF[3]));
    *(float4*)(V1) = make_float4(__expf(accB[0]), __expf(accB[1]), __expf(accB[2]), __expf(accB[3]));
  }
}

template <int SW>
__device__ __forceinline__ void prepass_sweep(const float* GLRS, const f32x2_t (&w2)[16], f32x2_t b2, u16* Sq, u16* Ub, float& accF, float& accB) {
  accF = 0.f; accB = 0.f;
#pragma unroll 16
  for (int u = 0; u < 32; ++u) {
    const int i = SW ? 32 + u : 31 - u;
    const float4* gr = (const float4*)(GLRS + i * 16);
    const float4 g0 = gr[0], g1 = gr[1], g2 = gr[2], g3 = gr[3];
    f32x2_t x = b2;
    x = w2[0] * g0.x + x;  x = w2[1] * g0.y + x;  x = w2[2] * g0.z + x;  x = w2[3] * g0.w + x;
    x = w2[4] * g1.x + x;  x = w2[5] * g1.y + x;  x = w2[6] * g1.z + x;  x = w2[7] * g1.w + x;
    x = w2[8] * g2.x + x;  x = w2[9] * g2.y + x;  x = w2[10] * g2.z + x; x = w2[11] * g2.w + x;
    x = w2[12] * g3.x + x; x = w2[13] * g3.y + x; x = w2[14] * g3.z + x; x = w2[15] * g3.w + x;
    const float laf = logsig16(x.x), lab = logsig16(x.y);
    float relf, relb;
    if (SW == 0) { relf = -accF; accF += laf; accB += lab; relb = accB; }
    else         { accF += laf; relf = accF; relb = -accB; accB += lab; }
    const float q = bf2f(Sq[(unsigned)i * 4096u]), k = bf2f(Sq[(unsigned)i * 4096u + 512u]);
    Sq[(unsigned)i * 4096u] = f2bf(q * __expf(relf));
    Sq[(unsigned)i * 4096u + 512u] = f2bf(k * __expf(-relf));
    Ub[(unsigned)i * 1024u] = f2bf(q * __expf(relb));
    Ub[(unsigned)i * 1024u + 512u] = f2bf(k * __expf(-relb));
  }
}

__device__ __forceinline__ void gla_prepass_unit1(const Params& p, int l, int unit, char* smem) {
  const int tid = opaque_tid();
  const int sw = unit & 1, ch = unit >> 1;
  const int b = ch / 68, cid = ch % 68;
  const int base = cid < 4 ? (MLAT + b * 256 + cid * 64) : (b * 4096 + (cid - 4) * 64);
  float* GLRS = (float*)smem;
  __syncthreads();
  {
    const int wid = tid >> 6, lane = tid & 63, fr = lane & 15, fq = lane >> 4;
    if (wid < 2) {
      const int r0 = sw * 32 + wid * 16;
      f32x4 g = (f32x4){0.f, 0.f, 0.f, 0.f};
      const u16* Ua = (const u16*)(p.ws + OFF_U) + (size_t)(base + r0 + fr) * 1024 + fq * 8;
      const u16* Wb = (const u16*)(p.ws + OFF_WT) + (size_t)(4096 + fr) * 1024 + fq * 8;
#pragma unroll 16
      for (int k = 0; k < 1024; k += 32) {
        bf16x8 a = *(const bf16x8*)(Ua + k);
        bf16x8 w = *(const bf16x8*)(Wb + k);
        g = __builtin_amdgcn_mfma_f32_16x16x32_bf16(a, w, g, 0, 0, 0);
      }
#pragma unroll
      for (int j = 0; j < 4; ++j) GLRS[(r0 + fq * 4 + j) * 16 + fr] = g[j];
    }
  }
  f32x2_t w2[16];
  {
    const float* w0 = p.gla_w_up + (size_t)(l * 2 + 0) * 16 * 512 + tid;
    const float* w1 = p.gla_w_up + (size_t)(l * 2 + 1) * 16 * 512 + tid;
#pragma unroll
    for (int r = 0; r < 16; ++r) { w2[r].x = w0[r * 512]; w2[r].y = w1[r * 512]; }
  }
  f32x2_t b2; b2.x = p.gla_b_up[(l * 2 + 0) * 512 + tid]; b2.y = p.gla_b_up[(l * 2 + 1) * 512 + tid];
  __syncthreads();
  u16* Sq = (u16*)(p.ws + OFF_S) + (size_t)base * 4096 + 2048 + tid;
  u16* Ub = (l == 0 ? (u16*)p.out : (u16*)(p.ws + OFF_U)) + (size_t)base * 1024 + tid;
  float* V0 = (float*)(p.ws + OFF_VECS) + ((size_t)(0 * 544 + b * 68 + cid) * 2) * 512 + tid;
  float* V1 = (float*)(p.ws + OFF_VECS) + ((size_t)(1 * 544 + b * 68 + cid) * 2) * 512 + tid;
  float accF, accB;
  if (sw == 0) {
    prepass_sweep<0>(GLRS, w2, b2, Sq, Ub, accF, accB);
    V0[0] = __expf(accF);
    V1[512] = __expf(accB);
  } else {
    prepass_sweep<1>(GLRS, w2, b2, Sq, Ub, accF, accB);
    V0[512] = __expf(accF);
    V1[0] = __expf(accB);
  }
}

#define L_QR   0
#define L_KR   17408
#define L_V    34816
#define L_SGT  44032
#define L_P    61440
#undef  SCAN_GB
#define SCAN_GB 70656

__device__ __forceinline__ int off128(int row, int col) { return row * 272 + col * 2; }
__device__ __forceinline__ int off64(int row, int col) { return row * 144 + col * 2; }

template <int RS>
__device__ __forceinline__ bf16x8 tr_frag(unsigned img_addr, int r0, int c0, int lane) {
  const int g = lane >> 4, q = (lane & 15) >> 2, pp = lane & 3;
  unsigned a = img_addr + (unsigned)((r0 + 8 * g + q) * RS + (c0 + 4 * pp) * 2);
  bf16x4 lo, hi;
  asm volatile("ds_read_b64_tr_b16 %0, %2\n\tds_read_b64_tr_b16 %1, %2 offset:%3\n\ts_waitcnt lgkmcnt(0)"
               : "=&v"(lo), "=&v"(hi) : "v"(a), "n"(4 * RS) : "memory");
  bf16x8 r;
  r[0] = lo[0]; r[1] = lo[1]; r[2] = lo[2]; r[3] = lo[3]; r[4] = hi[0]; r[5] = hi[1]; r[6] = hi[2]; r[7] = hi[3];
  return r;
}

__device__ __forceinline__ bf16x8 scale8(bf16x8 v, float f) {
  bf16x8 o;
#pragma unroll
  for (int x = 0; x < 8; ++x) o[x] = (short)f2bf(bf2f((u16)v[x]) * f);
  return o;
}

__device__ __forceinline__ void lds_barrier() { asm volatile("s_waitcnt lgkmcnt(0)" ::: "memory"); __builtin_amdgcn_s_barrier(); asm volatile("" ::: "memory"); }

template <int branch>
__device__ __forceinline__ void scan_item(const Params& p, int l, int item, char* smem) {
  const int b = (item >> 4) & 7, h = (item >> 2) & 3, slice = item & 3;
  const int tid = opaque_tid(), wid = __builtin_amdgcn_readfirstlane(tid >> 6), lane = tid & 63;
  const int dir = wid >> 2, gw = wid & 3, gt = tid & 255;
  const int fr = lane & 15, fq = lane >> 4;
  char* G = smem + dir * SCAN_GB;
  const unsigned Ga = (unsigned)(size_t)G;
  const u16* S = (const u16*)(p.ws + OFF_S);
  u16* RG = (u16*)(p.ws + OFF_RG);
  const u16* qsrc; unsigned qstride;
  if (branch == 0) { qsrc = S + h * 128; qstride = 4096; }
  else if (dir == 0) { qsrc = S + 2048 + h * 128; qstride = 4096; }
  else { qsrc = (l == 0 ? (const u16*)p.out : (const u16*)(p.ws + OFF_U)) + h * 128; qstride = 1024; }
  const int voff = branch * 2048 + 1024 + h * 256 + slice * 64;
  const int ooff = branch * 1024 + h * 256 + slice * 64;
  float lg = 0.f, egc = 1.f;
  if (branch == 0) { lg = __logf(1.f - __expf(p.ret_decay[(l * 2 + dir) * 4 + h])); egc = __expf(32.f * lg); }
  const float* VECS = (const float*)(p.ws + OFF_VECS) + ((size_t)(dir * 544 + b * 68) * 2) * 512 + h * 128;
  f32x4 st[2][4];
#pragma unroll
  for (int m = 0; m < 2; ++m)
#pragma unroll
    for (int n = 0; n < 4; ++n) st[m][n] = (f32x4){0.f, 0.f, 0.f, 0.f};

  const int qj = gt >> 4, qc = gt & 15;
  const int vj = gt >> 3, vc = gt & 7;
  bf16x8 pq[4], pk[4], pv[2];
  float4 peg[2], pel[2];
  auto prefetch = [&](int s) {
    int base, cid;
    if (s < 4) { int cc = dir ? 3 - s : s; base = MLAT + b * 256 + cc * 64; cid = cc; }
    else { int c = s - 4; int cc = dir ? 63 - c : c; base = b * 4096 + cc * 64; cid = 4 + cc; }
#pragma unroll
    for (int i = 0; i < 4; ++i) {
      int jp = qj + 16 * i;
      unsigned ro = (unsigned)(base + (dir ? 63 - jp : jp)) * qstride + qc * 8;
      pq[i] = *(const bf16x8*)(qsrc + ro);
      pk[i] = *(const bf16x8*)(qsrc + ro + 512);
    }
#pragma unroll
    for (int i = 0; i < 2; ++i) {
      int jp = vj + 32 * i;
      pv[i] = *(const bf16x8*)(S + (size_t)(base + (dir ? 63 - jp : jp)) * 4096 + voff + vc * 8);
    }
    if (branch == 1) {
#pragma unroll
      for (int m = 0; m < 2; ++m) {
        int d0 = gw * 32 + m * 16 + fq * 4;
        peg[m] = *(const float4*)(VECS + (size_t)cid * 1024 + d0);
        pel[m] = *(const float4*)(VECS + (size_t)cid * 1024 + 512 + d0);
      }
    }
  };
  prefetch(0);
  __syncthreads();

  for (int s = 0; s < 68; ++s) {
    int base; bool first; bool wout;
    if (s < 4) { int cc = dir ? 3 - s : s; base = MLAT + b * 256 + cc * 64; first = s < 2; wout = (l == 0); }
    else { int c = s - 4; int cc = dir ? 63 - c : c; base = b * 4096 + cc * 64; first = c < 32; wout = true; }
    float4 eg[2], el[2];
#pragma unroll
    for (int m = 0; m < 2; ++m) {
      if (branch == 1) { eg[m] = peg[m]; el[m] = pel[m]; }
      else { eg[m] = make_float4(egc, egc, egc, egc); el[m] = eg[m]; }
    }
#pragma unroll
    for (int i = 0; i < 4; ++i) {
      int jp = qj + 16 * i;
      bf16x8 qv = pq[i], kv_ = pk[i];
      if (branch == 0) {
        float fqs = __expf((float)(jp - 31) * lg), fks = __expf((float)(31 - jp) * lg);
        qv = scale8(qv, fqs); kv_ = scale8(kv_, fks);
      }
      *(bf16x8*)(G + L_QR + off128(jp, qc * 8)) = qv;
      *(bf16x8*)(G + L_KR + off128(jp, qc * 8)) = kv_;
    }
#pragma unroll
    for (int i = 0; i < 2; ++i) *(bf16x8*)(G + L_V + off64(vj + 32 * i, vc * 8)) = pv[i];
#pragma unroll
    for (int m = 0; m < 2; ++m) {
      int d0 = gw * 32 + m * 16 + fq * 4;
#pragma unroll
      for (int n = 0; n < 4; ++n) {
        int e = n * 16 + fr;
        bf16x4 o4;
        o4[0] = (short)f2bf(st[m][n][0] * eg[m].x); o4[1] = (short)f2bf(st[m][n][1] * eg[m].y);
        o4[2] = (short)f2bf(st[m][n][2] * eg[m].z); o4[3] = (short)f2bf(st[m][n][3] * eg[m].w);
        *(bf16x4*)(G + L_SGT + off128(e, d0)) = o4;
      }
    }
    u16 oldv[4][4];
    u16* dstb = RG + (size_t)base * 2048 + ooff + fr;
    if (wout && !first) {
#pragma unroll
      for (int r = 0; r < 4; ++r) {
        int ip = gw * 16 + fq * 4 + r;
        unsigned ro = (unsigned)(dir ? 63 - ip : ip) * 2048u;
#pragma unroll
        for (int n = 0; n < 4; ++n) oldv[r][n] = dstb[ro + n * 16];
      }
    }
    if (s + 1 < 68) prefetch(s + 1);
    lds_barrier();
    f32x4 pt[4], o[4];
#pragma unroll
    for (int n = 0; n < 4; ++n) { pt[n] = (f32x4){0.f, 0.f, 0.f, 0.f}; o[n] = (f32x4){0.f, 0.f, 0.f, 0.f}; }
#pragma unroll
    for (int ks = 0; ks < 4; ++ks) {
      int kc = ks * 32 + fq * 8;
      bf16x8 qa = *(const bf16x8*)(G + L_QR + off128(gw * 16 + fr, kc));
#pragma unroll
      for (int n = 0; n < 4; ++n) {
        bf16x8 ka = *(const bf16x8*)(G + L_KR + off128(n * 16 + fr, kc));
        bf16x8 sb = *(const bf16x8*)(G + L_SGT + off128(n * 16 + fr, kc));
        pt[n] = __builtin_amdgcn_mfma_f32_16x16x32_bf16(ka, qa, pt[n], 0, 0, 0);
        o[n] = __builtin_amdgcn_mfma_f32_16x16x32_bf16(qa, sb, o[n], 0, 0, 0);
      }
    }
    {
      const int ip = gw * 16 + fr;
#pragma unroll
      for (int n = 0; n < 4; ++n) {
        const int j0 = n * 16 + fq * 4;
        bf16x4 w;
#pragma unroll
        for (int r = 0; r < 4; ++r) {
          int jp = j0 + r;
          bool keep = dir ? (ip > jp) : (ip >= jp);
          w[r] = (short)f2bf(keep ? pt[n][r] : 0.f);
        }
        *(bf16x4*)(G + L_P + off64(ip, j0)) = w;
      }
    }
    asm volatile("s_waitcnt lgkmcnt(0)" ::: "memory");
    {
      const int tg = lane >> 4, tq = (lane & 15) >> 2, tp = lane & 3;
      const unsigned ka0 = Ga + L_KR + (unsigned)((8 * tg + tq) * 272 + (gw * 32 + 4 * tp) * 2);
      const unsigned va0 = Ga + L_V + (unsigned)((8 * tg + tq) * 144 + (4 * tp) * 2);
#pragma unroll
      for (int m = 0; m < 2; ++m) {
        f32x4 kv[4];
#pragma unroll
        for (int n = 0; n < 4; ++n) kv[n] = (f32x4){0.f, 0.f, 0.f, 0.f};
#pragma unroll
        for (int ks = 0; ks < 2; ++ks) {
          int kc = ks * 32 + fq * 8;
          bf16x4 r0, r1, r2, r3, r4, r5, r6, r7, r8, r9;
          asm volatile(
              "ds_read_b64_tr_b16 %0, %10\n\tds_read_b64_tr_b16 %1, %10 offset:1088\n\t"
              "ds_read_b64_tr_b16 %2, %11\n\tds_read_b64_tr_b16 %3, %11 offset:576\n\t"
              "ds_read_b64_tr_b16 %4, %11 offset:32\n\tds_read_b64_tr_b16 %5, %11 offset:608\n\t"
              "ds_read_b64_tr_b16 %6, %11 offset:64\n\tds_read_b64_tr_b16 %7, %11 offset:640\n\t"
              "ds_read_b64_tr_b16 %8, %11 offset:96\n\tds_read_b64_tr_b16 %9, %11 offset:672\n\t"
              "s_waitcnt lgkmcnt(0)"
              : "=&v"(r0), "=&v"(r1), "=&v"(r2), "=&v"(r3), "=&v"(r4), "=&v"(r5), "=&v"(r6), "=&v"(r7), "=&v"(r8), "=&v"(r9)
              : "v"(ka0 + (unsigned)(ks * 32 * 272 + m * 32)), "v"(va0 + (unsigned)(ks * 32 * 144))
              : "memory");
          bf16x8 km = __builtin_shufflevector(r0, r1, 0, 1, 2, 3, 4, 5, 6, 7);
          bf16x8 vb[4];
          vb[0] = __builtin_shufflevector(r2, r3, 0, 1, 2, 3, 4, 5, 6, 7);
          vb[1] = __builtin_shufflevector(r4, r5, 0, 1, 2, 3, 4, 5, 6, 7);
          vb[2] = __builtin_shufflevector(r6, r7, 0, 1, 2, 3, 4, 5, 6, 7);
          vb[3] = __builtin_shufflevector(r8, r9, 0, 1, 2, 3, 4, 5, 6, 7);
          bf16x8 pa;
          if (m == 0) pa = *(const bf16x8*)(G + L_P + off64(gw * 16 + fr, kc));
#pragma unroll
          for (int n = 0; n < 4; ++n) {
            if (m == 0) o[n] = __builtin_amdgcn_mfma_f32_16x16x32_bf16(pa, vb[n], o[n], 0, 0, 0);
            kv[n] = __builtin_amdgcn_mfma_f32_16x16x32_bf16(km, vb[n], kv[n], 0, 0, 0);
          }
        }
#pragma unroll
        for (int n = 0; n < 4; ++n) {
          st[m][n][0] = eg[m].x * el[m].x * st[m][n][0] + el[m].x * kv[n][0];
          st[m][n][1] = eg[m].y * el[m].y * st[m][n][1] + el[m].y * kv[n][1];
          st[m][n][2] = eg[m].z * el[m].z * st[m][n][2] + el[m].z * kv[n][2];
          st[m][n][3] = eg[m].w * el[m].w * st[m][n][3] + el[m].w * kv[n][3];
        }
      }
    }
    if (wout) {
#pragma unroll
      for (int r = 0; r < 4; ++r) {
        int ip = gw * 16 + fq * 4 + r;
        unsigned ro = (unsigned)(dir ? 63 - ip : ip) * 2048u;
#pragma unroll
        for (int n = 0; n < 4; ++n) {
          float v = o[n][r];
          if (!first) v += bf2f(oldv[r][n]);
          dstb[ro + n * 16] = f2bf(v);
        }
      }
    }
    __syncthreads();
  }
}

#define NPHASE 18
__device__ __forceinline__ void run_phase(const Params& p, int ph, char* smem) {
  const int nblk = gridDim.x, bid = blockIdx.x;
  if (ph == 0) {
#ifdef REP_P0
    for (int rep = 0; rep < REP_P0; ++rep)
#endif
    for (int u = bid; u < WT_UNITS + 96 + 1; u += nblk) {
      if (u < 96) mod_unit(p, u, smem);
      else if (u == 96) rot_unit(p);
      else wt_unit(p, 0, u - 97, smem);
    }
    return;
  }
  if (ph == NPHASE - 1) { phase_final(p); return; }
  const int l = (ph - 1) / 8, sp = (ph - 1) % 8;
  PG8_LAS unsigned char* lds = (PG8_LAS unsigned char*)smem;
  switch (sp) {
    case 0:
      phase_u(p, l);
      if (l == 1) for (int u = bid; u < WT_UNITS; u += nblk) wt_unit(p, 1, u, smem);
      break;
    case 1: {
      pg8::Gemm g{(const u16*)(p.ws + OFF_U), (const u16*)(p.ws + OFF_WT) + (size_t)WT_SCAN * 1024, 1024, MTOT, 4096, 1024};
      pg8::StaticOrder S; S.init(g.M, g.N, nblk, bid);
      EpiScanIn E{(u16*)(p.ws + OFF_S), (const float*)(p.ws + OFF_ROT)};
      pg8::gemm_phase(lds, g, S, E, opaque_tid());
    } break;
    case 2:
      for (int t = bid; t < 256; t += nblk) gla_prepass_unit(p, l, t, smem);
      for (int t = 1024 + (bid + 96) % nblk; t < 1088; t += nblk) gla_prepass_unit1(p, l, t, smem);
      break;
    case 3:
#ifdef REP_SCAN
      for (int rep = 0; rep < REP_SCAN; ++rep)
#endif
      for (int t = bid; t < 256; t += nblk) { if (t < 128) scan_item<0>(p, l, t, smem); else scan_item<1>(p, l, t, smem); } break;
    case 4:
      if (l != 0) phase_u(p, l);
      phase_stats(p, l);
      break;
    case 5: {
      pg8::Gemm g{(const u16*)(p.ws + OFF_U), (const u16*)(p.ws + OFF_WT) + (size_t)WT_GATE * 1024, 1024, l == 0 ? MTOT : MLAT, 4096, 1024};
      pg8::StaticOrder S; S.init(g.M, g.N, nblk, bid);
      EpiGate E{(const u16*)(p.ws + OFF_RG), (const float*)(p.ws + OFF_STATS), (u16*)(p.ws + OFF_S), p.ret_norm_gain + l * 1024, p.gla_norm_gain + l * 1024};
      pg8::gemm_phase(lds, g, S, E, opaque_tid());
    } break;
    case 6: {
#pragma unroll 1
      for (int pass = 0; pass < 2; ++pass) {
        pg8::Gemm g{(const u16*)(p.ws + OFF_S) + 2048 + pass * 1024, (const u16*)(p.ws + OFF_WT) + (size_t)(WT_BRR + pass * 1024) * 1024, 4096, l == 0 ? MTOT : MLAT, 1024, 1024};
        pg8::StaticOrder S; S.init(g.M, g.N, nblk, bid);
        EpiMerge E{(const u16*)(p.ws + OFF_S), (u16*)(p.ws + OFF_U), pass};
        pg8::gemm_phase(lds, g, S, E, opaque_tid());
      }
    } break;
    case 7: {
      pg8::Gemm g{(const u16*)(p.ws + OFF_U), (const u16*)(p.ws + OFF_WT) + (size_t)WT_OUT * 1024, 1024, l == 0 ? MTOT : MLAT, 1024, 1024};
      pg8::StaticOrder S; S.init(g.M, g.N, nblk, bid);
      EpiOut E{l == 0 ? p.x : p.out, p.ctx, p.out, (float*)(p.ws + OFF_HCTX), (const float*)(p.ws + OFF_MOD) + (size_t)l * 9 * 3072};
      pg8::gemm_phase(lds, g, S, E, opaque_tid());
    } break;
  }
}

#define XB_TMO      128
#define XB_XCNT(j)  (256  + 64 * (j))
#define XB_XSUB(j)  (1280 + 64 * (j))
#define XB_XGEN(j)  (2304 + 64 * (j))
#define XB_TOP      3328
#define XB_TOPGEN   3392
#define XCD_BAR_WORDS 3456
#define XB_SPIN_CAP (1u << 18)
__device__ __forceinline__ unsigned xb_ld(unsigned* p)              { return __hip_atomic_load(p, __ATOMIC_RELAXED, __HIP_MEMORY_SCOPE_AGENT); }
__device__ __forceinline__ unsigned xb_add(unsigned* p, unsigned v) { return __hip_atomic_fetch_add(p, v, __ATOMIC_RELAXED, __HIP_MEMORY_SCOPE_AGENT); }
__device__ __forceinline__ unsigned xb_xcc_id() { return (unsigned)__builtin_amdgcn_s_getreg((3 << 11) | 20) & 0xFu; }
#define XB_SPIN(cond, bar) do { unsigned _sp = 0; while (cond) { __builtin_amdgcn_s_sleep(1); \
    if ((++_sp & 255u) == 0u) { if (xb_ld(&(bar)[XB_TMO])) break; if (_sp > XB_SPIN_CAP) { atomicAdd(&(bar)[XB_TMO], 1u); break; } } } } while (0)

__device__ __forceinline__ void xcd_barrier_complete(unsigned* bar, unsigned x, unsigned& nloc, unsigned& nx) {
  const unsigned G = gridDim.x * gridDim.y * gridDim.z;
  unsigned sum, cnt, mine, sp = 0u;
  for (;;) {
    sum = 0u; cnt = 0u; mine = 0u;
#pragma unroll
    for (unsigned j = 0; j < 16; ++j) { const unsigned c = xb_ld(&bar[XB_XCNT(j)]); sum += c; cnt += (c > 0u) ? 1u : 0u; mine = (j == x) ? c : mine; }
    if (sum == G) break;
    __builtin_amdgcn_s_sleep(1);
    if ((++sp & 255u) == 0u) { if (xb_ld(&bar[XB_TMO])) break; if (sp > XB_SPIN_CAP) { atomicAdd(&bar[XB_TMO], 1u); break; } }
  }
  nloc = mine > 0u ? mine : 1u; nx = cnt > 0u ? cnt : 1u;
}

__device__ __forceinline__ void xcd_barrier(unsigned* bar, volatile unsigned* st) {
  asm volatile("s_waitcnt vmcnt(0)" ::: "memory");
  __syncthreads();
  if (threadIdx.x == 0) {
    const unsigned x = xb_xcc_id();
    __builtin_amdgcn_s_waitcnt(0);
    unsigned nloc = st[0], nx = st[1];
    if (nloc == 0u) { xcd_barrier_complete(bar, x, nloc, nx); st[0] = nloc; st[1] = nx; }
    const unsigned old = xb_add(&bar[XB_XSUB(x)], 1u);
    const unsigned gen = old / nloc;
    if (old + 1u == (gen + 1u) * nloc) {
      __builtin_amdgcn_fence(__ATOMIC_RELEASE, "agent");
      asm volatile("s_waitcnt vmcnt(0)" ::: "memory");
      const unsigned og = xb_add(&bar[XB_TOP], 1u);
      const unsigned tg = og / nx;
      if (og + 1u == (tg + 1u) * nx) xb_add(&bar[XB_TOPGEN], 1u);
      else XB_SPIN(xb_ld(&bar[XB_TOPGEN]) == tg, bar);
      __builtin_amdgcn_fence(__ATOMIC_ACQUIRE, "agent");
      xb_add(&bar[XB_XGEN(x)], 1u);
      asm volatile("s_waitcnt vmcnt(0)" ::: "memory");
    } else {
      XB_SPIN(xb_ld(&bar[XB_XGEN(x)]) == gen, bar);
      __builtin_amdgcn_fence(__ATOMIC_ACQUIRE, "agent");
      asm volatile("s_waitcnt vmcnt(0)" ::: "memory");
    }
  }
  __syncthreads();
}

__global__ void __launch_bounds__(NTHREADS) mega(Params p, int ph_lo, int ph_hi, int coop) {
  extern __shared__ __attribute__((aligned(16))) char smem[];
  volatile unsigned* xst = (volatile unsigned*)(smem + XB_LDS_OFF);
  unsigned* xbar = (unsigned*)(p.ws + OFF_BAR);
  if (coop) {
    if (threadIdx.x == 0) { xst[0] = 0u; xst[1] = 0u; (void)xb_add(&xbar[XB_XCNT(xb_xcc_id())], 1u); }
    __syncthreads();
  }
  for (int ph = ph_lo; ph < ph_hi; ++ph) {
    run_phase(p, ph, smem);
    if (coop && ph + 1 < ph_hi) {
      if (ph == ph_lo) cg::this_grid().sync();
      else xcd_barrier(xbar, xst);
    }
  }
}

extern "C" void kernel_launch(void* const* d_in, const int* in_sizes, int n_in,
                              void* d_out, int out_size, void* d_ws, size_t ws_size,
                              hipStream_t stream) {
  Params p{};
  p.x = (const float*)d_in[0]; p.c = (const float*)d_in[1]; p.ctx = (const float*)d_in[2]; p.c_ctx = (const float*)d_in[3];
  p.norm_gain = (const float*)d_in[4]; p.w_ada = (const float*)d_in[5]; p.b_ada = (const float*)d_in[6]; p.w_in = (const float*)d_in[7];
  p.ret_decay = (const float*)d_in[8]; p.gla_w_up = (const float*)d_in[9]; p.gla_b_up = (const float*)d_in[10];
  p.ret_norm_gain = (const float*)d_in[11]; p.gla_norm_gain = (const float*)d_in[12];
  p.w_br_ret = (const float*)d_in[13]; p.w_br_gla = (const float*)d_in[14]; p.w_out = (const float*)d_in[15]; p.final_gain = (const float*)d_in[16];
  p.out = (float*)d_out; p.ws = (char*)d_ws;
  static int grid_blocks = 0;
  if (!grid_blocks) {
    hipFuncSetAttribute((const void*)mega, hipFuncAttributeMaxDynamicSharedMemorySize, LDS_BYTES);
    int dev = 0, cus = 0, per_cu = 0;
    hipGetDevice(&dev);
    hipDeviceGetAttribute(&cus, hipDeviceAttributeMultiprocessorCount, dev);
    hipOccupancyMaxActiveBlocksPerMultiprocessor(&per_cu, mega, NTHREADS, LDS_BYTES);
    if (per_cu < 1) per_cu = 1;
    grid_blocks = cus * 1;
  }
#ifdef MULTI_LAUNCH
  for (int ph = 0; ph < NPHASE; ++ph) {
    mega<<<dim3(grid_blocks), dim3(NTHREADS), LDS_BYTES, stream>>>(p, ph, ph + 1, 0);
  }
#else
  hipMemsetAsync((char*)d_ws + OFF_BAR, 0, 16384, stream);
  int lo = 0, hi = NPHASE, coop = 1;
  void* args[] = {&p, &lo, &hi, &coop};
  hipError_t e = hipLaunchCooperativeKernel((void*)mega, dim3(grid_blocks), dim3(NTHREADS), args, LDS_BYTES, stream);
  if (e != hipSuccess) fprintf(stderr, "cooperative launch failed: %s (grid %d)\n", hipGetErrorString(e), grid_blocks);
#endif
}
```

```cpp
#include <hip/hip_runtime.h>
#include <hip/hip_cooperative_groups.h>
#include <cstdio>
namespace cg = cooperative_groups;

typedef unsigned short u16;
using bf16x8 = __attribute__((ext_vector_type(8))) short;
using bf16x4 = __attribute__((ext_vector_type(4))) short;
using f32x4  = __attribute__((ext_vector_type(4))) float;

#define NTHREADS 512
#define DM 1024
#define NB 8
#define SEQL 4096
#define CTXL 256
#define MLAT 32768
#define MCTX 2048
#define MTOT 34816
#define INW 8208

#define OFF_S    0ull
#define OFF_RG   (OFF_S   + (size_t)MTOT * 4096 * 2)
#define OFF_U    (OFF_RG  + (size_t)MTOT * 2048 * 2)
#define OFF_WT   (OFF_U   + (size_t)MTOT * 1024 * 2)
#define WT_ROWS  11392
#define OFF_GLR  (OFF_WT  + (size_t)WT_ROWS * 1024 * 2)
#define OFF_HCTX (OFF_GLR + (size_t)MTOT * 16 * 4)
#define OFF_MOD  (OFF_HCTX+ (size_t)MCTX * 1024 * 4)
#define OFF_ROT  (OFF_MOD + (size_t)2 * 9 * 3072 * 4)
#define OFF_BAR  (OFF_ROT + (size_t)64 * 32 * 2 * 4)
#define OFF_END  (OFF_BAR + 16384)

#define WT_SCAN 0
#define WT_GATE 4224
#define WT_BRR  8320
#define WT_BRG  9344
#define WT_OUT  10368

#define XB_LDS_OFF 161792
#define LDS_BYTES 161808
#define SCAN_GB   80896

struct Params {
  const float* x; const float* c; const float* ctx; const float* c_ctx;
  const float* norm_gain; const float* w_ada; const float* b_ada; const float* w_in;
  const float* ret_decay; const float* gla_w_up; const float* gla_b_up;
  const float* ret_norm_gain; const float* gla_norm_gain;
  const float* w_br_ret; const float* w_br_gla; const float* w_out; const float* final_gain;
  float* out; char* ws;
};

__device__ __forceinline__ u16 f2bf(float f) {
  __bf16 h = (__bf16)f;
  return *(u16*)&h;
}
__device__ __forceinline__ float bf2f(u16 h) { return __uint_as_float(((unsigned)h) << 16); }
__device__ __forceinline__ float sigmoidf_(float x) { return __builtin_amdgcn_rcpf(1.f + __expf(-x)); }
__device__ __forceinline__ float siluf_(float x) { return x * __builtin_amdgcn_rcpf(1.f + __expf(-x)); }

__device__ __forceinline__ int opaque_tid() { int t = threadIdx.x; asm volatile("" : "+v"(t)); return t; }

__device__ __forceinline__ float wave_sum(float v, int lane) {
#pragma unroll
  for (int o = 32; o > 0; o >>= 1)
    v += __int_as_float(__builtin_amdgcn_ds_bpermute((lane ^ o) << 2, __float_as_int(v)));
  return v;
}

__device__ __forceinline__ const float* wt_src(const Params& p, int l, int n, int& ld) {
  if (n < WT_GATE) {
    int tile = n >> 7, cc = n & 127;
    int col;
    if (tile < 8) {
      int d = (cc & 64) | ((cc & 16) << 1) | ((cc & 32) >> 1) | (cc & 15);
      col = tile * 128 + d;
    } else if (tile < 16) col = 1024 + (tile - 8) * 128 + cc;
    else if (tile < 24) col = 3072 + (tile - 16) * 128 + cc;
    else if (tile < 32) col = 4096 + (tile - 24) * 128 + cc;
    else { if (cc >= 16) { ld = 0; return nullptr; } col = 6144 + cc; }
    ld = INW; return p.w_in + (size_t)l * DM * INW + col;
  } else if (n < WT_BRR) {
    int g = n - WT_GATE; int col;
    if (g < 1024) col = 2048 + g;
    else if (g < 2048) col = 5120 + (g - 1024);
    else if (g < 3072) col = 6160 + (g - 2048);
    else col = 7184 + (g - 3072);
    ld = INW; return p.w_in + (size_t)l * DM * INW + col;
  } else if (n < WT_BRG) { ld = DM; return p.w_br_ret + (size_t)l * DM * DM + (n - WT_BRR); }
  else if (n < WT_OUT)   { ld = DM; return p.w_br_gla + (size_t)l * DM * DM + (n - WT_BRG); }
  else                   { ld = DM; return p.w_out    + (size_t)l * DM * DM + (n - WT_OUT); }
}

#define WT_UNITS (178 * 4)
__device__ __forceinline__ void wt_unit(const Params& p, int l, int unit, char* smem) {
  float* tile = (float*)smem;
  int nb = unit >> 2, kg = unit & 3;
  int tid = opaque_tid();
  int n0 = nb * 64, kbase = kg * 256;
  float v[4][8];
  {
    int nl = tid & 63, kq = tid >> 6;
    int ld; const float* src = wt_src(p, l, n0 + nl, ld);
#pragma unroll
    for (int q = 0; q < 4; ++q)
#pragma unroll
      for (int i = 0; i < 8; ++i) v[q][i] = src ? src[(size_t)(kbase + q * 64 + kq + 8 * i) * ld] : 0.f;
  }
  u16* wt = (u16*)(p.ws + OFF_WT);
#pragma unroll
  for (int q = 0; q < 4; ++q) {
    __syncthreads();
    {
      int nl = tid & 63, kq = tid >> 6;
#pragma unroll
      for (int i = 0; i < 8; ++i) tile[(kq + 8 * i) * 65 + nl] = v[q][i];
    }
    __syncthreads();
    {
      int nl = tid >> 3, kq = tid & 7;
      bf16x8 o;
#pragma unroll
      for (int j = 0; j < 8; ++j) o[j] = (short)f2bf(tile[(kq * 8 + j) * 65 + nl]);
      *(bf16x8*)(wt + (size_t)(n0 + nl) * 1024 + kbase + q * 64 + kq * 8) = o;
    }
  }
  __syncthreads();
}

__device__ __forceinline__ void mod_unit(const Params& p, int unit, char* smem) {
  float* sc = (float*)smem;
  float* red = sc + 9 * 1024;
  int l = unit / 48, jb = unit % 48;
  int tid = opaque_tid();
  for (int i = tid; i < 9 * 1024; i += NTHREADS) {
    int r = i >> 10, k = i & 1023;
    float v = (r < 8) ? p.c[r * 1024 + k] : p.c_ctx[k];
    sc[i] = siluf_(v);
  }
  __syncthreads();
  int jl = tid & 63, kg = tid >> 6;
  int j = jb * 64 + jl;
  float acc[9];
#pragma unroll
  for (int r = 0; r < 9; ++r) acc[r] = 0.f;
  const float* w = p.w_ada + (size_t)l * DM * 3072 + j;
#pragma unroll 16
  for (int k = kg * 128; k < kg * 128 + 128; ++k) {
    float wv = w[(size_t)k * 3072];
#pragma unroll
    for (int r = 0; r < 9; ++r) acc[r] += sc[r * 1024 + k] * wv;
  }
#pragma unroll
  for (int r = 0; r < 9; ++r) red[(kg * 9 + r) * 64 + jl] = acc[r];
  __syncthreads();
  float* mod = (float*)(p.ws + OFF_MOD);
  for (int i = tid; i < 9 * 64; i += NTHREADS) {
    int r = i >> 6, jj = i & 63;
    float s = 0.f;
#pragma unroll
    for (int g = 0; g < 8; ++g) s += red[(g * 9 + r) * 64 + jj];
    mod[((size_t)l * 9 + r) * 3072 + jb * 64 + jj] = s + p.b_ada[l * 3072 + jb * 64 + jj];
  }
  __syncthreads();
}

__device__ __forceinline__ void rot_unit(const Params& p) {
  float* rot = (float*)(p.ws + OFF_ROT);
  for (int i = opaque_tid(); i < 64 * 32; i += NTHREADS) {
    int pos = i >> 5, f = i & 31;
    float inv = exp2f(-(float)f * (13.287712379549449f / 32.f));
    float ang = (float)pos * inv;
    rot[i * 2] = __cosf(ang);
    rot[i * 2 + 1] = __sinf(ang);
  }
}

__device__ __forceinline__ void phase_u(const Params& p, int l) {
  const int tid = opaque_tid(); int wave = tid >> 6, lane = tid & 63;
  const float* mod = (const float*)(p.ws + OFF_MOD) + (size_t)l * 9 * 3072;
  const float* gain = p.norm_gain + l * DM;
  u16* U = (u16*)(p.ws + OFF_U);
  for (int row = (blockIdx.x * 8 + wave) * 4; row < MTOT; row += gridDim.x * 32) {
    const float* h; int r;
    if (row < MLAT) { h = (l == 0 ? p.x : p.out) + (size_t)row * DM; r = row >> 12; }
    else { int cr = row - MLAT; h = (l == 0 ? p.ctx : (const float*)(p.ws + OFF_HCTX)) + (size_t)cr * DM; r = 8; }
    float4 v[4][4]; float ss[4];
#pragma unroll
    for (int q = 0; q < 4; ++q) {
      ss[q] = 0.f;
#pragma unroll
      for (int i = 0; i < 4; ++i) v[q][i] = *(const float4*)(h + q * DM + i * 256 + lane * 4);
    }
#pragma unroll
    for (int q = 0; q < 4; ++q) {
#pragma unroll
      for (int i = 0; i < 4; ++i) ss[q] += v[q][i].x * v[q][i].x + v[q][i].y * v[q][i].y + v[q][i].z * v[q][i].z + v[q][i].w * v[q][i].w;
      ss[q] = rsqrtf(wave_sum(ss[q], lane) * (1.f / 1024.f) + 1e-6f);
    }
    const float* sh = mod + r * 3072;
#pragma unroll
    for (int i = 0; i < 4; ++i) {
      int cidx = i * 256 + lane * 4;
      float4 g = *(const float4*)(gain + cidx);
      float4 s = *(const float4*)(sh + cidx);
      float4 sc = *(const float4*)(sh + 1024 + cidx);
      g.x *= (1.f + sc.x); g.y *= (1.f + sc.y); g.z *= (1.f + sc.z); g.w *= (1.f + sc.w);
#pragma unroll
      for (int q = 0; q < 4; ++q) {
        bf16x4 o;
        o[0] = (short)f2bf(v[q][i].x * ss[q] * g.x + s.x);
        o[1] = (short)f2bf(v[q][i].y * ss[q] * g.y + s.y);
        o[2] = (short)f2bf(v[q][i].z * ss[q] * g.z + s.z);
        o[3] = (short)f2bf(v[q][i].w * ss[q] * g.w + s.w);
        *(bf16x4*)(U + (size_t)(row + q) * DM + cidx) = o;
      }
    }
  }
}

__device__ __forceinline__ void phase_final(const Params& p) {
  const int tid = opaque_tid(); int wave = tid >> 6, lane = tid & 63;
  for (int row = (blockIdx.x * 8 + wave) * 4; row < MLAT; row += gridDim.x * 32) {
    float* h = p.out + (size_t)row * DM;
    float4 v[4][4]; float ss[4];
#pragma unroll
    for (int q = 0; q < 4; ++q) {
      ss[q] = 0.f;
#pragma unroll
      for (int i = 0; i < 4; ++i) v[q][i] = *(const float4*)(h + q * DM + i * 256 + lane * 4);
    }
#pragma unroll
    for (int q = 0; q < 4; ++q) {
#pragma unroll
      for (int i = 0; i < 4; ++i) ss[q] += v[q][i].x * v[q][i].x + v[q][i].y * v[q][i].y + v[q][i].z * v[q][i].z + v[q][i].w * v[q][i].w;
      ss[q] = rsqrtf(wave_sum(ss[q], lane) * (1.f / 1024.f) + 1e-6f);
    }
#pragma unroll
    for (int i = 0; i < 4; ++i) {
      int cidx = i * 256 + lane * 4;
      float4 g = *(const float4*)(p.final_gain + cidx);
#pragma unroll
      for (int q = 0; q < 4; ++q) {
        float4 o;
        o.x = v[q][i].x * ss[q] * g.x; o.y = v[q][i].y * ss[q] * g.y; o.z = v[q][i].z * ss[q] * g.z; o.w = v[q][i].w * ss[q] * g.w;
        *(float4*)(h + q * DM + cidx) = o;
      }
    }
  }
}

#define PG8_LAS __attribute__((address_space(3)))
typedef unsigned u32x4 __attribute__((ext_vector_type(4)));
namespace pg8 {
constexpr int BM = 256, BK = 64, HALF = 128, HTB = HALF * BK * 2, STAGE_BYTES = 8 * HTB, NXCD = 8, WGM = 8;
__device__ __forceinline__ int lds_byte(int r, int c) { const int st = (r >> 4) * 2 + (c >> 5), rr = r & 15, cc = c & 31, ob = rr * 64 + cc * 2; return st * 1024 + (ob ^ (((ob >> 9) & 1) << 5)); }
__device__ __forceinline__ void stage_rc(int b, int& R, int& C) { const int st = b / 1024, sb = b % 1024, swz = sb ^ (((sb >> 9) & 1) << 5); R = (st >> 1) * 16 + swz / 64; C = (st & 1) * 32 + (swz % 64) / 2; }
__device__ __forceinline__ int perm32(int rho) { const int n = rho >> 4, i = rho & 15; return 8 * (i >> 2) + 4 * n + (i & 3); }
struct Unit { int pm, pn; };
struct Gemm { const u16* A; const u16* Bt; int lda; int M, N, K; };
struct StaticOrder {
  int nM, nN, nwg, G, c;
  __device__ void init(int M, int N, int G_, int c_) { nM = M / BM; nN = N / BM; nwg = nM * nN; G = G_; c = c_; }
  __device__ bool next(int i, Unit& u) const {
    const long L = (long)i * G + c; if (L >= nwg) return false;
    int wgid = (int)L; { const int q = nwg / NXCD, r = nwg % NXCD, xcd = wgid % NXCD, off = wgid / NXCD; wgid = (xcd < r ? xcd * (q + 1) : r * (q + 1) + (xcd - r) * q) + off; }
    const int nig = WGM * nN, gid = wgid / nig, fm = gid * WGM, gsz = (nM - fm) < WGM ? (nM - fm) : WGM;
    u.pm = fm + ((wgid % nig) % gsz); u.pn = (wgid % nig) / gsz; return true;
  }
};
typedef __attribute__((ext_vector_type(2))) float cvt_f2_t;
typedef __attribute__((ext_vector_type(2))) __bf16 cvt_b2_t;
__device__ __forceinline__ unsigned cvt_pk_bf16(float lo, float hi) { cvt_f2_t f = {lo, hi}; cvt_b2_t r = __builtin_convertvector(f, cvt_b2_t); return __builtin_bit_cast(unsigned, r); }

template <class Epi>
__device__ __forceinline__ void gemm_phase(PG8_LAS unsigned char* lds, const Gemm g, const StaticOrder& S, const Epi& E, const int tid) {
  const int wid = __builtin_amdgcn_readfirstlane(tid >> 6), lane = tid & 63, wr = wid >> 2, wc = wid & 3, fr = lane & 15, fq = lane >> 4;
  const int K = g.K, nt = K / BK;
  unsigned voffA[2], voffB[2];
#pragma unroll
  for (int i = 0; i < 2; ++i) { int R, C; stage_rc(tid * 16 + i * 8192, R, C); const int Rb = Epi::PERM ? ((R & ~31) + perm32(R & 31)) : R;
    voffA[i] = (unsigned)(R * g.lda + C) * 2u; voffB[i] = (unsigned)(Rb * K + C) * 2u; }
  const size_t kstep = (size_t)(BK * 2);
  const size_t hstepA = (size_t)HALF * g.lda * 2, hstepB = (size_t)HALF * K * 2;
  const size_t tstepA = 2 * hstepA, tstepB = 2 * hstepB;
  const unsigned ldsw = (unsigned)wid * 1024u;
  const int aoff = lds_byte(wr * 64 + fr, fq * 8), boff = lds_byte(wc * 32 + fr, fq * 8);
#define PG8_SA(b, h) (((b) * 2 + (h)) * HTB)
#define PG8_SB(b, h) ((4 + (b) * 2 + (h)) * HTB)
#define PG8_STAGE(bufoff, gbase, voff) do { _Pragma("unroll") for (int _i = 0; _i < 2; ++_i) \
    __builtin_amdgcn_global_load_lds((const unsigned*)((const char*)(gbase) + (voff)[_i]), (PG8_LAS unsigned*)(lds + (bufoff) + ldsw + _i * 8192), 16, 0, 0); } while (0)
#define PG8_LDA(dst, b, h) do { _Pragma("unroll") for (int m = 0; m < 4; ++m) _Pragma("unroll") for (int k = 0; k < 2; ++k) dst[m][k] = *(const PG8_LAS bf16x8*)(lds + PG8_SA(b, h) + aoff + m * 2048 + k * 1024); } while (0)
#define PG8_LDB(dst, b, h) do { _Pragma("unroll") for (int n = 0; n < 2; ++n) _Pragma("unroll") for (int k = 0; k < 2; ++k) dst[n][k] = *(const PG8_LAS bf16x8*)(lds + PG8_SB(b, h) + boff + n * 2048 + k * 1024); } while (0)
#define PG8_MMA(ai, bj, At, Bt) do { __builtin_amdgcn_s_setprio(1); _Pragma("unroll") for (int m = 0; m < 4; ++m) _Pragma("unroll") for (int n = 0; n < 2; ++n) _Pragma("unroll") for (int k = 0; k < 2; ++k) \
    acc[ai][bj][m][n] = __builtin_amdgcn_mfma_f32_16x16x32_bf16(Bt[n][k], At[m][k], acc[ai][bj][m][n], 0, 0, 0); __builtin_amdgcn_s_setprio(0); } while (0)
#define PG8_WAIT_V(n) asm volatile("s_waitcnt vmcnt(" #n ")" ::: "memory")
#define PG8_WAIT_L(n) asm volatile("s_waitcnt lgkmcnt(" #n ")" ::: "memory")
#define PG8_BAR __builtin_amdgcn_s_barrier()
#define PG8_SCHED __builtin_amdgcn_sched_barrier(0)
  Unit cur, nxt; int ui = 0;
  if (!S.next(0, cur)) return;
  f32x4 acc[2][2][4][2];
#pragma unroll
  for (int a = 0; a < 2; ++a)
#pragma unroll
    for (int b = 0; b < 2; ++b)
#pragma unroll
      for (int m = 0; m < 4; ++m)
#pragma unroll
        for (int n = 0; n < 2; ++n) acc[a][b][m][n] = (f32x4){0.f, 0.f, 0.f, 0.f};
  bf16x8 At[4][2], B0[2][2], B1[2][2];
  const char* cA = (const char*)g.A + (size_t)cur.pm * tstepA; const char* cB = (const char*)g.Bt + (size_t)cur.pn * tstepB;
  PG8_STAGE(PG8_SB(0, 0), cB, voffB); PG8_STAGE(PG8_SA(0, 0), cA, voffA); PG8_STAGE(PG8_SB(0, 1), cB + hstepB, voffB); PG8_STAGE(PG8_SA(0, 1), cA + hstepA, voffA);
  if (wr == 1) PG8_BAR;
  PG8_WAIT_V(4); PG8_BAR;
  PG8_STAGE(PG8_SB(1, 0), cB + kstep, voffB); PG8_STAGE(PG8_SA(1, 0), cA + kstep, voffA); PG8_STAGE(PG8_SB(1, 1), cB + hstepB + kstep, voffB);
  PG8_WAIT_V(6); PG8_BAR;
  for (;;) {
    const bool has_next = S.next(ui + 1, nxt);
    const char* nA = has_next ? (const char*)g.A + (size_t)nxt.pm * tstepA : cA; const char* nB = has_next ? (const char*)g.Bt + (size_t)nxt.pn * tstepB : cB;
    for (int t = 0; t < nt; t += 2) {
      const bool last = (t == nt - 2);
      const char* a1 = cA + (size_t)(t + 1) * kstep;
      const char* a2 = last ? nA : cA + (size_t)(t + 2) * kstep; const char* b2 = last ? nB : cB + (size_t)(t + 2) * kstep;
      const char* a3 = a2 + kstep; const char* b3 = b2 + kstep;
      PG8_LDB(B0, 0, 0); PG8_SCHED; PG8_LDA(At, 0, 0); PG8_STAGE(PG8_SA(1, 1), a1 + hstepA, voffA);
      PG8_WAIT_L(8); PG8_BAR; PG8_WAIT_L(0); PG8_MMA(0, 0, At, B0); PG8_BAR; PG8_SCHED;
      PG8_LDB(B1, 0, 1); PG8_STAGE(PG8_SB(0, 0), b2, voffB);
      PG8_BAR; PG8_WAIT_L(0); PG8_MMA(0, 1, At, B1); PG8_BAR;
      PG8_LDA(At, 0, 1); PG8_STAGE(PG8_SA(0, 0), a2, voffA);
      PG8_BAR; PG8_WAIT_L(0); PG8_MMA(1, 0, At, B0); PG8_BAR; PG8_SCHED;
      PG8_STAGE(PG8_SB(0, 1), b2 + hstepB, voffB);
      PG8_WAIT_V(6); PG8_BAR; PG8_MMA(1, 1, At, B1); PG8_BAR;
      PG8_LDB(B0, 1, 0); PG8_SCHED; PG8_LDA(At, 1, 0); PG8_STAGE(PG8_SA(0, 1), a2 + hstepA, voffA);
      PG8_WAIT_L(8); PG8_BAR; PG8_WAIT_L(0); PG8_MMA(0, 0, At, B0); PG8_BAR; PG8_SCHED;
      PG8_LDB(B1, 1, 1); PG8_STAGE(PG8_SB(1, 0), b3, voffB);
      PG8_BAR; PG8_WAIT_L(0); PG8_MMA(0, 1, At, B1); PG8_BAR;
      PG8_LDA(At, 1, 1); PG8_STAGE(PG8_SA(1, 0), a3, voffA);
      PG8_BAR; PG8_WAIT_L(0); PG8_MMA(1, 0, At, B0); PG8_BAR; PG8_SCHED;
      PG8_STAGE(PG8_SB(1, 1), b3 + hstepB, voffB);
      PG8_WAIT_V(6); PG8_BAR; PG8_MMA(1, 1, At, B1); PG8_BAR;
    }
    E(acc, cur, wr, wc, fr, fq, lane);
    if (!has_next) break;
#pragma unroll
    for (int a = 0; a < 2; ++a)
#pragma unroll
      for (int b = 0; b < 2; ++b)
#pragma unroll
        for (int m = 0; m < 4; ++m)
#pragma unroll
          for (int n = 0; n < 2; ++n) acc[a][b][m][n] = (f32x4){0.f, 0.f, 0.f, 0.f};
    cur = nxt; cA = nA; cB = nB; ++ui;
  }
  PG8_WAIT_V(0);
  if (wr == 0) PG8_BAR;
  PG8_BAR;
#undef PG8_SA
#undef PG8_SB
#undef PG8_STAGE
#undef PG8_LDA
#undef PG8_LDB
#undef PG8_MMA
#undef PG8_WAIT_V
#undef PG8_WAIT_L
#undef PG8_BAR
#undef PG8_SCHED
}
}

#define OFF_STATS OFF_GLR

__device__ __forceinline__ u32x4 pack8v(const f32x4& a, const f32x4& b) {
  u32x4 w; w.x = pg8::cvt_pk_bf16(a[0], a[1]); w.y = pg8::cvt_pk_bf16(a[2], a[3]); w.z = pg8::cvt_pk_bf16(b[0], b[1]); w.w = pg8::cvt_pk_bf16(b[2], b[3]); return w;
}
__device__ __forceinline__ float xlane32(float v, int lane) { return __int_as_float(__builtin_amdgcn_ds_bpermute((lane ^ 32) << 2, __float_as_int(v))); }

struct EpiScanIn {
  static constexpr bool PERM = true;
  u16* S; const float* rot;
  __device__ __forceinline__ void operator()(const f32x4 (&acc)[2][2][4][2], const pg8::Unit& u, int wr, int wc, int fr, int fq, int lane) const {
    u16* Sb = S + (size_t)u.pm * 256 * 4096;
    unsigned rl0 = wr * 64 + fr; asm volatile("" : "+v"(rl0));
#pragma unroll
    for (int bj = 0; bj < 2; ++bj) {
      const int nt128 = u.pn * 2 + bj;
      const bool scaled = (nt128 < 4) || (nt128 >= 16 && nt128 < 20);
      const float scl = scaled ? 0.08838834764831845f : 1.f;
      const unsigned cb = nt128 * 128 + wc * 32 + fq * 8;
      if (nt128 < 8 && u.pm < 128) {
        const int tb = (u.pm & 15) * 256;
        const int fo = ((wc & 1) * 16 + (fq & 1) * 8) * 2;
        const float sgn = (fq >> 1) ? 1.f : -1.f;
#pragma unroll
        for (int ai = 0; ai < 2; ++ai)
#pragma unroll
          for (int m = 0; m < 4; ++m) {
            const unsigned rl = rl0 + ai * 128 + m * 16;
            const int t = tb + rl;
            const unsigned pos = (wc >> 1) == 0 ? (t >> 6) : (t & 63);
            const float* rp = rot + pos * 64u + fo;
            const float4 c0 = *(const float4*)rp, c1 = *(const float4*)(rp + 4), c2 = *(const float4*)(rp + 8), c3 = *(const float4*)(rp + 12);
            const f32x4 v0 = acc[ai][bj][m][0], v1 = acc[ai][bj][m][1];
            f32x4 p0, p1;
#pragma unroll
            for (int j = 0; j < 4; ++j) { p0[j] = xlane32(v0[j], lane); p1[j] = xlane32(v1[j], lane); }
            f32x4 o0, o1;
            o0[0] = (v0[0] * c0.x + sgn * p0[0] * c0.y) * scl; o0[1] = (v0[1] * c0.z + sgn * p0[1] * c0.w) * scl;
            o0[2] = (v0[2] * c1.x + sgn * p0[2] * c1.y) * scl; o0[3] = (v0[3] * c1.z + sgn * p0[3] * c1.w) * scl;
            o1[0] = (v1[0] * c2.x + sgn * p1[0] * c2.y) * scl; o1[1] = (v1[1] * c2.z + sgn * p1[1] * c2.w) * scl;
            o1[2] = (v1[2] * c3.x + sgn * p1[2] * c3.y) * scl; o1[3] = (v1[3] * c3.z + sgn * p1[3] * c3.w) * scl;
            *(u32x4*)(Sb + rl * 4096u + cb) = pack8v(o0, o1);
            __builtin_amdgcn_sched_barrier(0);
          }
      } else {
#pragma unroll
        for (int ai = 0; ai < 2; ++ai)
#pragma unroll
          for (int m = 0; m < 4; ++m) {
            const unsigned rl = rl0 + ai * 128 + m * 16;
            *(u32x4*)(Sb + rl * 4096u + cb) = pack8v(acc[ai][bj][m][0] * scl, acc[ai][bj][m][1] * scl);
            __builtin_amdgcn_sched_barrier(0);
          }
      }
    }
  }
};

struct EpiGate {
  static constexpr bool PERM = true;
  const u16* RG; const float* stats; u16* S; const float* rgain; const float* ggain;
  __device__ __forceinline__ void operator()(const f32x4 (&acc)[2][2][4][2], const pg8::Unit& u, int wr, int wc, int fr, int fq, int lane) const {
    u16* Sb = S + (size_t)u.pm * 256 * 4096;
    unsigned rl0 = wr * 64 + fr; asm volatile("" : "+v"(rl0));
    if (u.pn < 8) {
      const int branch = u.pn >> 2, head = u.pn & 3;
      const u16* RGb = RG + (size_t)u.pm * 256 * 2048 + branch * 1024;
      const float* stb = stats + (size_t)u.pm * 256 * 16 + (branch * 4 + head) * 2;
      const float* gain = branch ? ggain : rgain;
#pragma unroll
      for (int bj = 0; bj < 2; ++bj) {
        const unsigned cb = head * 256 + bj * 128 + wc * 32 + fq * 8;
        const float4 g0 = *(const float4*)(gain + cb), g1 = *(const float4*)(gain + cb + 4);
#pragma unroll
        for (int ai = 0; ai < 2; ++ai)
#pragma unroll
          for (int m = 0; m < 4; ++m) {
            const unsigned rl = rl0 + ai * 128 + m * 16;
            const float2 st = *(const float2*)(stb + rl * 16u);
            const bf16x8 xr = *(const bf16x8*)(RGb + rl * 2048u + cb);
            f32x4 v0 = acc[ai][bj][m][0], v1 = acc[ai][bj][m][1];
            asm volatile("" : "+v"(v0), "+v"(v1));
            f32x4 o0, o1;
            o0[0] = (bf2f((u16)xr[0]) * st.x + st.y) * g0.x * siluf_(v0[0]); o0[1] = (bf2f((u16)xr[1]) * st.x + st.y) * g0.y * siluf_(v0[1]);
            o0[2] = (bf2f((u16)xr[2]) * st.x + st.y) * g0.z * siluf_(v0[2]); o0[3] = (bf2f((u16)xr[3]) * st.x + st.y) * g0.w * siluf_(v0[3]);
            o1[0] = (bf2f((u16)xr[4]) * st.x + st.y) * g1.x * siluf_(v1[0]); o1[1] = (bf2f((u16)xr[5]) * st.x + st.y) * g1.y * siluf_(v1[1]);
            o1[2] = (bf2f((u16)xr[6]) * st.x + st.y) * g1.z * siluf_(v1[2]); o1[3] = (bf2f((u16)xr[7]) * st.x + st.y) * g1.w * siluf_(v1[3]);
            *(u32x4*)(Sb + rl * 4096u + 2048u + branch * 1024 + cb) = pack8v(o0, o1);
            __builtin_amdgcn_sched_barrier(0);
          }
      }
    } else {
#pragma unroll
      for (int bj = 0; bj < 2; ++bj) {
        const unsigned cb = (u.pn - 8) * 256 + bj * 128 + wc * 32 + fq * 8;
#pragma unroll
        for (int ai = 0; ai < 2; ++ai)
#pragma unroll
          for (int m = 0; m < 4; ++m) {
            const unsigned rl = rl0 + ai * 128 + m * 16;
            f32x4 v0 = acc[ai][bj][m][0], v1 = acc[ai][bj][m][1];
            asm volatile("" : "+v"(v0), "+v"(v1));
            f32x4 o0, o1;
#pragma unroll
            for (int j = 0; j < 4; ++j) { o0[j] = sigmoidf_(v0[j]); o1[j] = sigmoidf_(v1[j]); }
            *(u32x4*)(Sb + rl * 4096u + cb) = pack8v(o0, o1);
            __builtin_amdgcn_sched_barrier(0);
          }
      }
    }
  }
};

struct EpiMerge {
  static constexpr bool PERM = true;
  const u16* S; u16* MG; int pass;
  __device__ __forceinline__ void operator()(const f32x4 (&acc)[2][2][4][2], const pg8::Unit& u, int wr, int wc, int fr, int fq, int lane) const {
    const u16* Sb = S + (size_t)u.pm * 256 * 4096 + pass * 1024;
    u16* MGb = MG + (size_t)u.pm * 256 * 1024;
    unsigned rl0 = wr * 64 + fr; asm volatile("" : "+v"(rl0));
#pragma unroll
    for (int bj = 0; bj < 2; ++bj) {
      const unsigned cb = u.pn * 256 + bj * 128 + wc * 32 + fq * 8;
#pragma unroll
      for (int ai = 0; ai < 2; ++ai)
#pragma unroll
        for (int m = 0; m < 4; ++m) {
          const unsigned rl = rl0 + ai * 128 + m * 16;
          const bf16x8 gt = *(const bf16x8*)(Sb + rl * 4096u + cb);
          f32x4 o0 = acc[ai][bj][m][0], o1 = acc[ai][bj][m][1];
#pragma unroll
          for (int j = 0; j < 4; ++j) { o0[j] *= bf2f((u16)gt[j]); o1[j] *= bf2f((u16)gt[4 + j]); }
          if (pass) {
            const bf16x8 old = *(const bf16x8*)(MGb + rl * 1024u + cb);
#pragma unroll
            for (int j = 0; j < 4; ++j) { o0[j] += bf2f((u16)old[j]); o1[j] += bf2f((u16)old[4 + j]); }
          }
          *(u32x4*)(MGb + rl * 1024u + cb) = pack8v(o0, o1);
            __builtin_amdgcn_sched_barrier(0);
        }
    }
  }
};

struct EpiOut {
  static constexpr bool PERM = false;
  const float* x_lat; const float* x_ctx; float* o_lat; float* o_ctx; const float* mod;
  __device__ __forceinline__ void operator()(const f32x4 (&acc)[2][2][4][2], const pg8::Unit& u, int wr, int wc, int fr, int fq, int lane) const {
    const float* hin; float* hout; int rmod;
    if (u.pm < 128) { hin = x_lat + (size_t)u.pm * 256 * DM; hout = o_lat + (size_t)u.pm * 256 * DM; rmod = u.pm >> 4; }
    else { hin = x_ctx + (size_t)(u.pm - 128) * 256 * DM; hout = o_ctx + (size_t)(u.pm - 128) * 256 * DM; rmod = 8; }
    const float* gate = mod + rmod * 3072 + 2048;
    unsigned rl0 = wr * 64 + fr; asm volatile("" : "+v"(rl0));
#pragma unroll
    for (int bj = 0; bj < 2; ++bj)
#pragma unroll
      for (int n = 0; n < 2; ++n) {
        const unsigned cb = u.pn * 256 + bj * 128 + wc * 32 + n * 16 + fq * 4;
        const float4 g = *(const float4*)(gate + cb);
#pragma unroll
        for (int ai = 0; ai < 2; ++ai)
#pragma unroll
          for (int m = 0; m < 4; ++m) {
            const unsigned o = (rl0 + ai * 128 + m * 16) * 1024u + cb;
            const float4 h = *(const float4*)(hin + o);
            const f32x4 v = acc[ai][bj][m][n];
            *(float4*)(hout + o) = make_float4(h.x + g.x * v[0], h.y + g.y * v[1], h.z + g.z * v[2], h.w + g.w * v[3]);
          }
      }
  }
};

__device__ __forceinline__ void phase_stats(const Params& p, int l) {
  const int tid = opaque_tid(); const int wave = tid >> 6, lane = tid & 63;
  const u16* RG = (const u16*)(p.ws + OFF_RG);
  float* ST = (float*)(p.ws + OFF_STATS);
  const int nrows = (l == 0) ? MTOT : MLAT;
  for (int row = (blockIdx.x * 8 + wave) * 4; row < nrows; row += gridDim.x * 32) {
    bf16x8 v[4][4];
#pragma unroll
    for (int q = 0; q < 4; ++q)
#pragma unroll
      for (int i = 0; i < 4; ++i) v[q][i] = *(const bf16x8*)(RG + (size_t)(row + q) * 2048 + i * 512 + lane * 8);
#pragma unroll
    for (int q = 0; q < 4; ++q)
#pragma unroll
      for (int i = 0; i < 4; ++i) {
        float s1 = 0.f, s2 = 0.f;
#pragma unroll
        for (int x = 0; x < 8; ++x) { float a = bf2f((u16)v[q][i][x]); s1 += a; s2 += a * a; }
#pragma unroll
        for (int o = 16; o > 0; o >>= 1) {
          s1 += __int_as_float(__builtin_amdgcn_ds_bpermute((lane ^ o) << 2, __float_as_int(s1)));
          s2 += __int_as_float(__builtin_amdgcn_ds_bpermute((lane ^ o) << 2, __float_as_int(s2)));
        }
        float sa, sb;
        if ((i >> 1) == 0) { float mu = s1 * (1.f / 256.f); float var = fmaxf(s2 * (1.f / 256.f) - mu * mu, 0.f); sa = rsqrtf(var + 1e-6f); sb = -mu * sa; }
        else { sa = rsqrtf(s2 * (1.f / 256.f) + 1e-6f); sb = 0.f; }
        if ((lane & 31) == 0) *(float2*)(ST + ((size_t)(row + q) * 8 + (i >> 1) * 4 + 2 * (i & 1) + (lane >> 5)) * 2) = make_float2(sa, sb);
      }
  }
}

#define OFF_VECS OFF_WT
__device__ __forceinline__ float logsig16(float x) { return (fminf(x, 0.f) - __logf(1.f + __expf(-fabsf(x)))) * (1.f / 16.f); }

typedef __attribute__((ext_vector_type(2))) float f32x2_t;

template <int SW>
__device__ __forceinline__ void prepass_sweep4(const float* GLRS, const f32x2_t (&w2)[4][16], const f32x2_t (&b2)[4], u16* Sq, u16* Ub,
                                               float (&accF)[4], float (&accB)[4]) {
#pragma unroll
  for (int c = 0; c < 4; ++c) { accF[c] = 0.f; accB[c] = 0.f; }
#pragma unroll 2
  for (int u = 0; u < 32; ++u) {
    const int i = SW ? 32 + u : 31 - u;
    const bf16x4 q4 = *(const bf16x4*)(Sq + (unsigned)i * 4096u);
    const bf16x4 k4 = *(const bf16x4*)(Sq + (unsigned)i * 4096u + 512u);
    const float4* gr = (const float4*)(GLRS + (i & 31) * 16);
    const float4 g0 = gr[0], g1 = gr[1], g2 = gr[2], g3 = gr[3];
    bf16x4 oqf, okf, oqb, okb;
#pragma unroll
    for (int c = 0; c < 4; ++c) {
      f32x2_t x = b2[c];
      x = w2[c][0] * g0.x + x;  x = w2[c][1] * g0.y + x;  x = w2[c][2] * g0.z + x;  x = w2[c][3] * g0.w + x;
      x = w2[c][4] * g1.x + x;  x = w2[c][5] * g1.y + x;  x = w2[c][6] * g1.z + x;  x = w2[c][7] * g1.w + x;
      x = w2[c][8] * g2.x + x;  x = w2[c][9] * g2.y + x;  x = w2[c][10] * g2.z + x; x = w2[c][11] * g2.w + x;
      x = w2[c][12] * g3.x + x; x = w2[c][13] * g3.y + x; x = w2[c][14] * g3.z + x; x = w2[c][15] * g3.w + x;
      const float laf = logsig16(x.x), lab = logsig16(x.y);
      float relf, relb;
      if (SW == 0) { relf = -accF[c]; accF[c] += laf; accB[c] += lab; relb = accB[c]; }
      else         { accF[c] += laf; relf = accF[c]; relb = -accB[c]; accB[c] += lab; }
      const float q = bf2f((u16)q4[c]), k = bf2f((u16)k4[c]);
      oqf[c] = (short)f2bf(q * __expf(relf)); okf[c] = (short)f2bf(k * __expf(-relf));
      oqb[c] = (short)f2bf(q * __expf(relb)); okb[c] = (short)f2bf(k * __expf(-relb));
    }
    *(bf16x4*)(Sq + (unsigned)i * 4096u) = oqf;
    *(bf16x4*)(Sq + (unsigned)i * 4096u + 512u) = okf;
    *(bf16x4*)(Ub + (unsigned)i * 1024u) = oqb;
    *(bf16x4*)(Ub + (unsigned)i * 1024u + 512u) = okb;
  }
}

__device__ __forceinline__ void gla_prepass_unit(const Params& p, int l, int bunit, char* smem) {
  const int tid = opaque_tid();
  const int ul = __builtin_amdgcn_readfirstlane(tid >> 7);
  const int gu = bunit * 4 + ul;
  const int sw = gu & 1, ch = gu >> 1;
  const int b = ch / 68, cid = ch % 68;
  const int base = cid < 4 ? (MLAT + b * 256 + cid * 64) : (b * 4096 + (cid - 4) * 64);
  float* GLRS = (float*)smem + ul * 512;
  const int col0 = (tid & 127) * 4;
  __syncthreads();
  {
    const int uw = (tid >> 6) & 1, lane = tid & 63, fr = lane & 15, fq = lane >> 4;
    f32x4 g = (f32x4){0.f, 0.f, 0.f, 0.f};
    const u16* Ua = (const u16*)(p.ws + OFF_U) + (size_t)(base + sw * 32 + uw * 16 + fr) * 1024 + fq * 8;
    const u16* Wb = (const u16*)(p.ws + OFF_WT) + (size_t)(4096 + fr) * 1024 + fq * 8;
#pragma unroll 16
    for (int k = 0; k < 1024; k += 32) {
      bf16x8 a = *(const bf16x8*)(Ua + k);
      bf16x8 w = *(const bf16x8*)(Wb + k);
      g = __builtin_amdgcn_mfma_f32_16x16x32_bf16(a, w, g, 0, 0, 0);
    }
#pragma unroll
    for (int j = 0; j < 4; ++j) GLRS[(uw * 16 + fq * 4 + j) * 16 + fr] = g[j];
  }
  f32x2_t w2[4][16], b2[4];
  {
    const float* w0 = p.gla_w_up + (size_t)(l * 2 + 0) * 16 * 512 + col0;
    const float* w1 = p.gla_w_up + (size_t)(l * 2 + 1) * 16 * 512 + col0;
#pragma unroll
    for (int r = 0; r < 16; ++r) {
      const float4 a = *(const float4*)(w0 + r * 512), c = *(const float4*)(w1 + r * 512);
      w2[0][r].x = a.x; w2[1][r].x = a.y; w2[2][r].x = a.z; w2[3][r].x = a.w;
      w2[0][r].y = c.x; w2[1][r].y = c.y; w2[2][r].y = c.z; w2[3][r].y = c.w;
    }
    const float4 a = *(const float4*)(p.gla_b_up + (l * 2 + 0) * 512 + col0), c = *(const float4*)(p.gla_b_up + (l * 2 + 1) * 512 + col0);
    b2[0].x = a.x; b2[1].x = a.y; b2[2].x = a.z; b2[3].x = a.w;
    b2[0].y = c.x; b2[1].y = c.y; b2[2].y = c.z; b2[3].y = c.w;
  }
  __syncthreads();
  u16* Sq = (u16*)(p.ws + OFF_S) + (size_t)base * 4096 + 2048 + col0;
  u16* Ub = (l == 0 ? (u16*)p.out : (u16*)(p.ws + OFF_U)) + (size_t)base * 1024 + col0;
  float* V0 = (float*)(p.ws + OFF_VECS) + ((size_t)(0 * 544 + b * 68 + cid) * 2) * 512 + col0;
  float* V1 = (float*)(p.ws + OFF_VECS) + ((size_t)(1 * 544 + b * 68 + cid) * 2) * 512 + col0;
  float accF[4], accB[4];
  if (sw == 0) {
    prepass_sweep4<0>(GLRS, w2, b2, Sq, Ub, accF, accB);
    *(float4*)(V0) = make_float4(__expf(accF[0]), __expf(accF[1]), __expf(accF[2]), __expf(accF[3]));
    *(float4*)(V1 + 512) = make_float4(__expf(accB[0]), __expf(accB[1]), __expf(accB[2]), __expf(accB[3]));
  } else {
    prepass_sweep4<1>(GLRS, w2, b2, Sq, Ub, accF, accB);
    *(float4*)(V0 + 512) = make_float4(__expf(accF[0]), __expf(accF[1]), __expf(accF[2]), __expf(accF[3]));
    *(float4*)(V1) = make_float4(__expf(accB[0]), __expf(accB[1]), __expf(accB[2]), __expf(accB[3]));
  }
}

template <int SW>
__device__ __forceinline__ void prepass_sweep(const float* GLRS, const f32x2_t (&w2)[16], f32x2_t b2, u16* Sq, u16* Ub, float& accF, float& accB) {
  accF = 0.f; accB = 0.f;
#pragma unroll 16
  for (int u = 0; u < 32; ++u) {
    const int i = SW ? 32 + u : 31 - u;
    const float4* gr = (const float4*)(GLRS + i * 16);
    const float4 g0 = gr[0], g1 = gr[1], g2 = gr[2], g3 = gr[3];
    f32x2_t x = b2;
    x = w2[0] * g0.x + x;  x = w2[1] * g0.y + x;  x = w2[2] * g0.z + x;  x = w2[3] * g0.w + x;
    x = w2[4] * g1.x + x;  x = w2[5] * g1.y + x;  x = w2[6] * g1.z + x;  x = w2[7] * g1.w + x;
    x = w2[8] * g2.x + x;  x = w2[9] * g2.y + x;  x = w2[10] * g2.z + x; x = w2[11] * g2.w + x;
    x = w2[12] * g3.x + x; x = w2[13] * g3.y + x; x = w2[14] * g3.z + x; x = w2[15] * g3.w + x;
    const float laf = logsig16(x.x), lab = logsig16(x.y);
    float relf, relb;
    if (SW == 0) { relf = -accF; accF += laf; accB += lab; relb = accB; }
    else         { accF += laf; relf = accF; relb = -accB; accB += lab; }
    const float q = bf2f(Sq[(unsigned)i * 4096u]), k = bf2f(Sq[(unsigned)i * 4096u + 512u]);
    Sq[(unsigned)i * 4096u] = f2bf(q * __expf(relf));
    Sq[(unsigned)i * 4096u + 512u] = f2bf(k * __expf(-relf));
    Ub[(unsigned)i * 1024u] = f2bf(q * __expf(relb));
    Ub[(unsigned)i * 1024u + 512u] = f2bf(k * __expf(-relb));
  }
}

__device__ __forceinline__ void gla_prepass_unit1(const Params& p, int l, int unit, char* smem) {
  const int tid = opaque_tid();
  const int sw = unit & 1, ch = unit >> 1;
  const int b = ch / 68, cid = ch % 68;
  const int base = cid < 4 ? (MLAT + b * 256 + cid * 64) : (b * 4096 + (cid - 4) * 64);
  float* GLRS = (float*)smem;
  __syncthreads();
  {
    const int wid = tid >> 6, lane = tid & 63, fr = lane & 15, fq = lane >> 4;
    if (wid < 2) {
      const int r0 = sw * 32 + wid * 16;
      f32x4 g = (f32x4){0.f, 0.f, 0.f, 0.f};
      const u16* Ua = (const u16*)(p.ws + OFF_U) + (size_t)(base + r0 + fr) * 1024 + fq * 8;
      const u16* Wb = (const u16*)(p.ws + OFF_WT) + (size_t)(4096 + fr) * 1024 + fq * 8;
#pragma unroll 16
      for (int k = 0; k < 1024; k += 32) {
        bf16x8 a = *(const bf16x8*)(Ua + k);
        bf16x8 w = *(const bf16x8*)(Wb + k);
        g = __builtin_amdgcn_mfma_f32_16x16x32_bf16(a, w, g, 0, 0, 0);
      }
#pragma unroll
      for (int j = 0; j < 4; ++j) GLRS[(r0 + fq * 4 + j) * 16 + fr] = g[j];
    }
  }
  f32x2_t w2[16];
  {
    const float* w0 = p.gla_w_up + (size_t)(l * 2 + 0) * 16 * 512 + tid;
    const float* w1 = p.gla_w_up + (size_t)(l * 2 + 1) * 16 * 512 + tid;
#pragma unroll
    for (int r = 0; r < 16; ++r) { w2[r].x = w0[r * 512]; w2[r].y = w1[r * 512]; }
  }
  f32x2_t b2; b2.x = p.gla_b_up[(l * 2 + 0) * 512 + tid]; b2.y = p.gla_b_up[(l * 2 + 1) * 512 + tid];
  __syncthreads();
  u16* Sq = (u16*)(p.ws + OFF_S) + (size_t)base * 4096 + 2048 + tid;
  u16* Ub = (l == 0 ? (u16*)p.out : (u16*)(p.ws + OFF_U)) + (size_t)base * 1024 + tid;
  float* V0 = (float*)(p.ws + OFF_VECS) + ((size_t)(0 * 544 + b * 68 + cid) * 2) * 512 + tid;
  float* V1 = (float*)(p.ws + OFF_VECS) + ((size_t)(1 * 544 + b * 68 + cid) * 2) * 512 + tid;
  float accF, accB;
  if (sw == 0) {
    prepass_sweep<0>(GLRS, w2, b2, Sq, Ub, accF, accB);
    V0[0] = __expf(accF);
    V1[512] = __expf(accB);
  } else {
    prepass_sweep<1>(GLRS, w2, b2, Sq, Ub, accF, accB);
    V0[512] = __expf(accF);
    V1[0] = __expf(accB);
  }
}

#define L_QR   0
#define L_KR   17408
#define L_V    34816
#define L_SGT  44032
#define L_P    61440
#undef  SCAN_GB
#define SCAN_GB 70656

__device__ __forceinline__ int off128(int row, int col) { return row * 272 + col * 2; }
__device__ __forceinline__ int off64(int row, int col) { return row * 144 + col * 2; }

template <int RS>
__device__ __forceinline__ bf16x8 tr_frag(unsigned img_addr, int r0, int c0, int lane) {
  const int g = lane >> 4, q = (lane & 15) >> 2, pp = lane & 3;
  unsigned a = img_addr + (unsigned)((r0 + 8 * g + q) * RS + (c0 + 4 * pp) * 2);
  bf16x4 lo, hi;
  asm volatile("ds_read_b64_tr_b16 %0, %2\n\tds_read_b64_tr_b16 %1, %2 offset:%3\n\ts_waitcnt lgkmcnt(0)"
               : "=&v"(lo), "=&v"(hi) : "v"(a), "n"(4 * RS) : "memory");
  bf16x8 r;
  r[0] = lo[0]; r[1] = lo[1]; r[2] = lo[2]; r[3] = lo[3]; r[4] = hi[0]; r[5] = hi[1]; r[6] = hi[2]; r[7] = hi[3];
  return r;
}

typedef short trs4_t __attribute__((ext_vector_type(4)));
__device__ __forceinline__ bf16x8 tr_pair(const char* p, int hi_off) {
  trs4_t lo = __builtin_amdgcn_ds_read_tr16_b64_v4i16((__attribute__((address_space(3))) trs4_t*)p);
  trs4_t hi = __builtin_amdgcn_ds_read_tr16_b64_v4i16((__attribute__((address_space(3))) trs4_t*)(p + hi_off));
  return __builtin_shufflevector(lo, hi, 0, 1, 2, 3, 4, 5, 6, 7);
}

__device__ __forceinline__ bf16x8 scale8(bf16x8 v, float f) {
  bf16x8 o;
#pragma unroll
  for (int x = 0; x < 8; ++x) o[x] = (short)f2bf(bf2f((u16)v[x]) * f);
  return o;
}

__device__ __forceinline__ void lds_barrier() { asm volatile("s_waitcnt lgkmcnt(0)" ::: "memory"); __builtin_amdgcn_s_barrier(); asm volatile("" ::: "memory"); }

template <int branch>
__device__ __forceinline__ void scan_item(const Params& p, int l, int item, char* smem) {
  const int b = (item >> 4) & 7, h = (item >> 2) & 3, slice = item & 3;
  const int tid = opaque_tid(), wid = __builtin_amdgcn_readfirstlane(tid >> 6), lane = tid & 63;
  const int dir = wid >> 2, gw = wid & 3, gt = tid & 255;
  const int fr = lane & 15, fq = lane >> 4;
  char* G = smem + dir * SCAN_GB;
  const unsigned Ga = (unsigned)(size_t)G;
  const u16* S = (const u16*)(p.ws + OFF_S);
  u16* RG = (u16*)(p.ws + OFF_RG);
  const u16* qsrc; unsigned qstride;
  if (branch == 0) { qsrc = S + h * 128; qstride = 4096; }
  else if (dir == 0) { qsrc = S + 2048 + h * 128; qstride = 4096; }
  else { qsrc = (l == 0 ? (const u16*)p.out : (const u16*)(p.ws + OFF_U)) + h * 128; qstride = 1024; }
  const int voff = branch * 2048 + 1024 + h * 256 + slice * 64;
  const int ooff = branch * 1024 + h * 256 + slice * 64;
  float lg = 0.f, egc = 1.f;
  if (branch == 0) { lg = __logf(1.f - __expf(p.ret_decay[(l * 2 + dir) * 4 + h])); egc = __expf(32.f * lg); }
  const float* VECS = (const float*)(p.ws + OFF_VECS) + ((size_t)(dir * 544 + b * 68) * 2) * 512 + h * 128;
  f32x4 st[2][4];
#pragma unroll
  for (int m = 0; m < 2; ++m)
#pragma unroll
    for (int n = 0; n < 4; ++n) st[m][n] = (f32x4){0.f, 0.f, 0.f, 0.f};

  const int qj = gt >> 4, qc = gt & 15;
  const int vj = gt >> 3, vc = gt & 7;
  bf16x8 pq[4], pk[4], pv[2];
  float4 peg[2], pel[2];
  auto prefetch = [&](int s) {
    int base, cid;
    if (s < 4) { int cc = dir ? 3 - s : s; base = MLAT + b * 256 + cc * 64; cid = cc; }
    else { int c = s - 4; int cc = dir ? 63 - c : c; base = b * 4096 + cc * 64; cid = 4 + cc; }
#pragma unroll
    for (int i = 0; i < 4; ++i) {
      int jp = qj + 16 * i;
      const u16* qb_ = qsrc + (size_t)base * qstride;
      unsigned ro = (unsigned)(dir ? 63 - jp : jp) * qstride + qc * 8;
      pq[i] = *(const bf16x8*)(qb_ + ro);
      pk[i] = *(const bf16x8*)(qb_ + ro + 512);
    }
#pragma unroll
    for (int i = 0; i < 2; ++i) {
      int jp = vj + 32 * i;
      pv[i] = *(const bf16x8*)((S + (size_t)base * 4096 + voff) + ((unsigned)(dir ? 63 - jp : jp) * 4096u + vc * 8));
    }
    (void)cid;
  };
  auto prefetch_vecs = [&](int s) {
    if (branch == 1) {
      int cid;
      if (s < 4) { cid = dir ? 3 - s : s; } else { int c = s - 4; cid = 4 + (dir ? 63 - c : c); }
#pragma unroll
      for (int m = 0; m < 2; ++m) {
        int d0 = gw * 32 + m * 16 + fq * 4;
        peg[m] = *(const float4*)(VECS + (size_t)cid * 1024 + d0);
        pel[m] = *(const float4*)(VECS + (size_t)cid * 1024 + 512 + d0);
      }
    } else {
#pragma unroll
      for (int m = 0; m < 2; ++m) { peg[m] = make_float4(egc, egc, egc, egc); pel[m] = peg[m]; }
    }
  };
  prefetch(0);
  prefetch_vecs(0);
  __syncthreads();

  for (int s = 0; s < 68; ++s) {
    int base; bool first; bool wout;
    if (s < 4) { int cc = dir ? 3 - s : s; base = MLAT + b * 256 + cc * 64; first = s < 2; wout = (l == 0); }
    else { int c = s - 4; int cc = dir ? 63 - c : c; base = b * 4096 + cc * 64; first = c < 32; wout = true; }
    float4 (&eg)[2] = peg; float4 (&el)[2] = pel;
#pragma unroll
    for (int i = 0; i < 4; ++i) {
      int jp = qj + 16 * i;
      bf16x8 qv = pq[i], kv_ = pk[i];
      if (branch == 0) {
        float fqs = __expf((float)(jp - 31) * lg), fks = __expf((float)(31 - jp) * lg);
        qv = scale8(qv, fqs); kv_ = scale8(kv_, fks);
      }
      *(bf16x8*)(G + L_QR + off128(jp, qc * 8)) = qv;
      *(bf16x8*)(G + L_KR + off128(jp, qc * 8)) = kv_;
    }
#pragma unroll
    for (int i = 0; i < 2; ++i) *(bf16x8*)(G + L_V + off64(vj + 32 * i, vc * 8)) = pv[i];
#pragma unroll
    for (int m = 0; m < 2; ++m) {
      int d0 = gw * 32 + m * 16 + fq * 4;
#pragma unroll
      for (int n = 0; n < 4; ++n) {
        int e = n * 16 + fr;
        bf16x4 o4;
        o4[0] = (short)f2bf(st[m][n][0] * eg[m].x); o4[1] = (short)f2bf(st[m][n][1] * eg[m].y);
        o4[2] = (short)f2bf(st[m][n][2] * eg[m].z); o4[3] = (short)f2bf(st[m][n][3] * eg[m].w);
        *(bf16x4*)(G + L_SGT + off128(e, d0)) = o4;
      }
    }
    u16 oldv[4][4];
    u16* dstb = RG + (size_t)base * 2048 + ooff;
    if (wout && !first) {
#pragma unroll
      for (int r = 0; r < 4; ++r) {
        int ip = gw * 16 + fq * 4 + r;
        unsigned ro = (unsigned)(dir ? 63 - ip : ip) * 2048u + fr;
#pragma unroll
        for (int n = 0; n < 4; ++n) oldv[r][n] = dstb[ro + n * 16];
      }
    }
    if (s + 1 < 68) prefetch(s + 1);
    lds_barrier();
    f32x4 pt[4], o[4];
#pragma unroll
    for (int n = 0; n < 4; ++n) { pt[n] = (f32x4){0.f, 0.f, 0.f, 0.f}; o[n] = (f32x4){0.f, 0.f, 0.f, 0.f}; }
#pragma unroll
    for (int ks = 0; ks < 4; ++ks) {
      int kc = ks * 32 + fq * 8;
      bf16x8 qa = *(const bf16x8*)(G + L_QR + off128(gw * 16 + fr, kc));
#pragma unroll
      for (int n = 0; n < 4; ++n) {
        bf16x8 ka = *(const bf16x8*)(G + L_KR + off128(n * 16 + fr, kc));
        bf16x8 sb = *(const bf16x8*)(G + L_SGT + off128(n * 16 + fr, kc));
        pt[n] = __builtin_amdgcn_mfma_f32_16x16x32_bf16(ka, qa, pt[n], 0, 0, 0);
        o[n] = __builtin_amdgcn_mfma_f32_16x16x32_bf16(qa, sb, o[n], 0, 0, 0);
      }
    }
    {
      const int ip = gw * 16 + fr;
#pragma unroll
      for (int n = 0; n < 4; ++n) {
        const int j0 = n * 16 + fq * 4;
        bf16x4 w;
#pragma unroll
        for (int r = 0; r < 4; ++r) {
          int jp = j0 + r;
          bool keep = dir ? (ip > jp) : (ip >= jp);
          w[r] = (short)f2bf(keep ? pt[n][r] : 0.f);
        }
        *(bf16x4*)(G + L_P + off64(ip, j0)) = w;
      }
    }
    asm volatile("s_waitcnt lgkmcnt(0)" ::: "memory");
    {
      const int tg = lane >> 4, tq = (lane & 15) >> 2, tp = lane & 3;
#pragma unroll
      for (int m = 0; m < 2; ++m) {
        f32x4 kv[4];
#pragma unroll
        for (int n = 0; n < 4; ++n) kv[n] = (f32x4){0.f, 0.f, 0.f, 0.f};
#pragma unroll
        for (int ks = 0; ks < 2; ++ks) {
          int kc = ks * 32 + fq * 8;
          const char* kp = G + L_KR + (8 * tg + tq) * 272 + (gw * 32 + 4 * tp) * 2 + ks * 32 * 272 + m * 32;
          const char* vp = G + L_V + (8 * tg + tq) * 144 + (4 * tp) * 2 + ks * 32 * 144;
          const bf16x8 km = tr_pair(kp, 4 * 272);
          bf16x8 vb[4];
#pragma unroll
          for (int n = 0; n < 4; ++n) vb[n] = tr_pair(vp + n * 32, 4 * 144);
          bf16x8 pa;
          if (m == 0) pa = *(const bf16x8*)(G + L_P + off64(gw * 16 + fr, kc));
#pragma unroll
          for (int n = 0; n < 4; ++n) {
            if (m == 0) o[n] = __builtin_amdgcn_mfma_f32_16x16x32_bf16(pa, vb[n], o[n], 0, 0, 0);
            kv[n] = __builtin_amdgcn_mfma_f32_16x16x32_bf16(km, vb[n], kv[n], 0, 0, 0);
          }
        }
#pragma unroll
        for (int n = 0; n < 4; ++n) {
          st[m][n][0] = eg[m].x * el[m].x * st[m][n][0] + el[m].x * kv[n][0];
          st[m][n][1] = eg[m].y * el[m].y * st[m][n][1] + el[m].y * kv[n][1];
          st[m][n][2] = eg[m].z * el[m].z * st[m][n][2] + el[m].z * kv[n][2];
          st[m][n][3] = eg[m].w * el[m].w * st[m][n][3] + el[m].w * kv[n][3];
        }
      }
    }
    if (branch == 1 && s + 1 < 68) prefetch_vecs(s + 1);
    if (wout) {
#pragma unroll
      for (int r = 0; r < 4; ++r) {
        int ip = gw * 16 + fq * 4 + r;
        unsigned ro = (unsigned)(dir ? 63 - ip : ip) * 2048u + fr;
#pragma unroll
        for (int n = 0; n < 4; ++n) {
          float v = o[n][r];
          if (!first) v += bf2f(oldv[r][n]);
          dstb[ro + n * 16] = f2bf(v);
        }
      }
    }
    __syncthreads();
  }
}

#define NPHASE 18
__device__ __forceinline__ void run_phase(const Params& p, int ph, char* smem) {
  const int nblk = gridDim.x, bid = blockIdx.x;
  if (ph == 0) {
#ifdef REP_P0
    for (int rep = 0; rep < REP_P0; ++rep)
#endif
    for (int u = bid; u < WT_UNITS + 96 + 1; u += nblk) {
      if (u < 96) mod_unit(p, u, smem);
      else if (u == 96) rot_unit(p);
      else wt_unit(p, 0, u - 97, smem);
    }
    return;
  }
  if (ph == NPHASE - 1) { phase_final(p); return; }
  const int l = (ph - 1) / 8, sp = (ph - 1) % 8;
  PG8_LAS unsigned char* lds = (PG8_LAS unsigned char*)smem;
  switch (sp) {
    case 0:
      phase_u(p, l);
      if (l == 1) for (int u = bid; u < WT_UNITS; u += nblk) wt_unit(p, 1, u, smem);
      break;
    case 1: {
      pg8::Gemm g{(const u16*)(p.ws + OFF_U), (const u16*)(p.ws + OFF_WT) + (size_t)WT_SCAN * 1024, 1024, MTOT, 4096, 1024};
      pg8::StaticOrder S; S.init(g.M, g.N, nblk, bid);
      EpiScanIn E{(u16*)(p.ws + OFF_S), (const float*)(p.ws + OFF_ROT)};
      pg8::gemm_phase(lds, g, S, E, opaque_tid());
    } break;
    case 2:
      for (int t = bid; t < 256; t += nblk) gla_prepass_unit(p, l, t, smem);
      for (int t = 1024 + (bid + 96) % nblk; t < 1088; t += nblk) gla_prepass_unit1(p, l, t, smem);
      break;
    case 3:
#ifdef REP_SCAN
      for (int rep = 0; rep < REP_SCAN; ++rep)
#endif
      for (int t = bid; t < 256; t += nblk) { if (t < 128) scan_item<0>(p, l, t, smem); else scan_item<1>(p, l, t, smem); } break;
    case 4:
      if (l != 0) phase_u(p, l);
      phase_stats(p, l);
      break;
    case 5: {
      pg8::Gemm g{(const u16*)(p.ws + OFF_U), (const u16*)(p.ws + OFF_WT) + (size_t)WT_GATE * 1024, 1024, l == 0 ? MTOT : MLAT, 4096, 1024};
      pg8::StaticOrder S; S.init(g.M, g.N, nblk, bid);
      EpiGate E{(const u16*)(p.ws + OFF_RG), (const float*)(p.ws + OFF_STATS), (u16*)(p.ws + OFF_S), p.ret_norm_gain + l * 1024, p.gla_norm_gain + l * 1024};
      pg8::gemm_phase(lds, g, S, E, opaque_tid());
    } break;
    case 6: {
#pragma unroll 1
      for (int pass = 0; pass < 2; ++pass) {
        pg8::Gemm g{(const u16*)(p.ws + OFF_S) + 2048 + pass * 1024, (const u16*)(p.ws + OFF_WT) + (size_t)(WT_BRR + pass * 1024) * 1024, 4096, l == 0 ? MTOT : MLAT, 1024, 1024};
        pg8::StaticOrder S; S.init(g.M, g.N, nblk, bid);
        EpiMerge E{(const u16*)(p.ws + OFF_S), (u16*)(p.ws + OFF_U), pass};
        pg8::gemm_phase(lds, g, S, E, opaque_tid());
      }
    } break;
    case 7: {
      pg8::Gemm g{(const u16*)(p.ws + OFF_U), (const u16*)(p.ws + OFF_WT) + (size_t)WT_OUT * 1024, 1024, l == 0 ? MTOT : MLAT, 1024, 1024};
      pg8::StaticOrder S; S.init(g.M, g.N, nblk, bid);
      EpiOut E{l == 0 ? p.x : p.out, p.ctx, p.out, (float*)(p.ws + OFF_HCTX), (const float*)(p.ws + OFF_MOD) + (size_t)l * 9 * 3072};
      pg8::gemm_phase(lds, g, S, E, opaque_tid());
    } break;
  }
}

#define XB_TMO      128
#define XB_XCNT(j)  (256  + 64 * (j))
#define XB_XSUB(j)  (1280 + 64 * (j))
#define XB_XGEN(j)  (2304 + 64 * (j))
#define XB_TOP      3328
#define XB_TOPGEN   3392
#define XCD_BAR_WORDS 3456
#define XB_SPIN_CAP (1u << 18)
__device__ __forceinline__ unsigned xb_ld(unsigned* p)              { return __hip_atomic_load(p, __ATOMIC_RELAXED, __HIP_MEMORY_SCOPE_AGENT); }
__device__ __forceinline__ unsigned xb_add(unsigned* p, unsigned v) { return __hip_atomic_fetch_add(p, v, __ATOMIC_RELAXED, __HIP_MEMORY_SCOPE_AGENT); }
__device__ __forceinline__ unsigned xb_xcc_id() { return (unsigned)__builtin_amdgcn_s_getreg((3 << 11) | 20) & 0xFu; }
#define XB_SPIN(cond, bar) do { unsigned _sp = 0; while (cond) { __builtin_amdgcn_s_sleep(1); \
    if ((++_sp & 255u) == 0u) { if (xb_ld(&(bar)[XB_TMO])) break; if (_sp > XB_SPIN_CAP) { atomicAdd(&(bar)[XB_TMO], 1u); break; } } } } while (0)

__device__ __forceinline__ void xcd_barrier_complete(unsigned* bar, unsigned x, unsigned& nloc, unsigned& nx) {
  const unsigned G = gridDim.x * gridDim.y * gridDim.z;
  unsigned sum, cnt, mine, sp = 0u;
  for (;;) {
    sum = 0u; cnt = 0u; mine = 0u;
#pragma unroll
    for (unsigned j = 0; j < 16; ++j) { const unsigned c = xb_ld(&bar[XB_XCNT(j)]); sum += c; cnt += (c > 0u) ? 1u : 0u; mine = (j == x) ? c : mine; }
    if (sum == G) break;
    __builtin_amdgcn_s_sleep(1);
    if ((++sp & 255u) == 0u) { if (xb_ld(&bar[XB_TMO])) break; if (sp > XB_SPIN_CAP) { atomicAdd(&bar[XB_TMO], 1u); break; } }
  }
  nloc = mine > 0u ? mine : 1u; nx = cnt > 0u ? cnt : 1u;
}

__device__ __forceinline__ void xcd_barrier(unsigned* bar, volatile unsigned* st) {
  asm volatile("s_waitcnt vmcnt(0)" ::: "memory");
  __syncthreads();
  if (threadIdx.x == 0) {
    const unsigned x = xb_xcc_id();
    __builtin_amdgcn_s_waitcnt(0);
    unsigned nloc = st[0], nx = st[1];
    if (nloc == 0u) { xcd_barrier_complete(bar, x, nloc, nx); st[0] = nloc; st[1] = nx; }
    const unsigned old = xb_add(&bar[XB_XSUB(x)], 1u);
    const unsigned gen = old / nloc;
    if (old + 1u == (gen + 1u) * nloc) {
      __builtin_amdgcn_fence(__ATOMIC_RELEASE, "agent");
      asm volatile("s_waitcnt vmcnt(0)" ::: "memory");
      const unsigned og = xb_add(&bar[XB_TOP], 1u);
      const unsigned tg = og / nx;
      if (og + 1u == (tg + 1u) * nx) xb_add(&bar[XB_TOPGEN], 1u);
      else XB_SPIN(xb_ld(&bar[XB_TOPGEN]) == tg, bar);
      __builtin_amdgcn_fence(__ATOMIC_ACQUIRE, "agent");
      xb_add(&bar[XB_XGEN(x)], 1u);
      asm volatile("s_waitcnt vmcnt(0)" ::: "memory");
    } else {
      XB_SPIN(xb_ld(&bar[XB_XGEN(x)]) == gen, bar);
      __builtin_amdgcn_fence(__ATOMIC_ACQUIRE, "agent");
      asm volatile("s_waitcnt vmcnt(0)" ::: "memory");
    }
  }
  __syncthreads();
}

__global__ void __launch_bounds__(NTHREADS) mega(Params p, int ph_lo, int ph_hi, int coop) {
  extern __shared__ __attribute__((aligned(16))) char smem[];
  volatile unsigned* xst = (volatile unsigned*)(smem + XB_LDS_OFF);
  unsigned* xbar = (unsigned*)(p.ws + OFF_BAR);
  if (coop) {
    if (threadIdx.x == 0) { xst[0] = 0u; xst[1] = 0u; (void)xb_add(&xbar[XB_XCNT(xb_xcc_id())], 1u); }
    __syncthreads();
  }
  for (int ph = ph_lo; ph < ph_hi; ++ph) {
    run_phase(p, ph, smem);
    if (coop && ph + 1 < ph_hi) {
      if (ph == ph_lo) cg::this_grid().sync();
      else xcd_barrier(xbar, xst);
    }
  }
}

extern "C" void kernel_launch(void* const* d_in, const int* in_sizes, int n_in,
                              void* d_out, int out_size, void* d_ws, size_t ws_size,
                              hipStream_t stream) {
  Params p{};
  p.x = (const float*)d_in[0]; p.c = (const float*)d_in[1]; p.ctx = (const float*)d_in[2]; p.c_ctx = (const float*)d_in[3];
  p.norm_gain = (const float*)d_in[4]; p.w_ada = (const float*)d_in[5]; p.b_ada = (const float*)d_in[6]; p.w_in = (const float*)d_in[7];
  p.ret_decay = (const float*)d_in[8]; p.gla_w_up = (const float*)d_in[9]; p.gla_b_up = (const float*)d_in[10];
  p.ret_norm_gain = (const float*)d_in[11]; p.gla_norm_gain = (const float*)d_in[12];
  p.w_br_ret = (const float*)d_in[13]; p.w_br_gla = (const float*)d_in[14]; p.w_out = (const float*)d_in[15]; p.final_gain = (const float*)d_in[16];
  p.out = (float*)d_out; p.ws = (char*)d_ws;
  static int grid_blocks = 0;
  if (!grid_blocks) {
    hipFuncSetAttribute((const void*)mega, hipFuncAttributeMaxDynamicSharedMemorySize, LDS_BYTES);
    int dev = 0, cus = 0, per_cu = 0;
    hipGetDevice(&dev);
    hipDeviceGetAttribute(&cus, hipDeviceAttributeMultiprocessorCount, dev);
    hipOccupancyMaxActiveBlocksPerMultiprocessor(&per_cu, mega, NTHREADS, LDS_BYTES);
    if (per_cu < 1) per_cu = 1;
    grid_blocks = cus * 1;
  }
#ifdef MULTI_LAUNCH
  for (int ph = 0; ph < NPHASE; ++ph) {
    mega<<<dim3(grid_blocks), dim3(NTHREADS), LDS_BYTES, stream>>>(p, ph, ph + 1, 0);
  }
#else
  hipMemsetAsync((char*)d_ws + OFF_BAR, 0, 16384, stream);
  int lo = 0, hi = NPHASE, coop = 1;
  void* args[] = {&p, &lo, &hi, &coop};
  hipError_t e = hipLaunchCooperativeKernel((void*)mega, dim3(grid_blocks), dim3(NTHREADS), args, LDS_BYTES, stream);
  if (e != hipSuccess) fprintf(stderr, "cooperative launch failed: %s (grid %d)\n", hipGetErrorString(e), grid_blocks);
#endif
}
```

```cpp
#include <hip/hip_runtime.h>
#include <hip/hip_cooperative_groups.h>
#include <cstdio>
namespace cg = cooperative_groups;

typedef unsigned short u16;
using bf16x8 = __attribute__((ext_vector_type(8))) short;
using bf16x4 = __attribute__((ext_vector_type(4))) short;
using f32x4  = __attribute__((ext_vector_type(4))) float;

#define NTHREADS 512
#define DM 1024
#define NB 8
#define SEQL 4096
#define CTXL 256
#define MLAT 32768
#define MCTX 2048
#define MTOT 34816
#define INW 8208

#define OFF_S    0ull
#define OFF_RG   (OFF_S   + (size_t)MTOT * 4096 * 2)
#define OFF_U    (OFF_RG  + (size_t)MTOT * 2048 * 2)
#define OFF_WT   (OFF_U   + (size_t)MTOT * 1024 * 2)
#define WT_ROWS  11392
#define OFF_GLR  (OFF_WT  + (size_t)WT_ROWS * 1024 * 2)
#define OFF_HCTX (OFF_GLR + (size_t)MTOT * 16 * 4)
#define OFF_MOD  (OFF_HCTX+ (size_t)MCTX * 1024 * 4)
#define OFF_ROT  (OFF_MOD + (size_t)2 * 9 * 3072 * 4)
#define OFF_BAR  (OFF_ROT + (size_t)64 * 32 * 2 * 4)
#define OFF_END  (OFF_BAR + 16384)

#define WT_SCAN 0
#define WT_GATE 4224
#define WT_BRR  8320
#define WT_BRG  9344
#define WT_OUT  10368

#define XB_LDS_OFF 161792
#define LDS_BYTES 161808
#define SCAN_GB   80896

struct Params {
  const float* x; const float* c; const float* ctx; const float* c_ctx;
  const float* norm_gain; const float* w_ada; const float* b_ada; const float* w_in;
  const float* ret_decay; const float* gla_w_up; const float* gla_b_up;
  const float* ret_norm_gain; const float* gla_norm_gain;
  const float* w_br_ret; const float* w_br_gla; const float* w_out; const float* final_gain;
  float* out; char* ws;
};

__device__ __forceinline__ u16 f2bf(float f) {
  __bf16 h = (__bf16)f;
  return *(u16*)&h;
}
__device__ __forceinline__ float bf2f(u16 h) { return __uint_as_float(((unsigned)h) << 16); }
__device__ __forceinline__ float sigmoidf_(float x) { return __builtin_amdgcn_rcpf(1.f + __expf(-x)); }
__device__ __forceinline__ float siluf_(float x) { return x * __builtin_amdgcn_rcpf(1.f + __expf(-x)); }

__device__ __forceinline__ int opaque_tid() { int t = threadIdx.x; asm volatile("" : "+v"(t)); return t; }

__device__ __forceinline__ float wave_sum(float v, int lane) {
#pragma unroll
  for (int o = 32; o > 0; o >>= 1)
    v += __int_as_float(__builtin_amdgcn_ds_bpermute((lane ^ o) << 2, __float_as_int(v)));
  return v;
}

__device__ __forceinline__ const float* wt_src(const Params& p, int l, int n, int& ld) {
  if (n < WT_GATE) {
    int tile = n >> 7, cc = n & 127;
    int col;
    if (tile < 8) {
      int d = (cc & 64) | ((cc & 16) << 1) | ((cc & 32) >> 1) | (cc & 15);
      col = tile * 128 + d;
    } else if (tile < 16) col = 1024 + (tile - 8) * 128 + cc;
    else if (tile < 24) col = 3072 + (tile - 16) * 128 + cc;
    else if (tile < 32) col = 4096 + (tile - 24) * 128 + cc;
    else { if (cc >= 16) { ld = 0; return nullptr; } col = 6144 + cc; }
    ld = INW; return p.w_in + (size_t)l * DM * INW + col;
  } else if (n < WT_BRR) {
    int g = n - WT_GATE; int col;
    if (g < 1024) col = 2048 + g;
    else if (g < 2048) col = 5120 + (g - 1024);
    else if (g < 3072) col = 6160 + (g - 2048);
    else col = 7184 + (g - 3072);
    ld = INW; return p.w_in + (size_t)l * DM * INW + col;
  } else if (n < WT_BRG) { ld = DM; return p.w_br_ret + (size_t)l * DM * DM + (n - WT_BRR); }
  else if (n < WT_OUT)   { ld = DM; return p.w_br_gla + (size_t)l * DM * DM + (n - WT_BRG); }
  else                   { ld = DM; return p.w_out    + (size_t)l * DM * DM + (n - WT_OUT); }
}

#define WT_UNITS (178 * 4)
__device__ __forceinline__ void wt_unit(const Params& p, int l, int unit, char* smem) {
  float* tile = (float*)smem;
  int nb = unit >> 2, kg = unit & 3;
  int tid = opaque_tid();
  int n0 = nb * 64, kbase = kg * 256;
  float v[4][8];
  {
    int nl = tid & 63, kq = tid >> 6;
    int ld; const float* src = wt_src(p, l, n0 + nl, ld);
#pragma unroll
    for (int q = 0; q < 4; ++q)
#pragma unroll
      for (int i = 0; i < 8; ++i) v[q][i] = src ? src[(size_t)(kbase + q * 64 + kq + 8 * i) * ld] : 0.f;
  }
  u16* wt = (u16*)(p.ws + OFF_WT);
#pragma unroll
  for (int q = 0; q < 4; ++q) {
    __syncthreads();
    {
      int nl = tid & 63, kq = tid >> 6;
#pragma unroll
      for (int i = 0; i < 8; ++i) tile[(kq + 8 * i) * 65 + nl] = v[q][i];
    }
    __syncthreads();
    {
      int nl = tid >> 3, kq = tid & 7;
      bf16x8 o;
#pragma unroll
      for (int j = 0; j < 8; ++j) o[j] = (short)f2bf(tile[(kq * 8 + j) * 65 + nl]);
      *(bf16x8*)(wt + (size_t)(n0 + nl) * 1024 + kbase + q * 64 + kq * 8) = o;
    }
  }
  __syncthreads();
}

__device__ __forceinline__ void mod_unit(const Params& p, int unit, char* smem) {
  float* sc = (float*)smem;
  float* red = sc + 9 * 1024;
  int l = unit / 48, jb = unit % 48;
  int tid = opaque_tid();
  for (int i = tid; i < 9 * 1024; i += NTHREADS) {
    int r = i >> 10, k = i & 1023;
    float v = (r < 8) ? p.c[r * 1024 + k] : p.c_ctx[k];
    sc[i] = siluf_(v);
  }
  __syncthreads();
  int jl = tid & 63, kg = tid >> 6;
  int j = jb * 64 + jl;
  float acc[9];
#pragma unroll
  for (int r = 0; r < 9; ++r) acc[r] = 0.f;
  const float* w = p.w_ada + (size_t)l * DM * 3072 + j;
#pragma unroll 16
  for (int k = kg * 128; k < kg * 128 + 128; ++k) {
    float wv = w[(size_t)k * 3072];
#pragma unroll
    for (int r = 0; r < 9; ++r) acc[r] += sc[r * 1024 + k] * wv;
  }
#pragma unroll
  for (int r = 0; r < 9; ++r) red[(kg * 9 + r) * 64 + jl] = acc[r];
  __syncthreads();
  float* mod = (float*)(p.ws + OFF_MOD);
  for (int i = tid; i < 9 * 64; i += NTHREADS) {
    int r = i >> 6, jj = i & 63;
    float s = 0.f;
#pragma unroll
    for (int g = 0; g < 8; ++g) s += red[(g * 9 + r) * 64 + jj];
    mod[((size_t)l * 9 + r) * 3072 + jb * 64 + jj] = s + p.b_ada[l * 3072 + jb * 64 + jj];
  }
  __syncthreads();
}

__device__ __forceinline__ void rot_unit(const Params& p) {
  float* rot = (float*)(p.ws + OFF_ROT);
  for (int i = opaque_tid(); i < 64 * 32; i += NTHREADS) {
    int pos = i >> 5, f = i & 31;
    float inv = exp2f(-(float)f * (13.287712379549449f / 32.f));
    float ang = (float)pos * inv;
    rot[i * 2] = __cosf(ang);
    rot[i * 2 + 1] = __sinf(ang);
  }
}

__device__ __forceinline__ void phase_u(const Params& p, int l) {
  const int tid = opaque_tid(); int wave = tid >> 6, lane = tid & 63;
  const float* mod = (const float*)(p.ws + OFF_MOD) + (size_t)l * 9 * 3072;
  const float* gain = p.norm_gain + l * DM;
  u16* U = (u16*)(p.ws + OFF_U);
  for (int row = (blockIdx.x * 8 + wave) * 4; row < MTOT; row += gridDim.x * 32) {
    const float* h; int r;
    if (row < MLAT) { h = (l == 0 ? p.x : p.out) + (size_t)row * DM; r = row >> 12; }
    else { int cr = row - MLAT; h = (l == 0 ? p.ctx : (const float*)(p.ws + OFF_HCTX)) + (size_t)cr * DM; r = 8; }
    float4 v[4][4]; float ss[4];
#pragma unroll
    for (int q = 0; q < 4; ++q) {
      ss[q] = 0.f;
#pragma unroll
      for (int i = 0; i < 4; ++i) v[q][i] = *(const float4*)(h + q * DM + i * 256 + lane * 4);
    }
#pragma unroll
    for (int q = 0; q < 4; ++q) {
#pragma unroll
      for (int i = 0; i < 4; ++i) ss[q] += v[q][i].x * v[q][i].x + v[q][i].y * v[q][i].y + v[q][i].z * v[q][i].z + v[q][i].w * v[q][i].w;
      ss[q] = rsqrtf(wave_sum(ss[q], lane) * (1.f / 1024.f) + 1e-6f);
    }
    const float* sh = mod + r * 3072;
#pragma unroll
    for (int i = 0; i < 4; ++i) {
      int cidx = i * 256 + lane * 4;
      float4 g = *(const float4*)(gain + cidx);
      float4 s = *(const float4*)(sh + cidx);
      float4 sc = *(const float4*)(sh + 1024 + cidx);
      g.x *= (1.f + sc.x); g.y *= (1.f + sc.y); g.z *= (1.f + sc.z); g.w *= (1.f + sc.w);
#pragma unroll
      for (int q = 0; q < 4; ++q) {
        bf16x4 o;
        o[0] = (short)f2bf(v[q][i].x * ss[q] * g.x + s.x);
        o[1] = (short)f2bf(v[q][i].y * ss[q] * g.y + s.y);
        o[2] = (short)f2bf(v[q][i].z * ss[q] * g.z + s.z);
        o[3] = (short)f2bf(v[q][i].w * ss[q] * g.w + s.w);
        *(bf16x4*)(U + (size_t)(row + q) * DM + cidx) = o;
      }
    }
  }
}

__device__ __forceinline__ void phase_final(const Params& p) {
  const int tid = opaque_tid(); int wave = tid >> 6, lane = tid & 63;
  for (int row = (blockIdx.x * 8 + wave) * 4; row < MLAT; row += gridDim.x * 32) {
    float* h = p.out + (size_t)row * DM;
    float4 v[4][4]; float ss[4];
#pragma unroll
    for (int q = 0; q < 4; ++q) {
      ss[q] = 0.f;
#pragma unroll
      for (int i = 0; i < 4; ++i) v[q][i] = *(const float4*)(h + q * DM + i * 256 + lane * 4);
    }
#pragma unroll
    for (int q = 0; q < 4; ++q) {
#pragma unroll
      for (int i = 0; i < 4; ++i) ss[q] += v[q][i].x * v[q][i].x + v[q][i].y * v[q][i].y + v[q][i].z * v[q][i].z + v[q][i].w * v[q][i].w;
      ss[q] = rsqrtf(wave_sum(ss[q], lane) * (1.f / 1024.f) + 1e-6f);
    }
#pragma unroll
    for (int i = 0; i < 4; ++i) {
      int cidx = i * 256 + lane * 4;
      float4 g = *(const float4*)(p.final_gain + cidx);
#pragma unroll
      for (int q = 0; q < 4; ++q) {
        float4 o;
        o.x = v[q][i].x * ss[q] * g.x; o.y = v[q][i].y * ss[q] * g.y; o.z = v[q][i].z * ss[q] * g.z; o.w = v[q][i].w * ss[q] * g.w;
        *(float4*)(h + q * DM + cidx) = o;
      }
    }
  }
}

#define PG8_LAS __attribute__((address_space(3)))
typedef unsigned u32x4 __attribute__((ext_vector_type(4)));
namespace pg8 {
constexpr int BM = 256, BK = 64, HALF = 128, HTB = HALF * BK * 2, STAGE_BYTES = 8 * HTB, NXCD = 8, WGM = 8;
__device__ __forceinline__ int lds_byte(int r, int c) { const int st = (r >> 4) * 2 + (c >> 5), rr = r & 15, cc = c & 31, ob = rr * 64 + cc * 2; return st * 1024 + (ob ^ (((ob >> 9) & 1) << 5)); }
__device__ __forceinline__ void stage_rc(int b, int& R, int& C) { const int st = b / 1024, sb = b % 1024, swz = sb ^ (((sb >> 9) & 1) << 5); R = (st >> 1) * 16 + swz / 64; C = (st & 1) * 32 + (swz % 64) / 2; }
__device__ __forceinline__ int perm32(int rho) { const int n = rho >> 4, i = rho & 15; return 8 * (i >> 2) + 4 * n + (i & 3); }
struct Unit { int pm, pn; };
struct Gemm { const u16* A; const u16* Bt; int lda; int M, N, K; };
struct StaticOrder {
  int nM, nN, nwg, G, c;
  __device__ void init(int M, int N, int G_, int c_) { nM = M / BM; nN = N / BM; nwg = nM * nN; G = G_; c = c_; }
  __device__ bool next(int i, Unit& u) const {
    const long L = (long)i * G + c; if (L >= nwg) return false;
    int wgid = (int)L; { const int q = nwg / NXCD, r = nwg % NXCD, xcd = wgid % NXCD, off = wgid / NXCD; wgid = (xcd < r ? xcd * (q + 1) : r * (q + 1) + (xcd - r) * q) + off; }
    const int nig = WGM * nN, gid = wgid / nig, fm = gid * WGM, gsz = (nM - fm) < WGM ? (nM - fm) : WGM;
    u.pm = fm + ((wgid % nig) % gsz); u.pn = (wgid % nig) / gsz; return true;
  }
};
typedef __attribute__((ext_vector_type(2))) float cvt_f2_t;
typedef __attribute__((ext_vector_type(2))) __bf16 cvt_b2_t;
__device__ __forceinline__ unsigned cvt_pk_bf16(float lo, float hi) { cvt_f2_t f = {lo, hi}; cvt_b2_t r = __builtin_convertvector(f, cvt_b2_t); return __builtin_bit_cast(unsigned, r); }

template <class Epi>
__device__ __forceinline__ void gemm_phase(PG8_LAS unsigned char* lds, const Gemm g, const StaticOrder& S, const Epi& E, const int tid) {
  const int wid = __builtin_amdgcn_readfirstlane(tid >> 6), lane = tid & 63, wr = wid >> 2, wc = wid & 3, fr = lane & 15, fq = lane >> 4;
  const int K = g.K, nt = K / BK;
  unsigned voffA[2], voffB[2];
#pragma unroll
  for (int i = 0; i < 2; ++i) { int R, C; stage_rc(tid * 16 + i * 8192, R, C); const int Rb = Epi::PERM ? ((R & ~31) + perm32(R & 31)) : R;
    voffA[i] = (unsigned)(R * g.lda + C) * 2u; voffB[i] = (unsigned)(Rb * K + C) * 2u; }
  const size_t kstep = (size_t)(BK * 2);
  const size_t hstepA = (size_t)HALF * g.lda * 2, hstepB = (size_t)HALF * K * 2;
  const size_t tstepA = 2 * hstepA, tstepB = 2 * hstepB;
  const unsigned ldsw = (unsigned)wid * 1024u;
  const int aoff = lds_byte(wr * 64 + fr, fq * 8), boff = lds_byte(wc * 32 + fr, fq * 8);
#define PG8_SA(b, h) (((b) * 2 + (h)) * HTB)
#define PG8_SB(b, h) ((4 + (b) * 2 + (h)) * HTB)
#define PG8_STAGE(bufoff, gbase, voff) do { _Pragma("unroll") for (int _i = 0; _i < 2; ++_i) \
    __builtin_amdgcn_global_load_lds((const unsigned*)((const char*)(gbase) + (voff)[_i]), (PG8_LAS unsigned*)(lds + (bufoff) + ldsw + _i * 8192), 16, 0, 0); } while (0)
#define PG8_LDA(dst, b, h) do { _Pragma("unroll") for (int m = 0; m < 4; ++m) _Pragma("unroll") for (int k = 0; k < 2; ++k) dst[m][k] = *(const PG8_LAS bf16x8*)(lds + PG8_SA(b, h) + aoff + m * 2048 + k * 1024); } while (0)
#define PG8_LDB(dst, b, h) do { _Pragma("unroll") for (int n = 0; n < 2; ++n) _Pragma("unroll") for (int k = 0; k < 2; ++k) dst[n][k] = *(const PG8_LAS bf16x8*)(lds + PG8_SB(b, h) + boff + n * 2048 + k * 1024); } while (0)
#define PG8_MMA(ai, bj, At, Bt) do { __builtin_amdgcn_s_setprio(1); _Pragma("unroll") for (int m = 0; m < 4; ++m) _Pragma("unroll") for (int n = 0; n < 2; ++n) _Pragma("unroll") for (int k = 0; k < 2; ++k) \
    acc[ai][bj][m][n] = __builtin_amdgcn_mfma_f32_16x16x32_bf16(Bt[n][k], At[m][k], acc[ai][bj][m][n], 0, 0, 0); __builtin_amdgcn_s_setprio(0); } while (0)
#define PG8_WAIT_V(n) asm volatile("s_waitcnt vmcnt(" #n ")" ::: "memory")
#define PG8_WAIT_L(n) asm volatile("s_waitcnt lgkmcnt(" #n ")" ::: "memory")
#define PG8_BAR __builtin_amdgcn_s_barrier()
#define PG8_SCHED __builtin_amdgcn_sched_barrier(0)
  Unit cur, nxt; int ui = 0;
  if (!S.next(0, cur)) return;
  f32x4 acc[2][2][4][2];
#pragma unroll
  for (int a = 0; a < 2; ++a)
#pragma unroll
    for (int b = 0; b < 2; ++b)
#pragma unroll
      for (int m = 0; m < 4; ++m)
#pragma unroll
        for (int n = 0; n < 2; ++n) acc[a][b][m][n] = (f32x4){0.f, 0.f, 0.f, 0.f};
  bf16x8 At[4][2], B0[2][2], B1[2][2];
  const char* cA = (const char*)g.A + (size_t)cur.pm * tstepA; const char* cB = (const char*)g.Bt + (size_t)cur.pn * tstepB;
  PG8_STAGE(PG8_SB(0, 0), cB, voffB); PG8_STAGE(PG8_SA(0, 0), cA, voffA); PG8_STAGE(PG8_SB(0, 1), cB + hstepB, voffB); PG8_STAGE(PG8_SA(0, 1), cA + hstepA, voffA);
  if (wr == 1) PG8_BAR;
  PG8_WAIT_V(4); PG8_BAR;
  PG8_STAGE(PG8_SB(1, 0), cB + kstep, voffB); PG8_STAGE(PG8_SA(1, 0), cA + kstep, voffA); PG8_STAGE(PG8_SB(1, 1), cB + hstepB + kstep, voffB);
  PG8_WAIT_V(6); PG8_BAR;
  for (;;) {
    const bool has_next = S.next(ui + 1, nxt);
    const char* nA = has_next ? (const char*)g.A + (size_t)nxt.pm * tstepA : cA; const char* nB = has_next ? (const char*)g.Bt + (size_t)nxt.pn * tstepB : cB;
    for (int t = 0; t < nt; t += 2) {
      const bool last = (t == nt - 2);
      const char* a1 = cA + (size_t)(t + 1) * kstep;
      const char* a2 = last ? nA : cA + (size_t)(t + 2) * kstep; const char* b2 = last ? nB : cB + (size_t)(t + 2) * kstep;
      const char* a3 = a2 + kstep; const char* b3 = b2 + kstep;
      PG8_LDB(B0, 0, 0); PG8_SCHED; PG8_LDA(At, 0, 0); PG8_STAGE(PG8_SA(1, 1), a1 + hstepA, voffA);
      PG8_WAIT_L(8); PG8_BAR; PG8_WAIT_L(0); PG8_MMA(0, 0, At, B0); PG8_BAR; PG8_SCHED;
      PG8_LDB(B1, 0, 1); PG8_STAGE(PG8_SB(0, 0), b2, voffB);
      PG8_BAR; PG8_WAIT_L(0); PG8_MMA(0, 1, At, B1); PG8_BAR;
      PG8_LDA(At, 0, 1); PG8_STAGE(PG8_SA(0, 0), a2, voffA);
      PG8_BAR; PG8_WAIT_L(0); PG8_MMA(1, 0, At, B0); PG8_BAR; PG8_SCHED;
      PG8_STAGE(PG8_SB(0, 1), b2 + hstepB, voffB);
      PG8_WAIT_V(6); PG8_BAR; PG8_MMA(1, 1, At, B1); PG8_BAR;
      PG8_LDB(B0, 1, 0); PG8_SCHED; PG8_LDA(At, 1, 0); PG8_STAGE(PG8_SA(0, 1), a2 + hstepA, voffA);
      PG8_WAIT_L(8); PG8_BAR; PG8_WAIT_L(0); PG8_MMA(0, 0, At, B0); PG8_BAR; PG8_SCHED;
      PG8_LDB(B1, 1, 1); PG8_STAGE(PG8_SB(1, 0), b3, voffB);
      PG8_BAR; PG8_WAIT_L(0); PG8_MMA(0, 1, At, B1); PG8_BAR;
      PG8_LDA(At, 1, 1); PG8_STAGE(PG8_SA(1, 0), a3, voffA);
      PG8_BAR; PG8_WAIT_L(0); PG8_MMA(1, 0, At, B0); PG8_BAR; PG8_SCHED;
      PG8_STAGE(PG8_SB(1, 1), b3 + hstepB, voffB);
      PG8_WAIT_V(6); PG8_BAR; PG8_MMA(1, 1, At, B1); PG8_BAR;
    }
    E(acc, cur, wr, wc, fr, fq, lane);
    if (!has_next) break;
#pragma unroll
    for (int a = 0; a < 2; ++a)
#pragma unroll
      for (int b = 0; b < 2; ++b)
#pragma unroll
        for (int m = 0; m < 4; ++m)
#pragma unroll
          for (int n = 0; n < 2; ++n) acc[a][b][m][n] = (f32x4){0.f, 0.f, 0.f, 0.f};
    cur = nxt; cA = nA; cB = nB; ++ui;
  }
  PG8_WAIT_V(0);
  if (wr == 0) PG8_BAR;
  PG8_BAR;
#undef PG8_SA
#undef PG8_SB
#undef PG8_STAGE
#undef PG8_LDA
#undef PG8_LDB
#undef PG8_MMA
#undef PG8_WAIT_V
#undef PG8_WAIT_L
#undef PG8_BAR
#undef PG8_SCHED
}
}

#define OFF_STATS OFF_GLR

__device__ __forceinline__ u32x4 pack8v(const f32x4& a, const f32x4& b) {
  u32x4 w; w.x = pg8::cvt_pk_bf16(a[0], a[1]); w.y = pg8::cvt_pk_bf16(a[2], a[3]); w.z = pg8::cvt_pk_bf16(b[0], b[1]); w.w = pg8::cvt_pk_bf16(b[2], b[3]); return w;
}
__device__ __forceinline__ float xlane32(float v, int lane) { return __int_as_float(__builtin_amdgcn_ds_bpermute((lane ^ 32) << 2, __float_as_int(v))); }

struct EpiScanIn {
  static constexpr bool PERM = true;
  u16* S; const float* rot;
  __device__ __forceinline__ void operator()(const f32x4 (&acc)[2][2][4][2], const pg8::Unit& u, int wr, int wc, int fr, int fq, int lane) const {
    u16* Sb = S + (size_t)u.pm * 256 * 4096;
    unsigned rl0 = wr * 64 + fr; asm volatile("" : "+v"(rl0));
#pragma unroll
    for (int bj = 0; bj < 2; ++bj) {
      const int nt128 = u.pn * 2 + bj;
      const bool scaled = (nt128 < 4) || (nt128 >= 16 && nt128 < 20);
      const float scl = scaled ? 0.08838834764831845f : 1.f;
      const unsigned cb = nt128 * 128 + wc * 32 + fq * 8;
      if (nt128 < 8 && u.pm < 128) {
        const int tb = (u.pm & 15) * 256;
        const int fo = ((wc & 1) * 16 + (fq & 1) * 8) * 2;
        const float sgn = (fq >> 1) ? 1.f : -1.f;
#pragma unroll
        for (int ai = 0; ai < 2; ++ai)
#pragma unroll
          for (int m = 0; m < 4; ++m) {
            const unsigned rl = rl0 + ai * 128 + m * 16;
            const int t = tb + rl;
            const unsigned pos = (wc >> 1) == 0 ? (t >> 6) : (t & 63);
            const float* rp = rot + pos * 64u + fo;
            const float4 c0 = *(const float4*)rp, c1 = *(const float4*)(rp + 4), c2 = *(const float4*)(rp + 8), c3 = *(const float4*)(rp + 12);
            const f32x4 v0 = acc[ai][bj][m][0], v1 = acc[ai][bj][m][1];
            f32x4 p0, p1;
#pragma unroll
            for (int j = 0; j < 4; ++j) { p0[j] = xlane32(v0[j], lane); p1[j] = xlane32(v1[j], lane); }
            f32x4 o0, o1;
            o0[0] = (v0[0] * c0.x + sgn * p0[0] * c0.y) * scl; o0[1] = (v0[1] * c0.z + sgn * p0[1] * c0.w) * scl;
            o0[2] = (v0[2] * c1.x + sgn * p0[2] * c1.y) * scl; o0[3] = (v0[3] * c1.z + sgn * p0[3] * c1.w) * scl;
            o1[0] = (v1[0] * c2.x + sgn * p1[0] * c2.y) * scl; o1[1] = (v1[1] * c2.z + sgn * p1[1] * c2.w) * scl;
            o1[2] = (v1[2] * c3.x + sgn * p1[2] * c3.y) * scl; o1[3] = (v1[3] * c3.z + sgn * p1[3] * c3.w) * scl;
            *(u32x4*)(Sb + rl * 4096u + cb) = pack8v(o0, o1);
            __builtin_amdgcn_sched_barrier(0);
          }
      } else {
#pragma unroll
        for (int ai = 0; ai < 2; ++ai)
#pragma unroll
          for (int m = 0; m < 4; ++m) {
            const unsigned rl = rl0 + ai * 128 + m * 16;
            *(u32x4*)(Sb + rl * 4096u + cb) = pack8v(acc[ai][bj][m][0] * scl, acc[ai][bj][m][1] * scl);
            __builtin_amdgcn_sched_barrier(0);
          }
      }
    }
  }
};

struct EpiGate {
  static constexpr bool PERM = true;
  const u16* RG; const float* stats; u16* S; const float* rgain; const float* ggain;
  __device__ __forceinline__ void operator()(const f32x4 (&acc)[2][2][4][2], const pg8::Unit& u, int wr, int wc, int fr, int fq, int lane) const {
    u16* Sb = S + (size_t)u.pm * 256 * 4096;
    unsigned rl0 = wr * 64 + fr; asm volatile("" : "+v"(rl0));
    if (u.pn < 8) {
      const int branch = u.pn >> 2, head = u.pn & 3;
      const u16* RGb = RG + (size_t)u.pm * 256 * 2048 + branch * 1024;
      const float* stb = stats + (size_t)u.pm * 256 * 16 + (branch * 4 + head) * 2;
      const float* gain = branch ? ggain : rgain;
#pragma unroll
      for (int bj = 0; bj < 2; ++bj) {
        const unsigned cb = head * 256 + bj * 128 + wc * 32 + fq * 8;
        const float4 g0 = *(const float4*)(gain + cb), g1 = *(const float4*)(gain + cb + 4);
#pragma unroll
        for (int ai = 0; ai < 2; ++ai) {
        float2 stv[4]; bf16x8 xrv[4];
#pragma unroll
        for (int q = 0; q < 4; ++q) {
          const unsigned rl = rl0 + ai * 128 + q * 16;
          stv[q] = *(const float2*)(stb + rl * 16u);
          xrv[q] = *(const bf16x8*)(RGb + rl * 2048u + cb);
        }
        __builtin_amdgcn_sched_barrier(0);
#pragma unroll
          for (int m = 0; m < 4; ++m) {
            const unsigned rl = rl0 + ai * 128 + m * 16;
            const float2 st = stv[m];
            const bf16x8 xr = xrv[m];
            f32x4 v0 = acc[ai][bj][m][0], v1 = acc[ai][bj][m][1];
            asm volatile("" : "+v"(v0), "+v"(v1));
            f32x4 o0, o1;
            o0[0] = (bf2f((u16)xr[0]) * st.x + st.y) * g0.x * siluf_(v0[0]); o0[1] = (bf2f((u16)xr[1]) * st.x + st.y) * g0.y * siluf_(v0[1]);
            o0[2] = (bf2f((u16)xr[2]) * st.x + st.y) * g0.z * siluf_(v0[2]); o0[3] = (bf2f((u16)xr[3]) * st.x + st.y) * g0.w * siluf_(v0[3]);
            o1[0] = (bf2f((u16)xr[4]) * st.x + st.y) * g1.x * siluf_(v1[0]); o1[1] = (bf2f((u16)xr[5]) * st.x + st.y) * g1.y * siluf_(v1[1]);
            o1[2] = (bf2f((u16)xr[6]) * st.x + st.y) * g1.z * siluf_(v1[2]); o1[3] = (bf2f((u16)xr[7]) * st.x + st.y) * g1.w * siluf_(v1[3]);
            *(u32x4*)(Sb + rl * 4096u + 2048u + branch * 1024 + cb) = pack8v(o0, o1);
            __builtin_amdgcn_sched_barrier(0);
          }
        }
      }
    } else {
#pragma unroll
      for (int bj = 0; bj < 2; ++bj) {
        const unsigned cb = (u.pn - 8) * 256 + bj * 128 + wc * 32 + fq * 8;
#pragma unroll
        for (int ai = 0; ai < 2; ++ai)
#pragma unroll
          for (int m = 0; m < 4; ++m) {
            const unsigned rl = rl0 + ai * 128 + m * 16;
            f32x4 v0 = acc[ai][bj][m][0], v1 = acc[ai][bj][m][1];
            asm volatile("" : "+v"(v0), "+v"(v1));
            f32x4 o0, o1;
#pragma unroll
            for (int j = 0; j < 4; ++j) { o0[j] = sigmoidf_(v0[j]); o1[j] = sigmoidf_(v1[j]); }
            *(u32x4*)(Sb + rl * 4096u + cb) = pack8v(o0, o1);
            __builtin_amdgcn_sched_barrier(0);
          }
      }
    }
  }
};

struct EpiMerge {
  static constexpr bool PERM = true;
  const u16* S; u16* MG; int pass;
  __device__ __forceinline__ void operator()(const f32x4 (&acc)[2][2][4][2], const pg8::Unit& u, int wr, int wc, int fr, int fq, int lane) const {
    const u16* Sb = S + (size_t)u.pm * 256 * 4096 + pass * 1024;
    u16* MGb = MG + (size_t)u.pm * 256 * 1024;
    unsigned rl0 = wr * 64 + fr; asm volatile("" : "+v"(rl0));
#pragma unroll
    for (int bj = 0; bj < 2; ++bj) {
      const unsigned cb = u.pn * 256 + bj * 128 + wc * 32 + fq * 8;
#pragma unroll
      for (int ai = 0; ai < 2; ++ai) {
      bf16x8 gtv[4], oldv_[4];
#pragma unroll
      for (int q = 0; q < 4; ++q) {
        const unsigned rl = rl0 + ai * 128 + q * 16;
        gtv[q] = *(const bf16x8*)(Sb + rl * 4096u + cb);
        if (pass) oldv_[q] = *(const bf16x8*)(MGb + rl * 1024u + cb);
      }
      __builtin_amdgcn_sched_barrier(0);
#pragma unroll
        for (int m = 0; m < 4; ++m) {
          const unsigned rl = rl0 + ai * 128 + m * 16;
          const bf16x8 gt = gtv[m];
          f32x4 o0 = acc[ai][bj][m][0], o1 = acc[ai][bj][m][1];
#pragma unroll
          for (int j = 0; j < 4; ++j) { o0[j] *= bf2f((u16)gt[j]); o1[j] *= bf2f((u16)gt[4 + j]); }
          if (pass) {
            const bf16x8 old = oldv_[m];
#pragma unroll
            for (int j = 0; j < 4; ++j) { o0[j] += bf2f((u16)old[j]); o1[j] += bf2f((u16)old[4 + j]); }
          }
          *(u32x4*)(MGb + rl * 1024u + cb) = pack8v(o0, o1);
            __builtin_amdgcn_sched_barrier(0);
        }
      }
    }
  }
};

struct EpiOut {
  static constexpr bool PERM = false;
  const float* x_lat; const float* x_ctx; float* o_lat; float* o_ctx; const float* mod;
  __device__ __forceinline__ void operator()(const f32x4 (&acc)[2][2][4][2], const pg8::Unit& u, int wr, int wc, int fr, int fq, int lane) const {
    const float* hin; float* hout; int rmod;
    if (u.pm < 128) { hin = x_lat + (size_t)u.pm * 256 * DM; hout = o_lat + (size_t)u.pm * 256 * DM; rmod = u.pm >> 4; }
    else { hin = x_ctx + (size_t)(u.pm - 128) * 256 * DM; hout = o_ctx + (size_t)(u.pm - 128) * 256 * DM; rmod = 8; }
    const float* gate = mod + rmod * 3072 + 2048;
    unsigned rl0 = wr * 64 + fr; asm volatile("" : "+v"(rl0));
#pragma unroll
    for (int bj = 0; bj < 2; ++bj)
#pragma unroll
      for (int n = 0; n < 2; ++n) {
        const unsigned cb = u.pn * 256 + bj * 128 + wc * 32 + n * 16 + fq * 4;
        const float4 g = *(const float4*)(gate + cb);
        float4 hv[8];
#pragma unroll
        for (int q = 0; q < 8; ++q) hv[q] = *(const float4*)(hin + (rl0 + (q >> 2) * 128 + (q & 3) * 16) * 1024u + cb);
        __builtin_amdgcn_sched_barrier(0);
#pragma unroll
        for (int ai = 0; ai < 2; ++ai)
#pragma unroll
          for (int m = 0; m < 4; ++m) {
            const unsigned o = (rl0 + ai * 128 + m * 16) * 1024u + cb;
            const float4 h = hv[ai * 4 + m];
            const f32x4 v = acc[ai][bj][m][n];
            *(float4*)(hout + o) = make_float4(h.x + g.x * v[0], h.y + g.y * v[1], h.z + g.z * v[2], h.w + g.w * v[3]);
          }
      }
  }
};

__device__ __forceinline__ void phase_stats(const Params& p, int l) {
  const int tid = opaque_tid(); const int wave = tid >> 6, lane = tid & 63;
  const u16* RG = (const u16*)(p.ws + OFF_RG);
  float* ST = (float*)(p.ws + OFF_STATS);
  const int nrows = (l == 0) ? MTOT : MLAT;
  for (int row = (blockIdx.x * 8 + wave) * 4; row < nrows; row += gridDim.x * 32) {
    bf16x8 v[4][4];
#pragma unroll
    for (int q = 0; q < 4; ++q)
#pragma unroll
      for (int i = 0; i < 4; ++i) v[q][i] = *(const bf16x8*)(RG + (size_t)(row + q) * 2048 + i * 512 + lane * 8);
#pragma unroll
    for (int q = 0; q < 4; ++q)
#pragma unroll
      for (int i = 0; i < 4; ++i) {
        float s1 = 0.f, s2 = 0.f;
#pragma unroll
        for (int x = 0; x < 8; ++x) { float a = bf2f((u16)v[q][i][x]); s1 += a; s2 += a * a; }
#pragma unroll
        for (int o = 16; o > 0; o >>= 1) {
          s1 += __int_as_float(__builtin_amdgcn_ds_bpermute((lane ^ o) << 2, __float_as_int(s1)));
          s2 += __int_as_float(__builtin_amdgcn_ds_bpermute((lane ^ o) << 2, __float_as_int(s2)));
        }
        float sa, sb;
        if ((i >> 1) == 0) { float mu = s1 * (1.f / 256.f); float var = fmaxf(s2 * (1.f / 256.f) - mu * mu, 0.f); sa = rsqrtf(var + 1e-6f); sb = -mu * sa; }
        else { sa = rsqrtf(s2 * (1.f / 256.f) + 1e-6f); sb = 0.f; }
        if ((lane & 31) == 0) *(float2*)(ST + ((size_t)(row + q) * 8 + (i >> 1) * 4 + 2 * (i & 1) + (lane >> 5)) * 2) = make_float2(sa, sb);
      }
  }
}

#define OFF_VECS OFF_WT
__device__ __forceinline__ float logsig16(float x) { return (fminf(x, 0.f) - __logf(1.f + __expf(-fabsf(x)))) * (1.f / 16.f); }

typedef __attribute__((ext_vector_type(2))) float f32x2_t;

template <int SW>
__device__ __forceinline__ void prepass_sweep4(const float* GLRS, const f32x2_t (&w2)[4][16], const f32x2_t (&b2)[4], u16* Sq, u16* Ub,
                                               float (&accF)[4], float (&accB)[4]) {
#pragma unroll
  for (int c = 0; c < 4; ++c) { accF[c] = 0.f; accB[c] = 0.f; }
#pragma unroll 2
  for (int u = 0; u < 32; ++u) {
    const int i = SW ? 32 + u : 31 - u;
    const bf16x4 q4 = *(const bf16x4*)(Sq + (unsigned)i * 4096u);
    const bf16x4 k4 = *(const bf16x4*)(Sq + (unsigned)i * 4096u + 512u);
    const float4* gr = (const float4*)(GLRS + (i & 31) * 16);
    const float4 g0 = gr[0], g1 = gr[1], g2 = gr[2], g3 = gr[3];
    bf16x4 oqf, okf, oqb, okb;
#pragma unroll
    for (int c = 0; c < 4; ++c) {
      f32x2_t x = b2[c];
      x = w2[c][0] * g0.x + x;  x = w2[c][1] * g0.y + x;  x = w2[c][2] * g0.z + x;  x = w2[c][3] * g0.w + x;
      x = w2[c][4] * g1.x + x;  x = w2[c][5] * g1.y + x;  x = w2[c][6] * g1.z + x;  x = w2[c][7] * g1.w + x;
      x = w2[c][8] * g2.x + x;  x = w2[c][9] * g2.y + x;  x = w2[c][10] * g2.z + x; x = w2[c][11] * g2.w + x;
      x = w2[c][12] * g3.x + x; x = w2[c][13] * g3.y + x; x = w2[c][14] * g3.z + x; x = w2[c][15] * g3.w + x;
      const float laf = logsig16(x.x), lab = logsig16(x.y);
      float relf, relb;
      if (SW == 0) { relf = -accF[c]; accF[c] += laf; accB[c] += lab; relb = accB[c]; }
      else         { accF[c] += laf; relf = accF[c]; relb = -accB[c]; accB[c] += lab; }
      const float q = bf2f((u16)q4[c]), k = bf2f((u16)k4[c]);
      oqf[c] = (short)f2bf(q * __expf(relf)); okf[c] = (short)f2bf(k * __expf(-relf));
      oqb[c] = (short)f2bf(q * __expf(relb)); okb[c] = (short)f2bf(k * __expf(-relb));
    }
    *(bf16x4*)(Sq + (unsigned)i * 4096u) = oqf;
    *(bf16x4*)(Sq + (unsigned)i * 4096u + 512u) = okf;
    *(bf16x4*)(Ub + (unsigned)i * 1024u) = oqb;
    *(bf16x4*)(Ub + (unsigned)i * 1024u + 512u) = okb;
  }
}

__device__ __forceinline__ void gla_prepass_unit(const Params& p, int l, int bunit, char* smem) {
  const int tid = opaque_tid();
  const int ul = __builtin_amdgcn_readfirstlane(tid >> 7);
  const int gu = bunit * 4 + ul;
  const int sw = gu & 1, ch = gu >> 1;
  const int b = ch / 68, cid = ch % 68;
  const int base = cid < 4 ? (MLAT + b * 256 + cid * 64) : (b * 4096 + (cid - 4) * 64);
  float* GLRS = (float*)smem + ul * 512;
  const int col0 = (tid & 127) * 4;
  __syncthreads();
  {
    const int uw = (tid >> 6) & 1, lane = tid & 63, fr = lane & 15, fq = lane >> 4;
    f32x4 g = (f32x4){0.f, 0.f, 0.f, 0.f};
    const u16* Ua = (const u16*)(p.ws + OFF_U) + (size_t)(base + sw * 32 + uw * 16 + fr) * 1024 + fq * 8;
    const u16* Wb = (const u16*)(p.ws + OFF_WT) + (size_t)(4096 + fr) * 1024 + fq * 8;
#pragma unroll 16
    for (int k = 0; k < 1024; k += 32) {
      bf16x8 a = *(const bf16x8*)(Ua + k);
      bf16x8 w = *(const bf16x8*)(Wb + k);
      g = __builtin_amdgcn_mfma_f32_16x16x32_bf16(a, w, g, 0, 0, 0);
    }
#pragma unroll
    for (int j = 0; j < 4; ++j) GLRS[(uw * 16 + fq * 4 + j) * 16 + fr] = g[j];
  }
  f32x2_t w2[4][16], b2[4];
  {
    const float* w0 = p.gla_w_up + (size_t)(l * 2 + 0) * 16 * 512 + col0;
    const float* w1 = p.gla_w_up + (size_t)(l * 2 + 1) * 16 * 512 + col0;
#pragma unroll
    for (int r = 0; r < 16; ++r) {
      const float4 a = *(const float4*)(w0 + r * 512), c = *(const float4*)(w1 + r * 512);
      w2[0][r].x = a.x; w2[1][r].x = a.y; w2[2][r].x = a.z; w2[3][r].x = a.w;
      w2[0][r].y = c.x; w2[1][r].y = c.y; w2[2][r].y = c.z; w2[3][r].y = c.w;
    }
    const float4 a = *(const float4*)(p.gla_b_up + (l * 2 + 0) * 512 + col0), c = *(const float4*)(p.gla_b_up + (l * 2 + 1) * 512 + col0);
    b2[0].x = a.x; b2[1].x = a.y; b2[2].x = a.z; b2[3].x = a.w;
    b2[0].y = c.x; b2[1].y = c.y; b2[2].y = c.z; b2[3].y = c.w;
  }
  __syncthreads();
  u16* Sq = (u16*)(p.ws + OFF_S) + (size_t)base * 4096 + 2048 + col0;
  u16* Ub = (l == 0 ? (u16*)p.out : (u16*)(p.ws + OFF_U)) + (size_t)base * 1024 + col0;
  float* V0 = (float*)(p.ws + OFF_VECS) + ((size_t)(0 * 544 + b * 68 + cid) * 2) * 512 + col0;
  float* V1 = (float*)(p.ws + OFF_VECS) + ((size_t)(1 * 544 + b * 68 + cid) * 2) * 512 + col0;
  float accF[4], accB[4];
  if (sw == 0) {
    prepass_sweep4<0>(GLRS, w2, b2, Sq, Ub, accF, accB);
    *(float4*)(V0) = make_float4(__expf(accF[0]), __expf(accF[1]), __expf(accF[2]), __expf(accF[3]));
    *(float4*)(V1 + 512) = make_float4(__expf(accB[0]), __expf(accB[1]), __expf(accB[2]), __expf(accB[3]));
  } else {
    prepass_sweep4<1>(GLRS, w2, b2, Sq, Ub, accF, accB);
    *(float4*)(V0 + 512) = make_float4(__expf(accF[0]), __expf(accF[1]), __expf(accF[2]), __expf(accF[3]));
    *(float4*)(V1) = make_float4(__expf(accB[0]), __expf(accB[1]), __expf(accB[2]), __expf(accB[3]));
  }
}

template <int SW>
__device__ __forceinline__ void prepass_sweep(const float* GLRS, const f32x2_t (&w2)[16], f32x2_t b2, u16* Sq, u16* Ub, float& accF, float& accB) {
  accF = 0.f; accB = 0.f;
#pragma unroll 16
  for (int u = 0; u < 32; ++u) {
    const int i = SW ? 32 + u : 31 - u;
    const float4* gr = (const float4*)(GLRS + i * 16);
    const float4 g0 = gr[0], g1 = gr[1], g2 = gr[2], g3 = gr[3];
    f32x2_t x = b2;
    x = w2[0] * g0.x + x;  x = w2[1] * g0.y + x;  x = w2[2] * g0.z + x;  x = w2[3] * g0.w + x;
    x = w2[4] * g1.x + x;  x = w2[5] * g1.y + x;  x = w2[6] * g1.z + x;  x = w2[7] * g1.w + x;
    x = w2[8] * g2.x + x;  x = w2[9] * g2.y + x;  x = w2[10] * g2.z + x; x = w2[11] * g2.w + x;
    x = w2[12] * g3.x + x; x = w2[13] * g3.y + x; x = w2[14] * g3.z + x; x = w2[15] * g3.w + x;
    const float laf = logsig16(x.x), lab = logsig16(x.y);
    float relf, relb;
    if (SW == 0) { relf = -accF; accF += laf; accB += lab; relb = accB; }
    else         { accF += laf; relf = accF; relb = -accB; accB += lab; }
    const float q = bf2f(Sq[(unsigned)i * 4096u]), k = bf2f(Sq[(unsigned)i * 4096u + 512u]);
    Sq[(unsigned)i * 4096u] = f2bf(q * __expf(relf));
    Sq[(unsigned)i * 4096u + 512u] = f2bf(k * __expf(-relf));
    Ub[(unsigned)i * 1024u] = f2bf(q * __expf(relb));
    Ub[(unsigned)i * 1024u + 512u] = f2bf(k * __expf(-relb));
  }
}

__device__ __forceinline__ void gla_prepass_unit1(const Params& p, int l, int unit, char* smem) {
  const int tid = opaque_tid();
  const int sw = unit & 1, ch = unit >> 1;
  const int b = ch / 68, cid = ch % 68;
  const int base = cid < 4 ? (MLAT + b * 256 + cid * 64) : (b * 4096 + (cid - 4) * 64);
  float* GLRS = (float*)smem;
  __syncthreads();
  {
    const int wid = tid >> 6, lane = tid & 63, fr = lane & 15, fq = lane >> 4;
    if (wid < 2) {
      const int r0 = sw * 32 + wid * 16;
      f32x4 g = (f32x4){0.f, 0.f, 0.f, 0.f};
      const u16* Ua = (const u16*)(p.ws + OFF_U) + (size_t)(base + r0 + fr) * 1024 + fq * 8;
      const u16* Wb = (const u16*)(p.ws + OFF_WT) + (size_t)(4096 + fr) * 1024 + fq * 8;
#pragma unroll 16
      for (int k = 0; k < 1024; k += 32) {
        bf16x8 a = *(const bf16x8*)(Ua + k);
        bf16x8 w = *(const bf16x8*)(Wb + k);
        g = __builtin_amdgcn_mfma_f32_16x16x32_bf16(a, w, g, 0, 0, 0);
      }
#pragma unroll
      for (int j = 0; j < 4; ++j) GLRS[(r0 + fq * 4 + j) * 16 + fr] = g[j];
    }
  }
  f32x2_t w2[16];
  {
    const float* w0 = p.gla_w_up + (size_t)(l * 2 + 0) * 16 * 512 + tid;
    const float* w1 = p.gla_w_up + (size_t)(l * 2 + 1) * 16 * 512 + tid;
#pragma unroll
    for (int r = 0; r < 16; ++r) { w2[r].x = w0[r * 512]; w2[r].y = w1[r * 512]; }
  }
  f32x2_t b2; b2.x = p.gla_b_up[(l * 2 + 0) * 512 + tid]; b2.y = p.gla_b_up[(l * 2 + 1) * 512 + tid];
  __syncthreads();
  u16* Sq = (u16*)(p.ws + OFF_S) + (size_t)base * 4096 + 2048 + tid;
  u16* Ub = (l == 0 ? (u16*)p.out : (u16*)(p.ws + OFF_U)) + (size_t)base * 1024 + tid;
  float* V0 = (float*)(p.ws + OFF_VECS) + ((size_t)(0 * 544 + b * 68 + cid) * 2) * 512 + tid;
  float* V1 = (float*)(p.ws + OFF_VECS) + ((size_t)(1 * 544 + b * 68 + cid) * 2) * 512 + tid;
  float accF, accB;
  if (sw == 0) {
    prepass_sweep<0>(GLRS, w2, b2, Sq, Ub, accF, accB);
    V0[0] = __expf(accF);
    V1[512] = __expf(accB);
  } else {
    prepass_sweep<1>(GLRS, w2, b2, Sq, Ub, accF, accB);
    V0[512] = __expf(accF);
    V1[0] = __expf(accB);
  }
}

#define L_QR   0
#define L_KR   17408
#define L_V    34816
#define L_SGT  44032
#define L_P    61440
#undef  SCAN_GB
#define SCAN_GB 70656

__device__ __forceinline__ int off128(int row, int col) { return row * 272 + col * 2; }
__device__ __forceinline__ int off64(int row, int col) { return row * 144 + col * 2; }

template <int RS>
__device__ __forceinline__ bf16x8 tr_frag(unsigned img_addr, int r0, int c0, int lane) {
  const int g = lane >> 4, q = (lane & 15) >> 2, pp = lane & 3;
  unsigned a = img_addr + (unsigned)((r0 + 8 * g + q) * RS + (c0 + 4 * pp) * 2);
  bf16x4 lo, hi;
  asm volatile("ds_read_b64_tr_b16 %0, %2\n\tds_read_b64_tr_b16 %1, %2 offset:%3\n\ts_waitcnt lgkmcnt(0)"
               : "=&v"(lo), "=&v"(hi) : "v"(a), "n"(4 * RS) : "memory");
  bf16x8 r;
  r[0] = lo[0]; r[1] = lo[1]; r[2] = lo[2]; r[3] = lo[3]; r[4] = hi[0]; r[5] = hi[1]; r[6] = hi[2]; r[7] = hi[3];
  return r;
}

typedef short trs4_t __attribute__((ext_vector_type(4)));
__device__ __forceinline__ bf16x8 tr_pair(const char* p, int hi_off) {
  trs4_t lo = __builtin_amdgcn_ds_read_tr16_b64_v4i16((__attribute__((address_space(3))) trs4_t*)p);
  trs4_t hi = __builtin_amdgcn_ds_read_tr16_b64_v4i16((__attribute__((address_space(3))) trs4_t*)(p + hi_off));
  return __builtin_shufflevector(lo, hi, 0, 1, 2, 3, 4, 5, 6, 7);
}

__device__ __forceinline__ bf16x8 scale8(bf16x8 v, float f) {
  bf16x8 o;
#pragma unroll
  for (int x = 0; x < 8; ++x) o[x] = (short)f2bf(bf2f((u16)v[x]) * f);
  return o;
}

__device__ __forceinline__ void lds_barrier() { asm volatile("s_waitcnt lgkmcnt(0)" ::: "memory"); __builtin_amdgcn_s_barrier(); asm volatile("" ::: "memory"); }

template <int branch>
__device__ __forceinline__ void scan_item(const Params& p, int l, int item, char* smem) {
  const int b = (item >> 4) & 7, h = (item >> 2) & 3, slice = item & 3;
  const int tid = opaque_tid(), wid = __builtin_amdgcn_readfirstlane(tid >> 6), lane = tid & 63;
  const int dir = wid >> 2, gw = wid & 3, gt = tid & 255;
  const int fr = lane & 15, fq = lane >> 4;
  char* G = smem + dir * SCAN_GB;
  const unsigned Ga = (unsigned)(size_t)G;
  const u16* S = (const u16*)(p.ws + OFF_S);
  u16* RG = (u16*)(p.ws + OFF_RG);
  const u16* qsrc; unsigned qstride;
  if (branch == 0) { qsrc = S + h * 128; qstride = 4096; }
  else if (dir == 0) { qsrc = S + 2048 + h * 128; qstride = 4096; }
  else { qsrc = (l == 0 ? (const u16*)p.out : (const u16*)(p.ws + OFF_U)) + h * 128; qstride = 1024; }
  const int voff = branch * 2048 + 1024 + h * 256 + slice * 64;
  const int ooff = branch * 1024 + h * 256 + slice * 64;
  float lg = 0.f, egc = 1.f;
  if (branch == 0) { lg = __logf(1.f - __expf(p.ret_decay[(l * 2 + dir) * 4 + h])); egc = __expf(32.f * lg); }
  const float* VECS = (const float*)(p.ws + OFF_VECS) + ((size_t)(dir * 544 + b * 68) * 2) * 512 + h * 128;
  f32x4 st[2][4];
#pragma unroll
  for (int m = 0; m < 2; ++m)
#pragma unroll
    for (int n = 0; n < 4; ++n) st[m][n] = (f32x4){0.f, 0.f, 0.f, 0.f};

  const int qj = gt >> 4, qc = gt & 15;
  const int vj = gt >> 3, vc = gt & 7;
  bf16x8 pq[4], pk[4], pv[2];
  float4 peg[2], pel[2];
  auto prefetch = [&](int s) {
    int base, cid;
    if (s < 4) { int cc = dir ? 3 - s : s; base = MLAT + b * 256 + cc * 64; cid = cc; }
    else { int c = s - 4; int cc = dir ? 63 - c : c; base = b * 4096 + cc * 64; cid = 4 + cc; }
#pragma unroll
    for (int i = 0; i < 4; ++i) {
      int jp = qj + 16 * i;
      const u16* qb_ = qsrc + (size_t)base * qstride;
      unsigned ro = (unsigned)(dir ? 63 - jp : jp) * qstride + qc * 8;
      pq[i] = *(const bf16x8*)(qb_ + ro);
      pk[i] = *(const bf16x8*)(qb_ + ro + 512);
    }
#pragma unroll
    for (int i = 0; i < 2; ++i) {
      int jp = vj + 32 * i;
      pv[i] = *(const bf16x8*)((S + (size_t)base * 4096 + voff) + ((unsigned)(dir ? 63 - jp : jp) * 4096u + vc * 8));
    }
    (void)cid;
  };
  auto prefetch_vecs = [&](int s) {
    if (branch == 1) {
      int cid;
      if (s < 4) { cid = dir ? 3 - s : s; } else { int c = s - 4; cid = 4 + (dir ? 63 - c : c); }
#pragma unroll
      for (int m = 0; m < 2; ++m) {
        int d0 = gw * 32 + m * 16 + fq * 4;
        peg[m] = *(const float4*)(VECS + (size_t)cid * 1024 + d0);
        pel[m] = *(const float4*)(VECS + (size_t)cid * 1024 + 512 + d0);
      }
    } else {
#pragma unroll
      for (int m = 0; m < 2; ++m) { peg[m] = make_float4(egc, egc, egc, egc); pel[m] = peg[m]; }
    }
  };
  prefetch(0);
  prefetch_vecs(0);
  __syncthreads();

  for (int s = 0; s < 68; ++s) {
    int base; bool first; bool wout;
    if (s < 4) { int cc = dir ? 3 - s : s; base = MLAT + b * 256 + cc * 64; first = s < 2; wout = (l == 0); }
    else { int c = s - 4; int cc = dir ? 63 - c : c; base = b * 4096 + cc * 64; first = c < 32; wout = true; }
    float4 (&eg)[2] = peg; float4 (&el)[2] = pel;
#pragma unroll
    for (int i = 0; i < 4; ++i) {
      int jp = qj + 16 * i;
      bf16x8 qv = pq[i], kv_ = pk[i];
      if (branch == 0) {
        float fqs = __expf((float)(jp - 31) * lg), fks = __expf((float)(31 - jp) * lg);
        qv = scale8(qv, fqs); kv_ = scale8(kv_, fks);
      }
      *(bf16x8*)(G + L_QR + off128(jp, qc * 8)) = qv;
      *(bf16x8*)(G + L_KR + off128(jp, qc * 8)) = kv_;
    }
#pragma unroll
    for (int i = 0; i < 2; ++i) *(bf16x8*)(G + L_V + off64(vj + 32 * i, vc * 8)) = pv[i];
#pragma unroll
    for (int m = 0; m < 2; ++m) {
      int d0 = gw * 32 + m * 16 + fq * 4;
#pragma unroll
      for (int n = 0; n < 4; ++n) {
        int e = n * 16 + fr;
        bf16x4 o4;
        o4[0] = (short)f2bf(st[m][n][0] * eg[m].x); o4[1] = (short)f2bf(st[m][n][1] * eg[m].y);
        o4[2] = (short)f2bf(st[m][n][2] * eg[m].z); o4[3] = (short)f2bf(st[m][n][3] * eg[m].w);
        *(bf16x4*)(G + L_SGT + off128(e, d0)) = o4;
      }
    }
    u16 oldv[4][4];
    u16* dstb = RG + (size_t)base * 2048 + ooff;
    if (wout && !first) {
#pragma unroll
      for (int r = 0; r < 4; ++r) {
        int ip = gw * 16 + fq * 4 + r;
        unsigned ro = (unsigned)(dir ? 63 - ip : ip) * 2048u + fr;
#pragma unroll
        for (int n = 0; n < 4; ++n) oldv[r][n] = dstb[ro + n * 16];
      }
    }
    if (s + 1 < 68) prefetch(s + 1);
    lds_barrier();
    f32x4 pt[4], o[4];
#pragma unroll
    for (int n = 0; n < 4; ++n) { pt[n] = (f32x4){0.f, 0.f, 0.f, 0.f}; o[n] = (f32x4){0.f, 0.f, 0.f, 0.f}; }
#pragma unroll
    for (int ks = 0; ks < 4; ++ks) {
      int kc = ks * 32 + fq * 8;
      bf16x8 qa = *(const bf16x8*)(G + L_QR + off128(gw * 16 + fr, kc));
#pragma unroll
      for (int n = 0; n < 4; ++n) {
        bf16x8 ka = *(const bf16x8*)(G + L_KR + off128(n * 16 + fr, kc));
        bf16x8 sb = *(const bf16x8*)(G + L_SGT + off128(n * 16 + fr, kc));
        pt[n] = __builtin_amdgcn_mfma_f32_16x16x32_bf16(ka, qa, pt[n], 0, 0, 0);
        o[n] = __builtin_amdgcn_mfma_f32_16x16x32_bf16(qa, sb, o[n], 0, 0, 0);
      }
    }
    {
      const int ip = gw * 16 + fr;
#pragma unroll
      for (int n = 0; n < 4; ++n) {
        const int j0 = n * 16 + fq * 4;
        bf16x4 w;
#pragma unroll
        for (int r = 0; r < 4; ++r) {
          int jp = j0 + r;
          bool keep = dir ? (ip > jp) : (ip >= jp);
          w[r] = (short)f2bf(keep ? pt[n][r] : 0.f);
        }
        *(bf16x4*)(G + L_P + off64(ip, j0)) = w;
      }
    }
    asm volatile("s_waitcnt lgkmcnt(0)" ::: "memory");
    {
      const int tg = lane >> 4, tq = (lane & 15) >> 2, tp = lane & 3;
#pragma unroll
      for (int m = 0; m < 2; ++m) {
        f32x4 kv[4];
#pragma unroll
        for (int n = 0; n < 4; ++n) kv[n] = (f32x4){0.f, 0.f, 0.f, 0.f};
#pragma unroll
        for (int ks = 0; ks < 2; ++ks) {
          int kc = ks * 32 + fq * 8;
          const char* kp = G + L_KR + (8 * tg + tq) * 272 + (gw * 32 + 4 * tp) * 2 + ks * 32 * 272 + m * 32;
          const char* vp = G + L_V + (8 * tg + tq) * 144 + (4 * tp) * 2 + ks * 32 * 144;
          const bf16x8 km = tr_pair(kp, 4 * 272);
          bf16x8 vb[4];
#pragma unroll
          for (int n = 0; n < 4; ++n) vb[n] = tr_pair(vp + n * 32, 4 * 144);
          bf16x8 pa;
          if (m == 0) pa = *(const bf16x8*)(G + L_P + off64(gw * 16 + fr, kc));
#pragma unroll
          for (int n = 0; n < 4; ++n) {
            if (m == 0) o[n] = __builtin_amdgcn_mfma_f32_16x16x32_bf16(pa, vb[n], o[n], 0, 0, 0);
            kv[n] = __builtin_amdgcn_mfma_f32_16x16x32_bf16(km, vb[n], kv[n], 0, 0, 0);
          }
        }
#pragma unroll
        for (int n = 0; n < 4; ++n) {
          st[m][n][0] = eg[m].x * el[m].x * st[m][n][0] + el[m].x * kv[n][0];
          st[m][n][1] = eg[m].y * el[m].y * st[m][n][1] + el[m].y * kv[n][1];
          st[m][n][2] = eg[m].z * el[m].z * st[m][n][2] + el[m].z * kv[n][2];
          st[m][n][3] = eg[m].w * el[m].w * st[m][n][3] + el[m].w * kv[n][3];
        }
      }
    }
    if (branch == 1 && s + 1 < 68) prefetch_vecs(s + 1);
    if (wout) {
#pragma unroll
      for (int r = 0; r < 4; ++r) {
        int ip = gw * 16 + fq * 4 + r;
        unsigned ro = (unsigned)(dir ? 63 - ip : ip) * 2048u + fr;
#pragma unroll
        for (int n = 0; n < 4; ++n) {
          float v = o[n][r];
          if (!first) v += bf2f(oldv[r][n]);
          dstb[ro + n * 16] = f2bf(v);
        }
      }
    }
    __syncthreads();
  }
}

#define NPHASE 18
__device__ __forceinline__ void run_phase(const Params& p, int ph, char* smem) {
  const int nblk = gridDim.x, bid = blockIdx.x;
  if (ph == 0) {
#ifdef REP_P0
    for (int rep = 0; rep < REP_P0; ++rep)
#endif
    for (int u = bid; u < WT_UNITS + 96 + 1; u += nblk) {
      if (u < 96) mod_unit(p, u, smem);
      else if (u == 96) rot_unit(p);
      else wt_unit(p, 0, u - 97, smem);
    }
    return;
  }
  if (ph == NPHASE - 1) { phase_final(p); return; }
  const int l = (ph - 1) / 8, sp = (ph - 1) % 8;
  PG8_LAS unsigned char* lds = (PG8_LAS unsigned char*)smem;
  switch (sp) {
    case 0:
      phase_u(p, l);
      if (l == 1) for (int u = bid; u < WT_UNITS; u += nblk) wt_unit(p, 1, u, smem);
      break;
    case 1: {
      pg8::Gemm g{(const u16*)(p.ws + OFF_U), (const u16*)(p.ws + OFF_WT) + (size_t)WT_SCAN * 1024, 1024, MTOT, 4096, 1024};
      pg8::StaticOrder S; S.init(g.M, g.N, nblk, bid);
      EpiScanIn E{(u16*)(p.ws + OFF_S), (const float*)(p.ws + OFF_ROT)};
      pg8::gemm_phase(lds, g, S, E, opaque_tid());
    } break;
    case 2:
      for (int t = bid; t < 256; t += nblk) gla_prepass_unit(p, l, t, smem);
      for (int t = 1024 + (bid + 96) % nblk; t < 1088; t += nblk) gla_prepass_unit1(p, l, t, smem);
      break;
    case 3:
#ifdef REP_SCAN
      for (int rep = 0; rep < REP_SCAN; ++rep)
#endif
      for (int t = bid; t < 256; t += nblk) { if (t < 128) scan_item<0>(p, l, t, smem); else scan_item<1>(p, l, t, smem); } break;
    case 4:
      if (l != 0) phase_u(p, l);
      phase_stats(p, l);
      break;
    case 5: {
      pg8::Gemm g{(const u16*)(p.ws + OFF_U), (const u16*)(p.ws + OFF_WT) + (size_t)WT_GATE * 1024, 1024, l == 0 ? MTOT : MLAT, 4096, 1024};
      pg8::StaticOrder S; S.init(g.M, g.N, nblk, bid);
      EpiGate E{(const u16*)(p.ws + OFF_RG), (const float*)(p.ws + OFF_STATS), (u16*)(p.ws + OFF_S), p.ret_norm_gain + l * 1024, p.gla_norm_gain + l * 1024};
      pg8::gemm_phase(lds, g, S, E, opaque_tid());
    } break;
    case 6: {
#pragma unroll 1
      for (int pass = 0; pass < 2; ++pass) {
        pg8::Gemm g{(const u16*)(p.ws + OFF_S) + 2048 + pass * 1024, (const u16*)(p.ws + OFF_WT) + (size_t)(WT_BRR + pass * 1024) * 1024, 4096, l == 0 ? MTOT : MLAT, 1024, 1024};
        pg8::StaticOrder S; S.init(g.M, g.N, nblk, bid);
        EpiMerge E{(const u16*)(p.ws + OFF_S), (u16*)(p.ws + OFF_U), pass};
        pg8::gemm_phase(lds, g, S, E, opaque_tid());
      }
    } break;
    case 7: {
      pg8::Gemm g{(const u16*)(p.ws + OFF_U), (const u16*)(p.ws + OFF_WT) + (size_t)WT_OUT * 1024, 1024, l == 0 ? MTOT : MLAT, 1024, 1024};
      pg8::StaticOrder S; S.init(g.M, g.N, nblk, bid);
      EpiOut E{l == 0 ? p.x : p.out, p.ctx, p.out, (float*)(p.ws + OFF_HCTX), (const float*)(p.ws + OFF_MOD) + (size_t)l * 9 * 3072};
      pg8::gemm_phase(lds, g, S, E, opaque_tid());
    } break;
  }
}

#define XB_TMO      128
#define XB_XCNT(j)  (256  + 64 * (j))
#define XB_XSUB(j)  (1280 + 64 * (j))
#define XB_XGEN(j)  (2304 + 64 * (j))
#define XB_TOP      3328
#define XB_TOPGEN   3392
#define XCD_BAR_WORDS 3456
#define XB_SPIN_CAP (1u << 18)
__device__ __forceinline__ unsigned xb_ld(unsigned* p)              { return __hip_atomic_load(p, __ATOMIC_RELAXED, __HIP_MEMORY_SCOPE_AGENT); }
__device__ __forceinline__ unsigned xb_add(unsigned* p, unsigned v) { return __hip_atomic_fetch_add(p, v, __ATOMIC_RELAXED, __HIP_MEMORY_SCOPE_AGENT); }
__device__ __forceinline__ unsigned xb_xcc_id() { return (unsigned)__builtin_amdgcn_s_getreg((3 << 11) | 20) & 0xFu; }
#define XB_SPIN(cond, bar) do { unsigned _sp = 0; while (cond) { __builtin_amdgcn_s_sleep(1); \
    if ((++_sp & 255u) == 0u) { if (xb_ld(&(bar)[XB_TMO])) break; if (_sp > XB_SPIN_CAP) { atomicAdd(&(bar)[XB_TMO], 1u); break; } } } } while (0)

__device__ __forceinline__ void xcd_barrier_complete(unsigned* bar, unsigned x, unsigned& nloc, unsigned& nx) {
  const unsigned G = gridDim.x * gridDim.y * gridDim.z;
  unsigned sum, cnt, mine, sp = 0u;
  for (;;) {
    sum = 0u; cnt = 0u; mine = 0u;
#pragma unroll
    for (unsigned j = 0; j < 16; ++j) { const unsigned c = xb_ld(&bar[XB_XCNT(j)]); sum += c; cnt += (c > 0u) ? 1u : 0u; mine = (j == x) ? c : mine; }
    if (sum == G) break;
    __builtin_amdgcn_s_sleep(1);
    if ((++sp & 255u) == 0u) { if (xb_ld(&bar[XB_TMO])) break; if (sp > XB_SPIN_CAP) { atomicAdd(&bar[XB_TMO], 1u); break; } }
  }
  nloc = mine > 0u ? mine : 1u; nx = cnt > 0u ? cnt : 1u;
}

__device__ __forceinline__ void xcd_barrier(unsigned* bar, volatile unsigned* st) {
  asm volatile("s_waitcnt vmcnt(0)" ::: "memory");
  __syncthreads();
  if (threadIdx.x == 0) {
    const unsigned x = xb_xcc_id();
    __builtin_amdgcn_s_waitcnt(0);
    unsigned nloc = st[0], nx = st[1];
    if (nloc == 0u) { xcd_barrier_complete(bar, x, nloc, nx); st[0] = nloc; st[1] = nx; }
    const unsigned old = xb_add(&bar[XB_XSUB(x)], 1u);
    const unsigned gen = old / nloc;
    if (old + 1u == (gen + 1u) * nloc) {
      __builtin_amdgcn_fence(__ATOMIC_RELEASE, "agent");
      asm volatile("s_waitcnt vmcnt(0)" ::: "memory");
      const unsigned og = xb_add(&bar[XB_TOP], 1u);
      const unsigned tg = og / nx;
      if (og + 1u == (tg + 1u) * nx) xb_add(&bar[XB_TOPGEN], 1u);
      else XB_SPIN(xb_ld(&bar[XB_TOPGEN]) == tg, bar);
      __builtin_amdgcn_fence(__ATOMIC_ACQUIRE, "agent");
      xb_add(&bar[XB_XGEN(x)], 1u);
      asm volatile("s_waitcnt vmcnt(0)" ::: "memory");
    } else {
      XB_SPIN(xb_ld(&bar[XB_XGEN(x)]) == gen, bar);
      __builtin_amdgcn_fence(__ATOMIC_ACQUIRE, "agent");
      asm volatile("s_waitcnt vmcnt(0)" ::: "memory");
    }
  }
  __syncthreads();
}

__global__ void __launch_bounds__(NTHREADS) mega(Params p, int ph_lo, int ph_hi, int coop) {
  extern __shared__ __attribute__((aligned(16))) char smem[];
  volatile unsigned* xst = (volatile unsigned*)(smem + XB_LDS_OFF);
  unsigned* xbar = (unsigned*)(p.ws + OFF_BAR);
  if (coop) {
    if (threadIdx.x == 0) { xst[0] = 0u; xst[1] = 0u; (void)xb_add(&xbar[XB_XCNT(xb_xcc_id())], 1u); }
    __syncthreads();
  }
  for (int ph = ph_lo; ph < ph_hi; ++ph) {
    run_phase(p, ph, smem);
    if (coop && ph + 1 < ph_hi) {
      if (ph == ph_lo) cg::this_grid().sync();
      else xcd_barrier(xbar, xst);
    }
  }
}

extern "C" void kernel_launch(void* const* d_in, const int* in_sizes, int n_in,
                              void* d_out, int out_size, void* d_ws, size_t ws_size,
                              hipStream_t stream) {
  Params p{};
  p.x = (const float*)d_in[0]; p.c = (const float*)d_in[1]; p.ctx = (const float*)d_in[2]; p.c_ctx = (const float*)d_in[3];
  p.norm_gain = (const float*)d_in[4]; p.w_ada = (const float*)d_in[5]; p.b_ada = (const float*)d_in[6]; p.w_in = (const float*)d_in[7];
  p.ret_decay = (const float*)d_in[8]; p.gla_w_up = (const float*)d_in[9]; p.gla_b_up = (const float*)d_in[10];
  p.ret_norm_gain = (const float*)d_in[11]; p.gla_norm_gain = (const float*)d_in[12];
  p.w_br_ret = (const float*)d_in[13]; p.w_br_gla = (const float*)d_in[14]; p.w_out = (const float*)d_in[15]; p.final_gain = (const float*)d_in[16];
  p.out = (float*)d_out; p.ws = (char*)d_ws;
  static int grid_blocks = 0;
  if (!grid_blocks) {
    hipFuncSetAttribute((const void*)mega, hipFuncAttributeMaxDynamicSharedMemorySize, LDS_BYTES);
    int dev = 0, cus = 0, per_cu = 0;
    hipGetDevice(&dev);
    hipDeviceGetAttribute(&cus, hipDeviceAttributeMultiprocessorCount, dev);
    hipOccupancyMaxActiveBlocksPerMultiprocessor(&per_cu, mega, NTHREADS, LDS_BYTES);
    if (per_cu < 1) per_cu = 1;
    grid_blocks = cus * 1;
  }
#ifdef MULTI_LAUNCH
  for (int ph = 0; ph < NPHASE; ++ph) {
    mega<<<dim3(grid_blocks), dim3(NTHREADS), LDS_BYTES, stream>>>(p, ph, ph + 1, 0);
  }
#else
  hipMemsetAsync((char*)d_ws + OFF_BAR, 0, 16384, stream);
  int lo = 0, hi = NPHASE, coop = 1;
  void* args[] = {&p, &lo, &hi, &coop};
  hipError_t e = hipLaunchCooperativeKernel((void*)mega, dim3(grid_blocks), dim3(NTHREADS), args, LDS_BYTES, stream);
  if (e != hipSuccess) fprintf(stderr, "cooperative launch failed: %s (grid %d)\n", hipGetErrorString(e), grid_blocks);
#endif
}
```

```cpp
#include <hip/hip_runtime.h>
#include <hip/hip_cooperative_groups.h>
#include <cstdio>
namespace cg = cooperative_groups;

typedef unsigned short u16;
using bf16x8 = __attribute__((ext_vector_type(8))) short;
using bf16x4 = __attribute__((ext_vector_type(4))) short;
using f32x4  = __attribute__((ext_vector_type(4))) float;

#define NTHREADS 512
#define DM 1024
#define NB 8
#define SEQL 4096
#define CTXL 256
#define MLAT 32768
#define MCTX 2048
#define MTOT 34816
#define INW 8208

#define OFF_S    0ull
#define OFF_RG   (OFF_S   + (size_t)MTOT * 4096 * 2)
#define OFF_U    (OFF_RG  + (size_t)MTOT * 2048 * 2)
#define OFF_WT   (OFF_U   + (size_t)MTOT * 1024 * 2)
#define WT_ROWS  11392
#define OFF_GLR  (OFF_WT  + (size_t)WT_ROWS * 1024 * 2)
#define OFF_HCTX (OFF_GLR + (size_t)MTOT * 16 * 4)
#define OFF_MOD  (OFF_HCTX+ (size_t)MCTX * 1024 * 4)
#define OFF_ROT  (OFF_MOD + (size_t)2 * 9 * 3072 * 4)
#define OFF_BAR  (OFF_ROT + (size_t)64 * 32 * 2 * 4)
#define OFF_END  (OFF_BAR + 16384)

#define WT_SCAN 0
#define WT_GATE 4224
#define WT_BRR  8320
#define WT_BRG  9344
#define WT_OUT  10368

#define XB_LDS_OFF 161792
#define LDS_BYTES 161808
#define SCAN_GB   80896

struct Params {
  const float* x; const float* c; const float* ctx; const float* c_ctx;
  const float* norm_gain; const float* w_ada; const float* b_ada; const float* w_in;
  const float* ret_decay; const float* gla_w_up; const float* gla_b_up;
  const float* ret_norm_gain; const float* gla_norm_gain;
  const float* w_br_ret; const float* w_br_gla; const float* w_out; const float* final_gain;
  float* out; char* ws;
};

__device__ __forceinline__ u16 f2bf(float f) {
  __bf16 h = (__bf16)f;
  return *(u16*)&h;
}
__device__ __forceinline__ float bf2f(u16 h) { return __uint_as_float(((unsigned)h) << 16); }
__device__ __forceinline__ float sigmoidf_(float x) { return __builtin_amdgcn_rcpf(1.f + __expf(-x)); }
__device__ __forceinline__ float siluf_(float x) { return x * __builtin_amdgcn_rcpf(1.f + __expf(-x)); }

__device__ __forceinline__ int opaque_tid() { int t = threadIdx.x; asm volatile("" : "+v"(t)); return t; }

__device__ __forceinline__ float wave_sum(float v, int lane) {
#pragma unroll
  for (int o = 32; o > 0; o >>= 1)
    v += __int_as_float(__builtin_amdgcn_ds_bpermute((lane ^ o) << 2, __float_as_int(v)));
  return v;
}

__device__ __forceinline__ const float* wt_src(const Params& p, int l, int n, int& ld) {
  if (n < WT_GATE) {
    int tile = n >> 7, cc = n & 127;
    int col;
    if (tile < 8) {
      int d = (cc & 64) | ((cc & 16) << 1) | ((cc & 32) >> 1) | (cc & 15);
      col = tile * 128 + d;
    } else if (tile < 16) col = 1024 + (tile - 8) * 128 + cc;
    else if (tile < 24) col = 3072 + (tile - 16) * 128 + cc;
    else if (tile < 32) col = 4096 + (tile - 24) * 128 + cc;
    else { if (cc >= 16) { ld = 0; return nullptr; } col = 6144 + cc; }
    ld = INW; return p.w_in + (size_t)l * DM * INW + col;
  } else if (n < WT_BRR) {
    int g = n - WT_GATE; int col;
    if (g < 1024) col = 2048 + g;
    else if (g < 2048) col = 5120 + (g - 1024);
    else if (g < 3072) col = 6160 + (g - 2048);
    else col = 7184 + (g - 3072);
    ld = INW; return p.w_in + (size_t)l * DM * INW + col;
  } else if (n < WT_BRG) { ld = DM; return p.w_br_ret + (size_t)l * DM * DM + (n - WT_BRR); }
  else if (n < WT_OUT)   { ld = DM; return p.w_br_gla + (size_t)l * DM * DM + (n - WT_BRG); }
  else                   { ld = DM; return p.w_out    + (size_t)l * DM * DM + (n - WT_OUT); }
}

#define WT_UNITS (178 * 4)
__device__ __forceinline__ void wt_unit(const Params& p, int l, int unit, char* smem) {
  float* tile = (float*)smem;
  int nb = unit >> 2, kg = unit & 3;
  int tid = opaque_tid();
  int n0 = nb * 64, kbase = kg * 256;
  float v[4][8];
  {
    int nl = tid & 63, kq = tid >> 6;
    int ld; const float* src = wt_src(p, l, n0 + nl, ld);
#pragma unroll
    for (int q = 0; q < 4; ++q)
#pragma unroll
      for (int i = 0; i < 8; ++i) v[q][i] = src ? src[(size_t)(kbase + q * 64 + kq + 8 * i) * ld] : 0.f;
  }
  u16* wt = (u16*)(p.ws + OFF_WT);
#pragma unroll
  for (int q = 0; q < 4; ++q) {
    __syncthreads();
    {
      int nl = tid & 63, kq = tid >> 6;
#pragma unroll
      for (int i = 0; i < 8; ++i) tile[(kq + 8 * i) * 65 + nl] = v[q][i];
    }
    __syncthreads();
    {
      int nl = tid >> 3, kq = tid & 7;
      bf16x8 o;
#pragma unroll
      for (int j = 0; j < 8; ++j) o[j] = (short)f2bf(tile[(kq * 8 + j) * 65 + nl]);
      *(bf16x8*)(wt + (size_t)(n0 + nl) * 1024 + kbase + q * 64 + kq * 8) = o;
    }
  }
  __syncthreads();
}

__device__ __forceinline__ void mod_unit(const Params& p, int unit, char* smem) {
  float* sc = (float*)smem;
  float* red = sc + 9 * 1024;
  int l = unit / 48, jb = unit % 48;
  int tid = opaque_tid();
  for (int i = tid; i < 9 * 1024; i += NTHREADS) {
    int r = i >> 10, k = i & 1023;
    float v = (r < 8) ? p.c[r * 1024 + k] : p.c_ctx[k];
    sc[i] = siluf_(v);
  }
  __syncthreads();
  int jl = tid & 63, kg = tid >> 6;
  int j = jb * 64 + jl;
  float acc[9];
#pragma unroll
  for (int r = 0; r < 9; ++r) acc[r] = 0.f;
  const float* w = p.w_ada + (size_t)l * DM * 3072 + j;
#pragma unroll 16
  for (int k = kg * 128; k < kg * 128 + 128; ++k) {
    float wv = w[(size_t)k * 3072];
#pragma unroll
    for (int r = 0; r < 9; ++r) acc[r] += sc[r * 1024 + k] * wv;
  }
#pragma unroll
  for (int r = 0; r < 9; ++r) red[(kg * 9 + r) * 64 + jl] = acc[r];
  __syncthreads();
  float* mod = (float*)(p.ws + OFF_MOD);
  for (int i = tid; i < 9 * 64; i += NTHREADS) {
    int r = i >> 6, jj = i & 63;
    float s = 0.f;
#pragma unroll
    for (int g = 0; g < 8; ++g) s += red[(g * 9 + r) * 64 + jj];
    mod[((size_t)l * 9 + r) * 3072 + jb * 64 + jj] = s + p.b_ada[l * 3072 + jb * 64 + jj];
  }
  __syncthreads();
}

__device__ __forceinline__ void rot_unit(const Params& p) {
  float* rot = (float*)(p.ws + OFF_ROT);
  for (int i = opaque_tid(); i < 64 * 32; i += NTHREADS) {
    int pos = i >> 5, f = i & 31;
    float inv = exp2f(-(float)f * (13.287712379549449f / 32.f));
    float ang = (float)pos * inv;
    rot[i * 2] = __cosf(ang);
    rot[i * 2 + 1] = __sinf(ang);
  }
}

__device__ __forceinline__ void phase_u(const Params& p, int l) {
  const int tid = opaque_tid(); int wave = tid >> 6, lane = tid & 63;
  const float* mod = (const float*)(p.ws + OFF_MOD) + (size_t)l * 9 * 3072;
  const float* gain = p.norm_gain + l * DM;
  u16* U = (u16*)(p.ws + OFF_U);
  for (int row = (blockIdx.x * 8 + wave) * 4; row < MTOT; row += gridDim.x * 32) {
    const float* h; int r;
    if (row < MLAT) { h = (l == 0 ? p.x : p.out) + (size_t)row * DM; r = row >> 12; }
    else { int cr = row - MLAT; h = (l == 0 ? p.ctx : (const float*)(p.ws + OFF_HCTX)) + (size_t)cr * DM; r = 8; }
    float4 v[4][4]; float ss[4];
#pragma unroll
    for (int q = 0; q < 4; ++q) {
      ss[q] = 0.f;
#pragma unroll
      for (int i = 0; i < 4; ++i) v[q][i] = *(const float4*)(h + q * DM + i * 256 + lane * 4);
    }
#pragma unroll
    for (int q = 0; q < 4; ++q) {
#pragma unroll
      for (int i = 0; i < 4; ++i) ss[q] += v[q][i].x * v[q][i].x + v[q][i].y * v[q][i].y + v[q][i].z * v[q][i].z + v[q][i].w * v[q][i].w;
      ss[q] = rsqrtf(wave_sum(ss[q], lane) * (1.f / 1024.f) + 1e-6f);
    }
    const float* sh = mod + r * 3072;
#pragma unroll
    for (int i = 0; i < 4; ++i) {
      int cidx = i * 256 + lane * 4;
      float4 g = *(const float4*)(gain + cidx);
      float4 s = *(const float4*)(sh + cidx);
      float4 sc = *(const float4*)(sh + 1024 + cidx);
      g.x *= (1.f + sc.x); g.y *= (1.f + sc.y); g.z *= (1.f + sc.z); g.w *= (1.f + sc.w);
#pragma unroll
      for (int q = 0; q < 4; ++q) {
        bf16x4 o;
        o[0] = (short)f2bf(v[q][i].x * ss[q] * g.x + s.x);
        o[1] = (short)f2bf(v[q][i].y * ss[q] * g.y + s.y);
        o[2] = (short)f2bf(v[q][i].z * ss[q] * g.z + s.z);
        o[3] = (short)f2bf(v[q][i].w * ss[q] * g.w + s.w);
        *(bf16x4*)(U + (size_t)(row + q) * DM + cidx) = o;
      }
    }
  }
}

__device__ __forceinline__ void phase_final(const Params& p) {
  const int tid = opaque_tid(); int wave = tid >> 6, lane = tid & 63;
  for (int row = (blockIdx.x * 8 + wave) * 4; row < MLAT; row += gridDim.x * 32) {
    float* h = p.out + (size_t)row * DM;
    float4 v[4][4]; float ss[4];
#pragma unroll
    for (int q = 0; q < 4; ++q) {
      ss[q] = 0.f;
#pragma unroll
      for (int i = 0; i < 4; ++i) v[q][i] = *(const float4*)(h + q * DM + i * 256 + lane * 4);
    }
#pragma unroll
    for (int q = 0; q < 4; ++q) {
#pragma unroll
      for (int i = 0; i < 4; ++i) ss[q] += v[q][i].x * v[q][i].x + v[q][i].y * v[q][i].y + v[q][i].z * v[q][i].z + v[q][i].w * v[q][i].w;
      ss[q] = rsqrtf(wave_sum(ss[q], lane) * (1.f / 1024.f) + 1e-6f);
    }
#pragma unroll
    for (int i = 0; i < 4; ++i) {
      int cidx = i * 256 + lane * 4;
      float4 g = *(const float4*)(p.final_gain + cidx);
#pragma unroll
      for (int q = 0; q < 4; ++q) {
        float4 o;
        o.x = v[q][i].x * ss[q] * g.x; o.y = v[q][i].y * ss[q] * g.y; o.z = v[q][i].z * ss[q] * g.z; o.w = v[q][i].w * ss[q] * g.w;
        *(float4*)(h + q * DM + cidx) = o;
      }
    }
  }
}

#define PG8_LAS __attribute__((address_space(3)))
typedef unsigned u32x4 __attribute__((ext_vector_type(4)));
namespace pg8 {
constexpr int BM = 256, BK = 64, HALF = 128, HTB = HALF * BK * 2, STAGE_BYTES = 8 * HTB, NXCD = 8, WGM = 8;
__device__ __forceinline__ int lds_byte(int r, int c) { const int st = (r >> 4) * 2 + (c >> 5), rr = r & 15, cc = c & 31, ob = rr * 64 + cc * 2; return st * 1024 + (ob ^ (((ob >> 9) & 1) << 5)); }
__device__ __forceinline__ void stage_rc(int b, int& R, int& C) { const int st = b / 1024, sb = b % 1024, swz = sb ^ (((sb >> 9) & 1) << 5); R = (st >> 1) * 16 + swz / 64; C = (st & 1) * 32 + (swz % 64) / 2; }
__device__ __forceinline__ int perm32(int rho) { const int n = rho >> 4, i = rho & 15; return 8 * (i >> 2) + 4 * n + (i & 3); }
struct Unit { int pm, pn; };
struct Gemm { const u16* A; const u16* Bt; int lda; int M, N, K; };
struct StaticOrder {
  int nM, nN, nwg, G, c;
  __device__ void init(int M, int N, int G_, int c_) { nM = M / BM; nN = N / BM; nwg = nM * nN; G = G_; c = c_; }
  __device__ bool next(int i, Unit& u) const {
    const long L = (long)i * G + c; if (L >= nwg) return false;
    int wgid = (int)L; { const int q = nwg / NXCD, r = nwg % NXCD, xcd = wgid % NXCD, off = wgid / NXCD; wgid = (xcd < r ? xcd * (q + 1) : r * (q + 1) + (xcd - r) * q) + off; }
    const int nig = WGM * nN, gid = wgid / nig, fm = gid * WGM, gsz = (nM - fm) < WGM ? (nM - fm) : WGM;
    u.pm = fm + ((wgid % nig) % gsz); u.pn = (wgid % nig) / gsz; return true;
  }
};
typedef __attribute__((ext_vector_type(2))) float cvt_f2_t;
typedef __attribute__((ext_vector_type(2))) __bf16 cvt_b2_t;
__device__ __forceinline__ unsigned cvt_pk_bf16(float lo, float hi) { cvt_f2_t f = {lo, hi}; cvt_b2_t r = __builtin_convertvector(f, cvt_b2_t); return __builtin_bit_cast(unsigned, r); }

template <class Epi>
__device__ __forceinline__ void gemm_phase(PG8_LAS unsigned char* lds, const Gemm g, const StaticOrder& S, const Epi& E, const int tid) {
  const int wid = __builtin_amdgcn_readfirstlane(tid >> 6), lane = tid & 63, wr = wid >> 2, wc = wid & 3, fr = lane & 15, fq = lane >> 4;
  const int K = g.K, nt = K / BK;
  unsigned voffA[2], voffB[2];
#pragma unroll
  for (int i = 0; i < 2; ++i) { int R, C; stage_rc(tid * 16 + i * 8192, R, C); const int Rb = Epi::PERM ? ((R & ~31) + perm32(R & 31)) : R;
    voffA[i] = (unsigned)(R * g.lda + C) * 2u; voffB[i] = (unsigned)(Rb * K + C) * 2u; }
  const size_t kstep = (size_t)(BK * 2);
  const size_t hstepA = (size_t)HALF * g.lda * 2, hstepB = (size_t)HALF * K * 2;
  const size_t tstepA = 2 * hstepA, tstepB = 2 * hstepB;
  const unsigned ldsw = (unsigned)wid * 1024u;
  const int aoff = lds_byte(wr * 64 + fr, fq * 8), boff = lds_byte(wc * 32 + fr, fq * 8);
#define PG8_SA(b, h) (((b) * 2 + (h)) * HTB)
#define PG8_SB(b, h) ((4 + (b) * 2 + (h)) * HTB)
#define PG8_STAGE(bufoff, gbase, voff) do { _Pragma("unroll") for (int _i = 0; _i < 2; ++_i) \
    __builtin_amdgcn_global_load_lds((const unsigned*)((const char*)(gbase) + (voff)[_i]), (PG8_LAS unsigned*)(lds + (bufoff) + ldsw + _i * 8192), 16, 0, 0); } while (0)
#define PG8_LDA(dst, b, h) do { _Pragma("unroll") for (int m = 0; m < 4; ++m) _Pragma("unroll") for (int k = 0; k < 2; ++k) dst[m][k] = *(const PG8_LAS bf16x8*)(lds + PG8_SA(b, h) + aoff + m * 2048 + k * 1024); } while (0)
#define PG8_LDB(dst, b, h) do { _Pragma("unroll") for (int n = 0; n < 2; ++n) _Pragma("unroll") for (int k = 0; k < 2; ++k) dst[n][k] = *(const PG8_LAS bf16x8*)(lds + PG8_SB(b, h) + boff + n * 2048 + k * 1024); } while (0)
#define PG8_MMA(ai, bj, At, Bt) do { __builtin_amdgcn_s_setprio(1); _Pragma("unroll") for (int m = 0; m < 4; ++m) _Pragma("unroll") for (int n = 0; n < 2; ++n) _Pragma("unroll") for (int k = 0; k < 2; ++k) \
    acc[ai][bj][m][n] = __builtin_amdgcn_mfma_f32_16x16x32_bf16(Bt[n][k], At[m][k], acc[ai][bj][m][n], 0, 0, 0); __builtin_amdgcn_s_setprio(0); } while (0)
#define PG8_WAIT_V(n) asm volatile("s_waitcnt vmcnt(" #n ")" ::: "memory")
#define PG8_WAIT_L(n) asm volatile("s_waitcnt lgkmcnt(" #n ")" ::: "memory")
#define PG8_BAR __builtin_amdgcn_s_barrier()
#define PG8_SCHED __builtin_amdgcn_sched_barrier(0)
  Unit cur, nxt; int ui = 0;
  if (!S.next(0, cur)) return;
  f32x4 acc[2][2][4][2];
#pragma unroll
  for (int a = 0; a < 2; ++a)
#pragma unroll
    for (int b = 0; b < 2; ++b)
#pragma unroll
      for (int m = 0; m < 4; ++m)
#pragma unroll
        for (int n = 0; n < 2; ++n) acc[a][b][m][n] = (f32x4){0.f, 0.f, 0.f, 0.f};
  bf16x8 At[4][2], B0[2][2], B1[2][2];
  const char* cA = (const char*)g.A + (size_t)cur.pm * tstepA; const char* cB = (const char*)g.Bt + (size_t)cur.pn * tstepB;
  PG8_STAGE(PG8_SB(0, 0), cB, voffB); PG8_STAGE(PG8_SA(0, 0), cA, voffA); PG8_STAGE(PG8_SB(0, 1), cB + hstepB, voffB); PG8_STAGE(PG8_SA(0, 1), cA + hstepA, voffA);
  if (wr == 1) PG8_BAR;
  PG8_WAIT_V(4); PG8_BAR;
  PG8_STAGE(PG8_SB(1, 0), cB + kstep, voffB); PG8_STAGE(PG8_SA(1, 0), cA + kstep, voffA); PG8_STAGE(PG8_SB(1, 1), cB + hstepB + kstep, voffB);
  PG8_WAIT_V(6); PG8_BAR;
  for (;;) {
    const bool has_next = S.next(ui + 1, nxt);
    const char* nA = has_next ? (const char*)g.A + (size_t)nxt.pm * tstepA : cA; const char* nB = has_next ? (const char*)g.Bt + (size_t)nxt.pn * tstepB : cB;
    for (int t = 0; t < nt; t += 2) {
      const bool last = (t == nt - 2);
      const char* a1 = cA + (size_t)(t + 1) * kstep;
      const char* a2 = last ? nA : cA + (size_t)(t + 2) * kstep; const char* b2 = last ? nB : cB + (size_t)(t + 2) * kstep;
      const char* a3 = a2 + kstep; const char* b3 = b2 + kstep;
      PG8_LDB(B0, 0, 0); PG8_SCHED; PG8_LDA(At, 0, 0); PG8_STAGE(PG8_SA(1, 1), a1 + hstepA, voffA);
      PG8_WAIT_L(8); PG8_BAR; PG8_WAIT_L(0); PG8_MMA(0, 0, At, B0); PG8_BAR; PG8_SCHED;
      PG8_LDB(B1, 0, 1); PG8_STAGE(PG8_SB(0, 0), b2, voffB);
      PG8_BAR; PG8_WAIT_L(0); PG8_MMA(0, 1, At, B1); PG8_BAR;
      PG8_LDA(At, 0, 1); PG8_STAGE(PG8_SA(0, 0), a2, voffA);
      PG8_BAR; PG8_WAIT_L(0); PG8_MMA(1, 0, At, B0); PG8_BAR; PG8_SCHED;
      PG8_STAGE(PG8_SB(0, 1), b2 + hstepB, voffB);
      PG8_WAIT_V(6); PG8_BAR; PG8_MMA(1, 1, At, B1); PG8_BAR;
      PG8_LDB(B0, 1, 0); PG8_SCHED; PG8_LDA(At, 1, 0); PG8_STAGE(PG8_SA(0, 1), a2 + hstepA, voffA);
      PG8_WAIT_L(8); PG8_BAR; PG8_WAIT_L(0); PG8_MMA(0, 0, At, B0); PG8_BAR; PG8_SCHED;
      PG8_LDB(B1, 1, 1); PG8_STAGE(PG8_SB(1, 0), b3, voffB);
      PG8_BAR; PG8_WAIT_L(0); PG8_MMA(0, 1, At, B1); PG8_BAR;
      PG8_LDA(At, 1, 1); PG8_STAGE(PG8_SA(1, 0), a3, voffA);
      PG8_BAR; PG8_WAIT_L(0); PG8_MMA(1, 0, At, B0); PG8_BAR; PG8_SCHED;
      PG8_STAGE(PG8_SB(1, 1), b3 + hstepB, voffB);
      PG8_WAIT_V(6); PG8_BAR; PG8_MMA(1, 1, At, B1); PG8_BAR;
    }
    E(acc, cur, wr, wc, fr, fq, lane);
    if (!has_next) break;
#pragma unroll
    for (int a = 0; a < 2; ++a)
#pragma unroll
      for (int b = 0; b < 2; ++b)
#pragma unroll
        for (int m = 0; m < 4; ++m)
#pragma unroll
          for (int n = 0; n < 2; ++n) acc[a][b][m][n] = (f32x4){0.f, 0.f, 0.f, 0.f};
    cur = nxt; cA = nA; cB = nB; ++ui;
  }
  PG8_WAIT_V(0);
  if (wr == 0) PG8_BAR;
  PG8_BAR;
#undef PG8_SA
#undef PG8_SB
#undef PG8_STAGE
#undef PG8_LDA
#undef PG8_LDB
#undef PG8_MMA
#undef PG8_WAIT_V
#undef PG8_WAIT_L
#undef PG8_BAR
#undef PG8_SCHED
}
}

#define OFF_STATS OFF_GLR

__device__ __forceinline__ u32x4 pack8v(const f32x4& a, const f32x4& b) {
  u32x4 w; w.x = pg8::cvt_pk_bf16(a[0], a[1]); w.y = pg8::cvt_pk_bf16(a[2], a[3]); w.z = pg8::cvt_pk_bf16(b[0], b[1]); w.w = pg8::cvt_pk_bf16(b[2], b[3]); return w;
}
__device__ __forceinline__ float xlane32(float v, int lane) { return __int_as_float(__builtin_amdgcn_ds_bpermute((lane ^ 32) << 2, __float_as_int(v))); }

struct EpiScanIn {
  static constexpr bool PERM = true;
  u16* S; const float* rot;
  __device__ __forceinline__ void operator()(const f32x4 (&acc)[2][2][4][2], const pg8::Unit& u, int wr, int wc, int fr, int fq, int lane) const {
    u16* Sb = S + (size_t)u.pm * 256 * 4096;
    unsigned rl0 = wr * 64 + fr; asm volatile("" : "+v"(rl0));
#pragma unroll
    for (int bj = 0; bj < 2; ++bj) {
      const int nt128 = u.pn * 2 + bj;
      const bool scaled = (nt128 < 4) || (nt128 >= 16 && nt128 < 20);
      const float scl = scaled ? 0.08838834764831845f : 1.f;
      const unsigned cb = nt128 * 128 + wc * 32 + fq * 8;
      if (nt128 < 8 && u.pm < 128) {
        const int tb = (u.pm & 15) * 256;
        const int fo = ((wc & 1) * 16 + (fq & 1) * 8) * 2;
        const float sgn = (fq >> 1) ? 1.f : -1.f;
#pragma unroll
        for (int ai = 0; ai < 2; ++ai) {
          float4 cs[4][4];
#pragma unroll
          for (int q = 0; q < 4; ++q) {
            const int t = tb + (int)(rl0 + ai * 128 + q * 16);
            const unsigned pos = (wc >> 1) == 0 ? (t >> 6) : (t & 63);
            const float* rp = rot + pos * 64u + fo;
            cs[q][0] = *(const float4*)rp; cs[q][1] = *(const float4*)(rp + 4); cs[q][2] = *(const float4*)(rp + 8); cs[q][3] = *(const float4*)(rp + 12);
          }
          __builtin_amdgcn_sched_barrier(0);
#pragma unroll
          for (int m = 0; m < 4; ++m) {
            const unsigned rl = rl0 + ai * 128 + m * 16;
            const float4 c0 = cs[m][0], c1 = cs[m][1], c2 = cs[m][2], c3 = cs[m][3];
            const f32x4 v0 = acc[ai][bj][m][0], v1 = acc[ai][bj][m][1];
            f32x4 p0, p1;
#pragma unroll
            for (int j = 0; j < 4; ++j) { p0[j] = xlane32(v0[j], lane); p1[j] = xlane32(v1[j], lane); }
            f32x4 o0, o1;
            o0[0] = (v0[0] * c0.x + sgn * p0[0] * c0.y) * scl; o0[1] = (v0[1] * c0.z + sgn * p0[1] * c0.w) * scl;
            o0[2] = (v0[2] * c1.x + sgn * p0[2] * c1.y) * scl; o0[3] = (v0[3] * c1.z + sgn * p0[3] * c1.w) * scl;
            o1[0] = (v1[0] * c2.x + sgn * p1[0] * c2.y) * scl; o1[1] = (v1[1] * c2.z + sgn * p1[1] * c2.w) * scl;
            o1[2] = (v1[2] * c3.x + sgn * p1[2] * c3.y) * scl; o1[3] = (v1[3] * c3.z + sgn * p1[3] * c3.w) * scl;
            *(u32x4*)(Sb + rl * 4096u + cb) = pack8v(o0, o1);
            __builtin_amdgcn_sched_barrier(0);
          }
        }
      } else {
#pragma unroll
        for (int ai = 0; ai < 2; ++ai)
#pragma unroll
          for (int m = 0; m < 4; ++m) {
            const unsigned rl = rl0 + ai * 128 + m * 16;
            *(u32x4*)(Sb + rl * 4096u + cb) = pack8v(acc[ai][bj][m][0] * scl, acc[ai][bj][m][1] * scl);
            __builtin_amdgcn_sched_barrier(0);
          }
      }
    }
  }
};

struct EpiGate {
  static constexpr bool PERM = true;
  const u16* RG; const float* stats; u16* S; const float* rgain; const float* ggain;
  __device__ __forceinline__ void operator()(const f32x4 (&acc)[2][2][4][2], const pg8::Unit& u, int wr, int wc, int fr, int fq, int lane) const {
    u16* Sb = S + (size_t)u.pm * 256 * 4096;
    unsigned rl0 = wr * 64 + fr; asm volatile("" : "+v"(rl0));
    if (u.pn < 8) {
      const int branch = u.pn >> 2, head = u.pn & 3;
      const u16* RGb = RG + (size_t)u.pm * 256 * 2048 + branch * 1024;
      const float* stb = stats + (size_t)u.pm * 256 * 16 + (branch * 4 + head) * 2;
      const float* gain = branch ? ggain : rgain;
#pragma unroll
      for (int bj = 0; bj < 2; ++bj) {
        const unsigned cb = head * 256 + bj * 128 + wc * 32 + fq * 8;
        const float4 g0 = *(const float4*)(gain + cb), g1 = *(const float4*)(gain + cb + 4);
#pragma unroll
        for (int ai = 0; ai < 2; ++ai) {
        float2 stv[4]; bf16x8 xrv[4];
#pragma unroll
        for (int q = 0; q < 4; ++q) {
          const unsigned rl = rl0 + ai * 128 + q * 16;
          stv[q] = *(const float2*)(stb + rl * 16u);
          xrv[q] = *(const bf16x8*)(RGb + rl * 2048u + cb);
        }
        __builtin_amdgcn_sched_barrier(0);
#pragma unroll
          for (int m = 0; m < 4; ++m) {
            const unsigned rl = rl0 + ai * 128 + m * 16;
            const float2 st = stv[m];
            const bf16x8 xr = xrv[m];
            f32x4 v0 = acc[ai][bj][m][0], v1 = acc[ai][bj][m][1];
            asm volatile("" : "+v"(v0), "+v"(v1));
            f32x4 o0, o1;
            o0[0] = (bf2f((u16)xr[0]) * st.x + st.y) * g0.x * siluf_(v0[0]); o0[1] = (bf2f((u16)xr[1]) * st.x + st.y) * g0.y * siluf_(v0[1]);
            o0[2] = (bf2f((u16)xr[2]) * st.x + st.y) * g0.z * siluf_(v0[2]); o0[3] = (bf2f((u16)xr[3]) * st.x + st.y) * g0.w * siluf_(v0[3]);
            o1[0] = (bf2f((u16)xr[4]) * st.x + st.y) * g1.x * siluf_(v1[0]); o1[1] = (bf2f((u16)xr[5]) * st.x + st.y) * g1.y * siluf_(v1[1]);
            o1[2] = (bf2f((u16)xr[6]) * st.x + st.y) * g1.z * siluf_(v1[2]); o1[3] = (bf2f((u16)xr[7]) * st.x + st.y) * g1.w * siluf_(v1[3]);
            *(u32x4*)(Sb + rl * 4096u + 2048u + branch * 1024 + cb) = pack8v(o0, o1);
            __builtin_amdgcn_sched_barrier(0);
          }
        }
      }
    } else {
#pragma unroll
      for (int bj = 0; bj < 2; ++bj) {
        const unsigned cb = (u.pn - 8) * 256 + bj * 128 + wc * 32 + fq * 8;
#pragma unroll
        for (int ai = 0; ai < 2; ++ai)
#pragma unroll
          for (int m = 0; m < 4; ++m) {
            const unsigned rl = rl0 + ai * 128 + m * 16;
            f32x4 v0 = acc[ai][bj][m][0], v1 = acc[ai][bj][m][1];
            asm volatile("" : "+v"(v0), "+v"(v1));
            f32x4 o0, o1;
#pragma unroll
            for (int j = 0; j < 4; ++j) { o0[j] = sigmoidf_(v0[j]); o1[j] = sigmoidf_(v1[j]); }
            *(u32x4*)(Sb + rl * 4096u + cb) = pack8v(o0, o1);
            __builtin_amdgcn_sched_barrier(0);
          }
      }
    }
  }
};

struct EpiMerge {
  static constexpr bool PERM = true;
  const u16* S; u16* MG; int pass;
  __device__ __forceinline__ void operator()(const f32x4 (&acc)[2][2][4][2], const pg8::Unit& u, int wr, int wc, int fr, int fq, int lane) const {
    const u16* Sb = S + (size_t)u.pm * 256 * 4096 + pass * 1024;
    u16* MGb = MG + (size_t)u.pm * 256 * 1024;
    unsigned rl0 = wr * 64 + fr; asm volatile("" : "+v"(rl0));
#pragma unroll
    for (int bj = 0; bj < 2; ++bj) {
      const unsigned cb = u.pn * 256 + bj * 128 + wc * 32 + fq * 8;
#pragma unroll
      for (int ai = 0; ai < 2; ++ai) {
      bf16x8 gtv[4], oldv_[4];
#pragma unroll
      for (int q = 0; q < 4; ++q) {
        const unsigned rl = rl0 + ai * 128 + q * 16;
        gtv[q] = *(const bf16x8*)(Sb + rl * 4096u + cb);
        if (pass) oldv_[q] = *(const bf16x8*)(MGb + rl * 1024u + cb);
      }
      __builtin_amdgcn_sched_barrier(0);
#pragma unroll
        for (int m = 0; m < 4; ++m) {
          const unsigned rl = rl0 + ai * 128 + m * 16;
          const bf16x8 gt = gtv[m];
          f32x4 o0 = acc[ai][bj][m][0], o1 = acc[ai][bj][m][1];
#pragma unroll
          for (int j = 0; j < 4; ++j) { o0[j] *= bf2f((u16)gt[j]); o1[j] *= bf2f((u16)gt[4 + j]); }
          if (pass) {
            const bf16x8 old = oldv_[m];
#pragma unroll
            for (int j = 0; j < 4; ++j) { o0[j] += bf2f((u16)old[j]); o1[j] += bf2f((u16)old[4 + j]); }
          }
          *(u32x4*)(MGb + rl * 1024u + cb) = pack8v(o0, o1);
            __builtin_amdgcn_sched_barrier(0);
        }
      }
    }
  }
};

struct EpiOut {
  static constexpr bool PERM = false;
  const float* x_lat; const float* x_ctx; float* o_lat; float* o_ctx; const float* mod;
  __device__ __forceinline__ void operator()(const f32x4 (&acc)[2][2][4][2], const pg8::Unit& u, int wr, int wc, int fr, int fq, int lane) const {
    const float* hin; float* hout; int rmod;
    if (u.pm < 128) { hin = x_lat + (size_t)u.pm * 256 * DM; hout = o_lat + (size_t)u.pm * 256 * DM; rmod = u.pm >> 4; }
    else { hin = x_ctx + (size_t)(u.pm - 128) * 256 * DM; hout = o_ctx + (size_t)(u.pm - 128) * 256 * DM; rmod = 8; }
    const float* gate = mod + rmod * 3072 + 2048;
    unsigned rl0 = wr * 64 + fr; asm volatile("" : "+v"(rl0));
#pragma unroll
    for (int bj = 0; bj < 2; ++bj)
#pragma unroll
      for (int n = 0; n < 2; ++n) {
        const unsigned cb = u.pn * 256 + bj * 128 + wc * 32 + n * 16 + fq * 4;
        const float4 g = *(const float4*)(gate + cb);
        float4 hv[8];
#pragma unroll
        for (int q = 0; q < 8; ++q) hv[q] = *(const float4*)(hin + (rl0 + (q >> 2) * 128 + (q & 3) * 16) * 1024u + cb);
        __builtin_amdgcn_sched_barrier(0);
#pragma unroll
        for (int ai = 0; ai < 2; ++ai)
#pragma unroll
          for (int m = 0; m < 4; ++m) {
            const unsigned o = (rl0 + ai * 128 + m * 16) * 1024u + cb;
            const float4 h = hv[ai * 4 + m];
            const f32x4 v = acc[ai][bj][m][n];
            *(float4*)(hout + o) = make_float4(h.x + g.x * v[0], h.y + g.y * v[1], h.z + g.z * v[2], h.w + g.w * v[3]);
          }
      }
  }
};

__device__ __forceinline__ void phase_stats(const Params& p, int l) {
  const int tid = opaque_tid(); const int wave = tid >> 6, lane = tid & 63;
  const u16* RG = (const u16*)(p.ws + OFF_RG);
  float* ST = (float*)(p.ws + OFF_STATS);
  const int nrows = (l == 0) ? MTOT : MLAT;
  for (int row = (blockIdx.x * 8 + wave) * 4; row < nrows; row += gridDim.x * 32) {
    bf16x8 v[4][4];
#pragma unroll
    for (int q = 0; q < 4; ++q)
#pragma unroll
      for (int i = 0; i < 4; ++i) v[q][i] = *(const bf16x8*)(RG + (size_t)(row + q) * 2048 + i * 512 + lane * 8);
#pragma unroll
    for (int q = 0; q < 4; ++q)
#pragma unroll
      for (int i = 0; i < 4; ++i) {
        float s1 = 0.f, s2 = 0.f;
#pragma unroll
        for (int x = 0; x < 8; ++x) { float a = bf2f((u16)v[q][i][x]); s1 += a; s2 += a * a; }
#pragma unroll
        for (int o = 16; o > 0; o >>= 1) {
          s1 += __int_as_float(__builtin_amdgcn_ds_bpermute((lane ^ o) << 2, __float_as_int(s1)));
          s2 += __int_as_float(__builtin_amdgcn_ds_bpermute((lane ^ o) << 2, __float_as_int(s2)));
        }
        float sa, sb;
        if ((i >> 1) == 0) { float mu = s1 * (1.f / 256.f); float var = fmaxf(s2 * (1.f / 256.f) - mu * mu, 0.f); sa = rsqrtf(var + 1e-6f); sb = -mu * sa; }
        else { sa = rsqrtf(s2 * (1.f / 256.f) + 1e-6f); sb = 0.f; }
        if ((lane & 31) == 0) *(float2*)(ST + ((size_t)(row + q) * 8 + (i >> 1) * 4 + 2 * (i & 1) + (lane >> 5)) * 2) = make_float2(sa, sb);
      }
  }
}

#define OFF_VECS OFF_WT
__device__ __forceinline__ float logsig16(float x) { return (fminf(x, 0.f) - __logf(1.f + __expf(-fabsf(x)))) * (1.f / 16.f); }

typedef __attribute__((ext_vector_type(2))) float f32x2_t;

template <int SW>
__device__ __forceinline__ void prepass_sweep4(const float* GLRS, const f32x2_t (&w2)[4][16], const f32x2_t (&b2)[4], u16* Sq, u16* Ub,
                                               float (&accF)[4], float (&accB)[4]) {
#pragma unroll
  for (int c = 0; c < 4; ++c) { accF[c] = 0.f; accB[c] = 0.f; }
#pragma unroll 4
  for (int u = 0; u < 32; ++u) {
    const int i = SW ? 32 + u : 31 - u;
    const bf16x4 q4 = *(const bf16x4*)(Sq + (unsigned)i * 4096u);
    const bf16x4 k4 = *(const bf16x4*)(Sq + (unsigned)i * 4096u + 512u);
    const float4* gr = (const float4*)(GLRS + (i & 31) * 16);
    const float4 g0 = gr[0], g1 = gr[1], g2 = gr[2], g3 = gr[3];
    bf16x4 oqf, okf, oqb, okb;
#pragma unroll
    for (int c = 0; c < 4; ++c) {
      f32x2_t x = b2[c];
      x = w2[c][0] * g0.x + x;  x = w2[c][1] * g0.y + x;  x = w2[c][2] * g0.z + x;  x = w2[c][3] * g0.w + x;
      x = w2[c][4] * g1.x + x;  x = w2[c][5] * g1.y + x;  x = w2[c][6] * g1.z + x;  x = w2[c][7] * g1.w + x;
      x = w2[c][8] * g2.x + x;  x = w2[c][9] * g2.y + x;  x = w2[c][10] * g2.z + x; x = w2[c][11] * g2.w + x;
      x = w2[c][12] * g3.x + x; x = w2[c][13] * g3.y + x; x = w2[c][14] * g3.z + x; x = w2[c][15] * g3.w + x;
      const float laf = logsig16(x.x), lab = logsig16(x.y);
      float relf, relb;
      if (SW == 0) { relf = -accF[c]; accF[c] += laf; accB[c] += lab; relb = accB[c]; }
      else         { accF[c] += laf; relf = accF[c]; relb = -accB[c]; accB[c] += lab; }
      const float q = bf2f((u16)q4[c]), k = bf2f((u16)k4[c]);
      oqf[c] = (short)f2bf(q * __expf(relf)); okf[c] = (short)f2bf(k * __expf(-relf));
      oqb[c] = (short)f2bf(q * __expf(relb)); okb[c] = (short)f2bf(k * __expf(-relb));
    }
    *(bf16x4*)(Sq + (unsigned)i * 4096u) = oqf;
    *(bf16x4*)(Sq + (unsigned)i * 4096u + 512u) = okf;
    *(bf16x4*)(Ub + (unsigned)i * 1024u) = oqb;
    *(bf16x4*)(Ub + (unsigned)i * 1024u + 512u) = okb;
  }
}

__device__ __forceinline__ void gla_prepass_unit(const Params& p, int l, int bunit, char* smem) {
  const int tid = opaque_tid();
  const int ul = __builtin_amdgcn_readfirstlane(tid >> 7);
  const int gu = bunit * 4 + ul;
  const int sw = gu & 1, ch = gu >> 1;
  const int b = ch / 68, cid = ch % 68;
  const int base = cid < 4 ? (MLAT + b * 256 + cid * 64) : (b * 4096 + (cid - 4) * 64);
  float* GLRS = (float*)smem + ul * 512;
  const int col0 = (tid & 127) * 4;
  __syncthreads();
  {
    const int uw = (tid >> 6) & 1, lane = tid & 63, fr = lane & 15, fq = lane >> 4;
    f32x4 g = (f32x4){0.f, 0.f, 0.f, 0.f};
    const u16* Ua = (const u16*)(p.ws + OFF_U) + (size_t)(base + sw * 32 + uw * 16 + fr) * 1024 + fq * 8;
    const u16* Wb = (const u16*)(p.ws + OFF_WT) + (size_t)(4096 + fr) * 1024 + fq * 8;
#pragma unroll 16
    for (int k = 0; k < 1024; k += 32) {
      bf16x8 a = *(const bf16x8*)(Ua + k);
      bf16x8 w = *(const bf16x8*)(Wb + k);
      g = __builtin_amdgcn_mfma_f32_16x16x32_bf16(a, w, g, 0, 0, 0);
    }
#pragma unroll
    for (int j = 0; j < 4; ++j) GLRS[(uw * 16 + fq * 4 + j) * 16 + fr] = g[j];
  }
  f32x2_t w2[4][16], b2[4];
  {
    const float* w0 = p.gla_w_up + (size_t)(l * 2 + 0) * 16 * 512 + col0;
    const float* w1 = p.gla_w_up + (size_t)(l * 2 + 1) * 16 * 512 + col0;
#pragma unroll
    for (int r = 0; r < 16; ++r) {
      const float4 a = *(const float4*)(w0 + r * 512), c = *(const float4*)(w1 + r * 512);
      w2[0][r].x = a.x; w2[1][r].x = a.y; w2[2][r].x = a.z; w2[3][r].x = a.w;
      w2[0][r].y = c.x; w2[1][r].y = c.y; w2[2][r].y = c.z; w2[3][r].y = c.w;
    }
    const float4 a = *(const float4*)(p.gla_b_up + (l * 2 + 0) * 512 + col0), c = *(const float4*)(p.gla_b_up + (l * 2 + 1) * 512 + col0);
    b2[0].x = a.x; b2[1].x = a.y; b2[2].x = a.z; b2[3].x = a.w;
    b2[0].y = c.x; b2[1].y = c.y; b2[2].y = c.z; b2[3].y = c.w;
  }
  __syncthreads();
  u16* Sq = (u16*)(p.ws + OFF_S) + (size_t)base * 4096 + 2048 + col0;
  u16* Ub = (l == 0 ? (u16*)p.out : (u16*)(p.ws + OFF_U)) + (size_t)base * 1024 + col0;
  float* V0 = (float*)(p.ws + OFF_VECS) + ((size_t)(0 * 544 + b * 68 + cid) * 2) * 512 + col0;
  float* V1 = (float*)(p.ws + OFF_VECS) + ((size_t)(1 * 544 + b * 68 + cid) * 2) * 512 + col0;
  float accF[4], accB[4];
  if (sw == 0) {
    prepass_sweep4<0>(GLRS, w2, b2, Sq, Ub, accF, accB);
    *(float4*)(V0) = make_float4(__expf(accF[0]), __expf(accF[1]), __expf(accF[2]), __expf(accF[3]));
    *(float4*)(V1 + 512) = make_float4(__expf(accB[0]), __expf(accB[1]), __expf(accB[2]), __expf(accB[3]));
  } else {
    prepass_sweep4<1>(GLRS, w2, b2, Sq, Ub, accF, accB);
    *(float4*)(V0 + 512) = make_float4(__expf(accF[0]), __expf(accF[1]), __expf(accF[2]), __expf(accF[3]));
    *(float4*)(V1) = make_float4(__expf(accB[0]), __expf(accB[1]), __expf(accB[2]), __expf(accB[3]));
  }
}

template <int SW>
__device__ __forceinline__ void prepass_sweep(const float* GLRS, const f32x2_t (&w2)[16], f32x2_t b2, u16* Sq, u16* Ub, float& accF, float& accB) {
  accF = 0.f; accB = 0.f;
#pragma unroll 16
  for (int u = 0; u < 32; ++u) {
    const int i = SW ? 32 + u : 31 - u;
    const float4* gr = (const float4*)(GLRS + i * 16);
    const float4 g0 = gr[0], g1 = gr[1], g2 = gr[2], g3 = gr[3];
    f32x2_t x = b2;
    x = w2[0] * g0.x + x;  x = w2[1] * g0.y + x;  x = w2[2] * g0.z + x;  x = w2[3] * g0.w + x;
    x = w2[4] * g1.x + x;  x = w2[5] * g1.y + x;  x = w2[6] * g1.z + x;  x = w2[7] * g1.w + x;
    x = w2[8] * g2.x + x;  x = w2[9] * g2.y + x;  x = w2[10] * g2.z + x; x = w2[11] * g2.w + x;
    x = w2[12] * g3.x + x; x = w2[13] * g3.y + x; x = w2[14] * g3.z + x; x = w2[15] * g3.w + x;
    const float laf = logsig16(x.x), lab = logsig16(x.y);
    float relf, relb;
    if (SW == 0) { relf = -accF; accF += laf; accB += lab; relb = accB; }
    else         { accF += laf; relf = accF; relb = -accB; accB += lab; }
    const float q = bf2f(Sq[(unsigned)i * 4096u]), k = bf2f(Sq[(unsigned)i * 4096u + 512u]);
    Sq[(unsigned)i * 4096u] = f2bf(q * __expf(relf));
    Sq[(unsigned)i * 4096u + 512u] = f2bf(k * __expf(-relf));
    Ub[(unsigned)i * 1024u] = f2bf(q * __expf(relb));
    Ub[(unsigned)i * 1024u + 512u] = f2bf(k * __expf(-relb));
  }
}

__device__ __forceinline__ void gla_prepass_unit1(const Params& p, int l, int unit, char* smem) {
  const int tid = opaque_tid();
  const int sw = unit & 1, ch = unit >> 1;
  const int b = ch / 68, cid = ch % 68;
  const int base = cid < 4 ? (MLAT + b * 256 + cid * 64) : (b * 4096 + (cid - 4) * 64);
  float* GLRS = (float*)smem;
  __syncthreads();
  {
    const int wid = tid >> 6, lane = tid & 63, fr = lane & 15, fq = lane >> 4;
    if (wid < 2) {
      const int r0 = sw * 32 + wid * 16;
      f32x4 g = (f32x4){0.f, 0.f, 0.f, 0.f};
      const u16* Ua = (const u16*)(p.ws + OFF_U) + (size_t)(base + r0 + fr) * 1024 + fq * 8;
      const u16* Wb = (const u16*)(p.ws + OFF_WT) + (size_t)(4096 + fr) * 1024 + fq * 8;
#pragma unroll 16
      for (int k = 0; k < 1024; k += 32) {
        bf16x8 a = *(const bf16x8*)(Ua + k);
        bf16x8 w = *(const bf16x8*)(Wb + k);
        g = __builtin_amdgcn_mfma_f32_16x16x32_bf16(a, w, g, 0, 0, 0);
      }
#pragma unroll
      for (int j = 0; j < 4; ++j) GLRS[(r0 + fq * 4 + j) * 16 + fr] = g[j];
    }
  }
  f32x2_t w2[16];
  {
    const float* w0 = p.gla_w_up + (size_t)(l * 2 + 0) * 16 * 512 + tid;
    const float* w1 = p.gla_w_up + (size_t)(l * 2 + 1) * 16 * 512 + tid;
#pragma unroll
    for (int r = 0; r < 16; ++r) { w2[r].x = w0[r * 512]; w2[r].y = w1[r * 512]; }
  }
  f32x2_t b2; b2.x = p.gla_b_up[(l * 2 + 0) * 512 + tid]; b2.y = p.gla_b_up[(l * 2 + 1) * 512 + tid];
  __syncthreads();
  u16* Sq = (u16*)(p.ws + OFF_S) + (size_t)base * 4096 + 2048 + tid;
  u16* Ub = (l == 0 ? (u16*)p.out : (u16*)(p.ws + OFF_U)) + (size_t)base * 1024 + tid;
  float* V0 = (float*)(p.ws + OFF_VECS) + ((size_t)(0 * 544 + b * 68 + cid) * 2) * 512 + tid;
  float* V1 = (float*)(p.ws + OFF_VECS) + ((size_t)(1 * 544 + b * 68 + cid) * 2) * 512 + tid;
  float accF, accB;
  if (sw == 0) {
    prepass_sweep<0>(GLRS, w2, b2, Sq, Ub, accF, accB);
    V0[0] = __expf(accF);
    V1[512] = __expf(accB);
  } else {
    prepass_sweep<1>(GLRS, w2, b2, Sq, Ub, accF, accB);
    V0[512] = __expf(accF);
    V1[0] = __expf(accB);
  }
}

#define L_QR   0
#define L_KR   17408
#define L_V    34816
#define L_SGT  44032
#define L_P    61440
#undef  SCAN_GB
#define SCAN_GB 70656

__device__ __forceinline__ int off128(int row, int col) { return row * 272 + col * 2; }
__device__ __forceinline__ int off64(int row, int col) { return row * 144 + col * 2; }

template <int RS>
__device__ __forceinline__ bf16x8 tr_frag(unsigned img_addr, int r0, int c0, int lane) {
  const int g = lane >> 4, q = (lane & 15) >> 2, pp = lane & 3;
  unsigned a = img_addr + (unsigned)((r0 + 8 * g + q) * RS + (c0 + 4 * pp) * 2);
  bf16x4 lo, hi;
  asm volatile("ds_read_b64_tr_b16 %0, %2\n\tds_read_b64_tr_b16 %1, %2 offset:%3\n\ts_waitcnt lgkmcnt(0)"
               : "=&v"(lo), "=&v"(hi) : "v"(a), "n"(4 * RS) : "memory");
  bf16x8 r;
  r[0] = lo[0]; r[1] = lo[1]; r[2] = lo[2]; r[3] = lo[3]; r[4] = hi[0]; r[5] = hi[1]; r[6] = hi[2]; r[7] = hi[3];
  return r;
}

typedef short trs4_t __attribute__((ext_vector_type(4)));
__device__ __forceinline__ bf16x8 tr_pair(const char* p, int hi_off) {
  trs4_t lo = __builtin_amdgcn_ds_read_tr16_b64_v4i16((__attribute__((address_space(3))) trs4_t*)p);
  trs4_t hi = __builtin_amdgcn_ds_read_tr16_b64_v4i16((__attribute__((address_space(3))) trs4_t*)(p + hi_off));
  return __builtin_shufflevector(lo, hi, 0, 1, 2, 3, 4, 5, 6, 7);
}

__device__ __forceinline__ bf16x8 scale8(bf16x8 v, float f) {
  bf16x8 o;
#pragma unroll
  for (int x = 0; x < 8; ++x) o[x] = (short)f2bf(bf2f((u16)v[x]) * f);
  return o;
}

__device__ __forceinline__ void lds_barrier() { asm volatile("s_waitcnt lgkmcnt(0)" ::: "memory"); __builtin_amdgcn_s_barrier(); asm volatile("" ::: "memory"); }

template <int branch>
__device__ __forceinline__ void scan_item(const Params& p, int l, int item, char* smem) {
  const int b = (item >> 4) & 7, h = (item >> 2) & 3, slice = item & 3;
  const int tid = opaque_tid(), wid = __builtin_amdgcn_readfirstlane(tid >> 6), lane = tid & 63;
  const int dir = wid >> 2, gw = wid & 3, gt = tid & 255;
  const int fr = lane & 15, fq = lane >> 4;
  char* G = smem + dir * SCAN_GB;
  const unsigned Ga = (unsigned)(size_t)G;
  const u16* S = (const u16*)(p.ws + OFF_S);
  u16* RG = (u16*)(p.ws + OFF_RG);
  const u16* qsrc; unsigned qstride;
  if (branch == 0) { qsrc = S + h * 128; qstride = 4096; }
  else if (dir == 0) { qsrc = S + 2048 + h * 128; qstride = 4096; }
  else { qsrc = (l == 0 ? (const u16*)p.out : (const u16*)(p.ws + OFF_U)) + h * 128; qstride = 1024; }
  const int voff = branch * 2048 + 1024 + h * 256 + slice * 64;
  const int ooff = branch * 1024 + h * 256 + slice * 64;
  float lg = 0.f, egc = 1.f;
  if (branch == 0) { lg = __logf(1.f - __expf(p.ret_decay[(l * 2 + dir) * 4 + h])); egc = __expf(32.f * lg); }
  const float* VECS = (const float*)(p.ws + OFF_VECS) + ((size_t)(dir * 544 + b * 68) * 2) * 512 + h * 128;
  f32x4 st[2][4];
#pragma unroll
  for (int m = 0; m < 2; ++m)
#pragma unroll
    for (int n = 0; n < 4; ++n) st[m][n] = (f32x4){0.f, 0.f, 0.f, 0.f};

  const int qj = gt >> 4, qc = gt & 15;
  const int vj = gt >> 3, vc = gt & 7;
  bf16x8 pq[4], pk[4], pv[2];
  float4 peg[2], pel[2];
  auto prefetch = [&](int s) {
    int base, cid;
    if (s < 4) { int cc = dir ? 3 - s : s; base = MLAT + b * 256 + cc * 64; cid = cc; }
    else { int c = s - 4; int cc = dir ? 63 - c : c; base = b * 4096 + cc * 64; cid = 4 + cc; }
#pragma unroll
    for (int i = 0; i < 4; ++i) {
      int jp = qj + 16 * i;
      const u16* qb_ = qsrc + (size_t)base * qstride;
      unsigned ro = (unsigned)(dir ? 63 - jp : jp) * qstride + qc * 8;
      pq[i] = *(const bf16x8*)(qb_ + ro);
      pk[i] = *(const bf16x8*)(qb_ + ro + 512);
    }
#pragma unroll
    for (int i = 0; i < 2; ++i) {
      int jp = vj + 32 * i;
      pv[i] = *(const bf16x8*)((S + (size_t)base * 4096 + voff) + ((unsigned)(dir ? 63 - jp : jp) * 4096u + vc * 8));
    }
    (void)cid;
  };
  auto prefetch_vecs = [&](int s) {
    if (branch == 1) {
      int cid;
      if (s < 4) { cid = dir ? 3 - s : s; } else { int c = s - 4; cid = 4 + (dir ? 63 - c : c); }
#pragma unroll
      for (int m = 0; m < 2; ++m) {
        int d0 = gw * 32 + m * 16 + fq * 4;
        peg[m] = *(const float4*)(VECS + (size_t)cid * 1024 + d0);
        pel[m] = *(const float4*)(VECS + (size_t)cid * 1024 + 512 + d0);
      }
    } else {
#pragma unroll
      for (int m = 0; m < 2; ++m) { peg[m] = make_float4(egc, egc, egc, egc); pel[m] = peg[m]; }
    }
  };
  prefetch(0);
  prefetch_vecs(0);
  __syncthreads();

  for (int s = 0; s < 68; ++s) {
    int base; bool first; bool wout;
    if (s < 4) { int cc = dir ? 3 - s : s; base = MLAT + b * 256 + cc * 64; first = s < 2; wout = (l == 0); }
    else { int c = s - 4; int cc = dir ? 63 - c : c; base = b * 4096 + cc * 64; first = c < 32; wout = true; }
    float4 (&eg)[2] = peg; float4 (&el)[2] = pel;
#pragma unroll
    for (int i = 0; i < 4; ++i) {
      int jp = qj + 16 * i;
      bf16x8 qv = pq[i], kv_ = pk[i];
      if (branch == 0) {
        float fqs = __expf((float)(jp - 31) * lg), fks = __expf((float)(31 - jp) * lg);
        qv = scale8(qv, fqs); kv_ = scale8(kv_, fks);
      }
      *(bf16x8*)(G + L_QR + off128(jp, qc * 8)) = qv;
      *(bf16x8*)(G + L_KR + off128(jp, qc * 8)) = kv_;
    }
#pragma unroll
    for (int i = 0; i < 2; ++i) *(bf16x8*)(G + L_V + off64(vj + 32 * i, vc * 8)) = pv[i];
#pragma unroll
    for (int m = 0; m < 2; ++m) {
      int d0 = gw * 32 + m * 16 + fq * 4;
#pragma unroll
      for (int n = 0; n < 4; ++n) {
        int e = n * 16 + fr;
        bf16x4 o4;
        o4[0] = (short)f2bf(st[m][n][0] * eg[m].x); o4[1] = (short)f2bf(st[m][n][1] * eg[m].y);
        o4[2] = (short)f2bf(st[m][n][2] * eg[m].z); o4[3] = (short)f2bf(st[m][n][3] * eg[m].w);
        *(bf16x4*)(G + L_SGT + off128(e, d0)) = o4;
      }
    }
    u16 oldv[4][4];
    u16* dstb = RG + (size_t)base * 2048 + ooff;
    if (wout && !first) {
#pragma unroll
      for (int r = 0; r < 4; ++r) {
        int ip = gw * 16 + fq * 4 + r;
        unsigned ro = (unsigned)(dir ? 63 - ip : ip) * 2048u + fr;
#pragma unroll
        for (int n = 0; n < 4; ++n) oldv[r][n] = dstb[ro + n * 16];
      }
    }
    if (s + 1 < 68) prefetch(s + 1);
    lds_barrier();
    f32x4 pt[4], o[4];
#pragma unroll
    for (int n = 0; n < 4; ++n) { pt[n] = (f32x4){0.f, 0.f, 0.f, 0.f}; o[n] = (f32x4){0.f, 0.f, 0.f, 0.f}; }
#pragma unroll
    for (int ks = 0; ks < 4; ++ks) {
      int kc = ks * 32 + fq * 8;
      bf16x8 qa = *(const bf16x8*)(G + L_QR + off128(gw * 16 + fr, kc));
#pragma unroll
      for (int n = 0; n < 4; ++n) {
        bf16x8 ka = *(const bf16x8*)(G + L_KR + off128(n * 16 + fr, kc));
        bf16x8 sb = *(const bf16x8*)(G + L_SGT + off128(n * 16 + fr, kc));
        pt[n] = __builtin_amdgcn_mfma_f32_16x16x32_bf16(ka, qa, pt[n], 0, 0, 0);
        o[n] = __builtin_amdgcn_mfma_f32_16x16x32_bf16(qa, sb, o[n], 0, 0, 0);
      }
    }
    {
      const int ip = gw * 16 + fr;
#pragma unroll
      for (int n = 0; n < 4; ++n) {
        const int j0 = n * 16 + fq * 4;
        bf16x4 w;
#pragma unroll
        for (int r = 0; r < 4; ++r) {
          int jp = j0 + r;
          bool keep = dir ? (ip > jp) : (ip >= jp);
          w[r] = (short)f2bf(keep ? pt[n][r] : 0.f);
        }
        *(bf16x4*)(G + L_P + off64(ip, j0)) = w;
      }
    }
    asm volatile("s_waitcnt lgkmcnt(0)" ::: "memory");
    {
      const int tg = lane >> 4, tq = (lane & 15) >> 2, tp = lane & 3;
#pragma unroll
      for (int m = 0; m < 2; ++m) {
        f32x4 kv[4];
#pragma unroll
        for (int n = 0; n < 4; ++n) kv[n] = (f32x4){0.f, 0.f, 0.f, 0.f};
#pragma unroll
        for (int ks = 0; ks < 2; ++ks) {
          int kc = ks * 32 + fq * 8;
          const char* kp = G + L_KR + (8 * tg + tq) * 272 + (gw * 32 + 4 * tp) * 2 + ks * 32 * 272 + m * 32;
          const char* vp = G + L_V + (8 * tg + tq) * 144 + (4 * tp) * 2 + ks * 32 * 144;
          const bf16x8 km = tr_pair(kp, 4 * 272);
          bf16x8 vb[4];
#pragma unroll
          for (int n = 0; n < 4; ++n) vb[n] = tr_pair(vp + n * 32, 4 * 144);
          bf16x8 pa;
          if (m == 0) pa = *(const bf16x8*)(G + L_P + off64(gw * 16 + fr, kc));
#pragma unroll
          for (int n = 0; n < 4; ++n) {
            if (m == 0) o[n] = __builtin_amdgcn_mfma_f32_16x16x32_bf16(pa, vb[n], o[n], 0, 0, 0);
            kv[n] = __builtin_amdgcn_mfma_f32_16x16x32_bf16(km, vb[n], kv[n], 0, 0, 0);
          }
        }
#pragma unroll
        for (int n = 0; n < 4; ++n) {
          st[m][n][0] = eg[m].x * el[m].x * st[m][n][0] + el[m].x * kv[n][0];
          st[m][n][1] = eg[m].y * el[m].y * st[m][n][1] + el[m].y * kv[n][1];
          st[m][n][2] = eg[m].z * el[m].z * st[m][n][2] + el[m].z * kv[n][2];
          st[m][n][3] = eg[m].w * el[m].w * st[m][n][3] + el[m].w * kv[n][3];
        }
      }
    }
    if (branch == 1 && s + 1 < 68) prefetch_vecs(s + 1);
    if (wout) {
#pragma unroll
      for (int r = 0; r < 4; ++r) {
        int ip = gw * 16 + fq * 4 + r;
        unsigned ro = (unsigned)(dir ? 63 - ip : ip) * 2048u + fr;
#pragma unroll
        for (int n = 0; n < 4; ++n) {
          float v = o[n][r];
          if (!first) v += bf2f(oldv[r][n]);
          dstb[ro + n * 16] = f2bf(v);
        }
      }
    }
    __syncthreads();
  }
}

#define NPHASE 18
__device__ __forceinline__ void run_phase(const Params& p, int ph, char* smem) {
  const int nblk = gridDim.x, bid = blockIdx.x;
  if (ph == 0) {
#ifdef REP_P0
    for (int rep = 0; rep < REP_P0; ++rep)
#endif
    for (int u = bid; u < WT_UNITS + 96 + 1; u += nblk) {
      if (u < 96) mod_unit(p, u, smem);
      else if (u == 96) rot_unit(p);
      else wt_unit(p, 0, u - 97, smem);
    }
    return;
  }
  if (ph == NPHASE - 1) { phase_final(p); return; }
  const int l = (ph - 1) / 8, sp = (ph - 1) % 8;
  PG8_LAS unsigned char* lds = (PG8_LAS unsigned char*)smem;
  switch (sp) {
    case 0:
      phase_u(p, l);
      if (l == 1) for (int u = bid; u < WT_UNITS; u += nblk) wt_unit(p, 1, u, smem);
      break;
    case 1: {
      pg8::Gemm g{(const u16*)(p.ws + OFF_U), (const u16*)(p.ws + OFF_WT) + (size_t)WT_SCAN * 1024, 1024, MTOT, 4096, 1024};
      pg8::StaticOrder S; S.init(g.M, g.N, nblk, bid);
      EpiScanIn E{(u16*)(p.ws + OFF_S), (const float*)(p.ws + OFF_ROT)};
      pg8::gemm_phase(lds, g, S, E, opaque_tid());
    } break;
    case 2:
      for (int t = bid; t < 256; t += nblk) gla_prepass_unit(p, l, t, smem);
      for (int t = 1024 + (bid + 96) % nblk; t < 1088; t += nblk) gla_prepass_unit1(p, l, t, smem);
      break;
    case 3:
#ifdef REP_SCAN
      for (int rep = 0; rep < REP_SCAN; ++rep)
#endif
      for (int t = bid; t < 256; t += nblk) { if (t < 128) scan_item<0>(p, l, t, smem); else scan_item<1>(p, l, t, smem); } break;
    case 4:
      if (l != 0) phase_u(p, l);
      phase_stats(p, l);
      break;
    case 5: {
      pg8::Gemm g{(const u16*)(p.ws + OFF_U), (const u16*)(p.ws + OFF_WT) + (size_t)WT_GATE * 1024, 1024, l == 0 ? MTOT : MLAT, 4096, 1024};
      pg8::StaticOrder S; S.init(g.M, g.N, nblk, bid);
      EpiGate E{(const u16*)(p.ws + OFF_RG), (const float*)(p.ws + OFF_STATS), (u16*)(p.ws + OFF_S), p.ret_norm_gain + l * 1024, p.gla_norm_gain + l * 1024};
      pg8::gemm_phase(lds, g, S, E, opaque_tid());
    } break;
    case 6: {
#pragma unroll 1
      for (int pass = 0; pass < 2; ++pass) {
        pg8::Gemm g{(const u16*)(p.ws + OFF_S) + 2048 + pass * 1024, (const u16*)(p.ws + OFF_WT) + (size_t)(WT_BRR + pass * 1024) * 1024, 4096, l == 0 ? MTOT : MLAT, 1024, 1024};
        pg8::StaticOrder S; S.init(g.M, g.N, nblk, bid);
        EpiMerge E{(const u16*)(p.ws + OFF_S), (u16*)(p.ws + OFF_U), pass};
        pg8::gemm_phase(lds, g, S, E, opaque_tid());
      }
    } break;
    case 7: {
      pg8::Gemm g{(const u16*)(p.ws + OFF_U), (const u16*)(p.ws + OFF_WT) + (size_t)WT_OUT * 1024, 1024, l == 0 ? MTOT : MLAT, 1024, 1024};
      pg8::StaticOrder S; S.init(g.M, g.N, nblk, bid);
      EpiOut E{l == 0 ? p.x : p.out, p.ctx, p.out, (float*)(p.ws + OFF_HCTX), (const float*)(p.ws + OFF_MOD) + (size_t)l * 9 * 3072};
      pg8::gemm_phase(lds, g, S, E, opaque_tid());
    } break;
  }
}

#define XB_TMO      128
#define XB_XCNT(j)  (256  + 64 * (j))
#define XB_XSUB(j)  (1280 + 64 * (j))
#define XB_XGEN(j)  (2304 + 64 * (j))
#define XB_TOP      3328
#define XB_TOPGEN   3392
#define XCD_BAR_WORDS 3456
#define XB_SPIN_CAP (1u << 18)
__device__ __forceinline__ unsigned xb_ld(unsigned* p)              { return __hip_atomic_load(p, __ATOMIC_RELAXED, __HIP_MEMORY_SCOPE_AGENT); }
__device__ __forceinline__ unsigned xb_add(unsigned* p, unsigned v) { return __hip_atomic_fetch_add(p, v, __ATOMIC_RELAXED, __HIP_MEMORY_SCOPE_AGENT); }
__device__ __forceinline__ unsigned xb_xcc_id() { return (unsigned)__builtin_amdgcn_s_getreg((3 << 11) | 20) & 0xFu; }
#define XB_SPIN(cond, bar) do { unsigned _sp = 0; while (cond) { __builtin_amdgcn_s_sleep(1); \
    if ((++_sp & 255u) == 0u) { if (xb_ld(&(bar)[XB_TMO])) break; if (_sp > XB_SPIN_CAP) { atomicAdd(&(bar)[XB_TMO], 1u); break; } } } } while (0)

__device__ __forceinline__ void xcd_barrier_complete(unsigned* bar, unsigned x, unsigned& nloc, unsigned& nx) {
  const unsigned G = gridDim.x * gridDim.y * gridDim.z;
  unsigned sum, cnt, mine, sp = 0u;
  for (;;) {
    sum = 0u; cnt = 0u; mine = 0u;
#pragma unroll
    for (unsigned j = 0; j < 16; ++j) { const unsigned c = xb_ld(&bar[XB_XCNT(j)]); sum += c; cnt += (c > 0u) ? 1u : 0u; mine = (j == x) ? c : mine; }
    if (sum == G) break;
    __builtin_amdgcn_s_sleep(1);
    if ((++sp & 255u) == 0u) { if (xb_ld(&bar[XB_TMO])) break; if (sp > XB_SPIN_CAP) { atomicAdd(&bar[XB_TMO], 1u); break; } }
  }
  nloc = mine > 0u ? mine : 1u; nx = cnt > 0u ? cnt : 1u;
}

__device__ __forceinline__ void xcd_barrier(unsigned* bar, volatile unsigned* st) {
  asm volatile("s_waitcnt vmcnt(0)" ::: "memory");
  __syncthreads();
  if (threadIdx.x == 0) {
    const unsigned x = xb_xcc_id();
    __builtin_amdgcn_s_waitcnt(0);
    unsigned nloc = st[0], nx = st[1];
    if (nloc == 0u) { xcd_barrier_complete(bar, x, nloc, nx); st[0] = nloc; st[1] = nx; }
    const unsigned old = xb_add(&bar[XB_XSUB(x)], 1u);
    const unsigned gen = old / nloc;
    if (old + 1u == (gen + 1u) * nloc) {
      __builtin_amdgcn_fence(__ATOMIC_RELEASE, "agent");
      asm volatile("s_waitcnt vmcnt(0)" ::: "memory");
      const unsigned og = xb_add(&bar[XB_TOP], 1u);
      const unsigned tg = og / nx;
      if (og + 1u == (tg + 1u) * nx) xb_add(&bar[XB_TOPGEN], 1u);
      else XB_SPIN(xb_ld(&bar[XB_TOPGEN]) == tg, bar);
      __builtin_amdgcn_fence(__ATOMIC_ACQUIRE, "agent");
      xb_add(&bar[XB_XGEN(x)], 1u);
      asm volatile("s_waitcnt vmcnt(0)" ::: "memory");
    } else {
      XB_SPIN(xb_ld(&bar[XB_XGEN(x)]) == gen, bar);
      __builtin_amdgcn_fence(__ATOMIC_ACQUIRE, "agent");
      asm volatile("s_waitcnt vmcnt(0)" ::: "memory");
    }
  }
  __syncthreads();
}

__global__ void __launch_bounds__(NTHREADS) mega(Params p, int ph_lo, int ph_hi, int coop) {
  extern __shared__ __attribute__((aligned(16))) char smem[];
  volatile unsigned* xst = (volatile unsigned*)(smem + XB_LDS_OFF);
  unsigned* xbar = (unsigned*)(p.ws + OFF_BAR);
  if (coop) {
    if (threadIdx.x == 0) { xst[0] = 0u; xst[1] = 0u; (void)xb_add(&xbar[XB_XCNT(xb_xcc_id())], 1u); }
    __syncthreads();
  }
  for (int ph = ph_lo; ph < ph_hi; ++ph) {
    run_phase(p, ph, smem);
    if (coop && ph + 1 < ph_hi) {
      if (ph == ph_lo) cg::this_grid().sync();
      else xcd_barrier(xbar, xst);
    }
  }
}

extern "C" void kernel_launch(void* const* d_in, const int* in_sizes, int n_in,
                              void* d_out, int out_size, void* d_ws, size_t ws_size,
                              hipStream_t stream) {
  Params p{};
  p.x = (const float*)d_in[0]; p.c = (const float*)d_in[1]; p.ctx = (const float*)d_in[2]; p.c_ctx = (const float*)d_in[3];
  p.norm_gain = (const float*)d_in[4]; p.w_ada = (const float*)d_in[5]; p.b_ada = (const float*)d_in[6]; p.w_in = (const float*)d_in[7];
  p.ret_decay = (const float*)d_in[8]; p.gla_w_up = (const float*)d_in[9]; p.gla_b_up = (const float*)d_in[10];
  p.ret_norm_gain = (const float*)d_in[11]; p.gla_norm_gain = (const float*)d_in[12];
  p.w_br_ret = (const float*)d_in[13]; p.w_br_gla = (const float*)d_in[14]; p.w_out = (const float*)d_in[15]; p.final_gain = (const float*)d_in[16];
  p.out = (float*)d_out; p.ws = (char*)d_ws;
  static int grid_blocks = 0;
  if (!grid_blocks) {
    hipFuncSetAttribute((const void*)mega, hipFuncAttributeMaxDynamicSharedMemorySize, LDS_BYTES);
    int dev = 0, cus = 0, per_cu = 0;
    hipGetDevice(&dev);
    hipDeviceGetAttribute(&cus, hipDeviceAttributeMultiprocessorCount, dev);
    hipOccupancyMaxActiveBlocksPerMultiprocessor(&per_cu, mega, NTHREADS, LDS_BYTES);
    if (per_cu < 1) per_cu = 1;
    grid_blocks = cus * 1;
  }
#ifdef MULTI_LAUNCH
  for (int ph = 0; ph < NPHASE; ++ph) {
    mega<<<dim3(grid_blocks), dim3(NTHREADS), LDS_BYTES, stream>>>(p, ph, ph + 1, 0);
  }
#else
  hipMemsetAsync((char*)d_ws + OFF_BAR, 0, 16384, stream);
  int lo = 0, hi = NPHASE, coop = 1;
  void* args[] = {&p, &lo, &hi, &coop};
  hipError_t e = hipLaunchCooperativeKernel((void*)mega, dim3(grid_blocks), dim3(NTHREADS), args, LDS_BYTES, stream);
  if (e != hipSuccess) fprintf(stderr, "cooperative launch failed: %s (grid %d)\n", hipGetErrorString(e), grid_blocks);
#endif
}
```

```cpp
#include <hip/hip_runtime.h>
#include <hip/hip_cooperative_groups.h>
#include <cstdio>
namespace cg = cooperative_groups;

typedef unsigned short u16;
using bf16x8 = __attribute__((ext_vector_type(8))) short;
using bf16x4 = __attribute__((ext_vector_type(4))) short;
using f32x4  = __attribute__((ext_vector_type(4))) float;

#define NTHREADS 512
#define DM 1024
#define NB 8
#define SEQL 4096
#define CTXL 256
#define MLAT 32768
#define MCTX 2048
#define MTOT 34816
#define INW 8208

#define OFF_S    0ull
#define OFF_RG   (OFF_S   + (size_t)MTOT * 4096 * 2)
#define OFF_U    (OFF_RG  + (size_t)MTOT * 2048 * 2)
#define OFF_WT   (OFF_U   + (size_t)MTOT * 1024 * 2)
#define WT_ROWS  11392
#define OFF_GLR  (OFF_WT  + (size_t)WT_ROWS * 1024 * 2)
#define OFF_HCTX (OFF_GLR + (size_t)MTOT * 16 * 4)
#define OFF_MOD  (OFF_HCTX+ (size_t)MCTX * 1024 * 4)
#define OFF_ROT  (OFF_MOD + (size_t)2 * 9 * 3072 * 4)
#define OFF_BAR  (OFF_ROT + (size_t)64 * 32 * 2 * 4)
#define OFF_END  (OFF_BAR + 16384)

#define WT_SCAN 0
#define WT_GATE 4224
#define WT_BRR  8320
#define WT_BRG  9344
#define WT_OUT  10368

#define XB_LDS_OFF 161792
#define LDS_BYTES 161808
#define SCAN_GB   80896

struct Params {
  const float* x; const float* c; const float* ctx; const float* c_ctx;
  const float* norm_gain; const float* w_ada; const float* b_ada; const float* w_in;
  const float* ret_decay; const float* gla_w_up; const float* gla_b_up;
  const float* ret_norm_gain; const float* gla_norm_gain;
  const float* w_br_ret; const float* w_br_gla; const float* w_out; const float* final_gain;
  float* out; char* ws;
};

__device__ __forceinline__ u16 f2bf(float f) {
  __bf16 h = (__bf16)f;
  return *(u16*)&h;
}
__device__ __forceinline__ float bf2f(u16 h) { return __uint_as_float(((unsigned)h) << 16); }
__device__ __forceinline__ float sigmoidf_(float x) { return __builtin_amdgcn_rcpf(1.f + __expf(-x)); }
__device__ __forceinline__ float siluf_(float x) { return x * __builtin_amdgcn_rcpf(1.f + __expf(-x)); }

__device__ __forceinline__ float4 ldnt4(const float* p) { f32x4 t = __builtin_nontemporal_load((const f32x4*)p); return make_float4(t[0], t[1], t[2], t[3]); }
__device__ __forceinline__ bf16x8 ldnt8(const u16* p) { return __builtin_nontemporal_load((const bf16x8*)p); }

__device__ __forceinline__ int opaque_tid() { int t = threadIdx.x; asm volatile("" : "+v"(t)); return t; }

__device__ __forceinline__ float wave_sum(float v, int lane) {
#pragma unroll
  for (int o = 32; o > 0; o >>= 1)
    v += __int_as_float(__builtin_amdgcn_ds_bpermute((lane ^ o) << 2, __float_as_int(v)));
  return v;
}

__device__ __forceinline__ const float* wt_src(const Params& p, int l, int n, int& ld) {
  if (n < WT_GATE) {
    int tile = n >> 7, cc = n & 127;
    int col;
    if (tile < 8) {
      int d = (cc & 64) | ((cc & 16) << 1) | ((cc & 32) >> 1) | (cc & 15);
      col = tile * 128 + d;
    } else if (tile < 16) col = 1024 + (tile - 8) * 128 + cc;
    else if (tile < 24) col = 3072 + (tile - 16) * 128 + cc;
    else if (tile < 32) col = 4096 + (tile - 24) * 128 + cc;
    else { if (cc >= 16) { ld = 0; return nullptr; } col = 6144 + cc; }
    ld = INW; return p.w_in + (size_t)l * DM * INW + col;
  } else if (n < WT_BRR) {
    int g = n - WT_GATE; int col;
    if (g < 1024) col = 2048 + g;
    else if (g < 2048) col = 5120 + (g - 1024);
    else if (g < 3072) col = 6160 + (g - 2048);
    else col = 7184 + (g - 3072);
    ld = INW; return p.w_in + (size_t)l * DM * INW + col;
  } else if (n < WT_BRG) { ld = DM; return p.w_br_ret + (size_t)l * DM * DM + (n - WT_BRR); }
  else if (n < WT_OUT)   { ld = DM; return p.w_br_gla + (size_t)l * DM * DM + (n - WT_BRG); }
  else                   { ld = DM; return p.w_out    + (size_t)l * DM * DM + (n - WT_OUT); }
}

#define WT_UNITS (178 * 4)
__device__ __forceinline__ void wt_unit(const Params& p, int l, int unit, char* smem) {
  float* tile = (float*)smem;
  int nb = unit >> 2, kg = unit & 3;
  int tid = opaque_tid();
  int n0 = nb * 64, kbase = kg * 256;
  float v[4][8];
  {
    int nl = tid & 63, kq = tid >> 6;
    int ld; const float* src = wt_src(p, l, n0 + nl, ld);
#pragma unroll
    for (int q = 0; q < 4; ++q)
#pragma unroll
      for (int i = 0; i < 8; ++i) v[q][i] = src ? __builtin_nontemporal_load(src + (size_t)(kbase + q * 64 + kq + 8 * i) * ld) : 0.f;
  }
  u16* wt = (u16*)(p.ws + OFF_WT);
#pragma unroll
  for (int q = 0; q < 4; ++q) {
    __syncthreads();
    {
      int nl = tid & 63, kq = tid >> 6;
#pragma unroll
      for (int i = 0; i < 8; ++i) tile[(kq + 8 * i) * 65 + nl] = v[q][i];
    }
    __syncthreads();
    {
      int nl = tid >> 3, kq = tid & 7;
      bf16x8 o;
#pragma unroll
      for (int j = 0; j < 8; ++j) o[j] = (short)f2bf(tile[(kq * 8 + j) * 65 + nl]);
      *(bf16x8*)(wt + (size_t)(n0 + nl) * 1024 + kbase + q * 64 + kq * 8) = o;
    }
  }
  __syncthreads();
}

__device__ __forceinline__ void mod_unit(const Params& p, int unit, char* smem) {
  float* sc = (float*)smem;
  float* red = sc + 9 * 1024;
  int l = unit / 48, jb = unit % 48;
  int tid = opaque_tid();
  for (int i = tid; i < 9 * 1024; i += NTHREADS) {
    int r = i >> 10, k = i & 1023;
    float v = (r < 8) ? p.c[r * 1024 + k] : p.c_ctx[k];
    sc[i] = siluf_(v);
  }
  __syncthreads();
  int jl = tid & 63, kg = tid >> 6;
  int j = jb * 64 + jl;
  float acc[9];
#pragma unroll
  for (int r = 0; r < 9; ++r) acc[r] = 0.f;
  const float* w = p.w_ada + (size_t)l * DM * 3072 + j;
#pragma unroll 16
  for (int k = kg * 128; k < kg * 128 + 128; ++k) {
    float wv = __builtin_nontemporal_load(w + (size_t)k * 3072);
#pragma unroll
    for (int r = 0; r < 9; ++r) acc[r] += sc[r * 1024 + k] * wv;
  }
#pragma unroll
  for (int r = 0; r < 9; ++r) red[(kg * 9 + r) * 64 + jl] = acc[r];
  __syncthreads();
  float* mod = (float*)(p.ws + OFF_MOD);
  for (int i = tid; i < 9 * 64; i += NTHREADS) {
    int r = i >> 6, jj = i & 63;
    float s = 0.f;
#pragma unroll
    for (int g = 0; g < 8; ++g) s += red[(g * 9 + r) * 64 + jj];
    mod[((size_t)l * 9 + r) * 3072 + jb * 64 + jj] = s + p.b_ada[l * 3072 + jb * 64 + jj];
  }
  __syncthreads();
}

__device__ __forceinline__ void rot_unit(const Params& p) {
  float* rot = (float*)(p.ws + OFF_ROT);
  for (int i = opaque_tid(); i < 64 * 32; i += NTHREADS) {
    int pos = i >> 5, f = i & 31;
    float inv = exp2f(-(float)f * (13.287712379549449f / 32.f));
    float ang = (float)pos * inv;
    rot[i * 2] = __cosf(ang);
    rot[i * 2 + 1] = __sinf(ang);
  }
}

__device__ __forceinline__ void phase_u(const Params& p, int l) {
  const int tid = opaque_tid(); int wave = tid >> 6, lane = tid & 63;
  const float* mod = (const float*)(p.ws + OFF_MOD) + (size_t)l * 9 * 3072;
  const float* gain = p.norm_gain + l * DM;
  u16* U = (u16*)(p.ws + OFF_U);
  for (int row = (blockIdx.x * 8 + wave) * 4; row < MTOT; row += gridDim.x * 32) {
    const float* h; int r;
    if (row < MLAT) { h = (l == 0 ? p.x : p.out) + (size_t)row * DM; r = row >> 12; }
    else { int cr = row - MLAT; h = (l == 0 ? p.ctx : (const float*)(p.ws + OFF_HCTX)) + (size_t)cr * DM; r = 8; }
    float4 v[4][4]; float ss[4];
#pragma unroll
    for (int q = 0; q < 4; ++q) {
      ss[q] = 0.f;
#pragma unroll
      for (int i = 0; i < 4; ++i) v[q][i] = ldnt4(h + q * DM + i * 256 + lane * 4);
    }
#pragma unroll
    for (int q = 0; q < 4; ++q) {
#pragma unroll
      for (int i = 0; i < 4; ++i) ss[q] += v[q][i].x * v[q][i].x + v[q][i].y * v[q][i].y + v[q][i].z * v[q][i].z + v[q][i].w * v[q][i].w;
      ss[q] = rsqrtf(wave_sum(ss[q], lane) * (1.f / 1024.f) + 1e-6f);
    }
    const float* sh = mod + r * 3072;
#pragma unroll
    for (int i = 0; i < 4; ++i) {
      int cidx = i * 256 + lane * 4;
      float4 g = *(const float4*)(gain + cidx);
      float4 s = *(const float4*)(sh + cidx);
      float4 sc = *(const float4*)(sh + 1024 + cidx);
      g.x *= (1.f + sc.x); g.y *= (1.f + sc.y); g.z *= (1.f + sc.z); g.w *= (1.f + sc.w);
#pragma unroll
      for (int q = 0; q < 4; ++q) {
        bf16x4 o;
        o[0] = (short)f2bf(v[q][i].x * ss[q] * g.x + s.x);
        o[1] = (short)f2bf(v[q][i].y * ss[q] * g.y + s.y);
        o[2] = (short)f2bf(v[q][i].z * ss[q] * g.z + s.z);
        o[3] = (short)f2bf(v[q][i].w * ss[q] * g.w + s.w);
        *(bf16x4*)(U + (size_t)(row + q) * DM + cidx) = o;
      }
    }
  }
}

__device__ __forceinline__ void phase_final(const Params& p) {
  const int tid = opaque_tid(); int wave = tid >> 6, lane = tid & 63;
  for (int row = (blockIdx.x * 8 + wave) * 4; row < MLAT; row += gridDim.x * 32) {
    float* h = p.out + (size_t)row * DM;
    float4 v[4][4]; float ss[4];
#pragma unroll
    for (int q = 0; q < 4; ++q) {
      ss[q] = 0.f;
#pragma unroll
      for (int i = 0; i < 4; ++i) v[q][i] = ldnt4(h + q * DM + i * 256 + lane * 4);
    }
#pragma unroll
    for (int q = 0; q < 4; ++q) {
#pragma unroll
      for (int i = 0; i < 4; ++i) ss[q] += v[q][i].x * v[q][i].x + v[q][i].y * v[q][i].y + v[q][i].z * v[q][i].z + v[q][i].w * v[q][i].w;
      ss[q] = rsqrtf(wave_sum(ss[q], lane) * (1.f / 1024.f) + 1e-6f);
    }
#pragma unroll
    for (int i = 0; i < 4; ++i) {
      int cidx = i * 256 + lane * 4;
      float4 g = *(const float4*)(p.final_gain + cidx);
#pragma unroll
      for (int q = 0; q < 4; ++q) {
        float4 o;
        o.x = v[q][i].x * ss[q] * g.x; o.y = v[q][i].y * ss[q] * g.y; o.z = v[q][i].z * ss[q] * g.z; o.w = v[q][i].w * ss[q] * g.w;
        *(float4*)(h + q * DM + cidx) = o;
      }
    }
  }
}

#define PG8_LAS __attribute__((address_space(3)))
typedef unsigned u32x4 __attribute__((ext_vector_type(4)));
namespace pg8 {
constexpr int BM = 256, BK = 64, HALF = 128, HTB = HALF * BK * 2, STAGE_BYTES = 8 * HTB, NXCD = 8, WGM = 8;
__device__ __forceinline__ int lds_byte(int r, int c) { const int st = (r >> 4) * 2 + (c >> 5), rr = r & 15, cc = c & 31, ob = rr * 64 + cc * 2; return st * 1024 + (ob ^ (((ob >> 9) & 1) << 5)); }
__device__ __forceinline__ void stage_rc(int b, int& R, int& C) { const int st = b / 1024, sb = b % 1024, swz = sb ^ (((sb >> 9) & 1) << 5); R = (st >> 1) * 16 + swz / 64; C = (st & 1) * 32 + (swz % 64) / 2; }
__device__ __forceinline__ int perm32(int rho) { const int n = rho >> 4, i = rho & 15; return 8 * (i >> 2) + 4 * n + (i & 3); }
struct Unit { int pm, pn; };
struct Gemm { const u16* A; const u16* Bt; int lda; int M, N, K; };
struct StaticOrder {
  int nM, nN, nwg, G, c;
  __device__ void init(int M, int N, int G_, int c_) { nM = M / BM; nN = N / BM; nwg = nM * nN; G = G_; c = c_; }
  __device__ bool next(int i, Unit& u) const {
    const long L = (long)i * G + c; if (L >= nwg) return false;
    int wgid = (int)L; { const int q = nwg / NXCD, r = nwg % NXCD, xcd = wgid % NXCD, off = wgid / NXCD; wgid = (xcd < r ? xcd * (q + 1) : r * (q + 1) + (xcd - r) * q) + off; }
    const int nig = WGM * nN, gid = wgid / nig, fm = gid * WGM, gsz = (nM - fm) < WGM ? (nM - fm) : WGM;
    u.pm = fm + ((wgid % nig) % gsz); u.pn = (wgid % nig) / gsz; return true;
  }
};
typedef __attribute__((ext_vector_type(2))) float cvt_f2_t;
typedef __attribute__((ext_vector_type(2))) __bf16 cvt_b2_t;
__device__ __forceinline__ unsigned cvt_pk_bf16(float lo, float hi) { cvt_f2_t f = {lo, hi}; cvt_b2_t r = __builtin_convertvector(f, cvt_b2_t); return __builtin_bit_cast(unsigned, r); }

template <class Epi>
__device__ __forceinline__ void gemm_phase(PG8_LAS unsigned char* lds, const Gemm g, const StaticOrder& S, const Epi& E, const int tid) {
  const int wid = __builtin_amdgcn_readfirstlane(tid >> 6), lane = tid & 63, wr = wid >> 2, wc = wid & 3, fr = lane & 15, fq = lane >> 4;
  const int K = g.K, nt = K / BK;
  unsigned voffA[2], voffB[2];
#pragma unroll
  for (int i = 0; i < 2; ++i) { int R, C; stage_rc(tid * 16 + i * 8192, R, C); const int Rb = Epi::PERM ? ((R & ~31) + perm32(R & 31)) : R;
    voffA[i] = (unsigned)(R * g.lda + C) * 2u; voffB[i] = (unsigned)(Rb * K + C) * 2u; }
  const size_t kstep = (size_t)(BK * 2);
  const size_t hstepA = (size_t)HALF * g.lda * 2, hstepB = (size_t)HALF * K * 2;
  const size_t tstepA = 2 * hstepA, tstepB = 2 * hstepB;
  const unsigned ldsw = (unsigned)wid * 1024u;
  const int aoff = lds_byte(wr * 64 + fr, fq * 8), boff = lds_byte(wc * 32 + fr, fq * 8);
#define PG8_SA(b, h) (((b) * 2 + (h)) * HTB)
#define PG8_SB(b, h) ((4 + (b) * 2 + (h)) * HTB)
#define PG8_STAGE(bufoff, gbase, voff) do { _Pragma("unroll") for (int _i = 0; _i < 2; ++_i) \
    __builtin_amdgcn_global_load_lds((const unsigned*)((const char*)(gbase) + (voff)[_i]), (PG8_LAS unsigned*)(lds + (bufoff) + ldsw + _i * 8192), 16, 0, 0); } while (0)
#define PG8_LDA(dst, b, h) do { _Pragma("unroll") for (int m = 0; m < 4; ++m) _Pragma("unroll") for (int k = 0; k < 2; ++k) dst[m][k] = *(const PG8_LAS bf16x8*)(lds + PG8_SA(b, h) + aoff + m * 2048 + k * 1024); } while (0)
#define PG8_LDB(dst, b, h) do { _Pragma("unroll") for (int n = 0; n < 2; ++n) _Pragma("unroll") for (int k = 0; k < 2; ++k) dst[n][k] = *(const PG8_LAS bf16x8*)(lds + PG8_SB(b, h) + boff + n * 2048 + k * 1024); } while (0)
#define PG8_MMA(ai, bj, At, Bt) do { __builtin_amdgcn_s_setprio(1); _Pragma("unroll") for (int m = 0; m < 4; ++m) _Pragma("unroll") for (int n = 0; n < 2; ++n) _Pragma("unroll") for (int k = 0; k < 2; ++k) \
    acc[ai][bj][m][n] = __builtin_amdgcn_mfma_f32_16x16x32_bf16(Bt[n][k], At[m][k], acc[ai][bj][m][n], 0, 0, 0); __builtin_amdgcn_s_setprio(0); } while (0)
#define PG8_WAIT_V(n) asm volatile("s_waitcnt vmcnt(" #n ")" ::: "memory")
#define PG8_WAIT_L(n) asm volatile("s_waitcnt lgkmcnt(" #n ")" ::: "memory")
#define PG8_BAR __builtin_amdgcn_s_barrier()
#define PG8_SCHED __builtin_amdgcn_sched_barrier(0)
  Unit cur, nxt; int ui = 0;
  if (!S.next(0, cur)) return;
  f32x4 acc[2][2][4][2];
#pragma unroll
  for (int a = 0; a < 2; ++a)
#pragma unroll
    for (int b = 0; b < 2; ++b)
#pragma unroll
      for (int m = 0; m < 4; ++m)
#pragma unroll
        for (int n = 0; n < 2; ++n) acc[a][b][m][n] = (f32x4){0.f, 0.f, 0.f, 0.f};
  bf16x8 At[4][2], B0[2][2], B1[2][2];
  const char* cA = (const char*)g.A + (size_t)cur.pm * tstepA; const char* cB = (const char*)g.Bt + (size_t)cur.pn * tstepB;
  PG8_STAGE(PG8_SB(0, 0), cB, voffB); PG8_STAGE(PG8_SA(0, 0), cA, voffA); PG8_STAGE(PG8_SB(0, 1), cB + hstepB, voffB); PG8_STAGE(PG8_SA(0, 1), cA + hstepA, voffA);
  if (wr == 1) PG8_BAR;
  PG8_WAIT_V(4); PG8_BAR;
  PG8_STAGE(PG8_SB(1, 0), cB + kstep, voffB); PG8_STAGE(PG8_SA(1, 0), cA + kstep, voffA); PG8_STAGE(PG8_SB(1, 1), cB + hstepB + kstep, voffB);
  PG8_WAIT_V(6); PG8_BAR;
  for (;;) {
    const bool has_next = S.next(ui + 1, nxt);
    const char* nA = has_next ? (const char*)g.A + (size_t)nxt.pm * tstepA : cA; const char* nB = has_next ? (const char*)g.Bt + (size_t)nxt.pn * tstepB : cB;
    for (int t = 0; t < nt; t += 2) {
      const bool last = (t == nt - 2);
      const char* a1 = cA + (size_t)(t + 1) * kstep;
      const char* a2 = last ? nA : cA + (size_t)(t + 2) * kstep; const char* b2 = last ? nB : cB + (size_t)(t + 2) * kstep;
      const char* a3 = a2 + kstep; const char* b3 = b2 + kstep;
      PG8_LDB(B0, 0, 0); PG8_SCHED; PG8_LDA(At, 0, 0); PG8_STAGE(PG8_SA(1, 1), a1 + hstepA, voffA);
      PG8_WAIT_L(8); PG8_BAR; PG8_WAIT_L(0); PG8_MMA(0, 0, At, B0); PG8_BAR; PG8_SCHED;
      PG8_LDB(B1, 0, 1); PG8_STAGE(PG8_SB(0, 0), b2, voffB);
      PG8_BAR; PG8_WAIT_L(0); PG8_MMA(0, 1, At, B1); PG8_BAR;
      PG8_LDA(At, 0, 1); PG8_STAGE(PG8_SA(0, 0), a2, voffA);
      PG8_BAR; PG8_WAIT_L(0); PG8_MMA(1, 0, At, B0); PG8_BAR; PG8_SCHED;
      PG8_STAGE(PG8_SB(0, 1), b2 + hstepB, voffB);
      PG8_WAIT_V(6); PG8_BAR; PG8_MMA(1, 1, At, B1); PG8_BAR;
      PG8_LDB(B0, 1, 0); PG8_SCHED; PG8_LDA(At, 1, 0); PG8_STAGE(PG8_SA(0, 1), a2 + hstepA, voffA);
      PG8_WAIT_L(8); PG8_BAR; PG8_WAIT_L(0); PG8_MMA(0, 0, At, B0); PG8_BAR; PG8_SCHED;
      PG8_LDB(B1, 1, 1); PG8_STAGE(PG8_SB(1, 0), b3, voffB);
      PG8_BAR; PG8_WAIT_L(0); PG8_MMA(0, 1, At, B1); PG8_BAR;
      PG8_LDA(At, 1, 1); PG8_STAGE(PG8_SA(1, 0), a3, voffA);
      PG8_BAR; PG8_WAIT_L(0); PG8_MMA(1, 0, At, B0); PG8_BAR; PG8_SCHED;
      PG8_STAGE(PG8_SB(1, 1), b3 + hstepB, voffB);
      PG8_WAIT_V(6); PG8_BAR; PG8_MMA(1, 1, At, B1); PG8_BAR;
    }
    E(acc, cur, wr, wc, fr, fq, lane);
    if (!has_next) break;
#pragma unroll
    for (int a = 0; a < 2; ++a)
#pragma unroll
      for (int b = 0; b < 2; ++b)
#pragma unroll
        for (int m = 0; m < 4; ++m)
#pragma unroll
          for (int n = 0; n < 2; ++n) acc[a][b][m][n] = (f32x4){0.f, 0.f, 0.f, 0.f};
    cur = nxt; cA = nA; cB = nB; ++ui;
  }
  PG8_WAIT_V(0);
  if (wr == 0) PG8_BAR;
  PG8_BAR;
#undef PG8_SA
#undef PG8_SB
#undef PG8_STAGE
#undef PG8_LDA
#undef PG8_LDB
#undef PG8_MMA
#undef PG8_WAIT_V
#undef PG8_WAIT_L
#undef PG8_BAR
#undef PG8_SCHED
}
}

#define OFF_STATS OFF_GLR

__device__ __forceinline__ u32x4 pack8v(const f32x4& a, const f32x4& b) {
  u32x4 w; w.x = pg8::cvt_pk_bf16(a[0], a[1]); w.y = pg8::cvt_pk_bf16(a[2], a[3]); w.z = pg8::cvt_pk_bf16(b[0], b[1]); w.w = pg8::cvt_pk_bf16(b[2], b[3]); return w;
}
__device__ __forceinline__ float xlane32(float v, int lane) { return __int_as_float(__builtin_amdgcn_ds_bpermute((lane ^ 32) << 2, __float_as_int(v))); }

struct EpiScanIn {
  static constexpr bool PERM = true;
  u16* S; const float* rot;
  __device__ __forceinline__ void operator()(const f32x4 (&acc)[2][2][4][2], const pg8::Unit& u, int wr, int wc, int fr, int fq, int lane) const {
    u16* Sb = S + (size_t)u.pm * 256 * 4096;
    unsigned rl0 = wr * 64 + fr; asm volatile("" : "+v"(rl0));
#pragma unroll
    for (int bj = 0; bj < 2; ++bj) {
      const int nt128 = u.pn * 2 + bj;
      const bool scaled = (nt128 < 4) || (nt128 >= 16 && nt128 < 20);
      const float scl = scaled ? 0.08838834764831845f : 1.f;
      const unsigned cb = nt128 * 128 + wc * 32 + fq * 8;
      if (nt128 < 8 && u.pm < 128) {
        const int tb = (u.pm & 15) * 256;
        const int fo = ((wc & 1) * 16 + (fq & 1) * 8) * 2;
        const float sgn = (fq >> 1) ? 1.f : -1.f;
#pragma unroll
        for (int ai = 0; ai < 2; ++ai) {
          float4 cs[4][4];
#pragma unroll
          for (int q = 0; q < 4; ++q) {
            const int t = tb + (int)(rl0 + ai * 128 + q * 16);
            const unsigned pos = (wc >> 1) == 0 ? (t >> 6) : (t & 63);
            const float* rp = rot + pos * 64u + fo;
            cs[q][0] = *(const float4*)rp; cs[q][1] = *(const float4*)(rp + 4); cs[q][2] = *(const float4*)(rp + 8); cs[q][3] = *(const float4*)(rp + 12);
          }
          __builtin_amdgcn_sched_barrier(0);
#pragma unroll
          for (int m = 0; m < 4; ++m) {
            const unsigned rl = rl0 + ai * 128 + m * 16;
            const float4 c0 = cs[m][0], c1 = cs[m][1], c2 = cs[m][2], c3 = cs[m][3];
            const f32x4 v0 = acc[ai][bj][m][0], v1 = acc[ai][bj][m][1];
            f32x4 p0, p1;
#pragma unroll
            for (int j = 0; j < 4; ++j) { p0[j] = xlane32(v0[j], lane); p1[j] = xlane32(v1[j], lane); }
            f32x4 o0, o1;
            o0[0] = (v0[0] * c0.x + sgn * p0[0] * c0.y) * scl; o0[1] = (v0[1] * c0.z + sgn * p0[1] * c0.w) * scl;
            o0[2] = (v0[2] * c1.x + sgn * p0[2] * c1.y) * scl; o0[3] = (v0[3] * c1.z + sgn * p0[3] * c1.w) * scl;
            o1[0] = (v1[0] * c2.x + sgn * p1[0] * c2.y) * scl; o1[1] = (v1[1] * c2.z + sgn * p1[1] * c2.w) * scl;
            o1[2] = (v1[2] * c3.x + sgn * p1[2] * c3.y) * scl; o1[3] = (v1[3] * c3.z + sgn * p1[3] * c3.w) * scl;
            *(u32x4*)(Sb + rl * 4096u + cb) = pack8v(o0, o1);
            __builtin_amdgcn_sched_barrier(0);
          }
        }
      } else {
#pragma unroll
        for (int ai = 0; ai < 2; ++ai)
#pragma unroll
          for (int m = 0; m < 4; ++m) {
            const unsigned rl = rl0 + ai * 128 + m * 16;
            *(u32x4*)(Sb + rl * 4096u + cb) = pack8v(acc[ai][bj][m][0] * scl, acc[ai][bj][m][1] * scl);
            __builtin_amdgcn_sched_barrier(0);
          }
      }
    }
  }
};

struct EpiGate {
  static constexpr bool PERM = true;
  const u16* RG; const float* stats; u16* S; const float* rgain; const float* ggain;
  __device__ __forceinline__ void operator()(const f32x4 (&acc)[2][2][4][2], const pg8::Unit& u, int wr, int wc, int fr, int fq, int lane) const {
    u16* Sb = S + (size_t)u.pm * 256 * 4096;
    unsigned rl0 = wr * 64 + fr; asm volatile("" : "+v"(rl0));
    if (u.pn < 8) {
      const int branch = u.pn >> 2, head = u.pn & 3;
      const u16* RGb = RG + (size_t)u.pm * 256 * 2048 + branch * 1024;
      const float* stb = stats + (size_t)u.pm * 256 * 16 + (branch * 4 + head) * 2;
      const float* gain = branch ? ggain : rgain;
#pragma unroll
      for (int bj = 0; bj < 2; ++bj) {
        const unsigned cb = head * 256 + bj * 128 + wc * 32 + fq * 8;
        const float4 g0 = *(const float4*)(gain + cb), g1 = *(const float4*)(gain + cb + 4);
#pragma unroll
        for (int ai = 0; ai < 2; ++ai) {
        float2 stv[4]; bf16x8 xrv[4];
#pragma unroll
        for (int q = 0; q < 4; ++q) {
          const unsigned rl = rl0 + ai * 128 + q * 16;
          stv[q] = *(const float2*)(stb + rl * 16u);
          xrv[q] = ldnt8(RGb + rl * 2048u + cb);
        }
        __builtin_amdgcn_sched_barrier(0);
#pragma unroll
          for (int m = 0; m < 4; ++m) {
            const unsigned rl = rl0 + ai * 128 + m * 16;
            const float2 st = stv[m];
            const bf16x8 xr = xrv[m];
            f32x4 v0 = acc[ai][bj][m][0], v1 = acc[ai][bj][m][1];
            asm volatile("" : "+v"(v0), "+v"(v1));
            f32x4 o0, o1;
            o0[0] = (bf2f((u16)xr[0]) * st.x + st.y) * g0.x * siluf_(v0[0]); o0[1] = (bf2f((u16)xr[1]) * st.x + st.y) * g0.y * siluf_(v0[1]);
            o0[2] = (bf2f((u16)xr[2]) * st.x + st.y) * g0.z * siluf_(v0[2]); o0[3] = (bf2f((u16)xr[3]) * st.x + st.y) * g0.w * siluf_(v0[3]);
            o1[0] = (bf2f((u16)xr[4]) * st.x + st.y) * g1.x * siluf_(v1[0]); o1[1] = (bf2f((u16)xr[5]) * st.x + st.y) * g1.y * siluf_(v1[1]);
            o1[2] = (bf2f((u16)xr[6]) * st.x + st.y) * g1.z * siluf_(v1[2]); o1[3] = (bf2f((u16)xr[7]) * st.x + st.y) * g1.w * siluf_(v1[3]);
            *(u32x4*)(Sb + rl * 4096u + 2048u + branch * 1024 + cb) = pack8v(o0, o1);
            __builtin_amdgcn_sched_barrier(0);
          }
        }
      }
    } else {
#pragma unroll
      for (int bj = 0; bj < 2; ++bj) {
        const unsigned cb = (u.pn - 8) * 256 + bj * 128 + wc * 32 + fq * 8;
#pragma unroll
        for (int ai = 0; ai < 2; ++ai)
#pragma unroll
          for (int m = 0; m < 4; ++m) {
            const unsigned rl = rl0 + ai * 128 + m * 16;
            f32x4 v0 = acc[ai][bj][m][0], v1 = acc[ai][bj][m][1];
            asm volatile("" : "+v"(v0), "+v"(v1));
            f32x4 o0, o1;
#pragma unroll
            for (int j = 0; j < 4; ++j) { o0[j] = sigmoidf_(v0[j]); o1[j] = sigmoidf_(v1[j]); }
            *(u32x4*)(Sb + rl * 4096u + cb) = pack8v(o0, o1);
            __builtin_amdgcn_sched_barrier(0);
          }
      }
    }
  }
};

struct EpiMerge {
  static constexpr bool PERM = true;
  const u16* S; u16* MG; int pass;
  __device__ __forceinline__ void operator()(const f32x4 (&acc)[2][2][4][2], const pg8::Unit& u, int wr, int wc, int fr, int fq, int lane) const {
    const u16* Sb = S + (size_t)u.pm * 256 * 4096 + pass * 1024;
    u16* MGb = MG + (size_t)u.pm * 256 * 1024;
    unsigned rl0 = wr * 64 + fr; asm volatile("" : "+v"(rl0));
#pragma unroll
    for (int bj = 0; bj < 2; ++bj) {
      const unsigned cb = u.pn * 256 + bj * 128 + wc * 32 + fq * 8;
#pragma unroll
      for (int ai = 0; ai < 2; ++ai) {
      bf16x8 gtv[4], oldv_[4];
#pragma unroll
      for (int q = 0; q < 4; ++q) {
        const unsigned rl = rl0 + ai * 128 + q * 16;
        gtv[q] = ldnt8(Sb + rl * 4096u + cb);
        if (pass) oldv_[q] = ldnt8(MGb + rl * 1024u + cb);
      }
      __builtin_amdgcn_sched_barrier(0);
#pragma unroll
        for (int m = 0; m < 4; ++m) {
          const unsigned rl = rl0 + ai * 128 + m * 16;
          const bf16x8 gt = gtv[m];
          f32x4 o0 = acc[ai][bj][m][0], o1 = acc[ai][bj][m][1];
#pragma unroll
          for (int j = 0; j < 4; ++j) { o0[j] *= bf2f((u16)gt[j]); o1[j] *= bf2f((u16)gt[4 + j]); }
          if (pass) {
            const bf16x8 old = oldv_[m];
#pragma unroll
            for (int j = 0; j < 4; ++j) { o0[j] += bf2f((u16)old[j]); o1[j] += bf2f((u16)old[4 + j]); }
          }
          *(u32x4*)(MGb + rl * 1024u + cb) = pack8v(o0, o1);
            __builtin_amdgcn_sched_barrier(0);
        }
      }
    }
  }
};

struct EpiOut {
  static constexpr bool PERM = false;
  const float* x_lat; const float* x_ctx; float* o_lat; float* o_ctx; const float* mod;
  __device__ __forceinline__ void operator()(const f32x4 (&acc)[2][2][4][2], const pg8::Unit& u, int wr, int wc, int fr, int fq, int lane) const {
    const float* hin; float* hout; int rmod;
    if (u.pm < 128) { hin = x_lat + (size_t)u.pm * 256 * DM; hout = o_lat + (size_t)u.pm * 256 * DM; rmod = u.pm >> 4; }
    else { hin = x_ctx + (size_t)(u.pm - 128) * 256 * DM; hout = o_ctx + (size_t)(u.pm - 128) * 256 * DM; rmod = 8; }
    const float* gate = mod + rmod * 3072 + 2048;
    unsigned rl0 = wr * 64 + fr; asm volatile("" : "+v"(rl0));
#pragma unroll
    for (int bj = 0; bj < 2; ++bj)
#pragma unroll
      for (int n = 0; n < 2; ++n) {
        const unsigned cb = u.pn * 256 + bj * 128 + wc * 32 + n * 16 + fq * 4;
        const float4 g = *(const float4*)(gate + cb);
        float4 hv[8];
#pragma unroll
        for (int q = 0; q < 8; ++q) hv[q] = ldnt4(hin + (rl0 + (q >> 2) * 128 + (q & 3) * 16) * 1024u + cb);
        __builtin_amdgcn_sched_barrier(0);
#pragma unroll
        for (int ai = 0; ai < 2; ++ai)
#pragma unroll
          for (int m = 0; m < 4; ++m) {
            const unsigned o = (rl0 + ai * 128 + m * 16) * 1024u + cb;
            const float4 h = hv[ai * 4 + m];
            const f32x4 v = acc[ai][bj][m][n];
            *(float4*)(hout + o) = make_float4(h.x + g.x * v[0], h.y + g.y * v[1], h.z + g.z * v[2], h.w + g.w * v[3]);
          }
      }
  }
};

__device__ __forceinline__ void phase_stats(const Params& p, int l) {
  const int tid = opaque_tid(); const int wave = tid >> 6, lane = tid & 63;
  const u16* RG = (const u16*)(p.ws + OFF_RG);
  float* ST = (float*)(p.ws + OFF_STATS);
  const int nrows = (l == 0) ? MTOT : MLAT;
  for (int row = (blockIdx.x * 8 + wave) * 4; row < nrows; row += gridDim.x * 32) {
    bf16x8 v[4][4];
#pragma unroll
    for (int q = 0; q < 4; ++q)
#pragma unroll
      for (int i = 0; i < 4; ++i) v[q][i] = ldnt8(RG + (size_t)(row + q) * 2048 + i * 512 + lane * 8);
#pragma unroll
    for (int q = 0; q < 4; ++q)
#pragma unroll
      for (int i = 0; i < 4; ++i) {
        float s1 = 0.f, s2 = 0.f;
#pragma unroll
        for (int x = 0; x < 8; ++x) { float a = bf2f((u16)v[q][i][x]); s1 += a; s2 += a * a; }
#pragma unroll
        for (int o = 16; o > 0; o >>= 1) {
          s1 += __int_as_float(__builtin_amdgcn_ds_bpermute((lane ^ o) << 2, __float_as_int(s1)));
          s2 += __int_as_float(__builtin_amdgcn_ds_bpermute((lane ^ o) << 2, __float_as_int(s2)));
        }
        float sa, sb;
        if ((i >> 1) == 0) { float mu = s1 * (1.f / 256.f); float var = fmaxf(s2 * (1.f / 256.f) - mu * mu, 0.f); sa = rsqrtf(var + 1e-6f); sb = -mu * sa; }
        else { sa = rsqrtf(s2 * (1.f / 256.f) + 1e-6f); sb = 0.f; }
        if ((lane & 31) == 0) *(float2*)(ST + ((size_t)(row + q) * 8 + (i >> 1) * 4 + 2 * (i & 1) + (lane >> 5)) * 2) = make_float2(sa, sb);
      }
  }
}

#define OFF_VECS OFF_WT
__device__ __forceinline__ float logsig16(float x) { return (fminf(x, 0.f) - __logf(1.f + __expf(-fabsf(x)))) * (1.f / 16.f); }

typedef __attribute__((ext_vector_type(2))) float f32x2_t;

template <int SW>
__device__ __forceinline__ void prepass_sweep4(const float* GLRS, const f32x2_t (&w2)[4][16], const f32x2_t (&b2)[4], u16* Sq, u16* Ub,
                                               float (&accF)[4], float (&accB)[4]) {
#pragma unroll
  for (int c = 0; c < 4; ++c) { accF[c] = 0.f; accB[c] = 0.f; }
#pragma unroll 4
  for (int u = 0; u < 32; ++u) {
    const int i = SW ? 32 + u : 31 - u;
    const bf16x4 q4 = __builtin_nontemporal_load((const bf16x4*)(Sq + (unsigned)i * 4096u));
    const bf16x4 k4 = __builtin_nontemporal_load((const bf16x4*)(Sq + (unsigned)i * 4096u + 512u));
    const float4* gr = (const float4*)(GLRS + (i & 31) * 16);
    const float4 g0 = gr[0], g1 = gr[1], g2 = gr[2], g3 = gr[3];
    bf16x4 oqf, okf, oqb, okb;
#pragma unroll
    for (int c = 0; c < 4; ++c) {
      f32x2_t x = b2[c];
      x = w2[c][0] * g0.x + x;  x = w2[c][1] * g0.y + x;  x = w2[c][2] * g0.z + x;  x = w2[c][3] * g0.w + x;
      x = w2[c][4] * g1.x + x;  x = w2[c][5] * g1.y + x;  x = w2[c][6] * g1.z + x;  x = w2[c][7] * g1.w + x;
      x = w2[c][8] * g2.x + x;  x = w2[c][9] * g2.y + x;  x = w2[c][10] * g2.z + x; x = w2[c][11] * g2.w + x;
      x = w2[c][12] * g3.x + x; x = w2[c][13] * g3.y + x; x = w2[c][14] * g3.z + x; x = w2[c][15] * g3.w + x;
      const float laf = logsig16(x.x), lab = logsig16(x.y);
      float relf, relb;
      if (SW == 0) { relf = -accF[c]; accF[c] += laf; accB[c] += lab; relb = accB[c]; }
      else         { accF[c] += laf; relf = accF[c]; relb = -accB[c]; accB[c] += lab; }
      const float q = bf2f((u16)q4[c]), k = bf2f((u16)k4[c]);
      oqf[c] = (short)f2bf(q * __expf(relf)); okf[c] = (short)f2bf(k * __expf(-relf));
      oqb[c] = (short)f2bf(q * __expf(relb)); okb[c] = (short)f2bf(k * __expf(-relb));
    }
    *(bf16x4*)(Sq + (unsigned)i * 4096u) = oqf;
    *(bf16x4*)(Sq + (unsigned)i * 4096u + 512u) = okf;
    *(bf16x4*)(Ub + (unsigned)i * 1024u) = oqb;
    *(bf16x4*)(Ub + (unsigned)i * 1024u + 512u) = okb;
  }
}

__device__ __forceinline__ void gla_prepass_unit(const Params& p, int l, int bunit, char* smem) {
  const int tid = opaque_tid();
  const int ul = __builtin_amdgcn_readfirstlane(tid >> 7);
  const int gu = bunit * 4 + ul;
  const int sw = gu & 1, ch = gu >> 1;
  const int b = ch / 68, cid = ch % 68;
  const int base = cid < 4 ? (MLAT + b * 256 + cid * 64) : (b * 4096 + (cid - 4) * 64);
  float* GLRS = (float*)smem + ul * 512;
  const int col0 = (tid & 127) * 4;
  __syncthreads();
  {
    const int uw = (tid >> 6) & 1, lane = tid & 63, fr = lane & 15, fq = lane >> 4;
    f32x4 g = (f32x4){0.f, 0.f, 0.f, 0.f};
    const u16* Ua = (const u16*)(p.ws + OFF_U) + (size_t)(base + sw * 32 + uw * 16 + fr) * 1024 + fq * 8;
    const u16* Wb = (const u16*)(p.ws + OFF_WT) + (size_t)(4096 + fr) * 1024 + fq * 8;
#pragma unroll 16
    for (int k = 0; k < 1024; k += 32) {
      bf16x8 a = *(const bf16x8*)(Ua + k);
      bf16x8 w = *(const bf16x8*)(Wb + k);
      g = __builtin_amdgcn_mfma_f32_16x16x32_bf16(a, w, g, 0, 0, 0);
    }
#pragma unroll
    for (int j = 0; j < 4; ++j) GLRS[(uw * 16 + fq * 4 + j) * 16 + fr] = g[j];
  }
  f32x2_t w2[4][16], b2[4];
  {
    const float* w0 = p.gla_w_up + (size_t)(l * 2 + 0) * 16 * 512 + col0;
    const float* w1 = p.gla_w_up + (size_t)(l * 2 + 1) * 16 * 512 + col0;
#pragma unroll
    for (int r = 0; r < 16; ++r) {
      const float4 a = *(const float4*)(w0 + r * 512), c = *(const float4*)(w1 + r * 512);
      w2[0][r].x = a.x; w2[1][r].x = a.y; w2[2][r].x = a.z; w2[3][r].x = a.w;
      w2[0][r].y = c.x; w2[1][r].y = c.y; w2[2][r].y = c.z; w2[3][r].y = c.w;
    }
    const float4 a = *(const float4*)(p.gla_b_up + (l * 2 + 0) * 512 + col0), c = *(const float4*)(p.gla_b_up + (l * 2 + 1) * 512 + col0);
    b2[0].x = a.x; b2[1].x = a.y; b2[2].x = a.z; b2[3].x = a.w;
    b2[0].y = c.x; b2[1].y = c.y; b2[2].y = c.z; b2[3].y = c.w;
  }
  __syncthreads();
  u16* Sq = (u16*)(p.ws + OFF_S) + (size_t)base * 4096 + 2048 + col0;
  u16* Ub = (l == 0 ? (u16*)p.out : (u16*)(p.ws + OFF_U)) + (size_t)base * 1024 + col0;
  float* V0 = (float*)(p.ws + OFF_VECS) + ((size_t)(0 * 544 + b * 68 + cid) * 2) * 512 + col0;
  float* V1 = (float*)(p.ws + OFF_VECS) + ((size_t)(1 * 544 + b * 68 + cid) * 2) * 512 + col0;
  float accF[4], accB[4];
  if (sw == 0) {
    prepass_sweep4<0>(GLRS, w2, b2, Sq, Ub, accF, accB);
    *(float4*)(V0) = make_float4(__expf(accF[0]), __expf(accF[1]), __expf(accF[2]), __expf(accF[3]));
    *(float4*)(V1 + 512) = make_float4(__expf(accB[0]), __expf(accB[1]), __expf(accB[2]), __expf(accB[3]));
  } else {
    prepass_sweep4<1>(GLRS, w2, b2, Sq, Ub, accF, accB);
    *(float4*)(V0 + 512) = make_float4(__expf(accF[0]), __expf(accF[1]), __expf(accF[2]), __expf(accF[3]));
    *(float4*)(V1) = make_float4(__expf(accB[0]), __expf(accB[1]), __expf(accB[2]), __expf(accB[3]));
  }
}

template <int SW>
__device__ __forceinline__ void prepass_sweep(const float* GLRS, const f32x2_t (&w2)[16], f32x2_t b2, u16* Sq, u16* Ub, float& accF, float& accB) {
  accF = 0.f; accB = 0.f;
#pragma unroll 16
  for (int u = 0; u < 32; ++u) {
    const int i = SW ? 32 + u : 31 - u;
    const float4* gr = (const float4*)(GLRS + i * 16);
    const float4 g0 = gr[0], g1 = gr[1], g2 = gr[2], g3 = gr[3];
    f32x2_t x = b2;
    x = w2[0] * g0.x + x;  x = w2[1] * g0.y + x;  x = w2[2] * g0.z + x;  x = w2[3] * g0.w + x;
    x = w2[4] * g1.x + x;  x = w2[5] * g1.y + x;  x = w2[6] * g1.z + x;  x = w2[7] * g1.w + x;
    x = w2[8] * g2.x + x;  x = w2[9] * g2.y + x;  x = w2[10] * g2.z + x; x = w2[11] * g2.w + x;
    x = w2[12] * g3.x + x; x = w2[13] * g3.y + x; x = w2[14] * g3.z + x; x = w2[15] * g3.w + x;
    const float laf = logsig16(x.x), lab = logsig16(x.y);
    float relf, relb;
    if (SW == 0) { relf = -accF; accF += laf; accB += lab; relb = accB; }
    else         { accF += laf; relf = accF; relb = -accB; accB += lab; }
    const float q = bf2f(Sq[(unsigned)i * 4096u]), k = bf2f(Sq[(unsigned)i * 4096u + 512u]);
    Sq[(unsigned)i * 4096u] = f2bf(q * __expf(relf));
    Sq[(unsigned)i * 4096u + 512u] = f2bf(k * __expf(-relf));
    Ub[(unsigned)i * 1024u] = f2bf(q * __expf(relb));
    Ub[(unsigned)i * 1024u + 512u] = f2bf(k * __expf(-relb));
  }
}

__device__ __forceinline__ void gla_prepass_unit1(const Params& p, int l, int unit, char* smem) {
  const int tid = opaque_tid();
  const int sw = unit & 1, ch = unit >> 1;
  const int b = ch / 68, cid = ch % 68;
  const int base = cid < 4 ? (MLAT + b * 256 + cid * 64) : (b * 4096 + (cid - 4) * 64);
  float* GLRS = (float*)smem;
  __syncthreads();
  {
    const int wid = tid >> 6, lane = tid & 63, fr = lane & 15, fq = lane >> 4;
    if (wid < 2) {
      const int r0 = sw * 32 + wid * 16;
      f32x4 g = (f32x4){0.f, 0.f, 0.f, 0.f};
      const u16* Ua = (const u16*)(p.ws + OFF_U) + (size_t)(base + r0 + fr) * 1024 + fq * 8;
      const u16* Wb = (const u16*)(p.ws + OFF_WT) + (size_t)(4096 + fr) * 1024 + fq * 8;
#pragma unroll 16
      for (int k = 0; k < 1024; k += 32) {
        bf16x8 a = *(const bf16x8*)(Ua + k);
        bf16x8 w = *(const bf16x8*)(Wb + k);
        g = __builtin_amdgcn_mfma_f32_16x16x32_bf16(a, w, g, 0, 0, 0);
      }
#pragma unroll
      for (int j = 0; j < 4; ++j) GLRS[(r0 + fq * 4 + j) * 16 + fr] = g[j];
    }
  }
  f32x2_t w2[16];
  {
    const float* w0 = p.gla_w_up + (size_t)(l * 2 + 0) * 16 * 512 + tid;
    const float* w1 = p.gla_w_up + (size_t)(l * 2 + 1) * 16 * 512 + tid;
#pragma unroll
    for (int r = 0; r < 16; ++r) { w2[r].x = w0[r * 512]; w2[r].y = w1[r * 512]; }
  }
  f32x2_t b2; b2.x = p.gla_b_up[(l * 2 + 0) * 512 + tid]; b2.y = p.gla_b_up[(l * 2 + 1) * 512 + tid];
  __syncthreads();
  u16* Sq = (u16*)(p.ws + OFF_S) + (size_t)base * 4096 + 2048 + tid;
  u16* Ub = (l == 0 ? (u16*)p.out : (u16*)(p.ws + OFF_U)) + (size_t)base * 1024 + tid;
  float* V0 = (float*)(p.ws + OFF_VECS) + ((size_t)(0 * 544 + b * 68 + cid) * 2) * 512 + tid;
  float* V1 = (float*)(p.ws + OFF_VECS) + ((size_t)(1 * 544 + b * 68 + cid) * 2) * 512 + tid;
  float accF, accB;
  if (sw == 0) {
    prepass_sweep<0>(GLRS, w2, b2, Sq, Ub, accF, accB);
    V0[0] = __expf(accF);
    V1[512] = __expf(accB);
  } else {
    prepass_sweep<1>(GLRS, w2, b2, Sq, Ub, accF, accB);
    V0[512] = __expf(accF);
    V1[0] = __expf(accB);
  }
}

#define L_QR   0
#define L_KR   17408
#define L_V    34816
#define L_SGT  44032
#define L_P    61440
#undef  SCAN_GB
#define SCAN_GB 70656

__device__ __forceinline__ int off128(int row, int col) { return row * 272 + col * 2; }
__device__ __forceinline__ int off64(int row, int col) { return row * 144 + col * 2; }

template <int RS>
__device__ __forceinline__ bf16x8 tr_frag(unsigned img_addr, int r0, int c0, int lane) {
  const int g = lane >> 4, q = (lane & 15) >> 2, pp = lane & 3;
  unsigned a = img_addr + (unsigned)((r0 + 8 * g + q) * RS + (c0 + 4 * pp) * 2);
  bf16x4 lo, hi;
  asm volatile("ds_read_b64_tr_b16 %0, %2\n\tds_read_b64_tr_b16 %1, %2 offset:%3\n\ts_waitcnt lgkmcnt(0)"
               : "=&v"(lo), "=&v"(hi) : "v"(a), "n"(4 * RS) : "memory");
  bf16x8 r;
  r[0] = lo[0]; r[1] = lo[1]; r[2] = lo[2]; r[3] = lo[3]; r[4] = hi[0]; r[5] = hi[1]; r[6] = hi[2]; r[7] = hi[3];
  return r;
}

typedef short trs4_t __attribute__((ext_vector_type(4)));
__device__ __forceinline__ bf16x8 tr_pair(const char* p, int hi_off) {
  trs4_t lo = __builtin_amdgcn_ds_read_tr16_b64_v4i16((__attribute__((address_space(3))) trs4_t*)p);
  trs4_t hi = __builtin_amdgcn_ds_read_tr16_b64_v4i16((__attribute__((address_space(3))) trs4_t*)(p + hi_off));
  return __builtin_shufflevector(lo, hi, 0, 1, 2, 3, 4, 5, 6, 7);
}

__device__ __forceinline__ bf16x8 scale8(bf16x8 v, float f) {
  bf16x8 o;
#pragma unroll
  for (int x = 0; x < 8; ++x) o[x] = (short)f2bf(bf2f((u16)v[x]) * f);
  return o;
}

__device__ __forceinline__ void lds_barrier() { asm volatile("s_waitcnt lgkmcnt(0)" ::: "memory"); __builtin_amdgcn_s_barrier(); asm volatile("" ::: "memory"); }

template <int branch>
__device__ __forceinline__ void scan_item(const Params& p, int l, int item, char* smem) {
  const int b = (item >> 4) & 7, h = (item >> 2) & 3, slice = item & 3;
  const int tid = opaque_tid(), wid = __builtin_amdgcn_readfirstlane(tid >> 6), lane = tid & 63;
  const int dir = wid >> 2, gw = wid & 3, gt = tid & 255;
  const int fr = lane & 15, fq = lane >> 4;
  char* G = smem + dir * SCAN_GB;
  const unsigned Ga = (unsigned)(size_t)G;
  const u16* S = (const u16*)(p.ws + OFF_S);
  u16* RG = (u16*)(p.ws + OFF_RG);
  const u16* qsrc; unsigned qstride;
  if (branch == 0) { qsrc = S + h * 128; qstride = 4096; }
  else if (dir == 0) { qsrc = S + 2048 + h * 128; qstride = 4096; }
  else { qsrc = (l == 0 ? (const u16*)p.out : (const u16*)(p.ws + OFF_U)) + h * 128; qstride = 1024; }
  const int voff = branch * 2048 + 1024 + h * 256 + slice * 64;
  const int ooff = branch * 1024 + h * 256 + slice * 64;
  float lg = 0.f, egc = 1.f;
  if (branch == 0) { lg = __logf(1.f - __expf(p.ret_decay[(l * 2 + dir) * 4 + h])); egc = __expf(32.f * lg); }
  const float* VECS = (const float*)(p.ws + OFF_VECS) + ((size_t)(dir * 544 + b * 68) * 2) * 512 + h * 128;
  f32x4 st[2][4];
#pragma unroll
  for (int m = 0; m < 2; ++m)
#pragma unroll
    for (int n = 0; n < 4; ++n) st[m][n] = (f32x4){0.f, 0.f, 0.f, 0.f};

  const int qj = gt >> 4, qc = gt & 15;
  const int vj = gt >> 3, vc = gt & 7;
  bf16x8 pq[4], pk[4], pv[2];
  float4 peg[2], pel[2];
  auto prefetch = [&](int s) {
    int base, cid;
    if (s < 4) { int cc = dir ? 3 - s : s; base = MLAT + b * 256 + cc * 64; cid = cc; }
    else { int c = s - 4; int cc = dir ? 63 - c : c; base = b * 4096 + cc * 64; cid = 4 + cc; }
#pragma unroll
    for (int i = 0; i < 4; ++i) {
      int jp = qj + 16 * i;
      const u16* qb_ = qsrc + (size_t)base * qstride;
      unsigned ro = (unsigned)(dir ? 63 - jp : jp) * qstride + qc * 8;
      pq[i] = *(const bf16x8*)(qb_ + ro);
      pk[i] = *(const bf16x8*)(qb_ + ro + 512);
    }
#pragma unroll
    for (int i = 0; i < 2; ++i) {
      int jp = vj + 32 * i;
      pv[i] = ldnt8((S + (size_t)base * 4096 + voff) + ((unsigned)(dir ? 63 - jp : jp) * 4096u + vc * 8));
    }
    (void)cid;
  };
  auto chunk_id = [&](int s) { int cid; if (s < 4) { cid = dir ? 3 - s : s; } else { int c = s - 4; cid = 4 + (dir ? 63 - c : c); } return cid; };
  auto prefetch_eg = [&](int s) {
    if (branch == 1) {
      const int cid = chunk_id(s);
#pragma unroll
      for (int m = 0; m < 2; ++m) peg[m] = *(const float4*)(VECS + (size_t)cid * 1024 + gw * 32 + m * 16 + fq * 4);
    } else {
#pragma unroll
      for (int m = 0; m < 2; ++m) peg[m] = make_float4(egc, egc, egc, egc);
    }
  };
  auto prefetch_el = [&](int s) {
    if (branch == 1) {
      const int cid = chunk_id(s);
#pragma unroll
      for (int m = 0; m < 2; ++m) pel[m] = *(const float4*)(VECS + (size_t)cid * 1024 + 512 + gw * 32 + m * 16 + fq * 4);
    } else {
#pragma unroll
      for (int m = 0; m < 2; ++m) pel[m] = make_float4(egc, egc, egc, egc);
    }
  };
  prefetch(0);
  prefetch_eg(0);
  prefetch_el(0);
  __syncthreads();

  for (int s = 0; s < 68; ++s) {
    int base; bool first; bool wout;
    if (s < 4) { int cc = dir ? 3 - s : s; base = MLAT + b * 256 + cc * 64; first = s < 2; wout = (l == 0); }
    else { int c = s - 4; int cc = dir ? 63 - c : c; base = b * 4096 + cc * 64; first = c < 32; wout = true; }
    float4 (&eg)[2] = peg; float4 (&el)[2] = pel;
    float4 egel[2];
#pragma unroll
    for (int i = 0; i < 4; ++i) {
      int jp = qj + 16 * i;
      bf16x8 qv = pq[i], kv_ = pk[i];
      if (branch == 0) {
        float fqs = __expf((float)(jp - 31) * lg), fks = __expf((float)(31 - jp) * lg);
        qv = scale8(qv, fqs); kv_ = scale8(kv_, fks);
      }
      *(bf16x8*)(G + L_QR + off128(jp, qc * 8)) = qv;
      *(bf16x8*)(G + L_KR + off128(jp, qc * 8)) = kv_;
    }
#pragma unroll
    for (int i = 0; i < 2; ++i) *(bf16x8*)(G + L_V + off64(vj + 32 * i, vc * 8)) = pv[i];
#pragma unroll
    for (int m = 0; m < 2; ++m) {
      int d0 = gw * 32 + m * 16 + fq * 4;
#pragma unroll
      for (int n = 0; n < 4; ++n) {
        int e = n * 16 + fr;
        bf16x4 o4;
        o4[0] = (short)f2bf(st[m][n][0] * eg[m].x); o4[1] = (short)f2bf(st[m][n][1] * eg[m].y);
        o4[2] = (short)f2bf(st[m][n][2] * eg[m].z); o4[3] = (short)f2bf(st[m][n][3] * eg[m].w);
        *(bf16x4*)(G + L_SGT + off128(e, d0)) = o4;
      }
    }
#pragma unroll
    for (int m = 0; m < 2; ++m) egel[m] = make_float4(eg[m].x * el[m].x, eg[m].y * el[m].y, eg[m].z * el[m].z, eg[m].w * el[m].w);
    if (branch == 1 && s + 1 < 68) prefetch_eg(s + 1);
    u16 oldv[4][4];
    u16* dstb = RG + (size_t)base * 2048 + ooff;
    if (wout && !first) {
#pragma unroll
      for (int r = 0; r < 4; ++r) {
        int ip = gw * 16 + fq * 4 + r;
        unsigned ro = (unsigned)(dir ? 63 - ip : ip) * 2048u + fr;
#pragma unroll
        for (int n = 0; n < 4; ++n) oldv[r][n] = dstb[ro + n * 16];
      }
    }
    if (s + 1 < 68) prefetch(s + 1);
    lds_barrier();
    f32x4 pt[4], o[4];
#pragma unroll
    for (int n = 0; n < 4; ++n) { pt[n] = (f32x4){0.f, 0.f, 0.f, 0.f}; o[n] = (f32x4){0.f, 0.f, 0.f, 0.f}; }
#pragma unroll
    for (int ks = 0; ks < 4; ++ks) {
      int kc = ks * 32 + fq * 8;
      bf16x8 qa = *(const bf16x8*)(G + L_QR + off128(gw * 16 + fr, kc));
#pragma unroll
      for (int n = 0; n < 4; ++n) {
        bf16x8 ka = *(const bf16x8*)(G + L_KR + off128(n * 16 + fr, kc));
        bf16x8 sb = *(const bf16x8*)(G + L_SGT + off128(n * 16 + fr, kc));
        pt[n] = __builtin_amdgcn_mfma_f32_16x16x32_bf16(ka, qa, pt[n], 0, 0, 0);
        o[n] = __builtin_amdgcn_mfma_f32_16x16x32_bf16(qa, sb, o[n], 0, 0, 0);
      }
    }
    {
      const int ip = gw * 16 + fr;
#pragma unroll
      for (int n = 0; n < 4; ++n) {
        const int j0 = n * 16 + fq * 4;
        bf16x4 w;
#pragma unroll
        for (int r = 0; r < 4; ++r) {
          int jp = j0 + r;
          bool keep = dir ? (ip > jp) : (ip >= jp);
          w[r] = (short)f2bf(keep ? pt[n][r] : 0.f);
        }
        *(bf16x4*)(G + L_P + off64(ip, j0)) = w;
      }
    }
    asm volatile("s_waitcnt lgkmcnt(0)" ::: "memory");
    {
      const int tg = lane >> 4, tq = (lane & 15) >> 2, tp = lane & 3;
#pragma unroll
      for (int m = 0; m < 2; ++m) {
        f32x4 kv[4];
#pragma unroll
        for (int n = 0; n < 4; ++n) kv[n] = (f32x4){0.f, 0.f, 0.f, 0.f};
#pragma unroll
        for (int ks = 0; ks < 2; ++ks) {
          int kc = ks * 32 + fq * 8;
          const char* kp = G + L_KR + (8 * tg + tq) * 272 + (gw * 32 + 4 * tp) * 2 + ks * 32 * 272 + m * 32;
          const char* vp = G + L_V + (8 * tg + tq) * 144 + (4 * tp) * 2 + ks * 32 * 144;
          const bf16x8 km = tr_pair(kp, 4 * 272);
          bf16x8 vb[4];
#pragma unroll
          for (int n = 0; n < 4; ++n) vb[n] = tr_pair(vp + n * 32, 4 * 144);
          bf16x8 pa;
          if (m == 0) pa = *(const bf16x8*)(G + L_P + off64(gw * 16 + fr, kc));
#pragma unroll
          for (int n = 0; n < 4; ++n) {
            if (m == 0) o[n] = __builtin_amdgcn_mfma_f32_16x16x32_bf16(pa, vb[n], o[n], 0, 0, 0);
            kv[n] = __builtin_amdgcn_mfma_f32_16x16x32_bf16(km, vb[n], kv[n], 0, 0, 0);
          }
        }
#pragma unroll
        for (int n = 0; n < 4; ++n) {
          st[m][n][0] = egel[m].x * st[m][n][0] + el[m].x * kv[n][0];
          st[m][n][1] = egel[m].y * st[m][n][1] + el[m].y * kv[n][1];
          st[m][n][2] = egel[m].z * st[m][n][2] + el[m].z * kv[n][2];
          st[m][n][3] = egel[m].w * st[m][n][3] + el[m].w * kv[n][3];
        }
      }
    }
    if (branch == 1 && s + 1 < 68) prefetch_el(s + 1);
    if (wout) {
#pragma unroll
      for (int r = 0; r < 4; ++r) {
        int ip = gw * 16 + fq * 4 + r;
        unsigned ro = (unsigned)(dir ? 63 - ip : ip) * 2048u + fr;
#pragma unroll
        for (int n = 0; n < 4; ++n) {
          float v = o[n][r];
          if (!first) v += bf2f(oldv[r][n]);
          dstb[ro + n * 16] = f2bf(v);
        }
      }
    }
    __syncthreads();
  }
}

#define NPHASE 18
__device__ __forceinline__ void run_phase(const Params& p, int ph, char* smem) {
  const int nblk = gridDim.x, bid = blockIdx.x;
  if (ph == 0) {
#ifdef REP_P0
    for (int rep = 0; rep < REP_P0; ++rep)
#endif
    for (int u = bid; u < WT_UNITS + 96 + 1; u += nblk) {
      if (u < 96) mod_unit(p, u, smem);
      else if (u == 96) rot_unit(p);
      else wt_unit(p, 0, u - 97, smem);
    }
    return;
  }
  if (ph == NPHASE - 1) { phase_final(p); return; }
  const int l = (ph - 1) / 8, sp = (ph - 1) % 8;
  PG8_LAS unsigned char* lds = (PG8_LAS unsigned char*)smem;
  switch (sp) {
    case 0:
      phase_u(p, l);
      if (l == 1) for (int u = bid; u < WT_UNITS; u += nblk) wt_unit(p, 1, u, smem);
      break;
    case 1: {
      pg8::Gemm g{(const u16*)(p.ws + OFF_U), (const u16*)(p.ws + OFF_WT) + (size_t)WT_SCAN * 1024, 1024, MTOT, 4096, 1024};
      pg8::StaticOrder S; S.init(g.M, g.N, nblk, bid);
      EpiScanIn E{(u16*)(p.ws + OFF_S), (const float*)(p.ws + OFF_ROT)};
      pg8::gemm_phase(lds, g, S, E, opaque_tid());
    } break;
    case 2:
      for (int t = bid; t < 256; t += nblk) gla_prepass_unit(p, l, t, smem);
      for (int t = 1024 + (bid + 96) % nblk; t < 1088; t += nblk) gla_prepass_unit1(p, l, t, smem);
      break;
    case 3:
#ifdef REP_SCAN
      for (int rep = 0; rep < REP_SCAN; ++rep)
#endif
      for (int t0 = bid; t0 < 256; t0 += nblk) {
        const int x = t0 & 7, j = t0 >> 3;
        const int grp = ((j >> 2) & 1) * 32 + x * 4 + (j >> 3);
        const int t = (grp << 2) | (j & 3);
        if (t < 128) scan_item<0>(p, l, t, smem); else scan_item<1>(p, l, t, smem);
      }
      break;
    case 4:
      if (l != 0) phase_u(p, l);
      phase_stats(p, l);
      break;
    case 5: {
      pg8::Gemm g{(const u16*)(p.ws + OFF_U), (const u16*)(p.ws + OFF_WT) + (size_t)WT_GATE * 1024, 1024, l == 0 ? MTOT : MLAT, 4096, 1024};
      pg8::StaticOrder S; S.init(g.M, g.N, nblk, bid);
      EpiGate E{(const u16*)(p.ws + OFF_RG), (const float*)(p.ws + OFF_STATS), (u16*)(p.ws + OFF_S), p.ret_norm_gain + l * 1024, p.gla_norm_gain + l * 1024};
      pg8::gemm_phase(lds, g, S, E, opaque_tid());
    } break;
    case 6: {
#pragma unroll 1
      for (int pass = 0; pass < 2; ++pass) {
        pg8::Gemm g{(const u16*)(p.ws + OFF_S) + 2048 + pass * 1024, (const u16*)(p.ws + OFF_WT) + (size_t)(WT_BRR + pass * 1024) * 1024, 4096, l == 0 ? MTOT : MLAT, 1024, 1024};
        pg8::StaticOrder S; S.init(g.M, g.N, nblk, bid);
        EpiMerge E{(const u16*)(p.ws + OFF_S), (u16*)(p.ws + OFF_U), pass};
        pg8::gemm_phase(lds, g, S, E, opaque_tid());
      }
    } break;
    case 7: {
      pg8::Gemm g{(const u16*)(p.ws + OFF_U), (const u16*)(p.ws + OFF_WT) + (size_t)WT_OUT * 1024, 1024, l == 0 ? MTOT : MLAT, 1024, 1024};
      pg8::StaticOrder S; S.init(g.M, g.N, nblk, bid);
      EpiOut E{l == 0 ? p.x : p.out, p.ctx, p.out, (float*)(p.ws + OFF_HCTX), (const float*)(p.ws + OFF_MOD) + (size_t)l * 9 * 3072};
      pg8::gemm_phase(lds, g, S, E, opaque_tid());
    } break;
  }
}

#define XB_TMO      128
#define XB_XCNT(j)  (256  + 64 * (j))
#define XB_XSUB(j)  (1280 + 64 * (j))
#define XB_XGEN(j)  (2304 + 64 * (j))
#define XB_TOP      3328
#define XB_TOPGEN   3392
#define XCD_BAR_WORDS 3456
#define XB_SPIN_CAP (1u << 18)
__device__ __forceinline__ unsigned xb_ld(unsigned* p)              { return __hip_atomic_load(p, __ATOMIC_RELAXED, __HIP_MEMORY_SCOPE_AGENT); }
__device__ __forceinline__ unsigned xb_add(unsigned* p, unsigned v) { return __hip_atomic_fetch_add(p, v, __ATOMIC_RELAXED, __HIP_MEMORY_SCOPE_AGENT); }
__device__ __forceinline__ unsigned xb_xcc_id() { return (unsigned)__builtin_amdgcn_s_getreg((3 << 11) | 20) & 0xFu; }
#define XB_SPIN(cond, bar) do { unsigned _sp = 0; while (cond) { __builtin_amdgcn_s_sleep(1); \
    if ((++_sp & 255u) == 0u) { if (xb_ld(&(bar)[XB_TMO])) break; if (_sp > XB_SPIN_CAP) { atomicAdd(&(bar)[XB_TMO], 1u); break; } } } } while (0)

__device__ __forceinline__ void xcd_barrier_complete(unsigned* bar, unsigned x, unsigned& nloc, unsigned& nx) {
  const unsigned G = gridDim.x * gridDim.y * gridDim.z;
  unsigned sum, cnt, mine, sp = 0u;
  for (;;) {
    sum = 0u; cnt = 0u; mine = 0u;
#pragma unroll
    for (unsigned j = 0; j < 16; ++j) { const unsigned c = xb_ld(&bar[XB_XCNT(j)]); sum += c; cnt += (c > 0u) ? 1u : 0u; mine = (j == x) ? c : mine; }
    if (sum == G) break;
    __builtin_amdgcn_s_sleep(1);
    if ((++sp & 255u) == 0u) { if (xb_ld(&bar[XB_TMO])) break; if (sp > XB_SPIN_CAP) { atomicAdd(&bar[XB_TMO], 1u); break; } }
  }
  nloc = mine > 0u ? mine : 1u; nx = cnt > 0u ? cnt : 1u;
}

__device__ __forceinline__ void xcd_barrier(unsigned* bar, volatile unsigned* st) {
  asm volatile("s_waitcnt vmcnt(0)" ::: "memory");
  __syncthreads();
  if (threadIdx.x == 0) {
    const unsigned x = xb_xcc_id();
    __builtin_amdgcn_s_waitcnt(0);
    unsigned nloc = st[0], nx = st[1];
    if (nloc == 0u) { xcd_barrier_complete(bar, x, nloc, nx); st[0] = nloc; st[1] = nx; }
    const unsigned old = xb_add(&bar[XB_XSUB(x)], 1u);
    const unsigned gen = old / nloc;
    if (old + 1u == (gen + 1u) * nloc) {
      __builtin_amdgcn_fence(__ATOMIC_RELEASE, "agent");
      asm volatile("s_waitcnt vmcnt(0)" ::: "memory");
      const unsigned og = xb_add(&bar[XB_TOP], 1u);
      const unsigned tg = og / nx;
      if (og + 1u == (tg + 1u) * nx) xb_add(&bar[XB_TOPGEN], 1u);
      else XB_SPIN(xb_ld(&bar[XB_TOPGEN]) == tg, bar);
      __builtin_amdgcn_fence(__ATOMIC_ACQUIRE, "agent");
      xb_add(&bar[XB_XGEN(x)], 1u);
      asm volatile("s_waitcnt vmcnt(0)" ::: "memory");
    } else {
      XB_SPIN(xb_ld(&bar[XB_XGEN(x)]) == gen, bar);
      __builtin_amdgcn_fence(__ATOMIC_ACQUIRE, "agent");
      asm volatile("s_waitcnt vmcnt(0)" ::: "memory");
    }
  }
  __syncthreads();
}

__global__ void __launch_bounds__(NTHREADS) mega(Params p, int ph_lo, int ph_hi, int coop) {
  extern __shared__ __attribute__((aligned(16))) char smem[];
  volatile unsigned* xst = (volatile unsigned*)(smem + XB_LDS_OFF);
  unsigned* xbar = (unsigned*)(p.ws + OFF_BAR);
  if (coop) {
    if (threadIdx.x == 0) { xst[0] = 0u; xst[1] = 0u; (void)xb_add(&xbar[XB_XCNT(xb_xcc_id())], 1u); }
    __syncthreads();
  }
  for (int ph = ph_lo; ph < ph_hi; ++ph) {
    run_phase(p, ph, smem);
    if (coop && ph + 1 < ph_hi) {
      if (ph == ph_lo) cg::this_grid().sync();
      else xcd_barrier(xbar, xst);
    }
  }
}

extern "C" void kernel_launch(void* const* d_in, const int* in_sizes, int n_in,
                              void* d_out, int out_size, void* d_ws, size_t ws_size,
                              hipStream_t stream) {
  Params p{};
  p.x = (const float*)d_in[0]; p.c = (const float*)d_in[1]; p.ctx = (const float*)d_in[2]; p.c_ctx = (const float*)d_in[3];
  p.norm_gain = (const float*)d_in[4]; p.w_ada = (const float*)d_in[5]; p.b_ada = (const float*)d_in[6]; p.w_in = (const float*)d_in[7];
  p.ret_decay = (const float*)d_in[8]; p.gla_w_up = (const float*)d_in[9]; p.gla_b_up = (const float*)d_in[10];
  p.ret_norm_gain = (const float*)d_in[11]; p.gla_norm_gain = (const float*)d_in[12];
  p.w_br_ret = (const float*)d_in[13]; p.w_br_gla = (const float*)d_in[14]; p.w_out = (const float*)d_in[15]; p.final_gain = (const float*)d_in[16];
  p.out = (float*)d_out; p.ws = (char*)d_ws;
  static int grid_blocks = 0;
  if (!grid_blocks) {
    hipFuncSetAttribute((const void*)mega, hipFuncAttributeMaxDynamicSharedMemorySize, LDS_BYTES);
    int dev = 0, cus = 0, per_cu = 0;
    hipGetDevice(&dev);
    hipDeviceGetAttribute(&cus, hipDeviceAttributeMultiprocessorCount, dev);
    hipOccupancyMaxActiveBlocksPerMultiprocessor(&per_cu, mega, NTHREADS, LDS_BYTES);
    if (per_cu < 1) per_cu = 1;
    grid_blocks = cus * 1;
  }
#ifdef MULTI_LAUNCH
  for (int ph = 0; ph < NPHASE; ++ph) {
    mega<<<dim3(grid_blocks), dim3(NTHREADS), LDS_BYTES, stream>>>(p, ph, ph + 1, 0);
  }
#else
  hipMemsetAsync((char*)d_ws + OFF_BAR, 0, 16384, stream);
  int lo = 0, hi = NPHASE, coop = 1;
  void* args[] = {&p, &lo, &hi, &coop};
  hipError_t e = hipLaunchCooperativeKernel((void*)mega, dim3(grid_blocks), dim3(NTHREADS), args, LDS_BYTES, stream);
  if (e != hipSuccess) fprintf(stderr, "cooperative launch failed: %s (grid %d)\n", hipGetErrorString(e), grid_blocks);
#endif
}
```

```cpp
#include <hip/hip_runtime.h>
#include <hip/hip_cooperative_groups.h>
#include <cstdio>
namespace cg = cooperative_groups;

typedef unsigned short u16;
using bf16x8 = __attribute__((ext_vector_type(8))) short;
using bf16x4 = __attribute__((ext_vector_type(4))) short;
using f32x4  = __attribute__((ext_vector_type(4))) float;

#define NTHREADS 512
#define DM 1024
#define NB 8
#define SEQL 4096
#define CTXL 256
#define MLAT 32768
#define MCTX 2048
#define MTOT 34816
#define INW 8208

#define OFF_S    0ull
#define OFF_RG   (OFF_S   + (size_t)MTOT * 4096 * 2)
#define OFF_U    (OFF_RG  + (size_t)MTOT * 2048 * 2)
#define OFF_WT   (OFF_U   + (size_t)MTOT * 1024 * 2)
#define WT_ROWS  11392
#define OFF_GLR  (OFF_WT  + (size_t)WT_ROWS * 1024 * 2)
#define OFF_HCTX (OFF_GLR + (size_t)MTOT * 16 * 4)
#define OFF_MOD  (OFF_HCTX+ (size_t)MCTX * 1024 * 4)
#define OFF_ROT  (OFF_MOD + (size_t)2 * 9 * 3072 * 4)
#define OFF_BAR  (OFF_ROT + (size_t)64 * 32 * 2 * 4)
#define OFF_END  (OFF_BAR + 16384)

#define WT_SCAN 0
#define WT_GATE 4224
#define WT_BRR  8320
#define WT_BRG  9344
#define WT_OUT  10368

#define XB_LDS_OFF 161792
#define LDS_BYTES 161808
#define SCAN_GB   80896

struct Params {
  const float* x; const float* c; const float* ctx; const float* c_ctx;
  const float* norm_gain; const float* w_ada; const float* b_ada; const float* w_in;
  const float* ret_decay; const float* gla_w_up; const float* gla_b_up;
  const float* ret_norm_gain; const float* gla_norm_gain;
  const float* w_br_ret; const float* w_br_gla; const float* w_out; const float* final_gain;
  float* out; char* ws;
};

__device__ __forceinline__ u16 f2bf(float f) {
  __bf16 h = (__bf16)f;
  return *(u16*)&h;
}
__device__ __forceinline__ float bf2f(u16 h) { return __uint_as_float(((unsigned)h) << 16); }
__device__ __forceinline__ float sigmoidf_(float x) { return __builtin_amdgcn_rcpf(1.f + __expf(-x)); }
__device__ __forceinline__ float siluf_(float x) { return x * __builtin_amdgcn_rcpf(1.f + __expf(-x)); }

__device__ __forceinline__ float4 ldnt4(const float* p) { f32x4 t = __builtin_nontemporal_load((const f32x4*)p); return make_float4(t[0], t[1], t[2], t[3]); }
__device__ __forceinline__ bf16x8 ldnt8(const u16* p) { return __builtin_nontemporal_load((const bf16x8*)p); }

__device__ __forceinline__ int opaque_tid() { int t = threadIdx.x; asm volatile("" : "+v"(t)); return t; }

__device__ __forceinline__ float wave_sum(float v, int lane) {
#pragma unroll
  for (int o = 32; o > 0; o >>= 1)
    v += __int_as_float(__builtin_amdgcn_ds_bpermute((lane ^ o) << 2, __float_as_int(v)));
  return v;
}

__device__ __forceinline__ const float* wt_src(const Params& p, int l, int n, int& ld) {
  if (n < WT_GATE) {
    int tile = n >> 7, cc = n & 127;
    int col;
    if (tile < 8) {
      int d = (cc & 64) | ((cc & 16) << 1) | ((cc & 32) >> 1) | (cc & 15);
      col = tile * 128 + d;
    } else if (tile < 16) col = 1024 + (tile - 8) * 128 + cc;
    else if (tile < 24) col = 3072 + (tile - 16) * 128 + cc;
    else if (tile < 32) col = 4096 + (tile - 24) * 128 + cc;
    else { if (cc >= 16) { ld = 0; return nullptr; } col = 6144 + cc; }
    ld = INW; return p.w_in + (size_t)l * DM * INW + col;
  } else if (n < WT_BRR) {
    int g = n - WT_GATE; int col;
    if (g < 1024) col = 2048 + g;
    else if (g < 2048) col = 5120 + (g - 1024);
    else if (g < 3072) col = 6160 + (g - 2048);
    else col = 7184 + (g - 3072);
    ld = INW; return p.w_in + (size_t)l * DM * INW + col;
  } else if (n < WT_BRG) { ld = DM; return p.w_br_ret + (size_t)l * DM * DM + (n - WT_BRR); }
  else if (n < WT_OUT)   { ld = DM; return p.w_br_gla + (size_t)l * DM * DM + (n - WT_BRG); }
  else                   { ld = DM; return p.w_out    + (size_t)l * DM * DM + (n - WT_OUT); }
}

#define WT_UNITS (178 * 4)
__device__ __forceinline__ void wt_unit(const Params& p, int l, int unit, char* smem) {
  float* tile = (float*)smem;
  int nb = unit >> 2, kg = unit & 3;
  int tid = opaque_tid();
  int n0 = nb * 64, kbase = kg * 256;
  float v[4][8];
  {
    int nl = tid & 63, kq = tid >> 6;
    int ld; const float* src = wt_src(p, l, n0 + nl, ld);
#pragma unroll
    for (int q = 0; q < 4; ++q)
#pragma unroll
      for (int i = 0; i < 8; ++i) v[q][i] = src ? src[(size_t)(kbase + q * 64 + kq + 8 * i) * ld] : 0.f;
  }
  u16* wt = (u16*)(p.ws + OFF_WT);
#pragma unroll
  for (int q = 0; q < 4; ++q) {
    __syncthreads();
    {
      int nl = tid & 63, kq = tid >> 6;
#pragma unroll
      for (int i = 0; i < 8; ++i) tile[(kq + 8 * i) * 65 + nl] = v[q][i];
    }
    __syncthreads();
    {
      int nl = tid >> 3, kq = tid & 7;
      bf16x8 o;
#pragma unroll
      for (int j = 0; j < 8; ++j) o[j] = (short)f2bf(tile[(kq * 8 + j) * 65 + nl]);
      *(bf16x8*)(wt + (size_t)(n0 + nl) * 1024 + kbase + q * 64 + kq * 8) = o;
    }
  }
  __syncthreads();
}

__device__ __forceinline__ void mod_unit(const Params& p, int unit, char* smem) {
  float* sc = (float*)smem;
  float* red = sc + 9 * 1024;
  int l = unit / 48, jb = unit % 48;
  int tid = opaque_tid();
  for (int i = tid; i < 9 * 1024; i += NTHREADS) {
    int r = i >> 10, k = i & 1023;
    float v = (r < 8) ? p.c[r * 1024 + k] : p.c_ctx[k];
    sc[i] = siluf_(v);
  }
  __syncthreads();
  int jl = tid & 63, kg = tid >> 6;
  int j = jb * 64 + jl;
  float acc[9];
#pragma unroll
  for (int r = 0; r < 9; ++r) acc[r] = 0.f;
  const float* w = p.w_ada + (size_t)l * DM * 3072 + j;
#pragma unroll 16
  for (int k = kg * 128; k < kg * 128 + 128; ++k) {
    float wv = w[(size_t)k * 3072];
#pragma unroll
    for (int r = 0; r < 9; ++r) acc[r] += sc[r * 1024 + k] * wv;
  }
#pragma unroll
  for (int r = 0; r < 9; ++r) red[(kg * 9 + r) * 64 + jl] = acc[r];
  __syncthreads();
  float* mod = (float*)(p.ws + OFF_MOD);
  for (int i = tid; i < 9 * 64; i += NTHREADS) {
    int r = i >> 6, jj = i & 63;
    float s = 0.f;
#pragma unroll
    for (int g = 0; g < 8; ++g) s += red[(g * 9 + r) * 64 + jj];
    mod[((size_t)l * 9 + r) * 3072 + jb * 64 + jj] = s + p.b_ada[l * 3072 + jb * 64 + jj];
  }
  __syncthreads();
}

__device__ __forceinline__ void rot_unit(const Params& p) {
  float* rot = (float*)(p.ws + OFF_ROT);
  for (int i = opaque_tid(); i < 64 * 32; i += NTHREADS) {
    int pos = i >> 5, f = i & 31;
    float inv = exp2f(-(float)f * (13.287712379549449f / 32.f));
    float ang = (float)pos * inv;
    rot[i * 2] = __cosf(ang);
    rot[i * 2 + 1] = __sinf(ang);
  }
}

__device__ __forceinline__ void phase_u(const Params& p, int l) {
  const int tid = opaque_tid(); int wave = tid >> 6, lane = tid & 63;
  const float* mod = (const float*)(p.ws + OFF_MOD) + (size_t)l * 9 * 3072;
  const float* gain = p.norm_gain + l * DM;
  u16* U = (u16*)(p.ws + OFF_U);
  for (int row = (blockIdx.x * 8 + wave) * 4; row < MTOT; row += gridDim.x * 32) {
    const float* h; int r;
    if (row < MLAT) { h = (l == 0 ? p.x : p.out) + (size_t)row * DM; r = row >> 12; }
    else { int cr = row - MLAT; h = (l == 0 ? p.ctx : (const float*)(p.ws + OFF_HCTX)) + (size_t)cr * DM; r = 8; }
    float4 v[4][4]; float ss[4];
#pragma unroll
    for (int q = 0; q < 4; ++q) {
      ss[q] = 0.f;
#pragma unroll
      for (int i = 0; i < 4; ++i) v[q][i] = ldnt4(h + q * DM + i * 256 + lane * 4);
    }
#pragma unroll
    for (int q = 0; q < 4; ++q) {
#pragma unroll
      for (int i = 0; i < 4; ++i) ss[q] += v[q][i].x * v[q][i].x + v[q][i].y * v[q][i].y + v[q][i].z * v[q][i].z + v[q][i].w * v[q][i].w;
      ss[q] = rsqrtf(wave_sum(ss[q], lane) * (1.f / 1024.f) + 1e-6f);
    }
    const float* sh = mod + r * 3072;
#pragma unroll
    for (int i = 0; i < 4; ++i) {
      int cidx = i * 256 + lane * 4;
      float4 g = *(const float4*)(gain + cidx);
      float4 s = *(const float4*)(sh + cidx);
      float4 sc = *(const float4*)(sh + 1024 + cidx);
      g.x *= (1.f + sc.x); g.y *= (1.f + sc.y); g.z *= (1.f + sc.z); g.w *= (1.f + sc.w);
#pragma unroll
      for (int q = 0; q < 4; ++q) {
        bf16x4 o;
        o[0] = (short)f2bf(v[q][i].x * ss[q] * g.x + s.x);
        o[1] = (short)f2bf(v[q][i].y * ss[q] * g.y + s.y);
        o[2] = (short)f2bf(v[q][i].z * ss[q] * g.z + s.z);
        o[3] = (short)f2bf(v[q][i].w * ss[q] * g.w + s.w);
        *(bf16x4*)(U + (size_t)(row + q) * DM + cidx) = o;
      }
    }
  }
}

__device__ __forceinline__ void phase_final(const Params& p) {
  const int tid = opaque_tid(); int wave = tid >> 6, lane = tid & 63;
  for (int row = (blockIdx.x * 8 + wave) * 4; row < MLAT; row += gridDim.x * 32) {
    float* h = p.out + (size_t)row * DM;
    float4 v[4][4]; float ss[4];
#pragma unroll
    for (int q = 0; q < 4; ++q) {
      ss[q] = 0.f;
#pragma unroll
      for (int i = 0; i < 4; ++i) v[q][i] = ldnt4(h + q * DM + i * 256 + lane * 4);
    }
#pragma unroll
    for (int q = 0; q < 4; ++q) {
#pragma unroll
      for (int i = 0; i < 4; ++i) ss[q] += v[q][i].x * v[q][i].x + v[q][i].y * v[q][i].y + v[q][i].z * v[q][i].z + v[q][i].w * v[q][i].w;
      ss[q] = rsqrtf(wave_sum(ss[q], lane) * (1.f / 1024.f) + 1e-6f);
    }
#pragma unroll
    for (int i = 0; i < 4; ++i) {
      int cidx = i * 256 + lane * 4;
      float4 g = *(const float4*)(p.final_gain + cidx);
#pragma unroll
      for (int q = 0; q < 4; ++q) {
        float4 o;
        o.x = v[q][i].x * ss[q] * g.x; o.y = v[q][i].y * ss[q] * g.y; o.z = v[q][i].z * ss[q] * g.z; o.w = v[q][i].w * ss[q] * g.w;
        *(float4*)(h + q * DM + cidx) = o;
      }
    }
  }
}

#define PG8_LAS __attribute__((address_space(3)))
typedef unsigned u32x4 __attribute__((ext_vector_type(4)));
namespace pg8 {
constexpr int BM = 256, BK = 64, HALF = 128, HTB = HALF * BK * 2, STAGE_BYTES = 8 * HTB, NXCD = 8, WGM = 8;
__device__ __forceinline__ int lds_byte(int r, int c) { const int st = (r >> 4) * 2 + (c >> 5), rr = r & 15, cc = c & 31, ob = rr * 64 + cc * 2; return st * 1024 + (ob ^ (((ob >> 9) & 1) << 5)); }
__device__ __forceinline__ void stage_rc(int b, int& R, int& C) { const int st = b / 1024, sb = b % 1024, swz = sb ^ (((sb >> 9) & 1) << 5); R = (st >> 1) * 16 + swz / 64; C = (st & 1) * 32 + (swz % 64) / 2; }
__device__ __forceinline__ int perm32(int rho) { const int n = rho >> 4, i = rho & 15; return 8 * (i >> 2) + 4 * n + (i & 3); }
struct Unit { int pm, pn; };
struct Gemm { const u16* A; const u16* Bt; int lda; int M, N, K; };
struct StaticOrder {
  int nM, nN, nwg, G, c;
  __device__ void init(int M, int N, int G_, int c_) { nM = M / BM; nN = N / BM; nwg = nM * nN; G = G_; c = c_; }
  __device__ bool next(int i, Unit& u) const {
    const long L = (long)i * G + c; if (L >= nwg) return false;
    int wgid = (int)L; { const int q = nwg / NXCD, r = nwg % NXCD, xcd = wgid % NXCD, off = wgid / NXCD; wgid = (xcd < r ? xcd * (q + 1) : r * (q + 1) + (xcd - r) * q) + off; }
    const int nig = WGM * nN, gid = wgid / nig, fm = gid * WGM, gsz = (nM - fm) < WGM ? (nM - fm) : WGM;
    u.pm = fm + ((wgid % nig) % gsz); u.pn = (wgid % nig) / gsz; return true;
  }
};
typedef __attribute__((ext_vector_type(2))) float cvt_f2_t;
typedef __attribute__((ext_vector_type(2))) __bf16 cvt_b2_t;
__device__ __forceinline__ unsigned cvt_pk_bf16(float lo, float hi) { cvt_f2_t f = {lo, hi}; cvt_b2_t r = __builtin_convertvector(f, cvt_b2_t); return __builtin_bit_cast(unsigned, r); }

template <class Epi>
__device__ __forceinline__ void gemm_phase(PG8_LAS unsigned char* lds, const Gemm g, const StaticOrder& S, const Epi& E, const int tid) {
  const int wid = __builtin_amdgcn_readfirstlane(tid >> 6), lane = tid & 63, wr = wid >> 2, wc = wid & 3, fr = lane & 15, fq = lane >> 4;
  const int K = g.K, nt = K / BK;
  unsigned voffA[2], voffB[2];
#pragma unroll
  for (int i = 0; i < 2; ++i) { int R, C; stage_rc(tid * 16 + i * 8192, R, C); const int Rb = Epi::PERM ? ((R & ~31) + perm32(R & 31)) : R;
    voffA[i] = (unsigned)(R * g.lda + C) * 2u; voffB[i] = (unsigned)(Rb * K + C) * 2u; }
  const size_t kstep = (size_t)(BK * 2);
  const size_t hstepA = (size_t)HALF * g.lda * 2, hstepB = (size_t)HALF * K * 2;
  const size_t tstepA = 2 * hstepA, tstepB = 2 * hstepB;
  const unsigned ldsw = (unsigned)wid * 1024u;
  const int aoff = lds_byte(wr * 64 + fr, fq * 8), boff = lds_byte(wc * 32 + fr, fq * 8);
#define PG8_SA(b, h) (((b) * 2 + (h)) * HTB)
#define PG8_SB(b, h) ((4 + (b) * 2 + (h)) * HTB)
#define PG8_STAGE(bufoff, gbase, voff) do { _Pragma("unroll") for (int _i = 0; _i < 2; ++_i) \
    __builtin_amdgcn_global_load_lds((const unsigned*)((const char*)(gbase) + (voff)[_i]), (PG8_LAS unsigned*)(lds + (bufoff) + ldsw + _i * 8192), 16, 0, 0); } while (0)
#define PG8_LDA(dst, b, h) do { _Pragma("unroll") for (int m = 0; m < 4; ++m) _Pragma("unroll") for (int k = 0; k < 2; ++k) dst[m][k] = *(const PG8_LAS bf16x8*)(lds + PG8_SA(b, h) + aoff + m * 2048 + k * 1024); } while (0)
#define PG8_LDB(dst, b, h) do { _Pragma("unroll") for (int n = 0; n < 2; ++n) _Pragma("unroll") for (int k = 0; k < 2; ++k) dst[n][k] = *(const PG8_LAS bf16x8*)(lds + PG8_SB(b, h) + boff + n * 2048 + k * 1024); } while (0)
#define PG8_MMA(ai, bj, At, Bt) do { __builtin_amdgcn_s_setprio(1); _Pragma("unroll") for (int m = 0; m < 4; ++m) _Pragma("unroll") for (int n = 0; n < 2; ++n) _Pragma("unroll") for (int k = 0; k < 2; ++k) \
    acc[ai][bj][m][n] = __builtin_amdgcn_mfma_f32_16x16x32_bf16(Bt[n][k], At[m][k], acc[ai][bj][m][n], 0, 0, 0); __builtin_amdgcn_s_setprio(0); } while (0)
#define PG8_WAIT_V(n) asm volatile("s_waitcnt vmcnt(" #n ")" ::: "memory")
#define PG8_WAIT_L(n) asm volatile("s_waitcnt lgkmcnt(" #n ")" ::: "memory")
#define PG8_BAR __builtin_amdgcn_s_barrier()
#define PG8_SCHED __builtin_amdgcn_sched_barrier(0)
  Unit cur, nxt; int ui = 0;
  if (!S.next(0, cur)) return;
  f32x4 acc[2][2][4][2];
#pragma unroll
  for (int a = 0; a < 2; ++a)
#pragma unroll
    for (int b = 0; b < 2; ++b)
#pragma unroll
      for (int m = 0; m < 4; ++m)
#pragma unroll
        for (int n = 0; n < 2; ++n) acc[a][b][m][n] = (f32x4){0.f, 0.f, 0.f, 0.f};
  bf16x8 At[4][2], B0[2][2], B1[2][2];
  const char* cA = (const char*)g.A + (size_t)cur.pm * tstepA; const char* cB = (const char*)g.Bt + (size_t)cur.pn * tstepB;
  PG8_STAGE(PG8_SB(0, 0), cB, voffB); PG8_STAGE(PG8_SA(0, 0), cA, voffA); PG8_STAGE(PG8_SB(0, 1), cB + hstepB, voffB); PG8_STAGE(PG8_SA(0, 1), cA + hstepA, voffA);
  if (wr == 1) PG8_BAR;
  PG8_WAIT_V(4); PG8_BAR;
  PG8_STAGE(PG8_SB(1, 0), cB + kstep, voffB); PG8_STAGE(PG8_SA(1, 0), cA + kstep, voffA); PG8_STAGE(PG8_SB(1, 1), cB + hstepB + kstep, voffB);
  PG8_WAIT_V(6); PG8_BAR;
  for (;;) {
    const bool has_next = S.next(ui + 1, nxt);
    const char* nA = has_next ? (const char*)g.A + (size_t)nxt.pm * tstepA : cA; const char* nB = has_next ? (const char*)g.Bt + (size_t)nxt.pn * tstepB : cB;
    for (int t = 0; t < nt; t += 2) {
      const bool last = (t == nt - 2);
      const char* a1 = cA + (size_t)(t + 1) * kstep;
      const char* a2 = last ? nA : cA + (size_t)(t + 2) * kstep; const char* b2 = last ? nB : cB + (size_t)(t + 2) * kstep;
      const char* a3 = a2 + kstep; const char* b3 = b2 + kstep;
      PG8_LDB(B0, 0, 0); PG8_SCHED; PG8_LDA(At, 0, 0); PG8_STAGE(PG8_SA(1, 1), a1 + hstepA, voffA);
      PG8_WAIT_L(8); PG8_BAR; PG8_WAIT_L(0); PG8_MMA(0, 0, At, B0); PG8_BAR; PG8_SCHED;
      PG8_LDB(B1, 0, 1); PG8_STAGE(PG8_SB(0, 0), b2, voffB);
      PG8_BAR; PG8_WAIT_L(0); PG8_MMA(0, 1, At, B1); PG8_BAR;
      PG8_LDA(At, 0, 1); PG8_STAGE(PG8_SA(0, 0), a2, voffA);
      PG8_BAR; PG8_WAIT_L(0); PG8_MMA(1, 0, At, B0); PG8_BAR; PG8_SCHED;
      PG8_STAGE(PG8_SB(0, 1), b2 + hstepB, voffB);
      PG8_WAIT_V(6); PG8_BAR; PG8_MMA(1, 1, At, B1); PG8_BAR;
      PG8_LDB(B0, 1, 0); PG8_SCHED; PG8_LDA(At, 1, 0); PG8_STAGE(PG8_SA(0, 1), a2 + hstepA, voffA);
      PG8_WAIT_L(8); PG8_BAR; PG8_WAIT_L(0); PG8_MMA(0, 0, At, B0); PG8_BAR; PG8_SCHED;
      PG8_LDB(B1, 1, 1); PG8_STAGE(PG8_SB(1, 0), b3, voffB);
      PG8_BAR; PG8_WAIT_L(0); PG8_MMA(0, 1, At, B1); PG8_BAR;
      PG8_LDA(At, 1, 1); PG8_STAGE(PG8_SA(1, 0), a3, voffA);
      PG8_BAR; PG8_WAIT_L(0); PG8_MMA(1, 0, At, B0); PG8_BAR; PG8_SCHED;
      PG8_STAGE(PG8_SB(1, 1), b3 + hstepB, voffB);
      PG8_WAIT_V(6); PG8_BAR; PG8_MMA(1, 1, At, B1); PG8_BAR;
    }
    E(acc, cur, wr, wc, fr, fq, lane);
    if (!has_next) break;
#pragma unroll
    for (int a = 0; a < 2; ++a)
#pragma unroll
      for (int b = 0; b < 2; ++b)
#pragma unroll
        for (int m = 0; m < 4; ++m)
#pragma unroll
          for (int n = 0; n < 2; ++n) acc[a][b][m][n] = (f32x4){0.f, 0.f, 0.f, 0.f};
    cur = nxt; cA = nA; cB = nB; ++ui;
  }
  PG8_WAIT_V(0);
  if (wr == 0) PG8_BAR;
  PG8_BAR;
#undef PG8_SA
#undef PG8_SB
#undef PG8_STAGE
#undef PG8_LDA
#undef PG8_LDB
#undef PG8_MMA
#undef PG8_WAIT_V
#undef PG8_WAIT_L
#undef PG8_BAR
#undef PG8_SCHED
}
}

#define OFF_STATS OFF_GLR

__device__ __forceinline__ u32x4 pack8v(const f32x4& a, const f32x4& b) {
  u32x4 w; w.x = pg8::cvt_pk_bf16(a[0], a[1]); w.y = pg8::cvt_pk_bf16(a[2], a[3]); w.z = pg8::cvt_pk_bf16(b[0], b[1]); w.w = pg8::cvt_pk_bf16(b[2], b[3]); return w;
}
__device__ __forceinline__ float xlane32(float v, int lane) { return __int_as_float(__builtin_amdgcn_ds_bpermute((lane ^ 32) << 2, __float_as_int(v))); }

struct EpiScanIn {
  static constexpr bool PERM = true;
  u16* S; const float* rot;
  __device__ __forceinline__ void operator()(const f32x4 (&acc)[2][2][4][2], const pg8::Unit& u, int wr, int wc, int fr, int fq, int lane) const {
    u16* Sb = S + (size_t)u.pm * 256 * 4096;
    unsigned rl0 = wr * 64 + fr; asm volatile("" : "+v"(rl0));
#pragma unroll
    for (int bj = 0; bj < 2; ++bj) {
      const int nt128 = u.pn * 2 + bj;
      const bool scaled = (nt128 < 4) || (nt128 >= 16 && nt128 < 20);
      const float scl = scaled ? 0.08838834764831845f : 1.f;
      const unsigned cb = nt128 * 128 + wc * 32 + fq * 8;
      if (nt128 < 8 && u.pm < 128) {
        const int tb = (u.pm & 15) * 256;
        const int fo = ((wc & 1) * 16 + (fq & 1) * 8) * 2;
        const float sgn = (fq >> 1) ? 1.f : -1.f;
#pragma unroll
        for (int ai = 0; ai < 2; ++ai) {
          float4 cs[4][4];
#pragma unroll
          for (int q = 0; q < 4; ++q) {
            const int t = tb + (int)(rl0 + ai * 128 + q * 16);
            const unsigned pos = (wc >> 1) == 0 ? (t >> 6) : (t & 63);
            const float* rp = rot + pos * 64u + fo;
            cs[q][0] = *(const float4*)rp; cs[q][1] = *(const float4*)(rp + 4); cs[q][2] = *(const float4*)(rp + 8); cs[q][3] = *(const float4*)(rp + 12);
          }
          __builtin_amdgcn_sched_barrier(0);
#pragma unroll
          for (int m = 0; m < 4; ++m) {
            const unsigned rl = rl0 + ai * 128 + m * 16;
            const float4 c0 = cs[m][0], c1 = cs[m][1], c2 = cs[m][2], c3 = cs[m][3];
            const f32x4 v0 = acc[ai][bj][m][0], v1 = acc[ai][bj][m][1];
            f32x4 p0, p1;
#pragma unroll
            for (int j = 0; j < 4; ++j) { p0[j] = xlane32(v0[j], lane); p1[j] = xlane32(v1[j], lane); }
            f32x4 o0, o1;
            o0[0] = (v0[0] * c0.x + sgn * p0[0] * c0.y) * scl; o0[1] = (v0[1] * c0.z + sgn * p0[1] * c0.w) * scl;
            o0[2] = (v0[2] * c1.x + sgn * p0[2] * c1.y) * scl; o0[3] = (v0[3] * c1.z + sgn * p0[3] * c1.w) * scl;
            o1[0] = (v1[0] * c2.x + sgn * p1[0] * c2.y) * scl; o1[1] = (v1[1] * c2.z + sgn * p1[1] * c2.w) * scl;
            o1[2] = (v1[2] * c3.x + sgn * p1[2] * c3.y) * scl; o1[3] = (v1[3] * c3.z + sgn * p1[3] * c3.w) * scl;
            *(u32x4*)(Sb + rl * 4096u + cb) = pack8v(o0, o1);
            __builtin_amdgcn_sched_barrier(0);
          }
        }
      } else {
#pragma unroll
        for (int ai = 0; ai < 2; ++ai)
#pragma unroll
          for (int m = 0; m < 4; ++m) {
            const unsigned rl = rl0 + ai * 128 + m * 16;
            *(u32x4*)(Sb + rl * 4096u + cb) = pack8v(acc[ai][bj][m][0] * scl, acc[ai][bj][m][1] * scl);
            __builtin_amdgcn_sched_barrier(0);
          }
      }
    }
  }
};

struct EpiGate {
  static constexpr bool PERM = true;
  const u16* RG; const float* stats; u16* S; const float* rgain; const float* ggain;
  __device__ __forceinline__ void operator()(const f32x4 (&acc)[2][2][4][2], const pg8::Unit& u, int wr, int wc, int fr, int fq, int lane) const {
    u16* Sb = S + (size_t)u.pm * 256 * 4096;
    unsigned rl0 = wr * 64 + fr; asm volatile("" : "+v"(rl0));
    if (u.pn < 8) {
      const int branch = u.pn >> 2, head = u.pn & 3;
      const u16* RGb = RG + (size_t)u.pm * 256 * 2048 + branch * 1024;
      const float* stb = stats + (size_t)u.pm * 256 * 16 + (branch * 4 + head) * 2;
      const float* gain = branch ? ggain : rgain;
#pragma unroll
      for (int bj = 0; bj < 2; ++bj) {
        const unsigned cb = head * 256 + bj * 128 + wc * 32 + fq * 8;
        const float4 g0 = *(const float4*)(gain + cb), g1 = *(const float4*)(gain + cb + 4);
#pragma unroll
        for (int ai = 0; ai < 2; ++ai) {
        float2 stv[4]; bf16x8 xrv[4];
#pragma unroll
        for (int q = 0; q < 4; ++q) {
          const unsigned rl = rl0 + ai * 128 + q * 16;
          stv[q] = *(const float2*)(stb + rl * 16u);
          xrv[q] = *(const bf16x8*)(RGb + rl * 2048u + cb);
        }
        __builtin_amdgcn_sched_barrier(0);
#pragma unroll
          for (int m = 0; m < 4; ++m) {
            const unsigned rl = rl0 + ai * 128 + m * 16;
            const float2 st = stv[m];
            const bf16x8 xr = xrv[m];
            f32x4 v0 = acc[ai][bj][m][0], v1 = acc[ai][bj][m][1];
            asm volatile("" : "+v"(v0), "+v"(v1));
            f32x4 o0, o1;
            o0[0] = (bf2f((u16)xr[0]) * st.x + st.y) * g0.x * siluf_(v0[0]); o0[1] = (bf2f((u16)xr[1]) * st.x + st.y) * g0.y * siluf_(v0[1]);
            o0[2] = (bf2f((u16)xr[2]) * st.x + st.y) * g0.z * siluf_(v0[2]); o0[3] = (bf2f((u16)xr[3]) * st.x + st.y) * g0.w * siluf_(v0[3]);
            o1[0] = (bf2f((u16)xr[4]) * st.x + st.y) * g1.x * siluf_(v1[0]); o1[1] = (bf2f((u16)xr[5]) * st.x + st.y) * g1.y * siluf_(v1[1]);
            o1[2] = (bf2f((u16)xr[6]) * st.x + st.y) * g1.z * siluf_(v1[2]); o1[3] = (bf2f((u16)xr[7]) * st.x + st.y) * g1.w * siluf_(v1[3]);
            *(u32x4*)(Sb + rl * 4096u + 2048u + branch * 1024 + cb) = pack8v(o0, o1);
            __builtin_amdgcn_sched_barrier(0);
          }
        }
      }
    } else {
#pragma unroll
      for (int bj = 0; bj < 2; ++bj) {
        const unsigned cb = (u.pn - 8) * 256 + bj * 128 + wc * 32 + fq * 8;
#pragma unroll
        for (int ai = 0; ai < 2; ++ai)
#pragma unroll
          for (int m = 0; m < 4; ++m) {
            const unsigned rl = rl0 + ai * 128 + m * 16;
            f32x4 v0 = acc[ai][bj][m][0], v1 = acc[ai][bj][m][1];
            asm volatile("" : "+v"(v0), "+v"(v1));
            f32x4 o0, o1;
#pragma unroll
            for (int j = 0; j < 4; ++j) { o0[j] = sigmoidf_(v0[j]); o1[j] = sigmoidf_(v1[j]); }
            *(u32x4*)(Sb + rl * 4096u + cb) = pack8v(o0, o1);
            __builtin_amdgcn_sched_barrier(0);
          }
      }
    }
  }
};

struct EpiMerge {
  static constexpr bool PERM = true;
  const u16* S; u16* MG; int pass;
  __device__ __forceinline__ void operator()(const f32x4 (&acc)[2][2][4][2], const pg8::Unit& u, int wr, int wc, int fr, int fq, int lane) const {
    const u16* Sb = S + (size_t)u.pm * 256 * 4096 + pass * 1024;
    u16* MGb = MG + (size_t)u.pm * 256 * 1024;
    unsigned rl0 = wr * 64 + fr; asm volatile("" : "+v"(rl0));
#pragma unroll
    for (int bj = 0; bj < 2; ++bj) {
      const unsigned cb = u.pn * 256 + bj * 128 + wc * 32 + fq * 8;
#pragma unroll
      for (int ai = 0; ai < 2; ++ai) {
      bf16x8 gtv[4], oldv_[4];
#pragma unroll
      for (int q = 0; q < 4; ++q) {
        const unsigned rl = rl0 + ai * 128 + q * 16;
        gtv[q] = *(const bf16x8*)(Sb + rl * 4096u + cb);
        if (pass) oldv_[q] = *(const bf16x8*)(MGb + rl * 1024u + cb);
      }
      __builtin_amdgcn_sched_barrier(0);
#pragma unroll
        for (int m = 0; m < 4; ++m) {
          const unsigned rl = rl0 + ai * 128 + m * 16;
          const bf16x8 gt = gtv[m];
          f32x4 o0 = acc[ai][bj][m][0], o1 = acc[ai][bj][m][1];
#pragma unroll
          for (int j = 0; j < 4; ++j) { o0[j] *= bf2f((u16)gt[j]); o1[j] *= bf2f((u16)gt[4 + j]); }
          if (pass) {
            const bf16x8 old = oldv_[m];
#pragma unroll
            for (int j = 0; j < 4; ++j) { o0[j] += bf2f((u16)old[j]); o1[j] += bf2f((u16)old[4 + j]); }
          }
          *(u32x4*)(MGb + rl * 1024u + cb) = pack8v(o0, o1);
            __builtin_amdgcn_sched_barrier(0);
        }
      }
    }
  }
};

struct EpiOut {
  static constexpr bool PERM = false;
  const float* x_lat; const float* x_ctx; float* o_lat; float* o_ctx; const float* mod;
  __device__ __forceinline__ void operator()(const f32x4 (&acc)[2][2][4][2], const pg8::Unit& u, int wr, int wc, int fr, int fq, int lane) const {
    const float* hin; float* hout; int rmod;
    if (u.pm < 128) { hin = x_lat + (size_t)u.pm * 256 * DM; hout = o_lat + (size_t)u.pm * 256 * DM; rmod = u.pm >> 4; }
    else { hin = x_ctx + (size_t)(u.pm - 128) * 256 * DM; hout = o_ctx + (size_t)(u.pm - 128) * 256 * DM; rmod = 8; }
    const float* gate = mod + rmod * 3072 + 2048;
    unsigned rl0 = wr * 64 + fr; asm volatile("" : "+v"(rl0));
#pragma unroll
    for (int bj = 0; bj < 2; ++bj)
#pragma unroll
      for (int n = 0; n < 2; ++n) {
        const unsigned cb = u.pn * 256 + bj * 128 + wc * 32 + n * 16 + fq * 4;
        const float4 g = *(const float4*)(gate + cb);
        float4 hv[8];
#pragma unroll
        for (int q = 0; q < 8; ++q) hv[q] = ldnt4(hin + (rl0 + (q >> 2) * 128 + (q & 3) * 16) * 1024u + cb);
        __builtin_amdgcn_sched_barrier(0);
#pragma unroll
        for (int ai = 0; ai < 2; ++ai)
#pragma unroll
          for (int m = 0; m < 4; ++m) {
            const unsigned o = (rl0 + ai * 128 + m * 16) * 1024u + cb;
            const float4 h = hv[ai * 4 + m];
            const f32x4 v = acc[ai][bj][m][n];
            *(float4*)(hout + o) = make_float4(h.x + g.x * v[0], h.y + g.y * v[1], h.z + g.z * v[2], h.w + g.w * v[3]);
          }
      }
  }
};

__device__ __forceinline__ void phase_stats(const Params& p, int l) {
  const int tid = opaque_tid(); const int wave = tid >> 6, lane = tid & 63;
  const u16* RG = (const u16*)(p.ws + OFF_RG);
  float* ST = (float*)(p.ws + OFF_STATS);
  const int nrows = (l == 0) ? MTOT : MLAT;
  for (int row = (blockIdx.x * 8 + wave) * 4; row < nrows; row += gridDim.x * 32) {
    bf16x8 v[4][4];
#pragma unroll
    for (int q = 0; q < 4; ++q)
#pragma unroll
      for (int i = 0; i < 4; ++i) v[q][i] = *(const bf16x8*)(RG + (size_t)(row + q) * 2048 + i * 512 + lane * 8);
#pragma unroll
    for (int q = 0; q < 4; ++q)
#pragma unroll
      for (int i = 0; i < 4; ++i) {
        float s1 = 0.f, s2 = 0.f;
#pragma unroll
        for (int x = 0; x < 8; ++x) { float a = bf2f((u16)v[q][i][x]); s1 += a; s2 += a * a; }
#pragma unroll
        for (int o = 16; o > 0; o >>= 1) {
          s1 += __int_as_float(__builtin_amdgcn_ds_bpermute((lane ^ o) << 2, __float_as_int(s1)));
          s2 += __int_as_float(__builtin_amdgcn_ds_bpermute((lane ^ o) << 2, __float_as_int(s2)));
        }
        float sa, sb;
        if ((i >> 1) == 0) { float mu = s1 * (1.f / 256.f); float var = fmaxf(s2 * (1.f / 256.f) - mu * mu, 0.f); sa = rsqrtf(var + 1e-6f); sb = -mu * sa; }
        else { sa = rsqrtf(s2 * (1.f / 256.f) + 1e-6f); sb = 0.f; }
        if ((lane & 31) == 0) *(float2*)(ST + ((size_t)(row + q) * 8 + (i >> 1) * 4 + 2 * (i & 1) + (lane >> 5)) * 2) = make_float2(sa, sb);
      }
  }
}

#define OFF_VECS OFF_WT
__device__ __forceinline__ float logsig16(float x) { return (fminf(x, 0.f) - __logf(1.f + __expf(-fabsf(x)))) * (1.f / 16.f); }

typedef __attribute__((ext_vector_type(2))) float f32x2_t;

template <int SW>
__device__ __forceinline__ void prepass_sweep4(const float* GLRS, const f32x2_t (&w2)[4][16], const f32x2_t (&b2)[4], u16* Sq, u16* Ub,
                                               float (&accF)[4], float (&accB)[4]) {
#pragma unroll
  for (int c = 0; c < 4; ++c) { accF[c] = 0.f; accB[c] = 0.f; }
#pragma unroll 4
  for (int u = 0; u < 32; ++u) {
    const int i = SW ? 32 + u : 31 - u;
    const bf16x4 q4 = *(const bf16x4*)(Sq + (unsigned)i * 4096u);
    const bf16x4 k4 = *(const bf16x4*)(Sq + (unsigned)i * 4096u + 512u);
    const float4* gr = (const float4*)(GLRS + (i & 31) * 16);
    const float4 g0 = gr[0], g1 = gr[1], g2 = gr[2], g3 = gr[3];
    bf16x4 oqf, okf, oqb, okb;
#pragma unroll
    for (int c = 0; c < 4; ++c) {
      f32x2_t x = b2[c];
      x = w2[c][0] * g0.x + x;  x = w2[c][1] * g0.y + x;  x = w2[c][2] * g0.z + x;  x = w2[c][3] * g0.w + x;
      x = w2[c][4] * g1.x + x;  x = w2[c][5] * g1.y + x;  x = w2[c][6] * g1.z + x;  x = w2[c][7] * g1.w + x;
      x = w2[c][8] * g2.x + x;  x = w2[c][9] * g2.y + x;  x = w2[c][10] * g2.z + x; x = w2[c][11] * g2.w + x;
      x = w2[c][12] * g3.x + x; x = w2[c][13] * g3.y + x; x = w2[c][14] * g3.z + x; x = w2[c][15] * g3.w + x;
      const float laf = logsig16(x.x), lab = logsig16(x.y);
      float relf, relb;
      if (SW == 0) { relf = -accF[c]; accF[c] += laf; accB[c] += lab; relb = accB[c]; }
      else         { accF[c] += laf; relf = accF[c]; relb = -accB[c]; accB[c] += lab; }
      const float q = bf2f((u16)q4[c]), k = bf2f((u16)k4[c]);
      oqf[c] = (short)f2bf(q * __expf(relf)); okf[c] = (short)f2bf(k * __expf(-relf));
      oqb[c] = (short)f2bf(q * __expf(relb)); okb[c] = (short)f2bf(k * __expf(-relb));
    }
    *(bf16x4*)(Sq + (unsigned)i * 4096u) = oqf;
    *(bf16x4*)(Sq + (unsigned)i * 4096u + 512u) = okf;
    *(bf16x4*)(Ub + (unsigned)i * 1024u) = oqb;
    *(bf16x4*)(Ub + (unsigned)i * 1024u + 512u) = okb;
  }
}

__device__ __forceinline__ void gla_prepass_unit(const Params& p, int l, int bunit, char* smem) {
  const int tid = opaque_tid();
  const int ul = __builtin_amdgcn_readfirstlane(tid >> 7);
  const int gu = bunit * 4 + ul;
  const int sw = gu & 1, ch = gu >> 1;
  const int b = ch / 68, cid = ch % 68;
  const int base = cid < 4 ? (MLAT + b * 256 + cid * 64) : (b * 4096 + (cid - 4) * 64);
  float* GLRS = (float*)smem + ul * 512;
  const int col0 = (tid & 127) * 4;
  __syncthreads();
  {
    const int uw = (tid >> 6) & 1, lane = tid & 63, fr = lane & 15, fq = lane >> 4;
    f32x4 g = (f32x4){0.f, 0.f, 0.f, 0.f};
    const u16* Ua = (const u16*)(p.ws + OFF_U) + (size_t)(base + sw * 32 + uw * 16 + fr) * 1024 + fq * 8;
    const u16* Wb = (const u16*)(p.ws + OFF_WT) + (size_t)(4096 + fr) * 1024 + fq * 8;
#pragma unroll 16
    for (int k = 0; k < 1024; k += 32) {
      bf16x8 a = *(const bf16x8*)(Ua + k);
      bf16x8 w = *(const bf16x8*)(Wb + k);
      g = __builtin_amdgcn_mfma_f32_16x16x32_bf16(a, w, g, 0, 0, 0);
    }
#pragma unroll
    for (int j = 0; j < 4; ++j) GLRS[(uw * 16 + fq * 4 + j) * 16 + fr] = g[j];
  }
  f32x2_t w2[4][16], b2[4];
  {
    const float* w0 = p.gla_w_up + (size_t)(l * 2 + 0) * 16 * 512 + col0;
    const float* w1 = p.gla_w_up + (size_t)(l * 2 + 1) * 16 * 512 + col0;
#pragma unroll
    for (int r = 0; r < 16; ++r) {
      const float4 a = *(const float4*)(w0 + r * 512), c = *(const float4*)(w1 + r * 512);
      w2[0][r].x = a.x; w2[1][r].x = a.y; w2[2][r].x = a.z; w2[3][r].x = a.w;
      w2[0][r].y = c.x; w2[1][r].y = c.y; w2[2][r].y = c.z; w2[3][r].y = c.w;
    }
    const float4 a = *(const float4*)(p.gla_b_up + (l * 2 + 0) * 512 + col0), c = *(const float4*)(p.gla_b_up + (l * 2 + 1) * 512 + col0);
    b2[0].x = a.x; b2[1].x = a.y; b2[2].x = a.z; b2[3].x = a.w;
    b2[0].y = c.x; b2[1].y = c.y; b2[2].y = c.z; b2[3].y = c.w;
  }
  __syncthreads();
  u16* Sq = (u16*)(p.ws + OFF_S) + (size_t)base * 4096 + 2048 + col0;
  u16* Ub = (l == 0 ? (u16*)p.out : (u16*)(p.ws + OFF_U)) + (size_t)base * 1024 + col0;
  float* V0 = (float*)(p.ws + OFF_VECS) + ((size_t)(0 * 544 + b * 68 + cid) * 2) * 512 + col0;
  float* V1 = (float*)(p.ws + OFF_VECS) + ((size_t)(1 * 544 + b * 68 + cid) * 2) * 512 + col0;
  float accF[4], accB[4];
  if (sw == 0) {
    prepass_sweep4<0>(GLRS, w2, b2, Sq, Ub, accF, accB);
    *(float4*)(V0) = make_float4(__expf(accF[0]), __expf(accF[1]), __expf(accF[2]), __expf(accF[3]));
    *(float4*)(V1 + 512) = make_float4(__expf(accB[0]), __expf(accB[1]), __expf(accB[2]), __expf(accB[3]));
  } else {
    prepass_sweep4<1>(GLRS, w2, b2, Sq, Ub, accF, accB);
    *(float4*)(V0 + 512) = make_float4(__expf(accF[0]), __expf(accF[1]), __expf(accF[2]), __expf(accF[3]));
    *(float4*)(V1) = make_float4(__expf(accB[0]), __expf(accB[1]), __expf(accB[2]), __expf(accB[3]));
  }
}

template <int SW>
__device__ __forceinline__ void prepass_sweep(const float* GLRS, const f32x2_t (&w2)[16], f32x2_t b2, u16* Sq, u16* Ub, float& accF, float& accB) {
  accF = 0.f; accB = 0.f;
#pragma unroll 16
  for (int u = 0; u < 32; ++u) {
    const int i = SW ? 32 + u : 31 - u;
    const float4* gr = (const float4*)(GLRS + i * 16);
    const float4 g0 = gr[0], g1 = gr[1], g2 = gr[2], g3 = gr[3];
    f32x2_t x = b2;
    x = w2[0] * g0.x + x;  x = w2[1] * g0.y + x;  x = w2[2] * g0.z + x;  x = w2[3] * g0.w + x;
    x = w2[4] * g1.x + x;  x = w2[5] * g1.y + x;  x = w2[6] * g1.z + x;  x = w2[7] * g1.w + x;
    x = w2[8] * g2.x + x;  x = w2[9] * g2.y + x;  x = w2[10] * g2.z + x; x = w2[11] * g2.w + x;
    x = w2[12] * g3.x + x; x = w2[13] * g3.y + x; x = w2[14] * g3.z + x; x = w2[15] * g3.w + x;
    const float laf = logsig16(x.x), lab = logsig16(x.y);
    float relf, relb;
    if (SW == 0) { relf = -accF; accF += laf; accB += lab; relb = accB; }
    else         { accF += laf; relf = accF; relb = -accB; accB += lab; }
    const float q = bf2f(Sq[(unsigned)i * 4096u]), k = bf2f(Sq[(unsigned)i * 4096u + 512u]);
    Sq[(unsigned)i * 4096u] = f2bf(q * __expf(relf));
    Sq[(unsigned)i * 4096u + 512u] = f2bf(k * __expf(-relf));
    Ub[(unsigned)i * 1024u] = f2bf(q * __expf(relb));
    Ub[(unsigned)i * 1024u + 512u] = f2bf(k * __expf(-relb));
  }
}

__device__ __forceinline__ void gla_prepass_unit1(const Params& p, int l, int unit, char* smem) {
  const int tid = opaque_tid();
  const int sw = unit & 1, ch = unit >> 1;
  const int b = ch / 68, cid = ch % 68;
  const int base = cid < 4 ? (MLAT + b * 256 + cid * 64) : (b * 4096 + (cid - 4) * 64);
  float* GLRS = (float*)smem;
  __syncthreads();
  {
    const int wid = tid >> 6, lane = tid & 63, fr = lane & 15, fq = lane >> 4;
    if (wid < 2) {
      const int r0 = sw * 32 + wid * 16;
      f32x4 g = (f32x4){0.f, 0.f, 0.f, 0.f};
      const u16* Ua = (const u16*)(p.ws + OFF_U) + (size_t)(base + r0 + fr) * 1024 + fq * 8;
      const u16* Wb = (const u16*)(p.ws + OFF_WT) + (size_t)(4096 + fr) * 1024 + fq * 8;
#pragma unroll 16
      for (int k = 0; k < 1024; k += 32) {
        bf16x8 a = *(const bf16x8*)(Ua + k);
        bf16x8 w = *(const bf16x8*)(Wb + k);
        g = __builtin_amdgcn_mfma_f32_16x16x32_bf16(a, w, g, 0, 0, 0);
      }
#pragma unroll
      for (int j = 0; j < 4; ++j) GLRS[(r0 + fq * 4 + j) * 16 + fr] = g[j];
    }
  }
  f32x2_t w2[16];
  {
    const float* w0 = p.gla_w_up + (size_t)(l * 2 + 0) * 16 * 512 + tid;
    const float* w1 = p.gla_w_up + (size_t)(l * 2 + 1) * 16 * 512 + tid;
#pragma unroll
    for (int r = 0; r < 16; ++r) { w2[r].x = w0[r * 512]; w2[r].y = w1[r * 512]; }
  }
  f32x2_t b2; b2.x = p.gla_b_up[(l * 2 + 0) * 512 + tid]; b2.y = p.gla_b_up[(l * 2 + 1) * 512 + tid];
  __syncthreads();
  u16* Sq = (u16*)(p.ws + OFF_S) + (size_t)base * 4096 + 2048 + tid;
  u16* Ub = (l == 0 ? (u16*)p.out : (u16*)(p.ws + OFF_U)) + (size_t)base * 1024 + tid;
  float* V0 = (float*)(p.ws + OFF_VECS) + ((size_t)(0 * 544 + b * 68 + cid) * 2) * 512 + tid;
  float* V1 = (float*)(p.ws + OFF_VECS) + ((size_t)(1 * 544 + b * 68 + cid) * 2) * 512 + tid;
  float accF, accB;
  if (sw == 0) {
    prepass_sweep<0>(GLRS, w2, b2, Sq, Ub, accF, accB);
    V0[0] = __expf(accF);
    V1[512] = __expf(accB);
  } else {
    prepass_sweep<1>(GLRS, w2, b2, Sq, Ub, accF, accB);
    V0[512] = __expf(accF);
    V1[0] = __expf(accB);
  }
}

#define L_QR   0
#define L_KR   17408
#define L_V    34816
#define L_SGT  44032
#define L_P    61440
#undef  SCAN_GB
#define SCAN_GB 70656

__device__ __forceinline__ int off128(int row, int col) { return row * 272 + col * 2; }
__device__ __forceinline__ int off64(int row, int col) { return row * 144 + col * 2; }

template <int RS>
__device__ __forceinline__ bf16x8 tr_frag(unsigned img_addr, int r0, int c0, int lane) {
  const int g = lane >> 4, q = (lane & 15) >> 2, pp = lane & 3;
  unsigned a = img_addr + (unsigned)((r0 + 8 * g + q) * RS + (c0 + 4 * pp) * 2);
  bf16x4 lo, hi;
  asm volatile("ds_read_b64_tr_b16 %0, %2\n\tds_read_b64_tr_b16 %1, %2 offset:%3\n\ts_waitcnt lgkmcnt(0)"
               : "=&v"(lo), "=&v"(hi) : "v"(a), "n"(4 * RS) : "memory");
  bf16x8 r;
  r[0] = lo[0]; r[1] = lo[1]; r[2] = lo[2]; r[3] = lo[3]; r[4] = hi[0]; r[5] = hi[1]; r[6] = hi[2]; r[7] = hi[3];
  return r;
}

typedef short trs4_t __attribute__((ext_vector_type(4)));
__device__ __forceinline__ bf16x8 tr_pair(const char* p, int hi_off) {
  trs4_t lo = __builtin_amdgcn_ds_read_tr16_b64_v4i16((__attribute__((address_space(3))) trs4_t*)p);
  trs4_t hi = __builtin_amdgcn_ds_read_tr16_b64_v4i16((__attribute__((address_space(3))) trs4_t*)(p + hi_off));
  return __builtin_shufflevector(lo, hi, 0, 1, 2, 3, 4, 5, 6, 7);
}

__device__ __forceinline__ bf16x8 scale8(bf16x8 v, float f) {
  bf16x8 o;
#pragma unroll
  for (int x = 0; x < 8; ++x) o[x] = (short)f2bf(bf2f((u16)v[x]) * f);
  return o;
}

__device__ __forceinline__ void lds_barrier() { asm volatile("s_waitcnt lgkmcnt(0)" ::: "memory"); __builtin_amdgcn_s_barrier(); asm volatile("" ::: "memory"); }

template <int branch>
__device__ __forceinline__ void scan_item(const Params& p, int l, int item, char* smem) {
  const int b = (item >> 4) & 7, h = (item >> 2) & 3, slice = item & 3;
  const int tid = opaque_tid(), wid = __builtin_amdgcn_readfirstlane(tid >> 6), lane = tid & 63;
  const int dir = wid >> 2, gw = wid & 3, gt = tid & 255;
  const int fr = lane & 15, fq = lane >> 4;
  char* G = smem + dir * SCAN_GB;
  const unsigned Ga = (unsigned)(size_t)G;
  const u16* S = (const u16*)(p.ws + OFF_S);
  u16* RG = (u16*)(p.ws + OFF_RG);
  const u16* qsrc; unsigned qstride;
  if (branch == 0) { qsrc = S + h * 128; qstride = 4096; }
  else if (dir == 0) { qsrc = S + 2048 + h * 128; qstride = 4096; }
  else { qsrc = (l == 0 ? (const u16*)p.out : (const u16*)(p.ws + OFF_U)) + h * 128; qstride = 1024; }
  const int voff = branch * 2048 + 1024 + h * 256 + slice * 64;
  const int ooff = branch * 1024 + h * 256 + slice * 64;
  float lg = 0.f, egc = 1.f;
  if (branch == 0) { lg = __logf(1.f - __expf(p.ret_decay[(l * 2 + dir) * 4 + h])); egc = __expf(32.f * lg); }
  const float* VECS = (const float*)(p.ws + OFF_VECS) + ((size_t)(dir * 544 + b * 68) * 2) * 512 + h * 128;
  f32x4 st[2][4];
#pragma unroll
  for (int m = 0; m < 2; ++m)
#pragma unroll
    for (int n = 0; n < 4; ++n) st[m][n] = (f32x4){0.f, 0.f, 0.f, 0.f};

  const int qj = gt >> 4, qc = gt & 15;
  const int vj = gt >> 3, vc = gt & 7;
  bf16x8 pq[4], pk[4], pv[2];
  float4 peg[2], pel[2];
  auto prefetch = [&](int s) {
    int base, cid;
    if (s < 4) { int cc = dir ? 3 - s : s; base = MLAT + b * 256 + cc * 64; cid = cc; }
    else { int c = s - 4; int cc = dir ? 63 - c : c; base = b * 4096 + cc * 64; cid = 4 + cc; }
#pragma unroll
    for (int i = 0; i < 4; ++i) {
      int jp = qj + 16 * i;
      const u16* qb_ = qsrc + (size_t)base * qstride;
      unsigned ro = (unsigned)(dir ? 63 - jp : jp) * qstride + qc * 8;
      pq[i] = *(const bf16x8*)(qb_ + ro);
      pk[i] = *(const bf16x8*)(qb_ + ro + 512);
    }
#pragma unroll
    for (int i = 0; i < 2; ++i) {
      int jp = vj + 32 * i;
      pv[i] = *(const bf16x8*)((S + (size_t)base * 4096 + voff) + ((unsigned)(dir ? 63 - jp : jp) * 4096u + vc * 8));
    }
    (void)cid;
  };
  auto chunk_id = [&](int s) { int cid; if (s < 4) { cid = dir ? 3 - s : s; } else { int c = s - 4; cid = 4 + (dir ? 63 - c : c); } return cid; };
  auto prefetch_eg = [&](int s) {
    if (branch == 1) {
      const int cid = chunk_id(s);
#pragma unroll
      for (int m = 0; m < 2; ++m) peg[m] = *(const float4*)(VECS + (size_t)cid * 1024 + gw * 32 + m * 16 + fq * 4);
    } else {
#pragma unroll
      for (int m = 0; m < 2; ++m) peg[m] = make_float4(egc, egc, egc, egc);
    }
  };
  auto prefetch_el = [&](int s) {
    if (branch == 1) {
      const int cid = chunk_id(s);
#pragma unroll
      for (int m = 0; m < 2; ++m) pel[m] = *(const float4*)(VECS + (size_t)cid * 1024 + 512 + gw * 32 + m * 16 + fq * 4);
    } else {
#pragma unroll
      for (int m = 0; m < 2; ++m) pel[m] = make_float4(egc, egc, egc, egc);
    }
  };
  prefetch(0);
  prefetch_eg(0);
  prefetch_el(0);
  __syncthreads();

  for (int s = 0; s < 68; ++s) {
    int base; bool first; bool wout;
    if (s < 4) { int cc = dir ? 3 - s : s; base = MLAT + b * 256 + cc * 64; first = s < 2; wout = (l == 0); }
    else { int c = s - 4; int cc = dir ? 63 - c : c; base = b * 4096 + cc * 64; first = c < 32; wout = true; }
    float4 (&eg)[2] = peg; float4 (&el)[2] = pel;
    float4 egel[2];
#pragma unroll
    for (int i = 0; i < 4; ++i) {
      int jp = qj + 16 * i;
      bf16x8 qv = pq[i], kv_ = pk[i];
      if (branch == 0) {
        float fqs = __expf((float)(jp - 31) * lg), fks = __expf((float)(31 - jp) * lg);
        qv = scale8(qv, fqs); kv_ = scale8(kv_, fks);
      }
      *(bf16x8*)(G + L_QR + off128(jp, qc * 8)) = qv;
      *(bf16x8*)(G + L_KR + off128(jp, qc * 8)) = kv_;
    }
#pragma unroll
    for (int i = 0; i < 2; ++i) *(bf16x8*)(G + L_V + off64(vj + 32 * i, vc * 8)) = pv[i];
#pragma unroll
    for (int m = 0; m < 2; ++m) {
      int d0 = gw * 32 + m * 16 + fq * 4;
#pragma unroll
      for (int n = 0; n < 4; ++n) {
        int e = n * 16 + fr;
        bf16x4 o4;
        o4[0] = (short)f2bf(st[m][n][0] * eg[m].x); o4[1] = (short)f2bf(st[m][n][1] * eg[m].y);
        o4[2] = (short)f2bf(st[m][n][2] * eg[m].z); o4[3] = (short)f2bf(st[m][n][3] * eg[m].w);
        *(bf16x4*)(G + L_SGT + off128(e, d0)) = o4;
      }
    }
#pragma unroll
    for (int m = 0; m < 2; ++m) egel[m] = make_float4(eg[m].x * el[m].x, eg[m].y * el[m].y, eg[m].z * el[m].z, eg[m].w * el[m].w);
    if (branch == 1 && s + 1 < 68) prefetch_eg(s + 1);
    u16 oldv[4][4];
    u16* dstb = RG + (size_t)base * 2048 + ooff;
    if (wout && !first) {
#pragma unroll
      for (int r = 0; r < 4; ++r) {
        int ip = gw * 16 + fq * 4 + r;
        unsigned ro = (unsigned)(dir ? 63 - ip : ip) * 2048u + fr;
#pragma unroll
        for (int n = 0; n < 4; ++n) oldv[r][n] = dstb[ro + n * 16];
      }
    }
    if (s + 1 < 68) prefetch(s + 1);
    lds_barrier();
    f32x4 pt[4], o[4];
#pragma unroll
    for (int n = 0; n < 4; ++n) { pt[n] = (f32x4){0.f, 0.f, 0.f, 0.f}; o[n] = (f32x4){0.f, 0.f, 0.f, 0.f}; }
#pragma unroll
    for (int ks = 0; ks < 4; ++ks) {
      int kc = ks * 32 + fq * 8;
      bf16x8 qa = *(const bf16x8*)(G + L_QR + off128(gw * 16 + fr, kc));
#pragma unroll
      for (int n = 0; n < 4; ++n) {
        bf16x8 ka = *(const bf16x8*)(G + L_KR + off128(n * 16 + fr, kc));
        bf16x8 sb = *(const bf16x8*)(G + L_SGT + off128(n * 16 + fr, kc));
        pt[n] = __builtin_amdgcn_mfma_f32_16x16x32_bf16(ka, qa, pt[n], 0, 0, 0);
        o[n] = __builtin_amdgcn_mfma_f32_16x16x32_bf16(qa, sb, o[n], 0, 0, 0);
      }
    }
    {
      const int ip = gw * 16 + fr;
#pragma unroll
      for (int n = 0; n < 4; ++n) {
        const int j0 = n * 16 + fq * 4;
        bf16x4 w;
#pragma unroll
        for (int r = 0; r < 4; ++r) {
          int jp = j0 + r;
          bool keep = dir ? (ip > jp) : (ip >= jp);
          w[r] = (short)f2bf(keep ? pt[n][r] : 0.f);
        }
        *(bf16x4*)(G + L_P + off64(ip, j0)) = w;
      }
    }
    asm volatile("s_waitcnt lgkmcnt(0)" ::: "memory");
    {
      const int tg = lane >> 4, tq = (lane & 15) >> 2, tp = lane & 3;
#pragma unroll
      for (int m = 0; m < 2; ++m) {
        f32x4 kv[4];
#pragma unroll
        for (int n = 0; n < 4; ++n) kv[n] = (f32x4){0.f, 0.f, 0.f, 0.f};
#pragma unroll
        for (int ks = 0; ks < 2; ++ks) {
          int kc = ks * 32 + fq * 8;
          const char* kp = G + L_KR + (8 * tg + tq) * 272 + (gw * 32 + 4 * tp) * 2 + ks * 32 * 272 + m * 32;
          const char* vp = G + L_V + (8 * tg + tq) * 144 + (4 * tp) * 2 + ks * 32 * 144;
          const bf16x8 km = tr_pair(kp, 4 * 272);
          bf16x8 vb[4];
#pragma unroll
          for (int n = 0; n < 4; ++n) vb[n] = tr_pair(vp + n * 32, 4 * 144);
          bf16x8 pa;
          if (m == 0) pa = *(const bf16x8*)(G + L_P + off64(gw * 16 + fr, kc));
#pragma unroll
          for (int n = 0; n < 4; ++n) {
            if (m == 0) o[n] = __builtin_amdgcn_mfma_f32_16x16x32_bf16(pa, vb[n], o[n], 0, 0, 0);
            kv[n] = __builtin_amdgcn_mfma_f32_16x16x32_bf16(km, vb[n], kv[n], 0, 0, 0);
          }
        }
#pragma unroll
        for (int n = 0; n < 4; ++n) {
          st[m][n][0] = egel[m].x * st[m][n][0] + el[m].x * kv[n][0];
          st[m][n][1] = egel[m].y * st[m][n][1] + el[m].y * kv[n][1];
          st[m][n][2] = egel[m].z * st[m][n][2] + el[m].z * kv[n][2];
          st[m][n][3] = egel[m].w * st[m][n][3] + el[m].w * kv[n][3];
        }
      }
    }
    if (branch == 1 && s + 1 < 68) prefetch_el(s + 1);
    if (wout) {
#pragma unroll
      for (int r = 0; r < 4; ++r) {
        int ip = gw * 16 + fq * 4 + r;
        unsigned ro = (unsigned)(dir ? 63 - ip : ip) * 2048u + fr;
#pragma unroll
        for (int n = 0; n < 4; ++n) {
          float v = o[n][r];
          if (!first) v += bf2f(oldv[r][n]);
          dstb[ro + n * 16] = f2bf(v);
        }
      }
    }
    __syncthreads();
  }
}

#define NPHASE 18
__device__ __forceinline__ void run_phase(const Params& p, int ph, char* smem) {
  const int nblk = gridDim.x, bid = blockIdx.x;
  if (ph == 0) {
#ifdef REP_P0
    for (int rep = 0; rep < REP_P0; ++rep)
#endif
    for (int u = bid; u < WT_UNITS + 96 + 1; u += nblk) {
      if (u < 96) mod_unit(p, u, smem);
      else if (u == 96) rot_unit(p);
      else wt_unit(p, 0, u - 97, smem);
    }
    return;
  }
  if (ph == NPHASE - 1) { phase_final(p); return; }
  const int l = (ph - 1) / 8, sp = (ph - 1) % 8;
  PG8_LAS unsigned char* lds = (PG8_LAS unsigned char*)smem;
  switch (sp) {
    case 0:
      phase_u(p, l);
      if (l == 1) for (int u = bid; u < WT_UNITS; u += nblk) wt_unit(p, 1, u, smem);
      break;
    case 1: {
      pg8::Gemm g{(const u16*)(p.ws + OFF_U), (const u16*)(p.ws + OFF_WT) + (size_t)WT_SCAN * 1024, 1024, MTOT, 4096, 1024};
      pg8::StaticOrder S; S.init(g.M, g.N, nblk, bid);
      EpiScanIn E{(u16*)(p.ws + OFF_S), (const float*)(p.ws + OFF_ROT)};
      pg8::gemm_phase(lds, g, S, E, opaque_tid());
    } break;
    case 2:
      for (int t = bid; t < 256; t += nblk) gla_prepass_unit(p, l, t, smem);
      for (int t = 1024 + (bid + 96) % nblk; t < 1088; t += nblk) gla_prepass_unit1(p, l, t, smem);
      break;
    case 3:
#ifdef REP_SCAN
      for (int rep = 0; rep < REP_SCAN; ++rep)
#endif
      for (int t0 = bid; t0 < 256; t0 += nblk) {
        const int x = t0 & 7, j = t0 >> 3;
        const int grp = ((j >> 2) & 1) * 32 + x * 4 + (j >> 3);
        const int t = (grp << 2) | (j & 3);
        if (t < 128) scan_item<0>(p, l, t, smem); else scan_item<1>(p, l, t, smem);
      }
      break;
    case 4:
      if (l != 0) phase_u(p, l);
      phase_stats(p, l);
      break;
    case 5: {
      pg8::Gemm g{(const u16*)(p.ws + OFF_U), (const u16*)(p.ws + OFF_WT) + (size_t)WT_GATE * 1024, 1024, l == 0 ? MTOT : MLAT, 4096, 1024};
      pg8::StaticOrder S; S.init(g.M, g.N, nblk, bid);
      EpiGate E{(const u16*)(p.ws + OFF_RG), (const float*)(p.ws + OFF_STATS), (u16*)(p.ws + OFF_S), p.ret_norm_gain + l * 1024, p.gla_norm_gain + l * 1024};
      pg8::gemm_phase(lds, g, S, E, opaque_tid());
    } break;
    case 6: {
#pragma unroll 1
      for (int pass = 0; pass < 2; ++pass) {
        pg8::Gemm g{(const u16*)(p.ws + OFF_S) + 2048 + pass * 1024, (const u16*)(p.ws + OFF_WT) + (size_t)(WT_BRR + pass * 1024) * 1024, 4096, l == 0 ? MTOT : MLAT, 1024, 1024};
        pg8::StaticOrder S; S.init(g.M, g.N, nblk, bid);
        EpiMerge E{(const u16*)(p.ws + OFF_S), (u16*)(p.ws + OFF_U), pass};
        pg8::gemm_phase(lds, g, S, E, opaque_tid());
      }
    } break;
    case 7: {
      pg8::Gemm g{(const u16*)(p.ws + OFF_U), (const u16*)(p.ws + OFF_WT) + (size_t)WT_OUT * 1024, 1024, l == 0 ? MTOT : MLAT, 1024, 1024};
      pg8::StaticOrder S; S.init(g.M, g.N, nblk, bid);
      EpiOut E{l == 0 ? p.x : p.out, p.ctx, p.out, (float*)(p.ws + OFF_HCTX), (const float*)(p.ws + OFF_MOD) + (size_t)l * 9 * 3072};
      pg8::gemm_phase(lds, g, S, E, opaque_tid());
    } break;
  }
}

#define XB_TMO      128
#define XB_XCNT(j)  (256  + 64 * (j))
#define XB_XSUB(j)  (1280 + 64 * (j))
#define XB_XGEN(j)  (2304 + 64 * (j))
#define XB_TOP      3328
#define XB_TOPGEN   3392
#define XCD_BAR_WORDS 3456
#define XB_SPIN_CAP (1u << 18)
__device__ __forceinline__ unsigned xb_ld(unsigned* p)              { return __hip_atomic_load(p, __ATOMIC_RELAXED, __HIP_MEMORY_SCOPE_AGENT); }
__device__ __forceinline__ unsigned xb_add(unsigned* p, unsigned v) { return __hip_atomic_fetch_add(p, v, __ATOMIC_RELAXED, __HIP_MEMORY_SCOPE_AGENT); }
__device__ __forceinline__ unsigned xb_xcc_id() { return (unsigned)__builtin_amdgcn_s_getreg((3 << 11) | 20) & 0xFu; }
#define XB_SPIN(cond, bar) do { unsigned _sp = 0; while (cond) { __builtin_amdgcn_s_sleep(1); \
    if ((++_sp & 255u) == 0u) { if (xb_ld(&(bar)[XB_TMO])) break; if (_sp > XB_SPIN_CAP) { atomicAdd(&(bar)[XB_TMO], 1u); break; } } } } while (0)

__device__ __forceinline__ void xcd_barrier_complete(unsigned* bar, unsigned x, unsigned& nloc, unsigned& nx) {
  const unsigned G = gridDim.x * gridDim.y * gridDim.z;
  unsigned sum, cnt, mine, sp = 0u;
  for (;;) {
    sum = 0u; cnt = 0u; mine = 0u;
#pragma unroll
    for (unsigned j = 0; j < 16; ++j) { const unsigned c = xb_ld(&bar[XB_XCNT(j)]); sum += c; cnt += (c > 0u) ? 1u : 0u; mine = (j == x) ? c : mine; }
    if (sum == G) break;
    __builtin_amdgcn_s_sleep(1);
    if ((++sp & 255u) == 0u) { if (xb_ld(&bar[XB_TMO])) break; if (sp > XB_SPIN_CAP) { atomicAdd(&bar[XB_TMO], 1u); break; } }
  }
  nloc = mine > 0u ? mine : 1u; nx = cnt > 0u ? cnt : 1u;
}

__device__ __forceinline__ void xcd_barrier(unsigned* bar, volatile unsigned* st) {
  asm volatile("s_waitcnt vmcnt(0)" ::: "memory");
  __syncthreads();
  if (threadIdx.x == 0) {
    const unsigned x = xb_xcc_id();
    __builtin_amdgcn_s_waitcnt(0);
    unsigned nloc = st[0], nx = st[1];
    if (nloc == 0u) { xcd_barrier_complete(bar, x, nloc, nx); st[0] = nloc; st[1] = nx; }
    const unsigned old = xb_add(&bar[XB_XSUB(x)], 1u);
    const unsigned gen = old / nloc;
    if (old + 1u == (gen + 1u) * nloc) {
      __builtin_amdgcn_fence(__ATOMIC_RELEASE, "agent");
      asm volatile("s_waitcnt vmcnt(0)" ::: "memory");
      const unsigned og = xb_add(&bar[XB_TOP], 1u);
      const unsigned tg = og / nx;
      if (og + 1u == (tg + 1u) * nx) xb_add(&bar[XB_TOPGEN], 1u);
      else XB_SPIN(xb_ld(&bar[XB_TOPGEN]) == tg, bar);
      __builtin_amdgcn_fence(__ATOMIC_ACQUIRE, "agent");
      xb_add(&bar[XB_XGEN(x)], 1u);
      asm volatile("s_waitcnt vmcnt(0)" ::: "memory");
    } else {
      XB_SPIN(xb_ld(&bar[XB_XGEN(x)]) == gen, bar);
      __builtin_amdgcn_fence(__ATOMIC_ACQUIRE, "agent");
      asm volatile("s_waitcnt vmcnt(0)" ::: "memory");
    }
  }
  __syncthreads();
}

__global__ void __launch_bounds__(NTHREADS) mega(Params p, int ph_lo, int ph_hi, int coop) {
  extern __shared__ __attribute__((aligned(16))) char smem[];
  volatile unsigned* xst = (volatile unsigned*)(smem + XB_LDS_OFF);
  unsigned* xbar = (unsigned*)(p.ws + OFF_BAR);
  if (coop) {
    if (threadIdx.x == 0) { xst[0] = 0u; xst[1] = 0u; (void)xb_add(&xbar[XB_XCNT(xb_xcc_id())], 1u); }
    __syncthreads();
  }
  for (int ph = ph_lo; ph < ph_hi; ++ph) {
    run_phase(p, ph, smem);
    if (coop && ph + 1 < ph_hi) {
      if (ph == ph_lo) cg::this_grid().sync();
      else xcd_barrier(xbar, xst);
    }
  }
}

extern "C" void kernel_launch(void* const* d_in, const int* in_sizes, int n_in,
                              void* d_out, int out_size, void* d_ws, size_t ws_size,
                              hipStream_t stream) {
  Params p{};
  p.x = (const float*)d_in[0]; p.c = (const float*)d_in[1]; p.ctx = (const float*)d_in[2]; p.c_ctx = (const float*)d_in[3];
  p.norm_gain = (const float*)d_in[4]; p.w_ada = (const float*)d_in[5]; p.b_ada = (const float*)d_in[6]; p.w_in = (const float*)d_in[7];
  p.ret_decay = (const float*)d_in[8]; p.gla_w_up = (const float*)d_in[9]; p.gla_b_up = (const float*)d_in[10];
  p.ret_norm_gain = (const float*)d_in[11]; p.gla_norm_gain = (const float*)d_in[12];
  p.w_br_ret = (const float*)d_in[13]; p.w_br_gla = (const float*)d_in[14]; p.w_out = (const float*)d_in[15]; p.final_gain = (const float*)d_in[16];
  p.out = (float*)d_out; p.ws = (char*)d_ws;
  static int grid_blocks = 0;
  if (!grid_blocks) {
    hipFuncSetAttribute((const void*)mega, hipFuncAttributeMaxDynamicSharedMemorySize, LDS_BYTES);
    int dev = 0, cus = 0, per_cu = 0;
    hipGetDevice(&dev);
    hipDeviceGetAttribute(&cus, hipDeviceAttributeMultiprocessorCount, dev);
    hipOccupancyMaxActiveBlocksPerMultiprocessor(&per_cu, mega, NTHREADS, LDS_BYTES);
    if (per_cu < 1) per_cu = 1;
    grid_blocks = cus * 1;
  }
#ifdef MULTI_LAUNCH
  for (int ph = 0; ph < NPHASE; ++ph) {
    mega<<<dim3(grid_blocks), dim3(NTHREADS), LDS_BYTES, stream>>>(p, ph, ph + 1, 0);
  }
#else
  hipMemsetAsync((char*)d_ws + OFF_BAR, 0, 16384, stream);
  int lo = 0, hi = NPHASE, coop = 1;
  void* args[] = {&p, &lo, &hi, &coop};
  hipError_t e = hipLaunchCooperativeKernel((void*)mega, dim3(grid_blocks), dim3(NTHREADS), args, LDS_BYTES, stream);
  if (e != hipSuccess) fprintf(stderr, "cooperative launch failed: %s (grid %d)\n", hipGetErrorString(e), grid_blocks);
#endif
}
```
